# Optimizing an MI355X kernel written in HIP

```python
import math
import jax, jax.numpy as jnp
from jax import lax
import numpy as np

D_MODEL = 1024
BATCH = 8
SEQ = 2048
DEPTH = 2

GRID_W = 64
CTX_LEN = 256

N_BRANCH = 4
BRANCH_W = 512
GDN_HEADS = 4
GDN_DK = 128
GDN_DV = 128
GDN_CHUNK = 64
SHORT_CONV = 5
CONF_KW = 31
CONF_GROUPS = 4
FFT_GROUPS = 4
SGU_CHUNK = 128
SGU_GROUPS = 4
MOE_GROUPS = 4
MOE_PER_GROUP = 4
N_EXPERTS = MOE_GROUPS * MOE_PER_GROUP
MOE_TOPK = 2
EXPERT_HIDDEN = 512

DN_ALPHA = (2 * DEPTH) ** 0.25
DN_BETA = (8 * DEPTH) ** -0.25
LN_EPS = 1e-6

OFF_Q = 0
OFF_K = OFF_Q + GDN_HEADS * GDN_DK
OFF_V = OFF_K + GDN_HEADS * GDN_DK
OFF_Z = OFF_V + GDN_HEADS * GDN_DV
OFF_A = OFF_Z + GDN_HEADS * GDN_DV
OFF_B = OFF_A + 2 * GDN_HEADS
OFF_CONF = OFF_B + 2 * GDN_HEADS
OFF_FFT = OFF_CONF + 2 * BRANCH_W
OFF_SGU = OFF_FFT + BRANCH_W
OFF_GATE = OFF_SGU + 2 * BRANCH_W
N_IN = OFF_GATE + N_BRANCH * D_MODEL

kernel_name = 'hybrid_gdn_conformer_fnet_sgu_hmoe'


def layer_norm(x, eps=LN_EPS):
    xf = x.astype(jnp.float32)
    mu = jnp.mean(xf, -1, keepdims=True)
    var = jnp.mean(jnp.square(xf - mu), -1, keepdims=True)
    return ((xf - mu) * lax.rsqrt(var + eps)).astype(x.dtype)


def affine_ln(x, g, b):
    return layer_norm(x) * g + b


def group_ln(x, g, b, groups):
    shp = x.shape
    y = layer_norm(x.reshape(*shp[:-1], groups, shp[-1] // groups)).reshape(shp)
    return y * g + b


def rms_norm(x, w, eps=LN_EPS):
    xf = x.astype(jnp.float32)
    return xf * lax.rsqrt(jnp.mean(jnp.square(xf), -1, keepdims=True) + eps) * w


def l2_normalize(x, eps=LN_EPS):
    xf = x.astype(jnp.float32)
    return xf * lax.rsqrt(jnp.sum(jnp.square(xf), -1, keepdims=True) + eps)


def modulate(x, shift, scale):
    return layer_norm(x) * (1 + scale) + shift


def depthwise_conv(x, w):
    k, ch = w.shape
    return lax.conv_general_dilated(x, w[:, None, :].astype(x.dtype), window_strides=(1,),
                                    padding=[(k // 2, k // 2)],
                                    dimension_numbers=('NWC', 'WIO', 'NWC'),
                                    feature_group_count=ch)


def sincos_2d(n, d):
    rows = n // GRID_W
    row = jnp.broadcast_to(jnp.arange(rows, dtype=jnp.float32)[:, None], (rows, GRID_W)).reshape(-1)
    col = jnp.broadcast_to(jnp.arange(GRID_W, dtype=jnp.float32)[None, :], (rows, GRID_W)).reshape(-1)
    quarter = d // 4
    omega = 1.0 / (10000.0 ** (jnp.arange(quarter, dtype=jnp.float32) / quarter))

    def enc(pos):
        ang = pos[:, None] * omega[None, :]
        return jnp.concatenate([jnp.sin(ang), jnp.cos(ang)], -1)

    return jnp.concatenate([enc(row), enc(col)], -1)


def gdn_chunk_scan(q, k, v, g, beta, s0):
    bsz, t, h, dk = q.shape
    dv = v.shape[-1]
    cs = GDN_CHUNK
    n = t // cs

    def to_chunks(a):
        a = a.reshape(bsz, n, cs, h, *a.shape[3:])
        return jnp.moveaxis(a, 3, 1)

    q, k, v, g, beta = (to_chunks(a) for a in (q, k, v, g, beta))
    gc = jnp.cumsum(g, axis=-1)
    incl = jnp.tril(jnp.ones((cs, cs), bool))
    strict = jnp.tril(jnp.ones((cs, cs), bool), -1)
    decay = jnp.exp(jnp.where(incl, gc[..., :, None] - gc[..., None, :], -jnp.inf))
    kb = k * beta[..., None]
    kk = jnp.einsum('bhnid,bhnjd->bhnij', kb, k) * decay
    a_mat = jnp.eye(cs, dtype=jnp.float32) + jnp.where(strict, kk, 0.0)
    rhs = jnp.concatenate([v * beta[..., None], kb * jnp.exp(gc)[..., None]], -1)
    sol = lax.linalg.triangular_solve(a_mat, rhs, left_side=True, lower=True, unit_diagonal=True)
    u, w = sol[..., :dv], sol[..., dv:]
    attn = jnp.einsum('bhnid,bhnjd->bhnij', q, k) * decay
    qg = q * jnp.exp(gc)[..., None]
    g_last = gc[..., -1]
    kd = k * jnp.exp(g_last[..., None] - gc)[..., None]

    def step(s, xs):
        w_n, u_n, qg_n, kd_n, attn_n, gl_n = xs
        v_new = u_n - jnp.einsum('bhcd,bhde->bhce', w_n, s)
        o_n = jnp.einsum('bhcd,bhde->bhce', qg_n, s) + jnp.einsum('bhij,bhje->bhie', attn_n, v_new)
        s = s * jnp.exp(gl_n)[..., None, None] + jnp.einsum('bhcd,bhce->bhde', kd_n, v_new)
        return s, o_n

    xs = tuple(jnp.moveaxis(a, 2, 0) for a in (w, u, qg, kd, attn, g_last))
    s_fin, o = lax.scan(step, s0, xs)
    o = o.transpose(1, 0, 3, 2, 4).reshape(bsz, t, h, dv)
    return o, s_fin


def gdn_inputs(p, conv_w, a_log, dt_bias):
    bsz, t, _ = p.shape
    qkv = jax.nn.silu(depthwise_conv(p[..., OFF_Q:OFF_Z], conv_w)).astype(jnp.float32)
    q = l2_normalize(qkv[..., OFF_Q:OFF_K].reshape(bsz, t, GDN_HEADS, GDN_DK)) * (GDN_DK ** -0.5)
    k = l2_normalize(qkv[..., OFF_K:OFF_V].reshape(bsz, t, GDN_HEADS, GDN_DK))
    v = qkv[..., OFF_V:OFF_Z].reshape(bsz, t, GDN_HEADS, GDN_DV)
    a = p[..., OFF_A:OFF_B].astype(jnp.float32).reshape(bsz, t, 2, GDN_HEADS)
    b = p[..., OFF_B:OFF_CONF].astype(jnp.float32).reshape(bsz, t, 2, GDN_HEADS)
    g = -jnp.exp(a_log.astype(jnp.float32)) * jax.nn.softplus(a + dt_bias.astype(jnp.float32))
    beta = jax.nn.sigmoid(b)
    return q, k, v, g, beta


def gdn_bidirectional(inputs, s0_f, s0_b):
    q, k, v, g, beta = inputs
    o_f, s_f = gdn_chunk_scan(q, k, v, g[:, :, 0], beta[:, :, 0], s0_f)
    flip = lambda a: jnp.flip(a, axis=1)
    o_b, s_b = gdn_chunk_scan(flip(q), flip(k), flip(v), flip(g[:, :, 1]), flip(beta[:, :, 1]), s0_b)
    return o_f + flip(o_b), s_f, s_b


def gdn_branch(o, p, norm_w):
    bsz, t = p.shape[:2]
    z = p[..., OFF_Z:OFF_A].astype(jnp.float32).reshape(bsz, t, GDN_HEADS, GDN_DV)
    y = rms_norm(o, norm_w.astype(jnp.float32)) * jax.nn.silu(z)
    return y.reshape(bsz, t, GDN_HEADS * GDN_DV).astype(p.dtype)


def conformer_branch(p, dw_w, dw_b, ln_g, ln_b):
    a, gt = jnp.split(p[..., OFF_CONF:OFF_FFT], 2, axis=-1)
    h = depthwise_conv(a * jax.nn.sigmoid(gt), dw_w) + dw_b
    return jax.nn.silu(group_ln(h, ln_g, ln_b, CONF_GROUPS))


def fourier_branch(p):
    bsz, t = p.shape[:2]
    h = p[..., OFF_FFT:OFF_SGU].astype(jnp.float32).reshape(bsz, t, FFT_GROUPS, BRANCH_W // FFT_GROUPS)
    y = jnp.fft.fft2(h, axes=(1, 3), norm='ortho').real
    return y.reshape(bsz, t, BRANCH_W).astype(p.dtype)


def sgu_branch(p, ln_g, ln_b, ws, bs):
    bsz, t = p.shape[:2]
    u, v = jnp.split(jax.nn.gelu(p[..., OFF_SGU:OFF_GATE]), 2, axis=-1)
    v = group_ln(v, ln_g, ln_b, SGU_GROUPS)
    vc = v.reshape(bsz, t // SGU_CHUNK, SGU_CHUNK, SGU_GROUPS, BRANCH_W // SGU_GROUPS)
    s = jnp.einsum('gpq,bnqgc->bnpgc', ws, vc) + bs.T[None, None, :, :, None]
    return u * s.reshape(bsz, t, BRANCH_W)


def token_mix_out(p, o_gdn, gdn_norm_w, conf_dw_w, conf_dw_b, conf_ln_g, conf_ln_b,
                  sgu_ln_g, sgu_ln_b, sgu_ws, sgu_bs, w_branch, w_out, b_out):
    bsz, t = p.shape[:2]
    branches = jnp.stack([gdn_branch(o_gdn, p, gdn_norm_w),
                          conformer_branch(p, conf_dw_w, conf_dw_b, conf_ln_g, conf_ln_b),
                          fourier_branch(p),
                          sgu_branch(p, sgu_ln_g, sgu_ln_b, sgu_ws, sgu_bs)], axis=2)
    proj = jnp.einsum('btiw,iwd->btid', branches, w_branch)
    gates = jax.nn.sigmoid(p[..., OFF_GATE:].reshape(bsz, t, N_BRANCH, D_MODEL))
    merged = jnp.sum(gates * proj, axis=2)
    return merged @ w_out + b_out


def hier_moe(h, rg_w, rg_b, re_w, re_b, w_gate, w_up, w_down):
    shp = h.shape
    tok = h.reshape(-1, shp[-1])
    glog = (tok @ rg_w + rg_b).astype(jnp.float32)
    gprob = jax.nn.softmax(glog, axis=-1)
    gsel = jnp.argmax(glog, axis=-1)
    gp = jnp.max(gprob, axis=-1, keepdims=True)
    elog = (tok @ re_w + re_b).astype(jnp.float32).reshape(-1, MOE_GROUPS, MOE_PER_GROUP)
    elog_sel = jnp.sum(elog * jax.nn.one_hot(gsel, MOE_GROUPS, dtype=jnp.float32)[:, :, None], axis=1)
    top_v, top_i = lax.top_k(elog_sel, MOE_TOPK)
    top_w = jax.nn.softmax(top_v, axis=-1) * gp
    eidx = gsel[:, None] * MOE_PER_GROUP + top_i
    comb = jnp.sum(jax.nn.one_hot(eidx, N_EXPERTS, dtype=jnp.float32) * top_w[..., None], axis=1)
    out = jnp.zeros(tok.shape, jnp.float32)
    for e in range(N_EXPERTS):
        hid = jax.nn.silu(tok @ w_gate[e]) * (tok @ w_up[e])
        out = out + comb[:, e:e + 1] * (hid @ w_down[e])
    return out.reshape(shp).astype(h.dtype)


def setup_inputs(seed: int = 0) -> dict:
    key = jax.random.key(seed)
    keys = jax.random.split(key, 48)
    counter = [0]

    def nk():
        k = keys[counter[0]]
        counter[0] += 1
        return k

    def nrm(shape, scale):
        return jax.random.normal(nk(), shape, jnp.float32) * scale

    L, D = DEPTH, D_MODEL
    x = nrm((BATCH, SEQ, D), 1.0)
    c = nrm((BATCH, D), 1.0)
    ctx = nrm((BATCH, CTX_LEN, D), 1.0)
    c_ctx = nrm((D,), 1.0)
    w_mod = nrm((L, D, 6 * D), 0.5 * D ** -0.5)
    b_mod = nrm((L, 6 * D), 0.02)
    w_in = nrm((L, D, N_IN), D ** -0.5)
    b_in = nrm((L, N_IN), 0.02)
    gdn_conv_w = nrm((L, SHORT_CONV, OFF_Z), SHORT_CONV ** -0.5)
    gdn_a_log = jnp.log(jax.random.uniform(nk(), (L, 2, GDN_HEADS), jnp.float32, 1.0, 16.0))
    dt = jnp.exp(jax.random.uniform(nk(), (L, 2, GDN_HEADS), jnp.float32, math.log(1e-3), math.log(1e-1)))
    gdn_dt_bias = dt + jnp.log(-jnp.expm1(-dt))
    gdn_norm_w = 1.0 + nrm((L, GDN_DV), 0.02)
    conf_dw_w = nrm((L, CONF_KW, BRANCH_W), CONF_KW ** -0.5)
    conf_dw_b = nrm((L, BRANCH_W), 0.02)
    conf_ln_g = 1.0 + nrm((L, BRANCH_W), 0.02)
    conf_ln_b = nrm((L, BRANCH_W), 0.02)
    sgu_ln_g = 1.0 + nrm((L, BRANCH_W), 0.02)
    sgu_ln_b = nrm((L, BRANCH_W), 0.02)
    sgu_ws = nrm((L, SGU_GROUPS, SGU_CHUNK, SGU_CHUNK), 0.5 * SGU_CHUNK ** -0.5)
    sgu_bs = 1.0 + nrm((L, SGU_GROUPS, SGU_CHUNK), 0.02)
    w_branch = nrm((L, N_BRANCH, BRANCH_W, D), DN_BETA * BRANCH_W ** -0.5)
    w_out = nrm((L, D, D), DN_BETA * D ** -0.5)
    b_out = nrm((L, D), 0.02)
    ln1_g = 1.0 + nrm((L, D), 0.02)
    ln1_b = nrm((L, D), 0.02)
    ln2_g = 1.0 + nrm((L, D), 0.02)
    ln2_b = nrm((L, D), 0.02)
    router_group_w = nrm((L, D, MOE_GROUPS), D ** -0.5)
    router_group_b = nrm((L, MOE_GROUPS), 0.01)
    router_expert_w = nrm((L, D, N_EXPERTS), D ** -0.5)
    router_expert_b = nrm((L, N_EXPERTS), 0.01)
    expert_w_gate = nrm((L, N_EXPERTS, D, EXPERT_HIDDEN), D ** -0.5)
    expert_w_up = nrm((L, N_EXPERTS, D, EXPERT_HIDDEN), D ** -0.5)
    expert_w_down = nrm((L, N_EXPERTS, EXPERT_HIDDEN, D), DN_BETA * EXPERT_HIDDEN ** -0.5)
    return {'x': x, 'c': c, 'ctx': ctx, 'c_ctx': c_ctx, 'w_mod': w_mod, 'b_mod': b_mod,
            'w_in': w_in, 'b_in': b_in, 'gdn_conv_w': gdn_conv_w, 'gdn_a_log': gdn_a_log,
            'gdn_dt_bias': gdn_dt_bias, 'gdn_norm_w': gdn_norm_w, 'conf_dw_w': conf_dw_w,
            'conf_dw_b': conf_dw_b, 'conf_ln_g': conf_ln_g, 'conf_ln_b': conf_ln_b,
            'sgu_ln_g': sgu_ln_g, 'sgu_ln_b': sgu_ln_b, 'sgu_ws': sgu_ws, 'sgu_bs': sgu_bs,
            'w_branch': w_branch, 'w_out': w_out, 'b_out': b_out, 'ln1_g': ln1_g, 'ln1_b': ln1_b,
            'ln2_g': ln2_g, 'ln2_b': ln2_b, 'router_group_w': router_group_w,
            'router_group_b': router_group_b, 'router_expert_w': router_expert_w,
            'router_expert_b': router_expert_b, 'expert_w_gate': expert_w_gate,
            'expert_w_up': expert_w_up, 'expert_w_down': expert_w_down}


def reference(x, c, ctx, c_ctx, w_mod, b_mod, w_in, b_in, gdn_conv_w, gdn_a_log, gdn_dt_bias, gdn_norm_w,
              conf_dw_w, conf_dw_b, conf_ln_g, conf_ln_b, sgu_ln_g, sgu_ln_b, sgu_ws, sgu_bs,
              w_branch, w_out, b_out, ln1_g, ln1_b, ln2_g, ln2_b, router_group_w, router_group_b,
              router_expert_w, router_expert_b, expert_w_gate, expert_w_up, expert_w_down):
    bsz, n_lat, d = x.shape
    h_lat = x + sincos_2d(n_lat, d).astype(x.dtype)[None]
    h_ctx = ctx
    s_zero = jnp.zeros((bsz, GDN_HEADS, GDN_DK, GDN_DV), jnp.float32)
    for l in range(DEPTH):
        last = l == DEPTH - 1
        mod_lat = jnp.split((jax.nn.silu(c) @ w_mod[l] + b_mod[l])[:, None, :], 6, axis=-1)
        mod_ctx = jnp.split((jax.nn.silu(c_ctx) @ w_mod[l] + b_mod[l])[None, None, :], 6, axis=-1)
        mix_w = (gdn_norm_w[l], conf_dw_w[l], conf_dw_b[l], conf_ln_g[l], conf_ln_b[l],
                 sgu_ln_g[l], sgu_ln_b[l], sgu_ws[l], sgu_bs[l], w_branch[l], w_out[l], b_out[l])
        moe_w = (router_group_w[l], router_group_b[l], router_expert_w[l], router_expert_b[l],
                 expert_w_gate[l], expert_w_up[l], expert_w_down[l])
        p_lat = modulate(h_lat, mod_lat[0], mod_lat[1]) @ w_in[l] + b_in[l]
        p_ctx = modulate(h_ctx, mod_ctx[0], mod_ctx[1]) @ w_in[l] + b_in[l]
        gdn_c = gdn_inputs(p_ctx, gdn_conv_w[l], gdn_a_log[l], gdn_dt_bias[l])
        o_ctx, s_f, s_b = gdn_bidirectional(gdn_c, s_zero, s_zero)
        gdn_l = gdn_inputs(p_lat, gdn_conv_w[l], gdn_a_log[l], gdn_dt_bias[l])
        o_lat, _, _ = gdn_bidirectional(gdn_l, s_f, s_b)
        y_lat = token_mix_out(p_lat, o_lat, *mix_w)
        h_lat = affine_ln(DN_ALPHA * h_lat + mod_lat[2] * y_lat, ln1_g[l], ln1_b[l])
        m_lat = hier_moe(modulate(h_lat, mod_lat[3], mod_lat[4]), *moe_w)
        h_lat = affine_ln(DN_ALPHA * h_lat + mod_lat[5] * m_lat, ln2_g[l], ln2_b[l])
        if not last:
            y_ctx = token_mix_out(p_ctx, o_ctx, *mix_w)
            h_ctx = affine_ln(DN_ALPHA * h_ctx + mod_ctx[2] * y_ctx, ln1_g[l], ln1_b[l])
            m_ctx = hier_moe(modulate(h_ctx, mod_ctx[3], mod_ctx[4]), *moe_w)
            h_ctx = affine_ln(DN_ALPHA * h_ctx + mod_ctx[5] * m_ctx, ln2_g[l], ln2_b[l])
    return h_lat
```

```cpp
#include <hip/hip_runtime.h>
#include <cstdio>
#include <cstdint>

#define GAS __attribute__((address_space(1)))
#define LAS __attribute__((address_space(3)))
typedef unsigned short bf16;
typedef unsigned v4u __attribute__((ext_vector_type(4)));
typedef unsigned v2u __attribute__((ext_vector_type(2)));
typedef float f32x4 __attribute__((ext_vector_type(4)));
typedef float f32x2 __attribute__((ext_vector_type(2)));
typedef short bf16x8 __attribute__((ext_vector_type(8)));

constexpr int D = 1024, NB = 8, SEQ = 2048, CTXL = 256, NLAT = NB * SEQ, NCTX = NB * CTXL, NTOK = NLAT + NCTX;
constexpr int OFF_Q = 0, OFF_K = 512, OFF_V = 1024, OFF_Z = 1536, OFF_A = 2048, OFF_B = 2056, OFF_CONF = 2064, OFF_FFT = 3088, OFF_SGU = 3600, OFF_GATE = 4624, N_IN = 8720;
constexpr int NWROWS = 9216;
constexpr float LN_EPS = 1e-6f;
constexpr float DN_ALPHA = 1.4142135623730951f;
constexpr int NWAVES = 8;
constexpr int NPH_LAYER = 13, NPHASES = 1 + 2 * NPH_LAYER;

#ifndef PHMASK
#define PHMASK 0xFFFFFFFFu
#endif
#define PH_ON(k) (((PHMASK) >> (k)) & 1u)
#ifndef CPART
#define CPART 15
#endif
#ifndef MK_ONE_LAUNCH
#define MK_ONE_LAUNCH 0
#endif

constexpr size_t MiB = 1u << 20;
constexpr size_t WS_CTL = 0, CTL_ZERO_BYTES = 1 * MiB;
constexpr size_t WS_MODV = 1 * MiB;
constexpr size_t WS_BIN = 1 * MiB + 512 * 1024;
constexpr size_t WS_ROUTE = WS_BIN + 64 * 1024;
constexpr size_t WS_HCTX = 3 * MiB;
constexpr size_t WS_XN = 11 * MiB;
constexpr size_t WS_WIN = 47 * MiB;
constexpr size_t WS_WBR = 65 * MiB;
constexpr size_t WS_WOUT = 69 * MiB;
constexpr size_t WS_DFTL = 71 * MiB;
constexpr size_t WS_DFTC = 87 * MiB;
constexpr size_t WS_R2 = 88 * MiB;
constexpr size_t WS_PQKV = WS_R2;
constexpr size_t WS_PCONF = WS_R2 + 54 * MiB;
constexpr size_t WS_PZ = WS_R2 + 72 * MiB;
constexpr size_t WS_PSGU = WS_R2 + 90 * MiB;
constexpr size_t WS_PFFT = WS_R2 + 126 * MiB;
constexpr size_t WS_PFFTC = WS_R2 + 158 * MiB;
constexpr size_t WS_AB = WS_R2 + 162 * MiB;
constexpr size_t WS_OF = WS_R2;
constexpr size_t WS_OB = WS_R2 + 36 * MiB;
constexpr size_t WS_G = WS_R2;
constexpr size_t WS_WGU = WS_R2;
constexpr size_t WS_WDN = WS_R2 + 32 * MiB;
constexpr size_t WS_XG = WS_R2 + 48 * MiB;
constexpr size_t WS_R3 = WS_R2 + 164 * MiB;
constexpr size_t WS_QKV = WS_R3;
constexpr size_t WS_GB = WS_R3 + 54 * MiB;
constexpr size_t WS_BR = WS_R3 + 72 * MiB;
constexpr size_t WS_MERGED = WS_R3;
constexpr size_t WS_Y = WS_R3 + 72 * MiB;
constexpr size_t WS_HID = WS_R3;
constexpr size_t WS_MO = WS_R3 + 40 * MiB;
constexpr size_t WS_END = WS_R3 + 144 * MiB;
static_assert(WS_END <= 405 * MiB, "workspace map");
constexpr int CW_BAR = 4096;
constexpr int CW_MOE = 16384;

constexpr int RING_BYTES = 131072;
constexpr int LDSCTL_OFF = RING_BYTES, MISC_OFF = LDSCTL_OFF + 320;
constexpr int LDS_BYTES = 147456;

#define LDS_WAIT() asm volatile("s_waitcnt lgkmcnt(0)" ::: "memory")
#define VM_WAIT() asm volatile("s_waitcnt vmcnt(0)" ::: "memory")
__device__ __forceinline__ unsigned f2bf(float f) { unsigned u = __builtin_bit_cast(unsigned, f); return (u + 0x7fffu + ((u >> 16) & 1u)) >> 16; }
__device__ __forceinline__ unsigned pk2(float lo, float hi) { return f2bf(lo) | (f2bf(hi) << 16); }
__device__ __forceinline__ float bflo(unsigned w) { return __builtin_bit_cast(float, w << 16); }
__device__ __forceinline__ float bfhi(unsigned w) { return __builtin_bit_cast(float, w & 0xffff0000u); }
__device__ __forceinline__ float bf1(bf16 b) { return __builtin_bit_cast(float, ((unsigned)b) << 16); }
__device__ __forceinline__ void unpack8(const v4u w, float (&o)[8]) { o[0] = bflo(w.x); o[1] = bfhi(w.x); o[2] = bflo(w.y); o[3] = bfhi(w.y); o[4] = bflo(w.z); o[5] = bfhi(w.z); o[6] = bflo(w.w); o[7] = bfhi(w.w); }
__device__ __forceinline__ v4u pack8(const float (&o)[8]) { v4u w; w.x = pk2(o[0], o[1]); w.y = pk2(o[2], o[3]); w.z = pk2(o[4], o[5]); w.w = pk2(o[6], o[7]); return w; }
__device__ __forceinline__ float sigmoidf_(float x) { return 1.0f / (1.0f + __expf(-x)); }
__device__ __forceinline__ float siluf_(float x) { return x / (1.0f + __expf(-x)); }
__device__ __forceinline__ float gelu_tanh(float x) { const float u = 0.7978845608028654f * (x + 0.044715f * x * x * x); return x / (1.0f + __expf(-2.0f * u)); }
__device__ __forceinline__ float wave_sum(float v) {
#pragma unroll
    for (int o = 1; o < 64; o <<= 1) v += __shfl_xor(v, o);
    return v;
}
__device__ __forceinline__ float g16_sum(float v) {
#pragma unroll
    for (int o = 1; o < 16; o <<= 1) v += __shfl_xor(v, o);
    return v;
}

namespace pg8 {
constexpr int BM = 256, BK = 64, HALF = 128, HTB = HALF * BK * 2, STAGE_BYTES = 8 * HTB;
__host__ __device__ __forceinline__ int lds_byte(int r, int c) { const int st = (r >> 4) * 2 + (c >> 5), rr = r & 15, cc = c & 31, ob = rr * 64 + cc * 2; return st * 1024 + (ob ^ (((ob >> 9) & 1) << 5)); }
__host__ __device__ __forceinline__ void stage_rc(int b, int& R, int& C) { const int st = b / 1024, sb = b % 1024, swz = sb ^ (((sb >> 9) & 1) << 5); R = (st >> 1) * 16 + swz / 64; C = (st & 1) * 32 + (swz % 64) / 2; }
__host__ __device__ __forceinline__ int perm32(int rho) { const int n = rho >> 4, i = rho & 15; return 8 * (i >> 2) + 4 * n + (i & 3); }

struct Unit { int pm, pn, aux; const char* a; const char* b; };
struct Gemm { int K, lda, ldb; };

__device__ __forceinline__ void map_tile(int L, int nM, int nN, int& pm, int& pn) {
    const int nwg = nM * nN; int wgid = L; { const int q = nwg / 8, r = nwg % 8, xcd = wgid % 8, off = wgid / 8; wgid = (xcd < r ? xcd * (q + 1) : r * (q + 1) + (xcd - r) * q) + off; }
    const int nig = 8 * nN, gid = wgid / nig, fm = gid * 8, gsz = (nM - fm) < 8 ? (nM - fm) : 8;
    pm = fm + ((wgid % nig) % gsz); pn = (wgid % nig) / gsz;
}
__device__ __forceinline__ unsigned cvt_pk_bf16(float lo, float hi) { unsigned r; asm volatile("v_cvt_pk_bf16_f32 %0, %1, %2" : "=v"(r) : "v"(lo), "v"(hi)); return r; }

template <class Epi, class Sched, bool ALIGN_EPI, bool SP2>
__device__ __forceinline__ void gemm_phase(LAS unsigned char* lds, const Gemm g, const Sched& S, const Epi& E) {
    int tid_l = threadIdx.x; asm volatile("" : "+v"(tid_l));
    const int tid = tid_l, wid = __builtin_amdgcn_readfirstlane(tid >> 6), lane = tid & 63, wr = wid >> 2, wc = wid & 3, fr = lane & 15, fq = lane >> 4;
    const int K = g.K, nt = K / BK;
    unsigned voffA[2], voffB[2];
#pragma unroll
    for (int i = 0; i < 2; ++i) { int R, C; stage_rc(tid * 16 + i * 8192, R, C); const int Rb = Epi::PERM ? ((R & ~31) + perm32(R & 31)) : R;
        voffA[i] = (unsigned)(R * g.lda + C) * 2u; voffB[i] = (unsigned)(Rb * g.ldb + C) * 2u; }
    const size_t kstep = (size_t)(BK * 2);
    const size_t hstepA = (size_t)HALF * g.lda * 2, hstepB = (size_t)HALF * g.ldb * 2;
    const unsigned ldsw = (unsigned)wid * 1024u;
    const int aoff = lds_byte(wr * 64 + fr, fq * 8), boff = lds_byte(wc * 32 + fr, fq * 8);
#define PG8_SA(b, h) (((b) * 2 + (h)) * HTB)
#define PG8_SB(b, h) ((4 + (b) * 2 + (h)) * HTB)
#define PG8_STAGE(bufoff, gbase, voff) do { _Pragma("unroll") for (int _i = 0; _i < 2; ++_i) \
        __builtin_amdgcn_global_load_lds((const unsigned*)((const char*)(gbase) + (voff)[_i]), (LAS unsigned*)(lds + (bufoff) + ldsw + _i * 8192), 16, 0, 0); } while (0)
#define PG8_LDA(dst, b, h) do { _Pragma("unroll") for (int m = 0; m < 4; ++m) _Pragma("unroll") for (int k = 0; k < 2; ++k) dst[m][k] = *(const LAS bf16x8*)(lds + PG8_SA(b, h) + aoff + m * 2048 + k * 1024); } while (0)
#define PG8_LDB(dst, b, h) do { _Pragma("unroll") for (int n = 0; n < 2; ++n) _Pragma("unroll") for (int k = 0; k < 2; ++k) dst[n][k] = *(const LAS bf16x8*)(lds + PG8_SB(b, h) + boff + n * 2048 + k * 1024); } while (0)
#define PG8_MMA(ai, bj, At, Bt) do { __builtin_amdgcn_s_setprio(1); _Pragma("unroll") for (int m = 0; m < 4; ++m) _Pragma("unroll") for (int n = 0; n < 2; ++n) _Pragma("unroll") for (int k = 0; k < 2; ++k) \
        acc[ai][bj][m][n] = __builtin_amdgcn_mfma_f32_16x16x32_bf16(Bt[n][k], At[m][k], acc[ai][bj][m][n], 0, 0, 0); __builtin_amdgcn_s_setprio(0); } while (0)
#define PG8_WAIT_V(n) asm volatile("s_waitcnt vmcnt(" #n ")" ::: "memory")
#define PG8_WAIT_L(n) asm volatile("s_waitcnt lgkmcnt(" #n ")" ::: "memory")
#define PG8_BAR __builtin_amdgcn_s_barrier()
#define PG8_SCHED __builtin_amdgcn_sched_barrier(0)
    Unit cur, nxt; int ui = 0;
    if (!S.next(0, cur)) return;
    f32x4 acc[2][2][4][2];
#pragma unroll
    for (int a = 0; a < 2; ++a)
#pragma unroll
        for (int b = 0; b < 2; ++b)
#pragma unroll
            for (int m = 0; m < 4; ++m)
#pragma unroll
                for (int n = 0; n < 2; ++n) acc[a][b][m][n] = (f32x4){0.f, 0.f, 0.f, 0.f};
    bf16x8 At[4][2], B0[2][2], B1[2][2];
    const char* cA = cur.a; const char* cB = cur.b;
    if constexpr (SP2) {
        PG8_STAGE(PG8_SB(0, 0), cB, voffB); PG8_STAGE(PG8_SB(0, 1), cB + hstepB, voffB); PG8_STAGE(PG8_SA(0, 0), cA, voffA); PG8_STAGE(PG8_SA(0, 1), cA + hstepA, voffA);
        if (wr == 1) PG8_BAR;
        PG8_WAIT_V(2); PG8_BAR;
        PG8_STAGE(PG8_SB(1, 0), cB + kstep, voffB); PG8_STAGE(PG8_SA(1, 0), cA + kstep, voffA); PG8_STAGE(PG8_SB(1, 1), cB + hstepB + kstep, voffB);
        PG8_WAIT_V(6); PG8_BAR;
    } else {
        PG8_STAGE(PG8_SB(0, 0), cB, voffB); PG8_STAGE(PG8_SA(0, 0), cA, voffA); PG8_STAGE(PG8_SB(0, 1), cB + hstepB, voffB); PG8_STAGE(PG8_SA(0, 1), cA + hstepA, voffA);
        if (wr == 1) PG8_BAR;
        PG8_WAIT_V(4); PG8_BAR;
        PG8_STAGE(PG8_SB(1, 0), cB + kstep, voffB); PG8_STAGE(PG8_SA(1, 0), cA + kstep, voffA); PG8_STAGE(PG8_SB(1, 1), cB + hstepB + kstep, voffB);
        PG8_WAIT_V(6); PG8_BAR;
    }
    for (;;) {
        const bool has_next = S.next(ui + 1, nxt);
        const char* nA = has_next ? nxt.a : cA; const char* nB = has_next ? nxt.b : cB;
        for (int t = 0; t < nt; t += 2) {
            const bool last = (t == nt - 2);
            const char* a1 = cA + (size_t)(t + 1) * kstep;
            const char* a2 = last ? nA : cA + (size_t)(t + 2) * kstep; const char* b2 = last ? nB : cB + (size_t)(t + 2) * kstep;
            const char* a3 = a2 + kstep; const char* b3 = b2 + kstep;
            if constexpr (SP2) {
            PG8_LDB(B0, 0, 0); PG8_LDB(B1, 0, 1); PG8_SCHED; PG8_LDA(At, 0, 0); PG8_STAGE(PG8_SA(1, 1), a1 + hstepA, voffA);
            PG8_WAIT_V(8); PG8_WAIT_L(0); PG8_BAR; PG8_MMA(0, 0, At, B0); PG8_MMA(0, 1, At, B1); PG8_BAR; PG8_SCHED;
            PG8_LDA(At, 0, 1); PG8_STAGE(PG8_SB(0, 0), b2, voffB); PG8_STAGE(PG8_SB(0, 1), b2 + hstepB, voffB); PG8_STAGE(PG8_SA(0, 0), a2, voffA);
            PG8_WAIT_V(8); PG8_WAIT_L(0); PG8_BAR; PG8_MMA(1, 0, At, B0); PG8_MMA(1, 1, At, B1); PG8_BAR; PG8_SCHED;
            PG8_LDB(B0, 1, 0); PG8_LDB(B1, 1, 1); PG8_SCHED; PG8_LDA(At, 1, 0); PG8_STAGE(PG8_SA(0, 1), a2 + hstepA, voffA);
            PG8_WAIT_V(8); PG8_WAIT_L(0); PG8_BAR; PG8_MMA(0, 0, At, B0); PG8_MMA(0, 1, At, B1); PG8_BAR; PG8_SCHED;
            PG8_LDA(At, 1, 1); PG8_STAGE(PG8_SB(1, 0), b3, voffB); PG8_STAGE(PG8_SB(1, 1), b3 + hstepB, voffB); PG8_STAGE(PG8_SA(1, 0), a3, voffA);
            PG8_WAIT_V(8); PG8_WAIT_L(0); PG8_BAR; PG8_MMA(1, 0, At, B0); PG8_MMA(1, 1, At, B1); PG8_BAR; PG8_SCHED;
            } else {
            PG8_LDB(B0, 0, 0); PG8_SCHED; PG8_LDA(At, 0, 0); PG8_STAGE(PG8_SA(1, 1), a1 + hstepA, voffA);
            PG8_WAIT_L(8); PG8_BAR; PG8_WAIT_L(0); PG8_MMA(0, 0, At, B0); PG8_BAR; PG8_SCHED;
            PG8_LDB(B1, 0, 1); PG8_STAGE(PG8_SB(0, 0), b2, voffB);
            PG8_BAR; PG8_WAIT_L(0); PG8_MMA(0, 1, At, B1); PG8_BAR;
            PG8_LDA(At, 0, 1); PG8_STAGE(PG8_SA(0, 0), a2, voffA);
            PG8_BAR; PG8_WAIT_L(0); PG8_MMA(1, 0, At, B0); PG8_BAR; PG8_SCHED;
            PG8_STAGE(PG8_SB(0, 1), b2 + hstepB, voffB);
            PG8_WAIT_V(6); PG8_BAR; PG8_MMA(1, 1, At, B1); PG8_BAR;
            PG8_LDB(B0, 1, 0); PG8_SCHED; PG8_LDA(At, 1, 0); PG8_STAGE(PG8_SA(0, 1), a2 + hstepA, voffA);
            PG8_WAIT_L(8); PG8_BAR; PG8_WAIT_L(0); PG8_MMA(0, 0, At, B0); PG8_BAR; PG8_SCHED;
            PG8_LDB(B1, 1, 1); PG8_STAGE(PG8_SB(1, 0), b3, voffB);
            PG8_BAR; PG8_WAIT_L(0); PG8_MMA(0, 1, At, B1); PG8_BAR;
            PG8_LDA(At, 1, 1); PG8_STAGE(PG8_SA(1, 0), a3, voffA);
            PG8_BAR; PG8_WAIT_L(0); PG8_MMA(1, 0, At, B0); PG8_BAR; PG8_SCHED;
            PG8_STAGE(PG8_SB(1, 1), b3 + hstepB, voffB);
            PG8_WAIT_V(6); PG8_BAR; PG8_MMA(1, 1, At, B1); PG8_BAR;
            }
        }
        if constexpr (ALIGN_EPI) { if (wr == 0) PG8_BAR; }
        E(acc, cur, wr, wc, fr, fq);
        if (!has_next) break;
#pragma unroll
        for (int a = 0; a < 2; ++a)
#pragma unroll
            for (int b = 0; b < 2; ++b)
#pragma unroll
                for (int m = 0; m < 4; ++m)
#pragma unroll
                    for (int n = 0; n < 2; ++n) acc[a][b][m][n] = (f32x4){0.f, 0.f, 0.f, 0.f};
        cur = nxt; cA = nA; cB = nB; ++ui;
        if constexpr (ALIGN_EPI) { if (wr == 1) PG8_BAR; }
    }
    PG8_WAIT_V(0);
    if constexpr (!ALIGN_EPI) { if (wr == 0) PG8_BAR; }
    PG8_BAR;
#undef PG8_SA
#undef PG8_SB
#undef PG8_STAGE
#undef PG8_LDA
#undef PG8_LDB
#undef PG8_MMA
#undef PG8_WAIT_V
#undef PG8_WAIT_L
#undef PG8_BAR
#undef PG8_SCHED
}
}
using pg8::Unit;
using pg8::Gemm;
typedef f32x4 AccT[2][2][4][2];

#define XB_TMO      128
#define XB_XCNT(j)  (256  + 64 * (j))
#define XB_XSUB(j)  (1280 + 64 * (j))
#define XB_XGEN(j)  (2304 + 64 * (j))
#define XB_TOP      3328
#define XB_TOPGEN   3392
#define XCD_BAR_WORDS 3456
#define XB_SPIN_CAP (1u << 18)
__device__ __forceinline__ unsigned xb_ld(unsigned* p)              { return __hip_atomic_load(p, __ATOMIC_RELAXED, __HIP_MEMORY_SCOPE_AGENT); }
__device__ __forceinline__ unsigned xb_add(unsigned* p, unsigned v) { return __hip_atomic_fetch_add(p, v, __ATOMIC_RELAXED, __HIP_MEMORY_SCOPE_AGENT); }
__device__ __forceinline__ unsigned xb_xcc_id() { return (unsigned)__builtin_amdgcn_s_getreg((3 << 11) | 20) & 0xFu; }
#define XB_SPIN(cond, bar) do { unsigned _sp = 0; while (cond) { __builtin_amdgcn_s_sleep(1); \
    if ((++_sp & 255u) == 0u) { if (xb_ld(&(bar)[XB_TMO])) break; if (_sp > XB_SPIN_CAP) { atomicAdd(&(bar)[XB_TMO], 1u); break; } } } } while (0)
struct XcdBarrier { unsigned* bar; unsigned x; volatile LAS unsigned* st; };
__device__ __forceinline__ XcdBarrier xcd_barrier_post(unsigned* bar, volatile LAS unsigned* st) {
    XcdBarrier b; b.bar = bar; b.x = xb_xcc_id(); b.st = st;
    if (threadIdx.x == 0) (void)xb_add(&bar[XB_XCNT(b.x)], 1u);
    return b;
}
__device__ __forceinline__ void xcd_barrier_complete(unsigned* bar, unsigned x, unsigned& nloc, unsigned& nx) {
    const unsigned G = gridDim.x * gridDim.y * gridDim.z;
    unsigned sum, cnt, mine, sp = 0u;
    for (;;) {
        sum = 0u; cnt = 0u; mine = 0u;
#pragma unroll
        for (unsigned j = 0; j < 16; ++j) { const unsigned c = xb_ld(&bar[XB_XCNT(j)]); sum += c; cnt += (c > 0u) ? 1u : 0u; mine = (j == x) ? c : mine; }
        if (sum == G) break;
        __builtin_amdgcn_s_sleep(1);
        if ((++sp & 255u) == 0u) { if (xb_ld(&bar[XB_TMO])) break; if (sp > XB_SPIN_CAP) { atomicAdd(&bar[XB_TMO], 1u); break; } }
    }
    nloc = mine > 0u ? mine : 1u; nx = cnt > 0u ? cnt : 1u;
}
__device__ __forceinline__ void xcd_barrier(const XcdBarrier& b) {
    asm volatile("s_waitcnt vmcnt(0)" ::: "memory");
    __syncthreads();
    if (threadIdx.x == 0) {
        unsigned* bar = b.bar;
        __builtin_amdgcn_s_waitcnt(0);
        unsigned nloc = b.st[0], nx = b.st[1];
        if (nloc == 0u) { xcd_barrier_complete(bar, b.x, nloc, nx); b.st[0] = nloc; b.st[1] = nx; }
        const unsigned old = xb_add(&bar[XB_XSUB(b.x)], 1u);
        const unsigned gen = old / nloc;
        if (old + 1u == (gen + 1u) * nloc) {
            __builtin_amdgcn_fence(__ATOMIC_RELEASE, "agent");
            asm volatile("s_waitcnt vmcnt(0)" ::: "memory");
            const unsigned og = xb_add(&bar[XB_TOP], 1u);
            const unsigned tg = og / nx;
            if (og + 1u == (tg + 1u) * nx) xb_add(&bar[XB_TOPGEN], 1u);
            else XB_SPIN(xb_ld(&bar[XB_TOPGEN]) == tg, bar);
            __builtin_amdgcn_fence(__ATOMIC_ACQUIRE, "agent");
            xb_add(&bar[XB_XGEN(b.x)], 1u);
            asm volatile("s_waitcnt vmcnt(0)" ::: "memory");
        } else {
            XB_SPIN(xb_ld(&bar[XB_XGEN(b.x)]) == gen, bar);
            __builtin_amdgcn_fence(__ATOMIC_ACQUIRE, "agent");
            asm volatile("s_waitcnt vmcnt(0)" ::: "memory");
        }
    }
    __syncthreads();
}

struct Args { const float* in[34]; float* out; unsigned char* ws; int ph_lo, ph_hi; };
enum { I_X = 0, I_C, I_CTX, I_CCTX, I_WMOD, I_BMOD, I_WIN, I_BIN, I_GCONV, I_GALOG, I_GDT, I_GNORM, I_CDWW, I_CDWB, I_CLNG, I_CLNB, I_SLNG, I_SLNB, I_SWS, I_SBS,
       I_WBR, I_WOUT, I_BOUT, I_LN1G, I_LN1B, I_LN2G, I_LN2B, I_RGW, I_RGB, I_REW, I_REB, I_EWG, I_EWU, I_EWD };

struct SchedInA {
    int G, c; const char* xn; const char* w;
    __device__ __forceinline__ bool next(int i, Unit& u) const {
        const int L = i * G + c; const size_t tstep = (size_t)256 * 1024 * 2;
        if (L < 1152) { int pm, pn; pg8::map_tile(L, 72, 16, pm, pn); u.pm = pm; u.pn = pn; u.aux = 0; u.a = xn + (size_t)pm * tstep; u.b = w + (size_t)pn * tstep; return true; }
        if (L < 1440) { const int q = L - 1152, pm = 16 + (q & 3), pn = q >> 2; u.pm = pm; u.pn = pn; u.aux = 1; u.a = w + (size_t)pm * tstep; u.b = xn + (size_t)pn * tstep; return true; }
        return false;
    }
};
struct SchedGrid {
    int G, c, nM, nN; const char* a0; const char* b0; size_t astep, bstep;
    __device__ __forceinline__ bool next(int i, Unit& u) const {
        const int L = i * G + c; if (L >= nM * nN) return false;
        int pm, pn; pg8::map_tile(L, nM, nN, pm, pn); u.pm = pm; u.pn = pn; u.aux = 0; u.a = a0 + (size_t)pm * astep; u.b = b0 + (size_t)pn * bstep; return true;
    }
};
struct SchedFftLat {
    int G, c; const char* dft; const char* pf;
    __device__ __forceinline__ bool next(int i, Unit& u) const {
        const int L = i * G + c; if (L >= 128) return false;
        const int b = L >> 4, kt = (L >> 1) & 7, pn = L & 1;
        u.pm = b * 8 + kt; u.pn = pn; u.aux = 0; u.a = dft + (size_t)kt * (256 * 4096 * 2); u.b = pf + (size_t)b * (512 * 4096 * 2) + (size_t)pn * (256 * 4096 * 2); return true;
    }
};
struct SchedFftCtx {
    int G, c; const char* dft; const char* pf;
    __device__ __forceinline__ bool next(int i, Unit& u) const {
        const int L = i * G + (G - 1 - c); if (L >= 16) return false;
        const int b = L >> 1, pn = L & 1;
        u.pm = 64 + b; u.pn = pn; u.aux = 0; u.a = dft; u.b = pf + (size_t)b * (512 * 512 * 2) + (size_t)pn * (256 * 512 * 2); return true;
    }
};
struct SchedBranch {
    int G, c, nM; const char* br; const char* wbr;
    __device__ __forceinline__ bool next(int j, Unit& u) const {
        const int L = (j >> 2) * G + c; if (L >= nM * 4) return false;
        int pm, pn; pg8::map_tile(L, nM, 4, pm, pn); const int i = j & 3;
        u.pm = pm; u.pn = pn; u.aux = i; u.a = br + (size_t)i * ((size_t)NTOK * 512 * 2) + (size_t)pm * (256 * 512 * 2); u.b = wbr + (size_t)i * (1024 * 512 * 2) + (size_t)pn * (256 * 512 * 2); return true;
    }
};
struct SchedMoe {
    int G, c; unsigned pre[17]; const char* a0; const char* w0; size_t astep, wstep_e, wstep_n;
    __device__ __forceinline__ void init(const unsigned* cnt  ) {
        unsigned s = 0;
#pragma unroll
        for (int e = 0; e < 16; ++e) { pre[e] = s; s += ((unsigned)__builtin_amdgcn_readfirstlane((int)__hip_atomic_load(cnt + 64 * e, __ATOMIC_RELAXED, __HIP_MEMORY_SCOPE_AGENT)) + 255u) >> 8; }
        pre[16] = s;
    }
    __device__ __forceinline__ bool next(int i, Unit& u) const {
        const int L = i * G + c; if (L >= (int)pre[16] * 4) return false;
        const int jt = L >> 2, pn = L & 3; int e = 0;
#pragma unroll
        for (int k = 1; k < 16; ++k) e += ((unsigned)jt >= pre[k]) ? 1 : 0;
        u.pm = jt; u.pn = pn; u.aux = e; u.a = a0 + (size_t)jt * astep; u.b = w0 + (size_t)e * wstep_e + (size_t)pn * wstep_n; return true;
    }
};

struct EpiInA {
    static constexpr bool PERM = true;
    bf16 *pqkv, *pz, *pconf, *psgu, *pfft, *pfftc; const float* bias;
    __device__ __forceinline__ void operator()(const AccT& acc, const Unit& u, int wr, int wc, int fr, int fq) const {
        if (u.aux == 0) {
            const int row0 = u.pm * 256 + wr * 64 + fr, cb = wc * 32 + 8 * fq, bcol0 = u.pn * 256 + cb;
            f32x4 bv[2][2];
#pragma unroll
            for (int bj = 0; bj < 2; ++bj)
#pragma unroll
                for (int n = 0; n < 2; ++n) bv[bj][n] = *(const f32x4*)(bias + bcol0 + bj * 128 + 4 * n);
            if (u.pn < 8) {
                const bool isz = u.pn >= 6;
#pragma unroll
                for (int ai = 0; ai < 2; ++ai)
#pragma unroll
                    for (int m = 0; m < 4; ++m) { const int row = row0 + ai * 128 + m * 16;
                        bf16* rowp = isz ? (pz + (size_t)row * 512 + (u.pn - 6) * 256 + cb) : (pqkv + (size_t)row * 1536 + u.pn * 256 + cb);
#pragma unroll
                        for (int bj = 0; bj < 2; ++bj) { f32x4 v0 = acc[ai][bj][m][0] + bv[bj][0], v1 = acc[ai][bj][m][1] + bv[bj][1];
                            if (isz) {
#pragma unroll
                                for (int j = 0; j < 4; ++j) { v0[j] = siluf_(v0[j]); v1[j] = siluf_(v1[j]); } }
                            v4u w; w.x = pk2(v0[0], v0[1]); w.y = pk2(v0[2], v0[3]); w.z = pk2(v1[0], v1[1]); w.w = pk2(v1[2], v1[3]);
                            *(v4u*)(rowp + bj * 128) = w; } }
            } else if (u.pn < 12) {
#pragma unroll
                for (int ai = 0; ai < 2; ++ai)
#pragma unroll
                    for (int m = 0; m < 4; ++m) { const int row = row0 + ai * 128 + m * 16;
                        const f32x4 a0 = acc[ai][0][m][0] + bv[0][0], a1 = acc[ai][0][m][1] + bv[0][1], g0 = acc[ai][1][m][0] + bv[1][0], g1 = acc[ai][1][m][1] + bv[1][1];
                        float o[8];
#pragma unroll
                        for (int j = 0; j < 4; ++j) { o[j] = a0[j] * sigmoidf_(g0[j]); o[4 + j] = a1[j] * sigmoidf_(g1[j]); }
                        *(v4u*)(pconf + (size_t)row * 512 + (u.pn - 8) * 128 + cb) = pack8(o); }
            } else {
#pragma unroll
                for (int ai = 0; ai < 2; ++ai)
#pragma unroll
                    for (int m = 0; m < 4; ++m) { const int row = row0 + ai * 128 + m * 16;
                        bf16* rowp = psgu + (size_t)row * 1024 + (u.pn - 12) * 256 + cb;
#pragma unroll
                        for (int bj = 0; bj < 2; ++bj) { f32x4 v0 = acc[ai][bj][m][0] + bv[bj][0], v1 = acc[ai][bj][m][1] + bv[bj][1];
#pragma unroll
                            for (int j = 0; j < 4; ++j) { v0[j] = gelu_tanh(v0[j]); v1[j] = gelu_tanh(v1[j]); }
                            v4u w; w.x = pk2(v0[0], v0[1]); w.y = pk2(v0[2], v0[3]); w.z = pk2(v1[0], v1[1]); w.w = pk2(v1[2], v1[3]);
                            *(v4u*)(rowp + bj * 128) = w; } }
            }
        } else {
            const int jrow0 = (u.pm - 16) * 256 + wr * 64 + fr, tok0 = u.pn * 256 + wc * 32 + 8 * fq;
#pragma unroll
            for (int ai = 0; ai < 2; ++ai)
#pragma unroll
                for (int m = 0; m < 4; ++m) { const int jrow = jrow0 + ai * 128 + m * 16; const float bb = bias[4096 + jrow]; const int cs = jrow >> 9, rr = jrow & 511;
#pragma unroll
                    for (int bj = 0; bj < 2; ++bj) { const int tok = tok0 + bj * 128; bf16* dst;
                        if (tok < NLAT) { const int b = tok >> 11, t = tok & 2047; dst = pfft + ((size_t)(b * 512 + rr)) * 4096 + cs * 2048 + t; }
                        else { const int tc = tok - NLAT, b = tc >> 8, t = tc & 255; dst = pfftc + ((size_t)(b * 512 + rr)) * 512 + cs * 256 + t; }
                        const f32x4 v0 = acc[ai][bj][m][0] + bb, v1 = acc[ai][bj][m][1] + bb;
                        v4u w; w.x = pk2(v0[0], v0[1]); w.y = pk2(v0[2], v0[3]); w.z = pk2(v1[0], v1[1]); w.w = pk2(v1[2], v1[3]);
                        *(v4u*)dst = w; } }
        }
    }
};
template <int ACT  > struct EpiBf16 {
    static constexpr bool PERM = true;
    bf16* O; int ldc; const float* bias;
    __device__ __forceinline__ void operator()(const AccT& acc, const Unit& u, int wr, int wc, int fr, int fq) const {
        const int row0 = u.pm * 256 + wr * 64 + fr, col0 = u.pn * 256 + wc * 32 + 8 * fq;
        f32x4 bv[2][2];
#pragma unroll
        for (int bj = 0; bj < 2; ++bj)
#pragma unroll
            for (int n = 0; n < 2; ++n) bv[bj][n] = bias ? *(const f32x4*)(bias + col0 + bj * 128 + 4 * n) : (f32x4){0.f, 0.f, 0.f, 0.f};
#pragma unroll
        for (int ai = 0; ai < 2; ++ai)
#pragma unroll
            for (int m = 0; m < 4; ++m) { bf16* rowp = O + (size_t)(row0 + ai * 128 + m * 16) * ldc + col0;
#pragma unroll
                for (int bj = 0; bj < 2; ++bj) { f32x4 v0 = acc[ai][bj][m][0] + bv[bj][0], v1 = acc[ai][bj][m][1] + bv[bj][1];
                    if (ACT == 1) {
#pragma unroll
                        for (int j = 0; j < 4; ++j) { v0[j] = sigmoidf_(v0[j]); v1[j] = sigmoidf_(v1[j]); } }
                    v4u w; w.x = pk2(v0[0], v0[1]); w.y = pk2(v0[2], v0[3]); w.z = pk2(v1[0], v1[1]); w.w = pk2(v1[2], v1[3]);
                    *(v4u*)(rowp + bj * 128) = w; } }
    }
};
struct EpiF32 {
    static constexpr bool PERM = false;
    float* C; int ldc; const float* bias;
    __device__ __forceinline__ void operator()(const AccT& acc, const Unit& u, int wr, int wc, int fr, int fq) const {
        const int row0 = u.pm * 256 + wr * 64 + fr, col0 = u.pn * 256 + wc * 32 + 4 * fq;
        f32x4 bv[2][2];
#pragma unroll
        for (int bj = 0; bj < 2; ++bj)
#pragma unroll
            for (int n = 0; n < 2; ++n) bv[bj][n] = *(const f32x4*)(bias + col0 + bj * 128 + n * 16);
#pragma unroll
        for (int ai = 0; ai < 2; ++ai)
#pragma unroll
            for (int m = 0; m < 4; ++m) { float* rowp = C + (size_t)(row0 + ai * 128 + m * 16) * ldc + col0;
#pragma unroll
                for (int bj = 0; bj < 2; ++bj)
#pragma unroll
                    for (int n = 0; n < 2; ++n) *(f32x4*)(rowp + bj * 128 + n * 16) = acc[ai][bj][m][n] + bv[bj][n]; }
    }
};
struct EpiBranch {
    static constexpr bool PERM = false;
    float* merged; bf16* mbf; const bf16* gates;
    __device__ __forceinline__ void operator()(const AccT& acc, const Unit& u, int wr, int wc, int fr, int fq) const {
        const int row0 = u.pm * 256 + wr * 64 + fr, col0 = u.pn * 256 + wc * 32 + 4 * fq, i = u.aux;
#pragma unroll
        for (int ai = 0; ai < 2; ++ai)
#pragma unroll
            for (int m = 0; m < 4; ++m) { const size_t row = (size_t)(row0 + ai * 128 + m * 16);
#pragma unroll
                for (int bj = 0; bj < 2; ++bj)
#pragma unroll
                    for (int n = 0; n < 2; ++n) { const int col = col0 + bj * 128 + n * 16;
                        const v2u gw = *(const v2u*)(gates + row * 4096 + i * 1024 + col);
                        f32x4 v = acc[ai][bj][m][n]; v[0] *= bflo(gw.x); v[1] *= bfhi(gw.x); v[2] *= bflo(gw.y); v[3] *= bfhi(gw.y);
                        float* mp = merged + row * 1024 + col;
                        if (i > 0) v += *(const f32x4*)mp;
                        if (i < 3) *(f32x4*)mp = v;
                        else { v2u w; w.x = pk2(v[0], v[1]); w.y = pk2(v[2], v[3]); *(v2u*)(mbf + row * 1024 + col) = w; } } }
    }
};
struct EpiMoe1 {
    static constexpr bool PERM = true;
    bf16* hid;
    __device__ __forceinline__ void operator()(const AccT& acc, const Unit& u, int wr, int wc, int fr, int fq) const {
        const int row0 = u.pm * 256 + wr * 64 + fr, cb = wc * 32 + 8 * fq;
#pragma unroll
        for (int ai = 0; ai < 2; ++ai)
#pragma unroll
            for (int m = 0; m < 4; ++m) { const int row = row0 + ai * 128 + m * 16;
                const f32x4 g0 = acc[ai][0][m][0], g1 = acc[ai][0][m][1], u0 = acc[ai][1][m][0], u1 = acc[ai][1][m][1];
                float o[8];
#pragma unroll
                for (int j = 0; j < 4; ++j) { o[j] = siluf_(g0[j]) * u0[j]; o[4 + j] = siluf_(g1[j]) * u1[j]; }
                *(v4u*)(hid + (size_t)row * 512 + u.pn * 128 + cb) = pack8(o); }
    }
};

struct Ctx {
    LAS unsigned char* lds; int tid, lane, wave, G, bid;
};

__device__ __forceinline__ void cvt_tile(const Ctx& X, const float* src, int ld, int k0, bf16* dst, int Kp) {
    LAS float* tile = (LAS float*)X.lds;
#pragma unroll
    for (int i = 0; i < 8; ++i) { const int kk = (X.tid >> 6) + 8 * i, nn = X.tid & 63; tile[kk * 65 + nn] = src[(size_t)(k0 + kk) * ld + nn]; }
    __syncthreads();
    { const int n = X.tid >> 3, kc = X.tid & 7; float o[8];
#pragma unroll
      for (int j = 0; j < 8; ++j) o[j] = tile[(8 * kc + j) * 65 + n];
      *(v4u*)(dst + (size_t)n * Kp + k0 + 8 * kc) = pack8(o); }
    __syncthreads();
}

__device__ __forceinline__ void ln_rows(f32x4 (&v)[4]) {
    float s = 0.f;
#pragma unroll
    for (int j = 0; j < 4; ++j) s += (v[j][0] + v[j][1]) + (v[j][2] + v[j][3]);
    const float mean = wave_sum(s) * (1.f / D); float s2 = 0.f;
#pragma unroll
    for (int j = 0; j < 4; ++j) { v[j] = v[j] - mean; s2 += (v[j][0] * v[j][0] + v[j][1] * v[j][1]) + (v[j][2] * v[j][2] + v[j][3] * v[j][3]); }
    const float rstd = 1.0f / sqrtf(wave_sum(s2) * (1.f / D) + LN_EPS);
#pragma unroll
    for (int j = 0; j < 4; ++j) v[j] = v[j] * rstd;
}

#define PH_BEGIN() \
    int tid_l = threadIdx.x; asm volatile("" : "+v"(tid_l)); const int tid = tid_l, lane = tid & 63; \
    Ctx X; X.lds = lds; X.tid = tid; X.lane = lane; X.wave = __builtin_amdgcn_readfirstlane(tid >> 6); X.G = gridDim.x; X.bid = blockIdx.x; \
    const int gw = X.bid * NWAVES + X.wave, NGW = X.G * NWAVES; (void)gw; (void)NGW; \
    const __attribute__((address_space(4))) char* kp = (const __attribute__((address_space(4))) char*)__builtin_amdgcn_kernarg_segment_ptr(); asm volatile("" : "+s"(kp)); \
    unsigned char* const ws = *(unsigned char* const __attribute__((address_space(4)))*)(kp + 280); \
    float* const hlat = *(float* const __attribute__((address_space(4)))*)(kp + 272); (void)hlat; \
    float* const hctx = (float*)(ws + WS_HCTX); (void)hctx; \
    float* const modv = (float*)(ws + WS_MODV); (void)modv; \
    float* const binv = (float*)(ws + WS_BIN); (void)binv; \
    bf16* const XN = (bf16*)(ws + WS_XN); (void)XN; \
    bf16* const WIN = (bf16*)(ws + WS_WIN); (void)WIN; \
    bf16* const WBR = (bf16*)(ws + WS_WBR); (void)WBR; \
    bf16* const WOUT = (bf16*)(ws + WS_WOUT); (void)WOUT; \
    bf16* const DFTL = (bf16*)(ws + WS_DFTL); (void)DFTL; \
    bf16* const DFTC = (bf16*)(ws + WS_DFTC); (void)DFTC; \
    bf16* const PQKV = (bf16*)(ws + WS_PQKV); (void)PQKV; \
    bf16* const PCONF = (bf16*)(ws + WS_PCONF); (void)PCONF; \
    bf16* const PZ = (bf16*)(ws + WS_PZ); (void)PZ; \
    bf16* const PSGU = (bf16*)(ws + WS_PSGU); (void)PSGU; \
    bf16* const PFFT = (bf16*)(ws + WS_PFFT); (void)PFFT; \
    bf16* const PFFTC = (bf16*)(ws + WS_PFFTC); (void)PFFTC; \
    float* const AB = (float*)(ws + WS_AB); (void)AB; \
    float* const OF = (float*)(ws + WS_OF); (void)OF; \
    float* const OB = (float*)(ws + WS_OB); (void)OB; \
    bf16* const GT = (bf16*)(ws + WS_G); (void)GT; \
    bf16* const WGU = (bf16*)(ws + WS_WGU); (void)WGU; \
    bf16* const WDN = (bf16*)(ws + WS_WDN); (void)WDN; \
    bf16* const XG = (bf16*)(ws + WS_XG); (void)XG; \
    bf16* const QKV = (bf16*)(ws + WS_QKV); (void)QKV; \
    float* const GB = (float*)(ws + WS_GB); (void)GB; \
    bf16* const BR = (bf16*)(ws + WS_BR); (void)BR; \
    float* const MERGED = (float*)(ws + WS_MERGED); (void)MERGED; \
    float* const YB = (float*)(ws + WS_Y); (void)YB; \
    bf16* const HID = (bf16*)(ws + WS_HID); (void)HID; \
    bf16* const MO = (bf16*)(ws + WS_MO); (void)MO; \
    float* const ROUTE = (float*)(ws + WS_ROUTE); (void)ROUTE; \
    unsigned* const ctl = (unsigned*)(ws + WS_CTL); (void)ctl;
#define INP(i) (*(const float* const __attribute__((address_space(4)))*)(kp + 8 * (i)))
__global__ void __launch_bounds__(NWAVES * 64, 2) fwd(Args args) {
    extern __shared__ __attribute__((aligned(16))) unsigned char lds_raw[];
    LAS unsigned char* const lds = (LAS unsigned char*)lds_raw;
    volatile LAS unsigned* MISC = (volatile LAS unsigned*)(lds + MISC_OFF);
    for (int u = threadIdx.x; u < (LDS_BYTES - LDSCTL_OFF) / 4; u += NWAVES * 64) ((LAS unsigned*)(lds + LDSCTL_OFF))[u] = 0u;
    __syncthreads();
#if MK_ONE_LAUNCH
    XcdBarrier bar = xcd_barrier_post((unsigned*)(args.ws + WS_CTL) + CW_BAR, MISC + 8);
#define GRID_BAR() xcd_barrier(bar)
#else
#define GRID_BAR() do { } while (0)
#endif
    const int lo = args.ph_lo, hi = args.ph_hi;
#define IN(k) (lo <= (k) && (k) < hi)
#define SEAM(k) do { if (IN(k) && IN((k) + 1)) GRID_BAR(); } while (0)

    if (PH_ON(0) && IN(0)) { PH_BEGIN();
        for (int t = gw; t < SEQ; t += NGW) {
            const int prow = t >> 6, pcol = t & 63; f32x4 pe[4];
#pragma unroll
            for (int j = 0; j < 4; ++j)
#pragma unroll
                for (int e = 0; e < 4; ++e) { const int col = 4 * lane + 256 * j + e, part = col >> 9, within = col & 511, i = within & 255;
                    const float omega = 1.0f / powf(10000.0f, (float)i * (1.0f / 256.0f)); const float ang = (float)(part ? pcol : prow) * omega;
                    pe[j][e] = (within >> 8) ? cosf(ang) : sinf(ang); }
            for (int b = 0; b < NB; ++b) { const size_t off = ((size_t)b * SEQ + t) * D;
#pragma unroll
                for (int j = 0; j < 4; ++j) *(f32x4*)(hlat + off + 4 * lane + 256 * j) = *(const f32x4*)(INP(I_X) + off + 4 * lane + 256 * j) + pe[j]; }
        }
        for (int r = gw; r < NCTX; r += NGW) {
#pragma unroll
            for (int j = 0; j < 4; ++j) *(f32x4*)(hctx + (size_t)r * D + 4 * lane + 256 * j) = *(const f32x4*)(INP(I_CTX) + (size_t)r * D + 4 * lane + 256 * j);
        }
        for (int idx = X.bid * 512 + tid; idx < 2048 * 4096 / 8; idx += X.G * 512) {
            const int k = idx >> 9, j0 = (idx & 511) * 8; float o[8];
#pragma unroll
            for (int e = 0; e < 8; ++e) { const int j = j0 + e, t = j & 2047, a = (k * t) & 2047; float s, c; sincospif((float)a * (1.0f / 1024.0f), &s, &c);
                o[e] = (j < 2048 ? c : -s) * 0.022097086912079608f; }
            *(v4u*)(DFTL + (size_t)k * 4096 + j0) = pack8(o);
        }
        for (int idx = X.bid * 512 + tid; idx < 256 * 512 / 8; idx += X.G * 512) {
            const int k = idx >> 6, j0 = (idx & 63) * 8; float o[8];
#pragma unroll
            for (int e = 0; e < 8; ++e) { const int j = j0 + e, t = j & 255, a = (k * t) & 255; float s, c; sincospif((float)a * (1.0f / 128.0f), &s, &c);
                o[e] = (j < 256 ? c : -s) * 0.0625f; }
            *(v4u*)(DFTC + (size_t)k * 512 + j0) = pack8(o);
        }
        {
            LAS float* sc = (LAS float*)lds;
            LAS float* red = (LAS float*)(lds + 36864);
            for (int i = tid; i < 9 * 1024; i += 512) { const int r = i >> 10, k = i & 1023; const float c = r < 8 ? INP(I_C)[r * 1024 + k] : INP(I_CCTX)[k]; sc[i] = siluf_(c); }
            __syncthreads();
            for (int it = X.bid; it < 192; it += X.G) {
                const int l = it / 96, j = (it % 96) * 64 + lane; const float* W = INP(I_WMOD) + (size_t)l * 1024 * 6144 + j;
                float a[9];
#pragma unroll
                for (int r = 0; r < 9; ++r) a[r] = 0.f;
                const int kb = X.wave * 128;
                for (int k = 0; k < 128; ++k) { const float w = W[(size_t)(kb + k) * 6144];
#pragma unroll
                    for (int r = 0; r < 9; ++r) a[r] += sc[r * 1024 + kb + k] * w; }
#pragma unroll
                for (int r = 0; r < 9; ++r) red[(X.wave * 9 + r) * 64 + lane] = a[r];
                __syncthreads();
                for (int o = tid; o < 9 * 64; o += 512) { const int r = o >> 6, jj = o & 63; float s = 0.f;
#pragma unroll
                    for (int w = 0; w < 8; ++w) s += red[(w * 9 + r) * 64 + jj];
                    const int jc = (it % 96) * 64 + jj; modv[((size_t)l * 9 + r) * 6144 + jc] = s + INP(I_BMOD)[l * 6144 + jc]; }
                __syncthreads();
            }
        }
    }
    SEAM(0);

    for (int l = 0; l < 2; ++l) {
        const int pb = 1 + NPH_LAYER * l;
        const int nrows2 = (l == 1) ? NLAT : NTOK;
        const int npan2 = nrows2 / 256;

        if (PH_ON(1) && IN(pb + 0)) { PH_BEGIN(); const float* mv = modv + (size_t)l * 9 * 6144; (void)mv; unsigned* const moecnt = ctl + CW_MOE + l * 16 * 64; (void)moecnt;
            const float* win = INP(I_WIN) + (size_t)l * 1024 * N_IN;
            const float* bin = INP(I_BIN) + (size_t)l * N_IN;
            for (int it = X.bid; it < 144 * 16; it += X.G) {
                const int rb = it >> 4, kb = it & 15, row0 = rb * 64; int col;
                if (row0 >= 4096 && row0 < 5120) continue;
                if (row0 < 2048) col = row0;
                else if (row0 < 3072) { const int q = row0 - 2048, j = q >> 8, w = q & 255; col = OFF_CONF + (w >= 128 ? 512 : 0) + 128 * j + (w & 127); }
                else if (row0 < 4096) col = OFF_SGU + (row0 - 3072);
                else col = OFF_GATE + (row0 - 5120);
                cvt_tile(X, win + col, N_IN, kb * 64, WIN + (size_t)row0 * 1024, 1024);
            }
            for (int it = X.bid; it < 64; it += X.G) {
                const int kb = it >> 2, g = it & 3; LAS float* Wt = (LAS float*)lds; LAS float* ct = (LAS float*)(lds + 32768); LAS float* st = ct + 128;
                for (int i = tid; i < 64 * 128; i += 512) { const int kk = i >> 7, c = i & 127; Wt[i] = win[(size_t)(kb * 64 + kk) * N_IN + OFF_FFT + g * 128 + c]; }
                if (tid < 128) { float s, c; sincospif((float)tid * (1.0f / 64.0f), &s, &c); ct[tid] = c * 0.08838834764831845f; st[tid] = s * 0.08838834764831845f; }
                __syncthreads();
                const int m = tid & 127, ks = tid >> 7; float oc[16], os[16];
#pragma unroll
                for (int kk = 0; kk < 16; ++kk) { oc[kk] = 0.f; os[kk] = 0.f; }
#pragma unroll 1
                for (int c = 0; c < 128; ++c) { const int a = (m * c) & 127; const float cv = ct[a], sv = st[a];
#pragma unroll
                    for (int kk = 0; kk < 16; ++kk) { const float w = Wt[(ks * 16 + kk) * 128 + c]; oc[kk] += w * cv; os[kk] += w * sv; } }
                bf16* dc = WIN + (size_t)(4096 + g * 128 + m) * 1024 + kb * 64 + ks * 16; bf16* dsn = dc + (size_t)512 * 1024;
                { float o[8];
#pragma unroll
                  for (int h2 = 0; h2 < 2; ++h2) {
#pragma unroll
                    for (int e = 0; e < 8; ++e) o[e] = oc[h2 * 8 + e];
                    *(v4u*)(dc + h2 * 8) = pack8(o);
#pragma unroll
                    for (int e = 0; e < 8; ++e) o[e] = os[h2 * 8 + e];
                    *(v4u*)(dsn + h2 * 8) = pack8(o); } }
                __syncthreads();
            }
            for (int r = X.bid * 512 + tid; r < NWROWS; r += X.G * 512) {
                float v;
                if (r < 2048) v = bin[r];
                else if (r < 3072) { const int q = r - 2048, j = q >> 8, w = q & 255; v = bin[OFF_CONF + (w >= 128 ? 512 : 0) + 128 * j + (w & 127)]; }
                else if (r < 4096) v = bin[OFF_SGU + (r - 3072)];
                else if (r < 5120) { const int q = r - 4096, cs = q >> 9, g = (q >> 7) & 3, m = q & 127; float s = 0.f;
                    for (int c = 0; c < 128; ++c) { float sn, cn; sincospif((float)((m * c) & 127) * (1.0f / 64.0f), &sn, &cn); s += bin[OFF_FFT + g * 128 + c] * (cs ? sn : cn); }
                    v = s * 0.08838834764831845f; }
                else v = bin[OFF_GATE + (r - 5120)];
                binv[r] = v;
            }
            for (int it = X.bid; it < 4 * 16 * 8; it += X.G) { const int i = it >> 7, nb = (it >> 3) & 15, kb = it & 7;
                cvt_tile(X, INP(I_WBR) + ((size_t)(l * 4 + i) * 512) * 1024 + nb * 64, 1024, kb * 64, WBR + ((size_t)i * 1024 + nb * 64) * 512, 512); }
            for (int it = X.bid; it < 16 * 16; it += X.G) { const int nb = it >> 4, kb = it & 15;
                cvt_tile(X, INP(I_WOUT) + (size_t)l * 1024 * 1024 + nb * 64, 1024, kb * 64, WOUT + (size_t)nb * 64 * 1024, 1024); }
            LAS float* wab = (LAS float*)lds;
            __syncthreads();
            for (int i = tid; i < 16 * 1024; i += 512) { const int o = i >> 10, k = i & 1023; wab[i] = win[(size_t)k * N_IN + OFF_A + o]; }
            __syncthreads();
            for (int row = gw; row < NTOK; row += NGW) {
                const float* hrow = row < NLAT ? hlat + (size_t)row * D : hctx + (size_t)(row - NLAT) * D;
                const int mi = row < NLAT ? (row >> 11) : 8; const float* shift = mv + mi * 6144, *scale = shift + 1024;
                f32x4 v[4];
#pragma unroll
                for (int j = 0; j < 4; ++j) v[j] = *(const f32x4*)(hrow + 4 * lane + 256 * j);
                ln_rows(v);
#pragma unroll
                for (int j = 0; j < 4; ++j) { const f32x4 sc = *(const f32x4*)(scale + 4 * lane + 256 * j), sh = *(const f32x4*)(shift + 4 * lane + 256 * j); v[j] = v[j] * (sc + 1.0f) + sh;
                    v2u w; w.x = pk2(v[j][0], v[j][1]); w.y = pk2(v[j][2], v[j][3]); *(v2u*)(XN + (size_t)row * D + 4 * lane + 256 * j) = w; }
                float myv = 0.f;
#pragma unroll 2
                for (int o = 0; o < 16; ++o) { float s = 0.f;
#pragma unroll
                    for (int j = 0; j < 4; ++j) { const f32x4 w = *(const LAS f32x4*)(wab + o * 1024 + 4 * lane + 256 * j); s += (v[j][0] * w[0] + v[j][1] * w[1]) + (v[j][2] * w[2] + v[j][3] * w[3]); }
                    s = wave_sum(s); if (lane == o) myv = s; }
                if (lane < 16) AB[(size_t)row * 16 + lane] = myv + bin[OFF_A + lane];
            }
        }
        SEAM(pb + 0);

        if (PH_ON(2) && IN(pb + 1)) { PH_BEGIN(); const float* mv = modv + (size_t)l * 9 * 6144; (void)mv; unsigned* const moecnt = ctl + CW_MOE + l * 16 * 64; (void)moecnt;
            SchedInA S{X.G, X.bid, (const char*)XN, (const char*)WIN};
            EpiInA E{PQKV, PZ, PCONF, PSGU, PFFT, PFFTC, binv};
            pg8::gemm_phase<EpiInA, SchedInA, true, true>(lds, Gemm{1024, 1024, 1024}, S, E);
        }
        SEAM(pb + 1);

        if (PH_ON(3) && IN(pb + 2)) { PH_BEGIN(); const float* mv = modv + (size_t)l * 9 * 6144; (void)mv; unsigned* const moecnt = ctl + CW_MOE + l * 16 * 64; (void)moecnt;
            if (CPART & 1) {
            { SchedFftLat S{X.G, X.bid, (const char*)DFTL, (const char*)PFFT}; EpiBf16<0> E{BR + (size_t)2 * NTOK * 512, 512, nullptr};
              pg8::gemm_phase<EpiBf16<0>, SchedFftLat, true, true>(lds, Gemm{4096, 4096, 4096}, S, E); }
            { SchedFftCtx S{X.G, X.bid, (const char*)DFTC, (const char*)PFFTC}; EpiBf16<0> E{BR + (size_t)2 * NTOK * 512, 512, nullptr};
              pg8::gemm_phase<EpiBf16<0>, SchedFftCtx, true, true>(lds, Gemm{512, 512, 512}, S, E); }
            __syncthreads();
            }
            if (CPART & 2) {
                const float* cw = INP(I_GCONV) + (size_t)l * 5 * 1536;
                for (int row = gw; row < NTOK; row += NGW) {
                    int t, T; if (row < NLAT) { t = row & 2047; T = 2048; } else { t = (row - NLAT) & 255; T = 256; }
#pragma unroll 1
                    for (int seg = 0; seg < 3; ++seg) { const int ch = seg * 512 + 8 * lane; float a[8];
#pragma unroll
                        for (int e = 0; e < 8; ++e) a[e] = 0.f;
#pragma unroll
                        for (int j = 0; j < 5; ++j) { const int tt = t + j - 2; if (tt >= 0 && tt < T) { float xv[8]; unpack8(*(const v4u*)(PQKV + (size_t)(row + j - 2) * 1536 + ch), xv);
                            const f32x4 w0 = *(const f32x4*)(cw + j * 1536 + ch), w1 = *(const f32x4*)(cw + j * 1536 + ch + 4);
#pragma unroll
                            for (int e = 0; e < 4; ++e) { a[e] += w0[e] * xv[e]; a[4 + e] += w1[e] * xv[4 + e]; } } }
                        float ss = 0.f;
#pragma unroll
                        for (int e = 0; e < 8; ++e) { a[e] = siluf_(a[e]); ss += a[e] * a[e]; }
                        if (seg < 2) { ss = g16_sum(ss); const float sc = (1.0f / sqrtf(ss + LN_EPS)) * (seg == 0 ? 0.08838834764831845f : 1.0f);
#pragma unroll
                            for (int e = 0; e < 8; ++e) a[e] *= sc; }
                        *(v4u*)(QKV + (size_t)row * 1536 + ch) = pack8(a); }
                    if (lane < 8) { const float av = AB[(size_t)row * 16 + lane], bv = AB[(size_t)row * 16 + 8 + lane];
                        const float xs = av + INP(I_GDT)[l * 8 + lane]; const float sp = xs > 20.f ? xs : log1pf(expf(xs));
                        GB[(size_t)row * 16 + lane] = -expf(INP(I_GALOG)[l * 8 + lane]) * sp; GB[(size_t)row * 16 + 8 + lane] = 1.0f / (1.0f + expf(-bv)); }
                }
            }
            if (CPART & 4) {
                const float* dw = INP(I_CDWW) + (size_t)l * 31 * 512; const float* dwb = INP(I_CDWB) + l * 512, *lg = INP(I_CLNG) + l * 512, *lb = INP(I_CLNB) + l * 512;
                bf16* B1 = BR + (size_t)1 * NTOK * 512; const int ch = 8 * lane;
                for (int row = gw; row < nrows2; row += NGW) {
                    int t, T; if (row < NLAT) { t = row & 2047; T = 2048; } else { t = (row - NLAT) & 255; T = 256; }
                    float a[8];
#pragma unroll
                    for (int e = 0; e < 8; ++e) a[e] = dwb[ch + e];
#pragma unroll 4
                    for (int j = 0; j < 31; ++j) { const int tt = t + j - 15; if (tt >= 0 && tt < T) { float xv[8]; unpack8(*(const v4u*)(PCONF + (size_t)(row + j - 15) * 512 + ch), xv);
                        const f32x4 w0 = *(const f32x4*)(dw + j * 512 + ch), w1 = *(const f32x4*)(dw + j * 512 + ch + 4);
#pragma unroll
                        for (int e = 0; e < 4; ++e) { a[e] += w0[e] * xv[e]; a[4 + e] += w1[e] * xv[4 + e]; } } }
                    float s = 0.f;
#pragma unroll
                    for (int e = 0; e < 8; ++e) s += a[e];
                    const float mean = g16_sum(s) * (1.0f / 128.0f); float s2 = 0.f;
#pragma unroll
                    for (int e = 0; e < 8; ++e) { a[e] -= mean; s2 += a[e] * a[e]; }
                    const float rstd = 1.0f / sqrtf(g16_sum(s2) * (1.0f / 128.0f) + LN_EPS);
#pragma unroll
                    for (int e = 0; e < 8; ++e) a[e] = siluf_(a[e] * rstd * lg[ch + e] + lb[ch + e]);
                    *(v4u*)(B1 + (size_t)row * 512 + ch) = pack8(a);
                }
            }
            if (CPART & 8) {
                LAS float* vn = (LAS float*)lds; LAS float* wsg = (LAS float*)(lds + 65536);
                const float* lg = INP(I_SLNG) + l * 512, *lb = INP(I_SLNB) + l * 512;
                bf16* B3 = BR + (size_t)3 * NTOK * 512;
                const int nitems = (nrows2 / 128) * 4;
                __syncthreads();
                for (int it = X.bid; it < nitems; it += X.G) {
                    const int chunk = it >> 2, g = it & 3, r0 = chunk * 128;
                    const float* wsrc = INP(I_SWS) + ((size_t)(l * 4 + g)) * 128 * 128;
                    for (int i = tid; i < 128 * 128 / 4; i += 512) *(LAS f32x4*)(wsg + 4 * i) = *(const f32x4*)(wsrc + 4 * i);
                    for (int q = X.wave; q < 128; q += 8) { const unsigned w = *(const unsigned*)(PSGU + (size_t)(r0 + q) * 1024 + 512 + g * 128 + 2 * lane);
                        float v0 = bflo(w), v1 = bfhi(w); const float mean = wave_sum(v0 + v1) * (1.0f / 128.0f); v0 -= mean; v1 -= mean;
                        const float rstd = 1.0f / sqrtf(wave_sum(v0 * v0 + v1 * v1) * (1.0f / 128.0f) + LN_EPS);
                        const int c = g * 128 + 2 * lane; vn[q * 128 + 2 * lane] = v0 * rstd * lg[c] + lb[c]; vn[q * 128 + 2 * lane + 1] = v1 * rstd * lg[c + 1] + lb[c + 1]; }
                    __syncthreads();
                    const int c4 = (tid & 31) * 4, pblk = tid >> 5; f32x4 acc[8];
#pragma unroll
                    for (int i = 0; i < 8; ++i) acc[i] = (f32x4){0.f, 0.f, 0.f, 0.f};
                    for (int q = 0; q < 128; q += 4) {
                        f32x4 vq[4];
#pragma unroll
                        for (int qq = 0; qq < 4; ++qq) vq[qq] = *(const LAS f32x4*)(vn + (q + qq) * 128 + c4);
#pragma unroll
                        for (int i = 0; i < 8; ++i) { const f32x4 w = *(const LAS f32x4*)(wsg + (pblk * 8 + i) * 128 + q);
                            acc[i] += vq[0] * w[0]; acc[i] += vq[1] * w[1]; acc[i] += vq[2] * w[2]; acc[i] += vq[3] * w[3]; }
                    }
#pragma unroll
                    for (int i = 0; i < 8; ++i) { const int p = pblk * 8 + i; const float bs = INP(I_SBS)[(l * 4 + g) * 128 + p];
                        const v2u uw = *(const v2u*)(PSGU + (size_t)(r0 + p) * 1024 + g * 128 + c4);
                        v2u o; o.x = pk2(bflo(uw.x) * (acc[i][0] + bs), bfhi(uw.x) * (acc[i][1] + bs)); o.y = pk2(bflo(uw.y) * (acc[i][2] + bs), bfhi(uw.y) * (acc[i][3] + bs));
                        *(v2u*)(B3 + (size_t)(r0 + p) * 512 + g * 128 + c4) = o; }
                    __syncthreads();
                }
            }
        }
        SEAM(pb + 2);

        if (PH_ON(4) && IN(pb + 3)) { PH_BEGIN(); const float* mv = modv + (size_t)l * 9 * 6144; (void)mv; unsigned* const moecnt = ctl + CW_MOE + l * 16 * 64; (void)moecnt;
            if (X.wave < 4) {
                for (int item = X.bid * 4 + X.wave; item < 1024; item += X.G * 4) {
                    const int chain = item >> 4, slice = item & 15, b = chain >> 3, hh = (chain >> 1) & 3, dir = chain & 1;
                    const int ig = lane >> 3, jj = lane & 7;
                    float* const O = dir ? OB : OF;
                    float S[16];
#pragma unroll
                    for (int i = 0; i < 16; ++i) S[i] = 0.f;
                    for (int st = 0; st < 2; ++st) {
                        const int T = st == 0 ? CTXL : SEQ, rbase = st == 0 ? NLAT + b * CTXL : b * SEQ;
                        v4u kq[4]; float vv, gg, bb;
                        { const int row = rbase + (dir ? T - 1 : 0); const bf16* p = QKV + (size_t)row * 1536 + hh * 128;
                          kq[0] = *(const v4u*)(p + 512 + ig * 16); kq[1] = *(const v4u*)(p + 512 + ig * 16 + 8); kq[2] = *(const v4u*)(p + ig * 16); kq[3] = *(const v4u*)(p + ig * 16 + 8);
                          vv = bf1(p[1024 + slice * 8 + jj]); gg = GB[(size_t)row * 16 + dir * 4 + hh]; bb = GB[(size_t)row * 16 + 8 + dir * 4 + hh]; }
                        for (int step = 0; step < T; ++step) {
                            const int row = rbase + (dir ? T - 1 - step : step);
                            v4u nkq[4]; float nv = 0.f, ng = 0.f, nb = 0.f;
                            nkq[0] = kq[0]; nkq[1] = kq[1]; nkq[2] = kq[2]; nkq[3] = kq[3];
                            if (step + 1 < T) { const int nrow = rbase + (dir ? T - 2 - step : step + 1); const bf16* p = QKV + (size_t)nrow * 1536 + hh * 128;
                                nkq[0] = *(const v4u*)(p + 512 + ig * 16); nkq[1] = *(const v4u*)(p + 512 + ig * 16 + 8); nkq[2] = *(const v4u*)(p + ig * 16); nkq[3] = *(const v4u*)(p + ig * 16 + 8);
                                nv = bf1(p[1024 + slice * 8 + jj]); ng = GB[(size_t)nrow * 16 + dir * 4 + hh]; nb = GB[(size_t)nrow * 16 + 8 + dir * 4 + hh]; }
                            float kk[16], qq[16]; { float t8[8]; unpack8(kq[0], t8);
#pragma unroll
                                for (int e = 0; e < 8; ++e) kk[e] = t8[e];
                                unpack8(kq[1], t8);
#pragma unroll
                                for (int e = 0; e < 8; ++e) kk[8 + e] = t8[e];
                                unpack8(kq[2], t8);
#pragma unroll
                                for (int e = 0; e < 8; ++e) qq[e] = t8[e];
                                unpack8(kq[3], t8);
#pragma unroll
                                for (int e = 0; e < 8; ++e) qq[8 + e] = t8[e]; }
                            const float eg = expf(gg); float r0 = 0.f, r1 = 0.f;
#pragma unroll
                            for (int i = 0; i < 16; i += 2) { S[i] *= eg; S[i + 1] *= eg; r0 += kk[i] * S[i]; r1 += kk[i + 1] * S[i + 1]; }
                            float r = r0 + r1; r += __shfl_xor(r, 8); r += __shfl_xor(r, 16); r += __shfl_xor(r, 32);
                            const float vn = bb * (vv - r); float o0 = 0.f, o1 = 0.f;
#pragma unroll
                            for (int i = 0; i < 16; i += 2) { S[i] += kk[i] * vn; S[i + 1] += kk[i + 1] * vn; o0 += qq[i] * S[i]; o1 += qq[i + 1] * S[i + 1]; }
                            float o = o0 + o1; o += __shfl_xor(o, 8); o += __shfl_xor(o, 16); o += __shfl_xor(o, 32);
                            if (ig == 0) O[(size_t)row * 512 + hh * 128 + slice * 8 + jj] = o;
                            kq[0] = nkq[0]; kq[1] = nkq[1]; kq[2] = nkq[2]; kq[3] = nkq[3]; vv = nv; gg = ng; bb = nb;
                        }
                    }
                }
            }
        }
        SEAM(pb + 3);

        if (PH_ON(5) && IN(pb + 4)) { PH_BEGIN(); const float* mv = modv + (size_t)l * 9 * 6144; (void)mv; unsigned* const moecnt = ctl + CW_MOE + l * 16 * 64; (void)moecnt;
            const float* nw = INP(I_GNORM) + l * 128; const int ch = 8 * lane;
            for (int row = gw; row < nrows2; row += NGW) {
                const f32x4 a0 = *(const f32x4*)(OF + (size_t)row * 512 + ch) + *(const f32x4*)(OB + (size_t)row * 512 + ch);
                const f32x4 a1 = *(const f32x4*)(OF + (size_t)row * 512 + ch + 4) + *(const f32x4*)(OB + (size_t)row * 512 + ch + 4);
                float ss = (a0[0] * a0[0] + a0[1] * a0[1]) + (a0[2] * a0[2] + a0[3] * a0[3]) + (a1[0] * a1[0] + a1[1] * a1[1]) + (a1[2] * a1[2] + a1[3] * a1[3]);
                const float rs = 1.0f / sqrtf(g16_sum(ss) * (1.0f / 128.0f) + LN_EPS);
                float z[8]; unpack8(*(const v4u*)(PZ + (size_t)row * 512 + ch), z); float o[8];
#pragma unroll
                for (int e = 0; e < 4; ++e) { o[e] = a0[e] * rs * nw[(ch & 127) + e] * z[e]; o[4 + e] = a1[e] * rs * nw[(ch & 127) + 4 + e] * z[4 + e]; }
                *(v4u*)(BR + (size_t)row * 512 + ch) = pack8(o);
            }
        }
        SEAM(pb + 4);

        if (PH_ON(6) && IN(pb + 5)) { PH_BEGIN(); const float* mv = modv + (size_t)l * 9 * 6144; (void)mv; unsigned* const moecnt = ctl + CW_MOE + l * 16 * 64; (void)moecnt;
            SchedGrid S{X.G, X.bid, npan2, 16, (const char*)XN, (const char*)(WIN + (size_t)5120 * 1024), (size_t)256 * 1024 * 2, (size_t)256 * 1024 * 2};
            EpiBf16<1> E{GT, 4096, binv + 5120};
            pg8::gemm_phase<EpiBf16<1>, SchedGrid, true, true>(lds, Gemm{1024, 1024, 1024}, S, E);
        }
        SEAM(pb + 5);

        if (PH_ON(7) && IN(pb + 6)) { PH_BEGIN(); const float* mv = modv + (size_t)l * 9 * 6144; (void)mv; unsigned* const moecnt = ctl + CW_MOE + l * 16 * 64; (void)moecnt;
            SchedBranch S{X.G, X.bid, npan2, (const char*)BR, (const char*)WBR};
            EpiBranch E{MERGED, XN, GT};
            pg8::gemm_phase<EpiBranch, SchedBranch, true, true>(lds, Gemm{512, 512, 512}, S, E);
        }
        SEAM(pb + 6);

        if (PH_ON(8) && IN(pb + 7)) { PH_BEGIN(); const float* mv = modv + (size_t)l * 9 * 6144; (void)mv; unsigned* const moecnt = ctl + CW_MOE + l * 16 * 64; (void)moecnt;
            SchedGrid S{X.G, X.bid, npan2, 4, (const char*)XN, (const char*)WOUT, (size_t)256 * 1024 * 2, (size_t)256 * 1024 * 2};
            EpiF32 E{YB, 1024, INP(I_BOUT) + l * 1024};
            pg8::gemm_phase<EpiF32, SchedGrid, true, true>(lds, Gemm{1024, 1024, 1024}, S, E);
        }
        SEAM(pb + 7);

        if (PH_ON(9) && IN(pb + 8)) { PH_BEGIN(); const float* mv = modv + (size_t)l * 9 * 6144; (void)mv; unsigned* const moecnt = ctl + CW_MOE + l * 16 * 64; (void)moecnt;
            for (int it = X.bid; it < 16 * 16 * 16; it += X.G) { const int e = it >> 8, rb = (it >> 4) & 15, kb = it & 15, row0 = rb * 64, j = row0 >> 8, w = row0 & 255;
                const float* src = (w < 128 ? INP(I_EWG) : INP(I_EWU)) + ((size_t)(l * 16 + e) * 1024) * 512 + 128 * j + (w & 127);
                cvt_tile(X, src, 512, kb * 64, WGU + ((size_t)e * 1024 + row0) * 1024, 1024); }
            for (int it = X.bid; it < 16 * 16 * 8; it += X.G) { const int e = it >> 7, rb = (it >> 3) & 15, kb = it & 7;
                cvt_tile(X, INP(I_EWD) + ((size_t)(l * 16 + e) * 512) * 1024 + rb * 64, 1024, kb * 64, WDN + ((size_t)e * 1024 + rb * 64) * 512, 512); }
            LAS float* wr_ = (LAS float*)lds;
            __syncthreads();
            for (int i = tid; i < 20 * 1024; i += 512) { const int o = i >> 10, k = i & 1023; wr_[i] = o < 4 ? INP(I_RGW)[(size_t)l * 4096 + k * 4 + o] : INP(I_REW)[(size_t)l * 16384 + k * 16 + (o - 4)]; }
            __syncthreads();
            const float* g1 = INP(I_LN1G) + l * 1024, *b1 = INP(I_LN1B) + l * 1024;
            for (int row = gw; row < nrows2; row += NGW) {
                float* hrow = row < NLAT ? hlat + (size_t)row * D : hctx + (size_t)(row - NLAT) * D;
                const int mi = row < NLAT ? (row >> 11) : 8; const float* mrow = mv + mi * 6144;
                f32x4 v[4];
#pragma unroll
                for (int j = 0; j < 4; ++j) { const int c = 4 * lane + 256 * j; v[j] = *(const f32x4*)(hrow + c) * DN_ALPHA + *(const f32x4*)(mrow + 2048 + c) * *(const f32x4*)(YB + (size_t)row * D + c); }
                ln_rows(v);
#pragma unroll
                for (int j = 0; j < 4; ++j) { const int c = 4 * lane + 256 * j; v[j] = v[j] * *(const f32x4*)(g1 + c) + *(const f32x4*)(b1 + c); *(f32x4*)(hrow + c) = v[j]; }
                ln_rows(v);
#pragma unroll
                for (int j = 0; j < 4; ++j) { const int c = 4 * lane + 256 * j; v[j] = v[j] * (*(const f32x4*)(mrow + 4096 + c) + 1.0f) + *(const f32x4*)(mrow + 3072 + c);
                    v2u w; w.x = pk2(v[j][0], v[j][1]); w.y = pk2(v[j][2], v[j][3]); *(v2u*)(XN + (size_t)row * D + c) = w; }
                float mylg = 0.f;
#pragma unroll 2
                for (int o = 0; o < 20; ++o) { float s = 0.f;
#pragma unroll
                    for (int j = 0; j < 4; ++j) { const f32x4 w = *(const LAS f32x4*)(wr_ + o * 1024 + 4 * lane + 256 * j); s += (v[j][0] * w[0] + v[j][1] * w[1]) + (v[j][2] * w[2] + v[j][3] * w[3]); }
                    s = wave_sum(s); if (lane == o) mylg = s; }
                if (lane < 20) mylg += (lane < 4 ? INP(I_RGB)[l * 4 + lane] : INP(I_REB)[l * 16 + lane - 4]);
                float lg[20];
#pragma unroll
                for (int o = 0; o < 20; ++o) lg[o] = __shfl(mylg, o);
                int gs = 0; float gm = lg[0];
#pragma unroll
                for (int o = 1; o < 4; ++o) if (lg[o] > gm) { gm = lg[o]; gs = o; }
                float den = 0.f;
#pragma unroll
                for (int o = 0; o < 4; ++o) den += expf(lg[o] - gm);
                const float gp = 1.0f / den;
                float el[4];
#pragma unroll
                for (int o = 0; o < 4; ++o) el[o] = gs == 0 ? lg[4 + o] : gs == 1 ? lg[8 + o] : gs == 2 ? lg[12 + o] : lg[16 + o];
                int i0 = 0; float v0 = el[0];
#pragma unroll
                for (int o = 1; o < 4; ++o) if (el[o] > v0) { v0 = el[o]; i0 = o; }
                int i1 = -1; float v1 = 0.f;
#pragma unroll
                for (int o = 0; o < 4; ++o) if (o != i0 && (i1 < 0 || el[o] > v1)) { v1 = el[o]; i1 = o; }
                const float ex = expf(v1 - v0), w0 = gp / (1.0f + ex), w1 = gp * ex / (1.0f + ex);
                const int e0 = gs * 4 + i0, e1 = gs * 4 + i1;
                if (lane == 0) {
                    const unsigned p0 = __hip_atomic_fetch_add(moecnt + 64 * e0, 1u, __ATOMIC_RELAXED, __HIP_MEMORY_SCOPE_AGENT);
                    const unsigned p1 = __hip_atomic_fetch_add(moecnt + 64 * e1, 1u, __ATOMIC_RELAXED, __HIP_MEMORY_SCOPE_AGENT);
                    float* rt = ROUTE + (size_t)row * 8;
                    rt[0] = __builtin_bit_cast(float, e0); rt[1] = __builtin_bit_cast(float, e1); rt[2] = w0; rt[3] = w1; rt[4] = __builtin_bit_cast(float, (int)p0); rt[5] = __builtin_bit_cast(float, (int)p1);
                }
            }
        }
        SEAM(pb + 8);

        if (PH_ON(10) && IN(pb + 9)) { PH_BEGIN(); const float* mv = modv + (size_t)l * 9 * 6144; (void)mv; unsigned* const moecnt = ctl + CW_MOE + l * 16 * 64; (void)moecnt;
            unsigned pre[16]; { unsigned s = 0;
#pragma unroll
                for (int e = 0; e < 16; ++e) { pre[e] = s; s += ((__hip_atomic_load(moecnt + 64 * e, __ATOMIC_RELAXED, __HIP_MEMORY_SCOPE_AGENT) + 255u) >> 8) << 8; } }
            for (int as = gw; as < nrows2 * 2; as += NGW) { const int row = as >> 1, sl = as & 1; const float* rt = ROUTE + (size_t)row * 8;
                const int e = __builtin_bit_cast(int, rt[sl]), p = __builtin_bit_cast(int, rt[4 + sl]); unsigned base = 0;
#pragma unroll
                for (int k = 0; k < 16; ++k) base = (k == e) ? pre[k] : base;
                const size_t dst = (size_t)(base + (unsigned)p) * D;
#pragma unroll
                for (int j = 0; j < 2; ++j) *(v4u*)(XG + dst + 8 * lane + 512 * j) = *(const v4u*)(XN + (size_t)row * D + 8 * lane + 512 * j);
            }
        }
        SEAM(pb + 9);

        if (PH_ON(11) && IN(pb + 10)) { PH_BEGIN(); const float* mv = modv + (size_t)l * 9 * 6144; (void)mv; unsigned* const moecnt = ctl + CW_MOE + l * 16 * 64; (void)moecnt;
            SchedMoe S; S.G = X.G; S.c = X.bid; S.a0 = (const char*)XG; S.w0 = (const char*)WGU; S.astep = (size_t)256 * 1024 * 2; S.wstep_e = (size_t)1024 * 1024 * 2; S.wstep_n = (size_t)256 * 1024 * 2; S.init(moecnt);
            EpiMoe1 E{HID};
            pg8::gemm_phase<EpiMoe1, SchedMoe, true, true>(lds, Gemm{1024, 1024, 1024}, S, E);
        }
        SEAM(pb + 10);

        if (PH_ON(12) && IN(pb + 11)) { PH_BEGIN(); const float* mv = modv + (size_t)l * 9 * 6144; (void)mv; unsigned* const moecnt = ctl + CW_MOE + l * 16 * 64; (void)moecnt;
            SchedMoe S; S.G = X.G; S.c = X.bid; S.a0 = (const char*)HID; S.w0 = (const char*)WDN; S.astep = (size_t)256 * 512 * 2; S.wstep_e = (size_t)1024 * 512 * 2; S.wstep_n = (size_t)256 * 512 * 2; S.init(moecnt);
            EpiBf16<0> E{MO, 1024, nullptr};
            pg8::gemm_phase<EpiBf16<0>, SchedMoe, true, true>(lds, Gemm{512, 512, 512}, S, E);
        }
        SEAM(pb + 11);

        if (PH_ON(13) && IN(pb + 12)) { PH_BEGIN(); const float* mv = modv + (size_t)l * 9 * 6144; (void)mv; unsigned* const moecnt = ctl + CW_MOE + l * 16 * 64; (void)moecnt;
            unsigned pre[16]; { unsigned s = 0;
#pragma unroll
                for (int e = 0; e < 16; ++e) { pre[e] = s; s += ((__hip_atomic_load(moecnt + 64 * e, __ATOMIC_RELAXED, __HIP_MEMORY_SCOPE_AGENT) + 255u) >> 8) << 8; } }
            const float* g2 = INP(I_LN2G) + l * 1024, *b2 = INP(I_LN2B) + l * 1024;
            for (int row = gw; row < nrows2; row += NGW) {
                float* hrow = row < NLAT ? hlat + (size_t)row * D : hctx + (size_t)(row - NLAT) * D;
                const int mi = row < NLAT ? (row >> 11) : 8; const float* mrow = mv + mi * 6144;
                const float* rt = ROUTE + (size_t)row * 8;
                const int e0 = __builtin_bit_cast(int, rt[0]), e1 = __builtin_bit_cast(int, rt[1]), p0 = __builtin_bit_cast(int, rt[4]), p1 = __builtin_bit_cast(int, rt[5]); const float w0 = rt[2], w1 = rt[3];
                unsigned ba0 = 0, ba1 = 0;
#pragma unroll
                for (int k = 0; k < 16; ++k) { ba0 = (k == e0) ? pre[k] : ba0; ba1 = (k == e1) ? pre[k] : ba1; }
                const bf16* m0 = MO + (size_t)(ba0 + (unsigned)p0) * D, *m1 = MO + (size_t)(ba1 + (unsigned)p1) * D;
                f32x4 v[4];
#pragma unroll
                for (int j = 0; j < 4; ++j) { const int c = 4 * lane + 256 * j; const v2u a = *(const v2u*)(m0 + c), b = *(const v2u*)(m1 + c);
                    f32x4 mm; mm[0] = w0 * bflo(a.x) + w1 * bflo(b.x); mm[1] = w0 * bfhi(a.x) + w1 * bfhi(b.x); mm[2] = w0 * bflo(a.y) + w1 * bflo(b.y); mm[3] = w0 * bfhi(a.y) + w1 * bfhi(b.y);
                    v[j] = *(const f32x4*)(hrow + c) * DN_ALPHA + *(const f32x4*)(mrow + 5120 + c) * mm; }
                ln_rows(v);
#pragma unroll
                for (int j = 0; j < 4; ++j) { const int c = 4 * lane + 256 * j; *(f32x4*)(hrow + c) = v[j] * *(const f32x4*)(g2 + c) + *(const f32x4*)(b2 + c); }
            }
        }
        SEAM(pb + 12);
    }
#undef IN
#undef SEAM
}

extern "C" void kernel_launch(void* const* d_in, const int* in_sizes, int n_in, void* d_out, int out_size, void* d_ws, size_t ws_size, hipStream_t stream) {
    static int grid = 0;
    if (grid == 0) {
        if (n_in != 34 || out_size != NLAT * D || ws_size < WS_END) { fprintf(stderr, "kernel_launch: unexpected problem (n_in %d out %d ws %zu)\n", n_in, out_size, ws_size); grid = -1; return; }
        int dev = 0, cus = 0, per_cu = 0;
        if (hipGetDevice(&dev) != hipSuccess || hipDeviceGetAttribute(&cus, hipDeviceAttributeMultiprocessorCount, dev) != hipSuccess) { grid = -1; return; }
        if (hipFuncSetAttribute((const void*)fwd, hipFuncAttributeMaxDynamicSharedMemorySize, LDS_BYTES) != hipSuccess) { fprintf(stderr, "kernel_launch: hipFuncSetAttribute failed\n"); grid = -1; return; }
        if (hipOccupancyMaxActiveBlocksPerMultiprocessor(&per_cu, (const void*)fwd, NWAVES * 64, LDS_BYTES) != hipSuccess || per_cu < 1) { fprintf(stderr, "kernel_launch: occupancy query reports %d\n", per_cu); }
        (void)hipGetLastError();
        grid = cus;
    }
    if (grid < 0) return;
    if (hipMemsetAsync((char*)d_ws + WS_CTL, 0, CTL_ZERO_BYTES, stream) != hipSuccess) return;
    Args a{};
    for (int i = 0; i < 34; ++i) a.in[i] = (const float*)d_in[i];
    a.out = (float*)d_out; a.ws = (unsigned char*)d_ws;
#if MK_ONE_LAUNCH
    a.ph_lo = 0; a.ph_hi = NPHASES;
    hipLaunchKernelGGL(fwd, dim3(grid), dim3(NWAVES * 64), LDS_BYTES, stream, a);
#else
    for (int p = 0; p < NPHASES; ++p) { a.ph_lo = p; a.ph_hi = p + 1; hipLaunchKernelGGL(fwd, dim3(grid), dim3(NWAVES * 64), LDS_BYTES, stream, a); }
#endif
}
```

```cpp
#include <hip/hip_runtime.h>
#include <cstdio>
#include <cstdint>

#define GAS __attribute__((address_space(1)))
#define LAS __attribute__((address_space(3)))
typedef unsigned short bf16;
typedef unsigned v4u __attribute__((ext_vector_type(4)));
typedef unsigned v2u __attribute__((ext_vector_type(2)));
typedef float f32x4 __attribute__((ext_vector_type(4)));
typedef float f32x2 __attribute__((ext_vector_type(2)));
typedef short bf16x8 __attribute__((ext_vector_type(8)));

constexpr int D = 1024, NB = 8, SEQ = 2048, CTXL = 256, NLAT = NB * SEQ, NCTX = NB * CTXL, NTOK = NLAT + NCTX;
constexpr int OFF_Q = 0, OFF_K = 512, OFF_V = 1024, OFF_Z = 1536, OFF_A = 2048, OFF_B = 2056, OFF_CONF = 2064, OFF_FFT = 3088, OFF_SGU = 3600, OFF_GATE = 4624, N_IN = 8720;
constexpr int NWROWS = 9216;
constexpr float LN_EPS = 1e-6f;
constexpr float DN_ALPHA = 1.4142135623730951f;
constexpr int NWAVES = 8;
constexpr int NPH_LAYER = 13, NPHASES = 1 + 2 * NPH_LAYER;

#ifndef PHMASK
#define PHMASK 0xFFFFFFFFu
#endif
#define PH_ON(k) (((PHMASK) >> (k)) & 1u)
#ifndef CPART
#define CPART 15
#endif
#ifndef MK_ONE_LAUNCH
#define MK_ONE_LAUNCH 1
#endif

constexpr size_t MiB = 1u << 20;
constexpr size_t WS_CTL = 0, CTL_ZERO_BYTES = 1 * MiB;
constexpr size_t WS_MODV = 1 * MiB;
constexpr size_t WS_BIN = 1 * MiB + 512 * 1024;
constexpr size_t WS_ROUTE = WS_BIN + 64 * 1024;
constexpr size_t WS_HCTX = 3 * MiB;
constexpr size_t WS_XN = 11 * MiB;
constexpr size_t WS_WIN = 47 * MiB;
constexpr size_t WS_WBR = 65 * MiB;
constexpr size_t WS_WOUT = 69 * MiB;
constexpr size_t WS_DFTL = 71 * MiB;
constexpr size_t WS_DFTC = 87 * MiB;
constexpr size_t WS_R2 = 88 * MiB;
constexpr size_t WS_PQKV = WS_R2;
constexpr size_t WS_PCONF = WS_R2 + 54 * MiB;
constexpr size_t WS_PZ = WS_R2 + 72 * MiB;
constexpr size_t WS_PSGU = WS_R2 + 90 * MiB;
constexpr size_t WS_PFFT = WS_R2 + 126 * MiB;
constexpr size_t WS_PFFTC = WS_R2 + 158 * MiB;
constexpr size_t WS_AB = WS_R2 + 162 * MiB;
constexpr size_t WS_OF = WS_R2;
constexpr size_t WS_OB = WS_R2 + 36 * MiB;
constexpr size_t WS_G = WS_R2;
constexpr size_t WS_WGU = WS_R2;
constexpr size_t WS_WDN = WS_R2 + 32 * MiB;
constexpr size_t WS_XG = WS_R2 + 48 * MiB;
constexpr size_t WS_R3 = WS_R2 + 164 * MiB;
constexpr size_t WS_QKV = WS_R3;
constexpr size_t WS_GB = WS_R3 + 54 * MiB;
constexpr size_t WS_BR = WS_R3 + 72 * MiB;
constexpr size_t WS_MERGED = WS_R3;
constexpr size_t WS_Y = WS_R3 + 72 * MiB;
constexpr size_t WS_HID = WS_R3;
constexpr size_t WS_MO = WS_R3 + 40 * MiB;
constexpr size_t WS_END = WS_R3 + 144 * MiB;
static_assert(WS_END <= 405 * MiB, "workspace map");
constexpr int CW_BAR = 4096;
constexpr int CW_MOE = 16384;

constexpr int RING_BYTES = 131072;
constexpr int LDSCTL_OFF = RING_BYTES, MISC_OFF = LDSCTL_OFF + 320;
constexpr int LDS_BYTES = 147456;

#define LDS_WAIT() asm volatile("s_waitcnt lgkmcnt(0)" ::: "memory")
#define VM_WAIT() asm volatile("s_waitcnt vmcnt(0)" ::: "memory")
__device__ __forceinline__ unsigned f2bf(float f) { unsigned u = __builtin_bit_cast(unsigned, f); return (u + 0x7fffu + ((u >> 16) & 1u)) >> 16; }
__device__ __forceinline__ unsigned pk2(float lo, float hi) { return f2bf(lo) | (f2bf(hi) << 16); }
__device__ __forceinline__ float bflo(unsigned w) { return __builtin_bit_cast(float, w << 16); }
__device__ __forceinline__ float bfhi(unsigned w) { return __builtin_bit_cast(float, w & 0xffff0000u); }
__device__ __forceinline__ float bf1(bf16 b) { return __builtin_bit_cast(float, ((unsigned)b) << 16); }
__device__ __forceinline__ void unpack8(const v4u w, float (&o)[8]) { o[0] = bflo(w.x); o[1] = bfhi(w.x); o[2] = bflo(w.y); o[3] = bfhi(w.y); o[4] = bflo(w.z); o[5] = bfhi(w.z); o[6] = bflo(w.w); o[7] = bfhi(w.w); }
__device__ __forceinline__ v4u pack8(const float (&o)[8]) { v4u w; w.x = pk2(o[0], o[1]); w.y = pk2(o[2], o[3]); w.z = pk2(o[4], o[5]); w.w = pk2(o[6], o[7]); return w; }
__device__ __forceinline__ float sigmoidf_(float x) { return 1.0f / (1.0f + __expf(-x)); }
__device__ __forceinline__ float siluf_(float x) { return x / (1.0f + __expf(-x)); }
__device__ __forceinline__ float gelu_tanh(float x) { const float u = 0.7978845608028654f * (x + 0.044715f * x * x * x); return x / (1.0f + __expf(-2.0f * u)); }
__device__ __forceinline__ float wave_sum(float v) {
#pragma unroll
    for (int o = 1; o < 64; o <<= 1) v += __shfl_xor(v, o);
    return v;
}
__device__ __forceinline__ float g16_sum(float v) {
#pragma unroll
    for (int o = 1; o < 16; o <<= 1) v += __shfl_xor(v, o);
    return v;
}

namespace pg8 {
constexpr int BM = 256, BK = 64, HALF = 128, HTB = HALF * BK * 2, STAGE_BYTES = 8 * HTB;
__host__ __device__ __forceinline__ int lds_byte(int r, int c) { const int st = (r >> 4) * 2 + (c >> 5), rr = r & 15, cc = c & 31, ob = rr * 64 + cc * 2; return st * 1024 + (ob ^ (((ob >> 9) & 1) << 5)); }
__host__ __device__ __forceinline__ void stage_rc(int b, int& R, int& C) { const int st = b / 1024, sb = b % 1024, swz = sb ^ (((sb >> 9) & 1) << 5); R = (st >> 1) * 16 + swz / 64; C = (st & 1) * 32 + (swz % 64) / 2; }
__host__ __device__ __forceinline__ int perm32(int rho) { const int n = rho >> 4, i = rho & 15; return 8 * (i >> 2) + 4 * n + (i & 3); }

struct Unit { int pm, pn, aux; const char* a; const char* b; };
struct Gemm { int K, lda, ldb; };

__device__ __forceinline__ void map_tile(int L, int nM, int nN, int& pm, int& pn) {
    const int nwg = nM * nN; int wgid = L; { const int q = nwg / 8, r = nwg % 8, xcd = wgid % 8, off = wgid / 8; wgid = (xcd < r ? xcd * (q + 1) : r * (q + 1) + (xcd - r) * q) + off; }
    const int nig = 8 * nN, gid = wgid / nig, fm = gid * 8, gsz = (nM - fm) < 8 ? (nM - fm) : 8;
    pm = fm + ((wgid % nig) % gsz); pn = (wgid % nig) / gsz;
}
__device__ __forceinline__ unsigned cvt_pk_bf16(float lo, float hi) { unsigned r; asm volatile("v_cvt_pk_bf16_f32 %0, %1, %2" : "=v"(r) : "v"(lo), "v"(hi)); return r; }

template <class Epi, class Sched, bool ALIGN_EPI, bool SP2>
__device__ __forceinline__ void gemm_phase(LAS unsigned char* lds, const Gemm g, const Sched& S, const Epi& E) {
    int tid_l = threadIdx.x; asm volatile("" : "+v"(tid_l));
    const int tid = tid_l, wid = __builtin_amdgcn_readfirstlane(tid >> 6), lane = tid & 63, wr = wid >> 2, wc = wid & 3, fr = lane & 15, fq = lane >> 4;
    const int K = g.K, nt = K / BK;
    unsigned voffA[2], voffB[2];
#pragma unroll
    for (int i = 0; i < 2; ++i) { int R, C; stage_rc(tid * 16 + i * 8192, R, C); const int Rb = Epi::PERM ? ((R & ~31) + perm32(R & 31)) : R;
        voffA[i] = (unsigned)(R * g.lda + C) * 2u; voffB[i] = (unsigned)(Rb * g.ldb + C) * 2u; }
    const size_t kstep = (size_t)(BK * 2);
    const size_t hstepA = (size_t)HALF * g.lda * 2, hstepB = (size_t)HALF * g.ldb * 2;
    const unsigned ldsw = (unsigned)wid * 1024u;
    const int aoff = lds_byte(wr * 64 + fr, fq * 8), boff = lds_byte(wc * 32 + fr, fq * 8);
#define PG8_SA(b, h) (((b) * 2 + (h)) * HTB)
#define PG8_SB(b, h) ((4 + (b) * 2 + (h)) * HTB)
#define PG8_STAGE(bufoff, gbase, voff) do { _Pragma("unroll") for (int _i = 0; _i < 2; ++_i) \
        __builtin_amdgcn_global_load_lds((const unsigned*)((const char*)(gbase) + (voff)[_i]), (LAS unsigned*)(lds + (bufoff) + ldsw + _i * 8192), 16, 0, 0); } while (0)
#define PG8_LDA(dst, b, h) do { _Pragma("unroll") for (int m = 0; m < 4; ++m) _Pragma("unroll") for (int k = 0; k < 2; ++k) dst[m][k] = *(const LAS bf16x8*)(lds + PG8_SA(b, h) + aoff + m * 2048 + k * 1024); } while (0)
#define PG8_LDB(dst, b, h) do { _Pragma("unroll") for (int n = 0; n < 2; ++n) _Pragma("unroll") for (int k = 0; k < 2; ++k) dst[n][k] = *(const LAS bf16x8*)(lds + PG8_SB(b, h) + boff + n * 2048 + k * 1024); } while (0)
#define PG8_MMA(ai, bj, At, Bt) do { __builtin_amdgcn_s_setprio(1); _Pragma("unroll") for (int m = 0; m < 4; ++m) _Pragma("unroll") for (int n = 0; n < 2; ++n) _Pragma("unroll") for (int k = 0; k < 2; ++k) \
        acc[ai][bj][m][n] = __builtin_amdgcn_mfma_f32_16x16x32_bf16(Bt[n][k], At[m][k], acc[ai][bj][m][n], 0, 0, 0); __builtin_amdgcn_s_setprio(0); } while (0)
#define PG8_WAIT_V(n) asm volatile("s_waitcnt vmcnt(" #n ")" ::: "memory")
#define PG8_WAIT_L(n) asm volatile("s_waitcnt lgkmcnt(" #n ")" ::: "memory")
#define PG8_BAR __builtin_amdgcn_s_barrier()
#define PG8_SCHED __builtin_amdgcn_sched_barrier(0)
    Unit cur, nxt; int ui = 0;
    if (!S.next(0, cur)) return;
    f32x4 acc[2][2][4][2];
#pragma unroll
    for (int a = 0; a < 2; ++a)
#pragma unroll
        for (int b = 0; b < 2; ++b)
#pragma unroll
            for (int m = 0; m < 4; ++m)
#pragma unroll
                for (int n = 0; n < 2; ++n) acc[a][b][m][n] = (f32x4){0.f, 0.f, 0.f, 0.f};
    bf16x8 At[4][2], B0[2][2], B1[2][2];
    const char* cA = cur.a; const char* cB = cur.b;
    if constexpr (SP2) {
        PG8_STAGE(PG8_SB(0, 0), cB, voffB); PG8_STAGE(PG8_SB(0, 1), cB + hstepB, voffB); PG8_STAGE(PG8_SA(0, 0), cA, voffA); PG8_STAGE(PG8_SA(0, 1), cA + hstepA, voffA);
        if (wr == 1) PG8_BAR;
        PG8_WAIT_V(2); PG8_BAR;
        PG8_STAGE(PG8_SB(1, 0), cB + kstep, voffB); PG8_STAGE(PG8_SA(1, 0), cA + kstep, voffA); PG8_STAGE(PG8_SB(1, 1), cB + hstepB + kstep, voffB);
        PG8_WAIT_V(6); PG8_BAR;
    } else {
        PG8_STAGE(PG8_SB(0, 0), cB, voffB); PG8_STAGE(PG8_SA(0, 0), cA, voffA); PG8_STAGE(PG8_SB(0, 1), cB + hstepB, voffB); PG8_STAGE(PG8_SA(0, 1), cA + hstepA, voffA);
        if (wr == 1) PG8_BAR;
        PG8_WAIT_V(4); PG8_BAR;
        PG8_STAGE(PG8_SB(1, 0), cB + kstep, voffB); PG8_STAGE(PG8_SA(1, 0), cA + kstep, voffA); PG8_STAGE(PG8_SB(1, 1), cB + hstepB + kstep, voffB);
        PG8_WAIT_V(6); PG8_BAR;
    }
    for (;;) {
        const bool has_next = S.next(ui + 1, nxt);
        const char* nA = has_next ? nxt.a : cA; const char* nB = has_next ? nxt.b : cB;
        for (int t = 0; t < nt; t += 2) {
            const bool last = (t == nt - 2);
            const char* a1 = cA + (size_t)(t + 1) * kstep;
            const char* a2 = last ? nA : cA + (size_t)(t + 2) * kstep; const char* b2 = last ? nB : cB + (size_t)(t + 2) * kstep;
            const char* a3 = a2 + kstep; const char* b3 = b2 + kstep;
            if constexpr (SP2) {
            PG8_LDB(B0, 0, 0); PG8_LDB(B1, 0, 1); PG8_SCHED; PG8_LDA(At, 0, 0); PG8_STAGE(PG8_SA(1, 1), a1 + hstepA, voffA);
            PG8_WAIT_V(8); PG8_WAIT_L(0); PG8_BAR; PG8_MMA(0, 0, At, B0); PG8_MMA(0, 1, At, B1); PG8_BAR; PG8_SCHED;
            PG8_LDA(At, 0, 1); PG8_STAGE(PG8_SB(0, 0), b2, voffB); PG8_STAGE(PG8_SB(0, 1), b2 + hstepB, voffB); PG8_STAGE(PG8_SA(0, 0), a2, voffA);
            PG8_WAIT_V(8); PG8_WAIT_L(0); PG8_BAR; PG8_MMA(1, 0, At, B0); PG8_MMA(1, 1, At, B1); PG8_BAR; PG8_SCHED;
            PG8_LDB(B0, 1, 0); PG8_LDB(B1, 1, 1); PG8_SCHED; PG8_LDA(At, 1, 0); PG8_STAGE(PG8_SA(0, 1), a2 + hstepA, voffA);
            PG8_WAIT_V(8); PG8_WAIT_L(0); PG8_BAR; PG8_MMA(0, 0, At, B0); PG8_MMA(0, 1, At, B1); PG8_BAR; PG8_SCHED;
            PG8_LDA(At, 1, 1); PG8_STAGE(PG8_SB(1, 0), b3, voffB); PG8_STAGE(PG8_SB(1, 1), b3 + hstepB, voffB); PG8_STAGE(PG8_SA(1, 0), a3, voffA);
            PG8_WAIT_V(8); PG8_WAIT_L(0); PG8_BAR; PG8_MMA(1, 0, At, B0); PG8_MMA(1, 1, At, B1); PG8_BAR; PG8_SCHED;
            } else {
            PG8_LDB(B0, 0, 0); PG8_SCHED; PG8_LDA(At, 0, 0); PG8_STAGE(PG8_SA(1, 1), a1 + hstepA, voffA);
            PG8_WAIT_L(8); PG8_BAR; PG8_WAIT_L(0); PG8_MMA(0, 0, At, B0); PG8_BAR; PG8_SCHED;
            PG8_LDB(B1, 0, 1); PG8_STAGE(PG8_SB(0, 0), b2, voffB);
            PG8_BAR; PG8_WAIT_L(0); PG8_MMA(0, 1, At, B1); PG8_BAR;
            PG8_LDA(At, 0, 1); PG8_STAGE(PG8_SA(0, 0), a2, voffA);
            PG8_BAR; PG8_WAIT_L(0); PG8_MMA(1, 0, At, B0); PG8_BAR; PG8_SCHED;
            PG8_STAGE(PG8_SB(0, 1), b2 + hstepB, voffB);
            PG8_WAIT_V(6); PG8_BAR; PG8_MMA(1, 1, At, B1); PG8_BAR;
            PG8_LDB(B0, 1, 0); PG8_SCHED; PG8_LDA(At, 1, 0); PG8_STAGE(PG8_SA(0, 1), a2 + hstepA, voffA);
            PG8_WAIT_L(8); PG8_BAR; PG8_WAIT_L(0); PG8_MMA(0, 0, At, B0); PG8_BAR; PG8_SCHED;
            PG8_LDB(B1, 1, 1); PG8_STAGE(PG8_SB(1, 0), b3, voffB);
            PG8_BAR; PG8_WAIT_L(0); PG8_MMA(0, 1, At, B1); PG8_BAR;
            PG8_LDA(At, 1, 1); PG8_STAGE(PG8_SA(1, 0), a3, voffA);
            PG8_BAR; PG8_WAIT_L(0); PG8_MMA(1, 0, At, B0); PG8_BAR; PG8_SCHED;
            PG8_STAGE(PG8_SB(1, 1), b3 + hstepB, voffB);
            PG8_WAIT_V(6); PG8_BAR; PG8_MMA(1, 1, At, B1); PG8_BAR;
            }
        }
        if constexpr (ALIGN_EPI) { if (wr == 0) PG8_BAR; }
        E(acc, cur, wr, wc, fr, fq);
        if (!has_next) break;
#pragma unroll
        for (int a = 0; a < 2; ++a)
#pragma unroll
            for (int b = 0; b < 2; ++b)
#pragma unroll
                for (int m = 0; m < 4; ++m)
#pragma unroll
                    for (int n = 0; n < 2; ++n) acc[a][b][m][n] = (f32x4){0.f, 0.f, 0.f, 0.f};
        cur = nxt; cA = nA; cB = nB; ++ui;
        if constexpr (ALIGN_EPI) { if (wr == 1) PG8_BAR; }
    }
    PG8_WAIT_V(0);
    if constexpr (!ALIGN_EPI) { if (wr == 0) PG8_BAR; }
    PG8_BAR;
#undef PG8_SA
#undef PG8_SB
#undef PG8_STAGE
#undef PG8_LDA
#undef PG8_LDB
#undef PG8_MMA
#undef PG8_WAIT_V
#undef PG8_WAIT_L
#undef PG8_BAR
#undef PG8_SCHED
}
}
using pg8::Unit;
using pg8::Gemm;
typedef f32x4 AccT[2][2][4][2];

#define XB_TMO      128
#define XB_XCNT(j)  (256  + 64 * (j))
#define XB_XSUB(j)  (1280 + 64 * (j))
#define XB_XGEN(j)  (2304 + 64 * (j))
#define XB_TOP      3328
#define XB_TOPGEN   3392
#define XCD_BAR_WORDS 3456
#define XB_SPIN_CAP (1u << 18)
__device__ __forceinline__ unsigned xb_ld(unsigned* p)              { return __hip_atomic_load(p, __ATOMIC_RELAXED, __HIP_MEMORY_SCOPE_AGENT); }
__device__ __forceinline__ unsigned xb_add(unsigned* p, unsigned v) { return __hip_atomic_fetch_add(p, v, __ATOMIC_RELAXED, __HIP_MEMORY_SCOPE_AGENT); }
__device__ __forceinline__ unsigned xb_xcc_id() { return (unsigned)__builtin_amdgcn_s_getreg((3 << 11) | 20) & 0xFu; }
#define XB_SPIN(cond, bar) do { unsigned _sp = 0; while (cond) { __builtin_amdgcn_s_sleep(1); \
    if ((++_sp & 255u) == 0u) { if (xb_ld(&(bar)[XB_TMO])) break; if (_sp > XB_SPIN_CAP) { atomicAdd(&(bar)[XB_TMO], 1u); break; } } } } while (0)
struct XcdBarrier { unsigned* bar; unsigned x; volatile LAS unsigned* st; };
__device__ __forceinline__ XcdBarrier xcd_barrier_post(unsigned* bar, volatile LAS unsigned* st) {
    XcdBarrier b; b.bar = bar; b.x = xb_xcc_id(); b.st = st;
    if (threadIdx.x == 0) (void)xb_add(&bar[XB_XCNT(b.x)], 1u);
    return b;
}
__device__ __forceinline__ void xcd_barrier_complete(unsigned* bar, unsigned x, unsigned& nloc, unsigned& nx) {
    const unsigned G = gridDim.x * gridDim.y * gridDim.z;
    unsigned sum, cnt, mine, sp = 0u;
    for (;;) {
        sum = 0u; cnt = 0u; mine = 0u;
#pragma unroll
        for (unsigned j = 0; j < 16; ++j) { const unsigned c = xb_ld(&bar[XB_XCNT(j)]); sum += c; cnt += (c > 0u) ? 1u : 0u; mine = (j == x) ? c : mine; }
        if (sum == G) break;
        __builtin_amdgcn_s_sleep(1);
        if ((++sp & 255u) == 0u) { if (xb_ld(&bar[XB_TMO])) break; if (sp > XB_SPIN_CAP) { atomicAdd(&bar[XB_TMO], 1u); break; } }
    }
    nloc = mine > 0u ? mine : 1u; nx = cnt > 0u ? cnt : 1u;
}
__device__ __forceinline__ void xcd_barrier(const XcdBarrier& b) {
    asm volatile("s_waitcnt vmcnt(0)" ::: "memory");
    __syncthreads();
    if (threadIdx.x == 0) {
        unsigned* bar = b.bar;
        __builtin_amdgcn_s_waitcnt(0);
        unsigned nloc = b.st[0], nx = b.st[1];
        if (nloc == 0u) { xcd_barrier_complete(bar, b.x, nloc, nx); b.st[0] = nloc; b.st[1] = nx; }
        const unsigned old = xb_add(&bar[XB_XSUB(b.x)], 1u);
        const unsigned gen = old / nloc;
        if (old + 1u == (gen + 1u) * nloc) {
            __builtin_amdgcn_fence(__ATOMIC_RELEASE, "agent");
            asm volatile("s_waitcnt vmcnt(0)" ::: "memory");
            const unsigned og = xb_add(&bar[XB_TOP], 1u);
            const unsigned tg = og / nx;
            if (og + 1u == (tg + 1u) * nx) xb_add(&bar[XB_TOPGEN], 1u);
            else XB_SPIN(xb_ld(&bar[XB_TOPGEN]) == tg, bar);
            __builtin_amdgcn_fence(__ATOMIC_ACQUIRE, "agent");
            xb_add(&bar[XB_XGEN(b.x)], 1u);
            asm volatile("s_waitcnt vmcnt(0)" ::: "memory");
        } else {
            XB_SPIN(xb_ld(&bar[XB_XGEN(b.x)]) == gen, bar);
            __builtin_amdgcn_fence(__ATOMIC_ACQUIRE, "agent");
            asm volatile("s_waitcnt vmcnt(0)" ::: "memory");
        }
    }
    __syncthreads();
}

struct Args { const float* in[34]; float* out; unsigned char* ws; int ph_lo, ph_hi; };
enum { I_X = 0, I_C, I_CTX, I_CCTX, I_WMOD, I_BMOD, I_WIN, I_BIN, I_GCONV, I_GALOG, I_GDT, I_GNORM, I_CDWW, I_CDWB, I_CLNG, I_CLNB, I_SLNG, I_SLNB, I_SWS, I_SBS,
       I_WBR, I_WOUT, I_BOUT, I_LN1G, I_LN1B, I_LN2G, I_LN2B, I_RGW, I_RGB, I_REW, I_REB, I_EWG, I_EWU, I_EWD };

struct SchedInA {
    int G, c; const char* xn; const char* w;
    __device__ __forceinline__ bool next(int i, Unit& u) const {
        const int L = i * G + c; const size_t tstep = (size_t)256 * 1024 * 2;
        if (L < 1152) { int pm, pn; pg8::map_tile(L, 72, 16, pm, pn); u.pm = pm; u.pn = pn; u.aux = 0; u.a = xn + (size_t)pm * tstep; u.b = w + (size_t)pn * tstep; return true; }
        if (L < 1440) { const int q = L - 1152, pm = 16 + (q & 3), pn = q >> 2; u.pm = pm; u.pn = pn; u.aux = 1; u.a = w + (size_t)pm * tstep; u.b = xn + (size_t)pn * tstep; return true; }
        return false;
    }
};
struct SchedGrid {
    int G, c, nM, nN; const char* a0; const char* b0; size_t astep, bstep;
    __device__ __forceinline__ bool next(int i, Unit& u) const {
        const int L = i * G + c; if (L >= nM * nN) return false;
        int pm, pn; pg8::map_tile(L, nM, nN, pm, pn); u.pm = pm; u.pn = pn; u.aux = 0; u.a = a0 + (size_t)pm * astep; u.b = b0 + (size_t)pn * bstep; return true;
    }
};
struct SchedFftLat {
    int G, c; const char* dft; const char* pf;
    __device__ __forceinline__ bool next(int i, Unit& u) const {
        const int L = i * G + c; if (L >= 128) return false;
        const int b = L >> 4, kt = (L >> 1) & 7, pn = L & 1;
        u.pm = b * 8 + kt; u.pn = pn; u.aux = 0; u.a = dft + (size_t)kt * (256 * 4096 * 2); u.b = pf + (size_t)b * (512 * 4096 * 2) + (size_t)pn * (256 * 4096 * 2); return true;
    }
};
struct SchedFftCtx {
    int G, c; const char* dft; const char* pf;
    __device__ __forceinline__ bool next(int i, Unit& u) const {
        const int L = i * G + (G - 1 - c); if (L >= 16) return false;
        const int b = L >> 1, pn = L & 1;
        u.pm = 64 + b; u.pn = pn; u.aux = 0; u.a = dft; u.b = pf + (size_t)b * (512 * 512 * 2) + (size_t)pn * (256 * 512 * 2); return true;
    }
};
struct SchedBranch {
    int G, c, nM; const char* br; const char* wbr;
    __device__ __forceinline__ bool next(int j, Unit& u) const {
        const int L = (j >> 2) * G + c; if (L >= nM * 4) return false;
        int pm, pn; pg8::map_tile(L, nM, 4, pm, pn); const int i = j & 3;
        u.pm = pm; u.pn = pn; u.aux = i; u.a = br + (size_t)i * ((size_t)NTOK * 512 * 2) + (size_t)pm * (256 * 512 * 2); u.b = wbr + (size_t)i * (1024 * 512 * 2) + (size_t)pn * (256 * 512 * 2); return true;
    }
};
struct SchedMoe {
    int G, c; unsigned pre[17]; const char* a0; const char* w0; size_t astep, wstep_e, wstep_n;
    __device__ __forceinline__ void init(const unsigned* cnt  ) {
        unsigned s = 0;
#pragma unroll
        for (int e = 0; e < 16; ++e) { pre[e] = s; s += ((unsigned)__builtin_amdgcn_readfirstlane((int)__hip_atomic_load(cnt + 64 * e, __ATOMIC_RELAXED, __HIP_MEMORY_SCOPE_AGENT)) + 255u) >> 8; }
        pre[16] = s;
    }
    __device__ __forceinline__ bool next(int i, Unit& u) const {
        const int L = i * G + c; if (L >= (int)pre[16] * 4) return false;
        const int jt = L >> 2, pn = L & 3; int e = 0;
#pragma unroll
        for (int k = 1; k < 16; ++k) e += ((unsigned)jt >= pre[k]) ? 1 : 0;
        u.pm = jt; u.pn = pn; u.aux = e; u.a = a0 + (size_t)jt * astep; u.b = w0 + (size_t)e * wstep_e + (size_t)pn * wstep_n; return true;
    }
};

struct EpiInA {
    static constexpr bool PERM = true;
    bf16 *pqkv, *pz, *pconf, *psgu, *pfft, *pfftc; const float* bias;
    __device__ __forceinline__ void operator()(const AccT& acc, const Unit& u, int wr, int wc, int fr, int fq) const {
        if (u.aux == 0) {
            const int row0 = u.pm * 256 + wr * 64 + fr, cb = wc * 32 + 8 * fq, bcol0 = u.pn * 256 + cb;
            f32x4 bv[2][2];
#pragma unroll
            for (int bj = 0; bj < 2; ++bj)
#pragma unroll
                for (int n = 0; n < 2; ++n) bv[bj][n] = *(const f32x4*)(bias + bcol0 + bj * 128 + 4 * n);
            if (u.pn < 8) {
                const bool isz = u.pn >= 6;
#pragma unroll
                for (int ai = 0; ai < 2; ++ai)
#pragma unroll
                    for (int m = 0; m < 4; ++m) { const int row = row0 + ai * 128 + m * 16;
                        bf16* rowp = isz ? (pz + (size_t)row * 512 + (u.pn - 6) * 256 + cb) : (pqkv + (size_t)row * 1536 + u.pn * 256 + cb);
#pragma unroll
                        for (int bj = 0; bj < 2; ++bj) { f32x4 v0 = acc[ai][bj][m][0] + bv[bj][0], v1 = acc[ai][bj][m][1] + bv[bj][1];
                            if (isz) {
#pragma unroll
                                for (int j = 0; j < 4; ++j) { v0[j] = siluf_(v0[j]); v1[j] = siluf_(v1[j]); } }
                            v4u w; w.x = pk2(v0[0], v0[1]); w.y = pk2(v0[2], v0[3]); w.z = pk2(v1[0], v1[1]); w.w = pk2(v1[2], v1[3]);
                            *(v4u*)(rowp + bj * 128) = w; } }
            } else if (u.pn < 12) {
#pragma unroll
                for (int ai = 0; ai < 2; ++ai)
#pragma unroll
                    for (int m = 0; m < 4; ++m) { const int row = row0 + ai * 128 + m * 16;
                        const f32x4 a0 = acc[ai][0][m][0] + bv[0][0], a1 = acc[ai][0][m][1] + bv[0][1], g0 = acc[ai][1][m][0] + bv[1][0], g1 = acc[ai][1][m][1] + bv[1][1];
                        float o[8];
#pragma unroll
                        for (int j = 0; j < 4; ++j) { o[j] = a0[j] * sigmoidf_(g0[j]); o[4 + j] = a1[j] * sigmoidf_(g1[j]); }
                        *(v4u*)(pconf + (size_t)row * 512 + (u.pn - 8) * 128 + cb) = pack8(o); }
            } else {
#pragma unroll
                for (int ai = 0; ai < 2; ++ai)
#pragma unroll
                    for (int m = 0; m < 4; ++m) { const int row = row0 + ai * 128 + m * 16;
                        bf16* rowp = psgu + (size_t)row * 1024 + (u.pn - 12) * 256 + cb;
#pragma unroll
                        for (int bj = 0; bj < 2; ++bj) { f32x4 v0 = acc[ai][bj][m][0] + bv[bj][0], v1 = acc[ai][bj][m][1] + bv[bj][1];
#pragma unroll
                            for (int j = 0; j < 4; ++j) { v0[j] = gelu_tanh(v0[j]); v1[j] = gelu_tanh(v1[j]); }
                            v4u w; w.x = pk2(v0[0], v0[1]); w.y = pk2(v0[2], v0[3]); w.z = pk2(v1[0], v1[1]); w.w = pk2(v1[2], v1[3]);
                            *(v4u*)(rowp + bj * 128) = w; } }
            }
        } else {
            const int jrow0 = (u.pm - 16) * 256 + wr * 64 + fr, tok0 = u.pn * 256 + wc * 32 + 8 * fq;
#pragma unroll
            for (int ai = 0; ai < 2; ++ai)
#pragma unroll
                for (int m = 0; m < 4; ++m) { const int jrow = jrow0 + ai * 128 + m * 16; const float bb = bias[4096 + jrow]; const int cs = jrow >> 9, rr = jrow & 511;
#pragma unroll
                    for (int bj = 0; bj < 2; ++bj) { const int tok = tok0 + bj * 128; bf16* dst;
                        if (tok < NLAT) { const int b = tok >> 11, t = tok & 2047; dst = pfft + ((size_t)(b * 512 + rr)) * 4096 + cs * 2048 + t; }
                        else { const int tc = tok - NLAT, b = tc >> 8, t = tc & 255; dst = pfftc + ((size_t)(b * 512 + rr)) * 512 + cs * 256 + t; }
                        const f32x4 v0 = acc[ai][bj][m][0] + bb, v1 = acc[ai][bj][m][1] + bb;
                        v4u w; w.x = pk2(v0[0], v0[1]); w.y = pk2(v0[2], v0[3]); w.z = pk2(v1[0], v1[1]); w.w = pk2(v1[2], v1[3]);
                        *(v4u*)dst = w; } }
        }
    }
};
template <int ACT  > struct EpiBf16 {
    static constexpr bool PERM = true;
    bf16* O; int ldc; const float* bias;
    __device__ __forceinline__ void operator()(const AccT& acc, const Unit& u, int wr, int wc, int fr, int fq) const {
        const int row0 = u.pm * 256 + wr * 64 + fr, col0 = u.pn * 256 + wc * 32 + 8 * fq;
        f32x4 bv[2][2];
#pragma unroll
        for (int bj = 0; bj < 2; ++bj)
#pragma unroll
            for (int n = 0; n < 2; ++n) bv[bj][n] = bias ? *(const f32x4*)(bias + col0 + bj * 128 + 4 * n) : (f32x4){0.f, 0.f, 0.f, 0.f};
#pragma unroll
        for (int ai = 0; ai < 2; ++ai)
#pragma unroll
            for (int m = 0; m < 4; ++m) { bf16* rowp = O + (size_t)(row0 + ai * 128 + m * 16) * ldc + col0;
#pragma unroll
                for (int bj = 0; bj < 2; ++bj) { f32x4 v0 = acc[ai][bj][m][0] + bv[bj][0], v1 = acc[ai][bj][m][1] + bv[bj][1];
                    if (ACT == 1) {
#pragma unroll
                        for (int j = 0; j < 4; ++j) { v0[j] = sigmoidf_(v0[j]); v1[j] = sigmoidf_(v1[j]); } }
                    v4u w; w.x = pk2(v0[0], v0[1]); w.y = pk2(v0[2], v0[3]); w.z = pk2(v1[0], v1[1]); w.w = pk2(v1[2], v1[3]);
                    *(v4u*)(rowp + bj * 128) = w; } }
    }
};
struct EpiF32 {
    static constexpr bool PERM = false;
    float* C; int ldc; const float* bias;
    __device__ __forceinline__ void operator()(const AccT& acc, const Unit& u, int wr, int wc, int fr, int fq) const {
        const int row0 = u.pm * 256 + wr * 64 + fr, col0 = u.pn * 256 + wc * 32 + 4 * fq;
        f32x4 bv[2][2];
#pragma unroll
        for (int bj = 0; bj < 2; ++bj)
#pragma unroll
            for (int n = 0; n < 2; ++n) bv[bj][n] = *(const f32x4*)(bias + col0 + bj * 128 + n * 16);
#pragma unroll
        for (int ai = 0; ai < 2; ++ai)
#pragma unroll
            for (int m = 0; m < 4; ++m) { float* rowp = C + (size_t)(row0 + ai * 128 + m * 16) * ldc + col0;
#pragma unroll
                for (int bj = 0; bj < 2; ++bj)
#pragma unroll
                    for (int n = 0; n < 2; ++n) *(f32x4*)(rowp + bj * 128 + n * 16) = acc[ai][bj][m][n] + bv[bj][n]; }
    }
};
struct EpiBranch {
    static constexpr bool PERM = false;
    float* merged; bf16* mbf; const bf16* gates;
    __device__ __forceinline__ void operator()(const AccT& acc, const Unit& u, int wr, int wc, int fr, int fq) const {
        const int row0 = u.pm * 256 + wr * 64 + fr, col0 = u.pn * 256 + wc * 32 + 4 * fq, i = u.aux;
#pragma unroll
        for (int ai = 0; ai < 2; ++ai)
#pragma unroll
            for (int m = 0; m < 4; ++m) { const size_t row = (size_t)(row0 + ai * 128 + m * 16);
#pragma unroll
                for (int bj = 0; bj < 2; ++bj)
#pragma unroll
                    for (int n = 0; n < 2; ++n) { const int col = col0 + bj * 128 + n * 16;
                        const v2u gw = *(const v2u*)(gates + row * 4096 + i * 1024 + col);
                        f32x4 v = acc[ai][bj][m][n]; v[0] *= bflo(gw.x); v[1] *= bfhi(gw.x); v[2] *= bflo(gw.y); v[3] *= bfhi(gw.y);
                        float* mp = merged + row * 1024 + col;
                        if (i > 0) v += *(const f32x4*)mp;
                        if (i < 3) *(f32x4*)mp = v;
                        else { v2u w; w.x = pk2(v[0], v[1]); w.y = pk2(v[2], v[3]); *(v2u*)(mbf + row * 1024 + col) = w; } } }
    }
};
struct EpiMoe1 {
    static constexpr bool PERM = true;
    bf16* hid;
    __device__ __forceinline__ void operator()(const AccT& acc, const Unit& u, int wr, int wc, int fr, int fq) const {
        const int row0 = u.pm * 256 + wr * 64 + fr, cb = wc * 32 + 8 * fq;
#pragma unroll
        for (int ai = 0; ai < 2; ++ai)
#pragma unroll
            for (int m = 0; m < 4; ++m) { const int row = row0 + ai * 128 + m * 16;
                const f32x4 g0 = acc[ai][0][m][0], g1 = acc[ai][0][m][1], u0 = acc[ai][1][m][0], u1 = acc[ai][1][m][1];
                float o[8];
#pragma unroll
                for (int j = 0; j < 4; ++j) { o[j] = siluf_(g0[j]) * u0[j]; o[4 + j] = siluf_(g1[j]) * u1[j]; }
                *(v4u*)(hid + (size_t)row * 512 + u.pn * 128 + cb) = pack8(o); }
    }
};

struct Ctx {
    LAS unsigned char* lds; int tid, lane, wave, G, bid;
};

__device__ __forceinline__ void cvt_tile(const Ctx& X, const float* src, int ld, int k0, bf16* dst, int Kp) {
    LAS float* tile = (LAS float*)X.lds;
#pragma unroll
    for (int i = 0; i < 8; ++i) { const int kk = (X.tid >> 6) + 8 * i, nn = X.tid & 63; tile[kk * 65 + nn] = src[(size_t)(k0 + kk) * ld + nn]; }
    __syncthreads();
    { const int n = X.tid >> 3, kc = X.tid & 7; float o[8];
#pragma unroll
      for (int j = 0; j < 8; ++j) o[j] = tile[(8 * kc + j) * 65 + n];
      *(v4u*)(dst + (size_t)n * Kp + k0 + 8 * kc) = pack8(o); }
    __syncthreads();
}

__device__ __forceinline__ void ln_rows(f32x4 (&v)[4]) {
    float s = 0.f;
#pragma unroll
    for (int j = 0; j < 4; ++j) s += (v[j][0] + v[j][1]) + (v[j][2] + v[j][3]);
    const float mean = wave_sum(s) * (1.f / D); float s2 = 0.f;
#pragma unroll
    for (int j = 0; j < 4; ++j) { v[j] = v[j] - mean; s2 += (v[j][0] * v[j][0] + v[j][1] * v[j][1]) + (v[j][2] * v[j][2] + v[j][3] * v[j][3]); }
    const float rstd = 1.0f / sqrtf(wave_sum(s2) * (1.f / D) + LN_EPS);
#pragma unroll
    for (int j = 0; j < 4; ++j) v[j] = v[j] * rstd;
}

#define PH_BEGIN() \
    int tid_l = threadIdx.x; asm volatile("" : "+v"(tid_l)); const int tid = tid_l, lane = tid & 63; \
    Ctx X; X.lds = lds; X.tid = tid; X.lane = lane; X.wave = __builtin_amdgcn_readfirstlane(tid >> 6); X.G = gridDim.x; X.bid = blockIdx.x; \
    const int gw = X.bid * NWAVES + X.wave, NGW = X.G * NWAVES; (void)gw; (void)NGW; \
    const __attribute__((address_space(4))) char* kp = (const __attribute__((address_space(4))) char*)__builtin_amdgcn_kernarg_segment_ptr(); asm volatile("" : "+s"(kp)); \
    unsigned char* const ws = *(unsigned char* const __attribute__((address_space(4)))*)(kp + 280); \
    float* const hlat = *(float* const __attribute__((address_space(4)))*)(kp + 272); (void)hlat; \
    float* const hctx = (float*)(ws + WS_HCTX); (void)hctx; \
    float* const modv = (float*)(ws + WS_MODV); (void)modv; \
    float* const binv = (float*)(ws + WS_BIN); (void)binv; \
    bf16* const XN = (bf16*)(ws + WS_XN); (void)XN; \
    bf16* const WIN = (bf16*)(ws + WS_WIN); (void)WIN; \
    bf16* const WBR = (bf16*)(ws + WS_WBR); (void)WBR; \
    bf16* const WOUT = (bf16*)(ws + WS_WOUT); (void)WOUT; \
    bf16* const DFTL = (bf16*)(ws + WS_DFTL); (void)DFTL; \
    bf16* const DFTC = (bf16*)(ws + WS_DFTC); (void)DFTC; \
    bf16* const PQKV = (bf16*)(ws + WS_PQKV); (void)PQKV; \
    bf16* const PCONF = (bf16*)(ws + WS_PCONF); (void)PCONF; \
    bf16* const PZ = (bf16*)(ws + WS_PZ); (void)PZ; \
    bf16* const PSGU = (bf16*)(ws + WS_PSGU); (void)PSGU; \
    bf16* const PFFT = (bf16*)(ws + WS_PFFT); (void)PFFT; \
    bf16* const PFFTC = (bf16*)(ws + WS_PFFTC); (void)PFFTC; \
    float* const AB = (float*)(ws + WS_AB); (void)AB; \
    float* const OF = (float*)(ws + WS_OF); (void)OF; \
    float* const OB = (float*)(ws + WS_OB); (void)OB; \
    bf16* const GT = (bf16*)(ws + WS_G); (void)GT; \
    bf16* const WGU = (bf16*)(ws + WS_WGU); (void)WGU; \
    bf16* const WDN = (bf16*)(ws + WS_WDN); (void)WDN; \
    bf16* const XG = (bf16*)(ws + WS_XG); (void)XG; \
    bf16* const QKV = (bf16*)(ws + WS_QKV); (void)QKV; \
    float* const GB = (float*)(ws + WS_GB); (void)GB; \
    bf16* const BR = (bf16*)(ws + WS_BR); (void)BR; \
    float* const MERGED = (float*)(ws + WS_MERGED); (void)MERGED; \
    float* const YB = (float*)(ws + WS_Y); (void)YB; \
    bf16* const HID = (bf16*)(ws + WS_HID); (void)HID; \
    bf16* const MO = (bf16*)(ws + WS_MO); (void)MO; \
    float* const ROUTE = (float*)(ws + WS_ROUTE); (void)ROUTE; \
    unsigned* const ctl = (unsigned*)(ws + WS_CTL); (void)ctl;
#define INP(i) (*(const float* const __attribute__((address_space(4)))*)(kp + 8 * (i)))
__global__ void __launch_bounds__(NWAVES * 64, 2) fwd(Args args) {
    extern __shared__ __attribute__((aligned(16))) unsigned char lds_raw[];
    LAS unsigned char* const lds = (LAS unsigned char*)lds_raw;
    volatile LAS unsigned* MISC = (volatile LAS unsigned*)(lds + MISC_OFF);
    for (int u = threadIdx.x; u < (LDS_BYTES - LDSCTL_OFF) / 4; u += NWAVES * 64) ((LAS unsigned*)(lds + LDSCTL_OFF))[u] = 0u;
    __syncthreads();
#if MK_ONE_LAUNCH
    XcdBarrier bar = xcd_barrier_post((unsigned*)(args.ws + WS_CTL) + CW_BAR, MISC + 8);
#define GRID_BAR() xcd_barrier(bar)
#else
#define GRID_BAR() do { } while (0)
#endif
    const int lo = args.ph_lo, hi = args.ph_hi;
#define IN(k) (lo <= (k) && (k) < hi)
#define SEAM(k) do { if (IN(k) && IN((k) + 1)) GRID_BAR(); } while (0)

    if (PH_ON(0) && IN(0)) { PH_BEGIN();
        for (int t = gw; t < SEQ; t += NGW) {
            const int prow = t >> 6, pcol = t & 63; f32x4 pe[4];
#pragma unroll
            for (int j = 0; j < 4; ++j)
#pragma unroll
                for (int e = 0; e < 4; ++e) { const int col = 4 * lane + 256 * j + e, part = col >> 9, within = col & 511, i = within & 255;
                    const float omega = 1.0f / powf(10000.0f, (float)i * (1.0f / 256.0f)); const float ang = (float)(part ? pcol : prow) * omega;
                    pe[j][e] = (within >> 8) ? cosf(ang) : sinf(ang); }
            for (int b = 0; b < NB; ++b) { const size_t off = ((size_t)b * SEQ + t) * D;
#pragma unroll
                for (int j = 0; j < 4; ++j) *(f32x4*)(hlat + off + 4 * lane + 256 * j) = *(const f32x4*)(INP(I_X) + off + 4 * lane + 256 * j) + pe[j]; }
        }
        for (int r = gw; r < NCTX; r += NGW) {
#pragma unroll
            for (int j = 0; j < 4; ++j) *(f32x4*)(hctx + (size_t)r * D + 4 * lane + 256 * j) = *(const f32x4*)(INP(I_CTX) + (size_t)r * D + 4 * lane + 256 * j);
        }
        for (int idx = X.bid * 512 + tid; idx < 2048 * 4096 / 8; idx += X.G * 512) {
            const int k = idx >> 9, j0 = (idx & 511) * 8; float o[8];
#pragma unroll
            for (int e = 0; e < 8; ++e) { const int j = j0 + e, t = j & 2047, a = (k * t) & 2047; float s, c; sincospif((float)a * (1.0f / 1024.0f), &s, &c);
                o[e] = (j < 2048 ? c : -s) * 0.022097086912079608f; }
            *(v4u*)(DFTL + (size_t)k * 4096 + j0) = pack8(o);
        }
        for (int idx = X.bid * 512 + tid; idx < 256 * 512 / 8; idx += X.G * 512) {
            const int k = idx >> 6, j0 = (idx & 63) * 8; float o[8];
#pragma unroll
            for (int e = 0; e < 8; ++e) { const int j = j0 + e, t = j & 255, a = (k * t) & 255; float s, c; sincospif((float)a * (1.0f / 128.0f), &s, &c);
                o[e] = (j < 256 ? c : -s) * 0.0625f; }
            *(v4u*)(DFTC + (size_t)k * 512 + j0) = pack8(o);
        }
        {
            LAS float* sc = (LAS float*)lds;
            LAS float* red = (LAS float*)(lds + 36864);
            for (int i = tid; i < 9 * 1024; i += 512) { const int r = i >> 10, k = i & 1023; const float c = r < 8 ? INP(I_C)[r * 1024 + k] : INP(I_CCTX)[k]; sc[i] = siluf_(c); }
            __syncthreads();
            for (int it = X.bid; it < 192; it += X.G) {
                const int l = it / 96, j = (it % 96) * 64 + lane; const float* W = INP(I_WMOD) + (size_t)l * 1024 * 6144 + j;
                float a[9];
#pragma unroll
                for (int r = 0; r < 9; ++r) a[r] = 0.f;
                const int kb = X.wave * 128;
                for (int k = 0; k < 128; ++k) { const float w = W[(size_t)(kb + k) * 6144];
#pragma unroll
                    for (int r = 0; r < 9; ++r) a[r] += sc[r * 1024 + kb + k] * w; }
#pragma unroll
                for (int r = 0; r < 9; ++r) red[(X.wave * 9 + r) * 64 + lane] = a[r];
                __syncthreads();
                for (int o = tid; o < 9 * 64; o += 512) { const int r = o >> 6, jj = o & 63; float s = 0.f;
#pragma unroll
                    for (int w = 0; w < 8; ++w) s += red[(w * 9 + r) * 64 + jj];
                    const int jc = (it % 96) * 64 + jj; modv[((size_t)l * 9 + r) * 6144 + jc] = s + INP(I_BMOD)[l * 6144 + jc]; }
                __syncthreads();
            }
        }
    }
    SEAM(0);

    for (int l = 0; l < 2; ++l) {
        const int pb = 1 + NPH_LAYER * l;
        const int nrows2 = (l == 1) ? NLAT : NTOK;
        const int npan2 = nrows2 / 256;

        if (PH_ON(1) && IN(pb + 0)) { PH_BEGIN(); const float* mv = modv + (size_t)l * 9 * 6144; (void)mv; unsigned* const moecnt = ctl + CW_MOE + l * 16 * 64; (void)moecnt;
            const float* win = INP(I_WIN) + (size_t)l * 1024 * N_IN;
            const float* bin = INP(I_BIN) + (size_t)l * N_IN;
            for (int it = X.bid; it < 144 * 16; it += X.G) {
                const int rb = it >> 4, kb = it & 15, row0 = rb * 64; int col;
                if (row0 >= 4096 && row0 < 5120) continue;
                if (row0 < 2048) col = row0;
                else if (row0 < 3072) { const int q = row0 - 2048, j = q >> 8, w = q & 255; col = OFF_CONF + (w >= 128 ? 512 : 0) + 128 * j + (w & 127); }
                else if (row0 < 4096) col = OFF_SGU + (row0 - 3072);
                else col = OFF_GATE + (row0 - 5120);
                cvt_tile(X, win + col, N_IN, kb * 64, WIN + (size_t)row0 * 1024, 1024);
            }
            for (int it = X.bid; it < 64; it += X.G) {
                const int kb = it >> 2, g = it & 3; LAS float* Wt = (LAS float*)lds; LAS float* ct = (LAS float*)(lds + 32768); LAS float* st = ct + 128;
                for (int i = tid; i < 64 * 128; i += 512) { const int kk = i >> 7, c = i & 127; Wt[i] = win[(size_t)(kb * 64 + kk) * N_IN + OFF_FFT + g * 128 + c]; }
                if (tid < 128) { float s, c; sincospif((float)tid * (1.0f / 64.0f), &s, &c); ct[tid] = c * 0.08838834764831845f; st[tid] = s * 0.08838834764831845f; }
                __syncthreads();
                const int m = tid & 127, ks = tid >> 7; float oc[16], os[16];
#pragma unroll
                for (int kk = 0; kk < 16; ++kk) { oc[kk] = 0.f; os[kk] = 0.f; }
#pragma unroll 1
                for (int c = 0; c < 128; ++c) { const int a = (m * c) & 127; const float cv = ct[a], sv = st[a];
#pragma unroll
                    for (int kk = 0; kk < 16; ++kk) { const float w = Wt[(ks * 16 + kk) * 128 + c]; oc[kk] += w * cv; os[kk] += w * sv; } }
                bf16* dc = WIN + (size_t)(4096 + g * 128 + m) * 1024 + kb * 64 + ks * 16; bf16* dsn = dc + (size_t)512 * 1024;
                { float o[8];
#pragma unroll
                  for (int h2 = 0; h2 < 2; ++h2) {
#pragma unroll
                    for (int e = 0; e < 8; ++e) o[e] = oc[h2 * 8 + e];
                    *(v4u*)(dc + h2 * 8) = pack8(o);
#pragma unroll
                    for (int e = 0; e < 8; ++e) o[e] = os[h2 * 8 + e];
                    *(v4u*)(dsn + h2 * 8) = pack8(o); } }
                __syncthreads();
            }
            for (int r = X.bid * 512 + tid; r < NWROWS; r += X.G * 512) {
                float v;
                if (r < 2048) v = bin[r];
                else if (r < 3072) { const int q = r - 2048, j = q >> 8, w = q & 255; v = bin[OFF_CONF + (w >= 128 ? 512 : 0) + 128 * j + (w & 127)]; }
                else if (r < 4096) v = bin[OFF_SGU + (r - 3072)];
                else if (r < 5120) { const int q = r - 4096, cs = q >> 9, g = (q >> 7) & 3, m = q & 127; float s = 0.f;
                    for (int c = 0; c < 128; ++c) { float sn, cn; sincospif((float)((m * c) & 127) * (1.0f / 64.0f), &sn, &cn); s += bin[OFF_FFT + g * 128 + c] * (cs ? sn : cn); }
                    v = s * 0.08838834764831845f; }
                else v = bin[OFF_GATE + (r - 5120)];
                binv[r] = v;
            }
            for (int it = X.bid; it < 4 * 16 * 8; it += X.G) { const int i = it >> 7, nb = (it >> 3) & 15, kb = it & 7;
                cvt_tile(X, INP(I_WBR) + ((size_t)(l * 4 + i) * 512) * 1024 + nb * 64, 1024, kb * 64, WBR + ((size_t)i * 1024 + nb * 64) * 512, 512); }
            for (int it = X.bid; it < 16 * 16; it += X.G) { const int nb = it >> 4, kb = it & 15;
                cvt_tile(X, INP(I_WOUT) + (size_t)l * 1024 * 1024 + nb * 64, 1024, kb * 64, WOUT + (size_t)nb * 64 * 1024, 1024); }
            LAS float* wab = (LAS float*)lds;
            __syncthreads();
            for (int i = tid; i < 16 * 1024; i += 512) { const int o = i >> 10, k = i & 1023; wab[i] = win[(size_t)k * N_IN + OFF_A + o]; }
            __syncthreads();
            for (int row = gw; row < NTOK; row += NGW) {
                const float* hrow = row < NLAT ? hlat + (size_t)row * D : hctx + (size_t)(row - NLAT) * D;
                const int mi = row < NLAT ? (row >> 11) : 8; const float* shift = mv + mi * 6144, *scale = shift + 1024;
                f32x4 v[4];
#pragma unroll
                for (int j = 0; j < 4; ++j) v[j] = *(const f32x4*)(hrow + 4 * lane + 256 * j);
                ln_rows(v);
#pragma unroll
                for (int j = 0; j < 4; ++j) { const f32x4 sc = *(const f32x4*)(scale + 4 * lane + 256 * j), sh = *(const f32x4*)(shift + 4 * lane + 256 * j); v[j] = v[j] * (sc + 1.0f) + sh;
                    v2u w; w.x = pk2(v[j][0], v[j][1]); w.y = pk2(v[j][2], v[j][3]); *(v2u*)(XN + (size_t)row * D + 4 * lane + 256 * j) = w; }
                float myv = 0.f;
#pragma unroll 2
                for (int o = 0; o < 16; ++o) { float s = 0.f;
#pragma unroll
                    for (int j = 0; j < 4; ++j) { const f32x4 w = *(const LAS f32x4*)(wab + o * 1024 + 4 * lane + 256 * j); s += (v[j][0] * w[0] + v[j][1] * w[1]) + (v[j][2] * w[2] + v[j][3] * w[3]); }
                    s = wave_sum(s); if (lane == o) myv = s; }
                if (lane < 16) AB[(size_t)row * 16 + lane] = myv + bin[OFF_A + lane];
            }
        }
        SEAM(pb + 0);

        if (PH_ON(2) && IN(pb + 1)) { PH_BEGIN(); const float* mv = modv + (size_t)l * 9 * 6144; (void)mv; unsigned* const moecnt = ctl + CW_MOE + l * 16 * 64; (void)moecnt;
            SchedInA S{X.G, X.bid, (const char*)XN, (const char*)WIN};
            EpiInA E{PQKV, PZ, PCONF, PSGU, PFFT, PFFTC, binv};
            pg8::gemm_phase<EpiInA, SchedInA, true, true>(lds, Gemm{1024, 1024, 1024}, S, E);
        }
        SEAM(pb + 1);

        if (PH_ON(3) && IN(pb + 2)) { PH_BEGIN(); const float* mv = modv + (size_t)l * 9 * 6144; (void)mv; unsigned* const moecnt = ctl + CW_MOE + l * 16 * 64; (void)moecnt;
            if (CPART & 1) {
            { SchedFftLat S{X.G, X.bid, (const char*)DFTL, (const char*)PFFT}; EpiBf16<0> E{BR + (size_t)2 * NTOK * 512, 512, nullptr};
              pg8::gemm_phase<EpiBf16<0>, SchedFftLat, true, true>(lds, Gemm{4096, 4096, 4096}, S, E); }
            { SchedFftCtx S{X.G, X.bid, (const char*)DFTC, (const char*)PFFTC}; EpiBf16<0> E{BR + (size_t)2 * NTOK * 512, 512, nullptr};
              pg8::gemm_phase<EpiBf16<0>, SchedFftCtx, true, true>(lds, Gemm{512, 512, 512}, S, E); }
            __syncthreads();
            }
            if (CPART & 2) {
                const float* cw = INP(I_GCONV) + (size_t)l * 5 * 1536;
                for (int row = gw; row < NTOK; row += NGW) {
                    int t, T; if (row < NLAT) { t = row & 2047; T = 2048; } else { t = (row - NLAT) & 255; T = 256; }
#pragma unroll 1
                    for (int seg = 0; seg < 3; ++seg) { const int ch = seg * 512 + 8 * lane; float a[8];
#pragma unroll
                        for (int e = 0; e < 8; ++e) a[e] = 0.f;
#pragma unroll
                        for (int j = 0; j < 5; ++j) { const int tt = t + j - 2; if (tt >= 0 && tt < T) { float xv[8]; unpack8(*(const v4u*)(PQKV + (size_t)(row + j - 2) * 1536 + ch), xv);
                            const f32x4 w0 = *(const f32x4*)(cw + j * 1536 + ch), w1 = *(const f32x4*)(cw + j * 1536 + ch + 4);
#pragma unroll
                            for (int e = 0; e < 4; ++e) { a[e] += w0[e] * xv[e]; a[4 + e] += w1[e] * xv[4 + e]; } } }
                        float ss = 0.f;
#pragma unroll
                        for (int e = 0; e < 8; ++e) { a[e] = siluf_(a[e]); ss += a[e] * a[e]; }
                        if (seg < 2) { ss = g16_sum(ss); const float sc = (1.0f / sqrtf(ss + LN_EPS)) * (seg == 0 ? 0.08838834764831845f : 1.0f);
#pragma unroll
                            for (int e = 0; e < 8; ++e) a[e] *= sc; }
                        *(v4u*)(QKV + (size_t)row * 1536 + ch) = pack8(a); }
                    if (lane < 8) { const float av = AB[(size_t)row * 16 + lane], bv = AB[(size_t)row * 16 + 8 + lane];
                        const float xs = av + INP(I_GDT)[l * 8 + lane]; const float sp = xs > 20.f ? xs : log1pf(expf(xs));
                        GB[(size_t)row * 16 + lane] = -expf(INP(I_GALOG)[l * 8 + lane]) * sp; GB[(size_t)row * 16 + 8 + lane] = 1.0f / (1.0f + expf(-bv)); }
                }
            }
            if (CPART & 4) {
                const float* dw = INP(I_CDWW) + (size_t)l * 31 * 512; const float* dwb = INP(I_CDWB) + l * 512, *lg = INP(I_CLNG) + l * 512, *lb = INP(I_CLNB) + l * 512;
                bf16* B1 = BR + (size_t)1 * NTOK * 512; const int ch = 8 * lane;
                for (int row = gw; row < nrows2; row += NGW) {
                    int t, T; if (row < NLAT) { t = row & 2047; T = 2048; } else { t = (row - NLAT) & 255; T = 256; }
                    float a[8];
#pragma unroll
                    for (int e = 0; e < 8; ++e) a[e] = dwb[ch + e];
#pragma unroll 4
                    for (int j = 0; j < 31; ++j) { const int tt = t + j - 15; if (tt >= 0 && tt < T) { float xv[8]; unpack8(*(const v4u*)(PCONF + (size_t)(row + j - 15) * 512 + ch), xv);
                        const f32x4 w0 = *(const f32x4*)(dw + j * 512 + ch), w1 = *(const f32x4*)(dw + j * 512 + ch + 4);
#pragma unroll
                        for (int e = 0; e < 4; ++e) { a[e] += w0[e] * xv[e]; a[4 + e] += w1[e] * xv[4 + e]; } } }
                    float s = 0.f;
#pragma unroll
                    for (int e = 0; e < 8; ++e) s += a[e];
                    const float mean = g16_sum(s) * (1.0f / 128.0f); float s2 = 0.f;
#pragma unroll
                    for (int e = 0; e < 8; ++e) { a[e] -= mean; s2 += a[e] * a[e]; }
                    const float rstd = 1.0f / sqrtf(g16_sum(s2) * (1.0f / 128.0f) + LN_EPS);
#pragma unroll
                    for (int e = 0; e < 8; ++e) a[e] = siluf_(a[e] * rstd * lg[ch + e] + lb[ch + e]);
                    *(v4u*)(B1 + (size_t)row * 512 + ch) = pack8(a);
                }
            }
            if (CPART & 8) {
                LAS float* vn = (LAS float*)lds; LAS float* wsg = (LAS float*)(lds + 65536);
                const float* lg = INP(I_SLNG) + l * 512, *lb = INP(I_SLNB) + l * 512;
                bf16* B3 = BR + (size_t)3 * NTOK * 512;
                const int nitems = (nrows2 / 128) * 4;
                __syncthreads();
                for (int it = X.bid; it < nitems; it += X.G) {
                    const int chunk = it >> 2, g = it & 3, r0 = chunk * 128;
                    const float* wsrc = INP(I_SWS) + ((size_t)(l * 4 + g)) * 128 * 128;
                    for (int i = tid; i < 128 * 128 / 4; i += 512) *(LAS f32x4*)(wsg + 4 * i) = *(const f32x4*)(wsrc + 4 * i);
                    for (int q = X.wave; q < 128; q += 8) { const unsigned w = *(const unsigned*)(PSGU + (size_t)(r0 + q) * 1024 + 512 + g * 128 + 2 * lane);
                        float v0 = bflo(w), v1 = bfhi(w); const float mean = wave_sum(v0 + v1) * (1.0f / 128.0f); v0 -= mean; v1 -= mean;
                        const float rstd = 1.0f / sqrtf(wave_sum(v0 * v0 + v1 * v1) * (1.0f / 128.0f) + LN_EPS);
                        const int c = g * 128 + 2 * lane; vn[q * 128 + 2 * lane] = v0 * rstd * lg[c] + lb[c]; vn[q * 128 + 2 * lane + 1] = v1 * rstd * lg[c + 1] + lb[c + 1]; }
                    __syncthreads();
                    const int c4 = (tid & 31) * 4, pblk = tid >> 5; f32x4 acc[8];
#pragma unroll
                    for (int i = 0; i < 8; ++i) acc[i] = (f32x4){0.f, 0.f, 0.f, 0.f};
                    for (int q = 0; q < 128; q += 4) {
                        f32x4 vq[4];
#pragma unroll
                        for (int qq = 0; qq < 4; ++qq) vq[qq] = *(const LAS f32x4*)(vn + (q + qq) * 128 + c4);
#pragma unroll
                        for (int i = 0; i < 8; ++i) { const f32x4 w = *(const LAS f32x4*)(wsg + (pblk * 8 + i) * 128 + q);
                            acc[i] += vq[0] * w[0]; acc[i] += vq[1] * w[1]; acc[i] += vq[2] * w[2]; acc[i] += vq[3] * w[3]; }
                    }
#pragma unroll
                    for (int i = 0; i < 8; ++i) { const int p = pblk * 8 + i; const float bs = INP(I_SBS)[(l * 4 + g) * 128 + p];
                        const v2u uw = *(const v2u*)(PSGU + (size_t)(r0 + p) * 1024 + g * 128 + c4);
                        v2u o; o.x = pk2(bflo(uw.x) * (acc[i][0] + bs), bfhi(uw.x) * (acc[i][1] + bs)); o.y = pk2(bflo(uw.y) * (acc[i][2] + bs), bfhi(uw.y) * (acc[i][3] + bs));
                        *(v2u*)(B3 + (size_t)(r0 + p) * 512 + g * 128 + c4) = o; }
                    __syncthreads();
                }
            }
        }
        SEAM(pb + 2);

        if (PH_ON(4) && IN(pb + 3)) { PH_BEGIN(); const float* mv = modv + (size_t)l * 9 * 6144; (void)mv; unsigned* const moecnt = ctl + CW_MOE + l * 16 * 64; (void)moecnt;
            if (X.wave < 4) {
                for (int item = X.bid * 4 + X.wave; item < 1024; item += X.G * 4) {
                    const int chain = item >> 4, slice = item & 15, b = chain >> 3, hh = (chain >> 1) & 3, dir = chain & 1;
                    const int ig = lane >> 3, jj = lane & 7;
                    float* const O = dir ? OB : OF;
                    float S[16];
#pragma unroll
                    for (int i = 0; i < 16; ++i) S[i] = 0.f;
                    for (int st = 0; st < 2; ++st) {
                        const int T = st == 0 ? CTXL : SEQ, rbase = st == 0 ? NLAT + b * CTXL : b * SEQ;
                        v4u kq[4]; float vv, gg, bb;
                        { const int row = rbase + (dir ? T - 1 : 0); const bf16* p = QKV + (size_t)row * 1536 + hh * 128;
                          kq[0] = *(const v4u*)(p + 512 + ig * 16); kq[1] = *(const v4u*)(p + 512 + ig * 16 + 8); kq[2] = *(const v4u*)(p + ig * 16); kq[3] = *(const v4u*)(p + ig * 16 + 8);
                          vv = bf1(p[1024 + slice * 8 + jj]); gg = GB[(size_t)row * 16 + dir * 4 + hh]; bb = GB[(size_t)row * 16 + 8 + dir * 4 + hh]; }
                        for (int step = 0; step < T; ++step) {
                            const int row = rbase + (dir ? T - 1 - step : step);
                            v4u nkq[4]; float nv = 0.f, ng = 0.f, nb = 0.f;
                            nkq[0] = kq[0]; nkq[1] = kq[1]; nkq[2] = kq[2]; nkq[3] = kq[3];
                            if (step + 1 < T) { const int nrow = rbase + (dir ? T - 2 - step : step + 1); const bf16* p = QKV + (size_t)nrow * 1536 + hh * 128;
                                nkq[0] = *(const v4u*)(p + 512 + ig * 16); nkq[1] = *(const v4u*)(p + 512 + ig * 16 + 8); nkq[2] = *(const v4u*)(p + ig * 16); nkq[3] = *(const v4u*)(p + ig * 16 + 8);
                                nv = bf1(p[1024 + slice * 8 + jj]); ng = GB[(size_t)nrow * 16 + dir * 4 + hh]; nb = GB[(size_t)nrow * 16 + 8 + dir * 4 + hh]; }
                            float kk[16], qq[16]; { float t8[8]; unpack8(kq[0], t8);
#pragma unroll
                                for (int e = 0; e < 8; ++e) kk[e] = t8[e];
                                unpack8(kq[1], t8);
#pragma unroll
                                for (int e = 0; e < 8; ++e) kk[8 + e] = t8[e];
                                unpack8(kq[2], t8);
#pragma unroll
                                for (int e = 0; e < 8; ++e) qq[e] = t8[e];
                                unpack8(kq[3], t8);
#pragma unroll
                                for (int e = 0; e < 8; ++e) qq[8 + e] = t8[e]; }
                            const float eg = expf(gg); float r0 = 0.f, r1 = 0.f;
#pragma unroll
                            for (int i = 0; i < 16; i += 2) { S[i] *= eg; S[i + 1] *= eg; r0 += kk[i] * S[i]; r1 += kk[i + 1] * S[i + 1]; }
                            float r = r0 + r1; r += __shfl_xor(r, 8); r += __shfl_xor(r, 16); r += __shfl_xor(r, 32);
                            const float vn = bb * (vv - r); float o0 = 0.f, o1 = 0.f;
#pragma unroll
                            for (int i = 0; i < 16; i += 2) { S[i] += kk[i] * vn; S[i + 1] += kk[i + 1] * vn; o0 += qq[i] * S[i]; o1 += qq[i + 1] * S[i + 1]; }
                            float o = o0 + o1; o += __shfl_xor(o, 8); o += __shfl_xor(o, 16); o += __shfl_xor(o, 32);
                            if (ig == 0) O[(size_t)row * 512 + hh * 128 + slice * 8 + jj] = o;
                            kq[0] = nkq[0]; kq[1] = nkq[1]; kq[2] = nkq[2]; kq[3] = nkq[3]; vv = nv; gg = ng; bb = nb;
                        }
                    }
                }
            }
        }
        SEAM(pb + 3);

        if (PH_ON(5) && IN(pb + 4)) { PH_BEGIN(); const float* mv = modv + (size_t)l * 9 * 6144; (void)mv; unsigned* const moecnt = ctl + CW_MOE + l * 16 * 64; (void)moecnt;
            const float* nw = INP(I_GNORM) + l * 128; const int ch = 8 * lane;
            for (int row = gw; row < nrows2; row += NGW) {
                const f32x4 a0 = *(const f32x4*)(OF + (size_t)row * 512 + ch) + *(const f32x4*)(OB + (size_t)row * 512 + ch);
                const f32x4 a1 = *(const f32x4*)(OF + (size_t)row * 512 + ch + 4) + *(const f32x4*)(OB + (size_t)row * 512 + ch + 4);
                float ss = (a0[0] * a0[0] + a0[1] * a0[1]) + (a0[2] * a0[2] + a0[3] * a0[3]) + (a1[0] * a1[0] + a1[1] * a1[1]) + (a1[2] * a1[2] + a1[3] * a1[3]);
                const float rs = 1.0f / sqrtf(g16_sum(ss) * (1.0f / 128.0f) + LN_EPS);
                float z[8]; unpack8(*(const v4u*)(PZ + (size_t)row * 512 + ch), z); float o[8];
#pragma unroll
                for (int e = 0; e < 4; ++e) { o[e] = a0[e] * rs * nw[(ch & 127) + e] * z[e]; o[4 + e] = a1[e] * rs * nw[(ch & 127) + 4 + e] * z[4 + e]; }
                *(v4u*)(BR + (size_t)row * 512 + ch) = pack8(o);
            }
        }
        SEAM(pb + 4);

        if (PH_ON(6) && IN(pb + 5)) { PH_BEGIN(); const float* mv = modv + (size_t)l * 9 * 6144; (void)mv; unsigned* const moecnt = ctl + CW_MOE + l * 16 * 64; (void)moecnt;
            SchedGrid S{X.G, X.bid, npan2, 16, (const char*)XN, (const char*)(WIN + (size_t)5120 * 1024), (size_t)256 * 1024 * 2, (size_t)256 * 1024 * 2};
            EpiBf16<1> E{GT, 4096, binv + 5120};
            pg8::gemm_phase<EpiBf16<1>, SchedGrid, true, true>(lds, Gemm{1024, 1024, 1024}, S, E);
        }
        SEAM(pb + 5);

        if (PH_ON(7) && IN(pb + 6)) { PH_BEGIN(); const float* mv = modv + (size_t)l * 9 * 6144; (void)mv; unsigned* const moecnt = ctl + CW_MOE + l * 16 * 64; (void)moecnt;
            SchedBranch S{X.G, X.bid, npan2, (const char*)BR, (const char*)WBR};
            EpiBranch E{MERGED, XN, GT};
            pg8::gemm_phase<EpiBranch, SchedBranch, true, true>(lds, Gemm{512, 512, 512}, S, E);
        }
        SEAM(pb + 6);

        if (PH_ON(8) && IN(pb + 7)) { PH_BEGIN(); const float* mv = modv + (size_t)l * 9 * 6144; (void)mv; unsigned* const moecnt = ctl + CW_MOE + l * 16 * 64; (void)moecnt;
            SchedGrid S{X.G, X.bid, npan2, 4, (const char*)XN, (const char*)WOUT, (size_t)256 * 1024 * 2, (size_t)256 * 1024 * 2};
            EpiF32 E{YB, 1024, INP(I_BOUT) + l * 1024};
            pg8::gemm_phase<EpiF32, SchedGrid, true, true>(lds, Gemm{1024, 1024, 1024}, S, E);
        }
        SEAM(pb + 7);

        if (PH_ON(9) && IN(pb + 8)) { PH_BEGIN(); const float* mv = modv + (size_t)l * 9 * 6144; (void)mv; unsigned* const moecnt = ctl + CW_MOE + l * 16 * 64; (void)moecnt;
            for (int it = X.bid; it < 16 * 16 * 16; it += X.G) { const int e = it >> 8, rb = (it >> 4) & 15, kb = it & 15, row0 = rb * 64, j = row0 >> 8, w = row0 & 255;
                const float* src = (w < 128 ? INP(I_EWG) : INP(I_EWU)) + ((size_t)(l * 16 + e) * 1024) * 512 + 128 * j + (w & 127);
                cvt_tile(X, src, 512, kb * 64, WGU + ((size_t)e * 1024 + row0) * 1024, 1024); }
            for (int it = X.bid; it < 16 * 16 * 8; it += X.G) { const int e = it >> 7, rb = (it >> 3) & 15, kb = it & 7;
                cvt_tile(X, INP(I_EWD) + ((size_t)(l * 16 + e) * 512) * 1024 + rb * 64, 1024, kb * 64, WDN + ((size_t)e * 1024 + rb * 64) * 512, 512); }
            LAS float* wr_ = (LAS float*)lds;
            __syncthreads();
            for (int i = tid; i < 20 * 1024; i += 512) { const int o = i >> 10, k = i & 1023; wr_[i] = o < 4 ? INP(I_RGW)[(size_t)l * 4096 + k * 4 + o] : INP(I_REW)[(size_t)l * 16384 + k * 16 + (o - 4)]; }
            __syncthreads();
            const float* g1 = INP(I_LN1G) + l * 1024, *b1 = INP(I_LN1B) + l * 1024;
            for (int row = gw; row < nrows2; row += NGW) {
                float* hrow = row < NLAT ? hlat + (size_t)row * D : hctx + (size_t)(row - NLAT) * D;
                const int mi = row < NLAT ? (row >> 11) : 8; const float* mrow = mv + mi * 6144;
                f32x4 v[4];
#pragma unroll
                for (int j = 0; j < 4; ++j) { const int c = 4 * lane + 256 * j; v[j] = *(const f32x4*)(hrow + c) * DN_ALPHA + *(const f32x4*)(mrow + 2048 + c) * *(const f32x4*)(YB + (size_t)row * D + c); }
                ln_rows(v);
#pragma unroll
                for (int j = 0; j < 4; ++j) { const int c = 4 * lane + 256 * j; v[j] = v[j] * *(const f32x4*)(g1 + c) + *(const f32x4*)(b1 + c); *(f32x4*)(hrow + c) = v[j]; }
                ln_rows(v);
#pragma unroll
                for (int j = 0; j < 4; ++j) { const int c = 4 * lane + 256 * j; v[j] = v[j] * (*(const f32x4*)(mrow + 4096 + c) + 1.0f) + *(const f32x4*)(mrow + 3072 + c);
                    v2u w; w.x = pk2(v[j][0], v[j][1]); w.y = pk2(v[j][2], v[j][3]); *(v2u*)(XN + (size_t)row * D + c) = w; }
                float mylg = 0.f;
#pragma unroll 2
                for (int o = 0; o < 20; ++o) { float s = 0.f;
#pragma unroll
                    for (int j = 0; j < 4; ++j) { const f32x4 w = *(const LAS f32x4*)(wr_ + o * 1024 + 4 * lane + 256 * j); s += (v[j][0] * w[0] + v[j][1] * w[1]) + (v[j][2] * w[2] + v[j][3] * w[3]); }
                    s = wave_sum(s); if (lane == o) mylg = s; }
                if (lane < 20) mylg += (lane < 4 ? INP(I_RGB)[l * 4 + lane] : INP(I_REB)[l * 16 + lane - 4]);
                float lg[20];
#pragma unroll
                for (int o = 0; o < 20; ++o) lg[o] = __shfl(mylg, o);
                int gs = 0; float gm = lg[0];
#pragma unroll
                for (int o = 1; o < 4; ++o) if (lg[o] > gm) { gm = lg[o]; gs = o; }
                float den = 0.f;
#pragma unroll
                for (int o = 0; o < 4; ++o) den += expf(lg[o] - gm);
                const float gp = 1.0f / den;
                float el[4];
#pragma unroll
                for (int o = 0; o < 4; ++o) el[o] = gs == 0 ? lg[4 + o] : gs == 1 ? lg[8 + o] : gs == 2 ? lg[12 + o] : lg[16 + o];
                int i0 = 0; float v0 = el[0];
#pragma unroll
                for (int o = 1; o < 4; ++o) if (el[o] > v0) { v0 = el[o]; i0 = o; }
                int i1 = -1; float v1 = 0.f;
#pragma unroll
                for (int o = 0; o < 4; ++o) if (o != i0 && (i1 < 0 || el[o] > v1)) { v1 = el[o]; i1 = o; }
                const float ex = expf(v1 - v0), w0 = gp / (1.0f + ex), w1 = gp * ex / (1.0f + ex);
                const int e0 = gs * 4 + i0, e1 = gs * 4 + i1;
                if (lane == 0) {
                    const unsigned p0 = __hip_atomic_fetch_add(moecnt + 64 * e0, 1u, __ATOMIC_RELAXED, __HIP_MEMORY_SCOPE_AGENT);
                    const unsigned p1 = __hip_atomic_fetch_add(moecnt + 64 * e1, 1u, __ATOMIC_RELAXED, __HIP_MEMORY_SCOPE_AGENT);
                    float* rt = ROUTE + (size_t)row * 8;
                    rt[0] = __builtin_bit_cast(float, e0); rt[1] = __builtin_bit_cast(float, e1); rt[2] = w0; rt[3] = w1; rt[4] = __builtin_bit_cast(float, (int)p0); rt[5] = __builtin_bit_cast(float, (int)p1);
                }
            }
        }
        SEAM(pb + 8);

        if (PH_ON(10) && IN(pb + 9)) { PH_BEGIN(); const float* mv = modv + (size_t)l * 9 * 6144; (void)mv; unsigned* const moecnt = ctl + CW_MOE + l * 16 * 64; (void)moecnt;
            unsigned pre[16]; { unsigned s = 0;
#pragma unroll
                for (int e = 0; e < 16; ++e) { pre[e] = s; s += ((__hip_atomic_load(moecnt + 64 * e, __ATOMIC_RELAXED, __HIP_MEMORY_SCOPE_AGENT) + 255u) >> 8) << 8; } }
            for (int as = gw; as < nrows2 * 2; as += NGW) { const int row = as >> 1, sl = as & 1; const float* rt = ROUTE + (size_t)row * 8;
                const int e = __builtin_bit_cast(int, rt[sl]), p = __builtin_bit_cast(int, rt[4 + sl]); unsigned base = 0;
#pragma unroll
                for (int k = 0; k < 16; ++k) base = (k == e) ? pre[k] : base;
                const size_t dst = (size_t)(base + (unsigned)p) * D;
#pragma unroll
                for (int j = 0; j < 2; ++j) *(v4u*)(XG + dst + 8 * lane + 512 * j) = *(const v4u*)(XN + (size_t)row * D + 8 * lane + 512 * j);
            }
        }
        SEAM(pb + 9);

        if (PH_ON(11) && IN(pb + 10)) { PH_BEGIN(); const float* mv = modv + (size_t)l * 9 * 6144; (void)mv; unsigned* const moecnt = ctl + CW_MOE + l * 16 * 64; (void)moecnt;
            SchedMoe S; S.G = X.G; S.c = X.bid; S.a0 = (const char*)XG; S.w0 = (const char*)WGU; S.astep = (size_t)256 * 1024 * 2; S.wstep_e = (size_t)1024 * 1024 * 2; S.wstep_n = (size_t)256 * 1024 * 2; S.init(moecnt);
            EpiMoe1 E{HID};
            pg8::gemm_phase<EpiMoe1, SchedMoe, true, true>(lds, Gemm{1024, 1024, 1024}, S, E);
        }
        SEAM(pb + 10);

        if (PH_ON(12) && IN(pb + 11)) { PH_BEGIN(); const float* mv = modv + (size_t)l * 9 * 6144; (void)mv; unsigned* const moecnt = ctl + CW_MOE + l * 16 * 64; (void)moecnt;
            SchedMoe S; S.G = X.G; S.c = X.bid; S.a0 = (const char*)HID; S.w0 = (const char*)WDN; S.astep = (size_t)256 * 512 * 2; S.wstep_e = (size_t)1024 * 512 * 2; S.wstep_n = (size_t)256 * 512 * 2; S.init(moecnt);
            EpiBf16<0> E{MO, 1024, nullptr};
            pg8::gemm_phase<EpiBf16<0>, SchedMoe, true, true>(lds, Gemm{512, 512, 512}, S, E);
        }
        SEAM(pb + 11);

        if (PH_ON(13) && IN(pb + 12)) { PH_BEGIN(); const float* mv = modv + (size_t)l * 9 * 6144; (void)mv; unsigned* const moecnt = ctl + CW_MOE + l * 16 * 64; (void)moecnt;
            unsigned pre[16]; { unsigned s = 0;
#pragma unroll
                for (int e = 0; e < 16; ++e) { pre[e] = s; s += ((__hip_atomic_load(moecnt + 64 * e, __ATOMIC_RELAXED, __HIP_MEMORY_SCOPE_AGENT) + 255u) >> 8) << 8; } }
            const float* g2 = INP(I_LN2G) + l * 1024, *b2 = INP(I_LN2B) + l * 1024;
            for (int row = gw; row < nrows2; row += NGW) {
                float* hrow = row < NLAT ? hlat + (size_t)row * D : hctx + (size_t)(row - NLAT) * D;
                const int mi = row < NLAT ? (row >> 11) : 8; const float* mrow = mv + mi * 6144;
                const float* rt = ROUTE + (size_t)row * 8;
                const int e0 = __builtin_bit_cast(int, rt[0]), e1 = __builtin_bit_cast(int, rt[1]), p0 = __builtin_bit_cast(int, rt[4]), p1 = __builtin_bit_cast(int, rt[5]); const float w0 = rt[2], w1 = rt[3];
                unsigned ba0 = 0, ba1 = 0;
#pragma unroll
                for (int k = 0; k < 16; ++k) { ba0 = (k == e0) ? pre[k] : ba0; ba1 = (k == e1) ? pre[k] : ba1; }
                const bf16* m0 = MO + (size_t)(ba0 + (unsigned)p0) * D, *m1 = MO + (size_t)(ba1 + (unsigned)p1) * D;
                f32x4 v[4];
#pragma unroll
                for (int j = 0; j < 4; ++j) { const int c = 4 * lane + 256 * j; const v2u a = *(const v2u*)(m0 + c), b = *(const v2u*)(m1 + c);
                    f32x4 mm; mm[0] = w0 * bflo(a.x) + w1 * bflo(b.x); mm[1] = w0 * bfhi(a.x) + w1 * bfhi(b.x); mm[2] = w0 * bflo(a.y) + w1 * bflo(b.y); mm[3] = w0 * bfhi(a.y) + w1 * bfhi(b.y);
                    v[j] = *(const f32x4*)(hrow + c) * DN_ALPHA + *(const f32x4*)(mrow + 5120 + c) * mm; }
                ln_rows(v);
#pragma unroll
                for (int j = 0; j < 4; ++j) { const int c = 4 * lane + 256 * j; *(f32x4*)(hrow + c) = v[j] * *(const f32x4*)(g2 + c) + *(const f32x4*)(b2 + c); }
            }
        }
        SEAM(pb + 12);
    }
#undef IN
#undef SEAM
}

extern "C" void kernel_launch(void* const* d_in, const int* in_sizes, int n_in, void* d_out, int out_size, void* d_ws, size_t ws_size, hipStream_t stream) {
    static int grid = 0;
    if (grid == 0) {
        if (n_in != 34 || out_size != NLAT * D || ws_size < WS_END) { fprintf(stderr, "kernel_launch: unexpected problem (n_in %d out %d ws %zu)\n", n_in, out_size, ws_size); grid = -1; return; }
        int dev = 0, cus = 0, per_cu = 0;
        if (hipGetDevice(&dev) != hipSuccess || hipDeviceGetAttribute(&cus, hipDeviceAttributeMultiprocessorCount, dev) != hipSuccess) { grid = -1; return; }
        if (hipFuncSetAttribute((const void*)fwd, hipFuncAttributeMaxDynamicSharedMemorySize, LDS_BYTES) != hipSuccess) { fprintf(stderr, "kernel_launch: hipFuncSetAttribute failed\n"); grid = -1; return; }
        if (hipOccupancyMaxActiveBlocksPerMultiprocessor(&per_cu, (const void*)fwd, NWAVES * 64, LDS_BYTES) != hipSuccess || per_cu < 1) { fprintf(stderr, "kernel_launch: occupancy query reports %d\n", per_cu); }
        (void)hipGetLastError();
        grid = cus;
    }
    if (grid < 0) return;
    if (hipMemsetAsync((char*)d_ws + WS_CTL, 0, CTL_ZERO_BYTES, stream) != hipSuccess) return;
    Args a{};
    for (int i = 0; i < 34; ++i) a.in[i] = (const float*)d_in[i];
    a.out = (float*)d_out; a.ws = (unsigned char*)d_ws;
#if MK_ONE_LAUNCH
    a.ph_lo = 0; a.ph_hi = NPHASES;
    hipLaunchKernelGGL(fwd, dim3(grid), dim3(NWAVES * 64), LDS_BYTES, stream, a);
#else
    for (int p = 0; p < NPHASES; ++p) { a.ph_lo = p; a.ph_hi = p + 1; hipLaunchKernelGGL(fwd, dim3(grid), dim3(NWAVES * 64), LDS_BYTES, stream, a); }
#endif
}
```

```cpp
#include <hip/hip_runtime.h>
#include <cstdio>
#include <cstdint>

#define GAS __attribute__((address_space(1)))
#define LAS __attribute__((address_space(3)))
typedef unsigned short bf16;
typedef unsigned v4u __attribute__((ext_vector_type(4)));
typedef unsigned v2u __attribute__((ext_vector_type(2)));
typedef float f32x4 __attribute__((ext_vector_type(4)));
typedef float f32x2 __attribute__((ext_vector_type(2)));
typedef short bf16x8 __attribute__((ext_vector_type(8)));

constexpr int D = 1024, NB = 8, SEQ = 2048, CTXL = 256, NLAT = NB * SEQ, NCTX = NB * CTXL, NTOK = NLAT + NCTX;
constexpr int OFF_Q = 0, OFF_K = 512, OFF_V = 1024, OFF_Z = 1536, OFF_A = 2048, OFF_B = 2056, OFF_CONF = 2064, OFF_FFT = 3088, OFF_SGU = 3600, OFF_GATE = 4624, N_IN = 8720;
constexpr int NWROWS = 9216;
constexpr float LN_EPS = 1e-6f;
constexpr float DN_ALPHA = 1.4142135623730951f;
constexpr int NWAVES = 8;
constexpr int NPH_LAYER = 14, NPHASES = 1 + 2 * NPH_LAYER;

#ifndef PHMASK
#define PHMASK 0xFFFFFFFFu
#endif
#define PH_ON(k) (((PHMASK) >> (k)) & 1u)
#ifndef CPART
#define CPART 15
#endif
#ifndef MK_ONE_LAUNCH
#define MK_ONE_LAUNCH 1
#endif

constexpr size_t MiB = 1u << 20;
constexpr size_t WS_CTL = 0, CTL_ZERO_BYTES = 1 * MiB;
constexpr size_t WS_MODV = 1 * MiB;
constexpr size_t WS_BIN = 1 * MiB + 512 * 1024;
constexpr size_t WS_ROUTE = WS_BIN + 64 * 1024;
constexpr size_t WS_HCTX = 3 * MiB;
constexpr size_t WS_XN = 11 * MiB;
constexpr size_t WS_WIN = 47 * MiB;
constexpr size_t WS_WBR = 65 * MiB;
constexpr size_t WS_WOUT = 69 * MiB;
constexpr size_t WS_DFTL = 71 * MiB;
constexpr size_t WS_DFTC = 87 * MiB;
constexpr size_t WS_R2 = 88 * MiB;
constexpr size_t WS_PQKV = WS_R2;
constexpr size_t WS_PCONF = WS_R2 + 54 * MiB;
constexpr size_t WS_PZ = WS_R2 + 72 * MiB;
constexpr size_t WS_PSGU = WS_R2 + 90 * MiB;
constexpr size_t WS_PFFT = WS_R2 + 126 * MiB;
constexpr size_t WS_PFFTC = WS_R2 + 158 * MiB;
constexpr size_t WS_AB = WS_R2 + 162 * MiB;
constexpr size_t WS_WIT = WS_R2;
constexpr size_t WS_UIT = WS_R2 + 36 * MiB;
constexpr size_t WS_AIT = WS_R2 + 90 * MiB;
constexpr size_t WS_KIT = WS_R2 + 108 * MiB;
constexpr size_t WS_SIT = WS_R2 + 126 * MiB;
constexpr size_t WS_OF = WS_R2 + 128 * MiB;
constexpr size_t WS_OB = WS_R2 + 146 * MiB;
constexpr size_t WS_G = WS_R2;
constexpr size_t WS_WGU = WS_R2;
constexpr size_t WS_WDN = WS_R2 + 32 * MiB;
constexpr size_t WS_XG = WS_R2 + 48 * MiB;
constexpr size_t WS_R3 = WS_R2 + 164 * MiB;
constexpr size_t WS_QKV = WS_R3;
constexpr size_t WS_GB = WS_R3 + 54 * MiB;
constexpr size_t WS_BR = WS_R3 + 72 * MiB;
constexpr size_t WS_MERGED = WS_R3;
constexpr size_t WS_Y = WS_R3 + 72 * MiB;
constexpr size_t WS_HID = WS_R3;
constexpr size_t WS_MO = WS_R3 + 40 * MiB;
constexpr size_t WS_END = WS_R3 + 144 * MiB;
static_assert(WS_END <= 405 * MiB, "workspace map");
constexpr int CW_BAR = 4096;
constexpr int CW_MOE = 16384;

constexpr int RING_BYTES = 131072;
constexpr int LDSCTL_OFF = RING_BYTES, MISC_OFF = LDSCTL_OFF + 320;
constexpr int LDS_BYTES = 147456;

#define LDS_WAIT() asm volatile("s_waitcnt lgkmcnt(0)" ::: "memory")
#define VM_WAIT() asm volatile("s_waitcnt vmcnt(0)" ::: "memory")
__device__ __forceinline__ unsigned f2bf(float f) { unsigned u = __builtin_bit_cast(unsigned, f); return (u + 0x7fffu + ((u >> 16) & 1u)) >> 16; }
__device__ __forceinline__ unsigned pk2(float lo, float hi) { return f2bf(lo) | (f2bf(hi) << 16); }
__device__ __forceinline__ float bflo(unsigned w) { return __builtin_bit_cast(float, w << 16); }
__device__ __forceinline__ float bfhi(unsigned w) { return __builtin_bit_cast(float, w & 0xffff0000u); }
__device__ __forceinline__ float bf1(bf16 b) { return __builtin_bit_cast(float, ((unsigned)b) << 16); }
__device__ __forceinline__ void unpack8(const v4u w, float (&o)[8]) { o[0] = bflo(w.x); o[1] = bfhi(w.x); o[2] = bflo(w.y); o[3] = bfhi(w.y); o[4] = bflo(w.z); o[5] = bfhi(w.z); o[6] = bflo(w.w); o[7] = bfhi(w.w); }
__device__ __forceinline__ v4u pack8(const float (&o)[8]) { v4u w; w.x = pk2(o[0], o[1]); w.y = pk2(o[2], o[3]); w.z = pk2(o[4], o[5]); w.w = pk2(o[6], o[7]); return w; }
__device__ __forceinline__ float sigmoidf_(float x) { return 1.0f / (1.0f + __expf(-x)); }
__device__ __forceinline__ float siluf_(float x) { return x / (1.0f + __expf(-x)); }
__device__ __forceinline__ float gelu_tanh(float x) { const float u = 0.7978845608028654f * (x + 0.044715f * x * x * x); return x / (1.0f + __expf(-2.0f * u)); }
__device__ __forceinline__ float wave_sum(float v) {
#pragma unroll
    for (int o = 1; o < 64; o <<= 1) v += __shfl_xor(v, o);
    return v;
}
__device__ __forceinline__ float g16_sum(float v) {
#pragma unroll
    for (int o = 1; o < 16; o <<= 1) v += __shfl_xor(v, o);
    return v;
}

namespace pg8 {
constexpr int BM = 256, BK = 64, HALF = 128, HTB = HALF * BK * 2, STAGE_BYTES = 8 * HTB;
__host__ __device__ __forceinline__ int lds_byte(int r, int c) { const int st = (r >> 4) * 2 + (c >> 5), rr = r & 15, cc = c & 31, ob = rr * 64 + cc * 2; return st * 1024 + (ob ^ (((ob >> 9) & 1) << 5)); }
__host__ __device__ __forceinline__ void stage_rc(int b, int& R, int& C) { const int st = b / 1024, sb = b % 1024, swz = sb ^ (((sb >> 9) & 1) << 5); R = (st >> 1) * 16 + swz / 64; C = (st & 1) * 32 + (swz % 64) / 2; }
__host__ __device__ __forceinline__ int perm32(int rho) { const int n = rho >> 4, i = rho & 15; return 8 * (i >> 2) + 4 * n + (i & 3); }

struct Unit { int pm, pn, aux; const char* a; const char* b; };
struct Gemm { int K, lda, ldb; };

__device__ __forceinline__ void map_tile(int L, int nM, int nN, int& pm, int& pn) {
    const int nwg = nM * nN; int wgid = L; { const int q = nwg / 8, r = nwg % 8, xcd = wgid % 8, off = wgid / 8; wgid = (xcd < r ? xcd * (q + 1) : r * (q + 1) + (xcd - r) * q) + off; }
    const int nig = 8 * nN, gid = wgid / nig, fm = gid * 8, gsz = (nM - fm) < 8 ? (nM - fm) : 8;
    pm = fm + ((wgid % nig) % gsz); pn = (wgid % nig) / gsz;
}
__device__ __forceinline__ unsigned cvt_pk_bf16(float lo, float hi) { unsigned r; asm volatile("v_cvt_pk_bf16_f32 %0, %1, %2" : "=v"(r) : "v"(lo), "v"(hi)); return r; }

template <class Epi, class Sched, bool ALIGN_EPI, bool SP2>
__device__ __forceinline__ void gemm_phase(LAS unsigned char* lds, const Gemm g, const Sched& S, const Epi& E) {
    int tid_l = threadIdx.x; asm volatile("" : "+v"(tid_l));
    const int tid = tid_l, wid = __builtin_amdgcn_readfirstlane(tid >> 6), lane = tid & 63, wr = wid >> 2, wc = wid & 3, fr = lane & 15, fq = lane >> 4;
    const int K = g.K, nt = K / BK;
    unsigned voffA[2], voffB[2];
#pragma unroll
    for (int i = 0; i < 2; ++i) { int R, C; stage_rc(tid * 16 + i * 8192, R, C); const int Rb = Epi::PERM ? ((R & ~31) + perm32(R & 31)) : R;
        voffA[i] = (unsigned)(R * g.lda + C) * 2u; voffB[i] = (unsigned)(Rb * g.ldb + C) * 2u; }
    const size_t kstep = (size_t)(BK * 2);
    const size_t hstepA = (size_t)HALF * g.lda * 2, hstepB = (size_t)HALF * g.ldb * 2;
    const unsigned ldsw = (unsigned)wid * 1024u;
    const int aoff = lds_byte(wr * 64 + fr, fq * 8), boff = lds_byte(wc * 32 + fr, fq * 8);
#define PG8_SA(b, h) (((b) * 2 + (h)) * HTB)
#define PG8_SB(b, h) ((4 + (b) * 2 + (h)) * HTB)
#define PG8_STAGE(bufoff, gbase, voff) do { _Pragma("unroll") for (int _i = 0; _i < 2; ++_i) \
        __builtin_amdgcn_global_load_lds((const unsigned*)((const char*)(gbase) + (voff)[_i]), (LAS unsigned*)(lds + (bufoff) + ldsw + _i * 8192), 16, 0, 0); } while (0)
#define PG8_LDA(dst, b, h) do { _Pragma("unroll") for (int m = 0; m < 4; ++m) _Pragma("unroll") for (int k = 0; k < 2; ++k) dst[m][k] = *(const LAS bf16x8*)(lds + PG8_SA(b, h) + aoff + m * 2048 + k * 1024); } while (0)
#define PG8_LDB(dst, b, h) do { _Pragma("unroll") for (int n = 0; n < 2; ++n) _Pragma("unroll") for (int k = 0; k < 2; ++k) dst[n][k] = *(const LAS bf16x8*)(lds + PG8_SB(b, h) + boff + n * 2048 + k * 1024); } while (0)
#define PG8_MMA(ai, bj, At, Bt) do { __builtin_amdgcn_s_setprio(1); _Pragma("unroll") for (int m = 0; m < 4; ++m) _Pragma("unroll") for (int n = 0; n < 2; ++n) _Pragma("unroll") for (int k = 0; k < 2; ++k) \
        acc[ai][bj][m][n] = __builtin_amdgcn_mfma_f32_16x16x32_bf16(Bt[n][k], At[m][k], acc[ai][bj][m][n], 0, 0, 0); __builtin_amdgcn_s_setprio(0); } while (0)
#define PG8_WAIT_V(n) asm volatile("s_waitcnt vmcnt(" #n ")" ::: "memory")
#define PG8_WAIT_L(n) asm volatile("s_waitcnt lgkmcnt(" #n ")" ::: "memory")
#define PG8_BAR __builtin_amdgcn_s_barrier()
#define PG8_SCHED __builtin_amdgcn_sched_barrier(0)
    Unit cur, nxt; int ui = 0;
    if (!S.next(0, cur)) return;
    f32x4 acc[2][2][4][2];
#pragma unroll
    for (int a = 0; a < 2; ++a)
#pragma unroll
        for (int b = 0; b < 2; ++b)
#pragma unroll
            for (int m = 0; m < 4; ++m)
#pragma unroll
                for (int n = 0; n < 2; ++n) acc[a][b][m][n] = (f32x4){0.f, 0.f, 0.f, 0.f};
    bf16x8 At[4][2], B0[2][2], B1[2][2];
    const char* cA = cur.a; const char* cB = cur.b;
    if constexpr (SP2) {
        PG8_STAGE(PG8_SB(0, 0), cB, voffB); PG8_STAGE(PG8_SB(0, 1), cB + hstepB, voffB); PG8_STAGE(PG8_SA(0, 0), cA, voffA); PG8_STAGE(PG8_SA(0, 1), cA + hstepA, voffA);
        if (wr == 1) PG8_BAR;
        PG8_WAIT_V(2); PG8_BAR;
        PG8_STAGE(PG8_SB(1, 0), cB + kstep, voffB); PG8_STAGE(PG8_SA(1, 0), cA + kstep, voffA); PG8_STAGE(PG8_SB(1, 1), cB + hstepB + kstep, voffB);
        PG8_WAIT_V(6); PG8_BAR;
    } else {
        PG8_STAGE(PG8_SB(0, 0), cB, voffB); PG8_STAGE(PG8_SA(0, 0), cA, voffA); PG8_STAGE(PG8_SB(0, 1), cB + hstepB, voffB); PG8_STAGE(PG8_SA(0, 1), cA + hstepA, voffA);
        if (wr == 1) PG8_BAR;
        PG8_WAIT_V(4); PG8_BAR;
        PG8_STAGE(PG8_SB(1, 0), cB + kstep, voffB); PG8_STAGE(PG8_SA(1, 0), cA + kstep, voffA); PG8_STAGE(PG8_SB(1, 1), cB + hstepB + kstep, voffB);
        PG8_WAIT_V(6); PG8_BAR;
    }
    for (;;) {
        const bool has_next = S.next(ui + 1, nxt);
        const char* nA = has_next ? nxt.a : cA; const char* nB = has_next ? nxt.b : cB;
        for (int t = 0; t < nt; t += 2) {
            const bool last = (t == nt - 2);
            const char* a1 = cA + (size_t)(t + 1) * kstep;
            const char* a2 = last ? nA : cA + (size_t)(t + 2) * kstep; const char* b2 = last ? nB : cB + (size_t)(t + 2) * kstep;
            const char* a3 = a2 + kstep; const char* b3 = b2 + kstep;
            if constexpr (SP2) {
            PG8_LDB(B0, 0, 0); PG8_LDB(B1, 0, 1); PG8_SCHED; PG8_LDA(At, 0, 0); PG8_STAGE(PG8_SA(1, 1), a1 + hstepA, voffA);
            PG8_WAIT_V(8); PG8_WAIT_L(0); PG8_BAR; PG8_MMA(0, 0, At, B0); PG8_MMA(0, 1, At, B1); PG8_BAR; PG8_SCHED;
            PG8_LDA(At, 0, 1); PG8_STAGE(PG8_SB(0, 0), b2, voffB); PG8_STAGE(PG8_SB(0, 1), b2 + hstepB, voffB); PG8_STAGE(PG8_SA(0, 0), a2, voffA);
            PG8_WAIT_V(8); PG8_WAIT_L(0); PG8_BAR; PG8_MMA(1, 0, At, B0); PG8_MMA(1, 1, At, B1); PG8_BAR; PG8_SCHED;
            PG8_LDB(B0, 1, 0); PG8_LDB(B1, 1, 1); PG8_SCHED; PG8_LDA(At, 1, 0); PG8_STAGE(PG8_SA(0, 1), a2 + hstepA, voffA);
            PG8_WAIT_V(8); PG8_WAIT_L(0); PG8_BAR; PG8_MMA(0, 0, At, B0); PG8_MMA(0, 1, At, B1); PG8_BAR; PG8_SCHED;
            PG8_LDA(At, 1, 1); PG8_STAGE(PG8_SB(1, 0), b3, voffB); PG8_STAGE(PG8_SB(1, 1), b3 + hstepB, voffB); PG8_STAGE(PG8_SA(1, 0), a3, voffA);
            PG8_WAIT_V(8); PG8_WAIT_L(0); PG8_BAR; PG8_MMA(1, 0, At, B0); PG8_MMA(1, 1, At, B1); PG8_BAR; PG8_SCHED;
            } else {
            PG8_LDB(B0, 0, 0); PG8_SCHED; PG8_LDA(At, 0, 0); PG8_STAGE(PG8_SA(1, 1), a1 + hstepA, voffA);
            PG8_WAIT_L(8); PG8_BAR; PG8_WAIT_L(0); PG8_MMA(0, 0, At, B0); PG8_BAR; PG8_SCHED;
            PG8_LDB(B1, 0, 1); PG8_STAGE(PG8_SB(0, 0), b2, voffB);
            PG8_BAR; PG8_WAIT_L(0); PG8_MMA(0, 1, At, B1); PG8_BAR;
            PG8_LDA(At, 0, 1); PG8_STAGE(PG8_SA(0, 0), a2, voffA);
            PG8_BAR; PG8_WAIT_L(0); PG8_MMA(1, 0, At, B0); PG8_BAR; PG8_SCHED;
            PG8_STAGE(PG8_SB(0, 1), b2 + hstepB, voffB);
            PG8_WAIT_V(6); PG8_BAR; PG8_MMA(1, 1, At, B1); PG8_BAR;
            PG8_LDB(B0, 1, 0); PG8_SCHED; PG8_LDA(At, 1, 0); PG8_STAGE(PG8_SA(0, 1), a2 + hstepA, voffA);
            PG8_WAIT_L(8); PG8_BAR; PG8_WAIT_L(0); PG8_MMA(0, 0, At, B0); PG8_BAR; PG8_SCHED;
            PG8_LDB(B1, 1, 1); PG8_STAGE(PG8_SB(1, 0), b3, voffB);
            PG8_BAR; PG8_WAIT_L(0); PG8_MMA(0, 1, At, B1); PG8_BAR;
            PG8_LDA(At, 1, 1); PG8_STAGE(PG8_SA(1, 0), a3, voffA);
            PG8_BAR; PG8_WAIT_L(0); PG8_MMA(1, 0, At, B0); PG8_BAR; PG8_SCHED;
            PG8_STAGE(PG8_SB(1, 1), b3 + hstepB, voffB);
            PG8_WAIT_V(6); PG8_BAR; PG8_MMA(1, 1, At, B1); PG8_BAR;
            }
        }
        if constexpr (ALIGN_EPI) { if (wr == 0) PG8_BAR; }
        E(acc, cur, wr, wc, fr, fq);
        if (!has_next) break;
#pragma unroll
        for (int a = 0; a < 2; ++a)
#pragma unroll
            for (int b = 0; b < 2; ++b)
#pragma unroll
                for (int m = 0; m < 4; ++m)
#pragma unroll
                    for (int n = 0; n < 2; ++n) acc[a][b][m][n] = (f32x4){0.f, 0.f, 0.f, 0.f};
        cur = nxt; cA = nA; cB = nB; ++ui;
        if constexpr (ALIGN_EPI) { if (wr == 1) PG8_BAR; }
    }
    PG8_WAIT_V(0);
    if constexpr (!ALIGN_EPI) { if (wr == 0) PG8_BAR; }
    PG8_BAR;
#undef PG8_SA
#undef PG8_SB
#undef PG8_STAGE
#undef PG8_LDA
#undef PG8_LDB
#undef PG8_MMA
#undef PG8_WAIT_V
#undef PG8_WAIT_L
#undef PG8_BAR
#undef PG8_SCHED
}
}
using pg8::Unit;
using pg8::Gemm;
typedef f32x4 AccT[2][2][4][2];

#define XB_TMO      128
#define XB_XCNT(j)  (256  + 64 * (j))
#define XB_XSUB(j)  (1280 + 64 * (j))
#define XB_XGEN(j)  (2304 + 64 * (j))
#define XB_TOP      3328
#define XB_TOPGEN   3392
#define XCD_BAR_WORDS 3456
#define XB_SPIN_CAP (1u << 18)
__device__ __forceinline__ unsigned xb_ld(unsigned* p)              { return __hip_atomic_load(p, __ATOMIC_RELAXED, __HIP_MEMORY_SCOPE_AGENT); }
__device__ __forceinline__ unsigned xb_add(unsigned* p, unsigned v) { return __hip_atomic_fetch_add(p, v, __ATOMIC_RELAXED, __HIP_MEMORY_SCOPE_AGENT); }
__device__ __forceinline__ unsigned xb_xcc_id() { return (unsigned)__builtin_amdgcn_s_getreg((3 << 11) | 20) & 0xFu; }
#define XB_SPIN(cond, bar) do { unsigned _sp = 0; while (cond) { __builtin_amdgcn_s_sleep(1); \
    if ((++_sp & 255u) == 0u) { if (xb_ld(&(bar)[XB_TMO])) break; if (_sp > XB_SPIN_CAP) { atomicAdd(&(bar)[XB_TMO], 1u); break; } } } } while (0)
struct XcdBarrier { unsigned* bar; unsigned x; volatile LAS unsigned* st; };
__device__ __forceinline__ XcdBarrier xcd_barrier_post(unsigned* bar, volatile LAS unsigned* st) {
    XcdBarrier b; b.bar = bar; b.x = xb_xcc_id(); b.st = st;
    if (threadIdx.x == 0) (void)xb_add(&bar[XB_XCNT(b.x)], 1u);
    return b;
}
__device__ __forceinline__ void xcd_barrier_complete(unsigned* bar, unsigned x, unsigned& nloc, unsigned& nx) {
    const unsigned G = gridDim.x * gridDim.y * gridDim.z;
    unsigned sum, cnt, mine, sp = 0u;
    for (;;) {
        sum = 0u; cnt = 0u; mine = 0u;
#pragma unroll
        for (unsigned j = 0; j < 16; ++j) { const unsigned c = xb_ld(&bar[XB_XCNT(j)]); sum += c; cnt += (c > 0u) ? 1u : 0u; mine = (j == x) ? c : mine; }
        if (sum == G) break;
        __builtin_amdgcn_s_sleep(1);
        if ((++sp & 255u) == 0u) { if (xb_ld(&bar[XB_TMO])) break; if (sp > XB_SPIN_CAP) { atomicAdd(&bar[XB_TMO], 1u); break; } }
    }
    nloc = mine > 0u ? mine : 1u; nx = cnt > 0u ? cnt : 1u;
}
__device__ __forceinline__ void xcd_barrier(const XcdBarrier& b) {
    asm volatile("s_waitcnt vmcnt(0)" ::: "memory");
    __syncthreads();
    if (threadIdx.x == 0) {
        unsigned* bar = b.bar;
        __builtin_amdgcn_s_waitcnt(0);
        unsigned nloc = b.st[0], nx = b.st[1];
        if (nloc == 0u) { xcd_barrier_complete(bar, b.x, nloc, nx); b.st[0] = nloc; b.st[1] = nx; }
        const unsigned old = xb_add(&bar[XB_XSUB(b.x)], 1u);
        const unsigned gen = old / nloc;
        if (old + 1u == (gen + 1u) * nloc) {
            __builtin_amdgcn_fence(__ATOMIC_RELEASE, "agent");
            asm volatile("s_waitcnt vmcnt(0)" ::: "memory");
            const unsigned og = xb_add(&bar[XB_TOP], 1u);
            const unsigned tg = og / nx;
            if (og + 1u == (tg + 1u) * nx) xb_add(&bar[XB_TOPGEN], 1u);
            else XB_SPIN(xb_ld(&bar[XB_TOPGEN]) == tg, bar);
            __builtin_amdgcn_fence(__ATOMIC_ACQUIRE, "agent");
            xb_add(&bar[XB_XGEN(b.x)], 1u);
            asm volatile("s_waitcnt vmcnt(0)" ::: "memory");
        } else {
            XB_SPIN(xb_ld(&bar[XB_XGEN(b.x)]) == gen, bar);
            __builtin_amdgcn_fence(__ATOMIC_ACQUIRE, "agent");
            asm volatile("s_waitcnt vmcnt(0)" ::: "memory");
        }
    }
    __syncthreads();
}

struct Args { const float* in[34]; float* out; unsigned char* ws; int ph_lo, ph_hi; };
enum { I_X = 0, I_C, I_CTX, I_CCTX, I_WMOD, I_BMOD, I_WIN, I_BIN, I_GCONV, I_GALOG, I_GDT, I_GNORM, I_CDWW, I_CDWB, I_CLNG, I_CLNB, I_SLNG, I_SLNB, I_SWS, I_SBS,
       I_WBR, I_WOUT, I_BOUT, I_LN1G, I_LN1B, I_LN2G, I_LN2B, I_RGW, I_RGB, I_REW, I_REB, I_EWG, I_EWU, I_EWD };

struct SchedInA {
    int G, c; const char* xn; const char* w;
    __device__ __forceinline__ bool next(int i, Unit& u) const {
        const int L = i * G + c; const size_t tstep = (size_t)256 * 1024 * 2;
        if (L < 1152) { int pm, pn; pg8::map_tile(L, 72, 16, pm, pn); u.pm = pm; u.pn = pn; u.aux = 0; u.a = xn + (size_t)pm * tstep; u.b = w + (size_t)pn * tstep; return true; }
        if (L < 1440) { const int q = L - 1152, pm = 16 + (q & 3), pn = q >> 2; u.pm = pm; u.pn = pn; u.aux = 1; u.a = w + (size_t)pm * tstep; u.b = xn + (size_t)pn * tstep; return true; }
        return false;
    }
};
struct SchedGrid {
    int G, c, nM, nN; const char* a0; const char* b0; size_t astep, bstep;
    __device__ __forceinline__ bool next(int i, Unit& u) const {
        const int L = i * G + c; if (L >= nM * nN) return false;
        int pm, pn; pg8::map_tile(L, nM, nN, pm, pn); u.pm = pm; u.pn = pn; u.aux = 0; u.a = a0 + (size_t)pm * astep; u.b = b0 + (size_t)pn * bstep; return true;
    }
};
struct SchedFftLat {
    int G, c; const char* dft; const char* pf;
    __device__ __forceinline__ bool next(int i, Unit& u) const {
        const int L = i * G + c; if (L >= 128) return false;
        const int b = L >> 4, kt = (L >> 1) & 7, pn = L & 1;
        u.pm = b * 8 + kt; u.pn = pn; u.aux = 0; u.a = dft + (size_t)kt * (256 * 4096 * 2); u.b = pf + (size_t)b * (512 * 4096 * 2) + (size_t)pn * (256 * 4096 * 2); return true;
    }
};
struct SchedFftCtx {
    int G, c; const char* dft; const char* pf;
    __device__ __forceinline__ bool next(int i, Unit& u) const {
        const int L = i * G + (G - 1 - c); if (L >= 16) return false;
        const int b = L >> 1, pn = L & 1;
        u.pm = 64 + b; u.pn = pn; u.aux = 0; u.a = dft; u.b = pf + (size_t)b * (512 * 512 * 2) + (size_t)pn * (256 * 512 * 2); return true;
    }
};
struct SchedBranch {
    int G, c, nM; const char* br; const char* wbr;
    __device__ __forceinline__ bool next(int j, Unit& u) const {
        const int L = (j >> 2) * G + c; if (L >= nM * 4) return false;
        int pm, pn; pg8::map_tile(L, nM, 4, pm, pn); const int i = j & 3;
        u.pm = pm; u.pn = pn; u.aux = i; u.a = br + (size_t)i * ((size_t)NTOK * 512 * 2) + (size_t)pm * (256 * 512 * 2); u.b = wbr + (size_t)i * (1024 * 512 * 2) + (size_t)pn * (256 * 512 * 2); return true;
    }
};
struct SchedMoe {
    int G, c; unsigned pre[17]; const char* a0; const char* w0; size_t astep, wstep_e, wstep_n;
    __device__ __forceinline__ void init(const unsigned* cnt  ) {
        unsigned s = 0;
#pragma unroll
        for (int e = 0; e < 16; ++e) { pre[e] = s; s += ((unsigned)__builtin_amdgcn_readfirstlane((int)__hip_atomic_load(cnt + 64 * e, __ATOMIC_RELAXED, __HIP_MEMORY_SCOPE_AGENT)) + 255u) >> 8; }
        pre[16] = s;
    }
    __device__ __forceinline__ bool next(int i, Unit& u) const {
        const int L = i * G + c; if (L >= (int)pre[16] * 4) return false;
        const int jt = L >> 2, pn = L & 3; int e = 0;
#pragma unroll
        for (int k = 1; k < 16; ++k) e += ((unsigned)jt >= pre[k]) ? 1 : 0;
        u.pm = jt; u.pn = pn; u.aux = e; u.a = a0 + (size_t)jt * astep; u.b = w0 + (size_t)e * wstep_e + (size_t)pn * wstep_n; return true;
    }
};

struct EpiInA {
    static constexpr bool PERM = true;
    bf16 *pqkv, *pz, *pconf, *psgu, *pfft, *pfftc; const float* bias;
    __device__ __forceinline__ void operator()(const AccT& acc, const Unit& u, int wr, int wc, int fr, int fq) const {
        if (u.aux == 0) {
            const int row0 = u.pm * 256 + wr * 64 + fr, cb = wc * 32 + 8 * fq, bcol0 = u.pn * 256 + cb;
            f32x4 bv[2][2];
#pragma unroll
            for (int bj = 0; bj < 2; ++bj)
#pragma unroll
                for (int n = 0; n < 2; ++n) bv[bj][n] = *(const f32x4*)(bias + bcol0 + bj * 128 + 4 * n);
            if (u.pn < 8) {
                const bool isz = u.pn >= 6;
#pragma unroll
                for (int ai = 0; ai < 2; ++ai)
#pragma unroll
                    for (int m = 0; m < 4; ++m) { const int row = row0 + ai * 128 + m * 16;
                        bf16* rowp = isz ? (pz + (size_t)row * 512 + (u.pn - 6) * 256 + cb) : (pqkv + (size_t)row * 1536 + u.pn * 256 + cb);
#pragma unroll
                        for (int bj = 0; bj < 2; ++bj) { f32x4 v0 = acc[ai][bj][m][0] + bv[bj][0], v1 = acc[ai][bj][m][1] + bv[bj][1];
                            if (isz) {
#pragma unroll
                                for (int j = 0; j < 4; ++j) { v0[j] = siluf_(v0[j]); v1[j] = siluf_(v1[j]); } }
                            v4u w; w.x = pk2(v0[0], v0[1]); w.y = pk2(v0[2], v0[3]); w.z = pk2(v1[0], v1[1]); w.w = pk2(v1[2], v1[3]);
                            *(v4u*)(rowp + bj * 128) = w; } }
            } else if (u.pn < 12) {
#pragma unroll
                for (int ai = 0; ai < 2; ++ai)
#pragma unroll
                    for (int m = 0; m < 4; ++m) { const int row = row0 + ai * 128 + m * 16;
                        const f32x4 a0 = acc[ai][0][m][0] + bv[0][0], a1 = acc[ai][0][m][1] + bv[0][1], g0 = acc[ai][1][m][0] + bv[1][0], g1 = acc[ai][1][m][1] + bv[1][1];
                        float o[8];
#pragma unroll
                        for (int j = 0; j < 4; ++j) { o[j] = a0[j] * sigmoidf_(g0[j]); o[4 + j] = a1[j] * sigmoidf_(g1[j]); }
                        *(v4u*)(pconf + (size_t)row * 512 + (u.pn - 8) * 128 + cb) = pack8(o); }
            } else {
#pragma unroll
                for (int ai = 0; ai < 2; ++ai)
#pragma unroll
                    for (int m = 0; m < 4; ++m) { const int row = row0 + ai * 128 + m * 16;
                        bf16* rowp = psgu + (size_t)row * 1024 + (u.pn - 12) * 256 + cb;
#pragma unroll
                        for (int bj = 0; bj < 2; ++bj) { f32x4 v0 = acc[ai][bj][m][0] + bv[bj][0], v1 = acc[ai][bj][m][1] + bv[bj][1];
#pragma unroll
                            for (int j = 0; j < 4; ++j) { v0[j] = gelu_tanh(v0[j]); v1[j] = gelu_tanh(v1[j]); }
                            v4u w; w.x = pk2(v0[0], v0[1]); w.y = pk2(v0[2], v0[3]); w.z = pk2(v1[0], v1[1]); w.w = pk2(v1[2], v1[3]);
                            *(v4u*)(rowp + bj * 128) = w; } }
            }
        } else {
            const int jrow0 = (u.pm - 16) * 256 + wr * 64 + fr, tok0 = u.pn * 256 + wc * 32 + 8 * fq;
#pragma unroll
            for (int ai = 0; ai < 2; ++ai)
#pragma unroll
                for (int m = 0; m < 4; ++m) { const int jrow = jrow0 + ai * 128 + m * 16; const float bb = bias[4096 + jrow]; const int cs = jrow >> 9, rr = jrow & 511;
#pragma unroll
                    for (int bj = 0; bj < 2; ++bj) { const int tok = tok0 + bj * 128; bf16* dst;
                        if (tok < NLAT) { const int b = tok >> 11, t = tok & 2047; dst = pfft + ((size_t)(b * 512 + rr)) * 4096 + cs * 2048 + t; }
                        else { const int tc = tok - NLAT, b = tc >> 8, t = tc & 255; dst = pfftc + ((size_t)(b * 512 + rr)) * 512 + cs * 256 + t; }
                        const f32x4 v0 = acc[ai][bj][m][0] + bb, v1 = acc[ai][bj][m][1] + bb;
                        v4u w; w.x = pk2(v0[0], v0[1]); w.y = pk2(v0[2], v0[3]); w.z = pk2(v1[0], v1[1]); w.w = pk2(v1[2], v1[3]);
                        *(v4u*)dst = w; } }
        }
    }
};
template <int ACT  > struct EpiBf16 {
    static constexpr bool PERM = true;
    bf16* O; int ldc; const float* bias;
    __device__ __forceinline__ void operator()(const AccT& acc, const Unit& u, int wr, int wc, int fr, int fq) const {
        const int row0 = u.pm * 256 + wr * 64 + fr, col0 = u.pn * 256 + wc * 32 + 8 * fq;
        f32x4 bv[2][2];
#pragma unroll
        for (int bj = 0; bj < 2; ++bj)
#pragma unroll
            for (int n = 0; n < 2; ++n) bv[bj][n] = bias ? *(const f32x4*)(bias + col0 + bj * 128 + 4 * n) : (f32x4){0.f, 0.f, 0.f, 0.f};
#pragma unroll
        for (int ai = 0; ai < 2; ++ai)
#pragma unroll
            for (int m = 0; m < 4; ++m) { bf16* rowp = O + (size_t)(row0 + ai * 128 + m * 16) * ldc + col0;
#pragma unroll
                for (int bj = 0; bj < 2; ++bj) { f32x4 v0 = acc[ai][bj][m][0] + bv[bj][0], v1 = acc[ai][bj][m][1] + bv[bj][1];
                    if (ACT == 1) {
#pragma unroll
                        for (int j = 0; j < 4; ++j) { v0[j] = sigmoidf_(v0[j]); v1[j] = sigmoidf_(v1[j]); } }
                    v4u w; w.x = pk2(v0[0], v0[1]); w.y = pk2(v0[2], v0[3]); w.z = pk2(v1[0], v1[1]); w.w = pk2(v1[2], v1[3]);
                    *(v4u*)(rowp + bj * 128) = w; } }
    }
};
struct EpiF32 {
    static constexpr bool PERM = false;
    float* C; int ldc; const float* bias;
    __device__ __forceinline__ void operator()(const AccT& acc, const Unit& u, int wr, int wc, int fr, int fq) const {
        const int row0 = u.pm * 256 + wr * 64 + fr, col0 = u.pn * 256 + wc * 32 + 4 * fq;
        f32x4 bv[2][2];
#pragma unroll
        for (int bj = 0; bj < 2; ++bj)
#pragma unroll
            for (int n = 0; n < 2; ++n) bv[bj][n] = *(const f32x4*)(bias + col0 + bj * 128 + n * 16);
#pragma unroll
        for (int ai = 0; ai < 2; ++ai)
#pragma unroll
            for (int m = 0; m < 4; ++m) { float* rowp = C + (size_t)(row0 + ai * 128 + m * 16) * ldc + col0;
#pragma unroll
                for (int bj = 0; bj < 2; ++bj)
#pragma unroll
                    for (int n = 0; n < 2; ++n) *(f32x4*)(rowp + bj * 128 + n * 16) = acc[ai][bj][m][n] + bv[bj][n]; }
    }
};
struct EpiBranch {
    static constexpr bool PERM = false;
    float* merged; bf16* mbf; const bf16* gates;
    __device__ __forceinline__ void operator()(const AccT& acc, const Unit& u, int wr, int wc, int fr, int fq) const {
        const int row0 = u.pm * 256 + wr * 64 + fr, col0 = u.pn * 256 + wc * 32 + 4 * fq, i = u.aux;
#pragma unroll
        for (int ai = 0; ai < 2; ++ai)
#pragma unroll
            for (int m = 0; m < 4; ++m) { const size_t row = (size_t)(row0 + ai * 128 + m * 16);
#pragma unroll
                for (int bj = 0; bj < 2; ++bj)
#pragma unroll
                    for (int n = 0; n < 2; ++n) { const int col = col0 + bj * 128 + n * 16;
                        const v2u gw = *(const v2u*)(gates + row * 4096 + i * 1024 + col);
                        f32x4 v = acc[ai][bj][m][n]; v[0] *= bflo(gw.x); v[1] *= bfhi(gw.x); v[2] *= bflo(gw.y); v[3] *= bfhi(gw.y);
                        float* mp = merged + row * 1024 + col;
                        if (i > 0) v += *(const f32x4*)mp;
                        if (i < 3) *(f32x4*)mp = v;
                        else { v2u w; w.x = pk2(v[0], v[1]); w.y = pk2(v[2], v[3]); *(v2u*)(mbf + row * 1024 + col) = w; } } }
    }
};
struct EpiMoe1 {
    static constexpr bool PERM = true;
    bf16* hid;
    __device__ __forceinline__ void operator()(const AccT& acc, const Unit& u, int wr, int wc, int fr, int fq) const {
        const int row0 = u.pm * 256 + wr * 64 + fr, cb = wc * 32 + 8 * fq;
#pragma unroll
        for (int ai = 0; ai < 2; ++ai)
#pragma unroll
            for (int m = 0; m < 4; ++m) { const int row = row0 + ai * 128 + m * 16;
                const f32x4 g0 = acc[ai][0][m][0], g1 = acc[ai][0][m][1], u0 = acc[ai][1][m][0], u1 = acc[ai][1][m][1];
                float o[8];
#pragma unroll
                for (int j = 0; j < 4; ++j) { o[j] = siluf_(g0[j]) * u0[j]; o[4 + j] = siluf_(g1[j]) * u1[j]; }
                *(v4u*)(hid + (size_t)row * 512 + u.pn * 128 + cb) = pack8(o); }
    }
};

struct Ctx {
    LAS unsigned char* lds; int tid, lane, wave, G, bid;
};

__device__ __forceinline__ void cvt_tile(const Ctx& X, const float* src, int ld, int k0, bf16* dst, int Kp) {
    LAS float* tile = (LAS float*)X.lds;
#pragma unroll
    for (int i = 0; i < 8; ++i) { const int kk = (X.tid >> 6) + 8 * i, nn = X.tid & 63; tile[kk * 65 + nn] = src[(size_t)(k0 + kk) * ld + nn]; }
    __syncthreads();
    { const int n = X.tid >> 3, kc = X.tid & 7; float o[8];
#pragma unroll
      for (int j = 0; j < 8; ++j) o[j] = tile[(8 * kc + j) * 65 + n];
      *(v4u*)(dst + (size_t)n * Kp + k0 + 8 * kc) = pack8(o); }
    __syncthreads();
}

__device__ __forceinline__ void ln_rows(f32x4 (&v)[4]) {
    float s = 0.f;
#pragma unroll
    for (int j = 0; j < 4; ++j) s += (v[j][0] + v[j][1]) + (v[j][2] + v[j][3]);
    const float mean = wave_sum(s) * (1.f / D); float s2 = 0.f;
#pragma unroll
    for (int j = 0; j < 4; ++j) { v[j] = v[j] - mean; s2 += (v[j][0] * v[j][0] + v[j][1] * v[j][1]) + (v[j][2] * v[j][2] + v[j][3] * v[j][3]); }
    const float rstd = 1.0f / sqrtf(wave_sum(s2) * (1.f / D) + LN_EPS);
#pragma unroll
    for (int j = 0; j < 4; ++j) v[j] = v[j] * rstd;
}

#define PH_BEGIN() \
    int tid_l = threadIdx.x; asm volatile("" : "+v"(tid_l)); const int tid = tid_l, lane = tid & 63; \
    Ctx X; X.lds = lds; X.tid = tid; X.lane = lane; X.wave = __builtin_amdgcn_readfirstlane(tid >> 6); X.G = gridDim.x; X.bid = blockIdx.x; \
    const int gw = X.bid * NWAVES + X.wave, NGW = X.G * NWAVES; (void)gw; (void)NGW; \
    const __attribute__((address_space(4))) char* kp = (const __attribute__((address_space(4))) char*)__builtin_amdgcn_kernarg_segment_ptr(); asm volatile("" : "+s"(kp)); \
    unsigned char* const ws = *(unsigned char* const __attribute__((address_space(4)))*)(kp + 280); \
    float* const hlat = *(float* const __attribute__((address_space(4)))*)(kp + 272); (void)hlat; \
    float* const hctx = (float*)(ws + WS_HCTX); (void)hctx; \
    float* const modv = (float*)(ws + WS_MODV); (void)modv; \
    float* const binv = (float*)(ws + WS_BIN); (void)binv; \
    bf16* const XN = (bf16*)(ws + WS_XN); (void)XN; \
    bf16* const WIN = (bf16*)(ws + WS_WIN); (void)WIN; \
    bf16* const WBR = (bf16*)(ws + WS_WBR); (void)WBR; \
    bf16* const WOUT = (bf16*)(ws + WS_WOUT); (void)WOUT; \
    bf16* const DFTL = (bf16*)(ws + WS_DFTL); (void)DFTL; \
    bf16* const DFTC = (bf16*)(ws + WS_DFTC); (void)DFTC; \
    bf16* const PQKV = (bf16*)(ws + WS_PQKV); (void)PQKV; \
    bf16* const PCONF = (bf16*)(ws + WS_PCONF); (void)PCONF; \
    bf16* const PZ = (bf16*)(ws + WS_PZ); (void)PZ; \
    bf16* const PSGU = (bf16*)(ws + WS_PSGU); (void)PSGU; \
    bf16* const PFFT = (bf16*)(ws + WS_PFFT); (void)PFFT; \
    bf16* const PFFTC = (bf16*)(ws + WS_PFFTC); (void)PFFTC; \
    float* const AB = (float*)(ws + WS_AB); (void)AB; \
    bf16* const OF = (bf16*)(ws + WS_OF); (void)OF; \
    bf16* const OB = (bf16*)(ws + WS_OB); (void)OB; \
    bf16* const WIT = (bf16*)(ws + WS_WIT); (void)WIT; \
    bf16* const UIT = (bf16*)(ws + WS_UIT); (void)UIT; \
    bf16* const AIT = (bf16*)(ws + WS_AIT); (void)AIT; \
    bf16* const KIT = (bf16*)(ws + WS_KIT); (void)KIT; \
    float* const SIT = (float*)(ws + WS_SIT); (void)SIT; \
    bf16* const GT = (bf16*)(ws + WS_G); (void)GT; \
    bf16* const WGU = (bf16*)(ws + WS_WGU); (void)WGU; \
    bf16* const WDN = (bf16*)(ws + WS_WDN); (void)WDN; \
    bf16* const XG = (bf16*)(ws + WS_XG); (void)XG; \
    bf16* const QKV = (bf16*)(ws + WS_QKV); (void)QKV; \
    float* const GB = (float*)(ws + WS_GB); (void)GB; \
    bf16* const BR = (bf16*)(ws + WS_BR); (void)BR; \
    float* const MERGED = (float*)(ws + WS_MERGED); (void)MERGED; \
    float* const YB = (float*)(ws + WS_Y); (void)YB; \
    bf16* const HID = (bf16*)(ws + WS_HID); (void)HID; \
    bf16* const MO = (bf16*)(ws + WS_MO); (void)MO; \
    float* const ROUTE = (float*)(ws + WS_ROUTE); (void)ROUTE; \
    unsigned* const ctl = (unsigned*)(ws + WS_CTL); (void)ctl;
#define INP(i) (*(const float* const __attribute__((address_space(4)))*)(kp + 8 * (i)))
__global__ void __launch_bounds__(NWAVES * 64, 2) fwd(Args args) {
    extern __shared__ __attribute__((aligned(16))) unsigned char lds_raw[];
    LAS unsigned char* const lds = (LAS unsigned char*)lds_raw;
    volatile LAS unsigned* MISC = (volatile LAS unsigned*)(lds + MISC_OFF);
    for (int u = threadIdx.x; u < (LDS_BYTES - LDSCTL_OFF) / 4; u += NWAVES * 64) ((LAS unsigned*)(lds + LDSCTL_OFF))[u] = 0u;
    __syncthreads();
#if MK_ONE_LAUNCH
    XcdBarrier bar = xcd_barrier_post((unsigned*)(args.ws + WS_CTL) + CW_BAR, MISC + 8);
#define GRID_BAR() xcd_barrier(bar)
#else
#define GRID_BAR() do { } while (0)
#endif
    const int lo = args.ph_lo, hi = args.ph_hi;
#define IN(k) (lo <= (k) && (k) < hi)
#define SEAM(k) do { if (IN(k) && IN((k) + 1)) GRID_BAR(); } while (0)

    if (PH_ON(0) && IN(0)) { PH_BEGIN();
        for (int t = gw; t < SEQ; t += NGW) {
            const int prow = t >> 6, pcol = t & 63; f32x4 pe[4];
#pragma unroll
            for (int j = 0; j < 4; ++j)
#pragma unroll
                for (int e = 0; e < 4; ++e) { const int col = 4 * lane + 256 * j + e, part = col >> 9, within = col & 511, i = within & 255;
                    const float omega = 1.0f / powf(10000.0f, (float)i * (1.0f / 256.0f)); const float ang = (float)(part ? pcol : prow) * omega;
                    pe[j][e] = (within >> 8) ? cosf(ang) : sinf(ang); }
            for (int b = 0; b < NB; ++b) { const size_t off = ((size_t)b * SEQ + t) * D;
#pragma unroll
                for (int j = 0; j < 4; ++j) *(f32x4*)(hlat + off + 4 * lane + 256 * j) = *(const f32x4*)(INP(I_X) + off + 4 * lane + 256 * j) + pe[j]; }
        }
        for (int r = gw; r < NCTX; r += NGW) {
#pragma unroll
            for (int j = 0; j < 4; ++j) *(f32x4*)(hctx + (size_t)r * D + 4 * lane + 256 * j) = *(const f32x4*)(INP(I_CTX) + (size_t)r * D + 4 * lane + 256 * j);
        }
        for (int idx = X.bid * 512 + tid; idx < 2048 * 4096 / 8; idx += X.G * 512) {
            const int k = idx >> 9, j0 = (idx & 511) * 8; float o[8];
#pragma unroll
            for (int e = 0; e < 8; ++e) { const int j = j0 + e, t = j & 2047, a = (k * t) & 2047; float s, c; sincospif((float)a * (1.0f / 1024.0f), &s, &c);
                o[e] = (j < 2048 ? c : -s) * 0.022097086912079608f; }
            *(v4u*)(DFTL + (size_t)k * 4096 + j0) = pack8(o);
        }
        for (int idx = X.bid * 512 + tid; idx < 256 * 512 / 8; idx += X.G * 512) {
            const int k = idx >> 6, j0 = (idx & 63) * 8; float o[8];
#pragma unroll
            for (int e = 0; e < 8; ++e) { const int j = j0 + e, t = j & 255, a = (k * t) & 255; float s, c; sincospif((float)a * (1.0f / 128.0f), &s, &c);
                o[e] = (j < 256 ? c : -s) * 0.0625f; }
            *(v4u*)(DFTC + (size_t)k * 512 + j0) = pack8(o);
        }
        {
            LAS float* sc = (LAS float*)lds;
            LAS float* red = (LAS float*)(lds + 36864);
            for (int i = tid; i < 9 * 1024; i += 512) { const int r = i >> 10, k = i & 1023; const float c = r < 8 ? INP(I_C)[r * 1024 + k] : INP(I_CCTX)[k]; sc[i] = siluf_(c); }
            __syncthreads();
            for (int it = X.bid; it < 192; it += X.G) {
                const int l = it / 96, j = (it % 96) * 64 + lane; const float* W = INP(I_WMOD) + (size_t)l * 1024 * 6144 + j;
                float a[9];
#pragma unroll
                for (int r = 0; r < 9; ++r) a[r] = 0.f;
                const int kb = X.wave * 128;
                for (int k = 0; k < 128; ++k) { const float w = W[(size_t)(kb + k) * 6144];
#pragma unroll
                    for (int r = 0; r < 9; ++r) a[r] += sc[r * 1024 + kb + k] * w; }
#pragma unroll
                for (int r = 0; r < 9; ++r) red[(X.wave * 9 + r) * 64 + lane] = a[r];
                __syncthreads();
                for (int o = tid; o < 9 * 64; o += 512) { const int r = o >> 6, jj = o & 63; float s = 0.f;
#pragma unroll
                    for (int w = 0; w < 8; ++w) s += red[(w * 9 + r) * 64 + jj];
                    const int jc = (it % 96) * 64 + jj; modv[((size_t)l * 9 + r) * 6144 + jc] = s + INP(I_BMOD)[l * 6144 + jc]; }
                __syncthreads();
            }
        }
    }
    SEAM(0);

    for (int l = 0; l < 2; ++l) {
        const int pb = 1 + NPH_LAYER * l;
        const int nrows2 = (l == 1) ? NLAT : NTOK;
        const int npan2 = nrows2 / 256;

        if (PH_ON(1) && IN(pb + 0)) { PH_BEGIN(); const float* mv = modv + (size_t)l * 9 * 6144; (void)mv; unsigned* const moecnt = ctl + CW_MOE + l * 16 * 64; (void)moecnt;
            const float* win = INP(I_WIN) + (size_t)l * 1024 * N_IN;
            const float* bin = INP(I_BIN) + (size_t)l * N_IN;
            for (int it = X.bid; it < 144 * 16; it += X.G) {
                const int rb = it >> 4, kb = it & 15, row0 = rb * 64; int col;
                if (row0 >= 4096 && row0 < 5120) continue;
                if (row0 < 2048) col = row0;
                else if (row0 < 3072) { const int q = row0 - 2048, j = q >> 8, w = q & 255; col = OFF_CONF + (w >= 128 ? 512 : 0) + 128 * j + (w & 127); }
                else if (row0 < 4096) col = OFF_SGU + (row0 - 3072);
                else col = OFF_GATE + (row0 - 5120);
                cvt_tile(X, win + col, N_IN, kb * 64, WIN + (size_t)row0 * 1024, 1024);
            }
            for (int it = X.bid; it < 64; it += X.G) {
                const int kb = it >> 2, g = it & 3; LAS float* Wt = (LAS float*)lds; LAS float* ct = (LAS float*)(lds + 32768); LAS float* st = ct + 128;
                for (int i = tid; i < 64 * 128; i += 512) { const int kk = i >> 7, c = i & 127; Wt[i] = win[(size_t)(kb * 64 + kk) * N_IN + OFF_FFT + g * 128 + c]; }
                if (tid < 128) { float s, c; sincospif((float)tid * (1.0f / 64.0f), &s, &c); ct[tid] = c * 0.08838834764831845f; st[tid] = s * 0.08838834764831845f; }
                __syncthreads();
                const int m = tid & 127, ks = tid >> 7; float oc[16], os[16];
#pragma unroll
                for (int kk = 0; kk < 16; ++kk) { oc[kk] = 0.f; os[kk] = 0.f; }
#pragma unroll 1
                for (int c = 0; c < 128; ++c) { const int a = (m * c) & 127; const float cv = ct[a], sv = st[a];
#pragma unroll
                    for (int kk = 0; kk < 16; ++kk) { const float w = Wt[(ks * 16 + kk) * 128 + c]; oc[kk] += w * cv; os[kk] += w * sv; } }
                bf16* dc = WIN + (size_t)(4096 + g * 128 + m) * 1024 + kb * 64 + ks * 16; bf16* dsn = dc + (size_t)512 * 1024;
                { float o[8];
#pragma unroll
                  for (int h2 = 0; h2 < 2; ++h2) {
#pragma unroll
                    for (int e = 0; e < 8; ++e) o[e] = oc[h2 * 8 + e];
                    *(v4u*)(dc + h2 * 8) = pack8(o);
#pragma unroll
                    for (int e = 0; e < 8; ++e) o[e] = os[h2 * 8 + e];
                    *(v4u*)(dsn + h2 * 8) = pack8(o); } }
                __syncthreads();
            }
            for (int r = X.bid * 512 + tid; r < NWROWS; r += X.G * 512) {
                float v;
                if (r < 2048) v = bin[r];
                else if (r < 3072) { const int q = r - 2048, j = q >> 8, w = q & 255; v = bin[OFF_CONF + (w >= 128 ? 512 : 0) + 128 * j + (w & 127)]; }
                else if (r < 4096) v = bin[OFF_SGU + (r - 3072)];
                else if (r < 5120) { const int q = r - 4096, cs = q >> 9, g = (q >> 7) & 3, m = q & 127; float s = 0.f;
                    for (int c = 0; c < 128; ++c) { float sn, cn; sincospif((float)((m * c) & 127) * (1.0f / 64.0f), &sn, &cn); s += bin[OFF_FFT + g * 128 + c] * (cs ? sn : cn); }
                    v = s * 0.08838834764831845f; }
                else v = bin[OFF_GATE + (r - 5120)];
                binv[r] = v;
            }
            for (int it = X.bid; it < 4 * 16 * 8; it += X.G) { const int i = it >> 7, nb = (it >> 3) & 15, kb = it & 7;
                cvt_tile(X, INP(I_WBR) + ((size_t)(l * 4 + i) * 512) * 1024 + nb * 64, 1024, kb * 64, WBR + ((size_t)i * 1024 + nb * 64) * 512, 512); }
            for (int it = X.bid; it < 16 * 16; it += X.G) { const int nb = it >> 4, kb = it & 15;
                cvt_tile(X, INP(I_WOUT) + (size_t)l * 1024 * 1024 + nb * 64, 1024, kb * 64, WOUT + (size_t)nb * 64 * 1024, 1024); }
            LAS float* wab = (LAS float*)lds;
            __syncthreads();
            for (int i = tid; i < 16 * 1024; i += 512) { const int o = i >> 10, k = i & 1023; wab[i] = win[(size_t)k * N_IN + OFF_A + o]; }
            __syncthreads();
            for (int row = gw; row < NTOK; row += NGW) {
                const float* hrow = row < NLAT ? hlat + (size_t)row * D : hctx + (size_t)(row - NLAT) * D;
                const int mi = row < NLAT ? (row >> 11) : 8; const float* shift = mv + mi * 6144, *scale = shift + 1024;
                f32x4 v[4];
#pragma unroll
                for (int j = 0; j < 4; ++j) v[j] = *(const f32x4*)(hrow + 4 * lane + 256 * j);
                ln_rows(v);
#pragma unroll
                for (int j = 0; j < 4; ++j) { const f32x4 sc = *(const f32x4*)(scale + 4 * lane + 256 * j), sh = *(const f32x4*)(shift + 4 * lane + 256 * j); v[j] = v[j] * (sc + 1.0f) + sh;
                    v2u w; w.x = pk2(v[j][0], v[j][1]); w.y = pk2(v[j][2], v[j][3]); *(v2u*)(XN + (size_t)row * D + 4 * lane + 256 * j) = w; }
                float myv = 0.f;
#pragma unroll 2
                for (int o = 0; o < 16; ++o) { float s = 0.f;
#pragma unroll
                    for (int j = 0; j < 4; ++j) { const f32x4 w = *(const LAS f32x4*)(wab + o * 1024 + 4 * lane + 256 * j); s += (v[j][0] * w[0] + v[j][1] * w[1]) + (v[j][2] * w[2] + v[j][3] * w[3]); }
                    s = wave_sum(s); if (lane == o) myv = s; }
                if (lane < 16) AB[(size_t)row * 16 + lane] = myv + bin[OFF_A + lane];
            }
        }
        SEAM(pb + 0);

        if (PH_ON(2) && IN(pb + 1)) { PH_BEGIN(); const float* mv = modv + (size_t)l * 9 * 6144; (void)mv; unsigned* const moecnt = ctl + CW_MOE + l * 16 * 64; (void)moecnt;
            SchedInA S{X.G, X.bid, (const char*)XN, (const char*)WIN};
            EpiInA E{PQKV, PZ, PCONF, PSGU, PFFT, PFFTC, binv};
            pg8::gemm_phase<EpiInA, SchedInA, true, true>(lds, Gemm{1024, 1024, 1024}, S, E);
        }
        SEAM(pb + 1);

        if (PH_ON(3) && IN(pb + 2)) { PH_BEGIN(); const float* mv = modv + (size_t)l * 9 * 6144; (void)mv; unsigned* const moecnt = ctl + CW_MOE + l * 16 * 64; (void)moecnt;
            if (CPART & 1) {
            { SchedFftLat S{X.G, X.bid, (const char*)DFTL, (const char*)PFFT}; EpiBf16<0> E{BR + (size_t)2 * NTOK * 512, 512, nullptr};
              pg8::gemm_phase<EpiBf16<0>, SchedFftLat, true, true>(lds, Gemm{4096, 4096, 4096}, S, E); }
            { SchedFftCtx S{X.G, X.bid, (const char*)DFTC, (const char*)PFFTC}; EpiBf16<0> E{BR + (size_t)2 * NTOK * 512, 512, nullptr};
              pg8::gemm_phase<EpiBf16<0>, SchedFftCtx, true, true>(lds, Gemm{512, 512, 512}, S, E); }
            __syncthreads();
            }
            if (CPART & 2) {
                const float* cw = INP(I_GCONV) + (size_t)l * 5 * 1536;
                for (int row = gw; row < NTOK; row += NGW) {
                    int t, T; if (row < NLAT) { t = row & 2047; T = 2048; } else { t = (row - NLAT) & 255; T = 256; }
#pragma unroll 1
                    for (int seg = 0; seg < 3; ++seg) { const int ch = seg * 512 + 8 * lane; float a[8];
#pragma unroll
                        for (int e = 0; e < 8; ++e) a[e] = 0.f;
#pragma unroll
                        for (int j = 0; j < 5; ++j) { const int tt = t + j - 2; if (tt >= 0 && tt < T) { float xv[8]; unpack8(*(const v4u*)(PQKV + (size_t)(row + j - 2) * 1536 + ch), xv);
                            const f32x4 w0 = *(const f32x4*)(cw + j * 1536 + ch), w1 = *(const f32x4*)(cw + j * 1536 + ch + 4);
#pragma unroll
                            for (int e = 0; e < 4; ++e) { a[e] += w0[e] * xv[e]; a[4 + e] += w1[e] * xv[4 + e]; } } }
                        float ss = 0.f;
#pragma unroll
                        for (int e = 0; e < 8; ++e) { a[e] = siluf_(a[e]); ss += a[e] * a[e]; }
                        if (seg < 2) { ss = g16_sum(ss); const float sc = (1.0f / sqrtf(ss + LN_EPS)) * (seg == 0 ? 0.08838834764831845f : 1.0f);
#pragma unroll
                            for (int e = 0; e < 8; ++e) a[e] *= sc; }
                        *(v4u*)(QKV + (size_t)row * 1536 + ch) = pack8(a); }
                    if (lane < 8) { const float av = AB[(size_t)row * 16 + lane], bv = AB[(size_t)row * 16 + 8 + lane];
                        const float xs = av + INP(I_GDT)[l * 8 + lane]; const float sp = xs > 20.f ? xs : log1pf(expf(xs));
                        GB[(size_t)row * 16 + lane] = -expf(INP(I_GALOG)[l * 8 + lane]) * sp; GB[(size_t)row * 16 + 8 + lane] = 1.0f / (1.0f + expf(-bv)); }
                }
            }
            if (CPART & 4) {
                const float* dw = INP(I_CDWW) + (size_t)l * 31 * 512; const float* dwb = INP(I_CDWB) + l * 512, *lg = INP(I_CLNG) + l * 512, *lb = INP(I_CLNB) + l * 512;
                bf16* B1 = BR + (size_t)1 * NTOK * 512; const int ch = 8 * lane;
                for (int row = gw; row < nrows2; row += NGW) {
                    int t, T; if (row < NLAT) { t = row & 2047; T = 2048; } else { t = (row - NLAT) & 255; T = 256; }
                    float a[8];
#pragma unroll
                    for (int e = 0; e < 8; ++e) a[e] = dwb[ch + e];
#pragma unroll 4
                    for (int j = 0; j < 31; ++j) { const int tt = t + j - 15; if (tt >= 0 && tt < T) { float xv[8]; unpack8(*(const v4u*)(PCONF + (size_t)(row + j - 15) * 512 + ch), xv);
                        const f32x4 w0 = *(const f32x4*)(dw + j * 512 + ch), w1 = *(const f32x4*)(dw + j * 512 + ch + 4);
#pragma unroll
                        for (int e = 0; e < 4; ++e) { a[e] += w0[e] * xv[e]; a[4 + e] += w1[e] * xv[4 + e]; } } }
                    float s = 0.f;
#pragma unroll
                    for (int e = 0; e < 8; ++e) s += a[e];
                    const float mean = g16_sum(s) * (1.0f / 128.0f); float s2 = 0.f;
#pragma unroll
                    for (int e = 0; e < 8; ++e) { a[e] -= mean; s2 += a[e] * a[e]; }
                    const float rstd = 1.0f / sqrtf(g16_sum(s2) * (1.0f / 128.0f) + LN_EPS);
#pragma unroll
                    for (int e = 0; e < 8; ++e) a[e] = siluf_(a[e] * rstd * lg[ch + e] + lb[ch + e]);
                    *(v4u*)(B1 + (size_t)row * 512 + ch) = pack8(a);
                }
            }
            if (CPART & 8) {
                LAS float* vn = (LAS float*)lds; LAS float* wsg = (LAS float*)(lds + 65536);
                const float* lg = INP(I_SLNG) + l * 512, *lb = INP(I_SLNB) + l * 512;
                bf16* B3 = BR + (size_t)3 * NTOK * 512;
                const int nitems = (nrows2 / 128) * 4;
                __syncthreads();
                for (int it = X.bid; it < nitems; it += X.G) {
                    const int chunk = it >> 2, g = it & 3, r0 = chunk * 128;
                    const float* wsrc = INP(I_SWS) + ((size_t)(l * 4 + g)) * 128 * 128;
                    for (int i = tid; i < 128 * 128 / 4; i += 512) *(LAS f32x4*)(wsg + 4 * i) = *(const f32x4*)(wsrc + 4 * i);
                    for (int q = X.wave; q < 128; q += 8) { const unsigned w = *(const unsigned*)(PSGU + (size_t)(r0 + q) * 1024 + 512 + g * 128 + 2 * lane);
                        float v0 = bflo(w), v1 = bfhi(w); const float mean = wave_sum(v0 + v1) * (1.0f / 128.0f); v0 -= mean; v1 -= mean;
                        const float rstd = 1.0f / sqrtf(wave_sum(v0 * v0 + v1 * v1) * (1.0f / 128.0f) + LN_EPS);
                        const int c = g * 128 + 2 * lane; vn[q * 128 + 2 * lane] = v0 * rstd * lg[c] + lb[c]; vn[q * 128 + 2 * lane + 1] = v1 * rstd * lg[c + 1] + lb[c + 1]; }
                    __syncthreads();
                    const int c4 = (tid & 31) * 4, pblk = tid >> 5; f32x4 acc[8];
#pragma unroll
                    for (int i = 0; i < 8; ++i) acc[i] = (f32x4){0.f, 0.f, 0.f, 0.f};
                    for (int q = 0; q < 128; q += 4) {
                        f32x4 vq[4];
#pragma unroll
                        for (int qq = 0; qq < 4; ++qq) vq[qq] = *(const LAS f32x4*)(vn + (q + qq) * 128 + c4);
#pragma unroll
                        for (int i = 0; i < 8; ++i) { const f32x4 w = *(const LAS f32x4*)(wsg + (pblk * 8 + i) * 128 + q);
                            acc[i] += vq[0] * w[0]; acc[i] += vq[1] * w[1]; acc[i] += vq[2] * w[2]; acc[i] += vq[3] * w[3]; }
                    }
#pragma unroll
                    for (int i = 0; i < 8; ++i) { const int p = pblk * 8 + i; const float bs = INP(I_SBS)[(l * 4 + g) * 128 + p];
                        const v2u uw = *(const v2u*)(PSGU + (size_t)(r0 + p) * 1024 + g * 128 + c4);
                        v2u o; o.x = pk2(bflo(uw.x) * (acc[i][0] + bs), bfhi(uw.x) * (acc[i][1] + bs)); o.y = pk2(bflo(uw.y) * (acc[i][2] + bs), bfhi(uw.y) * (acc[i][3] + bs));
                        *(v2u*)(B3 + (size_t)(r0 + p) * 512 + g * 128 + c4) = o; }
                    __syncthreads();
                }
            }
        }
        SEAM(pb + 2);

        if (PH_ON(4) && IN(pb + 3)) { PH_BEGIN(); const float* mv = modv + (size_t)l * 9 * 6144; (void)mv; unsigned* const moecnt = ctl + CW_MOE + l * 16 * 64; (void)moecnt;
            for (int qi = gw; qi < 9216; qi += NGW) {
                int lane_l = lane; asm volatile("" : "+v"(lane_l));
                const int r16 = lane_l & 15, quad = lane_l >> 4;
                LAS float* const Mt = (LAS float*)(lds + X.wave * 16384);
                LAS float* const gcl = (LAS float*)(lds + 132096 + X.wave * 1024);
                const int item = qi >> 2, q = qi & 3, cidx = item % 36, chain = item / 36, dir = chain & 1, hh = (chain >> 1) & 3, b = chain >> 3;
                const int row0 = cidx < 4 ? NLAT + b * CTXL + cidx * 64 : b * SEQ + (cidx - 4) * 64;
                const int rb = row0 + (dir ? 63 : 0); const long sg = dir ? -1 : 1;
                const float ga = GB[(size_t)(rb + sg * lane_l) * 16 + dir * 4 + hh], be = GB[(size_t)(rb + sg * lane_l) * 16 + 8 + dir * 4 + hh];
                float gc = ga;
#pragma unroll
                for (int o = 1; o < 64; o <<= 1) { const float tu = __shfl_up(gc, o); gc += (lane_l >= o) ? tu : 0.f; }
                const float gl = __shfl(gc, 63);
                gcl[lane_l] = gc; gcl[64 + lane_l] = be;
                const float scl = q >= 2 ? be * __expf(gc) : be;
                bf16x8 Kf[4][4];
                { const bf16* kp = QKV + (size_t)(rb + sg * r16) * 1536 + 512 + hh * 128 + quad * 8; const long ms = sg * 16 * 1536;
#pragma unroll
                  for (int mi = 0; mi < 4; ++mi)
#pragma unroll
                      for (int ks = 0; ks < 4; ++ks) Kf[mi][ks] = *(const bf16x8*)(kp + mi * ms + ks * 32); }
                LDS_WAIT();
                if (q == 0) {
                    bf16x8 Qf[4][4];
                    { const bf16* qp = QKV + (size_t)(rb + sg * r16) * 1536 + hh * 128 + quad * 8; const long ms = sg * 16 * 1536;
#pragma unroll
                      for (int mi = 0; mi < 4; ++mi)
#pragma unroll
                          for (int ks = 0; ks < 4; ++ks) Qf[mi][ks] = *(const bf16x8*)(qp + mi * ms + ks * 32); }
                    bf16* ait = AIT + (size_t)item * 4096 + r16 * 64 + quad * 4;
#pragma unroll
                    for (int mi = 0; mi < 4; ++mi) { const float gci = gcl[16 * mi + r16];
#pragma unroll
                        for (int nj = 0; nj < 4; ++nj) {
                            v2u w; w.x = 0u; w.y = 0u;
                            if (nj <= mi) {
                                f32x4 c = (f32x4){0.f, 0.f, 0.f, 0.f};
#pragma unroll
                                for (int ks = 0; ks < 4; ++ks) c = __builtin_amdgcn_mfma_f32_16x16x32_bf16(Kf[nj][ks], Qf[mi][ks], c, 0, 0, 0);
                                const f32x4 gcj = *(const LAS f32x4*)(gcl + 16 * nj + quad * 4); float o4[4];
#pragma unroll
                                for (int r = 0; r < 4; ++r) { const bool incl = (nj < mi) || (quad * 4 + r <= r16); o4[r] = incl ? c[r] * __expf(gci - gcj[r]) : 0.f; }
                                w.x = pk2(o4[0], o4[1]); w.y = pk2(o4[2], o4[3]); }
                            *(v2u*)(ait + mi * 16 * 64 + 16 * nj) = w; }
                    }
                }
                if (q == 1) { SIT[(size_t)item * 192 + lane_l] = __expf(gc); SIT[(size_t)item * 192 + 64 + lane_l] = __expf(gl - gc); if (lane_l == 0) SIT[(size_t)item * 192 + 128] = __expf(gl); }
                asm volatile("" ::: "memory");
                { LAS float* mw = Mt + r16 * 64 + quad * 4;
#pragma unroll
                  for (int mi = 0; mi < 4; ++mi) {
                    const f32x4 gci = *(const LAS f32x4*)(gcl + 16 * mi + quad * 4), bei = *(const LAS f32x4*)(gcl + 64 + 16 * mi + quad * 4);
#pragma unroll
                    for (int nj = 0; nj <= mi; ++nj) {
                        f32x4 c = (f32x4){0.f, 0.f, 0.f, 0.f};
#pragma unroll
                        for (int ks = 0; ks < 4; ++ks) c = __builtin_amdgcn_mfma_f32_16x16x32_bf16(Kf[mi][ks], Kf[nj][ks], c, 0, 0, 0);
                        const float gcj = gcl[16 * nj + r16]; f32x4 mv4;
#pragma unroll
                        for (int r = 0; r < 4; ++r) { const bool strict = (nj < mi) || (r16 < quad * 4 + r); mv4[r] = strict ? bei[r] * c[r] * __expf(gci[r] - gcj) : 0.f; }
                        *(LAS f32x4*)(mw + (16 * nj) * 64 + 16 * mi) = mv4;
                    }
                  } }
                asm volatile("" ::: "memory");
                LDS_WAIT();
                float Xs[64];
                { const bf16* src = QKV + (size_t)rb * 1536 + (q < 2 ? 1024 + 64 * q : 512 + 64 * (q - 2)) + hh * 128 + lane_l; const long sstep = sg * 1536;
#pragma unroll
                  for (int sidx = 0; sidx < 64; ++sidx) { const bf16 w = *src; src += sstep;
                      const float sc = __builtin_bit_cast(float, __builtin_amdgcn_readlane(__builtin_bit_cast(int, scl), sidx));
                      Xs[sidx] = bf1(w) * sc; if ((sidx & 15) == 15) asm volatile("" ::: "memory"); } }
#pragma unroll
                for (int g4 = 0; g4 < 16; ++g4) {
                    f32x4 acc = (f32x4){Xs[4 * g4], Xs[4 * g4 + 1], Xs[4 * g4 + 2], Xs[4 * g4 + 3]};
#pragma unroll
                    for (int sp = 0; sp < 4 * g4; ++sp) { const f32x4 m = *(const LAS f32x4*)(Mt + sp * 64 + 4 * g4); acc -= m * Xs[sp]; if ((sp & 15) == 15) asm volatile("" ::: "memory"); }
                    const f32x4 m0 = *(const LAS f32x4*)(Mt + (4 * g4) * 64 + 4 * g4), m1 = *(const LAS f32x4*)(Mt + (4 * g4 + 1) * 64 + 4 * g4), m2 = *(const LAS f32x4*)(Mt + (4 * g4 + 2) * 64 + 4 * g4);
                    const float x0 = acc[0], x1 = acc[1] - m0[1] * x0, x2 = acc[2] - m0[2] * x0 - m1[2] * x1, x3 = acc[3] - m0[3] * x0 - m1[3] * x1 - m2[3] * x2;
                    Xs[4 * g4] = x0; Xs[4 * g4 + 1] = x1; Xs[4 * g4 + 2] = x2; Xs[4 * g4 + 3] = x3;
                    asm volatile("" ::: "memory");
                }
                if (q < 2) {
                    bf16* u0 = UIT + (size_t)item * 8192 + (size_t)(64 * q + lane_l) * 64;
#pragma unroll
                    for (int p = 0; p < 8; ++p) { float c0[8];
#pragma unroll
                        for (int e = 0; e < 8; ++e) c0[e] = Xs[8 * p + e];
                        *(v4u*)(u0 + 8 * p) = pack8(c0); }
                } else {
                    bf16* w0 = WIT + (size_t)item * 8192 + 64 * (q - 2) + lane_l;
#pragma unroll
                    for (int sidx = 0; sidx < 64; ++sidx) { w0[sidx * 128] = (bf16)f2bf(Xs[sidx]); if ((sidx & 15) == 15) asm volatile("" ::: "memory"); }
                    asm volatile("" ::: "memory");
                    if (dir == 0) {
                        const bf16* src = QKV + (size_t)row0 * 1536 + 512 + hh * 128 + 64 * (q - 2) + lane_l;
                        bf16* k0 = KIT + ((size_t)((b * 4 + hh) * 36 + cidx)) * 8192 + (size_t)(64 * (q - 2) + lane_l) * 64;
#pragma unroll
                        for (int p = 0; p < 8; ++p) { unsigned kw[8];
#pragma unroll
                            for (int e = 0; e < 8; ++e) kw[e] = src[(size_t)(8 * p + e) * 1536];
                            v4u lo; lo.x = kw[0] | (kw[1] << 16); lo.y = kw[2] | (kw[3] << 16); lo.z = kw[4] | (kw[5] << 16); lo.w = kw[6] | (kw[7] << 16);
                            *(v4u*)(k0 + 8 * p) = lo; if (p & 1) asm volatile("" ::: "memory"); }
                    }
                }
                LDS_WAIT();
            }
        }
        SEAM(pb + 3);

        if (PH_ON(5) && IN(pb + 4)) { PH_BEGIN(); const float* mv = modv + (size_t)l * 9 * 6144; (void)mv; unsigned* const moecnt = ctl + CW_MOE + l * 16 * 64; (void)moecnt;
            LAS bf16* const STl = (LAS bf16*)lds;
            LAS bf16* const VNl = (LAS bf16*)(lds + 8704);
            LAS bf16* const VSl = (LAS bf16*)(lds + 13312);
            const int w = X.wave, mt = w & 3, nt = w >> 2, r16 = lane & 15, quad = lane >> 4;
            for (int blk = X.bid; blk < 256; blk += X.G) {
                const int chain = blk >> 2, slice = blk & 3, dir = chain & 1, hh = (chain >> 1) & 3, b = chain >> 3;
                bf16* const O = dir ? OB : OF;
                __syncthreads();
                for (int i = tid; i < 32 * 136 / 2; i += 512) ((LAS unsigned*)STl)[i] = 0u;
                __syncthreads();
                f32x4 Sacc[2]; Sacc[0] = (f32x4){0.f, 0.f, 0.f, 0.f}; Sacc[1] = (f32x4){0.f, 0.f, 0.f, 0.f};
#define GDN_LOAD(P, step_) do { const int cidx_ = dir ? ((step_) < 4 ? 3 - (step_) : 39 - (step_)) : (step_); const int item_ = chain * 36 + cidx_, kti_ = (chain >> 1) * 36 + cidx_; \
                    const int row0_ = cidx_ < 4 ? NLAT + b * CTXL + cidx_ * 64 : b * SEQ + (cidx_ - 4) * 64; \
                    const bf16* wp_ = WIT + (size_t)item_ * 8192 + (16 * mt + r16) * 128 + quad * 8; const bf16* qp_ = QKV + (size_t)(row0_ + (dir ? 63 - (16 * mt + r16) : 16 * mt + r16)) * 1536 + hh * 128 + quad * 8; \
                    _Pragma("unroll") for (int ks = 0; ks < 4; ++ks) { P##Wf[ks] = *(const bf16x8*)(wp_ + 32 * ks); P##Qf[ks] = *(const bf16x8*)(qp_ + 32 * ks); } \
                    const bf16* ap_ = AIT + (size_t)item_ * 4096 + (16 * mt + r16) * 64 + quad * 8; const bf16* kp_ = KIT + (size_t)kti_ * 8192 + (16 * w + r16) * 64 + (dir ? 56 - quad * 8 : quad * 8); \
                    _Pragma("unroll") for (int ks = 0; ks < 2; ++ks) { P##Af[ks] = *(const bf16x8*)(ap_ + 32 * ks); const v4u kx_ = *(const v4u*)(kp_ + (dir ? -32 * ks : 32 * ks)); v4u kr_; \
                        kr_.x = dir ? ((kx_.w >> 16) | (kx_.w << 16)) : kx_.x; kr_.y = dir ? ((kx_.z >> 16) | (kx_.z << 16)) : kx_.y; kr_.z = dir ? ((kx_.y >> 16) | (kx_.y << 16)) : kx_.z; kr_.w = dir ? ((kx_.x >> 16) | (kx_.x << 16)) : kx_.w; \
                        P##Kt[ks] = __builtin_bit_cast(bf16x8, kr_); } \
                    P##u4 = *(const v2u*)(UIT + (size_t)item_ * 8192 + (size_t)(slice * 32 + 16 * nt + r16) * 64 + 16 * mt + quad * 4); \
                    const float* sp_ = SIT + (size_t)item_ * 192; P##egc4 = *(const f32x4*)(sp_ + 16 * mt + quad * 4); P##ksc4 = *(const f32x4*)(sp_ + 64 + 16 * mt + quad * 4); P##egl = sp_[128]; } while (0)
                bf16x8 cWf[4], cQf[4], cAf[2], cKt[2]; v2u cu4; f32x4 cegc4, cksc4; float cegl;
                GDN_LOAD(c, 0);
                for (int step = 0; step < 36; ++step) {
                    const int cidx = dir ? (step < 4 ? 3 - step : 39 - step) : step;
                    const int row0 = cidx < 4 ? NLAT + b * CTXL + cidx * 64 : b * SEQ + (cidx - 4) * 64;
                    bf16x8 nWf[4], nQf[4], nAf[2], nKt[2]; v2u nu4; f32x4 negc4, nksc4; float negl;
                    { const int sn = step + 1 < 36 ? step + 1 : step; GDN_LOAD(n, sn); }
                    f32x4 v1 = (f32x4){0.f, 0.f, 0.f, 0.f}, q1 = (f32x4){0.f, 0.f, 0.f, 0.f};
#pragma unroll
                    for (int ks = 0; ks < 4; ++ks) { const bf16x8 bfr = *(const LAS bf16x8*)(STl + (16 * nt + r16) * 136 + 32 * ks + quad * 8);
                        v1 = __builtin_amdgcn_mfma_f32_16x16x32_bf16(cWf[ks], bfr, v1, 0, 0, 0); q1 = __builtin_amdgcn_mfma_f32_16x16x32_bf16(cQf[ks], bfr, q1, 0, 0, 0); }
                    f32x4 vn; vn[0] = bflo(cu4.x) - v1[0]; vn[1] = bfhi(cu4.x) - v1[1]; vn[2] = bflo(cu4.y) - v1[2]; vn[3] = bfhi(cu4.y) - v1[3];
                    { v2u p; p.x = pk2(vn[0], vn[1]); p.y = pk2(vn[2], vn[3]); *(LAS v2u*)(VNl + (16 * nt + r16) * 72 + 16 * mt + quad * 4) = p;
                      v2u q; q.x = pk2(vn[0] * cksc4[0], vn[1] * cksc4[1]); q.y = pk2(vn[2] * cksc4[2], vn[3] * cksc4[3]); *(LAS v2u*)(VSl + (16 * nt + r16) * 72 + 16 * mt + quad * 4) = q; }
                    f32x4 oacc = q1 * cegc4;
                    __syncthreads();
                    { const bf16x8 b0 = *(const LAS bf16x8*)(VNl + (16 * nt + r16) * 72 + quad * 8), b1 = *(const LAS bf16x8*)(VNl + (16 * nt + r16) * 72 + 32 + quad * 8);
                      oacc = __builtin_amdgcn_mfma_f32_16x16x32_bf16(cAf[0], b0, oacc, 0, 0, 0); oacc = __builtin_amdgcn_mfma_f32_16x16x32_bf16(cAf[1], b1, oacc, 0, 0, 0); }
                    { bf16* op = O + (size_t)(row0 + (dir ? 63 - (16 * mt + quad * 4) : 16 * mt + quad * 4)) * 512 + hh * 128 + slice * 32 + 16 * nt + r16; const long ostep = dir ? -512 : 512;
#pragma unroll
                      for (int j = 0; j < 4; ++j) op[j * ostep] = (bf16)f2bf(oacc[j]); }
#pragma unroll
                    for (int n2 = 0; n2 < 2; ++n2) { const bf16x8 b0 = *(const LAS bf16x8*)(VSl + (16 * n2 + r16) * 72 + quad * 8), b1 = *(const LAS bf16x8*)(VSl + (16 * n2 + r16) * 72 + 32 + quad * 8);
                        f32x4 sa = Sacc[n2] * cegl; sa = __builtin_amdgcn_mfma_f32_16x16x32_bf16(cKt[0], b0, sa, 0, 0, 0); sa = __builtin_amdgcn_mfma_f32_16x16x32_bf16(cKt[1], b1, sa, 0, 0, 0); Sacc[n2] = sa;
                        v2u p; p.x = pk2(sa[0], sa[1]); p.y = pk2(sa[2], sa[3]); *(LAS v2u*)(STl + (16 * n2 + r16) * 136 + 16 * w + quad * 4) = p; }
                    __syncthreads();
#pragma unroll
                    for (int ks = 0; ks < 4; ++ks) { cWf[ks] = nWf[ks]; cQf[ks] = nQf[ks]; }
#pragma unroll
                    for (int ks = 0; ks < 2; ++ks) { cAf[ks] = nAf[ks]; cKt[ks] = nKt[ks]; }
                    cu4 = nu4; cegc4 = negc4; cksc4 = nksc4; cegl = negl;
                }
#undef GDN_LOAD
            }
        }
        SEAM(pb + 4);

        if (PH_ON(6) && IN(pb + 5)) { PH_BEGIN(); const float* mv = modv + (size_t)l * 9 * 6144; (void)mv; unsigned* const moecnt = ctl + CW_MOE + l * 16 * 64; (void)moecnt;
            const float* nw = INP(I_GNORM) + l * 128; const int ch = 8 * lane;
            for (int row = gw; row < nrows2; row += NGW) {
                float of[8], ob[8]; unpack8(*(const v4u*)(OF + (size_t)row * 512 + ch), of); unpack8(*(const v4u*)(OB + (size_t)row * 512 + ch), ob);
                const f32x4 a0 = (f32x4){of[0] + ob[0], of[1] + ob[1], of[2] + ob[2], of[3] + ob[3]}, a1 = (f32x4){of[4] + ob[4], of[5] + ob[5], of[6] + ob[6], of[7] + ob[7]};
                float ss = (a0[0] * a0[0] + a0[1] * a0[1]) + (a0[2] * a0[2] + a0[3] * a0[3]) + (a1[0] * a1[0] + a1[1] * a1[1]) + (a1[2] * a1[2] + a1[3] * a1[3]);
                const float rs = 1.0f / sqrtf(g16_sum(ss) * (1.0f / 128.0f) + LN_EPS);
                float z[8]; unpack8(*(const v4u*)(PZ + (size_t)row * 512 + ch), z); float o[8];
#pragma unroll
                for (int e = 0; e < 4; ++e) { o[e] = a0[e] * rs * nw[(ch & 127) + e] * z[e]; o[4 + e] = a1[e] * rs * nw[(ch & 127) + 4 + e] * z[4 + e]; }
                *(v4u*)(BR + (size_t)row * 512 + ch) = pack8(o);
            }
        }
        SEAM(pb + 5);

        if (PH_ON(7) && IN(pb + 6)) { PH_BEGIN(); const float* mv = modv + (size_t)l * 9 * 6144; (void)mv; unsigned* const moecnt = ctl + CW_MOE + l * 16 * 64; (void)moecnt;
            SchedGrid S{X.G, X.bid, npan2, 16, (const char*)XN, (const char*)(WIN + (size_t)5120 * 1024), (size_t)256 * 1024 * 2, (size_t)256 * 1024 * 2};
            EpiBf16<1> E{GT, 4096, binv + 5120};
            pg8::gemm_phase<EpiBf16<1>, SchedGrid, true, true>(lds, Gemm{1024, 1024, 1024}, S, E);
        }
        SEAM(pb + 6);

        if (PH_ON(8) && IN(pb + 7)) { PH_BEGIN(); const float* mv = modv + (size_t)l * 9 * 6144; (void)mv; unsigned* const moecnt = ctl + CW_MOE + l * 16 * 64; (void)moecnt;
            SchedBranch S{X.G, X.bid, npan2, (const char*)BR, (const char*)WBR};
            EpiBranch E{MERGED, XN, GT};
            pg8::gemm_phase<EpiBranch, SchedBranch, true, true>(lds, Gemm{512, 512, 512}, S, E);
        }
        SEAM(pb + 7);

        if (PH_ON(9) && IN(pb + 8)) { PH_BEGIN(); const float* mv = modv + (size_t)l * 9 * 6144; (void)mv; unsigned* const moecnt = ctl + CW_MOE + l * 16 * 64; (void)moecnt;
            SchedGrid S{X.G, X.bid, npan2, 4, (const char*)XN, (const char*)WOUT, (size_t)256 * 1024 * 2, (size_t)256 * 1024 * 2};
            EpiF32 E{YB, 1024, INP(I_BOUT) + l * 1024};
            pg8::gemm_phase<EpiF32, SchedGrid, true, true>(lds, Gemm{1024, 1024, 1024}, S, E);
        }
        SEAM(pb + 8);

        if (PH_ON(10) && IN(pb + 9)) { PH_BEGIN(); const float* mv = modv + (size_t)l * 9 * 6144; (void)mv; unsigned* const moecnt = ctl + CW_MOE + l * 16 * 64; (void)moecnt;
            for (int it = X.bid; it < 16 * 16 * 16; it += X.G) { const int e = it >> 8, rb = (it >> 4) & 15, kb = it & 15, row0 = rb * 64, j = row0 >> 8, w = row0 & 255;
                const float* src = (w < 128 ? INP(I_EWG) : INP(I_EWU)) + ((size_t)(l * 16 + e) * 1024) * 512 + 128 * j + (w & 127);
                cvt_tile(X, src, 512, kb * 64, WGU + ((size_t)e * 1024 + row0) * 1024, 1024); }
            for (int it = X.bid; it < 16 * 16 * 8; it += X.G) { const int e = it >> 7, rb = (it >> 3) & 15, kb = it & 7;
                cvt_tile(X, INP(I_EWD) + ((size_t)(l * 16 + e) * 512) * 1024 + rb * 64, 1024, kb * 64, WDN + ((size_t)e * 1024 + rb * 64) * 512, 512); }
            LAS float* wr_ = (LAS float*)lds;
            __syncthreads();
            for (int i = tid; i < 20 * 1024; i += 512) { const int o = i >> 10, k = i & 1023; wr_[i] = o < 4 ? INP(I_RGW)[(size_t)l * 4096 + k * 4 + o] : INP(I_REW)[(size_t)l * 16384 + k * 16 + (o - 4)]; }
            __syncthreads();
            const float* g1 = INP(I_LN1G) + l * 1024, *b1 = INP(I_LN1B) + l * 1024;
            for (int row = gw; row < nrows2; row += NGW) {
                float* hrow = row < NLAT ? hlat + (size_t)row * D : hctx + (size_t)(row - NLAT) * D;
                const int mi = row < NLAT ? (row >> 11) : 8; const float* mrow = mv + mi * 6144;
                f32x4 v[4];
#pragma unroll
                for (int j = 0; j < 4; ++j) { const int c = 4 * lane + 256 * j; v[j] = *(const f32x4*)(hrow + c) * DN_ALPHA + *(const f32x4*)(mrow + 2048 + c) * *(const f32x4*)(YB + (size_t)row * D + c); }
                ln_rows(v);
#pragma unroll
                for (int j = 0; j < 4; ++j) { const int c = 4 * lane + 256 * j; v[j] = v[j] * *(const f32x4*)(g1 + c) + *(const f32x4*)(b1 + c); *(f32x4*)(hrow + c) = v[j]; }
                ln_rows(v);
#pragma unroll
                for (int j = 0; j < 4; ++j) { const int c = 4 * lane + 256 * j; v[j] = v[j] * (*(const f32x4*)(mrow + 4096 + c) + 1.0f) + *(const f32x4*)(mrow + 3072 + c);
                    v2u w; w.x = pk2(v[j][0], v[j][1]); w.y = pk2(v[j][2], v[j][3]); *(v2u*)(XN + (size_t)row * D + c) = w; }
                float mylg = 0.f;
#pragma unroll 2
                for (int o = 0; o < 20; ++o) { float s = 0.f;
#pragma unroll
                    for (int j = 0; j < 4; ++j) { const f32x4 w = *(const LAS f32x4*)(wr_ + o * 1024 + 4 * lane + 256 * j); s += (v[j][0] * w[0] + v[j][1] * w[1]) + (v[j][2] * w[2] + v[j][3] * w[3]); }
                    s = wave_sum(s); if (lane == o) mylg = s; }
                if (lane < 20) mylg += (lane < 4 ? INP(I_RGB)[l * 4 + lane] : INP(I_REB)[l * 16 + lane - 4]);
                float lg[20];
#pragma unroll
                for (int o = 0; o < 20; ++o) lg[o] = __shfl(mylg, o);
                int gs = 0; float gm = lg[0];
#pragma unroll
                for (int o = 1; o < 4; ++o) if (lg[o] > gm) { gm = lg[o]; gs = o; }
                float den = 0.f;
#pragma unroll
                for (int o = 0; o < 4; ++o) den += expf(lg[o] - gm);
                const float gp = 1.0f / den;
                float el[4];
#pragma unroll
                for (int o = 0; o < 4; ++o) el[o] = gs == 0 ? lg[4 + o] : gs == 1 ? lg[8 + o] : gs == 2 ? lg[12 + o] : lg[16 + o];
                int i0 = 0; float v0 = el[0];
#pragma unroll
                for (int o = 1; o < 4; ++o) if (el[o] > v0) { v0 = el[o]; i0 = o; }
                int i1 = -1; float v1 = 0.f;
#pragma unroll
                for (int o = 0; o < 4; ++o) if (o != i0 && (i1 < 0 || el[o] > v1)) { v1 = el[o]; i1 = o; }
                const float ex = expf(v1 - v0), w0 = gp / (1.0f + ex), w1 = gp * ex / (1.0f + ex);
                const int e0 = gs * 4 + i0, e1 = gs * 4 + i1;
                if (lane == 0) {
                    const unsigned p0 = __hip_atomic_fetch_add(moecnt + 64 * e0, 1u, __ATOMIC_RELAXED, __HIP_MEMORY_SCOPE_AGENT);
                    const unsigned p1 = __hip_atomic_fetch_add(moecnt + 64 * e1, 1u, __ATOMIC_RELAXED, __HIP_MEMORY_SCOPE_AGENT);
                    float* rt = ROUTE + (size_t)row * 8;
                    rt[0] = __builtin_bit_cast(float, e0); rt[1] = __builtin_bit_cast(float, e1); rt[2] = w0; rt[3] = w1; rt[4] = __builtin_bit_cast(float, (int)p0); rt[5] = __builtin_bit_cast(float, (int)p1);
                }
            }
        }
        SEAM(pb + 9);

        if (PH_ON(11) && IN(pb + 10)) { PH_BEGIN(); const float* mv = modv + (size_t)l * 9 * 6144; (void)mv; unsigned* const moecnt = ctl + CW_MOE + l * 16 * 64; (void)moecnt;
            unsigned pre[16]; { unsigned s = 0;
#pragma unroll
                for (int e = 0; e < 16; ++e) { pre[e] = s; s += ((__hip_atomic_load(moecnt + 64 * e, __ATOMIC_RELAXED, __HIP_MEMORY_SCOPE_AGENT) + 255u) >> 8) << 8; } }
            for (int as = gw; as < nrows2 * 2; as += NGW) { const int row = as >> 1, sl = as & 1; const float* rt = ROUTE + (size_t)row * 8;
                const int e = __builtin_bit_cast(int, rt[sl]), p = __builtin_bit_cast(int, rt[4 + sl]); unsigned base = 0;
#pragma unroll
                for (int k = 0; k < 16; ++k) base = (k == e) ? pre[k] : base;
                const size_t dst = (size_t)(base + (unsigned)p) * D;
#pragma unroll
                for (int j = 0; j < 2; ++j) *(v4u*)(XG + dst + 8 * lane + 512 * j) = *(const v4u*)(XN + (size_t)row * D + 8 * lane + 512 * j);
            }
        }
        SEAM(pb + 10);

        if (PH_ON(12) && IN(pb + 11)) { PH_BEGIN(); const float* mv = modv + (size_t)l * 9 * 6144; (void)mv; unsigned* const moecnt = ctl + CW_MOE + l * 16 * 64; (void)moecnt;
            SchedMoe S; S.G = X.G; S.c = X.bid; S.a0 = (const char*)XG; S.w0 = (const char*)WGU; S.astep = (size_t)256 * 1024 * 2; S.wstep_e = (size_t)1024 * 1024 * 2; S.wstep_n = (size_t)256 * 1024 * 2; S.init(moecnt);
            EpiMoe1 E{HID};
            pg8::gemm_phase<EpiMoe1, SchedMoe, true, true>(lds, Gemm{1024, 1024, 1024}, S, E);
        }
        SEAM(pb + 11);

        if (PH_ON(13) && IN(pb + 12)) { PH_BEGIN(); const float* mv = modv + (size_t)l * 9 * 6144; (void)mv; unsigned* const moecnt = ctl + CW_MOE + l * 16 * 64; (void)moecnt;
            SchedMoe S; S.G = X.G; S.c = X.bid; S.a0 = (const char*)HID; S.w0 = (const char*)WDN; S.astep = (size_t)256 * 512 * 2; S.wstep_e = (size_t)1024 * 512 * 2; S.wstep_n = (size_t)256 * 512 * 2; S.init(moecnt);
            EpiBf16<0> E{MO, 1024, nullptr};
            pg8::gemm_phase<EpiBf16<0>, SchedMoe, true, true>(lds, Gemm{512, 512, 512}, S, E);
        }
        SEAM(pb + 12);

        if (PH_ON(14) && IN(pb + 13)) { PH_BEGIN(); const float* mv = modv + (size_t)l * 9 * 6144; (void)mv; unsigned* const moecnt = ctl + CW_MOE + l * 16 * 64; (void)moecnt;
            unsigned pre[16]; { unsigned s = 0;
#pragma unroll
                for (int e = 0; e < 16; ++e) { pre[e] = s; s += ((__hip_atomic_load(moecnt + 64 * e, __ATOMIC_RELAXED, __HIP_MEMORY_SCOPE_AGENT) + 255u) >> 8) << 8; } }
            const float* g2 = INP(I_LN2G) + l * 1024, *b2 = INP(I_LN2B) + l * 1024;
            for (int row = gw; row < nrows2; row += NGW) {
                float* hrow = row < NLAT ? hlat + (size_t)row * D : hctx + (size_t)(row - NLAT) * D;
                const int mi = row < NLAT ? (row >> 11) : 8; const float* mrow = mv + mi * 6144;
                const float* rt = ROUTE + (size_t)row * 8;
                const int e0 = __builtin_bit_cast(int, rt[0]), e1 = __builtin_bit_cast(int, rt[1]), p0 = __builtin_bit_cast(int, rt[4]), p1 = __builtin_bit_cast(int, rt[5]); const float w0 = rt[2], w1 = rt[3];
                unsigned ba0 = 0, ba1 = 0;
#pragma unroll
                for (int k = 0; k < 16; ++k) { ba0 = (k == e0) ? pre[k] : ba0; ba1 = (k == e1) ? pre[k] : ba1; }
                const bf16* m0 = MO + (size_t)(ba0 + (unsigned)p0) * D, *m1 = MO + (size_t)(ba1 + (unsigned)p1) * D;
                f32x4 v[4];
#pragma unroll
                for (int j = 0; j < 4; ++j) { const int c = 4 * lane + 256 * j; const v2u a = *(const v2u*)(m0 + c), b = *(const v2u*)(m1 + c);
                    f32x4 mm; mm[0] = w0 * bflo(a.x) + w1 * bflo(b.x); mm[1] = w0 * bfhi(a.x) + w1 * bfhi(b.x); mm[2] = w0 * bflo(a.y) + w1 * bflo(b.y); mm[3] = w0 * bfhi(a.y) + w1 * bfhi(b.y);
                    v[j] = *(const f32x4*)(hrow + c) * DN_ALPHA + *(const f32x4*)(mrow + 5120 + c) * mm; }
                ln_rows(v);
#pragma unroll
                for (int j = 0; j < 4; ++j) { const int c = 4 * lane + 256 * j; *(f32x4*)(hrow + c) = v[j] * *(const f32x4*)(g2 + c) + *(const f32x4*)(b2 + c); }
            }
        }
        SEAM(pb + 13);
    }
#undef IN
#undef SEAM
}

extern "C" void kernel_launch(void* const* d_in, const int* in_sizes, int n_in, void* d_out, int out_size, void* d_ws, size_t ws_size, hipStream_t stream) {
    static int grid = 0;
    if (grid == 0) {
        if (n_in != 34 || out_size != NLAT * D || ws_size < WS_END) { fprintf(stderr, "kernel_launch: unexpected problem (n_in %d out %d ws %zu)\n", n_in, out_size, ws_size); grid = -1; return; }
        int dev = 0, cus = 0, per_cu = 0;
        if (hipGetDevice(&dev) != hipSuccess || hipDeviceGetAttribute(&cus, hipDeviceAttributeMultiprocessorCount, dev) != hipSuccess) { grid = -1; return; }
        if (hipFuncSetAttribute((const void*)fwd, hipFuncAttributeMaxDynamicSharedMemorySize, LDS_BYTES) != hipSuccess) { fprintf(stderr, "kernel_launch: hipFuncSetAttribute failed\n"); grid = -1; return; }
        if (hipOccupancyMaxActiveBlocksPerMultiprocessor(&per_cu, (const void*)fwd, NWAVES * 64, LDS_BYTES) != hipSuccess || per_cu < 1) { fprintf(stderr, "kernel_launch: occupancy query reports %d\n", per_cu); }
        (void)hipGetLastError();
        grid = cus;
    }
    if (grid < 0) return;
    if (hipMemsetAsync((char*)d_ws + WS_CTL, 0, CTL_ZERO_BYTES, stream) != hipSuccess) return;
    Args a{};
    for (int i = 0; i < 34; ++i) a.in[i] = (const float*)d_in[i];
    a.out = (float*)d_out; a.ws = (unsigned char*)d_ws;
#if MK_ONE_LAUNCH
    a.ph_lo = 0; a.ph_hi = NPHASES;
    hipLaunchKernelGGL(fwd, dim3(grid), dim3(NWAVES * 64), LDS_BYTES, stream, a);
#else
    for (int p = 0; p < NPHASES; ++p) { a.ph_lo = p; a.ph_hi = p + 1; hipLaunchKernelGGL(fwd, dim3(grid), dim3(NWAVES * 64), LDS_BYTES, stream, a); }
#endif
}
```

```cpp
#include <hip/hip_runtime.h>
#include <cstdio>
#include <cstdint>

#define GAS __attribute__((address_space(1)))
#define LAS __attribute__((address_space(3)))
typedef unsigned short bf16;
typedef unsigned v4u __attribute__((ext_vector_type(4)));
typedef unsigned v2u __attribute__((ext_vector_type(2)));
typedef float f32x4 __attribute__((ext_vector_type(4)));
typedef float f32x2 __attribute__((ext_vector_type(2)));
typedef short bf16x8 __attribute__((ext_vector_type(8)));

constexpr int D = 1024, NB = 8, SEQ = 2048, CTXL = 256, NLAT = NB * SEQ, NCTX = NB * CTXL, NTOK = NLAT + NCTX;
constexpr int OFF_Q = 0, OFF_K = 512, OFF_V = 1024, OFF_Z = 1536, OFF_A = 2048, OFF_B = 2056, OFF_CONF = 2064, OFF_FFT = 3088, OFF_SGU = 3600, OFF_GATE = 4624, N_IN = 8720;
constexpr int NWROWS = 9216;
constexpr float LN_EPS = 1e-6f;
constexpr float DN_ALPHA = 1.4142135623730951f;
constexpr int NWAVES = 8;
constexpr int NPH_LAYER = 14, NPHASES = 1 + 2 * NPH_LAYER;

#ifndef PHMASK
#define PHMASK 0xFFFFFFFFu
#endif
#define PH_ON(k) (((PHMASK) >> (k)) & 1u)
#ifndef REPMASK
#define REPMASK 0u
#endif
#define PH_REP(k) (((REPMASK) >> (k)) & 1u)
#ifndef CPART
#define CPART 15
#endif
#ifndef MK_ONE_LAUNCH
#define MK_ONE_LAUNCH 1
#endif

constexpr size_t MiB = 1u << 20;
constexpr size_t WS_CTL = 0, CTL_ZERO_BYTES = 1 * MiB;
constexpr size_t WS_MODV = 1 * MiB;
constexpr size_t WS_BIN = 1 * MiB + 512 * 1024;
constexpr size_t WS_ROUTE = WS_BIN + 64 * 1024;
constexpr size_t WS_HCTX = 3 * MiB;
constexpr size_t WS_XN = 11 * MiB;
constexpr size_t WS_WIN = 47 * MiB;
constexpr size_t WS_WBR = 65 * MiB;
constexpr size_t WS_WOUT = 69 * MiB;
constexpr size_t WS_DFTL = 71 * MiB;
constexpr size_t WS_DFTC = 87 * MiB;
constexpr size_t WS_R2 = 88 * MiB;
constexpr size_t WS_PQKV = WS_R2;
constexpr size_t WS_PCONF = WS_R2 + 54 * MiB;
constexpr size_t WS_PZ = WS_R2 + 72 * MiB;
constexpr size_t WS_PSGU = WS_R2 + 90 * MiB;
constexpr size_t WS_PFFT = WS_R2 + 126 * MiB;
constexpr size_t WS_PFFTC = WS_R2 + 158 * MiB;
constexpr size_t WS_AB = WS_R2 + 162 * MiB;
constexpr size_t WS_WIT = WS_R2;
constexpr size_t WS_UIT = WS_R2 + 36 * MiB;
constexpr size_t WS_AIT = WS_R2 + 90 * MiB;
constexpr size_t WS_KIT = WS_R2 + 108 * MiB;
constexpr size_t WS_SIT = WS_R2 + 126 * MiB;
constexpr size_t WS_OF = WS_R2 + 128 * MiB;
constexpr size_t WS_OB = WS_R2 + 146 * MiB;
constexpr size_t WS_G = WS_R2;
constexpr size_t WS_WGU = WS_R2;
constexpr size_t WS_WDN = WS_R2 + 32 * MiB;
constexpr size_t WS_XG = WS_R2 + 48 * MiB;
constexpr size_t WS_R3 = WS_R2 + 164 * MiB;
constexpr size_t WS_QKV = WS_R3;
constexpr size_t WS_GB = WS_R3 + 54 * MiB;
constexpr size_t WS_BR = WS_R3 + 72 * MiB;
constexpr size_t WS_MERGED = WS_R3;
constexpr size_t WS_Y = WS_R3 + 72 * MiB;
constexpr size_t WS_HID = WS_R3;
constexpr size_t WS_MO = WS_R3 + 40 * MiB;
constexpr size_t WS_END = WS_R3 + 144 * MiB;
static_assert(WS_END <= 405 * MiB, "workspace map");
constexpr int CW_BAR = 4096;
constexpr int CW_MOE = 16384;

constexpr int RING_BYTES = 131072;
constexpr int LDSCTL_OFF = RING_BYTES, MISC_OFF = LDSCTL_OFF + 320;
constexpr int LDS_BYTES = 147456;

#define LDS_WAIT() asm volatile("s_waitcnt lgkmcnt(0)" ::: "memory")
#define VM_WAIT() asm volatile("s_waitcnt vmcnt(0)" ::: "memory")
__device__ __forceinline__ unsigned f2bf(float f) { unsigned u = __builtin_bit_cast(unsigned, f); return (u + 0x7fffu + ((u >> 16) & 1u)) >> 16; }
__device__ __forceinline__ unsigned pk2(float lo, float hi) { return f2bf(lo) | (f2bf(hi) << 16); }
__device__ __forceinline__ float bflo(unsigned w) { return __builtin_bit_cast(float, w << 16); }
__device__ __forceinline__ float bfhi(unsigned w) { return __builtin_bit_cast(float, w & 0xffff0000u); }
__device__ __forceinline__ float bf1(bf16 b) { return __builtin_bit_cast(float, ((unsigned)b) << 16); }
__device__ __forceinline__ void unpack8(const v4u w, float (&o)[8]) { o[0] = bflo(w.x); o[1] = bfhi(w.x); o[2] = bflo(w.y); o[3] = bfhi(w.y); o[4] = bflo(w.z); o[5] = bfhi(w.z); o[6] = bflo(w.w); o[7] = bfhi(w.w); }
__device__ __forceinline__ v4u pack8(const float (&o)[8]) { v4u w; w.x = pk2(o[0], o[1]); w.y = pk2(o[2], o[3]); w.z = pk2(o[4], o[5]); w.w = pk2(o[6], o[7]); return w; }
__device__ __forceinline__ float sigmoidf_(float x) { return 1.0f / (1.0f + __expf(-x)); }
__device__ __forceinline__ float siluf_(float x) { return x / (1.0f + __expf(-x)); }
__device__ __forceinline__ float gelu_tanh(float x) { const float u = 0.7978845608028654f * (x + 0.044715f * x * x * x); return x / (1.0f + __expf(-2.0f * u)); }
__device__ __forceinline__ float wave_sum(float v) {
#pragma unroll
    for (int o = 1; o < 64; o <<= 1) v += __shfl_xor(v, o);
    return v;
}
__device__ __forceinline__ float g16_sum(float v) {
#pragma unroll
    for (int o = 1; o < 16; o <<= 1) v += __shfl_xor(v, o);
    return v;
}

namespace pg8 {
constexpr int BM = 256, BK = 64, HALF = 128, HTB = HALF * BK * 2, STAGE_BYTES = 8 * HTB;
__host__ __device__ __forceinline__ int lds_byte(int r, int c) { const int st = (r >> 4) * 2 + (c >> 5), rr = r & 15, cc = c & 31, ob = rr * 64 + cc * 2; return st * 1024 + (ob ^ (((ob >> 9) & 1) << 5)); }
__host__ __device__ __forceinline__ void stage_rc(int b, int& R, int& C) { const int st = b / 1024, sb = b % 1024, swz = sb ^ (((sb >> 9) & 1) << 5); R = (st >> 1) * 16 + swz / 64; C = (st & 1) * 32 + (swz % 64) / 2; }
__host__ __device__ __forceinline__ int perm32(int rho) { const int n = rho >> 4, i = rho & 15; return 8 * (i >> 2) + 4 * n + (i & 3); }

struct Unit { int pm, pn, aux; const char* a; const char* b; };
struct Gemm { int K, lda, ldb; };

__device__ __forceinline__ void map_tile(int L, int nM, int nN, int& pm, int& pn) {
    const int nwg = nM * nN; int wgid = L; { const int q = nwg / 8, r = nwg % 8, xcd = wgid % 8, off = wgid / 8; wgid = (xcd < r ? xcd * (q + 1) : r * (q + 1) + (xcd - r) * q) + off; }
    const int nig = 8 * nN, gid = wgid / nig, fm = gid * 8, gsz = (nM - fm) < 8 ? (nM - fm) : 8;
    pm = fm + ((wgid % nig) % gsz); pn = (wgid % nig) / gsz;
}
__device__ __forceinline__ unsigned cvt_pk_bf16(float lo, float hi) { unsigned r; asm volatile("v_cvt_pk_bf16_f32 %0, %1, %2" : "=v"(r) : "v"(lo), "v"(hi)); return r; }

template <class Epi, class Sched, bool ALIGN_EPI, bool SP2>
__device__ __forceinline__ void gemm_phase(LAS unsigned char* lds, const Gemm g, const Sched& S, const Epi& E) {
    int tid_l = threadIdx.x; asm volatile("" : "+v"(tid_l));
    const int tid = tid_l, wid = __builtin_amdgcn_readfirstlane(tid >> 6), lane = tid & 63, wr = wid >> 2, wc = wid & 3, fr = lane & 15, fq = lane >> 4;
    const int K = g.K, nt = K / BK;
    unsigned voffA[2], voffB[2];
#pragma unroll
    for (int i = 0; i < 2; ++i) { int R, C; stage_rc(tid * 16 + i * 8192, R, C); const int Rb = Epi::PERM ? ((R & ~31) + perm32(R & 31)) : R;
        voffA[i] = (unsigned)(R * g.lda + C) * 2u; voffB[i] = (unsigned)(Rb * g.ldb + C) * 2u; }
    const size_t kstep = (size_t)(BK * 2);
    const size_t hstepA = (size_t)HALF * g.lda * 2, hstepB = (size_t)HALF * g.ldb * 2;
    const unsigned ldsw = (unsigned)wid * 1024u;
    const int aoff = lds_byte(wr * 64 + fr, fq * 8), boff = lds_byte(wc * 32 + fr, fq * 8);
#define PG8_SA(b, h) (((b) * 2 + (h)) * HTB)
#define PG8_SB(b, h) ((4 + (b) * 2 + (h)) * HTB)
#define PG8_STAGE(bufoff, gbase, voff) do { _Pragma("unroll") for (int _i = 0; _i < 2; ++_i) \
        __builtin_amdgcn_global_load_lds((const unsigned*)((const char*)(gbase) + (voff)[_i]), (LAS unsigned*)(lds + (bufoff) + ldsw + _i * 8192), 16, 0, 0); } while (0)
#define PG8_LDA(dst, b, h) do { _Pragma("unroll") for (int m = 0; m < 4; ++m) _Pragma("unroll") for (int k = 0; k < 2; ++k) dst[m][k] = *(const LAS bf16x8*)(lds + PG8_SA(b, h) + aoff + m * 2048 + k * 1024); } while (0)
#define PG8_LDB(dst, b, h) do { _Pragma("unroll") for (int n = 0; n < 2; ++n) _Pragma("unroll") for (int k = 0; k < 2; ++k) dst[n][k] = *(const LAS bf16x8*)(lds + PG8_SB(b, h) + boff + n * 2048 + k * 1024); } while (0)
#define PG8_MMA(ai, bj, At, Bt) do { __builtin_amdgcn_s_setprio(1); _Pragma("unroll") for (int m = 0; m < 4; ++m) _Pragma("unroll") for (int n = 0; n < 2; ++n) _Pragma("unroll") for (int k = 0; k < 2; ++k) \
        acc[ai][bj][m][n] = __builtin_amdgcn_mfma_f32_16x16x32_bf16(Bt[n][k], At[m][k], acc[ai][bj][m][n], 0, 0, 0); __builtin_amdgcn_s_setprio(0); } while (0)
#define PG8_WAIT_V(n) asm volatile("s_waitcnt vmcnt(" #n ")" ::: "memory")
#define PG8_WAIT_L(n) asm volatile("s_waitcnt lgkmcnt(" #n ")" ::: "memory")
#define PG8_BAR __builtin_amdgcn_s_barrier()
#define PG8_SCHED __builtin_amdgcn_sched_barrier(0)
    Unit cur, nxt; int ui = 0;
    if (!S.next(0, cur)) return;
    f32x4 acc[2][2][4][2];
#pragma unroll
    for (int a = 0; a < 2; ++a)
#pragma unroll
        for (int b = 0; b < 2; ++b)
#pragma unroll
            for (int m = 0; m < 4; ++m)
#pragma unroll
                for (int n = 0; n < 2; ++n) acc[a][b][m][n] = (f32x4){0.f, 0.f, 0.f, 0.f};
    bf16x8 At[4][2], B0[2][2], B1[2][2];
    const char* cA = cur.a; const char* cB = cur.b;
    if constexpr (SP2) {
        PG8_STAGE(PG8_SB(0, 0), cB, voffB); PG8_STAGE(PG8_SB(0, 1), cB + hstepB, voffB); PG8_STAGE(PG8_SA(0, 0), cA, voffA); PG8_STAGE(PG8_SA(0, 1), cA + hstepA, voffA);
        if (wr == 1) PG8_BAR;
        PG8_WAIT_V(2); PG8_BAR;
        PG8_STAGE(PG8_SB(1, 0), cB + kstep, voffB); PG8_STAGE(PG8_SA(1, 0), cA + kstep, voffA); PG8_STAGE(PG8_SB(1, 1), cB + hstepB + kstep, voffB);
        PG8_WAIT_V(6); PG8_BAR;
    } else {
        PG8_STAGE(PG8_SB(0, 0), cB, voffB); PG8_STAGE(PG8_SA(0, 0), cA, voffA); PG8_STAGE(PG8_SB(0, 1), cB + hstepB, voffB); PG8_STAGE(PG8_SA(0, 1), cA + hstepA, voffA);
        if (wr == 1) PG8_BAR;
        PG8_WAIT_V(4); PG8_BAR;
        PG8_STAGE(PG8_SB(1, 0), cB + kstep, voffB); PG8_STAGE(PG8_SA(1, 0), cA + kstep, voffA); PG8_STAGE(PG8_SB(1, 1), cB + hstepB + kstep, voffB);
        PG8_WAIT_V(6); PG8_BAR;
    }
    for (;;) {
        const bool has_next = S.next(ui + 1, nxt);
        const char* nA = has_next ? nxt.a : cA; const char* nB = has_next ? nxt.b : cB;
        for (int t = 0; t < nt; t += 2) {
            const bool last = (t == nt - 2);
            const char* a1 = cA + (size_t)(t + 1) * kstep;
            const char* a2 = last ? nA : cA + (size_t)(t + 2) * kstep; const char* b2 = last ? nB : cB + (size_t)(t + 2) * kstep;
            const char* a3 = a2 + kstep; const char* b3 = b2 + kstep;
            if constexpr (SP2) {
            PG8_LDB(B0, 0, 0); PG8_LDB(B1, 0, 1); PG8_SCHED; PG8_LDA(At, 0, 0); PG8_STAGE(PG8_SA(1, 1), a1 + hstepA, voffA);
            PG8_WAIT_V(8); PG8_WAIT_L(0); PG8_BAR; PG8_MMA(0, 0, At, B0); PG8_MMA(0, 1, At, B1); PG8_BAR; PG8_SCHED;
            PG8_LDA(At, 0, 1); PG8_STAGE(PG8_SB(0, 0), b2, voffB); PG8_STAGE(PG8_SB(0, 1), b2 + hstepB, voffB); PG8_STAGE(PG8_SA(0, 0), a2, voffA);
            PG8_WAIT_V(8); PG8_WAIT_L(0); PG8_BAR; PG8_MMA(1, 0, At, B0); PG8_MMA(1, 1, At, B1); PG8_BAR; PG8_SCHED;
            PG8_LDB(B0, 1, 0); PG8_LDB(B1, 1, 1); PG8_SCHED; PG8_LDA(At, 1, 0); PG8_STAGE(PG8_SA(0, 1), a2 + hstepA, voffA);
            PG8_WAIT_V(8); PG8_WAIT_L(0); PG8_BAR; PG8_MMA(0, 0, At, B0); PG8_MMA(0, 1, At, B1); PG8_BAR; PG8_SCHED;
            PG8_LDA(At, 1, 1); PG8_STAGE(PG8_SB(1, 0), b3, voffB); PG8_STAGE(PG8_SB(1, 1), b3 + hstepB, voffB); PG8_STAGE(PG8_SA(1, 0), a3, voffA);
            PG8_WAIT_V(8); PG8_WAIT_L(0); PG8_BAR; PG8_MMA(1, 0, At, B0); PG8_MMA(1, 1, At, B1); PG8_BAR; PG8_SCHED;
            } else {
            PG8_LDB(B0, 0, 0); PG8_SCHED; PG8_LDA(At, 0, 0); PG8_STAGE(PG8_SA(1, 1), a1 + hstepA, voffA);
            PG8_WAIT_L(8); PG8_BAR; PG8_WAIT_L(0); PG8_MMA(0, 0, At, B0); PG8_BAR; PG8_SCHED;
            PG8_LDB(B1, 0, 1); PG8_STAGE(PG8_SB(0, 0), b2, voffB);
            PG8_BAR; PG8_WAIT_L(0); PG8_MMA(0, 1, At, B1); PG8_BAR;
            PG8_LDA(At, 0, 1); PG8_STAGE(PG8_SA(0, 0), a2, voffA);
            PG8_BAR; PG8_WAIT_L(0); PG8_MMA(1, 0, At, B0); PG8_BAR; PG8_SCHED;
            PG8_STAGE(PG8_SB(0, 1), b2 + hstepB, voffB);
            PG8_WAIT_V(6); PG8_BAR; PG8_MMA(1, 1, At, B1); PG8_BAR;
            PG8_LDB(B0, 1, 0); PG8_SCHED; PG8_LDA(At, 1, 0); PG8_STAGE(PG8_SA(0, 1), a2 + hstepA, voffA);
            PG8_WAIT_L(8); PG8_BAR; PG8_WAIT_L(0); PG8_MMA(0, 0, At, B0); PG8_BAR; PG8_SCHED;
            PG8_LDB(B1, 1, 1); PG8_STAGE(PG8_SB(1, 0), b3, voffB);
            PG8_BAR; PG8_WAIT_L(0); PG8_MMA(0, 1, At, B1); PG8_BAR;
            PG8_LDA(At, 1, 1); PG8_STAGE(PG8_SA(1, 0), a3, voffA);
            PG8_BAR; PG8_WAIT_L(0); PG8_MMA(1, 0, At, B0); PG8_BAR; PG8_SCHED;
            PG8_STAGE(PG8_SB(1, 1), b3 + hstepB, voffB);
            PG8_WAIT_V(6); PG8_BAR; PG8_MMA(1, 1, At, B1); PG8_BAR;
            }
        }
        if constexpr (ALIGN_EPI) { if (wr == 0) PG8_BAR; }
        E(acc, cur, wr, wc, fr, fq);
        if (!has_next) break;
#pragma unroll
        for (int a = 0; a < 2; ++a)
#pragma unroll
            for (int b = 0; b < 2; ++b)
#pragma unroll
                for (int m = 0; m < 4; ++m)
#pragma unroll
                    for (int n = 0; n < 2; ++n) acc[a][b][m][n] = (f32x4){0.f, 0.f, 0.f, 0.f};
        cur = nxt; cA = nA; cB = nB; ++ui;
        if constexpr (ALIGN_EPI) { if (wr == 1) PG8_BAR; }
    }
    PG8_WAIT_V(0);
    if constexpr (!ALIGN_EPI) { if (wr == 0) PG8_BAR; }
    PG8_BAR;
#undef PG8_SA
#undef PG8_SB
#undef PG8_STAGE
#undef PG8_LDA
#undef PG8_LDB
#undef PG8_MMA
#undef PG8_WAIT_V
#undef PG8_WAIT_L
#undef PG8_BAR
#undef PG8_SCHED
}
}
using pg8::Unit;
using pg8::Gemm;
typedef f32x4 AccT[2][2][4][2];

#define XB_TMO      128
#define XB_XCNT(j)  (256  + 64 * (j))
#define XB_XSUB(j)  (1280 + 64 * (j))
#define XB_XGEN(j)  (2304 + 64 * (j))
#define XB_TOP      3328
#define XB_TOPGEN   3392
#define XCD_BAR_WORDS 3456
#define XB_SPIN_CAP (1u << 18)
__device__ __forceinline__ unsigned xb_ld(unsigned* p)              { return __hip_atomic_load(p, __ATOMIC_RELAXED, __HIP_MEMORY_SCOPE_AGENT); }
__device__ __forceinline__ unsigned xb_add(unsigned* p, unsigned v) { return __hip_atomic_fetch_add(p, v, __ATOMIC_RELAXED, __HIP_MEMORY_SCOPE_AGENT); }
__device__ __forceinline__ unsigned xb_xcc_id() { return (unsigned)__builtin_amdgcn_s_getreg((3 << 11) | 20) & 0xFu; }
#define XB_SPIN(cond, bar) do { unsigned _sp = 0; while (cond) { __builtin_amdgcn_s_sleep(1); \
    if ((++_sp & 255u) == 0u) { if (xb_ld(&(bar)[XB_TMO])) break; if (_sp > XB_SPIN_CAP) { atomicAdd(&(bar)[XB_TMO], 1u); break; } } } } while (0)
struct XcdBarrier { unsigned* bar; unsigned x; volatile LAS unsigned* st; };
__device__ __forceinline__ XcdBarrier xcd_barrier_post(unsigned* bar, volatile LAS unsigned* st) {
    XcdBarrier b; b.bar = bar; b.x = xb_xcc_id(); b.st = st;
    if (threadIdx.x == 0) (void)xb_add(&bar[XB_XCNT(b.x)], 1u);
    return b;
}
__device__ __forceinline__ void xcd_barrier_complete(unsigned* bar, unsigned x, unsigned& nloc, unsigned& nx) {
    const unsigned G = gridDim.x * gridDim.y * gridDim.z;
    unsigned sum, cnt, mine, sp = 0u;
    for (;;) {
        sum = 0u; cnt = 0u; mine = 0u;
#pragma unroll
        for (unsigned j = 0; j < 16; ++j) { const unsigned c = xb_ld(&bar[XB_XCNT(j)]); sum += c; cnt += (c > 0u) ? 1u : 0u; mine = (j == x) ? c : mine; }
        if (sum == G) break;
        __builtin_amdgcn_s_sleep(1);
        if ((++sp & 255u) == 0u) { if (xb_ld(&bar[XB_TMO])) break; if (sp > XB_SPIN_CAP) { atomicAdd(&bar[XB_TMO], 1u); break; } }
    }
    nloc = mine > 0u ? mine : 1u; nx = cnt > 0u ? cnt : 1u;
}
__device__ __forceinline__ void xcd_barrier(const XcdBarrier& b) {
    asm volatile("s_waitcnt vmcnt(0)" ::: "memory");
    __syncthreads();
    if (threadIdx.x == 0) {
        unsigned* bar = b.bar;
        __builtin_amdgcn_s_waitcnt(0);
        unsigned nloc = b.st[0], nx = b.st[1];
        if (nloc == 0u) { xcd_barrier_complete(bar, b.x, nloc, nx); b.st[0] = nloc; b.st[1] = nx; }
        const unsigned old = xb_add(&bar[XB_XSUB(b.x)], 1u);
        const unsigned gen = old / nloc;
        if (old + 1u == (gen + 1u) * nloc) {
            __builtin_amdgcn_fence(__ATOMIC_RELEASE, "agent");
            asm volatile("s_waitcnt vmcnt(0)" ::: "memory");
            const unsigned og = xb_add(&bar[XB_TOP], 1u);
            const unsigned tg = og / nx;
            if (og + 1u == (tg + 1u) * nx) xb_add(&bar[XB_TOPGEN], 1u);
            else XB_SPIN(xb_ld(&bar[XB_TOPGEN]) == tg, bar);
            __builtin_amdgcn_fence(__ATOMIC_ACQUIRE, "agent");
            xb_add(&bar[XB_XGEN(b.x)], 1u);
            asm volatile("s_waitcnt vmcnt(0)" ::: "memory");
        } else {
            XB_SPIN(xb_ld(&bar[XB_XGEN(b.x)]) == gen, bar);
            __builtin_amdgcn_fence(__ATOMIC_ACQUIRE, "agent");
            asm volatile("s_waitcnt vmcnt(0)" ::: "memory");
        }
    }
    __syncthreads();
}

struct Args { const float* in[34]; float* out; unsigned char* ws; int ph_lo, ph_hi; };
enum { I_X = 0, I_C, I_CTX, I_CCTX, I_WMOD, I_BMOD, I_WIN, I_BIN, I_GCONV, I_GALOG, I_GDT, I_GNORM, I_CDWW, I_CDWB, I_CLNG, I_CLNB, I_SLNG, I_SLNB, I_SWS, I_SBS,
       I_WBR, I_WOUT, I_BOUT, I_LN1G, I_LN1B, I_LN2G, I_LN2B, I_RGW, I_RGB, I_REW, I_REB, I_EWG, I_EWU, I_EWD };

struct SchedInA {
    int G, c; const char* xn; const char* w;
    __device__ __forceinline__ bool next(int i, Unit& u) const {
        const int L = i * G + c; const size_t tstep = (size_t)256 * 1024 * 2;
        if (L < 1152) { int pm, pn; pg8::map_tile(L, 72, 16, pm, pn); u.pm = pm; u.pn = pn; u.aux = 0; u.a = xn + (size_t)pm * tstep; u.b = w + (size_t)pn * tstep; return true; }
        if (L < 1440) { const int q = L - 1152, pm = 16 + (q & 3), pn = q >> 2; u.pm = pm; u.pn = pn; u.aux = 1; u.a = w + (size_t)pm * tstep; u.b = xn + (size_t)pn * tstep; return true; }
        return false;
    }
};
struct SchedGrid {
    int G, c, nM, nN; const char* a0; const char* b0; size_t astep, bstep;
    __device__ __forceinline__ bool next(int i, Unit& u) const {
        const int L = i * G + c; if (L >= nM * nN) return false;
        int pm, pn; pg8::map_tile(L, nM, nN, pm, pn); u.pm = pm; u.pn = pn; u.aux = 0; u.a = a0 + (size_t)pm * astep; u.b = b0 + (size_t)pn * bstep; return true;
    }
};
struct SchedFftLat {
    int G, c; const char* dft; const char* pf;
    __device__ __forceinline__ bool next(int i, Unit& u) const {
        const int L = i * G + c; if (L >= 128) return false;
        const int b = L >> 4, kt = (L >> 1) & 7, pn = L & 1;
        u.pm = b * 8 + kt; u.pn = pn; u.aux = 0; u.a = dft + (size_t)kt * (256 * 4096 * 2); u.b = pf + (size_t)b * (512 * 4096 * 2) + (size_t)pn * (256 * 4096 * 2); return true;
    }
};
struct SchedFftCtx {
    int G, c; const char* dft; const char* pf;
    __device__ __forceinline__ bool next(int i, Unit& u) const {
        const int L = i * G + (G - 1 - c); if (L >= 16) return false;
        const int b = L >> 1, pn = L & 1;
        u.pm = 64 + b; u.pn = pn; u.aux = 0; u.a = dft; u.b = pf + (size_t)b * (512 * 512 * 2) + (size_t)pn * (256 * 512 * 2); return true;
    }
};
struct SchedBranch {
    int G, c, nM; const char* br; const char* wbr;
    __device__ __forceinline__ bool next(int j, Unit& u) const {
        const int L = j * G + c; if (L >= nM * 16) return false;
        int pm, pn; pg8::map_tile(L, nM, 16, pm, pn);
        u.pm = pm; u.pn = pn; u.aux = 0; u.a = br + (size_t)(pn >> 2) * ((size_t)NTOK * 512 * 2) + (size_t)pm * (256 * 512 * 2); u.b = wbr + (size_t)pn * (256 * 512 * 2); return true;
    }
};
struct SchedMoe {
    int G, c; unsigned pre[17]; const char* a0; const char* w0; size_t astep, wstep_e, wstep_n;
    __device__ __forceinline__ void init(const unsigned* cnt  ) {
        unsigned s = 0;
#pragma unroll
        for (int e = 0; e < 16; ++e) { pre[e] = s; s += ((unsigned)__builtin_amdgcn_readfirstlane((int)__hip_atomic_load(cnt + 64 * e, __ATOMIC_RELAXED, __HIP_MEMORY_SCOPE_AGENT)) + 255u) >> 8; }
        pre[16] = s;
    }
    __device__ __forceinline__ bool next(int i, Unit& u) const {
        const int L = i * G + c; if (L >= (int)pre[16] * 4) return false;
        const int jt = L >> 2, pn = L & 3; int e = 0;
#pragma unroll
        for (int k = 1; k < 16; ++k) e += ((unsigned)jt >= pre[k]) ? 1 : 0;
        u.pm = jt; u.pn = pn; u.aux = e; u.a = a0 + (size_t)jt * astep; u.b = w0 + (size_t)e * wstep_e + (size_t)pn * wstep_n; return true;
    }
};

struct EpiInA {
    static constexpr bool PERM = true;
    bf16 *pqkv, *pz, *pconf, *psgu, *pfft, *pfftc; const float* bias;
    __device__ __forceinline__ void operator()(const AccT& acc, const Unit& u, int wr, int wc, int fr, int fq) const {
        if (u.aux == 0) {
            const int row0 = u.pm * 256 + wr * 64 + fr, cb = wc * 32 + 8 * fq, bcol0 = u.pn * 256 + cb;
            f32x4 bv[2][2];
#pragma unroll
            for (int bj = 0; bj < 2; ++bj)
#pragma unroll
                for (int n = 0; n < 2; ++n) bv[bj][n] = *(const f32x4*)(bias + bcol0 + bj * 128 + 4 * n);
            if (u.pn < 8) {
                const bool isz = u.pn >= 6;
#pragma unroll
                for (int ai = 0; ai < 2; ++ai)
#pragma unroll
                    for (int m = 0; m < 4; ++m) { const int row = row0 + ai * 128 + m * 16;
                        bf16* rowp = isz ? (pz + (size_t)row * 512 + (u.pn - 6) * 256 + cb) : (pqkv + (size_t)row * 1536 + u.pn * 256 + cb);
#pragma unroll
                        for (int bj = 0; bj < 2; ++bj) { f32x4 v0 = acc[ai][bj][m][0] + bv[bj][0], v1 = acc[ai][bj][m][1] + bv[bj][1];
                            if (isz) {
#pragma unroll
                                for (int j = 0; j < 4; ++j) { v0[j] = siluf_(v0[j]); v1[j] = siluf_(v1[j]); } }
                            v4u w; w.x = pk2(v0[0], v0[1]); w.y = pk2(v0[2], v0[3]); w.z = pk2(v1[0], v1[1]); w.w = pk2(v1[2], v1[3]);
                            *(v4u*)(rowp + bj * 128) = w; } }
            } else if (u.pn < 12) {
#pragma unroll
                for (int ai = 0; ai < 2; ++ai)
#pragma unroll
                    for (int m = 0; m < 4; ++m) { const int row = row0 + ai * 128 + m * 16;
                        const f32x4 a0 = acc[ai][0][m][0] + bv[0][0], a1 = acc[ai][0][m][1] + bv[0][1], g0 = acc[ai][1][m][0] + bv[1][0], g1 = acc[ai][1][m][1] + bv[1][1];
                        float o[8];
#pragma unroll
                        for (int j = 0; j < 4; ++j) { o[j] = a0[j] * sigmoidf_(g0[j]); o[4 + j] = a1[j] * sigmoidf_(g1[j]); }
                        *(v4u*)(pconf + (size_t)row * 512 + (u.pn - 8) * 128 + cb) = pack8(o); }
            } else {
#pragma unroll
                for (int ai = 0; ai < 2; ++ai)
#pragma unroll
                    for (int m = 0; m < 4; ++m) { const int row = row0 + ai * 128 + m * 16;
                        bf16* rowp = psgu + (size_t)row * 1024 + (u.pn - 12) * 256 + cb;
#pragma unroll
                        for (int bj = 0; bj < 2; ++bj) { f32x4 v0 = acc[ai][bj][m][0] + bv[bj][0], v1 = acc[ai][bj][m][1] + bv[bj][1];
#pragma unroll
                            for (int j = 0; j < 4; ++j) { v0[j] = gelu_tanh(v0[j]); v1[j] = gelu_tanh(v1[j]); }
                            v4u w; w.x = pk2(v0[0], v0[1]); w.y = pk2(v0[2], v0[3]); w.z = pk2(v1[0], v1[1]); w.w = pk2(v1[2], v1[3]);
                            *(v4u*)(rowp + bj * 128) = w; } }
            }
        } else {
            const int jrow0 = (u.pm - 16) * 256 + wr * 64 + fr, tok0 = u.pn * 256 + wc * 32 + 8 * fq;
#pragma unroll
            for (int ai = 0; ai < 2; ++ai)
#pragma unroll
                for (int m = 0; m < 4; ++m) { const int jrow = jrow0 + ai * 128 + m * 16; const float bb = bias[4096 + jrow]; const int cs = jrow >> 9, rr = jrow & 511;
#pragma unroll
                    for (int bj = 0; bj < 2; ++bj) { const int tok = tok0 + bj * 128; bf16* dst;
                        if (tok < NLAT) { const int b = tok >> 11, t = tok & 2047; dst = pfft + ((size_t)(b * 512 + rr)) * 4096 + cs * 2048 + t; }
                        else { const int tc = tok - NLAT, b = tc >> 8, t = tc & 255; dst = pfftc + ((size_t)(b * 512 + rr)) * 512 + cs * 256 + t; }
                        const f32x4 v0 = acc[ai][bj][m][0] + bb, v1 = acc[ai][bj][m][1] + bb;
                        v4u w; w.x = pk2(v0[0], v0[1]); w.y = pk2(v0[2], v0[3]); w.z = pk2(v1[0], v1[1]); w.w = pk2(v1[2], v1[3]);
                        *(v4u*)dst = w; } }
        }
    }
};
template <int ACT  > struct EpiBf16 {
    static constexpr bool PERM = true;
    bf16* O; int ldc; const float* bias;
    __device__ __forceinline__ void operator()(const AccT& acc, const Unit& u, int wr, int wc, int fr, int fq) const {
        const int row0 = u.pm * 256 + wr * 64 + fr, col0 = u.pn * 256 + wc * 32 + 8 * fq;
        f32x4 bv[2][2];
#pragma unroll
        for (int bj = 0; bj < 2; ++bj)
#pragma unroll
            for (int n = 0; n < 2; ++n) bv[bj][n] = bias ? *(const f32x4*)(bias + col0 + bj * 128 + 4 * n) : (f32x4){0.f, 0.f, 0.f, 0.f};
#pragma unroll
        for (int ai = 0; ai < 2; ++ai)
#pragma unroll
            for (int m = 0; m < 4; ++m) { bf16* rowp = O + (size_t)(row0 + ai * 128 + m * 16) * ldc + col0;
#pragma unroll
                for (int bj = 0; bj < 2; ++bj) { f32x4 v0 = acc[ai][bj][m][0] + bv[bj][0], v1 = acc[ai][bj][m][1] + bv[bj][1];
                    if (ACT == 1) {
#pragma unroll
                        for (int j = 0; j < 4; ++j) { v0[j] = sigmoidf_(v0[j]); v1[j] = sigmoidf_(v1[j]); } }
                    v4u w; w.x = pk2(v0[0], v0[1]); w.y = pk2(v0[2], v0[3]); w.z = pk2(v1[0], v1[1]); w.w = pk2(v1[2], v1[3]);
                    *(v4u*)(rowp + bj * 128) = w; } }
    }
};
struct EpiF32 {
    static constexpr bool PERM = false;
    float* C; int ldc; const float* bias;
    __device__ __forceinline__ void operator()(const AccT& acc, const Unit& u, int wr, int wc, int fr, int fq) const {
        const int row0 = u.pm * 256 + wr * 64 + fr, col0 = u.pn * 256 + wc * 32 + 4 * fq;
        f32x4 bv[2][2];
#pragma unroll
        for (int bj = 0; bj < 2; ++bj)
#pragma unroll
            for (int n = 0; n < 2; ++n) bv[bj][n] = *(const f32x4*)(bias + col0 + bj * 128 + n * 16);
#pragma unroll
        for (int ai = 0; ai < 2; ++ai)
#pragma unroll
            for (int m = 0; m < 4; ++m) { float* rowp = C + (size_t)(row0 + ai * 128 + m * 16) * ldc + col0;
#pragma unroll
                for (int bj = 0; bj < 2; ++bj)
#pragma unroll
                    for (int n = 0; n < 2; ++n) *(f32x4*)(rowp + bj * 128 + n * 16) = acc[ai][bj][m][n] + bv[bj][n]; }
    }
};
struct EpiGateMerge {
    static constexpr bool PERM = true;
    const bf16* P; bf16* mbf; const float* bias;
    __device__ __forceinline__ void operator()(const AccT& acc, const Unit& u, int wr, int wc, int fr, int fq) const {
        const int row0 = u.pm * 256 + wr * 64 + fr, cb = wc * 32 + 8 * fq, d0 = u.pn * 64 + wc * 16 + 4 * fq;
        f32x4 bv[2][2];
#pragma unroll
        for (int bj = 0; bj < 2; ++bj)
#pragma unroll
            for (int n = 0; n < 2; ++n) bv[bj][n] = *(const f32x4*)(bias + u.pn * 256 + cb + bj * 128 + 4 * n);
#pragma unroll
        for (int ai = 0; ai < 2; ++ai)
#pragma unroll
            for (int m = 0; m < 4; ++m) { const size_t row = (size_t)(row0 + ai * 128 + m * 16); const bf16* pr = P + row * 4096 + d0;
                f32x4 o = (f32x4){0.f, 0.f, 0.f, 0.f};
#pragma unroll
                for (int bj = 0; bj < 2; ++bj)
#pragma unroll
                    for (int n = 0; n < 2; ++n) { const v2u pw = *(const v2u*)(pr + (2 * bj + n) * 1024); const f32x4 g = acc[ai][bj][m][n] + bv[bj][n];
                        o[0] += sigmoidf_(g[0]) * bflo(pw.x); o[1] += sigmoidf_(g[1]) * bfhi(pw.x); o[2] += sigmoidf_(g[2]) * bflo(pw.y); o[3] += sigmoidf_(g[3]) * bfhi(pw.y); }
                v2u w; w.x = pk2(o[0], o[1]); w.y = pk2(o[2], o[3]); *(v2u*)(mbf + row * 1024 + d0) = w; }
    }
};
struct EpiMoe1 {
    static constexpr bool PERM = true;
    bf16* hid;
    __device__ __forceinline__ void operator()(const AccT& acc, const Unit& u, int wr, int wc, int fr, int fq) const {
        const int row0 = u.pm * 256 + wr * 64 + fr, cb = wc * 32 + 8 * fq;
#pragma unroll
        for (int ai = 0; ai < 2; ++ai)
#pragma unroll
            for (int m = 0; m < 4; ++m) { const int row = row0 + ai * 128 + m * 16;
                const f32x4 g0 = acc[ai][0][m][0], g1 = acc[ai][0][m][1], u0 = acc[ai][1][m][0], u1 = acc[ai][1][m][1];
                float o[8];
#pragma unroll
                for (int j = 0; j < 4; ++j) { o[j] = siluf_(g0[j]) * u0[j]; o[4 + j] = siluf_(g1[j]) * u1[j]; }
                *(v4u*)(hid + (size_t)row * 512 + u.pn * 128 + cb) = pack8(o); }
    }
};

struct Ctx {
    LAS unsigned char* lds; int tid, lane, wave, G, bid;
};

__device__ __forceinline__ int gate_srccol(int r) { const int q = r - 5120, t = q >> 8, c = q & 255, bj = c >> 7, wc = (c >> 5) & 3, fq = (c >> 3) & 3, n = (c >> 2) & 1, j = c & 3;
    return OFF_GATE + (2 * bj + n) * 1024 + 64 * t + 16 * wc + 4 * fq + j; }
__device__ __forceinline__ void cvt_tile(const Ctx& X, const float* src, int ld, int k0, bf16* dst, int Kp) {
    LAS float* tile = (LAS float*)X.lds;
#pragma unroll
    for (int i = 0; i < 8; ++i) { const int kk = (X.tid >> 6) + 8 * i, nn = X.tid & 63; tile[kk * 65 + nn] = src[(size_t)(k0 + kk) * ld + nn]; }
    __syncthreads();
    { const int n = X.tid >> 3, kc = X.tid & 7; float o[8];
#pragma unroll
      for (int j = 0; j < 8; ++j) o[j] = tile[(8 * kc + j) * 65 + n];
      *(v4u*)(dst + (size_t)n * Kp + k0 + 8 * kc) = pack8(o); }
    __syncthreads();
}

__device__ __forceinline__ void cvt_item(const float* src, int ld, int srccol, int k0, bf16* dst, int Kp, LAS float* scr, int lane) {
#pragma unroll 8
    for (int i = 0; i < 32; ++i) { const int kk = 2 * i + (lane >> 5); scr[kk * 33 + (lane & 31)] = src[(size_t)(k0 + kk) * ld + srccol]; }
    LDS_WAIT(); asm volatile("" ::: "memory");
    const int c = lane & 7;
#pragma unroll
    for (int j = 0; j < 4; ++j) { const int n = (lane >> 3) + 8 * j; const LAS float* sp = scr + (8 * c) * 33 + n; float o[8];
#pragma unroll
        for (int e = 0; e < 8; ++e) o[e] = sp[e * 33];
        *(v4u*)(dst + (size_t)n * Kp + k0 + 8 * c) = pack8(o); }
    LDS_WAIT(); asm volatile("" ::: "memory");
}

__device__ __forceinline__ void ln_rows(f32x4 (&v)[4]) {
    float s = 0.f;
#pragma unroll
    for (int j = 0; j < 4; ++j) s += (v[j][0] + v[j][1]) + (v[j][2] + v[j][3]);
    const float mean = wave_sum(s) * (1.f / D); float s2 = 0.f;
#pragma unroll
    for (int j = 0; j < 4; ++j) { v[j] = v[j] - mean; s2 += (v[j][0] * v[j][0] + v[j][1] * v[j][1]) + (v[j][2] * v[j][2] + v[j][3] * v[j][3]); }
    const float rstd = 1.0f / sqrtf(wave_sum(s2) * (1.f / D) + LN_EPS);
#pragma unroll
    for (int j = 0; j < 4; ++j) v[j] = v[j] * rstd;
}

#define PH_BEGIN() \
    int tid_l = threadIdx.x; asm volatile("" : "+v"(tid_l)); const int tid = tid_l, lane = tid & 63; \
    Ctx X; X.lds = lds; X.tid = tid; X.lane = lane; X.wave = __builtin_amdgcn_readfirstlane(tid >> 6); X.G = gridDim.x; X.bid = blockIdx.x; \
    const int gw = X.bid * NWAVES + X.wave, NGW = X.G * NWAVES; (void)gw; (void)NGW; \
    const __attribute__((address_space(4))) char* kp = (const __attribute__((address_space(4))) char*)__builtin_amdgcn_kernarg_segment_ptr(); asm volatile("" : "+s"(kp)); \
    unsigned char* const ws = *(unsigned char* const __attribute__((address_space(4)))*)(kp + 280); \
    float* const hlat = *(float* const __attribute__((address_space(4)))*)(kp + 272); (void)hlat; \
    float* const hctx = (float*)(ws + WS_HCTX); (void)hctx; \
    float* const modv = (float*)(ws + WS_MODV); (void)modv; \
    float* const binv = (float*)(ws + WS_BIN); (void)binv; \
    bf16* const XN = (bf16*)(ws + WS_XN); (void)XN; \
    bf16* const WIN = (bf16*)(ws + WS_WIN); (void)WIN; \
    bf16* const WBR = (bf16*)(ws + WS_WBR); (void)WBR; \
    bf16* const WOUT = (bf16*)(ws + WS_WOUT); (void)WOUT; \
    bf16* const DFTL = (bf16*)(ws + WS_DFTL); (void)DFTL; \
    bf16* const DFTC = (bf16*)(ws + WS_DFTC); (void)DFTC; \
    bf16* const PQKV = (bf16*)(ws + WS_PQKV); (void)PQKV; \
    bf16* const PCONF = (bf16*)(ws + WS_PCONF); (void)PCONF; \
    bf16* const PZ = (bf16*)(ws + WS_PZ); (void)PZ; \
    bf16* const PSGU = (bf16*)(ws + WS_PSGU); (void)PSGU; \
    bf16* const PFFT = (bf16*)(ws + WS_PFFT); (void)PFFT; \
    bf16* const PFFTC = (bf16*)(ws + WS_PFFTC); (void)PFFTC; \
    float* const AB = (float*)(ws + WS_AB); (void)AB; \
    bf16* const OF = (bf16*)(ws + WS_OF); (void)OF; \
    bf16* const OB = (bf16*)(ws + WS_OB); (void)OB; \
    bf16* const WIT = (bf16*)(ws + WS_WIT); (void)WIT; \
    bf16* const UIT = (bf16*)(ws + WS_UIT); (void)UIT; \
    bf16* const AIT = (bf16*)(ws + WS_AIT); (void)AIT; \
    bf16* const KIT = (bf16*)(ws + WS_KIT); (void)KIT; \
    float* const SIT = (float*)(ws + WS_SIT); (void)SIT; \
    bf16* const GT = (bf16*)(ws + WS_G); (void)GT; \
    bf16* const WGU = (bf16*)(ws + WS_WGU); (void)WGU; \
    bf16* const WDN = (bf16*)(ws + WS_WDN); (void)WDN; \
    bf16* const XG = (bf16*)(ws + WS_XG); (void)XG; \
    bf16* const QKV = (bf16*)(ws + WS_QKV); (void)QKV; \
    float* const GB = (float*)(ws + WS_GB); (void)GB; \
    bf16* const BR = (bf16*)(ws + WS_BR); (void)BR; \
    float* const MERGED = (float*)(ws + WS_MERGED); (void)MERGED; \
    float* const YB = (float*)(ws + WS_Y); (void)YB; \
    bf16* const HID = (bf16*)(ws + WS_HID); (void)HID; \
    bf16* const MO = (bf16*)(ws + WS_MO); (void)MO; \
    float* const ROUTE = (float*)(ws + WS_ROUTE); (void)ROUTE; \
    unsigned* const ctl = (unsigned*)(ws + WS_CTL); (void)ctl;
#define INP(i) (*(const float* const __attribute__((address_space(4)))*)(kp + 8 * (i)))
__global__ void __launch_bounds__(NWAVES * 64, 2) fwd(Args args) {
    extern __shared__ __attribute__((aligned(16))) unsigned char lds_raw[];
    LAS unsigned char* const lds = (LAS unsigned char*)lds_raw;
    volatile LAS unsigned* MISC = (volatile LAS unsigned*)(lds + MISC_OFF);
    for (int u = threadIdx.x; u < (LDS_BYTES - LDSCTL_OFF) / 4; u += NWAVES * 64) ((LAS unsigned*)(lds + LDSCTL_OFF))[u] = 0u;
    __syncthreads();
#if MK_ONE_LAUNCH
    XcdBarrier bar = xcd_barrier_post((unsigned*)(args.ws + WS_CTL) + CW_BAR, MISC + 8);
#define GRID_BAR() xcd_barrier(bar)
#else
#define GRID_BAR() do { } while (0)
#endif
    const int lo = args.ph_lo, hi = args.ph_hi;
#define IN(k) (lo <= (k) && (k) < hi)
#define SEAM(k) do { if (IN(k) && IN((k) + 1)) GRID_BAR(); } while (0)

    if (PH_ON(0) && IN(0)) { PH_BEGIN();
        for (int t = gw; t < SEQ; t += NGW) {
            const int prow = t >> 6, pcol = t & 63; f32x4 pe[4];
#pragma unroll
            for (int j = 0; j < 4; ++j)
#pragma unroll
                for (int e = 0; e < 4; ++e) { const int col = 4 * lane + 256 * j + e, part = col >> 9, within = col & 511, i = within & 255;
                    const float omega = 1.0f / powf(10000.0f, (float)i * (1.0f / 256.0f)); const float ang = (float)(part ? pcol : prow) * omega;
                    pe[j][e] = (within >> 8) ? cosf(ang) : sinf(ang); }
            for (int b = 0; b < NB; ++b) { const size_t off = ((size_t)b * SEQ + t) * D;
#pragma unroll
                for (int j = 0; j < 4; ++j) *(f32x4*)(hlat + off + 4 * lane + 256 * j) = *(const f32x4*)(INP(I_X) + off + 4 * lane + 256 * j) + pe[j]; }
        }
        for (int r = gw; r < NCTX; r += NGW) {
#pragma unroll
            for (int j = 0; j < 4; ++j) *(f32x4*)(hctx + (size_t)r * D + 4 * lane + 256 * j) = *(const f32x4*)(INP(I_CTX) + (size_t)r * D + 4 * lane + 256 * j);
        }
        for (int idx = X.bid * 512 + tid; idx < 2048 * 4096 / 8; idx += X.G * 512) {
            const int k = idx >> 9, j0 = (idx & 511) * 8; float o[8];
#pragma unroll
            for (int e = 0; e < 8; ++e) { const int j = j0 + e, t = j & 2047, a = (k * t) & 2047; float s, c; sincospif((float)a * (1.0f / 1024.0f), &s, &c);
                o[e] = (j < 2048 ? c : -s) * 0.022097086912079608f; }
            *(v4u*)(DFTL + (size_t)k * 4096 + j0) = pack8(o);
        }
        for (int idx = X.bid * 512 + tid; idx < 256 * 512 / 8; idx += X.G * 512) {
            const int k = idx >> 6, j0 = (idx & 63) * 8; float o[8];
#pragma unroll
            for (int e = 0; e < 8; ++e) { const int j = j0 + e, t = j & 255, a = (k * t) & 255; float s, c; sincospif((float)a * (1.0f / 128.0f), &s, &c);
                o[e] = (j < 256 ? c : -s) * 0.0625f; }
            *(v4u*)(DFTC + (size_t)k * 512 + j0) = pack8(o);
        }
        {
            LAS float* sc = (LAS float*)lds;
            LAS float* red = (LAS float*)(lds + 36864);
            for (int i = tid; i < 9 * 1024; i += 512) { const int r = i >> 10, k = i & 1023; const float c = r < 8 ? INP(I_C)[r * 1024 + k] : INP(I_CCTX)[k]; sc[i] = siluf_(c); }
            __syncthreads();
            for (int it = X.bid; it < 192; it += X.G) {
                const int l = it / 96, j = (it % 96) * 64 + lane; const float* W = INP(I_WMOD) + (size_t)l * 1024 * 6144 + j;
                float a[9];
#pragma unroll
                for (int r = 0; r < 9; ++r) a[r] = 0.f;
                const int kb = X.wave * 128;
#pragma unroll 16
                for (int k = 0; k < 128; ++k) { const float w = W[(size_t)(kb + k) * 6144];
#pragma unroll
                    for (int r = 0; r < 9; ++r) a[r] += sc[r * 1024 + kb + k] * w; }
#pragma unroll
                for (int r = 0; r < 9; ++r) red[(X.wave * 9 + r) * 64 + lane] = a[r];
                __syncthreads();
                for (int o = tid; o < 9 * 64; o += 512) { const int r = o >> 6, jj = o & 63; float s = 0.f;
#pragma unroll
                    for (int w = 0; w < 8; ++w) s += red[(w * 9 + r) * 64 + jj];
                    const int jc = (it % 96) * 64 + jj; modv[((size_t)l * 9 + r) * 6144 + jc] = s + INP(I_BMOD)[l * 6144 + jc]; }
                __syncthreads();
            }
        }
    }
    SEAM(0);

    for (int l = 0; l < 2; ++l) {
        const int pb = 1 + NPH_LAYER * l;
        const int nrows2 = (l == 1) ? NLAT : NTOK;
        const int npan2 = nrows2 / 256;

        for (int rep_ = 0; rep_ <= (int)PH_REP(1); ++rep_) { if (rep_) GRID_BAR();
        if (PH_ON(1) && IN(pb + 0)) { PH_BEGIN(); const float* mv = modv + (size_t)l * 9 * 6144; (void)mv; unsigned* const moecnt = ctl + CW_MOE + l * 16 * 64; (void)moecnt;
            const float* win = INP(I_WIN) + (size_t)l * 1024 * N_IN;
            const float* bin = INP(I_BIN) + (size_t)l * N_IN;
            LAS float* const wscr = (LAS float*)(lds + X.wave * 8448);
            for (int it = gw; it < 288 * 16; it += NGW) {
                const int rb = it >> 4, kb = it & 15, row0 = rb * 32; int col;
                if (row0 >= 4096 && row0 < 5120) continue;
                if (row0 < 2048) col = row0;
                else if (row0 < 3072) { const int q = row0 - 2048, j = q >> 8, w = q & 255; col = OFF_CONF + (w >= 128 ? 512 : 0) + 128 * j + (w & 127); }
                else if (row0 < 4096) col = OFF_SGU + (row0 - 3072);
                else col = -1;
                cvt_item(win, N_IN, col >= 0 ? col + (lane & 31) : gate_srccol(row0 + (lane & 31)), kb * 64, WIN + (size_t)row0 * 1024, 1024, wscr, lane);
            }
            __syncthreads();
            for (int it = X.bid; it < 64; it += X.G) {
                const int kb = it >> 2, g = it & 3; LAS float* Wt = (LAS float*)lds; LAS float* ct = (LAS float*)(lds + 32768); LAS float* st = ct + 128;
                for (int i = tid; i < 64 * 128; i += 512) { const int kk = i >> 7, c = i & 127; Wt[i] = win[(size_t)(kb * 64 + kk) * N_IN + OFF_FFT + g * 128 + c]; }
                if (tid < 128) { float s, c; sincospif((float)tid * (1.0f / 64.0f), &s, &c); ct[tid] = c * 0.08838834764831845f; st[tid] = s * 0.08838834764831845f; }
                __syncthreads();
                const int m = tid & 127, ks = tid >> 7; float oc[16], os[16];
#pragma unroll
                for (int kk = 0; kk < 16; ++kk) { oc[kk] = 0.f; os[kk] = 0.f; }
#pragma unroll 1
                for (int c = 0; c < 128; ++c) { const int a = (m * c) & 127; const float cv = ct[a], sv = st[a];
#pragma unroll
                    for (int kk = 0; kk < 16; ++kk) { const float w = Wt[(ks * 16 + kk) * 128 + c]; oc[kk] += w * cv; os[kk] += w * sv; } }
                bf16* dc = WIN + (size_t)(4096 + g * 128 + m) * 1024 + kb * 64 + ks * 16; bf16* dsn = dc + (size_t)512 * 1024;
                { float o[8];
#pragma unroll
                  for (int h2 = 0; h2 < 2; ++h2) {
#pragma unroll
                    for (int e = 0; e < 8; ++e) o[e] = oc[h2 * 8 + e];
                    *(v4u*)(dc + h2 * 8) = pack8(o);
#pragma unroll
                    for (int e = 0; e < 8; ++e) o[e] = os[h2 * 8 + e];
                    *(v4u*)(dsn + h2 * 8) = pack8(o); } }
                __syncthreads();
            }
            for (int r = X.bid * 512 + tid; r < NWROWS; r += X.G * 512) {
                float v;
                if (r < 2048) v = bin[r];
                else if (r < 3072) { const int q = r - 2048, j = q >> 8, w = q & 255; v = bin[OFF_CONF + (w >= 128 ? 512 : 0) + 128 * j + (w & 127)]; }
                else if (r < 4096) v = bin[OFF_SGU + (r - 3072)];
                else if (r < 5120) { const int q = r - 4096, cs = q >> 9, g = (q >> 7) & 3, m = q & 127; float s = 0.f;
                    for (int c = 0; c < 128; ++c) { float sn, cn; sincospif((float)((m * c) & 127) * (1.0f / 64.0f), &sn, &cn); s += bin[OFF_FFT + g * 128 + c] * (cs ? sn : cn); }
                    v = s * 0.08838834764831845f; }
                else v = bin[gate_srccol(r)];
                binv[r] = v;
            }
            __syncthreads();
            for (int it = gw; it < 4 * 32 * 8; it += NGW) { const int i = it >> 8, nb = (it >> 3) & 31, kb = it & 7;
                cvt_item(INP(I_WBR) + ((size_t)(l * 4 + i) * 512) * 1024, 1024, nb * 32 + (lane & 31), kb * 64, WBR + ((size_t)i * 1024 + nb * 32) * 512, 512, wscr, lane); }
            for (int it = gw; it < 32 * 16; it += NGW) { const int nb = it >> 4, kb = it & 15;
                cvt_item(INP(I_WOUT) + (size_t)l * 1024 * 1024, 1024, nb * 32 + (lane & 31), kb * 64, WOUT + (size_t)nb * 32 * 1024, 1024, wscr, lane); }
            LAS float* wab = (LAS float*)lds;
            __syncthreads();
            for (int i = tid; i < 16 * 1024; i += 512) { const int o = i >> 10, k = i & 1023; wab[i] = win[(size_t)k * N_IN + OFF_A + o]; }
            __syncthreads();
            for (int row = gw; row < NTOK; row += NGW) {
                const float* hrow = row < NLAT ? hlat + (size_t)row * D : hctx + (size_t)(row - NLAT) * D;
                const int mi = row < NLAT ? (row >> 11) : 8; const float* shift = mv + mi * 6144, *scale = shift + 1024;
                f32x4 v[4];
#pragma unroll
                for (int j = 0; j < 4; ++j) v[j] = *(const f32x4*)(hrow + 4 * lane + 256 * j);
                ln_rows(v);
#pragma unroll
                for (int j = 0; j < 4; ++j) { const f32x4 sc = *(const f32x4*)(scale + 4 * lane + 256 * j), sh = *(const f32x4*)(shift + 4 * lane + 256 * j); v[j] = v[j] * (sc + 1.0f) + sh;
                    v2u w; w.x = pk2(v[j][0], v[j][1]); w.y = pk2(v[j][2], v[j][3]); *(v2u*)(XN + (size_t)row * D + 4 * lane + 256 * j) = w; }
                float myv = 0.f;
#pragma unroll 2
                for (int o = 0; o < 16; ++o) { float s = 0.f;
#pragma unroll
                    for (int j = 0; j < 4; ++j) { const f32x4 w = *(const LAS f32x4*)(wab + o * 1024 + 4 * lane + 256 * j); s += (v[j][0] * w[0] + v[j][1] * w[1]) + (v[j][2] * w[2] + v[j][3] * w[3]); }
                    s = wave_sum(s); if (lane == o) myv = s; }
                if (lane < 16) AB[(size_t)row * 16 + lane] = myv + bin[OFF_A + lane];
            }
        } }
        SEAM(pb + 0);

        for (int rep_ = 0; rep_ <= (int)PH_REP(2); ++rep_) { if (rep_) GRID_BAR();
        if (PH_ON(2) && IN(pb + 1)) { PH_BEGIN(); const float* mv = modv + (size_t)l * 9 * 6144; (void)mv; unsigned* const moecnt = ctl + CW_MOE + l * 16 * 64; (void)moecnt;
            SchedInA S{X.G, X.bid, (const char*)XN, (const char*)WIN};
            EpiInA E{PQKV, PZ, PCONF, PSGU, PFFT, PFFTC, binv};
            pg8::gemm_phase<EpiInA, SchedInA, true, true>(lds, Gemm{1024, 1024, 1024}, S, E);
        } }
        SEAM(pb + 1);

        for (int rep_ = 0; rep_ <= (int)PH_REP(3); ++rep_) { if (rep_) GRID_BAR();
        if (PH_ON(3) && IN(pb + 2)) { PH_BEGIN(); const float* mv = modv + (size_t)l * 9 * 6144; (void)mv; unsigned* const moecnt = ctl + CW_MOE + l * 16 * 64; (void)moecnt;
            if (CPART & 1) {
            { SchedFftLat S{X.G, X.bid, (const char*)DFTL, (const char*)PFFT}; EpiBf16<0> E{BR + (size_t)2 * NTOK * 512, 512, nullptr};
              pg8::gemm_phase<EpiBf16<0>, SchedFftLat, true, true>(lds, Gemm{4096, 4096, 4096}, S, E); }
            { SchedFftCtx S{X.G, X.bid, (const char*)DFTC, (const char*)PFFTC}; EpiBf16<0> E{BR + (size_t)2 * NTOK * 512, 512, nullptr};
              pg8::gemm_phase<EpiBf16<0>, SchedFftCtx, true, true>(lds, Gemm{512, 512, 512}, S, E); }
            __syncthreads();
            }
            if (CPART & 2) {
                const float* cw = INP(I_GCONV) + (size_t)l * 5 * 1536;
                for (int row = gw; row < NTOK; row += NGW) {
                    int t, T; if (row < NLAT) { t = row & 2047; T = 2048; } else { t = (row - NLAT) & 255; T = 256; }
#pragma unroll 1
                    for (int seg = 0; seg < 3; ++seg) { const int ch = seg * 512 + 8 * lane; float a[8];
#pragma unroll
                        for (int e = 0; e < 8; ++e) a[e] = 0.f;
#pragma unroll
                        for (int j = 0; j < 5; ++j) { const int tt = t + j - 2; if (tt >= 0 && tt < T) { float xv[8]; unpack8(*(const v4u*)(PQKV + (size_t)(row + j - 2) * 1536 + ch), xv);
                            const f32x4 w0 = *(const f32x4*)(cw + j * 1536 + ch), w1 = *(const f32x4*)(cw + j * 1536 + ch + 4);
#pragma unroll
                            for (int e = 0; e < 4; ++e) { a[e] += w0[e] * xv[e]; a[4 + e] += w1[e] * xv[4 + e]; } } }
                        float ss = 0.f;
#pragma unroll
                        for (int e = 0; e < 8; ++e) { a[e] = siluf_(a[e]); ss += a[e] * a[e]; }
                        if (seg < 2) { ss = g16_sum(ss); const float sc = (1.0f / sqrtf(ss + LN_EPS)) * (seg == 0 ? 0.08838834764831845f : 1.0f);
#pragma unroll
                            for (int e = 0; e < 8; ++e) a[e] *= sc; }
                        *(v4u*)(QKV + (size_t)row * 1536 + ch) = pack8(a); }
                    if (lane < 8) { const float av = AB[(size_t)row * 16 + lane], bv = AB[(size_t)row * 16 + 8 + lane];
                        const float xs = av + INP(I_GDT)[l * 8 + lane]; const float sp = xs > 20.f ? xs : log1pf(expf(xs));
                        GB[(size_t)row * 16 + lane] = -expf(INP(I_GALOG)[l * 8 + lane]) * sp; GB[(size_t)row * 16 + 8 + lane] = 1.0f / (1.0f + expf(-bv)); }
                }
            }
            if (CPART & 4) {
                const float* dw = INP(I_CDWW) + (size_t)l * 31 * 512; const float* dwb = INP(I_CDWB) + l * 512, *lg = INP(I_CLNG) + l * 512, *lb = INP(I_CLNB) + l * 512;
                bf16* B1 = BR + (size_t)1 * NTOK * 512; const int ch = 8 * lane;
                for (int row = gw; row < nrows2; row += NGW) {
                    int t, T; if (row < NLAT) { t = row & 2047; T = 2048; } else { t = (row - NLAT) & 255; T = 256; }
                    float a[8];
#pragma unroll
                    for (int e = 0; e < 8; ++e) a[e] = dwb[ch + e];
#pragma unroll 4
                    for (int j = 0; j < 31; ++j) { const int tt = t + j - 15; if (tt >= 0 && tt < T) { float xv[8]; unpack8(*(const v4u*)(PCONF + (size_t)(row + j - 15) * 512 + ch), xv);
                        const f32x4 w0 = *(const f32x4*)(dw + j * 512 + ch), w1 = *(const f32x4*)(dw + j * 512 + ch + 4);
#pragma unroll
                        for (int e = 0; e < 4; ++e) { a[e] += w0[e] * xv[e]; a[4 + e] += w1[e] * xv[4 + e]; } } }
                    float s = 0.f;
#pragma unroll
                    for (int e = 0; e < 8; ++e) s += a[e];
                    const float mean = g16_sum(s) * (1.0f / 128.0f); float s2 = 0.f;
#pragma unroll
                    for (int e = 0; e < 8; ++e) { a[e] -= mean; s2 += a[e] * a[e]; }
                    const float rstd = 1.0f / sqrtf(g16_sum(s2) * (1.0f / 128.0f) + LN_EPS);
#pragma unroll
                    for (int e = 0; e < 8; ++e) a[e] = siluf_(a[e] * rstd * lg[ch + e] + lb[ch + e]);
                    *(v4u*)(B1 + (size_t)row * 512 + ch) = pack8(a);
                }
            }
            if (CPART & 8) {
                LAS float* vn = (LAS float*)lds; LAS float* wsg = (LAS float*)(lds + 65536);
                const float* lg = INP(I_SLNG) + l * 512, *lb = INP(I_SLNB) + l * 512;
                bf16* B3 = BR + (size_t)3 * NTOK * 512;
                const int nitems = (nrows2 / 128) * 4;
                __syncthreads();
                for (int it = X.bid; it < nitems; it += X.G) {
                    const int chunk = it >> 2, g = it & 3, r0 = chunk * 128;
                    const float* wsrc = INP(I_SWS) + ((size_t)(l * 4 + g)) * 128 * 128;
                    for (int i = tid; i < 128 * 128 / 4; i += 512) *(LAS f32x4*)(wsg + 4 * i) = *(const f32x4*)(wsrc + 4 * i);
                    for (int q = X.wave; q < 128; q += 8) { const unsigned w = *(const unsigned*)(PSGU + (size_t)(r0 + q) * 1024 + 512 + g * 128 + 2 * lane);
                        float v0 = bflo(w), v1 = bfhi(w); const float mean = wave_sum(v0 + v1) * (1.0f / 128.0f); v0 -= mean; v1 -= mean;
                        const float rstd = 1.0f / sqrtf(wave_sum(v0 * v0 + v1 * v1) * (1.0f / 128.0f) + LN_EPS);
                        const int c = g * 128 + 2 * lane; vn[q * 128 + 2 * lane] = v0 * rstd * lg[c] + lb[c]; vn[q * 128 + 2 * lane + 1] = v1 * rstd * lg[c + 1] + lb[c + 1]; }
                    __syncthreads();
                    const int c4 = (tid & 31) * 4, pblk = tid >> 5; f32x4 acc[8];
#pragma unroll
                    for (int i = 0; i < 8; ++i) acc[i] = (f32x4){0.f, 0.f, 0.f, 0.f};
                    for (int q = 0; q < 128; q += 4) {
                        f32x4 vq[4];
#pragma unroll
                        for (int qq = 0; qq < 4; ++qq) vq[qq] = *(const LAS f32x4*)(vn + (q + qq) * 128 + c4);
#pragma unroll
                        for (int i = 0; i < 8; ++i) { const f32x4 w = *(const LAS f32x4*)(wsg + (pblk * 8 + i) * 128 + q);
                            acc[i] += vq[0] * w[0]; acc[i] += vq[1] * w[1]; acc[i] += vq[2] * w[2]; acc[i] += vq[3] * w[3]; }
                    }
#pragma unroll
                    for (int i = 0; i < 8; ++i) { const int p = pblk * 8 + i; const float bs = INP(I_SBS)[(l * 4 + g) * 128 + p];
                        const v2u uw = *(const v2u*)(PSGU + (size_t)(r0 + p) * 1024 + g * 128 + c4);
                        v2u o; o.x = pk2(bflo(uw.x) * (acc[i][0] + bs), bfhi(uw.x) * (acc[i][1] + bs)); o.y = pk2(bflo(uw.y) * (acc[i][2] + bs), bfhi(uw.y) * (acc[i][3] + bs));
                        *(v2u*)(B3 + (size_t)(r0 + p) * 512 + g * 128 + c4) = o; }
                    __syncthreads();
                }
            }
        } }
        SEAM(pb + 2);

        for (int rep_ = 0; rep_ <= (int)PH_REP(4); ++rep_) { if (rep_) GRID_BAR();
        if (PH_ON(4) && IN(pb + 3)) { PH_BEGIN(); const float* mv = modv + (size_t)l * 9 * 6144; (void)mv; unsigned* const moecnt = ctl + CW_MOE + l * 16 * 64; (void)moecnt;
            for (int qi = gw; qi < 9216; qi += NGW) {
                int lane_l = lane; asm volatile("" : "+v"(lane_l));
                const int r16 = lane_l & 15, quad = lane_l >> 4;
                LAS float* const Mt = (LAS float*)(lds + X.wave * 16384);
                LAS float* const gcl = (LAS float*)(lds + 132096 + X.wave * 1024);
                const int item = qi >> 2, q = qi & 3, cidx = item % 36, chain = item / 36, dir = chain & 1, hh = (chain >> 1) & 3, b = chain >> 3;
                const int row0 = cidx < 4 ? NLAT + b * CTXL + cidx * 64 : b * SEQ + (cidx - 4) * 64;
                const int rb = row0 + (dir ? 63 : 0); const long sg = dir ? -1 : 1;
                const float ga = GB[(size_t)(rb + sg * lane_l) * 16 + dir * 4 + hh], be = GB[(size_t)(rb + sg * lane_l) * 16 + 8 + dir * 4 + hh];
                float gc = ga;
#pragma unroll
                for (int o = 1; o < 64; o <<= 1) { const float tu = __shfl_up(gc, o); gc += (lane_l >= o) ? tu : 0.f; }
                const float gl = __shfl(gc, 63);
                gcl[lane_l] = gc; gcl[64 + lane_l] = be;
                const float scl = q >= 2 ? be * __expf(gc) : be;
                bf16x8 Kf[4][4];
                { const bf16* kp = QKV + (size_t)(rb + sg * r16) * 1536 + 512 + hh * 128 + quad * 8; const long ms = sg * 16 * 1536;
#pragma unroll
                  for (int mi = 0; mi < 4; ++mi)
#pragma unroll
                      for (int ks = 0; ks < 4; ++ks) Kf[mi][ks] = *(const bf16x8*)(kp + mi * ms + ks * 32); }
                LDS_WAIT();
                if (q == 0) {
                    bf16x8 Qf[4][4];
                    { const bf16* qp = QKV + (size_t)(rb + sg * r16) * 1536 + hh * 128 + quad * 8; const long ms = sg * 16 * 1536;
#pragma unroll
                      for (int mi = 0; mi < 4; ++mi)
#pragma unroll
                          for (int ks = 0; ks < 4; ++ks) Qf[mi][ks] = *(const bf16x8*)(qp + mi * ms + ks * 32); }
                    bf16* ait = AIT + (size_t)item * 4096 + r16 * 64 + quad * 4;
#pragma unroll
                    for (int mi = 0; mi < 4; ++mi) { const float gci = gcl[16 * mi + r16];
#pragma unroll
                        for (int nj = 0; nj < 4; ++nj) {
                            v2u w; w.x = 0u; w.y = 0u;
                            if (nj <= mi) {
                                f32x4 c = (f32x4){0.f, 0.f, 0.f, 0.f};
#pragma unroll
                                for (int ks = 0; ks < 4; ++ks) c = __builtin_amdgcn_mfma_f32_16x16x32_bf16(Kf[nj][ks], Qf[mi][ks], c, 0, 0, 0);
                                const f32x4 gcj = *(const LAS f32x4*)(gcl + 16 * nj + quad * 4); float o4[4];
#pragma unroll
                                for (int r = 0; r < 4; ++r) { const bool incl = (nj < mi) || (quad * 4 + r <= r16); o4[r] = incl ? c[r] * __expf(gci - gcj[r]) : 0.f; }
                                w.x = pk2(o4[0], o4[1]); w.y = pk2(o4[2], o4[3]); }
                            *(v2u*)(ait + mi * 16 * 64 + 16 * nj) = w; }
                    }
                }
                if (q == 1) { SIT[(size_t)item * 192 + lane_l] = __expf(gc); SIT[(size_t)item * 192 + 64 + lane_l] = __expf(gl - gc); if (lane_l == 0) SIT[(size_t)item * 192 + 128] = __expf(gl); }
                asm volatile("" ::: "memory");
                { LAS float* mw = Mt + r16 * 64 + quad * 4;
#pragma unroll
                  for (int mi = 0; mi < 4; ++mi) {
                    const f32x4 gci = *(const LAS f32x4*)(gcl + 16 * mi + quad * 4), bei = *(const LAS f32x4*)(gcl + 64 + 16 * mi + quad * 4);
#pragma unroll
                    for (int nj = 0; nj <= mi; ++nj) {
                        f32x4 c = (f32x4){0.f, 0.f, 0.f, 0.f};
#pragma unroll
                        for (int ks = 0; ks < 4; ++ks) c = __builtin_amdgcn_mfma_f32_16x16x32_bf16(Kf[mi][ks], Kf[nj][ks], c, 0, 0, 0);
                        const float gcj = gcl[16 * nj + r16]; f32x4 mv4;
#pragma unroll
                        for (int r = 0; r < 4; ++r) { const bool strict = (nj < mi) || (r16 < quad * 4 + r); mv4[r] = strict ? -(bei[r] * c[r] * __expf(gci[r] - gcj)) : 0.f; }
                        *(LAS f32x4*)(mw + (16 * nj) * 64 + 16 * mi) = mv4;
                    }
                  } }
                asm volatile("" ::: "memory");
                LDS_WAIT();
                float Xs[64];
                { const bf16* src = QKV + (size_t)rb * 1536 + (q < 2 ? 1024 + 64 * q : 512 + 64 * (q - 2)) + hh * 128 + lane_l; const long sstep = sg * 1536;
                  bf16 raw[64];
#pragma unroll
                  for (int sidx = 0; sidx < 64; ++sidx) { raw[sidx] = *src; src += sstep; }
                  asm volatile("" ::: "memory");
#pragma unroll
                  for (int sidx = 0; sidx < 64; ++sidx) { const float sc = __builtin_bit_cast(float, __builtin_amdgcn_readlane(__builtin_bit_cast(int, scl), sidx)); Xs[sidx] = bf1(raw[sidx]) * sc; } }
#pragma unroll
                for (int g4 = 0; g4 < 16; ++g4) {
                    f32x4 acc = (f32x4){Xs[4 * g4], Xs[4 * g4 + 1], Xs[4 * g4 + 2], Xs[4 * g4 + 3]};
#pragma unroll
                    for (int c0 = 0; c0 < 4 * g4; c0 += 16) {
                        f32x4 mb[16];
#pragma unroll
                        for (int e = 0; e < 16; ++e) if (c0 + e < 4 * g4) mb[e] = *(const LAS f32x4*)(Mt + (c0 + e) * 64 + 4 * g4);
                        LDS_WAIT();
#pragma unroll
                        for (int e = 0; e < 16; ++e) if (c0 + e < 4 * g4) acc += mb[e] * Xs[c0 + e];
                    }
                    const f32x4 m0 = *(const LAS f32x4*)(Mt + (4 * g4) * 64 + 4 * g4), m1 = *(const LAS f32x4*)(Mt + (4 * g4 + 1) * 64 + 4 * g4), m2 = *(const LAS f32x4*)(Mt + (4 * g4 + 2) * 64 + 4 * g4);
                    LDS_WAIT();
                    const float x0 = acc[0], x1 = acc[1] + m0[1] * x0, x2 = acc[2] + m0[2] * x0 + m1[2] * x1, x3 = acc[3] + m0[3] * x0 + m1[3] * x1 + m2[3] * x2;
                    Xs[4 * g4] = x0; Xs[4 * g4 + 1] = x1; Xs[4 * g4 + 2] = x2; Xs[4 * g4 + 3] = x3;
                }
                if (q < 2) {
                    bf16* u0 = UIT + (size_t)item * 8192 + (size_t)(64 * q + lane_l) * 64;
#pragma unroll
                    for (int p = 0; p < 8; ++p) { float c0[8];
#pragma unroll
                        for (int e = 0; e < 8; ++e) c0[e] = Xs[8 * p + e];
                        *(v4u*)(u0 + 8 * p) = pack8(c0); }
                } else {
                    bf16* w0 = WIT + (size_t)item * 8192 + 64 * (q - 2) + lane_l;
#pragma unroll
                    for (int sidx = 0; sidx < 64; ++sidx) { w0[sidx * 128] = (bf16)f2bf(Xs[sidx]); if ((sidx & 15) == 15) asm volatile("" ::: "memory"); }
                    asm volatile("" ::: "memory");
                    if (dir == 0) {
                        const bf16* src = QKV + (size_t)row0 * 1536 + 512 + hh * 128 + 64 * (q - 2) + lane_l;
                        bf16* k0 = KIT + ((size_t)((b * 4 + hh) * 36 + cidx)) * 8192 + (size_t)(64 * (q - 2) + lane_l) * 64;
                        unsigned kw[64];
#pragma unroll
                        for (int e = 0; e < 64; ++e) kw[e] = src[(size_t)e * 1536];
                        asm volatile("" ::: "memory");
#pragma unroll
                        for (int p = 0; p < 8; ++p) { v4u lo; lo.x = kw[8 * p] | (kw[8 * p + 1] << 16); lo.y = kw[8 * p + 2] | (kw[8 * p + 3] << 16); lo.z = kw[8 * p + 4] | (kw[8 * p + 5] << 16); lo.w = kw[8 * p + 6] | (kw[8 * p + 7] << 16);
                            *(v4u*)(k0 + 8 * p) = lo; }
                    }
                }
                LDS_WAIT();
            }
        } }
        SEAM(pb + 3);

        for (int rep_ = 0; rep_ <= (int)PH_REP(5); ++rep_) { if (rep_) GRID_BAR();
        if (PH_ON(5) && IN(pb + 4)) { PH_BEGIN(); const float* mv = modv + (size_t)l * 9 * 6144; (void)mv; unsigned* const moecnt = ctl + CW_MOE + l * 16 * 64; (void)moecnt;
            LAS bf16* const STl = (LAS bf16*)lds;
            LAS bf16* const VNl = (LAS bf16*)(lds + 8704);
            LAS bf16* const VSl = (LAS bf16*)(lds + 13312);
            const int w = X.wave, mt = w & 3, nt = w >> 2, r16 = lane & 15, quad = lane >> 4;
            for (int blk = X.bid; blk < 256; blk += X.G) {
                const int chain = blk >> 2, slice = blk & 3, dir = chain & 1, hh = (chain >> 1) & 3, b = chain >> 3;
                bf16* const O = dir ? OB : OF;
                __syncthreads();
                for (int i = tid; i < 32 * 136 / 2; i += 512) ((LAS unsigned*)STl)[i] = 0u;
                __syncthreads();
                f32x4 Sacc[2]; Sacc[0] = (f32x4){0.f, 0.f, 0.f, 0.f}; Sacc[1] = (f32x4){0.f, 0.f, 0.f, 0.f};
#define GDN_LOAD(P, step_) do { const int cidx_ = dir ? ((step_) < 4 ? 3 - (step_) : 39 - (step_)) : (step_); const int item_ = chain * 36 + cidx_, kti_ = (chain >> 1) * 36 + cidx_; \
                    const int row0_ = cidx_ < 4 ? NLAT + b * CTXL + cidx_ * 64 : b * SEQ + (cidx_ - 4) * 64; \
                    const bf16* wp_ = WIT + (size_t)item_ * 8192 + (16 * mt + r16) * 128 + quad * 8; const bf16* qp_ = QKV + (size_t)(row0_ + (dir ? 63 - (16 * mt + r16) : 16 * mt + r16)) * 1536 + hh * 128 + quad * 8; \
                    _Pragma("unroll") for (int ks = 0; ks < 4; ++ks) { P##Wf[ks] = *(const bf16x8*)(wp_ + 32 * ks); P##Qf[ks] = *(const bf16x8*)(qp_ + 32 * ks); } \
                    const bf16* ap_ = AIT + (size_t)item_ * 4096 + (16 * mt + r16) * 64 + quad * 8; const bf16* kp_ = KIT + (size_t)kti_ * 8192 + (16 * w + r16) * 64 + (dir ? 56 - quad * 8 : quad * 8); \
                    _Pragma("unroll") for (int ks = 0; ks < 2; ++ks) { P##Af[ks] = *(const bf16x8*)(ap_ + 32 * ks); P##Kx[ks] = *(const v4u*)(kp_ + (dir ? -32 * ks : 32 * ks)); } \
                    P##u4 = *(const v2u*)(UIT + (size_t)item_ * 8192 + (size_t)(slice * 32 + 16 * nt + r16) * 64 + 16 * mt + quad * 4); \
                    const float* sp_ = SIT + (size_t)item_ * 192; P##egc4 = *(const f32x4*)(sp_ + 16 * mt + quad * 4); P##ksc4 = *(const f32x4*)(sp_ + 64 + 16 * mt + quad * 4); P##egl = sp_[128]; } while (0)
#define GDN_BAR() do { asm volatile("s_waitcnt lgkmcnt(0)" ::: "memory"); __builtin_amdgcn_s_barrier(); asm volatile("" ::: "memory"); } while (0)
#define GDN_STEP(P, step_) do { const int cidx = dir ? ((step_) < 4 ? 3 - (step_) : 39 - (step_)) : (step_); \
                    const int row0 = cidx < 4 ? NLAT + b * CTXL + cidx * 64 : b * SEQ + (cidx - 4) * 64; \
                      \
                    f32x4 v1 = (f32x4){0.f, 0.f, 0.f, 0.f}, q1 = (f32x4){0.f, 0.f, 0.f, 0.f}; \
                    _Pragma("unroll") for (int ks = 0; ks < 4; ++ks) { const bf16x8 bfr = *(const LAS bf16x8*)(STl + (16 * nt + r16) * 136 + 32 * ks + quad * 8); \
                        v1 = __builtin_amdgcn_mfma_f32_16x16x32_bf16(P##Wf[ks], bfr, v1, 0, 0, 0); q1 = __builtin_amdgcn_mfma_f32_16x16x32_bf16(P##Qf[ks], bfr, q1, 0, 0, 0); } \
                    f32x4 vn; vn[0] = bflo(P##u4.x) - v1[0]; vn[1] = bfhi(P##u4.x) - v1[1]; vn[2] = bflo(P##u4.y) - v1[2]; vn[3] = bfhi(P##u4.y) - v1[3]; \
                    { v2u p; p.x = pk2(vn[0], vn[1]); p.y = pk2(vn[2], vn[3]); *(LAS v2u*)(VNl + (16 * nt + r16) * 72 + 16 * mt + quad * 4) = p; \
                      v2u q; q.x = pk2(vn[0] * P##ksc4[0], vn[1] * P##ksc4[1]); q.y = pk2(vn[2] * P##ksc4[2], vn[3] * P##ksc4[3]); *(LAS v2u*)(VSl + (16 * nt + r16) * 72 + 16 * mt + quad * 4) = q; } \
                    f32x4 oacc = q1 * P##egc4; \
                    bf16x8 kt_[2]; \
                    _Pragma("unroll") for (int ks = 0; ks < 2; ++ks) { const v4u kx_ = P##Kx[ks]; v4u kr_; \
                        kr_.x = dir ? ((kx_.w >> 16) | (kx_.w << 16)) : kx_.x; kr_.y = dir ? ((kx_.z >> 16) | (kx_.z << 16)) : kx_.y; kr_.z = dir ? ((kx_.y >> 16) | (kx_.y << 16)) : kx_.z; kr_.w = dir ? ((kx_.x >> 16) | (kx_.x << 16)) : kx_.w; \
                        kt_[ks] = __builtin_bit_cast(bf16x8, kr_); } \
                    GDN_BAR(); \
                      \
                    { const bf16x8 b0 = *(const LAS bf16x8*)(VNl + (16 * nt + r16) * 72 + quad * 8), b1 = *(const LAS bf16x8*)(VNl + (16 * nt + r16) * 72 + 32 + quad * 8); \
                      oacc = __builtin_amdgcn_mfma_f32_16x16x32_bf16(P##Af[0], b0, oacc, 0, 0, 0); oacc = __builtin_amdgcn_mfma_f32_16x16x32_bf16(P##Af[1], b1, oacc, 0, 0, 0); } \
                    { bf16* op = O + (size_t)(row0 + (dir ? 63 - (16 * mt + quad * 4) : 16 * mt + quad * 4)) * 512 + hh * 128 + slice * 32 + 16 * nt + r16; const long ostep = dir ? -512 : 512; \
                      _Pragma("unroll") for (int j = 0; j < 4; ++j) op[j * ostep] = (bf16)f2bf(oacc[j]); } \
                    _Pragma("unroll") for (int n2 = 0; n2 < 2; ++n2) { const bf16x8 b0 = *(const LAS bf16x8*)(VSl + (16 * n2 + r16) * 72 + quad * 8), b1 = *(const LAS bf16x8*)(VSl + (16 * n2 + r16) * 72 + 32 + quad * 8); \
                        f32x4 sa = Sacc[n2] * P##egl; sa = __builtin_amdgcn_mfma_f32_16x16x32_bf16(kt_[0], b0, sa, 0, 0, 0); sa = __builtin_amdgcn_mfma_f32_16x16x32_bf16(kt_[1], b1, sa, 0, 0, 0); Sacc[n2] = sa; \
                        v2u p; p.x = pk2(sa[0], sa[1]); p.y = pk2(sa[2], sa[3]); *(LAS v2u*)(STl + (16 * n2 + r16) * 136 + 16 * w + quad * 4) = p; } \
                    GDN_BAR(); } while (0)
#define GDN_DECL(P) bf16x8 P##Wf[4], P##Qf[4], P##Af[2]; v4u P##Kx[2]; v2u P##u4; f32x4 P##egc4, P##ksc4; float P##egl
                GDN_DECL(sa_); GDN_DECL(sb_); GDN_DECL(sc_);
                GDN_LOAD(sa_, 0); GDN_LOAD(sb_, 1);
                for (int step = 0; step < 36; step += 3) {
                    GDN_LOAD(sc_, step + 2); GDN_STEP(sa_, step);
                    { const int s3 = step + 3 < 36 ? step + 3 : 35; GDN_LOAD(sa_, s3); } GDN_STEP(sb_, step + 1);
                    { const int s4 = step + 4 < 36 ? step + 4 : 35; GDN_LOAD(sb_, s4); } GDN_STEP(sc_, step + 2);
                }
#undef GDN_STEP
#undef GDN_BAR
#undef GDN_DECL
#undef GDN_LOAD
            }
        } }
        SEAM(pb + 4);

        for (int rep_ = 0; rep_ <= (int)PH_REP(6); ++rep_) { if (rep_) GRID_BAR();
        if (PH_ON(6) && IN(pb + 5)) { PH_BEGIN(); const float* mv = modv + (size_t)l * 9 * 6144; (void)mv; unsigned* const moecnt = ctl + CW_MOE + l * 16 * 64; (void)moecnt;
            const float* nw = INP(I_GNORM) + l * 128; const int ch = 8 * lane;
            for (int row = gw; row < nrows2; row += NGW) {
                float of[8], ob[8]; unpack8(*(const v4u*)(OF + (size_t)row * 512 + ch), of); unpack8(*(const v4u*)(OB + (size_t)row * 512 + ch), ob);
                const f32x4 a0 = (f32x4){of[0] + ob[0], of[1] + ob[1], of[2] + ob[2], of[3] + ob[3]}, a1 = (f32x4){of[4] + ob[4], of[5] + ob[5], of[6] + ob[6], of[7] + ob[7]};
                float ss = (a0[0] * a0[0] + a0[1] * a0[1]) + (a0[2] * a0[2] + a0[3] * a0[3]) + (a1[0] * a1[0] + a1[1] * a1[1]) + (a1[2] * a1[2] + a1[3] * a1[3]);
                const float rs = 1.0f / sqrtf(g16_sum(ss) * (1.0f / 128.0f) + LN_EPS);
                float z[8]; unpack8(*(const v4u*)(PZ + (size_t)row * 512 + ch), z); float o[8];
#pragma unroll
                for (int e = 0; e < 4; ++e) { o[e] = a0[e] * rs * nw[(ch & 127) + e] * z[e]; o[4 + e] = a1[e] * rs * nw[(ch & 127) + 4 + e] * z[4 + e]; }
                *(v4u*)(BR + (size_t)row * 512 + ch) = pack8(o);
            }
        } }
        SEAM(pb + 5);

        for (int rep_ = 0; rep_ <= (int)PH_REP(7); ++rep_) { if (rep_) GRID_BAR();
        if (PH_ON(7) && IN(pb + 6)) { PH_BEGIN(); const float* mv = modv + (size_t)l * 9 * 6144; (void)mv; unsigned* const moecnt = ctl + CW_MOE + l * 16 * 64; (void)moecnt;
            SchedBranch S{X.G, X.bid, npan2, (const char*)BR, (const char*)WBR};
            EpiBf16<0> E{GT, 4096, nullptr};
            pg8::gemm_phase<EpiBf16<0>, SchedBranch, true, true>(lds, Gemm{512, 512, 512}, S, E);
        } }
        SEAM(pb + 6);

        for (int rep_ = 0; rep_ <= (int)PH_REP(8); ++rep_) { if (rep_) GRID_BAR();
        if (PH_ON(8) && IN(pb + 7)) { PH_BEGIN(); const float* mv = modv + (size_t)l * 9 * 6144; (void)mv; unsigned* const moecnt = ctl + CW_MOE + l * 16 * 64; (void)moecnt;
            SchedGrid S{X.G, X.bid, npan2, 16, (const char*)XN, (const char*)(WIN + (size_t)5120 * 1024), (size_t)256 * 1024 * 2, (size_t)256 * 1024 * 2};
            EpiGateMerge E{GT, (bf16*)MERGED, binv + 5120};
            pg8::gemm_phase<EpiGateMerge, SchedGrid, true, true>(lds, Gemm{1024, 1024, 1024}, S, E);
        } }
        SEAM(pb + 7);

        for (int rep_ = 0; rep_ <= (int)PH_REP(9); ++rep_) { if (rep_) GRID_BAR();
        if (PH_ON(9) && IN(pb + 8)) { PH_BEGIN(); const float* mv = modv + (size_t)l * 9 * 6144; (void)mv; unsigned* const moecnt = ctl + CW_MOE + l * 16 * 64; (void)moecnt;
            SchedGrid S{X.G, X.bid, npan2, 4, (const char*)MERGED, (const char*)WOUT, (size_t)256 * 1024 * 2, (size_t)256 * 1024 * 2};
            EpiF32 E{YB, 1024, INP(I_BOUT) + l * 1024};
            pg8::gemm_phase<EpiF32, SchedGrid, true, true>(lds, Gemm{1024, 1024, 1024}, S, E);
        } }
        SEAM(pb + 8);

        for (int rep_ = 0; rep_ <= (int)PH_REP(10); ++rep_) { if (rep_) GRID_BAR();
        if (PH_ON(10) && IN(pb + 9)) { PH_BEGIN(); const float* mv = modv + (size_t)l * 9 * 6144; (void)mv; unsigned* const moecnt = ctl + CW_MOE + l * 16 * 64; (void)moecnt;
            { LAS float* const wscr = (LAS float*)(lds + X.wave * 8448);
            for (int it = gw; it < 16 * 32 * 16; it += NGW) { const int e = it >> 9, rb = (it >> 4) & 31, kb = it & 15, row0 = rb * 32, j = row0 >> 8, w = row0 & 255;
                const float* src = (w < 128 ? INP(I_EWG) : INP(I_EWU)) + ((size_t)(l * 16 + e) * 1024) * 512;
                cvt_item(src, 512, 128 * j + (w & 127) + (lane & 31), kb * 64, WGU + ((size_t)e * 1024 + row0) * 1024, 1024, wscr, lane); }
            for (int it = gw; it < 16 * 32 * 8; it += NGW) { const int e = it >> 8, rb = (it >> 3) & 31, kb = it & 7;
                cvt_item(INP(I_EWD) + ((size_t)(l * 16 + e) * 512) * 1024, 1024, rb * 32 + (lane & 31), kb * 64, WDN + ((size_t)e * 1024 + rb * 32) * 512, 512, wscr, lane); } }
            LAS float* wr_ = (LAS float*)lds;
            __syncthreads();
            for (int i = tid; i < 20 * 1024; i += 512) { const int o = i >> 10, k = i & 1023; wr_[i] = o < 4 ? INP(I_RGW)[(size_t)l * 4096 + k * 4 + o] : INP(I_REW)[(size_t)l * 16384 + k * 16 + (o - 4)]; }
            __syncthreads();
            const float* g1 = INP(I_LN1G) + l * 1024, *b1 = INP(I_LN1B) + l * 1024;
            for (int row = gw; row < nrows2; row += NGW) {
                float* hrow = row < NLAT ? hlat + (size_t)row * D : hctx + (size_t)(row - NLAT) * D;
                const int mi = row < NLAT ? (row >> 11) : 8; const float* mrow = mv + mi * 6144;
                f32x4 v[4];
#pragma unroll
                for (int j = 0; j < 4; ++j) { const int c = 4 * lane + 256 * j; v[j] = *(const f32x4*)(hrow + c) * DN_ALPHA + *(const f32x4*)(mrow + 2048 + c) * *(const f32x4*)(YB + (size_t)row * D + c); }
                ln_rows(v);
#pragma unroll
                for (int j = 0; j < 4; ++j) { const int c = 4 * lane + 256 * j; v[j] = v[j] * *(const f32x4*)(g1 + c) + *(const f32x4*)(b1 + c); *(f32x4*)(hrow + c) = v[j]; }
                ln_rows(v);
#pragma unroll
                for (int j = 0; j < 4; ++j) { const int c = 4 * lane + 256 * j; v[j] = v[j] * (*(const f32x4*)(mrow + 4096 + c) + 1.0f) + *(const f32x4*)(mrow + 3072 + c);
                    v2u w; w.x = pk2(v[j][0], v[j][1]); w.y = pk2(v[j][2], v[j][3]); *(v2u*)(XN + (size_t)row * D + c) = w; }
                float mylg = 0.f;
#pragma unroll 2
                for (int o = 0; o < 20; ++o) { float s = 0.f;
#pragma unroll
                    for (int j = 0; j < 4; ++j) { const f32x4 w = *(const LAS f32x4*)(wr_ + o * 1024 + 4 * lane + 256 * j); s += (v[j][0] * w[0] + v[j][1] * w[1]) + (v[j][2] * w[2] + v[j][3] * w[3]); }
                    s = wave_sum(s); if (lane == o) mylg = s; }
                if (lane < 20) mylg += (lane < 4 ? INP(I_RGB)[l * 4 + lane] : INP(I_REB)[l * 16 + lane - 4]);
                float lg[20];
#pragma unroll
                for (int o = 0; o < 20; ++o) lg[o] = __shfl(mylg, o);
                int gs = 0; float gm = lg[0];
#pragma unroll
                for (int o = 1; o < 4; ++o) if (lg[o] > gm) { gm = lg[o]; gs = o; }
                float den = 0.f;
#pragma unroll
                for (int o = 0; o < 4; ++o) den += expf(lg[o] - gm);
                const float gp = 1.0f / den;
                float el[4];
#pragma unroll
                for (int o = 0; o < 4; ++o) el[o] = gs == 0 ? lg[4 + o] : gs == 1 ? lg[8 + o] : gs == 2 ? lg[12 + o] : lg[16 + o];
                int i0 = 0; float v0 = el[0];
#pragma unroll
                for (int o = 1; o < 4; ++o) if (el[o] > v0) { v0 = el[o]; i0 = o; }
                int i1 = -1; float v1 = 0.f;
#pragma unroll
                for (int o = 0; o < 4; ++o) if (o != i0 && (i1 < 0 || el[o] > v1)) { v1 = el[o]; i1 = o; }
                const float ex = expf(v1 - v0), w0 = gp / (1.0f + ex), w1 = gp * ex / (1.0f + ex);
                const int e0 = gs * 4 + i0, e1 = gs * 4 + i1;
                if (lane == 0) {
                    const unsigned p0 = __hip_atomic_fetch_add(moecnt + 64 * e0, 1u, __ATOMIC_RELAXED, __HIP_MEMORY_SCOPE_AGENT);
                    const unsigned p1 = __hip_atomic_fetch_add(moecnt + 64 * e1, 1u, __ATOMIC_RELAXED, __HIP_MEMORY_SCOPE_AGENT);
                    float* rt = ROUTE + (size_t)row * 8;
                    rt[0] = __builtin_bit_cast(float, e0); rt[1] = __builtin_bit_cast(float, e1); rt[2] = w0; rt[3] = w1; rt[4] = __builtin_bit_cast(float, (int)p0); rt[5] = __builtin_bit_cast(float, (int)p1);
                }
            }
        } }
        SEAM(pb + 9);

        for (int rep_ = 0; rep_ <= (int)PH_REP(11); ++rep_) { if (rep_) GRID_BAR();
        if (PH_ON(11) && IN(pb + 10)) { PH_BEGIN(); const float* mv = modv + (size_t)l * 9 * 6144; (void)mv; unsigned* const moecnt = ctl + CW_MOE + l * 16 * 64; (void)moecnt;
            unsigned pre[16]; { unsigned s = 0;
#pragma unroll
                for (int e = 0; e < 16; ++e) { pre[e] = s; s += ((__hip_atomic_load(moecnt + 64 * e, __ATOMIC_RELAXED, __HIP_MEMORY_SCOPE_AGENT) + 255u) >> 8) << 8; } }
            for (int as = gw; as < nrows2 * 2; as += NGW) { const int row = as >> 1, sl = as & 1; const float* rt = ROUTE + (size_t)row * 8;
                const int e = __builtin_bit_cast(int, rt[sl]), p = __builtin_bit_cast(int, rt[4 + sl]); unsigned base = 0;
#pragma unroll
                for (int k = 0; k < 16; ++k) base = (k == e) ? pre[k] : base;
                const size_t dst = (size_t)(base + (unsigned)p) * D;
#pragma unroll
                for (int j = 0; j < 2; ++j) *(v4u*)(XG + dst + 8 * lane + 512 * j) = *(const v4u*)(XN + (size_t)row * D + 8 * lane + 512 * j);
            }
        } }
        SEAM(pb + 10);

        for (int rep_ = 0; rep_ <= (int)PH_REP(12); ++rep_) { if (rep_) GRID_BAR();
        if (PH_ON(12) && IN(pb + 11)) { PH_BEGIN(); const float* mv = modv + (size_t)l * 9 * 6144; (void)mv; unsigned* const moecnt = ctl + CW_MOE + l * 16 * 64; (void)moecnt;
            SchedMoe S; S.G = X.G; S.c = X.bid; S.a0 = (const char*)XG; S.w0 = (const char*)WGU; S.astep = (size_t)256 * 1024 * 2; S.wstep_e = (size_t)1024 * 1024 * 2; S.wstep_n = (size_t)256 * 1024 * 2; S.init(moecnt);
            EpiMoe1 E{HID};
            pg8::gemm_phase<EpiMoe1, SchedMoe, true, true>(lds, Gemm{1024, 1024, 1024}, S, E);
        } }
        SEAM(pb + 11);

        for (int rep_ = 0; rep_ <= (int)PH_REP(13); ++rep_) { if (rep_) GRID_BAR();
        if (PH_ON(13) && IN(pb + 12)) { PH_BEGIN(); const float* mv = modv + (size_t)l * 9 * 6144; (void)mv; unsigned* const moecnt = ctl + CW_MOE + l * 16 * 64; (void)moecnt;
            SchedMoe S; S.G = X.G; S.c = X.bid; S.a0 = (const char*)HID; S.w0 = (const char*)WDN; S.astep = (size_t)256 * 512 * 2; S.wstep_e = (size_t)1024 * 512 * 2; S.wstep_n = (size_t)256 * 512 * 2; S.init(moecnt);
            EpiBf16<0> E{MO, 1024, nullptr};
            pg8::gemm_phase<EpiBf16<0>, SchedMoe, true, true>(lds, Gemm{512, 512, 512}, S, E);
        } }
        SEAM(pb + 12);

        for (int rep_ = 0; rep_ <= (int)PH_REP(14); ++rep_) { if (rep_) GRID_BAR();
        if (PH_ON(14) && IN(pb + 13)) { PH_BEGIN(); const float* mv = modv + (size_t)l * 9 * 6144; (void)mv; unsigned* const moecnt = ctl + CW_MOE + l * 16 * 64; (void)moecnt;
            unsigned pre[16]; { unsigned s = 0;
#pragma unroll
                for (int e = 0; e < 16; ++e) { pre[e] = s; s += ((__hip_atomic_load(moecnt + 64 * e, __ATOMIC_RELAXED, __HIP_MEMORY_SCOPE_AGENT) + 255u) >> 8) << 8; } }
            const float* g2 = INP(I_LN2G) + l * 1024, *b2 = INP(I_LN2B) + l * 1024;
            for (int row = gw; row < nrows2; row += NGW) {
                float* hrow = row < NLAT ? hlat + (size_t)row * D : hctx + (size_t)(row - NLAT) * D;
                const int mi = row < NLAT ? (row >> 11) : 8; const float* mrow = mv + mi * 6144;
                const float* rt = ROUTE + (size_t)row * 8;
                const int e0 = __builtin_bit_cast(int, rt[0]), e1 = __builtin_bit_cast(int, rt[1]), p0 = __builtin_bit_cast(int, rt[4]), p1 = __builtin_bit_cast(int, rt[5]); const float w0 = rt[2], w1 = rt[3];
                unsigned ba0 = 0, ba1 = 0;
#pragma unroll
                for (int k = 0; k < 16; ++k) { ba0 = (k == e0) ? pre[k] : ba0; ba1 = (k == e1) ? pre[k] : ba1; }
                const bf16* m0 = MO + (size_t)(ba0 + (unsigned)p0) * D, *m1 = MO + (size_t)(ba1 + (unsigned)p1) * D;
                f32x4 v[4];
#pragma unroll
                for (int j = 0; j < 4; ++j) { const int c = 4 * lane + 256 * j; const v2u a = *(const v2u*)(m0 + c), b = *(const v2u*)(m1 + c);
                    f32x4 mm; mm[0] = w0 * bflo(a.x) + w1 * bflo(b.x); mm[1] = w0 * bfhi(a.x) + w1 * bfhi(b.x); mm[2] = w0 * bflo(a.y) + w1 * bflo(b.y); mm[3] = w0 * bfhi(a.y) + w1 * bfhi(b.y);
                    v[j] = *(const f32x4*)(hrow + c) * DN_ALPHA + *(const f32x4*)(mrow + 5120 + c) * mm; }
                ln_rows(v);
#pragma unroll
                for (int j = 0; j < 4; ++j) { const int c = 4 * lane + 256 * j; *(f32x4*)(hrow + c) = v[j] * *(const f32x4*)(g2 + c) + *(const f32x4*)(b2 + c); }
            }
        } }
        SEAM(pb + 13);
    }
#undef IN
#undef SEAM
}

extern "C" void kernel_launch(void* const* d_in, const int* in_sizes, int n_in, void* d_out, int out_size, void* d_ws, size_t ws_size, hipStream_t stream) {
    static int grid = 0;
    if (grid == 0) {
        if (n_in != 34 || out_size != NLAT * D || ws_size < WS_END) { fprintf(stderr, "kernel_launch: unexpected problem (n_in %d out %d ws %zu)\n", n_in, out_size, ws_size); grid = -1; return; }
        int dev = 0, cus = 0, per_cu = 0;
        if (hipGetDevice(&dev) != hipSuccess || hipDeviceGetAttribute(&cus, hipDeviceAttributeMultiprocessorCount, dev) != hipSuccess) { grid = -1; return; }
        if (hipFuncSetAttribute((const void*)fwd, hipFuncAttributeMaxDynamicSharedMemorySize, LDS_BYTES) != hipSuccess) { fprintf(stderr, "kernel_launch: hipFuncSetAttribute failed\n"); grid = -1; return; }
        if (hipOccupancyMaxActiveBlocksPerMultiprocessor(&per_cu, (const void*)fwd, NWAVES * 64, LDS_BYTES) != hipSuccess || per_cu < 1) { fprintf(stderr, "kernel_launch: occupancy query reports %d\n", per_cu); }
        (void)hipGetLastError();
        grid = cus;
    }
    if (grid < 0) return;
    if (hipMemsetAsync((char*)d_ws + WS_CTL, 0, CTL_ZERO_BYTES, stream) != hipSuccess) return;
    Args a{};
    for (int i = 0; i < 34; ++i) a.in[i] = (const float*)d_in[i];
    a.out = (float*)d_out; a.ws = (unsigned char*)d_ws;
#if MK_ONE_LAUNCH
    a.ph_lo = 0; a.ph_hi = NPHASES;
    hipLaunchKernelGGL(fwd, dim3(grid), dim3(NWAVES * 64), LDS_BYTES, stream, a);
#else
    for (int p = 0; p < NPHASES; ++p) { a.ph_lo = p; a.ph_hi = p + 1; hipLaunchKernelGGL(fwd, dim3(grid), dim3(NWAVES * 64), LDS_BYTES, stream, a); }
#endif
}
```

```cpp
#include <hip/hip_runtime.h>
#include <cstdio>
#include <cstdint>

#define GAS __attribute__((address_space(1)))
#define LAS __attribute__((address_space(3)))
typedef unsigned short bf16;
typedef unsigned v4u __attribute__((ext_vector_type(4)));
typedef unsigned v2u __attribute__((ext_vector_type(2)));
typedef float f32x4 __attribute__((ext_vector_type(4)));
typedef float f32x2 __attribute__((ext_vector_type(2)));
typedef short bf16x8 __attribute__((ext_vector_type(8)));

constexpr int D = 1024, NB = 8, SEQ = 2048, CTXL = 256, NLAT = NB * SEQ, NCTX = NB * CTXL, NTOK = NLAT + NCTX;
constexpr int OFF_Q = 0, OFF_K = 512, OFF_V = 1024, OFF_Z = 1536, OFF_A = 2048, OFF_B = 2056, OFF_CONF = 2064, OFF_FFT = 3088, OFF_SGU = 3600, OFF_GATE = 4624, N_IN = 8720;
constexpr int NWROWS = 9216;
constexpr float LN_EPS = 1e-6f;
constexpr float DN_ALPHA = 1.4142135623730951f;
constexpr int NWAVES = 8;
constexpr int NPH_LAYER = 14, NPHASES = 1 + 2 * NPH_LAYER;

#ifndef PHMASK
#define PHMASK 0xFFFFFFFFu
#endif
#define PH_ON(k) (((PHMASK) >> (k)) & 1u)
#ifndef REPMASK
#define REPMASK 0u
#endif
#define PH_REP(k) (((REPMASK) >> (k)) & 1u)
#ifndef CPART
#define CPART 15
#endif
#ifndef MK_ONE_LAUNCH
#define MK_ONE_LAUNCH 1
#endif

constexpr size_t MiB = 1u << 20;
constexpr size_t WS_CTL = 0, CTL_ZERO_BYTES = 1 * MiB;
constexpr size_t WS_MODV = 1 * MiB;
constexpr size_t WS_BIN = 1 * MiB + 512 * 1024;
constexpr size_t WS_ROUTE = WS_BIN + 64 * 1024;
constexpr size_t WS_HCTX = 3 * MiB;
constexpr size_t WS_XN = 11 * MiB;
constexpr size_t WS_WIN = 47 * MiB;
constexpr size_t WS_WBR = 65 * MiB;
constexpr size_t WS_WOUT = 69 * MiB;
constexpr size_t WS_DFTL = 71 * MiB;
constexpr size_t WS_DFTC = 87 * MiB;
constexpr size_t WS_F1B = 71 * MiB;
constexpr size_t WS_R2 = 88 * MiB;
constexpr size_t WS_PQKV = WS_R2;
constexpr size_t WS_PCONF = WS_R2 + 54 * MiB;
constexpr size_t WS_PZ = WS_R2 + 72 * MiB;
constexpr size_t WS_PSGU = WS_R2 + 90 * MiB;
constexpr size_t WS_PFFT = WS_R2 + 126 * MiB;
constexpr size_t WS_PFFTC = WS_R2 + 158 * MiB;
constexpr size_t WS_AB = WS_R2 + 162 * MiB;
constexpr size_t WS_WIT = WS_R2;
constexpr size_t WS_UIT = WS_R2 + 36 * MiB;
constexpr size_t WS_AIT = WS_R2 + 90 * MiB;
constexpr size_t WS_KIT = WS_R2 + 108 * MiB;
constexpr size_t WS_SIT = WS_R2 + 126 * MiB;
constexpr size_t WS_OF = WS_R2 + 128 * MiB;
constexpr size_t WS_OB = WS_R2 + 146 * MiB;
constexpr size_t WS_G = WS_R2;
constexpr size_t WS_WGU = WS_R2;
constexpr size_t WS_WDN = WS_R2 + 32 * MiB;
constexpr size_t WS_XG = WS_R2 + 48 * MiB;
constexpr size_t WS_R3 = WS_R2 + 164 * MiB;
constexpr size_t WS_QKV = WS_R3;
constexpr size_t WS_GB = WS_R3 + 54 * MiB;
constexpr size_t WS_BR = WS_R3 + 72 * MiB;
constexpr size_t WS_F1A = WS_BR;
constexpr size_t WS_MERGED = WS_R3;
constexpr size_t WS_Y = WS_R3 + 72 * MiB;
constexpr size_t WS_HID = WS_R3;
constexpr size_t WS_MO = WS_R3 + 40 * MiB;
constexpr size_t WS_END = WS_R3 + 144 * MiB;
static_assert(WS_END <= 405 * MiB, "workspace map");
constexpr int CW_BAR = 4096;
constexpr int CW_MOE = 16384;

constexpr int RING_BYTES = 131072;
constexpr int LDSCTL_OFF = RING_BYTES, MISC_OFF = LDSCTL_OFF + 320;
constexpr int LDS_BYTES = 147456;

#define LDS_WAIT() asm volatile("s_waitcnt lgkmcnt(0)" ::: "memory")
#define VM_WAIT() asm volatile("s_waitcnt vmcnt(0)" ::: "memory")
__device__ __forceinline__ unsigned f2bf(float f) { unsigned u = __builtin_bit_cast(unsigned, f); return (u + 0x7fffu + ((u >> 16) & 1u)) >> 16; }
__device__ __forceinline__ unsigned pk2(float lo, float hi) { return f2bf(lo) | (f2bf(hi) << 16); }
__device__ __forceinline__ float bflo(unsigned w) { return __builtin_bit_cast(float, w << 16); }
__device__ __forceinline__ float bfhi(unsigned w) { return __builtin_bit_cast(float, w & 0xffff0000u); }
__device__ __forceinline__ float bf1(bf16 b) { return __builtin_bit_cast(float, ((unsigned)b) << 16); }
__device__ __forceinline__ void unpack8(const v4u w, float (&o)[8]) { o[0] = bflo(w.x); o[1] = bfhi(w.x); o[2] = bflo(w.y); o[3] = bfhi(w.y); o[4] = bflo(w.z); o[5] = bfhi(w.z); o[6] = bflo(w.w); o[7] = bfhi(w.w); }
__device__ __forceinline__ v4u pack8(const float (&o)[8]) { v4u w; w.x = pk2(o[0], o[1]); w.y = pk2(o[2], o[3]); w.z = pk2(o[4], o[5]); w.w = pk2(o[6], o[7]); return w; }
__device__ __forceinline__ float sigmoidf_(float x) { return 1.0f / (1.0f + __expf(-x)); }
__device__ __forceinline__ float siluf_(float x) { return x / (1.0f + __expf(-x)); }
__device__ __forceinline__ float gelu_tanh(float x) { const float u = 0.7978845608028654f * (x + 0.044715f * x * x * x); return x / (1.0f + __expf(-2.0f * u)); }
__device__ __forceinline__ float wave_sum(float v) {
#pragma unroll
    for (int o = 1; o < 64; o <<= 1) v += __shfl_xor(v, o);
    return v;
}
__device__ __forceinline__ float reduce16(const float (&v)[16], int lane) {
    const bool b5 = (lane & 32) != 0, b4 = (lane & 16) != 0, b3 = (lane & 8) != 0, b2 = (lane & 4) != 0;
    float a[8], b[4], c[2];
#pragma unroll
    for (int i = 0; i < 8; ++i) a[i] = (b5 ? v[i + 8] : v[i]) + __shfl_xor(b5 ? v[i] : v[i + 8], 32);
#pragma unroll
    for (int i = 0; i < 4; ++i) b[i] = (b4 ? a[i + 4] : a[i]) + __shfl_xor(b4 ? a[i] : a[i + 4], 16);
#pragma unroll
    for (int i = 0; i < 2; ++i) c[i] = (b3 ? b[i + 2] : b[i]) + __shfl_xor(b3 ? b[i] : b[i + 2], 8);
    float d = (b2 ? c[1] : c[0]) + __shfl_xor(b2 ? c[0] : c[1], 4);
    d += __shfl_xor(d, 2); d += __shfl_xor(d, 1);
    return d;
}
__device__ __forceinline__ float reduce4(const float (&v)[4], int lane) {
    const bool b5 = (lane & 32) != 0, b4 = (lane & 16) != 0; float a[2];
#pragma unroll
    for (int i = 0; i < 2; ++i) a[i] = (b5 ? v[i + 2] : v[i]) + __shfl_xor(b5 ? v[i] : v[i + 2], 32);
    float d = (b4 ? a[1] : a[0]) + __shfl_xor(b4 ? a[0] : a[1], 16);
    d += __shfl_xor(d, 8); d += __shfl_xor(d, 4); d += __shfl_xor(d, 2); d += __shfl_xor(d, 1);
    return d;
}
__device__ __forceinline__ float g16_sum(float v) {
#pragma unroll
    for (int o = 1; o < 16; o <<= 1) v += __shfl_xor(v, o);
    return v;
}

namespace pg8 {
constexpr int BM = 256, BK = 64, HALF = 128, HTB = HALF * BK * 2, STAGE_BYTES = 8 * HTB;
__host__ __device__ __forceinline__ int lds_byte(int r, int c) { const int st = (r >> 4) * 2 + (c >> 5), rr = r & 15, cc = c & 31, ob = rr * 64 + cc * 2; return st * 1024 + (ob ^ (((ob >> 9) & 1) << 5)); }
__host__ __device__ __forceinline__ void stage_rc(int b, int& R, int& C) { const int st = b / 1024, sb = b % 1024, swz = sb ^ (((sb >> 9) & 1) << 5); R = (st >> 1) * 16 + swz / 64; C = (st & 1) * 32 + (swz % 64) / 2; }
__host__ __device__ __forceinline__ int perm32(int rho) { const int n = rho >> 4, i = rho & 15; return 8 * (i >> 2) + 4 * n + (i & 3); }

struct Unit { int pm, pn, aux; const char* a; const char* b; };
struct Gemm { int K, lda, ldb; };

__device__ __forceinline__ void map_tile(int L, int nM, int nN, int& pm, int& pn) {
    const int nwg = nM * nN; int wgid = L; { const int q = nwg / 8, r = nwg % 8, xcd = wgid % 8, off = wgid / 8; wgid = (xcd < r ? xcd * (q + 1) : r * (q + 1) + (xcd - r) * q) + off; }
    const int nig = 8 * nN, gid = wgid / nig, fm = gid * 8, gsz = (nM - fm) < 8 ? (nM - fm) : 8;
    pm = fm + ((wgid % nig) % gsz); pn = (wgid % nig) / gsz;
}
__device__ __forceinline__ unsigned cvt_pk_bf16(float lo, float hi) { unsigned r; asm volatile("v_cvt_pk_bf16_f32 %0, %1, %2" : "=v"(r) : "v"(lo), "v"(hi)); return r; }

template <class Epi, class Sched, bool ALIGN_EPI, bool SP2>
__device__ __forceinline__ void gemm_phase(LAS unsigned char* lds, const Gemm g, const Sched& S, const Epi& E) {
    int tid_l = threadIdx.x; asm volatile("" : "+v"(tid_l));
    const int tid = tid_l, wid = __builtin_amdgcn_readfirstlane(tid >> 6), lane = tid & 63, wr = wid >> 2, wc = wid & 3, fr = lane & 15, fq = lane >> 4;
    const int K = g.K, nt = K / BK;
    unsigned voffA[2], voffB[2];
#pragma unroll
    for (int i = 0; i < 2; ++i) { int R, C; stage_rc(tid * 16 + i * 8192, R, C); const int Rb = Epi::PERM ? ((R & ~31) + perm32(R & 31)) : R;
        voffA[i] = (unsigned)(R * g.lda + C) * 2u; voffB[i] = (unsigned)(Rb * g.ldb + C) * 2u; }
    const size_t kstep = (size_t)(BK * 2);
    const size_t hstepA = (size_t)HALF * g.lda * 2, hstepB = (size_t)HALF * g.ldb * 2;
    const unsigned ldsw = (unsigned)wid * 1024u;
    const int aoff = lds_byte(wr * 64 + fr, fq * 8), boff = lds_byte(wc * 32 + fr, fq * 8);
#define PG8_SA(b, h) (((b) * 2 + (h)) * HTB)
#define PG8_SB(b, h) ((4 + (b) * 2 + (h)) * HTB)
#define PG8_STAGE(bufoff, gbase, voff) do { _Pragma("unroll") for (int _i = 0; _i < 2; ++_i) \
        __builtin_amdgcn_global_load_lds((const unsigned*)((const char*)(gbase) + (voff)[_i]), (LAS unsigned*)(lds + (bufoff) + ldsw + _i * 8192), 16, 0, 0); } while (0)
#define PG8_LDA(dst, b, h) do { _Pragma("unroll") for (int m = 0; m < 4; ++m) _Pragma("unroll") for (int k = 0; k < 2; ++k) dst[m][k] = *(const LAS bf16x8*)(lds + PG8_SA(b, h) + aoff + m * 2048 + k * 1024); } while (0)
#define PG8_LDB(dst, b, h) do { _Pragma("unroll") for (int n = 0; n < 2; ++n) _Pragma("unroll") for (int k = 0; k < 2; ++k) dst[n][k] = *(const LAS bf16x8*)(lds + PG8_SB(b, h) + boff + n * 2048 + k * 1024); } while (0)
#define PG8_MMA(ai, bj, At, Bt) do { __builtin_amdgcn_s_setprio(1); _Pragma("unroll") for (int m = 0; m < 4; ++m) _Pragma("unroll") for (int n = 0; n < 2; ++n) _Pragma("unroll") for (int k = 0; k < 2; ++k) \
        acc[ai][bj][m][n] = __builtin_amdgcn_mfma_f32_16x16x32_bf16(Bt[n][k], At[m][k], acc[ai][bj][m][n], 0, 0, 0); __builtin_amdgcn_s_setprio(0); } while (0)
#define PG8_WAIT_V(n) asm volatile("s_waitcnt vmcnt(" #n ")" ::: "memory")
#define PG8_WAIT_L(n) asm volatile("s_waitcnt lgkmcnt(" #n ")" ::: "memory")
#define PG8_BAR __builtin_amdgcn_s_barrier()
#define PG8_SCHED __builtin_amdgcn_sched_barrier(0)
    Unit cur, nxt; int ui = 0;
    if (!S.next(0, cur)) return;
    f32x4 acc[2][2][4][2];
#pragma unroll
    for (int a = 0; a < 2; ++a)
#pragma unroll
        for (int b = 0; b < 2; ++b)
#pragma unroll
            for (int m = 0; m < 4; ++m)
#pragma unroll
                for (int n = 0; n < 2; ++n) acc[a][b][m][n] = (f32x4){0.f, 0.f, 0.f, 0.f};
    bf16x8 At[4][2], B0[2][2], B1[2][2];
    const char* cA = cur.a; const char* cB = cur.b;
    if constexpr (SP2) {
        PG8_STAGE(PG8_SB(0, 0), cB, voffB); PG8_STAGE(PG8_SB(0, 1), cB + hstepB, voffB); PG8_STAGE(PG8_SA(0, 0), cA, voffA); PG8_STAGE(PG8_SA(0, 1), cA + hstepA, voffA);
        if (wr == 1) PG8_BAR;
        PG8_WAIT_V(2); PG8_BAR;
        PG8_STAGE(PG8_SB(1, 0), cB + kstep, voffB); PG8_STAGE(PG8_SA(1, 0), cA + kstep, voffA); PG8_STAGE(PG8_SB(1, 1), cB + hstepB + kstep, voffB);
        PG8_WAIT_V(6); PG8_BAR;
    } else {
        PG8_STAGE(PG8_SB(0, 0), cB, voffB); PG8_STAGE(PG8_SA(0, 0), cA, voffA); PG8_STAGE(PG8_SB(0, 1), cB + hstepB, voffB); PG8_STAGE(PG8_SA(0, 1), cA + hstepA, voffA);
        if (wr == 1) PG8_BAR;
        PG8_WAIT_V(4); PG8_BAR;
        PG8_STAGE(PG8_SB(1, 0), cB + kstep, voffB); PG8_STAGE(PG8_SA(1, 0), cA + kstep, voffA); PG8_STAGE(PG8_SB(1, 1), cB + hstepB + kstep, voffB);
        PG8_WAIT_V(6); PG8_BAR;
    }
    for (;;) {
        const bool has_next = S.next(ui + 1, nxt);
        const char* nA = has_next ? nxt.a : cA; const char* nB = has_next ? nxt.b : cB;
        for (int t = 0; t < nt; t += 2) {
            const bool last = (t == nt - 2);
            const char* a1 = cA + (size_t)(t + 1) * kstep;
            const char* a2 = last ? nA : cA + (size_t)(t + 2) * kstep; const char* b2 = last ? nB : cB + (size_t)(t + 2) * kstep;
            const char* a3 = a2 + kstep; const char* b3 = b2 + kstep;
            if constexpr (SP2) {
            PG8_LDB(B0, 0, 0); PG8_LDB(B1, 0, 1); PG8_SCHED; PG8_LDA(At, 0, 0); PG8_STAGE(PG8_SA(1, 1), a1 + hstepA, voffA);
            PG8_WAIT_V(8); PG8_WAIT_L(0); PG8_BAR; PG8_MMA(0, 0, At, B0); PG8_MMA(0, 1, At, B1); PG8_BAR; PG8_SCHED;
            PG8_LDA(At, 0, 1); PG8_STAGE(PG8_SB(0, 0), b2, voffB); PG8_STAGE(PG8_SB(0, 1), b2 + hstepB, voffB); PG8_STAGE(PG8_SA(0, 0), a2, voffA);
            PG8_WAIT_V(8); PG8_WAIT_L(0); PG8_BAR; PG8_MMA(1, 0, At, B0); PG8_MMA(1, 1, At, B1); PG8_BAR; PG8_SCHED;
            PG8_LDB(B0, 1, 0); PG8_LDB(B1, 1, 1); PG8_SCHED; PG8_LDA(At, 1, 0); PG8_STAGE(PG8_SA(0, 1), a2 + hstepA, voffA);
            PG8_WAIT_V(8); PG8_WAIT_L(0); PG8_BAR; PG8_MMA(0, 0, At, B0); PG8_MMA(0, 1, At, B1); PG8_BAR; PG8_SCHED;
            PG8_LDA(At, 1, 1); PG8_STAGE(PG8_SB(1, 0), b3, voffB); PG8_STAGE(PG8_SB(1, 1), b3 + hstepB, voffB); PG8_STAGE(PG8_SA(1, 0), a3, voffA);
            PG8_WAIT_V(8); PG8_WAIT_L(0); PG8_BAR; PG8_MMA(1, 0, At, B0); PG8_MMA(1, 1, At, B1); PG8_BAR; PG8_SCHED;
            } else {
            PG8_LDB(B0, 0, 0); PG8_SCHED; PG8_LDA(At, 0, 0); PG8_STAGE(PG8_SA(1, 1), a1 + hstepA, voffA);
            PG8_WAIT_L(8); PG8_BAR; PG8_WAIT_L(0); PG8_MMA(0, 0, At, B0); PG8_BAR; PG8_SCHED;
            PG8_LDB(B1, 0, 1); PG8_STAGE(PG8_SB(0, 0), b2, voffB);
            PG8_BAR; PG8_WAIT_L(0); PG8_MMA(0, 1, At, B1); PG8_BAR;
            PG8_LDA(At, 0, 1); PG8_STAGE(PG8_SA(0, 0), a2, voffA);
            PG8_BAR; PG8_WAIT_L(0); PG8_MMA(1, 0, At, B0); PG8_BAR; PG8_SCHED;
            PG8_STAGE(PG8_SB(0, 1), b2 + hstepB, voffB);
            PG8_WAIT_V(6); PG8_BAR; PG8_MMA(1, 1, At, B1); PG8_BAR;
            PG8_LDB(B0, 1, 0); PG8_SCHED; PG8_LDA(At, 1, 0); PG8_STAGE(PG8_SA(0, 1), a2 + hstepA, voffA);
            PG8_WAIT_L(8); PG8_BAR; PG8_WAIT_L(0); PG8_MMA(0, 0, At, B0); PG8_BAR; PG8_SCHED;
            PG8_LDB(B1, 1, 1); PG8_STAGE(PG8_SB(1, 0), b3, voffB);
            PG8_BAR; PG8_WAIT_L(0); PG8_MMA(0, 1, At, B1); PG8_BAR;
            PG8_LDA(At, 1, 1); PG8_STAGE(PG8_SA(1, 0), a3, voffA);
            PG8_BAR; PG8_WAIT_L(0); PG8_MMA(1, 0, At, B0); PG8_BAR; PG8_SCHED;
            PG8_STAGE(PG8_SB(1, 1), b3 + hstepB, voffB);
            PG8_WAIT_V(6); PG8_BAR; PG8_MMA(1, 1, At, B1); PG8_BAR;
            }
        }
        if constexpr (ALIGN_EPI) { if (wr == 0) PG8_BAR; }
        E(acc, cur, wr, wc, fr, fq);
        if (!has_next) break;
#pragma unroll
        for (int a = 0; a < 2; ++a)
#pragma unroll
            for (int b = 0; b < 2; ++b)
#pragma unroll
                for (int m = 0; m < 4; ++m)
#pragma unroll
                    for (int n = 0; n < 2; ++n) acc[a][b][m][n] = (f32x4){0.f, 0.f, 0.f, 0.f};
        cur = nxt; cA = nA; cB = nB; ++ui;
        if constexpr (ALIGN_EPI) { if (wr == 1) PG8_BAR; }
    }
    PG8_WAIT_V(0);
    if constexpr (!ALIGN_EPI) { if (wr == 0) PG8_BAR; }
    PG8_BAR;
#undef PG8_SA
#undef PG8_SB
#undef PG8_STAGE
#undef PG8_LDA
#undef PG8_LDB
#undef PG8_MMA
#undef PG8_WAIT_V
#undef PG8_WAIT_L
#undef PG8_BAR
#undef PG8_SCHED
}
}
using pg8::Unit;
using pg8::Gemm;
typedef f32x4 AccT[2][2][4][2];

#define XB_TMO      128
#define XB_XCNT(j)  (256  + 64 * (j))
#define XB_XSUB(j)  (1280 + 64 * (j))
#define XB_XGEN(j)  (2304 + 64 * (j))
#define XB_TOP      3328
#define XB_TOPGEN   3392
#define XCD_BAR_WORDS 3456
#define XB_SPIN_CAP (1u << 18)
__device__ __forceinline__ unsigned xb_ld(unsigned* p)              { return __hip_atomic_load(p, __ATOMIC_RELAXED, __HIP_MEMORY_SCOPE_AGENT); }
__device__ __forceinline__ unsigned xb_add(unsigned* p, unsigned v) { return __hip_atomic_fetch_add(p, v, __ATOMIC_RELAXED, __HIP_MEMORY_SCOPE_AGENT); }
__device__ __forceinline__ unsigned xb_xcc_id() { return (unsigned)__builtin_amdgcn_s_getreg((3 << 11) | 20) & 0xFu; }
#define XB_SPIN(cond, bar) do { unsigned _sp = 0; while (cond) { __builtin_amdgcn_s_sleep(1); \
    if ((++_sp & 255u) == 0u) { if (xb_ld(&(bar)[XB_TMO])) break; if (_sp > XB_SPIN_CAP) { atomicAdd(&(bar)[XB_TMO], 1u); break; } } } } while (0)
struct XcdBarrier { unsigned* bar; unsigned x; volatile LAS unsigned* st; };
__device__ __forceinline__ XcdBarrier xcd_barrier_post(unsigned* bar, volatile LAS unsigned* st) {
    XcdBarrier b; b.bar = bar; b.x = xb_xcc_id(); b.st = st;
    if (threadIdx.x == 0) (void)xb_add(&bar[XB_XCNT(b.x)], 1u);
    return b;
}
__device__ __forceinline__ void xcd_barrier_complete(unsigned* bar, unsigned x, unsigned& nloc, unsigned& nx) {
    const unsigned G = gridDim.x * gridDim.y * gridDim.z;
    unsigned sum, cnt, mine, sp = 0u;
    for (;;) {
        sum = 0u; cnt = 0u; mine = 0u;
#pragma unroll
        for (unsigned j = 0; j < 16; ++j) { const unsigned c = xb_ld(&bar[XB_XCNT(j)]); sum += c; cnt += (c > 0u) ? 1u : 0u; mine = (j == x) ? c : mine; }
        if (sum == G) break;
        __builtin_amdgcn_s_sleep(1);
        if ((++sp & 255u) == 0u) { if (xb_ld(&bar[XB_TMO])) break; if (sp > XB_SPIN_CAP) { atomicAdd(&bar[XB_TMO], 1u); break; } }
    }
    nloc = mine > 0u ? mine : 1u; nx = cnt > 0u ? cnt : 1u;
}
__device__ __forceinline__ void xcd_barrier(const XcdBarrier& b) {
    asm volatile("s_waitcnt vmcnt(0)" ::: "memory");
    __syncthreads();
    if (threadIdx.x == 0) {
        unsigned* bar = b.bar;
        __builtin_amdgcn_s_waitcnt(0);
        unsigned nloc = b.st[0], nx = b.st[1];
        if (nloc == 0u) { xcd_barrier_complete(bar, b.x, nloc, nx); b.st[0] = nloc; b.st[1] = nx; }
        const unsigned old = xb_add(&bar[XB_XSUB(b.x)], 1u);
        const unsigned gen = old / nloc;
        if (old + 1u == (gen + 1u) * nloc) {
            __builtin_amdgcn_fence(__ATOMIC_RELEASE, "agent");
            asm volatile("s_waitcnt vmcnt(0)" ::: "memory");
            const unsigned og = xb_add(&bar[XB_TOP], 1u);
            const unsigned tg = og / nx;
            if (og + 1u == (tg + 1u) * nx) xb_add(&bar[XB_TOPGEN], 1u);
            else XB_SPIN(xb_ld(&bar[XB_TOPGEN]) == tg, bar);
            __builtin_amdgcn_fence(__ATOMIC_ACQUIRE, "agent");
            xb_add(&bar[XB_XGEN(b.x)], 1u);
            asm volatile("s_waitcnt vmcnt(0)" ::: "memory");
        } else {
            XB_SPIN(xb_ld(&bar[XB_XGEN(b.x)]) == gen, bar);
            __builtin_amdgcn_fence(__ATOMIC_ACQUIRE, "agent");
            asm volatile("s_waitcnt vmcnt(0)" ::: "memory");
        }
    }
    __syncthreads();
}

struct Args { const float* in[34]; float* out; unsigned char* ws; int ph_lo, ph_hi; };
enum { I_X = 0, I_C, I_CTX, I_CCTX, I_WMOD, I_BMOD, I_WIN, I_BIN, I_GCONV, I_GALOG, I_GDT, I_GNORM, I_CDWW, I_CDWB, I_CLNG, I_CLNB, I_SLNG, I_SLNB, I_SWS, I_SBS,
       I_WBR, I_WOUT, I_BOUT, I_LN1G, I_LN1B, I_LN2G, I_LN2B, I_RGW, I_RGB, I_REW, I_REB, I_EWG, I_EWU, I_EWD };

struct SchedInA {
    int G, c; const char* xn; const char* w;
    __device__ __forceinline__ bool next(int i, Unit& u) const {
        const int L = i * G + c; const size_t tstep = (size_t)256 * 1024 * 2;
        if (L < 1152) { int pm, pn; pg8::map_tile(L, 72, 16, pm, pn); u.pm = pm; u.pn = pn; u.aux = 0; u.a = xn + (size_t)pm * tstep; u.b = w + (size_t)pn * tstep; return true; }
        if (L < 1440) { const int q = L - 1152, pm = 16 + (q & 3), pn = q >> 2; u.pm = pm; u.pn = pn; u.aux = 1; u.a = w + (size_t)pm * tstep; u.b = xn + (size_t)pn * tstep; return true; }
        return false;
    }
};
struct SchedGrid {
    int G, c, nM, nN; const char* a0; const char* b0; size_t astep, bstep;
    __device__ __forceinline__ bool next(int i, Unit& u) const {
        const int L = i * G + c; if (L >= nM * nN) return false;
        int pm, pn; pg8::map_tile(L, nM, nN, pm, pn); u.pm = pm; u.pn = pn; u.aux = 0; u.a = a0 + (size_t)pm * astep; u.b = b0 + (size_t)pn * bstep; return true;
    }
};
struct SchedFftLat {
    int G, c; const char* dft; const char* pf;
    __device__ __forceinline__ bool next(int i, Unit& u) const {
        const int L = i * G + c; if (L >= 128) return false;
        const int b = L >> 4, kt = (L >> 1) & 7, pn = L & 1;
        u.pm = b * 8 + kt; u.pn = pn; u.aux = 0; u.a = dft + (size_t)kt * (256 * 4096 * 2); u.b = pf + (size_t)b * (512 * 4096 * 2) + (size_t)pn * (256 * 4096 * 2); return true;
    }
};
struct SchedFftCtx {
    int G, c; const char* dft; const char* pf;
    __device__ __forceinline__ bool next(int i, Unit& u) const {
        const int L = i * G + (G - 1 - c); if (L >= 16) return false;
        const int b = L >> 1, pn = L & 1;
        u.pm = 64 + b; u.pn = pn; u.aux = 0; u.a = dft; u.b = pf + (size_t)b * (512 * 512 * 2) + (size_t)pn * (256 * 512 * 2); return true;
    }
};
struct SchedBranch {
    int G, c, nM; const char* br; const char* wbr;
    __device__ __forceinline__ bool next(int j, Unit& u) const {
        const int L = j * G + c; if (L >= nM * 16) return false;
        int pm, pn; pg8::map_tile(L, nM, 16, pm, pn);
        u.pm = pm; u.pn = pn; u.aux = 0; u.a = br + (size_t)(pn >> 2) * ((size_t)NTOK * 512 * 2) + (size_t)pm * (256 * 512 * 2); u.b = wbr + (size_t)pn * (256 * 512 * 2); return true;
    }
};
struct SchedMoe {
    int G, c; unsigned pre[17]; const char* a0; const char* w0; size_t astep, wstep_e, wstep_n;
    __device__ __forceinline__ void init(const unsigned* cnt  ) {
        unsigned s = 0;
#pragma unroll
        for (int e = 0; e < 16; ++e) { pre[e] = s; s += ((unsigned)__builtin_amdgcn_readfirstlane((int)__hip_atomic_load(cnt + 64 * e, __ATOMIC_RELAXED, __HIP_MEMORY_SCOPE_AGENT)) + 255u) >> 8; }
        pre[16] = s;
    }
    __device__ __forceinline__ bool next(int i, Unit& u) const {
        const int L = i * G + c; if (L >= (int)pre[16] * 4) return false;
        const int jt = L >> 2, pn = L & 3; int e = 0;
#pragma unroll
        for (int k = 1; k < 16; ++k) e += ((unsigned)jt >= pre[k]) ? 1 : 0;
        u.pm = jt; u.pn = pn; u.aux = e; u.a = a0 + (size_t)jt * astep; u.b = w0 + (size_t)e * wstep_e + (size_t)pn * wstep_n; return true;
    }
};

struct EpiInA {
    static constexpr bool PERM = true;
    bf16 *pqkv, *pz, *pconf, *psgu, *pfft, *pfftc; const float* bias;
    __device__ __forceinline__ void operator()(const AccT& acc, const Unit& u, int wr, int wc, int fr, int fq) const {
        if (u.aux == 0) {
            const int row0 = u.pm * 256 + wr * 64 + fr, cb = wc * 32 + 8 * fq, bcol0 = u.pn * 256 + cb;
            f32x4 bv[2][2];
#pragma unroll
            for (int bj = 0; bj < 2; ++bj)
#pragma unroll
                for (int n = 0; n < 2; ++n) bv[bj][n] = *(const f32x4*)(bias + bcol0 + bj * 128 + 4 * n);
            if (u.pn < 8) {
                const bool isz = u.pn >= 6;
#pragma unroll
                for (int ai = 0; ai < 2; ++ai)
#pragma unroll
                    for (int m = 0; m < 4; ++m) { const int row = row0 + ai * 128 + m * 16;
                        bf16* rowp = isz ? (pz + (size_t)row * 512 + (u.pn - 6) * 256 + cb) : (pqkv + (size_t)row * 1536 + u.pn * 256 + cb);
#pragma unroll
                        for (int bj = 0; bj < 2; ++bj) { f32x4 v0 = acc[ai][bj][m][0] + bv[bj][0], v1 = acc[ai][bj][m][1] + bv[bj][1];
                            if (isz) {
#pragma unroll
                                for (int j = 0; j < 4; ++j) { v0[j] = siluf_(v0[j]); v1[j] = siluf_(v1[j]); } }
                            v4u w; w.x = pk2(v0[0], v0[1]); w.y = pk2(v0[2], v0[3]); w.z = pk2(v1[0], v1[1]); w.w = pk2(v1[2], v1[3]);
                            *(v4u*)(rowp + bj * 128) = w; } }
            } else if (u.pn < 12) {
#pragma unroll
                for (int ai = 0; ai < 2; ++ai)
#pragma unroll
                    for (int m = 0; m < 4; ++m) { const int row = row0 + ai * 128 + m * 16;
                        const f32x4 a0 = acc[ai][0][m][0] + bv[0][0], a1 = acc[ai][0][m][1] + bv[0][1], g0 = acc[ai][1][m][0] + bv[1][0], g1 = acc[ai][1][m][1] + bv[1][1];
                        float o[8];
#pragma unroll
                        for (int j = 0; j < 4; ++j) { o[j] = a0[j] * sigmoidf_(g0[j]); o[4 + j] = a1[j] * sigmoidf_(g1[j]); }
                        *(v4u*)(pconf + (size_t)row * 512 + (u.pn - 8) * 128 + cb) = pack8(o); }
            } else {
#pragma unroll
                for (int ai = 0; ai < 2; ++ai)
#pragma unroll
                    for (int m = 0; m < 4; ++m) { const int row = row0 + ai * 128 + m * 16;
                        bf16* rowp = psgu + (size_t)row * 1024 + (u.pn - 12) * 256 + cb;
#pragma unroll
                        for (int bj = 0; bj < 2; ++bj) { f32x4 v0 = acc[ai][bj][m][0] + bv[bj][0], v1 = acc[ai][bj][m][1] + bv[bj][1];
#pragma unroll
                            for (int j = 0; j < 4; ++j) { v0[j] = gelu_tanh(v0[j]); v1[j] = gelu_tanh(v1[j]); }
                            v4u w; w.x = pk2(v0[0], v0[1]); w.y = pk2(v0[2], v0[3]); w.z = pk2(v1[0], v1[1]); w.w = pk2(v1[2], v1[3]);
                            *(v4u*)(rowp + bj * 128) = w; } }
            }
        } else {
            const int jrow0 = (u.pm - 16) * 256 + wr * 64 + fr, tok0 = u.pn * 256 + wc * 32 + 8 * fq;
#pragma unroll
            for (int ai = 0; ai < 2; ++ai)
#pragma unroll
                for (int m = 0; m < 4; ++m) { const int jrow = jrow0 + ai * 128 + m * 16; const float bb = bias[4096 + jrow]; const int cs = jrow >> 9, rr = jrow & 511;
#pragma unroll
                    for (int bj = 0; bj < 2; ++bj) { const int tok = tok0 + bj * 128; bf16* dst;
                        if (tok < NLAT) { const int b = tok >> 11, t = tok & 2047; dst = pfft + ((size_t)(b * 512 + rr)) * 4096 + cs * 2048 + t; }
                        else { const int tc = tok - NLAT, b = tc >> 8, t = tc & 255; dst = pfftc + ((size_t)(b * 512 + rr)) * 512 + cs * 256 + t; }
                        const f32x4 v0 = acc[ai][bj][m][0] + bb, v1 = acc[ai][bj][m][1] + bb;
                        v4u w; w.x = pk2(v0[0], v0[1]); w.y = pk2(v0[2], v0[3]); w.z = pk2(v1[0], v1[1]); w.w = pk2(v1[2], v1[3]);
                        *(v4u*)dst = w; } }
        }
    }
};
template <int ACT  > struct EpiBf16 {
    static constexpr bool PERM = true;
    bf16* O; int ldc; const float* bias;
    __device__ __forceinline__ void operator()(const AccT& acc, const Unit& u, int wr, int wc, int fr, int fq) const {
        const int row0 = u.pm * 256 + wr * 64 + fr, col0 = u.pn * 256 + wc * 32 + 8 * fq;
        f32x4 bv[2][2];
#pragma unroll
        for (int bj = 0; bj < 2; ++bj)
#pragma unroll
            for (int n = 0; n < 2; ++n) bv[bj][n] = bias ? *(const f32x4*)(bias + col0 + bj * 128 + 4 * n) : (f32x4){0.f, 0.f, 0.f, 0.f};
#pragma unroll
        for (int ai = 0; ai < 2; ++ai)
#pragma unroll
            for (int m = 0; m < 4; ++m) { bf16* rowp = O + (size_t)(row0 + ai * 128 + m * 16) * ldc + col0;
#pragma unroll
                for (int bj = 0; bj < 2; ++bj) { f32x4 v0 = acc[ai][bj][m][0] + bv[bj][0], v1 = acc[ai][bj][m][1] + bv[bj][1];
                    if (ACT == 1) {
#pragma unroll
                        for (int j = 0; j < 4; ++j) { v0[j] = sigmoidf_(v0[j]); v1[j] = sigmoidf_(v1[j]); } }
                    v4u w; w.x = pk2(v0[0], v0[1]); w.y = pk2(v0[2], v0[3]); w.z = pk2(v1[0], v1[1]); w.w = pk2(v1[2], v1[3]);
                    *(v4u*)(rowp + bj * 128) = w; } }
    }
};
struct EpiF32 {
    static constexpr bool PERM = false;
    float* C; int ldc; const float* bias;
    __device__ __forceinline__ void operator()(const AccT& acc, const Unit& u, int wr, int wc, int fr, int fq) const {
        const int row0 = u.pm * 256 + wr * 64 + fr, col0 = u.pn * 256 + wc * 32 + 4 * fq;
        f32x4 bv[2][2];
#pragma unroll
        for (int bj = 0; bj < 2; ++bj)
#pragma unroll
            for (int n = 0; n < 2; ++n) bv[bj][n] = *(const f32x4*)(bias + col0 + bj * 128 + n * 16);
#pragma unroll
        for (int ai = 0; ai < 2; ++ai)
#pragma unroll
            for (int m = 0; m < 4; ++m) { float* rowp = C + (size_t)(row0 + ai * 128 + m * 16) * ldc + col0;
#pragma unroll
                for (int bj = 0; bj < 2; ++bj)
#pragma unroll
                    for (int n = 0; n < 2; ++n) *(f32x4*)(rowp + bj * 128 + n * 16) = acc[ai][bj][m][n] + bv[bj][n]; }
    }
};
struct EpiGateMerge {
    static constexpr bool PERM = true;
    const bf16* P; bf16* mbf; const float* bias;
    __device__ __forceinline__ void operator()(const AccT& acc, const Unit& u, int wr, int wc, int fr, int fq) const {
        const int row0 = u.pm * 256 + wr * 64 + fr, cb = wc * 32 + 8 * fq, d0 = u.pn * 64 + wc * 16 + 4 * fq;
        f32x4 bv[2][2];
#pragma unroll
        for (int bj = 0; bj < 2; ++bj)
#pragma unroll
            for (int n = 0; n < 2; ++n) bv[bj][n] = *(const f32x4*)(bias + u.pn * 256 + cb + bj * 128 + 4 * n);
#pragma unroll
        for (int ai = 0; ai < 2; ++ai)
#pragma unroll
            for (int m = 0; m < 4; ++m) { const size_t row = (size_t)(row0 + ai * 128 + m * 16); const bf16* pr = P + row * 4096 + d0;
                f32x4 o = (f32x4){0.f, 0.f, 0.f, 0.f};
#pragma unroll
                for (int bj = 0; bj < 2; ++bj)
#pragma unroll
                    for (int n = 0; n < 2; ++n) { const v2u pw = *(const v2u*)(pr + (2 * bj + n) * 1024); const f32x4 g = acc[ai][bj][m][n] + bv[bj][n];
                        o[0] += sigmoidf_(g[0]) * bflo(pw.x); o[1] += sigmoidf_(g[1]) * bfhi(pw.x); o[2] += sigmoidf_(g[2]) * bflo(pw.y); o[3] += sigmoidf_(g[3]) * bfhi(pw.y); }
                v2u w; w.x = pk2(o[0], o[1]); w.y = pk2(o[2], o[3]); *(v2u*)(mbf + row * 1024 + d0) = w; }
    }
};
struct EpiMoe1 {
    static constexpr bool PERM = true;
    bf16* hid;
    __device__ __forceinline__ void operator()(const AccT& acc, const Unit& u, int wr, int wc, int fr, int fq) const {
        const int row0 = u.pm * 256 + wr * 64 + fr, cb = wc * 32 + 8 * fq;
#pragma unroll
        for (int ai = 0; ai < 2; ++ai)
#pragma unroll
            for (int m = 0; m < 4; ++m) { const int row = row0 + ai * 128 + m * 16;
                const f32x4 g0 = acc[ai][0][m][0], g1 = acc[ai][0][m][1], u0 = acc[ai][1][m][0], u1 = acc[ai][1][m][1];
                float o[8];
#pragma unroll
                for (int j = 0; j < 4; ++j) { o[j] = siluf_(g0[j]) * u0[j]; o[4 + j] = siluf_(g1[j]) * u1[j]; }
                *(v4u*)(hid + (size_t)row * 512 + u.pn * 128 + cb) = pack8(o); }
    }
};

struct Ctx {
    LAS unsigned char* lds; int tid, lane, wave, G, bid;
};

__device__ __forceinline__ int gate_srccol(int r) { const int q = r - 5120, t = q >> 8, c = q & 255, bj = c >> 7, wc = (c >> 5) & 3, fq = (c >> 3) & 3, n = (c >> 2) & 1, j = c & 3;
    return OFF_GATE + (2 * bj + n) * 1024 + 64 * t + 16 * wc + 4 * fq + j; }
__device__ __forceinline__ void cvt_tile(const Ctx& X, const float* src, int ld, int k0, bf16* dst, int Kp) {
    LAS float* tile = (LAS float*)X.lds;
#pragma unroll
    for (int i = 0; i < 8; ++i) { const int kk = (X.tid >> 6) + 8 * i, nn = X.tid & 63; tile[kk * 65 + nn] = src[(size_t)(k0 + kk) * ld + nn]; }
    __syncthreads();
    { const int n = X.tid >> 3, kc = X.tid & 7; float o[8];
#pragma unroll
      for (int j = 0; j < 8; ++j) o[j] = tile[(8 * kc + j) * 65 + n];
      *(v4u*)(dst + (size_t)n * Kp + k0 + 8 * kc) = pack8(o); }
    __syncthreads();
}

__device__ __forceinline__ void cvt_item(const float* src, int ld, int srccol, int k0, bf16* dst, int Kp, LAS float* scr, int lane) {
#pragma unroll 8
    for (int i = 0; i < 32; ++i) { const int kk = 2 * i + (lane >> 5); scr[kk * 33 + (lane & 31)] = src[(size_t)(k0 + kk) * ld + srccol]; }
    LDS_WAIT(); asm volatile("" ::: "memory");
    const int c = lane & 7;
#pragma unroll
    for (int j = 0; j < 4; ++j) { const int n = (lane >> 3) + 8 * j; const LAS float* sp = scr + (8 * c) * 33 + n; float o[8];
#pragma unroll
        for (int e = 0; e < 8; ++e) o[e] = sp[e * 33];
        *(v4u*)(dst + (size_t)n * Kp + k0 + 8 * c) = pack8(o); }
    LDS_WAIT(); asm volatile("" ::: "memory");
}

__device__ __forceinline__ void ln_rows(f32x4 (&v)[4]) {
    float s = 0.f;
#pragma unroll
    for (int j = 0; j < 4; ++j) s += (v[j][0] + v[j][1]) + (v[j][2] + v[j][3]);
    const float mean = wave_sum(s) * (1.f / D); float s2 = 0.f;
#pragma unroll
    for (int j = 0; j < 4; ++j) { v[j] = v[j] - mean; s2 += (v[j][0] * v[j][0] + v[j][1] * v[j][1]) + (v[j][2] * v[j][2] + v[j][3] * v[j][3]); }
    const float rstd = 1.0f / sqrtf(wave_sum(s2) * (1.f / D) + LN_EPS);
#pragma unroll
    for (int j = 0; j < 4; ++j) v[j] = v[j] * rstd;
}

#define PH_BEGIN() \
    int tid_l = threadIdx.x; asm volatile("" : "+v"(tid_l)); const int tid = tid_l, lane = tid & 63; \
    Ctx X; X.lds = lds; X.tid = tid; X.lane = lane; X.wave = __builtin_amdgcn_readfirstlane(tid >> 6); X.G = gridDim.x; X.bid = blockIdx.x; \
    const int gw = X.bid * NWAVES + X.wave, NGW = X.G * NWAVES; (void)gw; (void)NGW; \
    const __attribute__((address_space(4))) char* kp = (const __attribute__((address_space(4))) char*)__builtin_amdgcn_kernarg_segment_ptr(); asm volatile("" : "+s"(kp)); \
    unsigned char* const ws = *(unsigned char* const __attribute__((address_space(4)))*)(kp + 280); \
    float* const hlat = *(float* const __attribute__((address_space(4)))*)(kp + 272); (void)hlat; \
    float* const hctx = (float*)(ws + WS_HCTX); (void)hctx; \
    float* const modv = (float*)(ws + WS_MODV); (void)modv; \
    float* const binv = (float*)(ws + WS_BIN); (void)binv; \
    bf16* const XN = (bf16*)(ws + WS_XN); (void)XN; \
    bf16* const WIN = (bf16*)(ws + WS_WIN); (void)WIN; \
    bf16* const WBR = (bf16*)(ws + WS_WBR); (void)WBR; \
    bf16* const WOUT = (bf16*)(ws + WS_WOUT); (void)WOUT; \
    bf16* const F1A = (bf16*)(ws + WS_F1A); (void)F1A; bf16* const F1B = (bf16*)(ws + WS_F1B); (void)F1B; \
    bf16* const DFTC = (bf16*)(ws + WS_DFTC); (void)DFTC; \
    bf16* const PQKV = (bf16*)(ws + WS_PQKV); (void)PQKV; \
    bf16* const PCONF = (bf16*)(ws + WS_PCONF); (void)PCONF; \
    bf16* const PZ = (bf16*)(ws + WS_PZ); (void)PZ; \
    bf16* const PSGU = (bf16*)(ws + WS_PSGU); (void)PSGU; \
    bf16* const PFFT = (bf16*)(ws + WS_PFFT); (void)PFFT; \
    bf16* const PFFTC = (bf16*)(ws + WS_PFFTC); (void)PFFTC; \
    float* const AB = (float*)(ws + WS_AB); (void)AB; \
    bf16* const OF = (bf16*)(ws + WS_OF); (void)OF; \
    bf16* const OB = (bf16*)(ws + WS_OB); (void)OB; \
    bf16* const WIT = (bf16*)(ws + WS_WIT); (void)WIT; \
    bf16* const UIT = (bf16*)(ws + WS_UIT); (void)UIT; \
    bf16* const AIT = (bf16*)(ws + WS_AIT); (void)AIT; \
    bf16* const KIT = (bf16*)(ws + WS_KIT); (void)KIT; \
    float* const SIT = (float*)(ws + WS_SIT); (void)SIT; \
    bf16* const GT = (bf16*)(ws + WS_G); (void)GT; \
    bf16* const WGU = (bf16*)(ws + WS_WGU); (void)WGU; \
    bf16* const WDN = (bf16*)(ws + WS_WDN); (void)WDN; \
    bf16* const XG = (bf16*)(ws + WS_XG); (void)XG; \
    bf16* const QKV = (bf16*)(ws + WS_QKV); (void)QKV; \
    float* const GB = (float*)(ws + WS_GB); (void)GB; \
    bf16* const BR = (bf16*)(ws + WS_BR); (void)BR; \
    float* const MERGED = (float*)(ws + WS_MERGED); (void)MERGED; \
    float* const YB = (float*)(ws + WS_Y); (void)YB; \
    bf16* const HID = (bf16*)(ws + WS_HID); (void)HID; \
    bf16* const MO = (bf16*)(ws + WS_MO); (void)MO; \
    float* const ROUTE = (float*)(ws + WS_ROUTE); (void)ROUTE; \
    unsigned* const ctl = (unsigned*)(ws + WS_CTL); (void)ctl;
#define INP(i) (*(const float* const __attribute__((address_space(4)))*)(kp + 8 * (i)))
__global__ void __launch_bounds__(NWAVES * 64, 2) fwd(Args args) {
    extern __shared__ __attribute__((aligned(16))) unsigned char lds_raw[];
    LAS unsigned char* const lds = (LAS unsigned char*)lds_raw;
    volatile LAS unsigned* MISC = (volatile LAS unsigned*)(lds + MISC_OFF);
    for (int u = threadIdx.x; u < (LDS_BYTES - LDSCTL_OFF) / 4; u += NWAVES * 64) ((LAS unsigned*)(lds + LDSCTL_OFF))[u] = 0u;
    __syncthreads();
#if MK_ONE_LAUNCH
    XcdBarrier bar = xcd_barrier_post((unsigned*)(args.ws + WS_CTL) + CW_BAR, MISC + 8);
#define GRID_BAR() xcd_barrier(bar)
#else
#define GRID_BAR() do { } while (0)
#endif
    const int lo = args.ph_lo, hi = args.ph_hi;
#define IN(k) (lo <= (k) && (k) < hi)
#define SEAM(k) do { if (IN(k) && IN((k) + 1)) GRID_BAR(); } while (0)

    if (PH_ON(0) && IN(0)) { PH_BEGIN();
        for (int t = gw; t < SEQ; t += NGW) {
            const int prow = t >> 6, pcol = t & 63; f32x4 pe[4];
#pragma unroll
            for (int j = 0; j < 4; ++j)
#pragma unroll
                for (int e = 0; e < 4; ++e) { const int col = 4 * lane + 256 * j + e, part = col >> 9, within = col & 511, i = within & 255;
                    const float omega = 1.0f / powf(10000.0f, (float)i * (1.0f / 256.0f)); const float ang = (float)(part ? pcol : prow) * omega;
                    pe[j][e] = (within >> 8) ? cosf(ang) : sinf(ang); }
            for (int b = 0; b < NB; ++b) { const size_t off = ((size_t)b * SEQ + t) * D;
#pragma unroll
                for (int j = 0; j < 4; ++j) *(f32x4*)(hlat + off + 4 * lane + 256 * j) = *(const f32x4*)(INP(I_X) + off + 4 * lane + 256 * j) + pe[j]; }
        }
        for (int r = gw; r < NCTX; r += NGW) {
#pragma unroll
            for (int j = 0; j < 4; ++j) *(f32x4*)(hctx + (size_t)r * D + 4 * lane + 256 * j) = *(const f32x4*)(INP(I_CTX) + (size_t)r * D + 4 * lane + 256 * j);
        }
        for (int idx = X.bid * 512 + tid; idx < 256 * 512 / 8; idx += X.G * 512) {
            const int k = idx >> 6, j0 = (idx & 63) * 8; float o[8];
#pragma unroll
            for (int e = 0; e < 8; ++e) { const int j = j0 + e, t = j & 255, a = (k * t) & 255; float s, c; sincospif((float)a * (1.0f / 128.0f), &s, &c);
                o[e] = (j < 256 ? c : -s) * 0.0625f; }
            *(v4u*)(DFTC + (size_t)k * 512 + j0) = pack8(o);
        }
        {
            LAS float* sc = (LAS float*)lds;
            LAS float* red = (LAS float*)(lds + 36864);
            for (int i = tid; i < 9 * 1024; i += 512) { const int r = i >> 10, k = i & 1023; const float c = r < 8 ? INP(I_C)[r * 1024 + k] : INP(I_CCTX)[k]; sc[i] = siluf_(c); }
            __syncthreads();
            for (int it = X.bid; it < 192; it += X.G) {
                const int l = it / 96, j = (it % 96) * 64 + lane; const float* W = INP(I_WMOD) + (size_t)l * 1024 * 6144 + j;
                float a[9];
#pragma unroll
                for (int r = 0; r < 9; ++r) a[r] = 0.f;
                const int kb = X.wave * 128;
#pragma unroll 16
                for (int k = 0; k < 128; ++k) { const float w = W[(size_t)(kb + k) * 6144];
#pragma unroll
                    for (int r = 0; r < 9; ++r) a[r] += sc[r * 1024 + kb + k] * w; }
#pragma unroll
                for (int r = 0; r < 9; ++r) red[(X.wave * 9 + r) * 64 + lane] = a[r];
                __syncthreads();
                for (int o = tid; o < 9 * 64; o += 512) { const int r = o >> 6, jj = o & 63; float s = 0.f;
#pragma unroll
                    for (int w = 0; w < 8; ++w) s += red[(w * 9 + r) * 64 + jj];
                    const int jc = (it % 96) * 64 + jj; modv[((size_t)l * 9 + r) * 6144 + jc] = s + INP(I_BMOD)[l * 6144 + jc]; }
                __syncthreads();
            }
        }
    }
    SEAM(0);

    for (int l = 0; l < 2; ++l) {
        const int pb = 1 + NPH_LAYER * l;
        const int nrows2 = (l == 1) ? NLAT : NTOK;
        const int npan2 = nrows2 / 256;

        for (int rep_ = 0; rep_ <= (int)PH_REP(1); ++rep_) { if (rep_) GRID_BAR();
        if (PH_ON(1) && IN(pb + 0)) { PH_BEGIN(); const float* mv = modv + (size_t)l * 9 * 6144; (void)mv; unsigned* const moecnt = ctl + CW_MOE + l * 16 * 64; (void)moecnt;
            const float* win = INP(I_WIN) + (size_t)l * 1024 * N_IN;
            const float* bin = INP(I_BIN) + (size_t)l * N_IN;
            LAS float* const wscr = (LAS float*)(lds + X.wave * 8448);
            for (int it = gw; it < 288 * 16; it += NGW) {
                const int rb = it >> 4, kb = it & 15, row0 = rb * 32; int col;
                if (row0 >= 4096 && row0 < 5120) continue;
                if (row0 < 2048) col = row0;
                else if (row0 < 3072) { const int q = row0 - 2048, j = q >> 8, w = q & 255; col = OFF_CONF + (w >= 128 ? 512 : 0) + 128 * j + (w & 127); }
                else if (row0 < 4096) col = OFF_SGU + (row0 - 3072);
                else col = -1;
                cvt_item(win, N_IN, col >= 0 ? col + (lane & 31) : gate_srccol(row0 + (lane & 31)), kb * 64, WIN + (size_t)row0 * 1024, 1024, wscr, lane);
            }
            __syncthreads();
            for (int it = X.bid; it < 64; it += X.G) {
                const int kb = it >> 2, g = it & 3; LAS float* Wt = (LAS float*)lds; LAS float* ct = (LAS float*)(lds + 32768); LAS float* st = ct + 128;
                for (int i = tid; i < 64 * 128; i += 512) { const int kk = i >> 7, c = i & 127; Wt[i] = win[(size_t)(kb * 64 + kk) * N_IN + OFF_FFT + g * 128 + c]; }
                if (tid < 128) { float s, c; sincospif((float)tid * (1.0f / 64.0f), &s, &c); ct[tid] = c * 0.08838834764831845f; st[tid] = s * 0.08838834764831845f; }
                __syncthreads();
                const int m = tid & 127, ks = tid >> 7; float oc[16], os[16];
#pragma unroll
                for (int kk = 0; kk < 16; ++kk) { oc[kk] = 0.f; os[kk] = 0.f; }
#pragma unroll 1
                for (int c = 0; c < 128; ++c) { const int a = (m * c) & 127; const float cv = ct[a], sv = st[a];
#pragma unroll
                    for (int kk = 0; kk < 16; ++kk) { const float w = Wt[(ks * 16 + kk) * 128 + c]; oc[kk] += w * cv; os[kk] += w * sv; } }
                bf16* dc = WIN + (size_t)(4096 + g * 128 + m) * 1024 + kb * 64 + ks * 16; bf16* dsn = dc + (size_t)512 * 1024;
                { float o[8];
#pragma unroll
                  for (int h2 = 0; h2 < 2; ++h2) {
#pragma unroll
                    for (int e = 0; e < 8; ++e) o[e] = oc[h2 * 8 + e];
                    *(v4u*)(dc + h2 * 8) = pack8(o);
#pragma unroll
                    for (int e = 0; e < 8; ++e) o[e] = os[h2 * 8 + e];
                    *(v4u*)(dsn + h2 * 8) = pack8(o); } }
                __syncthreads();
            }
            for (int r = X.bid * 512 + tid; r < NWROWS; r += X.G * 512) {
                float v;
                if (r < 2048) v = bin[r];
                else if (r < 3072) { const int q = r - 2048, j = q >> 8, w = q & 255; v = bin[OFF_CONF + (w >= 128 ? 512 : 0) + 128 * j + (w & 127)]; }
                else if (r < 4096) v = bin[OFF_SGU + (r - 3072)];
                else if (r < 5120) { const int q = r - 4096, cs = q >> 9, g = (q >> 7) & 3, m = q & 127; float s = 0.f;
                    for (int c = 0; c < 128; ++c) { float sn, cn; sincospif((float)((m * c) & 127) * (1.0f / 64.0f), &sn, &cn); s += bin[OFF_FFT + g * 128 + c] * (cs ? sn : cn); }
                    v = s * 0.08838834764831845f; }
                else v = bin[gate_srccol(r)];
                binv[r] = v;
            }
            __syncthreads();
            for (int it = gw; it < 4 * 32 * 8; it += NGW) { const int i = it >> 8, nb = (it >> 3) & 31, kb = it & 7;
                cvt_item(INP(I_WBR) + ((size_t)(l * 4 + i) * 512) * 1024, 1024, nb * 32 + (lane & 31), kb * 64, WBR + ((size_t)i * 1024 + nb * 32) * 512, 512, wscr, lane); }
            for (int it = gw; it < 32 * 16; it += NGW) { const int nb = it >> 4, kb = it & 15;
                cvt_item(INP(I_WOUT) + (size_t)l * 1024 * 1024, 1024, nb * 32 + (lane & 31), kb * 64, WOUT + (size_t)nb * 32 * 1024, 1024, wscr, lane); }
            LAS float* wab = (LAS float*)lds;
            __syncthreads();
            for (int i = tid; i < 16 * 1024; i += 512) { const int o = i >> 10, k = i & 1023; wab[i] = win[(size_t)k * N_IN + OFF_A + o]; }
            __syncthreads();
            for (int row = gw; row < NTOK; row += NGW) {
                const float* hrow = row < NLAT ? hlat + (size_t)row * D : hctx + (size_t)(row - NLAT) * D;
                const int mi = row < NLAT ? (row >> 11) : 8; const float* shift = mv + mi * 6144, *scale = shift + 1024;
                f32x4 v[4];
#pragma unroll
                for (int j = 0; j < 4; ++j) v[j] = *(const f32x4*)(hrow + 4 * lane + 256 * j);
                ln_rows(v);
#pragma unroll
                for (int j = 0; j < 4; ++j) { const f32x4 sc = *(const f32x4*)(scale + 4 * lane + 256 * j), sh = *(const f32x4*)(shift + 4 * lane + 256 * j); v[j] = v[j] * (sc + 1.0f) + sh;
                    v2u w; w.x = pk2(v[j][0], v[j][1]); w.y = pk2(v[j][2], v[j][3]); *(v2u*)(XN + (size_t)row * D + 4 * lane + 256 * j) = w; }
                float pd[16];
#pragma unroll
                for (int o = 0; o < 16; ++o) { float s = 0.f;
#pragma unroll
                    for (int j = 0; j < 4; ++j) { const f32x4 w = *(const LAS f32x4*)(wab + o * 1024 + 4 * lane + 256 * j); s += (v[j][0] * w[0] + v[j][1] * w[1]) + (v[j][2] * w[2] + v[j][3] * w[3]); }
                    pd[o] = s; if ((o & 3) == 3) asm volatile("" ::: "memory"); }
                const float tot = reduce16(pd, lane);
                if ((lane & 3) == 0) AB[(size_t)row * 16 + (lane >> 2)] = tot + bin[OFF_A + (lane >> 2)];
            }
        } }
        SEAM(pb + 0);

        for (int rep_ = 0; rep_ <= (int)PH_REP(2); ++rep_) { if (rep_) GRID_BAR();
        if (PH_ON(2) && IN(pb + 1)) { PH_BEGIN(); const float* mv = modv + (size_t)l * 9 * 6144; (void)mv; unsigned* const moecnt = ctl + CW_MOE + l * 16 * 64; (void)moecnt;
            SchedInA S{X.G, X.bid, (const char*)XN, (const char*)WIN};
            EpiInA E{PQKV, PZ, PCONF, PSGU, PFFT, PFFTC, binv};
            pg8::gemm_phase<EpiInA, SchedInA, true, true>(lds, Gemm{1024, 1024, 1024}, S, E);
        } }
        SEAM(pb + 1);

        for (int rep_ = 0; rep_ <= (int)PH_REP(3); ++rep_) { if (rep_) GRID_BAR();
        if (PH_ON(3) && IN(pb + 2)) { PH_BEGIN(); const float* mv = modv + (size_t)l * 9 * 6144; (void)mv; unsigned* const moecnt = ctl + CW_MOE + l * 16 * 64; (void)moecnt;
            {
                const int vb = X.bid, NB2 = X.G, gw2 = gw, NGW2 = NGW;
                { SchedFftCtx S{NB2, vb, (const char*)DFTC, (const char*)PFFTC}; EpiBf16<0> E{BR + (size_t)2 * NTOK * 512, 512, nullptr};
                  pg8::gemm_phase<EpiBf16<0>, SchedFftCtx, true, true>(lds, Gemm{512, 512, 512}, S, E); }
                __syncthreads();
                {
                    typedef short v4i16_t __attribute__((ext_vector_type(4)));
                    LAS unsigned char* tl = lds + X.wave * 8192;
                    const int r16 = lane & 15, quad = lane >> 4;
                    bf16x8 m1[4][2];
#pragma unroll
                    for (int mt = 0; mt < 4; ++mt)
#pragma unroll
                        for (int ks = 0; ks < 2; ++ks) { float o[8]; const int k1 = 16 * (mt & 1) + r16, ri = mt >> 1;
#pragma unroll
                            for (int e = 0; e < 8; ++e) { const int t1 = 8 * quad + e; float sn, cs; sincospif((float)((k1 * t1) & 31) * (1.0f / 16.0f), &sn, &cs);
                                o[e] = ri == 0 ? (ks == 0 ? cs : -sn) : (ks == 0 ? -sn : -cs); }
                            m1[mt][ks] = __builtin_bit_cast(bf16x8, pack8(o)); }
                    float twc[2][4][4], tws[2][4][4];
#pragma unroll
                    for (int ml = 0; ml < 2; ++ml)
#pragma unroll
                        for (int c = 0; c < 4; ++c)
#pragma unroll
                            for (int r = 0; r < 4; ++r) { const int k1 = 16 * ml + r16, t2 = 16 * c + 4 * quad + r; sincospif((float)(k1 * t2) * (1.0f / 1024.0f), &tws[ml][c][r], &twc[ml][c][r]); }
                    const unsigned tbase = (unsigned)(size_t)tl;
                    for (int it = gw2; it < NB * 512; it += NGW2) {
                        const int b = it >> 9, col = it & 511;
                        const bf16* src = PFFT + (size_t)it * 4096;
                        v4u ld[8];
#pragma unroll
                        for (int i = 0; i < 8; ++i) ld[i] = *(const v4u*)(src + (i * 64 + lane) * 8);
#pragma unroll
                        for (int i = 0; i < 8; ++i) *(LAS v4u*)(tl + (i * 64 + lane) * 16) = ld[i];
                        LDS_WAIT();
                        bf16* dst = (b < 4 ? F1A + (size_t)(b * 512 + col) * 4096 : F1B + (size_t)((b - 4) * 512 + col) * 4096);
#pragma unroll
                        for (int c = 0; c < 4; ++c) {
                            bf16x8 af[2];
#pragma unroll
                            for (int ks = 0; ks < 2; ++ks) { v4i16_t h[2];
#pragma unroll
                                for (int t = 0; t < 2; ++t) h[t] = __builtin_amdgcn_ds_read_tr16_b64_v4i16((LAS v4i16_t*)(tl + ks * 4096 + (8 * quad + 4 * t + (r16 >> 2)) * 128 + (16 * c + 4 * (lane & 3)) * 2));
                                bf16x8 f; f[0] = h[0][0]; f[1] = h[0][1]; f[2] = h[0][2]; f[3] = h[0][3]; f[4] = h[1][0]; f[5] = h[1][1]; f[6] = h[1][2]; f[7] = h[1][3]; af[ks] = f; }
                            f32x4 acc[4];
#pragma unroll
                            for (int mt = 0; mt < 4; ++mt) { acc[mt] = (f32x4){0.f, 0.f, 0.f, 0.f};
#pragma unroll
                                for (int ks = 0; ks < 2; ++ks) acc[mt] = __builtin_amdgcn_mfma_f32_16x16x32_bf16(af[ks], m1[mt][ks], acc[mt], 0, 0, 0); }
#pragma unroll
                            for (int ml = 0; ml < 2; ++ml) { const int k1 = 16 * ml + r16; float pr[4], pi[4];
#pragma unroll
                                for (int r = 0; r < 4; ++r) { const float ar = acc[ml][r], ai = acc[ml + 2][r]; pr[r] = ar * twc[ml][c][r] + ai * tws[ml][c][r]; pi[r] = ai * twc[ml][c][r] - ar * tws[ml][c][r]; }
                                v2u w0, w1; w0.x = pk2(pr[0], pr[1]); w0.y = pk2(pr[2], pr[3]); w1.x = pk2(pi[0], pi[1]); w1.y = pk2(pi[2], pi[3]);
                                *(v2u*)(dst + k1 * 128 + 16 * c + 4 * quad) = w0; *(v2u*)(dst + k1 * 128 + 64 + 16 * c + 4 * quad) = w1; }
                        }
                        LDS_WAIT();
                    }
                    (void)tbase;
                    __syncthreads();
                }
                {
                    LAS float* cwl = (LAS float*)lds;
                    const float* cw = INP(I_GCONV) + (size_t)l * 5 * 1536;
                    for (int i = tid; i < 5 * 1536 / 4; i += 512) *(LAS f32x4*)(cwl + 4 * i) = *(const f32x4*)(cw + 4 * i);
                    __syncthreads();
                    for (int row = gw2; row < NTOK; row += NGW2) {
                        int t, T; if (row < NLAT) { t = row & 2047; T = 2048; } else { t = (row - NLAT) & 255; T = 256; }
                        v4u xr[3][5];
#pragma unroll
                        for (int seg = 0; seg < 3; ++seg)
#pragma unroll
                            for (int j = 0; j < 5; ++j) { const int tt = t + j - 2; xr[seg][j] = (tt >= 0 && tt < T) ? *(const v4u*)(PQKV + (size_t)(row + j - 2) * 1536 + seg * 512 + 8 * lane) : (v4u){0u, 0u, 0u, 0u}; }
                        float av = 0.f, bv = 0.f; if (lane < 8) { av = AB[(size_t)row * 16 + lane]; bv = AB[(size_t)row * 16 + 8 + lane]; }
#pragma unroll
                        for (int seg = 0; seg < 3; ++seg) { const int ch = seg * 512 + 8 * lane; float a[8];
#pragma unroll
                            for (int e = 0; e < 8; ++e) a[e] = 0.f;
#pragma unroll
                            for (int j = 0; j < 5; ++j) { float xv[8]; unpack8(xr[seg][j], xv);
                                const f32x4 w0 = *(const LAS f32x4*)(cwl + j * 1536 + ch), w1 = *(const LAS f32x4*)(cwl + j * 1536 + ch + 4);
#pragma unroll
                                for (int e = 0; e < 4; ++e) { a[e] += w0[e] * xv[e]; a[4 + e] += w1[e] * xv[4 + e]; } }
                            float ss = 0.f;
#pragma unroll
                            for (int e = 0; e < 8; ++e) { a[e] = siluf_(a[e]); ss += a[e] * a[e]; }
                            if (seg < 2) { ss = g16_sum(ss); const float sc = (1.0f / sqrtf(ss + LN_EPS)) * (seg == 0 ? 0.08838834764831845f : 1.0f);
#pragma unroll
                                for (int e = 0; e < 8; ++e) a[e] *= sc; }
                            *(v4u*)(QKV + (size_t)row * 1536 + ch) = pack8(a); }
                        if (lane < 8) { const float xs = av + INP(I_GDT)[l * 8 + lane]; const float sp = xs > 20.f ? xs : log1pf(expf(xs));
                            GB[(size_t)row * 16 + lane] = -expf(INP(I_GALOG)[l * 8 + lane]) * sp; GB[(size_t)row * 16 + 8 + lane] = 1.0f / (1.0f + expf(-bv)); }
                    }
                    __syncthreads();
                }
                {
                    LAS bf16* xs = (LAS bf16*)lds;
                    LAS float* wl = (LAS float*)(lds + 63488);
                    const float* dw = INP(I_CDWW) + (size_t)l * 31 * 512; const float* dwb = INP(I_CDWB) + l * 512, *lg = INP(I_CLNG) + l * 512, *lb = INP(I_CLNB) + l * 512;
                    bf16* B1 = BR + (size_t)1 * NTOK * 512;
                    for (int i = tid; i < 31 * 512 / 4; i += 512) *(LAS f32x4*)(wl + 4 * i) = *(const f32x4*)(dw + 4 * i);
                    const int ch = 8 * lane, tq = X.wave;
                    f32x4 bia0 = *(const f32x4*)(dwb + ch), bia1 = *(const f32x4*)(dwb + ch + 4);
                    const f32x4 g0 = *(const f32x4*)(lg + ch), g1 = *(const f32x4*)(lg + ch + 4), b0 = *(const f32x4*)(lb + ch), b1 = *(const f32x4*)(lb + ch + 4);
                    for (int tile = vb; tile < nrows2 / 32; tile += NB2) {
                        const int t0 = tile * 32; int rbase, T; if (t0 < NLAT) { rbase = t0 & ~2047; T = 2048; } else { rbase = NLAT + ((t0 - NLAT) & ~255); T = 256; }
                        __syncthreads();
                        for (int i = tid; i < 62 * 64; i += 512) { const int r = i >> 6, c = i & 63, srow = t0 - 15 + r;
                            *(LAS v4u*)(xs + r * 512 + 8 * c) = (srow >= rbase && srow < rbase + T) ? *(const v4u*)(PCONF + (size_t)srow * 512 + 8 * c) : (v4u){0u, 0u, 0u, 0u}; }
                        __syncthreads();
                        float acc[4][8];
#pragma unroll
                        for (int k = 0; k < 4; ++k)
#pragma unroll
                            for (int e = 0; e < 4; ++e) { acc[k][e] = bia0[e]; acc[k][4 + e] = bia1[e]; }
#pragma unroll 1
                        for (int j = 0; j < 31; ++j) {
                            const f32x4 w0 = *(const LAS f32x4*)(wl + j * 512 + ch), w1 = *(const LAS f32x4*)(wl + j * 512 + ch + 4);
#pragma unroll
                            for (int k = 0; k < 4; ++k) { float xv[8]; unpack8(*(const LAS v4u*)(xs + (tq * 4 + k + j) * 512 + ch), xv);
#pragma unroll
                                for (int e = 0; e < 4; ++e) { acc[k][e] += w0[e] * xv[e]; acc[k][4 + e] += w1[e] * xv[4 + e]; } }
                        }
#pragma unroll
                        for (int k = 0; k < 4; ++k) { float s1 = 0.f;
#pragma unroll
                            for (int e = 0; e < 8; ++e) s1 += acc[k][e];
                            const float mean = g16_sum(s1) * (1.0f / 128.0f); float s2 = 0.f;
#pragma unroll
                            for (int e = 0; e < 8; ++e) { acc[k][e] -= mean; s2 += acc[k][e] * acc[k][e]; }
                            const float rstd = 1.0f / sqrtf(g16_sum(s2) * (1.0f / 128.0f) + LN_EPS); float o[8];
#pragma unroll
                            for (int e = 0; e < 4; ++e) { o[e] = siluf_(acc[k][e] * rstd * g0[e] + b0[e]); o[4 + e] = siluf_(acc[k][4 + e] * rstd * g1[e] + b1[e]); }
                            *(v4u*)(B1 + (size_t)(t0 + tq * 4 + k) * 512 + ch) = pack8(o); }
                    }
                    __syncthreads();
                }
                {
                    LAS bf16* vnT = (LAS bf16*)lds;
                    const float* lg = INP(I_SLNG) + l * 512, *lb = INP(I_SLNB) + l * 512;
                    bf16* B3 = BR + (size_t)3 * NTOK * 512;
                    const int nitems = (nrows2 / 128) * 4, r16 = lane & 15, quad = lane >> 4, w = X.wave;
                    for (int it = vb; it < nitems; it += NB2) {
                        const int chunk = it >> 2, g = it & 3, r0 = chunk * 128;
                        unsigned raw[16];
#pragma unroll
                        for (int i = 0; i < 16; ++i) raw[i] = *(const unsigned*)(PSGU + (size_t)(r0 + w * 16 + i) * 1024 + 512 + g * 128 + 2 * lane);
                        const int c = g * 128 + 2 * lane; const float lg0 = lg[c], lg1 = lg[c + 1], lb0 = lb[c], lb1 = lb[c + 1];
                        __syncthreads();
                        { float sv[16];
#pragma unroll
                          for (int i = 0; i < 16; ++i) sv[i] = bflo(raw[i]) + bfhi(raw[i]);
                          const float ts = reduce16(sv, lane) * (1.0f / 128.0f); float mean[16];
#pragma unroll
                          for (int i = 0; i < 16; ++i) { mean[i] = __shfl(ts, 4 * i); const float v0 = bflo(raw[i]) - mean[i], v1 = bfhi(raw[i]) - mean[i]; sv[i] = v0 * v0 + v1 * v1; }
                          const float tv = reduce16(sv, lane) * (1.0f / 128.0f);
#pragma unroll
                          for (int i = 0; i < 16; ++i) { const float rstd = 1.0f / sqrtf(__shfl(tv, 4 * i) + LN_EPS); const float v0 = bflo(raw[i]) - mean[i], v1 = bfhi(raw[i]) - mean[i];
                            vnT[(2 * lane) * 136 + w * 16 + i] = (bf16)f2bf(v0 * rstd * lg0 + lb0); vnT[(2 * lane + 1) * 136 + w * 16 + i] = (bf16)f2bf(v1 * rstd * lg1 + lb1); } }
                        bf16x8 wf[4];
                        { const float* wsrc = INP(I_SWS) + ((size_t)(l * 4 + g) * 128 + 16 * w + r16) * 128 + quad * 8;
#pragma unroll
                          for (int ks = 0; ks < 4; ++ks) { const f32x4 x0 = *(const f32x4*)(wsrc + 32 * ks), x1 = *(const f32x4*)(wsrc + 32 * ks + 4);
                              v4u pk; pk.x = pk2(x0[0], x0[1]); pk.y = pk2(x0[2], x0[3]); pk.z = pk2(x1[0], x1[1]); pk.w = pk2(x1[2], x1[3]); wf[ks] = __builtin_bit_cast(bf16x8, pk); } }
                        const float bs = INP(I_SBS)[(l * 4 + g) * 128 + 16 * w + r16];
                        __syncthreads();
                        const size_t prow = (size_t)(r0 + 16 * w + r16);
#pragma unroll
                        for (int nt = 0; nt < 8; ++nt) { f32x4 acc = (f32x4){0.f, 0.f, 0.f, 0.f};
#pragma unroll
                            for (int ks = 0; ks < 4; ++ks) { const bf16x8 vf = *(const LAS bf16x8*)(vnT + (16 * nt + r16) * 136 + 32 * ks + quad * 8); acc = __builtin_amdgcn_mfma_f32_16x16x32_bf16(vf, wf[ks], acc, 0, 0, 0); }
                            const v2u uw = *(const v2u*)(PSGU + prow * 1024 + g * 128 + 16 * nt + quad * 4);
                            v2u o; o.x = pk2(bflo(uw.x) * (acc[0] + bs), bfhi(uw.x) * (acc[1] + bs)); o.y = pk2(bflo(uw.y) * (acc[2] + bs), bfhi(uw.y) * (acc[3] + bs));
                            *(v2u*)(B3 + prow * 512 + g * 128 + 16 * nt + quad * 4) = o; }
                    }
                    __syncthreads();
                }
            }
        } }
        SEAM(pb + 2);

        for (int rep_ = 0; rep_ <= (int)PH_REP(4); ++rep_) { if (rep_) GRID_BAR();
        if (PH_ON(4) && IN(pb + 3)) { PH_BEGIN(); const float* mv = modv + (size_t)l * 9 * 6144; (void)mv; unsigned* const moecnt = ctl + CW_MOE + l * 16 * 64; (void)moecnt;
            {
                const int r16 = lane & 15, quad = lane >> 4;
                bf16x8 m2[4][4];
#pragma unroll
                for (int jt = 0; jt < 4; ++jt)
#pragma unroll
                    for (int ks = 0; ks < 4; ++ks) { float o[8]; const int k2 = 16 * jt + r16;
#pragma unroll
                        for (int e = 0; e < 8; ++e) { const int t2 = 32 * (ks & 1) + 8 * quad + e; float sn, cs; sincospif((float)((k2 * t2) & 63) * (1.0f / 32.0f), &sn, &cs); o[e] = ((ks >> 1) ? sn : cs) * 0.022097086912079608f; }
                        m2[jt][ks] = __builtin_bit_cast(bf16x8, pack8(o)); }
                bf16* B2 = BR + (size_t)2 * NTOK * 512;
                for (int it = gw; it < 8192; it += NGW) {
                    const int b = it >> 10, k1 = (it >> 5) & 31, ct = it & 31;
                    const bf16* f1 = (b < 4 ? F1A + (size_t)(b * 512 + 16 * ct + r16) * 4096 : F1B + (size_t)((b - 4) * 512 + 16 * ct + r16) * 4096) + k1 * 128 + 8 * quad;
                    bf16x8 af[4];
#pragma unroll
                    for (int ks = 0; ks < 4; ++ks) af[ks] = *(const bf16x8*)(f1 + 32 * ks);
#pragma unroll
                    for (int jt = 0; jt < 4; ++jt) { f32x4 acc = (f32x4){0.f, 0.f, 0.f, 0.f};
#pragma unroll
                        for (int ks = 0; ks < 4; ++ks) acc = __builtin_amdgcn_mfma_f32_16x16x32_bf16(af[ks], m2[jt][ks], acc, 0, 0, 0);
                        v2u w; w.x = pk2(acc[0], acc[1]); w.y = pk2(acc[2], acc[3]);
                        *(v2u*)(B2 + (size_t)(b * 2048 + k1 + 32 * (16 * jt + r16)) * 512 + 16 * ct + 4 * quad) = w; }
                }
            }
            for (int qi = gw; qi < 9216; qi += NGW) {
                int lane_l = lane; asm volatile("" : "+v"(lane_l));
                const int r16 = lane_l & 15, quad = lane_l >> 4;
                LAS float* const Mt = (LAS float*)(lds + X.wave * 16384);
                LAS float* const gcl = (LAS float*)(lds + 132096 + X.wave * 1024);
                const int item = qi >> 2, q = qi & 3, cidx = item % 36, chain = item / 36, dir = chain & 1, hh = (chain >> 1) & 3, b = chain >> 3;
                const int row0 = cidx < 4 ? NLAT + b * CTXL + cidx * 64 : b * SEQ + (cidx - 4) * 64;
                const int rb = row0 + (dir ? 63 : 0); const long sg = dir ? -1 : 1;
                const float ga = GB[(size_t)(rb + sg * lane_l) * 16 + dir * 4 + hh], be = GB[(size_t)(rb + sg * lane_l) * 16 + 8 + dir * 4 + hh];
                float gc = ga;
#pragma unroll
                for (int o = 1; o < 64; o <<= 1) { const float tu = __shfl_up(gc, o); gc += (lane_l >= o) ? tu : 0.f; }
                const float gl = __shfl(gc, 63);
                gcl[lane_l] = gc; gcl[64 + lane_l] = be;
                const float scl = q >= 2 ? be * __expf(gc) : be;
                bf16x8 Kf[4][4];
                { const bf16* kp = QKV + (size_t)(rb + sg * r16) * 1536 + 512 + hh * 128 + quad * 8; const long ms = sg * 16 * 1536;
#pragma unroll
                  for (int mi = 0; mi < 4; ++mi)
#pragma unroll
                      for (int ks = 0; ks < 4; ++ks) Kf[mi][ks] = *(const bf16x8*)(kp + mi * ms + ks * 32); }
                LDS_WAIT();
                if (q == 0) {
                    bf16x8 Qf[4][4];
                    { const bf16* qp = QKV + (size_t)(rb + sg * r16) * 1536 + hh * 128 + quad * 8; const long ms = sg * 16 * 1536;
#pragma unroll
                      for (int mi = 0; mi < 4; ++mi)
#pragma unroll
                          for (int ks = 0; ks < 4; ++ks) Qf[mi][ks] = *(const bf16x8*)(qp + mi * ms + ks * 32); }
                    bf16* ait = AIT + (size_t)item * 4096 + r16 * 64 + quad * 4;
#pragma unroll
                    for (int mi = 0; mi < 4; ++mi) { const float gci = gcl[16 * mi + r16];
#pragma unroll
                        for (int nj = 0; nj < 4; ++nj) {
                            v2u w; w.x = 0u; w.y = 0u;
                            if (nj <= mi) {
                                f32x4 c = (f32x4){0.f, 0.f, 0.f, 0.f};
#pragma unroll
                                for (int ks = 0; ks < 4; ++ks) c = __builtin_amdgcn_mfma_f32_16x16x32_bf16(Kf[nj][ks], Qf[mi][ks], c, 0, 0, 0);
                                const f32x4 gcj = *(const LAS f32x4*)(gcl + 16 * nj + quad * 4); float o4[4];
#pragma unroll
                                for (int r = 0; r < 4; ++r) { const bool incl = (nj < mi) || (quad * 4 + r <= r16); o4[r] = incl ? c[r] * __expf(gci - gcj[r]) : 0.f; }
                                w.x = pk2(o4[0], o4[1]); w.y = pk2(o4[2], o4[3]); }
                            *(v2u*)(ait + mi * 16 * 64 + 16 * nj) = w; }
                    }
                }
                if (q == 1) { SIT[(size_t)item * 192 + lane_l] = __expf(gc); SIT[(size_t)item * 192 + 64 + lane_l] = __expf(gl - gc); if (lane_l == 0) SIT[(size_t)item * 192 + 128] = __expf(gl); }
                asm volatile("" ::: "memory");
                { LAS float* mw = Mt + r16 * 64 + quad * 4;
#pragma unroll
                  for (int mi = 0; mi < 4; ++mi) {
                    const f32x4 gci = *(const LAS f32x4*)(gcl + 16 * mi + quad * 4), bei = *(const LAS f32x4*)(gcl + 64 + 16 * mi + quad * 4);
#pragma unroll
                    for (int nj = 0; nj <= mi; ++nj) {
                        f32x4 c = (f32x4){0.f, 0.f, 0.f, 0.f};
#pragma unroll
                        for (int ks = 0; ks < 4; ++ks) c = __builtin_amdgcn_mfma_f32_16x16x32_bf16(Kf[mi][ks], Kf[nj][ks], c, 0, 0, 0);
                        const float gcj = gcl[16 * nj + r16]; f32x4 mv4;
#pragma unroll
                        for (int r = 0; r < 4; ++r) { const bool strict = (nj < mi) || (r16 < quad * 4 + r); mv4[r] = strict ? -(bei[r] * c[r] * __expf(gci[r] - gcj)) : 0.f; }
                        *(LAS f32x4*)(mw + (16 * nj) * 64 + 16 * mi) = mv4;
                    }
                  } }
                asm volatile("" ::: "memory");
                LDS_WAIT();
                float Xs[64];
                { const bf16* src = QKV + (size_t)rb * 1536 + (q < 2 ? 1024 + 64 * q : 512 + 64 * (q - 2)) + hh * 128 + lane_l; const long sstep = sg * 1536;
                  bf16 raw[64];
#pragma unroll
                  for (int sidx = 0; sidx < 64; ++sidx) { raw[sidx] = *src; src += sstep; }
                  asm volatile("" ::: "memory");
#pragma unroll
                  for (int sidx = 0; sidx < 64; ++sidx) { const float sc = __builtin_bit_cast(float, __builtin_amdgcn_readlane(__builtin_bit_cast(int, scl), sidx)); Xs[sidx] = bf1(raw[sidx]) * sc; } }
#pragma unroll
                for (int g4 = 0; g4 < 16; ++g4) {
                    f32x4 acc = (f32x4){Xs[4 * g4], Xs[4 * g4 + 1], Xs[4 * g4 + 2], Xs[4 * g4 + 3]};
#pragma unroll
                    for (int c0 = 0; c0 < 4 * g4; c0 += 16) {
                        f32x4 mb[16];
#pragma unroll
                        for (int e = 0; e < 16; ++e) if (c0 + e < 4 * g4) mb[e] = *(const LAS f32x4*)(Mt + (c0 + e) * 64 + 4 * g4);
                        LDS_WAIT();
#pragma unroll
                        for (int e = 0; e < 16; ++e) if (c0 + e < 4 * g4) acc += mb[e] * Xs[c0 + e];
                    }
                    const f32x4 m0 = *(const LAS f32x4*)(Mt + (4 * g4) * 64 + 4 * g4), m1 = *(const LAS f32x4*)(Mt + (4 * g4 + 1) * 64 + 4 * g4), m2 = *(const LAS f32x4*)(Mt + (4 * g4 + 2) * 64 + 4 * g4);
                    LDS_WAIT();
                    const float x0 = acc[0], x1 = acc[1] + m0[1] * x0, x2 = acc[2] + m0[2] * x0 + m1[2] * x1, x3 = acc[3] + m0[3] * x0 + m1[3] * x1 + m2[3] * x2;
                    Xs[4 * g4] = x0; Xs[4 * g4 + 1] = x1; Xs[4 * g4 + 2] = x2; Xs[4 * g4 + 3] = x3;
                }
                if (q < 2) {
                    bf16* u0 = UIT + (size_t)item * 8192 + (size_t)(64 * q + lane_l) * 64;
#pragma unroll
                    for (int p = 0; p < 8; ++p) { float c0[8];
#pragma unroll
                        for (int e = 0; e < 8; ++e) c0[e] = Xs[8 * p + e];
                        *(v4u*)(u0 + 8 * p) = pack8(c0); }
                } else {
                    bf16* w0 = WIT + (size_t)item * 8192 + 64 * (q - 2) + lane_l;
#pragma unroll
                    for (int sidx = 0; sidx < 64; ++sidx) { w0[sidx * 128] = (bf16)f2bf(Xs[sidx]); if ((sidx & 15) == 15) asm volatile("" ::: "memory"); }
                    asm volatile("" ::: "memory");
                    if (dir == 0) {
                        const bf16* src = QKV + (size_t)row0 * 1536 + 512 + hh * 128 + 64 * (q - 2) + lane_l;
                        bf16* k0 = KIT + ((size_t)((b * 4 + hh) * 36 + cidx)) * 8192 + (size_t)(64 * (q - 2) + lane_l) * 64;
                        unsigned kw[64];
#pragma unroll
                        for (int e = 0; e < 64; ++e) kw[e] = src[(size_t)e * 1536];
                        asm volatile("" ::: "memory");
#pragma unroll
                        for (int p = 0; p < 8; ++p) { v4u lo; lo.x = kw[8 * p] | (kw[8 * p + 1] << 16); lo.y = kw[8 * p + 2] | (kw[8 * p + 3] << 16); lo.z = kw[8 * p + 4] | (kw[8 * p + 5] << 16); lo.w = kw[8 * p + 6] | (kw[8 * p + 7] << 16);
                            *(v4u*)(k0 + 8 * p) = lo; }
                    }
                }
                LDS_WAIT();
            }
        } }
        SEAM(pb + 3);

        for (int rep_ = 0; rep_ <= (int)PH_REP(5); ++rep_) { if (rep_) GRID_BAR();
        if (PH_ON(5) && IN(pb + 4)) { PH_BEGIN(); const float* mv = modv + (size_t)l * 9 * 6144; (void)mv; unsigned* const moecnt = ctl + CW_MOE + l * 16 * 64; (void)moecnt;
            LAS bf16* const STl = (LAS bf16*)lds;
            LAS bf16* const VNl = (LAS bf16*)(lds + 8704);
            LAS bf16* const VSl = (LAS bf16*)(lds + 13312);
            const int w = X.wave, mt = w & 3, nt = w >> 2, r16 = lane & 15, quad = lane >> 4;
            for (int blk = X.bid; blk < 256; blk += X.G) {
                const int chain = blk >> 2, slice = blk & 3, dir = chain & 1, hh = (chain >> 1) & 3, b = chain >> 3;
                bf16* const O = dir ? OB : OF;
                __syncthreads();
                for (int i = tid; i < 32 * 136 / 2; i += 512) ((LAS unsigned*)STl)[i] = 0u;
                __syncthreads();
                f32x4 Sacc[2]; Sacc[0] = (f32x4){0.f, 0.f, 0.f, 0.f}; Sacc[1] = (f32x4){0.f, 0.f, 0.f, 0.f};
#define GDN_LOAD(P, step_) do { const int cidx_ = dir ? ((step_) < 4 ? 3 - (step_) : 39 - (step_)) : (step_); const int item_ = chain * 36 + cidx_, kti_ = (chain >> 1) * 36 + cidx_; \
                    const int row0_ = cidx_ < 4 ? NLAT + b * CTXL + cidx_ * 64 : b * SEQ + (cidx_ - 4) * 64; \
                    const bf16* wp_ = WIT + (size_t)item_ * 8192 + (16 * mt + r16) * 128 + quad * 8; const bf16* qp_ = QKV + (size_t)(row0_ + (dir ? 63 - (16 * mt + r16) : 16 * mt + r16)) * 1536 + hh * 128 + quad * 8; \
                    _Pragma("unroll") for (int ks = 0; ks < 4; ++ks) { P##Wf[ks] = *(const bf16x8*)(wp_ + 32 * ks); P##Qf[ks] = *(const bf16x8*)(qp_ + 32 * ks); } \
                    const bf16* ap_ = AIT + (size_t)item_ * 4096 + (16 * mt + r16) * 64 + quad * 8; const bf16* kp_ = KIT + (size_t)kti_ * 8192 + (16 * w + r16) * 64 + (dir ? 56 - quad * 8 : quad * 8); \
                    _Pragma("unroll") for (int ks = 0; ks < 2; ++ks) { P##Af[ks] = *(const bf16x8*)(ap_ + 32 * ks); P##Kx[ks] = *(const v4u*)(kp_ + (dir ? -32 * ks : 32 * ks)); } \
                    P##u4 = *(const v2u*)(UIT + (size_t)item_ * 8192 + (size_t)(slice * 32 + 16 * nt + r16) * 64 + 16 * mt + quad * 4); \
                    const float* sp_ = SIT + (size_t)item_ * 192; P##egc4 = *(const f32x4*)(sp_ + 16 * mt + quad * 4); P##ksc4 = *(const f32x4*)(sp_ + 64 + 16 * mt + quad * 4); P##egl = sp_[128]; } while (0)
#define GDN_BAR() do { asm volatile("s_waitcnt lgkmcnt(0)" ::: "memory"); __builtin_amdgcn_s_barrier(); asm volatile("" ::: "memory"); } while (0)
#define GDN_STEP(P, step_) do { const int cidx = dir ? ((step_) < 4 ? 3 - (step_) : 39 - (step_)) : (step_); \
                    const int row0 = cidx < 4 ? NLAT + b * CTXL + cidx * 64 : b * SEQ + (cidx - 4) * 64; \
                      \
                    f32x4 v1 = (f32x4){0.f, 0.f, 0.f, 0.f}, q1 = (f32x4){0.f, 0.f, 0.f, 0.f}; \
                    _Pragma("unroll") for (int ks = 0; ks < 4; ++ks) { const bf16x8 bfr = *(const LAS bf16x8*)(STl + (16 * nt + r16) * 136 + 32 * ks + quad * 8); \
                        v1 = __builtin_amdgcn_mfma_f32_16x16x32_bf16(P##Wf[ks], bfr, v1, 0, 0, 0); q1 = __builtin_amdgcn_mfma_f32_16x16x32_bf16(P##Qf[ks], bfr, q1, 0, 0, 0); } \
                    f32x4 vn; vn[0] = bflo(P##u4.x) - v1[0]; vn[1] = bfhi(P##u4.x) - v1[1]; vn[2] = bflo(P##u4.y) - v1[2]; vn[3] = bfhi(P##u4.y) - v1[3]; \
                    { v2u p; p.x = pk2(vn[0], vn[1]); p.y = pk2(vn[2], vn[3]); *(LAS v2u*)(VNl + (16 * nt + r16) * 72 + 16 * mt + quad * 4) = p; \
                      v2u q; q.x = pk2(vn[0] * P##ksc4[0], vn[1] * P##ksc4[1]); q.y = pk2(vn[2] * P##ksc4[2], vn[3] * P##ksc4[3]); *(LAS v2u*)(VSl + (16 * nt + r16) * 72 + 16 * mt + quad * 4) = q; } \
                    f32x4 oacc = q1 * P##egc4; \
                    bf16x8 kt_[2]; \
                    _Pragma("unroll") for (int ks = 0; ks < 2; ++ks) { const v4u kx_ = P##Kx[ks]; v4u kr_; \
                        kr_.x = dir ? ((kx_.w >> 16) | (kx_.w << 16)) : kx_.x; kr_.y = dir ? ((kx_.z >> 16) | (kx_.z << 16)) : kx_.y; kr_.z = dir ? ((kx_.y >> 16) | (kx_.y << 16)) : kx_.z; kr_.w = dir ? ((kx_.x >> 16) | (kx_.x << 16)) : kx_.w; \
                        kt_[ks] = __builtin_bit_cast(bf16x8, kr_); } \
                    GDN_BAR(); \
                      \
                    { const bf16x8 b0 = *(const LAS bf16x8*)(VNl + (16 * nt + r16) * 72 + quad * 8), b1 = *(const LAS bf16x8*)(VNl + (16 * nt + r16) * 72 + 32 + quad * 8); \
                      oacc = __builtin_amdgcn_mfma_f32_16x16x32_bf16(P##Af[0], b0, oacc, 0, 0, 0); oacc = __builtin_amdgcn_mfma_f32_16x16x32_bf16(P##Af[1], b1, oacc, 0, 0, 0); } \
                    { bf16* op = O + (size_t)(row0 + (dir ? 63 - (16 * mt + quad * 4) : 16 * mt + quad * 4)) * 512 + hh * 128 + slice * 32 + 16 * nt + r16; const long ostep = dir ? -512 : 512; \
                      _Pragma("unroll") for (int j = 0; j < 4; ++j) op[j * ostep] = (bf16)f2bf(oacc[j]); } \
                    _Pragma("unroll") for (int n2 = 0; n2 < 2; ++n2) { const bf16x8 b0 = *(const LAS bf16x8*)(VSl + (16 * n2 + r16) * 72 + quad * 8), b1 = *(const LAS bf16x8*)(VSl + (16 * n2 + r16) * 72 + 32 + quad * 8); \
                        f32x4 sa = Sacc[n2] * P##egl; sa = __builtin_amdgcn_mfma_f32_16x16x32_bf16(kt_[0], b0, sa, 0, 0, 0); sa = __builtin_amdgcn_mfma_f32_16x16x32_bf16(kt_[1], b1, sa, 0, 0, 0); Sacc[n2] = sa; \
                        v2u p; p.x = pk2(sa[0], sa[1]); p.y = pk2(sa[2], sa[3]); *(LAS v2u*)(STl + (16 * n2 + r16) * 136 + 16 * w + quad * 4) = p; } \
                    GDN_BAR(); } while (0)
#define GDN_DECL(P) bf16x8 P##Wf[4], P##Qf[4], P##Af[2]; v4u P##Kx[2]; v2u P##u4; f32x4 P##egc4, P##ksc4; float P##egl
                GDN_DECL(sa_); GDN_DECL(sb_); GDN_DECL(sc_);
                GDN_LOAD(sa_, 0); GDN_LOAD(sb_, 1);
                for (int step = 0; step < 36; step += 3) {
                    GDN_LOAD(sc_, step + 2); GDN_STEP(sa_, step);
                    { const int s3 = step + 3 < 36 ? step + 3 : 35; GDN_LOAD(sa_, s3); } GDN_STEP(sb_, step + 1);
                    { const int s4 = step + 4 < 36 ? step + 4 : 35; GDN_LOAD(sb_, s4); } GDN_STEP(sc_, step + 2);
                }
#undef GDN_STEP
#undef GDN_BAR
#undef GDN_DECL
#undef GDN_LOAD
            }
        } }
        SEAM(pb + 4);

        for (int rep_ = 0; rep_ <= (int)PH_REP(6); ++rep_) { if (rep_) GRID_BAR();
        if (PH_ON(6) && IN(pb + 5)) { PH_BEGIN(); const float* mv = modv + (size_t)l * 9 * 6144; (void)mv; unsigned* const moecnt = ctl + CW_MOE + l * 16 * 64; (void)moecnt;
            const float* nw = INP(I_GNORM) + l * 128; const int ch = 8 * lane;
            for (int row = gw; row < nrows2; row += NGW) {
                float of[8], ob[8]; unpack8(*(const v4u*)(OF + (size_t)row * 512 + ch), of); unpack8(*(const v4u*)(OB + (size_t)row * 512 + ch), ob);
                const f32x4 a0 = (f32x4){of[0] + ob[0], of[1] + ob[1], of[2] + ob[2], of[3] + ob[3]}, a1 = (f32x4){of[4] + ob[4], of[5] + ob[5], of[6] + ob[6], of[7] + ob[7]};
                float ss = (a0[0] * a0[0] + a0[1] * a0[1]) + (a0[2] * a0[2] + a0[3] * a0[3]) + (a1[0] * a1[0] + a1[1] * a1[1]) + (a1[2] * a1[2] + a1[3] * a1[3]);
                const float rs = 1.0f / sqrtf(g16_sum(ss) * (1.0f / 128.0f) + LN_EPS);
                float z[8]; unpack8(*(const v4u*)(PZ + (size_t)row * 512 + ch), z); float o[8];
#pragma unroll
                for (int e = 0; e < 4; ++e) { o[e] = a0[e] * rs * nw[(ch & 127) + e] * z[e]; o[4 + e] = a1[e] * rs * nw[(ch & 127) + 4 + e] * z[4 + e]; }
                *(v4u*)(BR + (size_t)row * 512 + ch) = pack8(o);
            }
        } }
        SEAM(pb + 5);

        for (int rep_ = 0; rep_ <= (int)PH_REP(7); ++rep_) { if (rep_) GRID_BAR();
        if (PH_ON(7) && IN(pb + 6)) { PH_BEGIN(); const float* mv = modv + (size_t)l * 9 * 6144; (void)mv; unsigned* const moecnt = ctl + CW_MOE + l * 16 * 64; (void)moecnt;
            SchedBranch S{X.G, X.bid, npan2, (const char*)BR, (const char*)WBR};
            EpiBf16<0> E{GT, 4096, nullptr};
            pg8::gemm_phase<EpiBf16<0>, SchedBranch, true, true>(lds, Gemm{512, 512, 512}, S, E);
        } }
        SEAM(pb + 6);

        for (int rep_ = 0; rep_ <= (int)PH_REP(8); ++rep_) { if (rep_) GRID_BAR();
        if (PH_ON(8) && IN(pb + 7)) { PH_BEGIN(); const float* mv = modv + (size_t)l * 9 * 6144; (void)mv; unsigned* const moecnt = ctl + CW_MOE + l * 16 * 64; (void)moecnt;
            SchedGrid S{X.G, X.bid, npan2, 16, (const char*)XN, (const char*)(WIN + (size_t)5120 * 1024), (size_t)256 * 1024 * 2, (size_t)256 * 1024 * 2};
            EpiGateMerge E{GT, (bf16*)MERGED, binv + 5120};
            pg8::gemm_phase<EpiGateMerge, SchedGrid, true, true>(lds, Gemm{1024, 1024, 1024}, S, E);
        } }
        SEAM(pb + 7);

        for (int rep_ = 0; rep_ <= (int)PH_REP(9); ++rep_) { if (rep_) GRID_BAR();
        if (PH_ON(9) && IN(pb + 8)) { PH_BEGIN(); const float* mv = modv + (size_t)l * 9 * 6144; (void)mv; unsigned* const moecnt = ctl + CW_MOE + l * 16 * 64; (void)moecnt;
            SchedGrid S{X.G, X.bid, npan2, 4, (const char*)MERGED, (const char*)WOUT, (size_t)256 * 1024 * 2, (size_t)256 * 1024 * 2};
            EpiF32 E{YB, 1024, INP(I_BOUT) + l * 1024};
            pg8::gemm_phase<EpiF32, SchedGrid, true, true>(lds, Gemm{1024, 1024, 1024}, S, E);
        } }
        SEAM(pb + 8);

        for (int rep_ = 0; rep_ <= (int)PH_REP(10); ++rep_) { if (rep_) GRID_BAR();
        if (PH_ON(10) && IN(pb + 9)) { PH_BEGIN(); const float* mv = modv + (size_t)l * 9 * 6144; (void)mv; unsigned* const moecnt = ctl + CW_MOE + l * 16 * 64; (void)moecnt;
            { LAS float* const wscr = (LAS float*)(lds + X.wave * 8448);
            for (int it = gw; it < 16 * 32 * 16; it += NGW) { const int e = it >> 9, rb = (it >> 4) & 31, kb = it & 15, row0 = rb * 32, j = row0 >> 8, w = row0 & 255;
                const float* src = (w < 128 ? INP(I_EWG) : INP(I_EWU)) + ((size_t)(l * 16 + e) * 1024) * 512;
                cvt_item(src, 512, 128 * j + (w & 127) + (lane & 31), kb * 64, WGU + ((size_t)e * 1024 + row0) * 1024, 1024, wscr, lane); }
            for (int it = gw; it < 16 * 32 * 8; it += NGW) { const int e = it >> 8, rb = (it >> 3) & 31, kb = it & 7;
                cvt_item(INP(I_EWD) + ((size_t)(l * 16 + e) * 512) * 1024, 1024, rb * 32 + (lane & 31), kb * 64, WDN + ((size_t)e * 1024 + rb * 32) * 512, 512, wscr, lane); } }
            LAS float* wr_ = (LAS float*)lds;
            __syncthreads();
            for (int i = tid; i < 20 * 1024; i += 512) { const int o = i >> 10, k = i & 1023; wr_[i] = o < 4 ? INP(I_RGW)[(size_t)l * 4096 + k * 4 + o] : INP(I_REW)[(size_t)l * 16384 + k * 16 + (o - 4)]; }
            __syncthreads();
            const float* g1 = INP(I_LN1G) + l * 1024, *b1 = INP(I_LN1B) + l * 1024;
            for (int row = gw; row < nrows2; row += NGW) {
                float* hrow = row < NLAT ? hlat + (size_t)row * D : hctx + (size_t)(row - NLAT) * D;
                const int mi = row < NLAT ? (row >> 11) : 8; const float* mrow = mv + mi * 6144;
                f32x4 v[4];
#pragma unroll
                for (int j = 0; j < 4; ++j) { const int c = 4 * lane + 256 * j; v[j] = *(const f32x4*)(hrow + c) * DN_ALPHA + *(const f32x4*)(mrow + 2048 + c) * *(const f32x4*)(YB + (size_t)row * D + c); }
                ln_rows(v);
#pragma unroll
                for (int j = 0; j < 4; ++j) { const int c = 4 * lane + 256 * j; v[j] = v[j] * *(const f32x4*)(g1 + c) + *(const f32x4*)(b1 + c); *(f32x4*)(hrow + c) = v[j]; }
                ln_rows(v);
#pragma unroll
                for (int j = 0; j < 4; ++j) { const int c = 4 * lane + 256 * j; v[j] = v[j] * (*(const f32x4*)(mrow + 4096 + c) + 1.0f) + *(const f32x4*)(mrow + 3072 + c);
                    v2u w; w.x = pk2(v[j][0], v[j][1]); w.y = pk2(v[j][2], v[j][3]); *(v2u*)(XN + (size_t)row * D + c) = w; }
                float pg[4], pe[16];
#pragma unroll
                for (int o = 0; o < 20; ++o) { float s = 0.f;
#pragma unroll
                    for (int j = 0; j < 4; ++j) { const f32x4 w = *(const LAS f32x4*)(wr_ + o * 1024 + 4 * lane + 256 * j); s += (v[j][0] * w[0] + v[j][1] * w[1]) + (v[j][2] * w[2] + v[j][3] * w[3]); }
                    if (o < 4) pg[o] = s; else pe[o - 4] = s; if ((o & 3) == 3) asm volatile("" ::: "memory"); }
                float tg = reduce4(pg, lane), te = reduce16(pe, lane);
                tg += INP(I_RGB)[l * 4 + ((lane >> 4) & 3)]; te += INP(I_REB)[l * 16 + ((lane >> 2) & 15)];
                float lg[20];
#pragma unroll
                for (int o = 0; o < 4; ++o) lg[o] = __shfl(tg, o * 16);
#pragma unroll
                for (int o = 0; o < 16; ++o) lg[4 + o] = __shfl(te, o * 4);
                int gs = 0; float gm = lg[0];
#pragma unroll
                for (int o = 1; o < 4; ++o) if (lg[o] > gm) { gm = lg[o]; gs = o; }
                float den = 0.f;
#pragma unroll
                for (int o = 0; o < 4; ++o) den += expf(lg[o] - gm);
                const float gp = 1.0f / den;
                float el[4];
#pragma unroll
                for (int o = 0; o < 4; ++o) el[o] = gs == 0 ? lg[4 + o] : gs == 1 ? lg[8 + o] : gs == 2 ? lg[12 + o] : lg[16 + o];
                int i0 = 0; float v0 = el[0];
#pragma unroll
                for (int o = 1; o < 4; ++o) if (el[o] > v0) { v0 = el[o]; i0 = o; }
                int i1 = -1; float v1 = 0.f;
#pragma unroll
                for (int o = 0; o < 4; ++o) if (o != i0 && (i1 < 0 || el[o] > v1)) { v1 = el[o]; i1 = o; }
                const float ex = expf(v1 - v0), w0 = gp / (1.0f + ex), w1 = gp * ex / (1.0f + ex);
                const int e0 = gs * 4 + i0, e1 = gs * 4 + i1;
                if (lane == 0) {
                    const unsigned p0 = __hip_atomic_fetch_add(moecnt + 64 * e0, 1u, __ATOMIC_RELAXED, __HIP_MEMORY_SCOPE_AGENT);
                    const unsigned p1 = __hip_atomic_fetch_add(moecnt + 64 * e1, 1u, __ATOMIC_RELAXED, __HIP_MEMORY_SCOPE_AGENT);
                    float* rt = ROUTE + (size_t)row * 8;
                    rt[0] = __builtin_bit_cast(float, e0); rt[1] = __builtin_bit_cast(float, e1); rt[2] = w0; rt[3] = w1; rt[4] = __builtin_bit_cast(float, (int)p0); rt[5] = __builtin_bit_cast(float, (int)p1);
                }
            }
        } }
        SEAM(pb + 9);

        for (int rep_ = 0; rep_ <= (int)PH_REP(11); ++rep_) { if (rep_) GRID_BAR();
        if (PH_ON(11) && IN(pb + 10)) { PH_BEGIN(); const float* mv = modv + (size_t)l * 9 * 6144; (void)mv; unsigned* const moecnt = ctl + CW_MOE + l * 16 * 64; (void)moecnt;
            unsigned pre[16]; { unsigned s = 0;
#pragma unroll
                for (int e = 0; e < 16; ++e) { pre[e] = s; s += ((__hip_atomic_load(moecnt + 64 * e, __ATOMIC_RELAXED, __HIP_MEMORY_SCOPE_AGENT) + 255u) >> 8) << 8; } }
            for (int as = gw; as < nrows2 * 2; as += NGW) { const int row = as >> 1, sl = as & 1; const float* rt = ROUTE + (size_t)row * 8;
                const int e = __builtin_bit_cast(int, rt[sl]), p = __builtin_bit_cast(int, rt[4 + sl]); unsigned base = 0;
#pragma unroll
                for (int k = 0; k < 16; ++k) base = (k == e) ? pre[k] : base;
                const size_t dst = (size_t)(base + (unsigned)p) * D;
#pragma unroll
                for (int j = 0; j < 2; ++j) *(v4u*)(XG + dst + 8 * lane + 512 * j) = *(const v4u*)(XN + (size_t)row * D + 8 * lane + 512 * j);
            }
        } }
        SEAM(pb + 10);

        for (int rep_ = 0; rep_ <= (int)PH_REP(12); ++rep_) { if (rep_) GRID_BAR();
        if (PH_ON(12) && IN(pb + 11)) { PH_BEGIN(); const float* mv = modv + (size_t)l * 9 * 6144; (void)mv; unsigned* const moecnt = ctl + CW_MOE + l * 16 * 64; (void)moecnt;
            SchedMoe S; S.G = X.G; S.c = X.bid; S.a0 = (const char*)XG; S.w0 = (const char*)WGU; S.astep = (size_t)256 * 1024 * 2; S.wstep_e = (size_t)1024 * 1024 * 2; S.wstep_n = (size_t)256 * 1024 * 2; S.init(moecnt);
            EpiMoe1 E{HID};
            pg8::gemm_phase<EpiMoe1, SchedMoe, true, true>(lds, Gemm{1024, 1024, 1024}, S, E);
        } }
        SEAM(pb + 11);

        for (int rep_ = 0; rep_ <= (int)PH_REP(13); ++rep_) { if (rep_) GRID_BAR();
        if (PH_ON(13) && IN(pb + 12)) { PH_BEGIN(); const float* mv = modv + (size_t)l * 9 * 6144; (void)mv; unsigned* const moecnt = ctl + CW_MOE + l * 16 * 64; (void)moecnt;
            SchedMoe S; S.G = X.G; S.c = X.bid; S.a0 = (const char*)HID; S.w0 = (const char*)WDN; S.astep = (size_t)256 * 512 * 2; S.wstep_e = (size_t)1024 * 512 * 2; S.wstep_n = (size_t)256 * 512 * 2; S.init(moecnt);
            EpiBf16<0> E{MO, 1024, nullptr};
            pg8::gemm_phase<EpiBf16<0>, SchedMoe, true, true>(lds, Gemm{512, 512, 512}, S, E);
        } }
        SEAM(pb + 12);

        for (int rep_ = 0; rep_ <= (int)PH_REP(14); ++rep_) { if (rep_) GRID_BAR();
        if (PH_ON(14) && IN(pb + 13)) { PH_BEGIN(); const float* mv = modv + (size_t)l * 9 * 6144; (void)mv; unsigned* const moecnt = ctl + CW_MOE + l * 16 * 64; (void)moecnt;
            unsigned pre[16]; { unsigned s = 0;
#pragma unroll
                for (int e = 0; e < 16; ++e) { pre[e] = s; s += ((__hip_atomic_load(moecnt + 64 * e, __ATOMIC_RELAXED, __HIP_MEMORY_SCOPE_AGENT) + 255u) >> 8) << 8; } }
            const float* g2 = INP(I_LN2G) + l * 1024, *b2 = INP(I_LN2B) + l * 1024;
            for (int row = gw; row < nrows2; row += NGW) {
                float* hrow = row < NLAT ? hlat + (size_t)row * D : hctx + (size_t)(row - NLAT) * D;
                const int mi = row < NLAT ? (row >> 11) : 8; const float* mrow = mv + mi * 6144;
                const float* rt = ROUTE + (size_t)row * 8;
                const int e0 = __builtin_bit_cast(int, rt[0]), e1 = __builtin_bit_cast(int, rt[1]), p0 = __builtin_bit_cast(int, rt[4]), p1 = __builtin_bit_cast(int, rt[5]); const float w0 = rt[2], w1 = rt[3];
                unsigned ba0 = 0, ba1 = 0;
#pragma unroll
                for (int k = 0; k < 16; ++k) { ba0 = (k == e0) ? pre[k] : ba0; ba1 = (k == e1) ? pre[k] : ba1; }
                const bf16* m0 = MO + (size_t)(ba0 + (unsigned)p0) * D, *m1 = MO + (size_t)(ba1 + (unsigned)p1) * D;
                f32x4 v[4];
#pragma unroll
                for (int j = 0; j < 4; ++j) { const int c = 4 * lane + 256 * j; const v2u a = *(const v2u*)(m0 + c), b = *(const v2u*)(m1 + c);
                    f32x4 mm; mm[0] = w0 * bflo(a.x) + w1 * bflo(b.x); mm[1] = w0 * bfhi(a.x) + w1 * bfhi(b.x); mm[2] = w0 * bflo(a.y) + w1 * bflo(b.y); mm[3] = w0 * bfhi(a.y) + w1 * bfhi(b.y);
                    v[j] = *(const f32x4*)(hrow + c) * DN_ALPHA + *(const f32x4*)(mrow + 5120 + c) * mm; }
                ln_rows(v);
#pragma unroll
                for (int j = 0; j < 4; ++j) { const int c = 4 * lane + 256 * j; *(f32x4*)(hrow + c) = v[j] * *(const f32x4*)(g2 + c) + *(const f32x4*)(b2 + c); }
            }
        } }
        SEAM(pb + 13);
    }
#undef IN
#undef SEAM
}

extern "C" void kernel_launch(void* const* d_in, const int* in_sizes, int n_in, void* d_out, int out_size, void* d_ws, size_t ws_size, hipStream_t stream) {
    static int grid = 0;
    if (grid == 0) {
        if (n_in != 34 || out_size != NLAT * D || ws_size < WS_END) { fprintf(stderr, "kernel_launch: unexpected problem (n_in %d out %d ws %zu)\n", n_in, out_size, ws_size); grid = -1; return; }
        int dev = 0, cus = 0, per_cu = 0;
        if (hipGetDevice(&dev) != hipSuccess || hipDeviceGetAttribute(&cus, hipDeviceAttributeMultiprocessorCount, dev) != hipSuccess) { grid = -1; return; }
        if (hipFuncSetAttribute((const void*)fwd, hipFuncAttributeMaxDynamicSharedMemorySize, LDS_BYTES) != hipSuccess) { fprintf(stderr, "kernel_launch: hipFuncSetAttribute failed\n"); grid = -1; return; }
        if (hipOccupancyMaxActiveBlocksPerMultiprocessor(&per_cu, (const void*)fwd, NWAVES * 64, LDS_BYTES) != hipSuccess || per_cu < 1) { fprintf(stderr, "kernel_launch: occupancy query reports %d\n", per_cu); }
        (void)hipGetLastError();
        grid = cus;
    }
    if (grid < 0) return;
    if (hipMemsetAsync((char*)d_ws + WS_CTL, 0, CTL_ZERO_BYTES, stream) != hipSuccess) return;
    Args a{};
    for (int i = 0; i < 34; ++i) a.in[i] = (const float*)d_in[i];
    a.out = (float*)d_out; a.ws = (unsigned char*)d_ws;
#if MK_ONE_LAUNCH
    a.ph_lo = 0; a.ph_hi = NPHASES;
    hipLaunchKernelGGL(fwd, dim3(grid), dim3(NWAVES * 64), LDS_BYTES, stream, a);
#else
    for (int p = 0; p < NPHASES; ++p) { a.ph_lo = p; a.ph_hi = p + 1; hipLaunchKernelGGL(fwd, dim3(grid), dim3(NWAVES * 64), LDS_BYTES, stream, a); }
#endif
}
```

```cpp
#include <hip/hip_runtime.h>
#include <cstdio>
#include <cstdint>

#define GAS __attribute__((address_space(1)))
#define LAS __attribute__((address_space(3)))
typedef unsigned short bf16;
typedef unsigned v4u __attribute__((ext_vector_type(4)));
typedef unsigned v2u __attribute__((ext_vector_type(2)));
typedef float f32x4 __attribute__((ext_vector_type(4)));
typedef float f32x2 __attribute__((ext_vector_type(2)));
typedef short bf16x8 __attribute__((ext_vector_type(8)));

constexpr int D = 1024, NB = 8, SEQ = 2048, CTXL = 256, NLAT = NB * SEQ, NCTX = NB * CTXL, NTOK = NLAT + NCTX;
constexpr int OFF_Q = 0, OFF_K = 512, OFF_V = 1024, OFF_Z = 1536, OFF_A = 2048, OFF_B = 2056, OFF_CONF = 2064, OFF_FFT = 3088, OFF_SGU = 3600, OFF_GATE = 4624, N_IN = 8720;
constexpr int NWROWS = 9216;
constexpr float LN_EPS = 1e-6f;
constexpr float DN_ALPHA = 1.4142135623730951f;
constexpr int NWAVES = 8;
constexpr int NPH_LAYER = 14, NPHASES = 1 + 2 * NPH_LAYER;

#ifndef PHMASK
#define PHMASK 0xFFFFFFFFu
#endif
#define PH_ON(k) (((PHMASK) >> (k)) & 1u)
#ifndef REPMASK
#define REPMASK 0u
#endif
#define PH_REP(k) (((REPMASK) >> (k)) & 1u)
#ifndef TPA
#define TPA -1
#endif
#ifndef TPB
#define TPB -1
#endif
#ifndef TOFF
#define TOFF 0
#endif
#define TPROBE ((TPA) >= 0 || (TPB) >= 0)
#ifndef CPART
#define CPART 15
#endif
#ifndef MK_ONE_LAUNCH
#define MK_ONE_LAUNCH 1
#endif

constexpr size_t MiB = 1u << 20;
constexpr size_t WS_CTL = 0, CTL_ZERO_BYTES = 128 * 1024;
constexpr size_t WS_MODV = 1 * MiB;
constexpr size_t WS_BIN = 1 * MiB + 512 * 1024;
constexpr size_t WS_ROUTE = WS_BIN + 64 * 1024;
constexpr size_t WS_HCTX = 3 * MiB;
constexpr size_t WS_XN = 11 * MiB;
constexpr size_t WS_WIN = 47 * MiB;
constexpr size_t WS_WBR = 65 * MiB;
constexpr size_t WS_WOUT = 69 * MiB;
constexpr size_t WS_DFTL = 71 * MiB;
constexpr size_t WS_DFTC = 87 * MiB;
constexpr size_t WS_F1B = 71 * MiB;
constexpr size_t WS_R2 = 88 * MiB;
constexpr size_t WS_PQKV = WS_R2;
constexpr size_t WS_PCONF = WS_R2 + 54 * MiB;
constexpr size_t WS_PZ = WS_R2 + 72 * MiB;
constexpr size_t WS_PSGU = WS_R2 + 90 * MiB;
constexpr size_t WS_PFFT = WS_R2 + 126 * MiB;
constexpr size_t WS_PFFTC = WS_R2 + 158 * MiB;
constexpr size_t WS_AB = WS_R2 + 162 * MiB;
constexpr size_t WS_WIT = WS_R2;
constexpr size_t WS_UIT = WS_R2 + 36 * MiB;
constexpr size_t WS_AIT = WS_R2 + 90 * MiB;
constexpr size_t WS_KIT = WS_R2 + 108 * MiB;
constexpr size_t WS_SIT = WS_R2 + 126 * MiB;
constexpr size_t WS_OF = WS_R2 + 128 * MiB;
constexpr size_t WS_OB = WS_R2 + 146 * MiB;
constexpr size_t WS_G = WS_R2;
constexpr size_t WS_WGU = WS_R2;
constexpr size_t WS_WDN = WS_R2 + 32 * MiB;
constexpr size_t WS_XG = WS_R2 + 48 * MiB;
constexpr size_t WS_R3 = WS_R2 + 164 * MiB;
constexpr size_t WS_QKV = WS_R3;
constexpr size_t WS_GB = WS_R3 + 54 * MiB;
constexpr size_t WS_BR = WS_R3 + 72 * MiB;
constexpr size_t WS_F1A = WS_BR;
constexpr size_t WS_MERGED = WS_R3;
constexpr size_t WS_Y = WS_R3 + 72 * MiB;
constexpr size_t WS_HID = WS_R3;
constexpr size_t WS_MO = WS_R3 + 40 * MiB;
constexpr size_t WS_LIST = WS_R3 + 144 * MiB;
constexpr size_t WS_END = WS_LIST + 2 * MiB;
static_assert(WS_END <= 405 * MiB, "workspace map");
constexpr int CW_BAR = 4096;
constexpr int CW_MOE = 16384;

constexpr int RING_BYTES = 131072;
constexpr int LDSCTL_OFF = RING_BYTES, MISC_OFF = LDSCTL_OFF + 320;
constexpr int LDS_BYTES = 147456;

#define LDS_WAIT() asm volatile("s_waitcnt lgkmcnt(0)" ::: "memory")
#define VM_WAIT() asm volatile("s_waitcnt vmcnt(0)" ::: "memory")
typedef __bf16 bf16x2_t __attribute__((ext_vector_type(2)));
__device__ __forceinline__ unsigned pk2(float lo, float hi) { const f32x2 v = {lo, hi}; const bf16x2_t b = __builtin_convertvector(v, bf16x2_t); return __builtin_bit_cast(unsigned, b); }
__device__ __forceinline__ unsigned f2bf(float f) { return pk2(f, 0.0f) & 0xffffu; }
__device__ __forceinline__ float bflo(unsigned w) { return __builtin_bit_cast(float, w << 16); }
__device__ __forceinline__ float bfhi(unsigned w) { return __builtin_bit_cast(float, w & 0xffff0000u); }
__device__ __forceinline__ float bf1(bf16 b) { return __builtin_bit_cast(float, ((unsigned)b) << 16); }
__device__ __forceinline__ void unpack8(const v4u w, float (&o)[8]) { o[0] = bflo(w.x); o[1] = bfhi(w.x); o[2] = bflo(w.y); o[3] = bfhi(w.y); o[4] = bflo(w.z); o[5] = bfhi(w.z); o[6] = bflo(w.w); o[7] = bfhi(w.w); }
__device__ __forceinline__ v4u pack8(const float (&o)[8]) { v4u w; w.x = pk2(o[0], o[1]); w.y = pk2(o[2], o[3]); w.z = pk2(o[4], o[5]); w.w = pk2(o[6], o[7]); return w; }
__device__ __forceinline__ void fsincospi(float x, float* sn, float* cs) { *sn = __builtin_amdgcn_sinf(0.5f * x); *cs = __builtin_amdgcn_cosf(0.5f * x); }
__device__ __forceinline__ float sigmoidf_(float x) { return __builtin_amdgcn_rcpf(1.0f + __expf(-x)); }
__device__ __forceinline__ float siluf_(float x) { return x * __builtin_amdgcn_rcpf(1.0f + __expf(-x)); }
__device__ __forceinline__ float gelu_tanh(float x) { const float u = 0.7978845608028654f * (x + 0.044715f * x * x * x); return x * __builtin_amdgcn_rcpf(1.0f + __expf(-2.0f * u)); }
__device__ __forceinline__ float wave_sum(float v) {
#pragma unroll
    for (int o = 1; o < 64; o <<= 1) v += __shfl_xor(v, o);
    return v;
}
__device__ __forceinline__ float reduce16(const float (&v)[16], int lane) {
    const bool b5 = (lane & 32) != 0, b4 = (lane & 16) != 0, b3 = (lane & 8) != 0, b2 = (lane & 4) != 0;
    float a[8], b[4], c[2];
#pragma unroll
    for (int i = 0; i < 8; ++i) a[i] = (b5 ? v[i + 8] : v[i]) + __shfl_xor(b5 ? v[i] : v[i + 8], 32);
#pragma unroll
    for (int i = 0; i < 4; ++i) b[i] = (b4 ? a[i + 4] : a[i]) + __shfl_xor(b4 ? a[i] : a[i + 4], 16);
#pragma unroll
    for (int i = 0; i < 2; ++i) c[i] = (b3 ? b[i + 2] : b[i]) + __shfl_xor(b3 ? b[i] : b[i + 2], 8);
    float d = (b2 ? c[1] : c[0]) + __shfl_xor(b2 ? c[0] : c[1], 4);
    d += __shfl_xor(d, 2); d += __shfl_xor(d, 1);
    return d;
}
__device__ __forceinline__ float reduce4(const float (&v)[4], int lane) {
    const bool b5 = (lane & 32) != 0, b4 = (lane & 16) != 0; float a[2];
#pragma unroll
    for (int i = 0; i < 2; ++i) a[i] = (b5 ? v[i + 2] : v[i]) + __shfl_xor(b5 ? v[i] : v[i + 2], 32);
    float d = (b4 ? a[1] : a[0]) + __shfl_xor(b4 ? a[0] : a[1], 16);
    d += __shfl_xor(d, 8); d += __shfl_xor(d, 4); d += __shfl_xor(d, 2); d += __shfl_xor(d, 1);
    return d;
}
__device__ __forceinline__ float g16_sum(float v) {
#pragma unroll
    for (int o = 1; o < 16; o <<= 1) v += __shfl_xor(v, o);
    return v;
}

namespace pg8 {
constexpr int BM = 256, BK = 64, HALF = 128, HTB = HALF * BK * 2, STAGE_BYTES = 8 * HTB;
__host__ __device__ __forceinline__ int lds_byte(int r, int c) { const int st = (r >> 4) * 2 + (c >> 5), rr = r & 15, cc = c & 31, ob = rr * 64 + cc * 2; return st * 1024 + (ob ^ (((ob >> 9) & 1) << 5)); }
__host__ __device__ __forceinline__ void stage_rc(int b, int& R, int& C) { const int st = b / 1024, sb = b % 1024, swz = sb ^ (((sb >> 9) & 1) << 5); R = (st >> 1) * 16 + swz / 64; C = (st & 1) * 32 + (swz % 64) / 2; }
__host__ __device__ __forceinline__ int perm32(int rho) { const int n = rho >> 4, i = rho & 15; return 8 * (i >> 2) + 4 * n + (i & 3); }

struct Unit { int pm, pn, aux, ax2; const char* a; const char* b; };
struct Gemm { int K, lda, ldb; };

__device__ __forceinline__ void map_tile(int L, int nM, int nN, int& pm, int& pn) {
    const int nwg = nM * nN; int wgid = L; { const int q = nwg / 8, r = nwg % 8, xcd = wgid % 8, off = wgid / 8; wgid = (xcd < r ? xcd * (q + 1) : r * (q + 1) + (xcd - r) * q) + off; }
    const int nig = 8 * nN, gid = wgid / nig, fm = gid * 8, gsz = (nM - fm) < 8 ? (nM - fm) : 8;
    pm = fm + ((wgid % nig) % gsz); pn = (wgid % nig) / gsz;
}
__device__ __forceinline__ unsigned cvt_pk_bf16(float lo, float hi) { unsigned r; asm volatile("v_cvt_pk_bf16_f32 %0, %1, %2" : "=v"(r) : "v"(lo), "v"(hi)); return r; }

template <class Epi, class Sched, bool ALIGN_EPI, bool SP2>
__device__ __forceinline__ void gemm_phase(LAS unsigned char* lds, const Gemm g, const Sched& S, const Epi& E) {
    int tid_l = threadIdx.x; asm volatile("" : "+v"(tid_l));
    const int tid = tid_l, wid = __builtin_amdgcn_readfirstlane(tid >> 6), lane = tid & 63, wr = wid >> 2, wc = wid & 3, fr = lane & 15, fq = lane >> 4;
    const int K = g.K, nt = K / BK;
    unsigned voffA[2], voffB[2];
#pragma unroll
    for (int i = 0; i < 2; ++i) { int R, C; stage_rc(tid * 16 + i * 8192, R, C); const int Rb = Epi::PERM ? ((R & ~31) + perm32(R & 31)) : R;
        voffA[i] = (unsigned)(R * g.lda + C) * 2u; voffB[i] = (unsigned)(Rb * g.ldb + C) * 2u; }
    static_assert(!Sched::GATHER || SP2, "gathered A rows: only the SP2 loop");
    unsigned vA[2][2], vAn[2][2];
#define PG8_GCALC(dst, u_) do { _Pragma("unroll") for (int i_ = 0; i_ < 2; ++i_) { int R_, C_; stage_rc(tid * 16 + i_ * 8192, R_, C_); _Pragma("unroll") for (int h_ = 0; h_ < 2; ++h_) dst[h_][i_] = S.arow(u_, R_ + 128 * h_) + (unsigned)C_ * 2u; } } while (0)
#define PG8_STAGE_A(bufoff, base, h, nextsel) do { if constexpr (Sched::GATHER) { unsigned vs_[2]; vs_[0] = (nextsel) ? vAn[h][0] : vA[h][0]; vs_[1] = (nextsel) ? vAn[h][1] : vA[h][1]; PG8_STAGE(bufoff, base, vs_); } \
        else { PG8_STAGE(bufoff, (base) + (h) * hstepA, voffA); } } while (0)
    const size_t kstep = (size_t)(BK * 2);
    const size_t hstepA = (size_t)HALF * g.lda * 2, hstepB = (size_t)HALF * g.ldb * 2;
    const unsigned ldsw = (unsigned)wid * 1024u;
    const int aoff = lds_byte(wr * 64 + fr, fq * 8), boff = lds_byte(wc * 32 + fr, fq * 8);
#define PG8_SA(b, h) (((b) * 2 + (h)) * HTB)
#define PG8_SB(b, h) ((4 + (b) * 2 + (h)) * HTB)
#define PG8_STAGE(bufoff, gbase, voff) do { _Pragma("unroll") for (int _i = 0; _i < 2; ++_i) \
        __builtin_amdgcn_global_load_lds((const unsigned*)((const char*)(gbase) + (voff)[_i]), (LAS unsigned*)(lds + (bufoff) + ldsw + _i * 8192), 16, 0, 0); } while (0)
#define PG8_LDA(dst, b, h) do { _Pragma("unroll") for (int m = 0; m < 4; ++m) _Pragma("unroll") for (int k = 0; k < 2; ++k) dst[m][k] = *(const LAS bf16x8*)(lds + PG8_SA(b, h) + aoff + m * 2048 + k * 1024); } while (0)
#define PG8_LDB(dst, b, h) do { _Pragma("unroll") for (int n = 0; n < 2; ++n) _Pragma("unroll") for (int k = 0; k < 2; ++k) dst[n][k] = *(const LAS bf16x8*)(lds + PG8_SB(b, h) + boff + n * 2048 + k * 1024); } while (0)
#define PG8_MMA(ai, bj, At, Bt) do { __builtin_amdgcn_s_setprio(1); _Pragma("unroll") for (int m = 0; m < 4; ++m) _Pragma("unroll") for (int n = 0; n < 2; ++n) _Pragma("unroll") for (int k = 0; k < 2; ++k) \
        acc[ai][bj][m][n] = __builtin_amdgcn_mfma_f32_16x16x32_bf16(Bt[n][k], At[m][k], acc[ai][bj][m][n], 0, 0, 0); __builtin_amdgcn_s_setprio(0); } while (0)
#define PG8_WAIT_V(n) asm volatile("s_waitcnt vmcnt(" #n ")" ::: "memory")
#define PG8_WAIT_L(n) asm volatile("s_waitcnt lgkmcnt(" #n ")" ::: "memory")
#define PG8_BAR __builtin_amdgcn_s_barrier()
#define PG8_SCHED __builtin_amdgcn_sched_barrier(0)
    Unit cur, nxt; int ui = 0;
    if (!S.next(0, cur)) return;
    f32x4 acc[2][2][4][2];
#pragma unroll
    for (int a = 0; a < 2; ++a)
#pragma unroll
        for (int b = 0; b < 2; ++b)
#pragma unroll
            for (int m = 0; m < 4; ++m)
#pragma unroll
                for (int n = 0; n < 2; ++n) acc[a][b][m][n] = (f32x4){0.f, 0.f, 0.f, 0.f};
    bf16x8 At[4][2], B0[2][2], B1[2][2];
    const char* cA = cur.a; const char* cB = cur.b;
    if constexpr (SP2) {
        if constexpr (Sched::GATHER) { PG8_GCALC(vA, cur); }
        PG8_STAGE(PG8_SB(0, 0), cB, voffB); PG8_STAGE(PG8_SB(0, 1), cB + hstepB, voffB); PG8_STAGE_A(PG8_SA(0, 0), cA, 0, false); PG8_STAGE_A(PG8_SA(0, 1), cA, 1, false);
        if (wr == 1) PG8_BAR;
        PG8_WAIT_V(2); PG8_BAR;
        PG8_STAGE(PG8_SB(1, 0), cB + kstep, voffB); PG8_STAGE_A(PG8_SA(1, 0), cA + kstep, 0, false); PG8_STAGE(PG8_SB(1, 1), cB + hstepB + kstep, voffB);
        PG8_WAIT_V(6); PG8_BAR;
    } else {
        PG8_STAGE(PG8_SB(0, 0), cB, voffB); PG8_STAGE(PG8_SA(0, 0), cA, voffA); PG8_STAGE(PG8_SB(0, 1), cB + hstepB, voffB); PG8_STAGE(PG8_SA(0, 1), cA + hstepA, voffA);
        if (wr == 1) PG8_BAR;
        PG8_WAIT_V(4); PG8_BAR;
        PG8_STAGE(PG8_SB(1, 0), cB + kstep, voffB); PG8_STAGE(PG8_SA(1, 0), cA + kstep, voffA); PG8_STAGE(PG8_SB(1, 1), cB + hstepB + kstep, voffB);
        PG8_WAIT_V(6); PG8_BAR;
    }
    for (;;) {
        const bool has_next = S.next(ui + 1, nxt);
        const char* nA = has_next ? nxt.a : cA; const char* nB = has_next ? nxt.b : cB;
        if constexpr (Sched::GATHER) { if (has_next) { PG8_GCALC(vAn, nxt); } else {
#pragma unroll
            for (int h_ = 0; h_ < 2; ++h_)
#pragma unroll
                for (int i_ = 0; i_ < 2; ++i_) vAn[h_][i_] = vA[h_][i_]; } }
        for (int t = 0; t < nt; t += 2) {
            const bool last = (t == nt - 2);
            const char* a1 = cA + (size_t)(t + 1) * kstep;
            const char* a2 = last ? nA : cA + (size_t)(t + 2) * kstep; const char* b2 = last ? nB : cB + (size_t)(t + 2) * kstep;
            const char* a3 = a2 + kstep; const char* b3 = b2 + kstep;
            if constexpr (SP2) {
            PG8_LDB(B0, 0, 0); PG8_LDB(B1, 0, 1); PG8_SCHED; PG8_LDA(At, 0, 0); PG8_STAGE_A(PG8_SA(1, 1), a1, 1, false);
            PG8_WAIT_V(8); PG8_WAIT_L(0); PG8_BAR; PG8_MMA(0, 0, At, B0); PG8_MMA(0, 1, At, B1); PG8_BAR; PG8_SCHED;
            PG8_LDA(At, 0, 1); PG8_STAGE(PG8_SB(0, 0), b2, voffB); PG8_STAGE(PG8_SB(0, 1), b2 + hstepB, voffB); PG8_STAGE_A(PG8_SA(0, 0), a2, 0, last);
            PG8_WAIT_V(8); PG8_WAIT_L(0); PG8_BAR; PG8_MMA(1, 0, At, B0); PG8_MMA(1, 1, At, B1); PG8_BAR; PG8_SCHED;
            PG8_LDB(B0, 1, 0); PG8_LDB(B1, 1, 1); PG8_SCHED; PG8_LDA(At, 1, 0); PG8_STAGE_A(PG8_SA(0, 1), a2, 1, last);
            PG8_WAIT_V(8); PG8_WAIT_L(0); PG8_BAR; PG8_MMA(0, 0, At, B0); PG8_MMA(0, 1, At, B1); PG8_BAR; PG8_SCHED;
            PG8_LDA(At, 1, 1); PG8_STAGE(PG8_SB(1, 0), b3, voffB); PG8_STAGE(PG8_SB(1, 1), b3 + hstepB, voffB); PG8_STAGE_A(PG8_SA(1, 0), a3, 0, last);
            PG8_WAIT_V(8); PG8_WAIT_L(0); PG8_BAR; PG8_MMA(1, 0, At, B0); PG8_MMA(1, 1, At, B1); PG8_BAR; PG8_SCHED;
            } else {
            PG8_LDB(B0, 0, 0); PG8_SCHED; PG8_LDA(At, 0, 0); PG8_STAGE(PG8_SA(1, 1), a1 + hstepA, voffA);
            PG8_WAIT_L(8); PG8_BAR; PG8_WAIT_L(0); PG8_MMA(0, 0, At, B0); PG8_BAR; PG8_SCHED;
            PG8_LDB(B1, 0, 1); PG8_STAGE(PG8_SB(0, 0), b2, voffB);
            PG8_BAR; PG8_WAIT_L(0); PG8_MMA(0, 1, At, B1); PG8_BAR;
            PG8_LDA(At, 0, 1); PG8_STAGE(PG8_SA(0, 0), a2, voffA);
            PG8_BAR; PG8_WAIT_L(0); PG8_MMA(1, 0, At, B0); PG8_BAR; PG8_SCHED;
            PG8_STAGE(PG8_SB(0, 1), b2 + hstepB, voffB);
            PG8_WAIT_V(6); PG8_BAR; PG8_MMA(1, 1, At, B1); PG8_BAR;
            PG8_LDB(B0, 1, 0); PG8_SCHED; PG8_LDA(At, 1, 0); PG8_STAGE(PG8_SA(0, 1), a2 + hstepA, voffA);
            PG8_WAIT_L(8); PG8_BAR; PG8_WAIT_L(0); PG8_MMA(0, 0, At, B0); PG8_BAR; PG8_SCHED;
            PG8_LDB(B1, 1, 1); PG8_STAGE(PG8_SB(1, 0), b3, voffB);
            PG8_BAR; PG8_WAIT_L(0); PG8_MMA(0, 1, At, B1); PG8_BAR;
            PG8_LDA(At, 1, 1); PG8_STAGE(PG8_SA(1, 0), a3, voffA);
            PG8_BAR; PG8_WAIT_L(0); PG8_MMA(1, 0, At, B0); PG8_BAR; PG8_SCHED;
            PG8_STAGE(PG8_SB(1, 1), b3 + hstepB, voffB);
            PG8_WAIT_V(6); PG8_BAR; PG8_MMA(1, 1, At, B1); PG8_BAR;
            }
        }
        if constexpr (ALIGN_EPI) { if (wr == 0) PG8_BAR; }
        E(acc, cur, wr, wc, fr, fq);
        if (!has_next) break;
#pragma unroll
        for (int a = 0; a < 2; ++a)
#pragma unroll
            for (int b = 0; b < 2; ++b)
#pragma unroll
                for (int m = 0; m < 4; ++m)
#pragma unroll
                    for (int n = 0; n < 2; ++n) acc[a][b][m][n] = (f32x4){0.f, 0.f, 0.f, 0.f};
        cur = nxt; cA = nA; cB = nB; ++ui;
        if constexpr (Sched::GATHER) {
#pragma unroll
            for (int h_ = 0; h_ < 2; ++h_)
#pragma unroll
                for (int i_ = 0; i_ < 2; ++i_) vA[h_][i_] = vAn[h_][i_]; }
        if constexpr (ALIGN_EPI) { if (wr == 1) PG8_BAR; }
    }
    PG8_WAIT_V(0);
    if constexpr (!ALIGN_EPI) { if (wr == 0) PG8_BAR; }
    PG8_BAR;
#undef PG8_SA
#undef PG8_SB
#undef PG8_STAGE
#undef PG8_STAGE_A
#undef PG8_GCALC
#undef PG8_LDA
#undef PG8_LDB
#undef PG8_MMA
#undef PG8_WAIT_V
#undef PG8_WAIT_L
#undef PG8_BAR
#undef PG8_SCHED
}
}
using pg8::Unit;
using pg8::Gemm;
typedef f32x4 AccT[2][2][4][2];

#define XB_TMO      128
#define XB_XCNT(j)  (256  + 64 * (j))
#define XB_XSUB(j)  (1280 + 64 * (j))
#define XB_XGEN(j)  (2304 + 64 * (j))
#define XB_TOP      3328
#define XB_TOPGEN   3392
#define XCD_BAR_WORDS 3456
#define XB_SPIN_CAP (1u << 18)
__device__ __forceinline__ unsigned xb_ld(unsigned* p)              { return __hip_atomic_load(p, __ATOMIC_RELAXED, __HIP_MEMORY_SCOPE_AGENT); }
__device__ __forceinline__ unsigned xb_add(unsigned* p, unsigned v) { return __hip_atomic_fetch_add(p, v, __ATOMIC_RELAXED, __HIP_MEMORY_SCOPE_AGENT); }
__device__ __forceinline__ unsigned xb_xcc_id() { return (unsigned)__builtin_amdgcn_s_getreg((3 << 11) | 20) & 0xFu; }
#define XB_SPIN(cond, bar) do { unsigned _sp = 0; while (cond) { __builtin_amdgcn_s_sleep(1); \
    if ((++_sp & 255u) == 0u) { if (xb_ld(&(bar)[XB_TMO])) break; if (_sp > XB_SPIN_CAP) { atomicAdd(&(bar)[XB_TMO], 1u); break; } } } } while (0)
struct XcdBarrier { unsigned* bar; unsigned x; volatile LAS unsigned* st; };
__device__ __forceinline__ XcdBarrier xcd_barrier_post(unsigned* bar, volatile LAS unsigned* st) {
    XcdBarrier b; b.bar = bar; b.x = xb_xcc_id(); b.st = st;
    if (threadIdx.x == 0) (void)xb_add(&bar[XB_XCNT(b.x)], 1u);
    return b;
}
__device__ __forceinline__ void xcd_barrier_complete(unsigned* bar, unsigned x, unsigned& nloc, unsigned& nx) {
    const unsigned G = gridDim.x * gridDim.y * gridDim.z;
    unsigned sum, cnt, mine, sp = 0u;
    for (;;) {
        sum = 0u; cnt = 0u; mine = 0u;
#pragma unroll
        for (unsigned j = 0; j < 16; ++j) { const unsigned c = xb_ld(&bar[XB_XCNT(j)]); sum += c; cnt += (c > 0u) ? 1u : 0u; mine = (j == x) ? c : mine; }
        if (sum == G) break;
        __builtin_amdgcn_s_sleep(1);
        if ((++sp & 255u) == 0u) { if (xb_ld(&bar[XB_TMO])) break; if (sp > XB_SPIN_CAP) { atomicAdd(&bar[XB_TMO], 1u); break; } }
    }
    nloc = mine > 0u ? mine : 1u; nx = cnt > 0u ? cnt : 1u;
}
__device__ __forceinline__ void xcd_barrier(const XcdBarrier& b) {
    asm volatile("s_waitcnt vmcnt(0)" ::: "memory");
    __syncthreads();
    if (threadIdx.x == 0) {
        unsigned* bar = b.bar;
        __builtin_amdgcn_s_waitcnt(0);
        unsigned nloc = b.st[0], nx = b.st[1];
        if (nloc == 0u) { xcd_barrier_complete(bar, b.x, nloc, nx); b.st[0] = nloc; b.st[1] = nx; }
        const unsigned old = xb_add(&bar[XB_XSUB(b.x)], 1u);
        const unsigned gen = old / nloc;
        if (old + 1u == (gen + 1u) * nloc) {
            __builtin_amdgcn_fence(__ATOMIC_RELEASE, "agent");
            asm volatile("s_waitcnt vmcnt(0)" ::: "memory");
            const unsigned og = xb_add(&bar[XB_TOP], 1u);
            const unsigned tg = og / nx;
            if (og + 1u == (tg + 1u) * nx) xb_add(&bar[XB_TOPGEN], 1u);
            else XB_SPIN(xb_ld(&bar[XB_TOPGEN]) == tg, bar);
            __builtin_amdgcn_fence(__ATOMIC_ACQUIRE, "agent");
            xb_add(&bar[XB_XGEN(b.x)], 1u);
            asm volatile("s_waitcnt vmcnt(0)" ::: "memory");
        } else {
            XB_SPIN(xb_ld(&bar[XB_XGEN(b.x)]) == gen, bar);
            __builtin_amdgcn_fence(__ATOMIC_ACQUIRE, "agent");
            asm volatile("s_waitcnt vmcnt(0)" ::: "memory");
        }
    }
    __syncthreads();
}

struct Args { const float* in[34]; float* out; unsigned char* ws; int ph_lo, ph_hi; };
enum { I_X = 0, I_C, I_CTX, I_CCTX, I_WMOD, I_BMOD, I_WIN, I_BIN, I_GCONV, I_GALOG, I_GDT, I_GNORM, I_CDWW, I_CDWB, I_CLNG, I_CLNB, I_SLNG, I_SLNB, I_SWS, I_SBS,
       I_WBR, I_WOUT, I_BOUT, I_LN1G, I_LN1B, I_LN2G, I_LN2B, I_RGW, I_RGB, I_REW, I_REB, I_EWG, I_EWU, I_EWD };

__device__ __forceinline__ int xcd_chunk(int L, int U) { const int q = U >> 3, r = U & 7, x = L & 7, off = L >> 3; return (x < r ? x * (q + 1) : r * (q + 1) + (x - r) * q) + off; }
struct SchedInA {
    static constexpr bool GATHER = false;
    int G, c; const char* xn; const char* w;
    __device__ __forceinline__ bool next(int i, Unit& u) const {
        const int L = i * G + c; const size_t tstep = (size_t)256 * 1024 * 2;
        if (L < 1152) { int pm, pn; pg8::map_tile(L, 72, 16, pm, pn); u.pm = pm; u.pn = pn; u.aux = 0; u.a = xn + (size_t)pm * tstep; u.b = w + (size_t)pn * tstep; return true; }
        if (L < 1440) { const int q = xcd_chunk(L - 1152, 288), pm = 16 + (q & 3), pn = q >> 2;        u.pm = pm; u.pn = pn; u.aux = 1; u.a = w + (size_t)pm * tstep; u.b = xn + (size_t)pn * tstep; return true; }
        return false;
    }
};
struct SchedGrid {
    static constexpr bool GATHER = false;
    int G, c, nM, nN; const char* a0; const char* b0; size_t astep, bstep;
    __device__ __forceinline__ bool next(int i, Unit& u) const {
        const int L = i * G + c; if (L >= nM * nN) return false;
        int pm, pn; pg8::map_tile(L, nM, nN, pm, pn); u.pm = pm; u.pn = pn; u.aux = 0; u.a = a0 + (size_t)pm * astep; u.b = b0 + (size_t)pn * bstep; return true;
    }
};
struct SchedFftLat {
    static constexpr bool GATHER = false;
    int G, c; const char* dft; const char* pf;
    __device__ __forceinline__ bool next(int i, Unit& u) const {
        const int L = i * G + c; if (L >= 128) return false;
        const int b = L >> 4, kt = (L >> 1) & 7, pn = L & 1;
        u.pm = b * 8 + kt; u.pn = pn; u.aux = 0; u.a = dft + (size_t)kt * (256 * 4096 * 2); u.b = pf + (size_t)b * (512 * 4096 * 2) + (size_t)pn * (256 * 4096 * 2); return true;
    }
};
struct SchedFftCtx {
    static constexpr bool GATHER = false;
    int G, c; const char* dft; const char* pf;
    __device__ __forceinline__ bool next(int i, Unit& u) const {
        const int L = i * G + (G - 1 - c); if (L >= 16) return false;
        const int b = L >> 1, pn = L & 1;
        u.pm = 64 + b; u.pn = pn; u.aux = 0; u.a = dft; u.b = pf + (size_t)b * (512 * 512 * 2) + (size_t)pn * (256 * 512 * 2); return true;
    }
};
struct SchedBranch {
    static constexpr bool GATHER = false;
    int G, c, nM; const char* br; const char* wbr;
    __device__ __forceinline__ bool next(int j, Unit& u) const {
        const int L = j * G + c; if (L >= nM * 16) return false;
        int pm, pn; pg8::map_tile(L, nM, 16, pm, pn);
        u.pm = pm; u.pn = pn; u.aux = 0; u.a = br + (size_t)(pn >> 2) * ((size_t)NTOK * 512 * 2) + (size_t)pm * (256 * 512 * 2); u.b = wbr + (size_t)pn * (256 * 512 * 2); return true;
    }
};
struct SchedMoe {
    static constexpr bool GATHER = false;
    int G, c; unsigned pre[17]; const char* a0; const char* w0; size_t astep, wstep_e, wstep_n;
    __device__ __forceinline__ void init(const unsigned* cnt  ) {
        unsigned s = 0;
#pragma unroll
        for (int e = 0; e < 16; ++e) { pre[e] = s; s += ((unsigned)__builtin_amdgcn_readfirstlane((int)__hip_atomic_load(cnt + 64 * e, __ATOMIC_RELAXED, __HIP_MEMORY_SCOPE_AGENT)) + 255u) >> 8; }
        pre[16] = s;
    }
    __device__ __forceinline__ bool next(int i, Unit& u) const {
        const int L = i * G + c; if (L >= (int)pre[16] * 4) return false;
        const int jt = L >> 2, pn = L & 3; int e = 0;
#pragma unroll
        for (int k = 1; k < 16; ++k) e += ((unsigned)jt >= pre[k]) ? 1 : 0;
        u.pm = jt; u.pn = pn; u.aux = e; u.a = a0 + (size_t)jt * astep; u.b = w0 + (size_t)e * wstep_e + (size_t)pn * wstep_n; return true;
    }
};

struct SchedMoeG {
    static constexpr bool GATHER = true;
    int G, c; const LAS unsigned* pre; const char* a0; const char* w0; size_t wstep_e, wstep_n; const int* list; const unsigned* cnt;
    __device__ __forceinline__ void init(const unsigned* cnt_  , LAS unsigned* pre_) { cnt = cnt_; pre = pre_;
        if (threadIdx.x == 0) { unsigned s = 0;
            for (int e = 0; e < 16; ++e) { pre_[e] = s; s += (__hip_atomic_load(cnt_ + 64 * e, __ATOMIC_RELAXED, __HIP_MEMORY_SCOPE_AGENT) + 255u) >> 8; }
            pre_[16] = s; }
        __syncthreads();
    }
    __device__ __forceinline__ bool next(int i, Unit& u) const {
        const int L = i * G + c; if (L >= (int)pre[16] * 4) return false;
        const int jt = L >> 2, pn = L & 3; int e = 0; unsigned pe = 0;
#pragma unroll
        for (int k = 1; k < 16; ++k) { const unsigned pk = pre[k]; const bool ge = (unsigned)jt >= pk; e += ge ? 1 : 0; pe = ge ? pk : pe; }
        e = __builtin_amdgcn_readfirstlane(e); pe = (unsigned)__builtin_amdgcn_readfirstlane((int)pe);
        u.pm = jt; u.pn = pn; u.aux = e; u.ax2 = (jt - (int)pe) * 256; u.a = a0; u.b = w0 + (size_t)e * wstep_e + (size_t)pn * wstep_n; return true;
    }
    __device__ __forceinline__ unsigned arow(const Unit& u, int r) const {
        const unsigned n = __hip_atomic_load(cnt + 64 * u.aux, __ATOMIC_RELAXED, __HIP_MEMORY_SCOPE_AGENT); const unsigned pos = (unsigned)(u.ax2 + r);
        const int tok = pos < n ? list[(size_t)u.aux * NTOK + pos] : 0; return (unsigned)tok * 2048u;
    }
};

struct EpiInA {
    static constexpr bool PERM = true;
    bf16 *pqkv, *pz, *pconf, *psgu, *pfft, *pfftc; const float* bias;
    __device__ __forceinline__ void operator()(const AccT& acc, const Unit& u, int wr, int wc, int fr, int fq) const {
        if (u.aux == 0) {
            const int row0 = u.pm * 256 + wr * 64 + fr, cb = wc * 32 + 8 * fq, bcol0 = u.pn * 256 + cb;
            f32x4 bv[2][2];
#pragma unroll
            for (int bj = 0; bj < 2; ++bj)
#pragma unroll
                for (int n = 0; n < 2; ++n) bv[bj][n] = *(const f32x4*)(bias + bcol0 + bj * 128 + 4 * n);
            if (u.pn < 8) {
                const bool isz = u.pn >= 6;
#pragma unroll
                for (int ai = 0; ai < 2; ++ai)
#pragma unroll
                    for (int m = 0; m < 4; ++m) { const int row = row0 + ai * 128 + m * 16;
                        bf16* rowp = isz ? (pz + (size_t)row * 512 + (u.pn - 6) * 256 + cb) : (pqkv + (size_t)row * 1536 + u.pn * 256 + cb);
#pragma unroll
                        for (int bj = 0; bj < 2; ++bj) { f32x4 v0 = acc[ai][bj][m][0] + bv[bj][0], v1 = acc[ai][bj][m][1] + bv[bj][1];
                            if (isz) {
#pragma unroll
                                for (int j = 0; j < 4; ++j) { v0[j] = siluf_(v0[j]); v1[j] = siluf_(v1[j]); } }
                            v4u w; w.x = pk2(v0[0], v0[1]); w.y = pk2(v0[2], v0[3]); w.z = pk2(v1[0], v1[1]); w.w = pk2(v1[2], v1[3]);
                            *(v4u*)(rowp + bj * 128) = w; } }
            } else if (u.pn < 12) {
#pragma unroll
                for (int ai = 0; ai < 2; ++ai)
#pragma unroll
                    for (int m = 0; m < 4; ++m) { const int row = row0 + ai * 128 + m * 16;
                        const f32x4 a0 = acc[ai][0][m][0] + bv[0][0], a1 = acc[ai][0][m][1] + bv[0][1], g0 = acc[ai][1][m][0] + bv[1][0], g1 = acc[ai][1][m][1] + bv[1][1];
                        float o[8];
#pragma unroll
                        for (int j = 0; j < 4; ++j) { o[j] = a0[j] * sigmoidf_(g0[j]); o[4 + j] = a1[j] * sigmoidf_(g1[j]); }
                        *(v4u*)(pconf + (size_t)row * 512 + (u.pn - 8) * 128 + cb) = pack8(o); }
            } else {
#pragma unroll
                for (int ai = 0; ai < 2; ++ai)
#pragma unroll
                    for (int m = 0; m < 4; ++m) { const int row = row0 + ai * 128 + m * 16;
                        bf16* rowp = psgu + (size_t)row * 1024 + (u.pn - 12) * 256 + cb;
#pragma unroll
                        for (int bj = 0; bj < 2; ++bj) { f32x4 v0 = acc[ai][bj][m][0] + bv[bj][0], v1 = acc[ai][bj][m][1] + bv[bj][1];
#pragma unroll
                            for (int j = 0; j < 4; ++j) { v0[j] = gelu_tanh(v0[j]); v1[j] = gelu_tanh(v1[j]); }
                            v4u w; w.x = pk2(v0[0], v0[1]); w.y = pk2(v0[2], v0[3]); w.z = pk2(v1[0], v1[1]); w.w = pk2(v1[2], v1[3]);
                            *(v4u*)(rowp + bj * 128) = w; } }
            }
        } else {
            const int jrow0 = (u.pm - 16) * 256 + wr * 64 + fr, tok0 = u.pn * 256 + wc * 32 + 8 * fq;
#pragma unroll
            for (int ai = 0; ai < 2; ++ai)
#pragma unroll
                for (int m = 0; m < 4; ++m) { const int jrow = jrow0 + ai * 128 + m * 16; const float bb = bias[4096 + jrow]; const int cs = jrow >> 9, rr = jrow & 511;
#pragma unroll
                    for (int bj = 0; bj < 2; ++bj) { const int tok = tok0 + bj * 128; bf16* dst;
                        if (tok < NLAT) { const int b = tok >> 11, t = tok & 2047; dst = pfft + ((size_t)(b * 512 + rr)) * 4096 + cs * 2048 + t; }
                        else { const int tc = tok - NLAT, b = tc >> 8, t = tc & 255; dst = pfftc + ((size_t)(b * 512 + rr)) * 512 + cs * 256 + t; }
                        const f32x4 v0 = acc[ai][bj][m][0] + bb, v1 = acc[ai][bj][m][1] + bb;
                        v4u w; w.x = pk2(v0[0], v0[1]); w.y = pk2(v0[2], v0[3]); w.z = pk2(v1[0], v1[1]); w.w = pk2(v1[2], v1[3]);
                        *(v4u*)dst = w; } }
        }
    }
};
template <int ACT  > struct EpiBf16 {
    static constexpr bool PERM = true;
    bf16* O; int ldc; const float* bias;
    __device__ __forceinline__ void operator()(const AccT& acc, const Unit& u, int wr, int wc, int fr, int fq) const {
        const int row0 = u.pm * 256 + wr * 64 + fr, col0 = u.pn * 256 + wc * 32 + 8 * fq;
        f32x4 bv[2][2];
#pragma unroll
        for (int bj = 0; bj < 2; ++bj)
#pragma unroll
            for (int n = 0; n < 2; ++n) bv[bj][n] = bias ? *(const f32x4*)(bias + col0 + bj * 128 + 4 * n) : (f32x4){0.f, 0.f, 0.f, 0.f};
#pragma unroll
        for (int ai = 0; ai < 2; ++ai)
#pragma unroll
            for (int m = 0; m < 4; ++m) { bf16* rowp = O + (size_t)(row0 + ai * 128 + m * 16) * ldc + col0;
#pragma unroll
                for (int bj = 0; bj < 2; ++bj) { f32x4 v0 = acc[ai][bj][m][0] + bv[bj][0], v1 = acc[ai][bj][m][1] + bv[bj][1];
                    if (ACT == 1) {
#pragma unroll
                        for (int j = 0; j < 4; ++j) { v0[j] = sigmoidf_(v0[j]); v1[j] = sigmoidf_(v1[j]); } }
                    v4u w; w.x = pk2(v0[0], v0[1]); w.y = pk2(v0[2], v0[3]); w.z = pk2(v1[0], v1[1]); w.w = pk2(v1[2], v1[3]);
                    *(v4u*)(rowp + bj * 128) = w; } }
    }
};
struct EpiF32 {
    static constexpr bool PERM = false;
    float* C; int ldc; const float* bias;
    __device__ __forceinline__ void operator()(const AccT& acc, const Unit& u, int wr, int wc, int fr, int fq) const {
        const int row0 = u.pm * 256 + wr * 64 + fr, col0 = u.pn * 256 + wc * 32 + 4 * fq;
        f32x4 bv[2][2];
#pragma unroll
        for (int bj = 0; bj < 2; ++bj)
#pragma unroll
            for (int n = 0; n < 2; ++n) bv[bj][n] = *(const f32x4*)(bias + col0 + bj * 128 + n * 16);
#pragma unroll
        for (int ai = 0; ai < 2; ++ai)
#pragma unroll
            for (int m = 0; m < 4; ++m) { float* rowp = C + (size_t)(row0 + ai * 128 + m * 16) * ldc + col0;
#pragma unroll
                for (int bj = 0; bj < 2; ++bj)
#pragma unroll
                    for (int n = 0; n < 2; ++n) *(f32x4*)(rowp + bj * 128 + n * 16) = acc[ai][bj][m][n] + bv[bj][n]; }
    }
};
struct EpiGateMerge {
    static constexpr bool PERM = true;
    const bf16* P; bf16* mbf; const float* bias;
    __device__ __forceinline__ void operator()(const AccT& acc, const Unit& u, int wr, int wc, int fr, int fq) const {
        const int row0 = u.pm * 256 + wr * 64 + fr, cb = wc * 32 + 8 * fq, d0 = u.pn * 64 + wc * 16 + 4 * fq;
        f32x4 bv[2][2];
#pragma unroll
        for (int bj = 0; bj < 2; ++bj)
#pragma unroll
            for (int n = 0; n < 2; ++n) bv[bj][n] = *(const f32x4*)(bias + u.pn * 256 + cb + bj * 128 + 4 * n);
#pragma unroll
        for (int ai = 0; ai < 2; ++ai)
#pragma unroll
            for (int m = 0; m < 4; ++m) { const size_t row = (size_t)(row0 + ai * 128 + m * 16); const bf16* pr = P + row * 4096 + d0;
                f32x4 o = (f32x4){0.f, 0.f, 0.f, 0.f};
#pragma unroll
                for (int bj = 0; bj < 2; ++bj)
#pragma unroll
                    for (int n = 0; n < 2; ++n) { const v2u pw = *(const v2u*)(pr + (2 * bj + n) * 1024); const f32x4 g = acc[ai][bj][m][n] + bv[bj][n];
                        o[0] += sigmoidf_(g[0]) * bflo(pw.x); o[1] += sigmoidf_(g[1]) * bfhi(pw.x); o[2] += sigmoidf_(g[2]) * bflo(pw.y); o[3] += sigmoidf_(g[3]) * bfhi(pw.y); }
                v2u w; w.x = pk2(o[0], o[1]); w.y = pk2(o[2], o[3]); *(v2u*)(mbf + row * 1024 + d0) = w; }
    }
};
struct EpiMoe1 {
    static constexpr bool PERM = true;
    bf16* hid;
    __device__ __forceinline__ void operator()(const AccT& acc, const Unit& u, int wr, int wc, int fr, int fq) const {
        const int row0 = u.pm * 256 + wr * 64 + fr, cb = wc * 32 + 8 * fq;
#pragma unroll
        for (int ai = 0; ai < 2; ++ai)
#pragma unroll
            for (int m = 0; m < 4; ++m) { const int row = row0 + ai * 128 + m * 16;
                const f32x4 g0 = acc[ai][0][m][0], g1 = acc[ai][0][m][1], u0 = acc[ai][1][m][0], u1 = acc[ai][1][m][1];
                float o[8];
#pragma unroll
                for (int j = 0; j < 4; ++j) { o[j] = siluf_(g0[j]) * u0[j]; o[4 + j] = siluf_(g1[j]) * u1[j]; }
                *(v4u*)(hid + (size_t)row * 512 + u.pn * 128 + cb) = pack8(o); }
    }
};

struct Ctx {
    LAS unsigned char* lds; int tid, lane, wave, G, bid;
};

__device__ __forceinline__ int gate_srccol(int r) { const int q = r - 5120, t = q >> 8, c = q & 255, bj = c >> 7, wc = (c >> 5) & 3, fq = (c >> 3) & 3, n = (c >> 2) & 1, j = c & 3;
    return OFF_GATE + (2 * bj + n) * 1024 + 64 * t + 16 * wc + 4 * fq + j; }
__device__ __forceinline__ void cvt_tile(const Ctx& X, const float* src, int ld, int k0, bf16* dst, int Kp) {
    LAS float* tile = (LAS float*)X.lds;
#pragma unroll
    for (int i = 0; i < 8; ++i) { const int kk = (X.tid >> 6) + 8 * i, nn = X.tid & 63; tile[kk * 65 + nn] = src[(size_t)(k0 + kk) * ld + nn]; }
    __syncthreads();
    { const int n = X.tid >> 3, kc = X.tid & 7; float o[8];
#pragma unroll
      for (int j = 0; j < 8; ++j) o[j] = tile[(8 * kc + j) * 65 + n];
      *(v4u*)(dst + (size_t)n * Kp + k0 + 8 * kc) = pack8(o); }
    __syncthreads();
}

__device__ __forceinline__ void cvt_item(const float* src, int ld, int srccol, int k0, bf16* dst, int Kp, LAS float* scr, int lane) {
    float tv[32];
#pragma unroll
    for (int i = 0; i < 32; ++i) { const int kk = 2 * i + (lane >> 5); tv[i] = src[(size_t)(k0 + kk) * ld + srccol]; }
#pragma unroll
    for (int i = 0; i < 32; ++i) { const int kk = 2 * i + (lane >> 5); scr[kk * 33 + (lane & 31)] = tv[i]; }
    LDS_WAIT(); asm volatile("" ::: "memory");
    const int c = lane & 7;
#pragma unroll
    for (int j = 0; j < 4; ++j) { const int n = (lane >> 3) + 8 * j; const LAS float* sp = scr + (8 * c) * 33 + n; float o[8];
#pragma unroll
        for (int e = 0; e < 8; ++e) o[e] = sp[e * 33];
        *(v4u*)(dst + (size_t)n * Kp + k0 + 8 * c) = pack8(o); }
    LDS_WAIT(); asm volatile("" ::: "memory");
}

__device__ __forceinline__ void cvt_item4(const float* src, int ld, int col4, int k0, bf16* dst, int Kp, LAS float* scr, int lane) {
    f32x4 v[8]; const int kq = lane >> 3, n4 = 4 * (lane & 7);
#pragma unroll
    for (int i = 0; i < 8; ++i) v[i] = *(const f32x4*)(src + (size_t)(k0 + kq + 8 * i) * ld + col4);
#pragma unroll
    for (int i = 0; i < 8; ++i) { LAS float* p = scr + (kq + 8 * i) * 33 + n4; p[0] = v[i][0]; p[1] = v[i][1]; p[2] = v[i][2]; p[3] = v[i][3]; }
    LDS_WAIT(); asm volatile("" ::: "memory");
    const int c = lane & 7;
#pragma unroll
    for (int j = 0; j < 4; ++j) { const int n = (lane >> 3) + 8 * j; const LAS float* sp = scr + (8 * c) * 33 + n; float o[8];
#pragma unroll
        for (int e = 0; e < 8; ++e) o[e] = sp[e * 33];
        *(v4u*)(dst + (size_t)n * Kp + k0 + 8 * c) = pack8(o); }
    LDS_WAIT(); asm volatile("" ::: "memory");
}

__device__ __forceinline__ void ln_rows(f32x4 (&v)[4]) {
    float s = 0.f;
#pragma unroll
    for (int j = 0; j < 4; ++j) s += (v[j][0] + v[j][1]) + (v[j][2] + v[j][3]);
    const float mean = wave_sum(s) * (1.f / D); float s2 = 0.f;
#pragma unroll
    for (int j = 0; j < 4; ++j) { v[j] = v[j] - mean; s2 += (v[j][0] * v[j][0] + v[j][1] * v[j][1]) + (v[j][2] * v[j][2] + v[j][3] * v[j][3]); }
    const float rstd = __builtin_amdgcn_rsqf(wave_sum(s2) * (1.f / D) + LN_EPS);
#pragma unroll
    for (int j = 0; j < 4; ++j) v[j] = v[j] * rstd;
}

#define PH_BEGIN() \
    int tid_l = threadIdx.x; asm volatile("" : "+v"(tid_l)); const int tid = tid_l, lane = tid & 63; \
    Ctx X; X.lds = lds; X.tid = tid; X.lane = lane; X.wave = __builtin_amdgcn_readfirstlane(tid >> 6); X.G = gridDim.x; X.bid = blockIdx.x; \
    const int gw = X.bid * NWAVES + X.wave, NGW = X.G * NWAVES; (void)gw; (void)NGW; \
    const __attribute__((address_space(4))) char* kp = (const __attribute__((address_space(4))) char*)__builtin_amdgcn_kernarg_segment_ptr(); asm volatile("" : "+s"(kp)); \
    unsigned char* const ws = *(unsigned char* const __attribute__((address_space(4)))*)(kp + 280); \
    float* const hlat = *(float* const __attribute__((address_space(4)))*)(kp + 272); (void)hlat; \
    float* const hctx = (float*)(ws + WS_HCTX); (void)hctx; \
    float* const modv = (float*)(ws + WS_MODV); (void)modv; \
    float* const binv = (float*)(ws + WS_BIN); (void)binv; \
    bf16* const XN = (bf16*)(ws + WS_XN); (void)XN; \
    bf16* const WIN = (bf16*)(ws + WS_WIN); (void)WIN; \
    bf16* const WBR = (bf16*)(ws + WS_WBR); (void)WBR; \
    bf16* const WOUT = (bf16*)(ws + WS_WOUT); (void)WOUT; \
    bf16* const F1A = (bf16*)(ws + WS_F1A); (void)F1A; bf16* const F1B = (bf16*)(ws + WS_F1B); (void)F1B; \
    bf16* const DFTC = (bf16*)(ws + WS_DFTC); (void)DFTC; \
    bf16* const PQKV = (bf16*)(ws + WS_PQKV); (void)PQKV; \
    bf16* const PCONF = (bf16*)(ws + WS_PCONF); (void)PCONF; \
    bf16* const PZ = (bf16*)(ws + WS_PZ); (void)PZ; \
    bf16* const PSGU = (bf16*)(ws + WS_PSGU); (void)PSGU; \
    bf16* const PFFT = (bf16*)(ws + WS_PFFT); (void)PFFT; \
    bf16* const PFFTC = (bf16*)(ws + WS_PFFTC); (void)PFFTC; \
    float* const AB = (float*)(ws + WS_AB); (void)AB; \
    bf16* const OF = (bf16*)(ws + WS_OF); (void)OF; \
    bf16* const OB = (bf16*)(ws + WS_OB); (void)OB; \
    bf16* const WIT = (bf16*)(ws + WS_WIT); (void)WIT; \
    bf16* const UIT = (bf16*)(ws + WS_UIT); (void)UIT; \
    bf16* const AIT = (bf16*)(ws + WS_AIT); (void)AIT; \
    bf16* const KIT = (bf16*)(ws + WS_KIT); (void)KIT; \
    float* const SIT = (float*)(ws + WS_SIT); (void)SIT; \
    bf16* const GT = (bf16*)(ws + WS_G); (void)GT; \
    bf16* const WGU = (bf16*)(ws + WS_WGU); (void)WGU; \
    bf16* const WDN = (bf16*)(ws + WS_WDN); (void)WDN; \
    bf16* const XG = (bf16*)(ws + WS_XG); (void)XG; \
    bf16* const QKV = (bf16*)(ws + WS_QKV); (void)QKV; \
    float* const GB = (float*)(ws + WS_GB); (void)GB; \
    bf16* const BR = (bf16*)(ws + WS_BR); (void)BR; \
    float* const MERGED = (float*)(ws + WS_MERGED); (void)MERGED; \
    float* const YB = (float*)(ws + WS_Y); (void)YB; \
    bf16* const HID = (bf16*)(ws + WS_HID); (void)HID; \
    bf16* const MO = (bf16*)(ws + WS_MO); (void)MO; \
    float* const ROUTE = (float*)(ws + WS_ROUTE); (void)ROUTE; int* const ELIST = (int*)(ws + WS_LIST); (void)ELIST; \
    unsigned* const ctl = (unsigned*)(ws + WS_CTL); (void)ctl;
#define INP(i) (*(const float* const __attribute__((address_space(4)))*)(kp + 8 * (i)))
__global__ void __launch_bounds__(NWAVES * 64, 2) fwd(Args args) {
    extern __shared__ __attribute__((aligned(16))) unsigned char lds_raw[];
    LAS unsigned char* const lds = (LAS unsigned char*)lds_raw;
    volatile LAS unsigned* MISC = (volatile LAS unsigned*)(lds + MISC_OFF);
    for (int u = threadIdx.x; u < (LDS_BYTES - LDSCTL_OFF) / 4; u += NWAVES * 64) ((LAS unsigned*)(lds + LDSCTL_OFF))[u] = 0u;
    __syncthreads();
#if MK_ONE_LAUNCH
    XcdBarrier bar = xcd_barrier_post((unsigned*)(args.ws + WS_CTL) + CW_BAR, MISC + 8);
#define GRID_BAR() xcd_barrier(bar)
#else
#define GRID_BAR() do { } while (0)
#endif
    const int lo = args.ph_lo, hi = args.ph_hi;
#define IN(k) (lo <= (k) && (k) < hi)
#define CW_TS 20000
#if TPROBE
#define STAMP(k) do { if (blockIdx.x == 0 && threadIdx.x == 0) __hip_atomic_store((unsigned*)(args.ws + WS_CTL) + CW_TS + (k), (unsigned)__builtin_amdgcn_s_memrealtime(), __ATOMIC_RELAXED, __HIP_MEMORY_SCOPE_AGENT); } while (0)
#else
#define STAMP(k) do { } while (0)
#endif
#define SEAM(k) do { if (IN(k) && IN((k) + 1)) GRID_BAR(); STAMP((k) + 1); } while (0)
    STAMP(0);

    for (int rep0_ = 0; rep0_ <= (int)PH_REP(0); ++rep0_) { if (rep0_) GRID_BAR();
    if (PH_ON(0) && IN(0)) { PH_BEGIN();
        for (int idx = X.bid * 512 + tid; idx < 256 * 512 / 8; idx += X.G * 512) {
            const int k = idx >> 6, j0 = (idx & 63) * 8; float o[8];
#pragma unroll
            for (int e = 0; e < 8; ++e) { const int j = j0 + e, t = j & 255, a = (k * t) & 255; float s, c; fsincospi((float)a * (1.0f / 128.0f), &s, &c);
                o[e] = (j < 256 ? c : -s) * 0.0625f; }
            *(v4u*)(DFTC + (size_t)k * 512 + j0) = pack8(o);
        }
        {
            LAS float* sc = (LAS float*)lds;
            LAS float* red = (LAS float*)(lds + 36864);
            for (int i = tid; i < 9 * 1024; i += 512) { const int r = i >> 10, k = i & 1023; const float c = r < 8 ? INP(I_C)[r * 1024 + k] : INP(I_CCTX)[k]; sc[i] = siluf_(c); }
            __syncthreads();
            for (int it = X.bid; it < 192; it += X.G) {
                const int l = it / 96, j = (it % 96) * 64 + lane; const float* W = INP(I_WMOD) + (size_t)l * 1024 * 6144 + j;
                float a[9];
#pragma unroll
                for (int r = 0; r < 9; ++r) a[r] = 0.f;
                const int kb = X.wave * 128;
                float wv[2][32];
#pragma unroll
                for (int i = 0; i < 32; ++i) wv[0][i] = W[(size_t)(kb + i) * 6144];
#pragma unroll
                for (int b = 0; b < 4; ++b) {
                    if (b < 3) {
#pragma unroll
                        for (int i = 0; i < 32; ++i) wv[(b + 1) & 1][i] = W[(size_t)(kb + 32 * (b + 1) + i) * 6144]; }
#pragma unroll
                    for (int i = 0; i < 32; i += 4) {
#pragma unroll
                        for (int r = 0; r < 9; ++r) { const f32x4 sv = *(const LAS f32x4*)(sc + r * 1024 + kb + 32 * b + i);
                            a[r] += (sv[0] * wv[b & 1][i] + sv[1] * wv[b & 1][i + 1]) + (sv[2] * wv[b & 1][i + 2] + sv[3] * wv[b & 1][i + 3]); } }
                }
#pragma unroll
                for (int r = 0; r < 9; ++r) red[(X.wave * 9 + r) * 64 + lane] = a[r];
                __syncthreads();
                for (int o = tid; o < 9 * 64; o += 512) { const int r = o >> 6, jj = o & 63; float s = 0.f;
#pragma unroll
                    for (int w = 0; w < 8; ++w) s += red[(w * 9 + r) * 64 + jj];
                    const int jc = (it % 96) * 64 + jj; modv[((size_t)l * 9 + r) * 6144 + jc] = s + INP(I_BMOD)[l * 6144 + jc]; }
                __syncthreads();
            }
        }
    } }
    SEAM(0);

    for (int l = 0; l < 2; ++l) {
        const int pb = 1 + NPH_LAYER * l;
        const int nrows2 = (l == 1) ? NLAT : NTOK;
        const int npan2 = nrows2 / 256;

        for (int rep_ = 0; rep_ <= (int)PH_REP(1); ++rep_) { if (rep_) GRID_BAR();
        if (PH_ON(1) && IN(pb + 0)) { PH_BEGIN(); const float* mv = modv + (size_t)l * 9 * 6144; (void)mv; unsigned* const moecnt = ctl + CW_MOE + l * 16 * 64; (void)moecnt;
            const float* win = INP(I_WIN) + (size_t)l * 1024 * N_IN;
            const float* bin = INP(I_BIN) + (size_t)l * N_IN;
#define FOLD_LOAD(it_) do { const int kb_ = (it_) >> 2, g_ = (it_) & 3; _Pragma("unroll") for (int j = 0; j < 4; ++j) { const int i = tid + 512 * j, kk = i >> 7, c = i & 127; wpre[j] = win[(size_t)(kb_ * 16 + kk) * N_IN + OFF_FFT + g_ * 128 + c]; } } while (0)
            float wpre[4]; FOLD_LOAD(X.bid < 256 ? X.bid : 255);
            LAS float* const wscr = (LAS float*)(lds + X.wave * 8448);
            for (int it = gw; it < 4096 + 1024 + 512 + 144; it += NGW) {
                if (it >= 5632) { const int r = (it - 5632) * 64 + lane;
                    if (r < 4096 || r >= 5120) { float v;
                        if (r < 2048) v = bin[r];
                        else if (r < 3072) { const int q = r - 2048, j = q >> 8, w = q & 255; v = bin[OFF_CONF + (w >= 128 ? 512 : 0) + 128 * j + (w & 127)]; }
                        else if (r < 4096) v = bin[OFF_SGU + (r - 3072)];
                        else v = bin[gate_srccol(r)];
                        binv[r] = v; }
                    continue; }
                const float* src; int ld, col, k0, Kp; bf16* dst; const int n4 = lane & 31;
                if (it < 4096) { const int rb_ = (it & 3) + 4 * ((it >> 3) & 63), rb = rb_ < 128 ? rb_ : rb_ + 32, row0 = rb * 32;
                    if (row0 < 2048) col = row0 + n4;
                    else if (row0 < 3072) { const int q = row0 - 2048, j = q >> 8, w = q & 255; col = OFF_CONF + (w >= 128 ? 512 : 0) + 128 * j + (w & 127) + n4; }
                    else if (row0 < 4096) col = OFF_SGU + (row0 - 3072) + n4;
                    else col = gate_srccol(row0 + n4);
                    src = win; ld = N_IN; k0 = (((it >> 2) & 1) + 2 * (it >> 9)) * 64; dst = WIN + (size_t)row0 * 1024; Kp = 1024; }
                else if (it < 5120) { const int q = it - 4096, i = q >> 8, nb = (q & 3) + 4 * ((q >> 3) & 7);
                    src = INP(I_WBR) + ((size_t)(l * 4 + i) * 512) * 1024; ld = 1024; col = nb * 32 + n4; k0 = (((q >> 2) & 1) + 2 * ((q >> 6) & 3)) * 64; dst = WBR + ((size_t)i * 1024 + nb * 32) * 512; Kp = 512; }
                else { const int q = it - 5120, nb = (q & 3) + 4 * ((q >> 3) & 7);
                    src = INP(I_WOUT) + (size_t)l * 1024 * 1024; ld = 1024; col = nb * 32 + n4; k0 = (((q >> 2) & 1) + 2 * (q >> 6)) * 64; dst = WOUT + (size_t)nb * 32 * 1024; Kp = 1024; }
                cvt_item(src, ld, col, k0, dst, Kp, wscr, lane);
            }
            LAS float* wab = (LAS float*)lds;
            f32x4 wq[8]; bool wq_have = false;
#pragma unroll
            for (int j = 0; j < 8; ++j) wq[j] = (f32x4){0.f, 0.f, 0.f, 0.f};
#define WAB_LOAD() do { _Pragma("unroll") for (int j = 0; j < 8; ++j) wq[j] = *(const f32x4*)(win + (size_t)(tid + 512 * (j & 1)) * N_IN + OFF_A + 4 * (j >> 1)); } while (0)
            for (int it = X.bid; it < 256; it += X.G) {
                const int kb = it >> 2, g = it & 3; LAS float* Wt = (LAS float*)(lds + 69632); LAS f32x2* cst = (LAS f32x2*)(lds + 69632 + 10240); LAS float* bl = (LAS float*)(cst + 128);
                if (it != X.bid) FOLD_LOAD(it);
#pragma unroll
                for (int j = 0; j < 4; ++j) { const int i = tid + 512 * j, kk = i >> 7, c = i & 127; Wt[c * 20 + kk] = wpre[j]; }
                if (tid < 128) { float sn, cn; fsincospi((float)tid * (1.0f / 64.0f), &sn, &cn); cst[tid] = (f32x2){cn * 0.08838834764831845f, sn * 0.08838834764831845f}; }
                else if (tid < 256 && kb == 0) bl[tid - 128] = bin[OFF_FFT + g * 128 + (tid - 128)];
                __syncthreads();
                if (!wq_have) { WAB_LOAD(); wq_have = true; }
                const int m = tid & 127, ks = tid >> 7; f32x2 acc[4];
#pragma unroll
                for (int kk = 0; kk < 4; ++kk) acc[kk] = (f32x2){0.f, 0.f};
                { int a = 0;
#pragma unroll 8
                for (int c = 0; c < 128; ++c) { const f32x2 t = cst[a]; const f32x4 w = *(const LAS f32x4*)(Wt + c * 20 + ks * 4);
#pragma unroll
                    for (int kk = 0; kk < 4; ++kk) acc[kk] += t * w[kk];
                    a = (a + m) & 127; } }
                bf16* dc = WIN + (size_t)(4096 + g * 128 + m) * 1024 + kb * 16 + ks * 4; bf16* dsn = dc + (size_t)512 * 1024;
                { v2u o; o.x = pk2(acc[0][0], acc[1][0]); o.y = pk2(acc[2][0], acc[3][0]); *(v2u*)dc = o; o.x = pk2(acc[0][1], acc[1][1]); o.y = pk2(acc[2][1], acc[3][1]); *(v2u*)dsn = o; }
                if (kb == 0 && tid < 256) {
                    const int cs = tid >> 7; float sb = 0.f; int a = 0;
#pragma unroll 8
                    for (int c = 0; c < 128; ++c) { const f32x2 t = cst[a]; sb += bl[c] * (cs ? t[1] : t[0]); a = (a + m) & 127; }
                    binv[4096 + cs * 512 + g * 128 + m] = sb; }
                if (it + X.G < 256) __syncthreads();
            }
            if (!wq_have) { __syncthreads(); WAB_LOAD(); }
#pragma unroll
            for (int j = 0; j < 8; ++j) { LAS float* p = wab + (4 * (j >> 1)) * 1024 + tid + 512 * (j & 1); p[0] = wq[j][0]; p[1024] = wq[j][1]; p[2048] = wq[j][2]; p[3072] = wq[j][3]; }
            __syncthreads();
#undef FOLD_LOAD
#undef WAB_LOAD
            f32x4 pe[4]; int pe_t = -1;
#pragma unroll
            for (int j = 0; j < 4; ++j) pe[j] = (f32x4){0.f, 0.f, 0.f, 0.f};
            for (int rowb = gw; rowb < NTOK; rowb += 2 * NGW) {
                f32x4 va[4], vb2[4];
                { const int row_ = rowb + 0, row = row_ < NTOK ? row_ : NTOK - 1; const bool LIVE_ = row_ < NTOK;
                float* hrow = row < NLAT ? hlat + (size_t)row * D : hctx + (size_t)(row - NLAT) * D;
                const int mi = row < NLAT ? (row >> 11) : 8; const float* shift = mv + mi * 6144, *scale = shift + 1024;

                if (l == 0) {
                    const float* src = row < NLAT ? INP(I_X) + (size_t)row * D : INP(I_CTX) + (size_t)(row - NLAT) * D;
#pragma unroll
                    for (int j = 0; j < 4; ++j) va[j] = *(const f32x4*)(src + 4 * lane + 256 * j);
                    if (row < NLAT) { const int t = row & 2047;
                        if (t != pe_t) { pe_t = t; const int prow = t >> 6, pcol = t & 63;
#pragma unroll 1
                            for (int j = 0; j < 4; ++j)
#pragma unroll
                                for (int e = 0; e < 4; ++e) { const int col = 4 * lane + 256 * j + e, part = col >> 9, within = col & 511, i = within & 255;
                                    const float omega = __builtin_amdgcn_exp2f((float)i * (-13.287712379549449f / 256.0f)); const float rev = (float)(part ? pcol : prow) * omega * 0.15915494309189535f;
                                    const float pv = (within >> 8) ? __builtin_amdgcn_cosf(rev) : __builtin_amdgcn_sinf(rev);
                                    if (j == 0) pe[0][e] = pv; else if (j == 1) pe[1][e] = pv; else if (j == 2) pe[2][e] = pv; else pe[3][e] = pv; } }
#pragma unroll
                        for (int j = 0; j < 4; ++j) va[j] += pe[j]; }
#pragma unroll
                    for (int j = 0; j < 4; ++j) if (LIVE_) *(f32x4*)(hrow + 4 * lane + 256 * j) = va[j];
                } else {
#pragma unroll
                    for (int j = 0; j < 4; ++j) va[j] = *(const f32x4*)(hrow + 4 * lane + 256 * j);
                }
                ln_rows(va);
#pragma unroll
                for (int j = 0; j < 4; ++j) { const f32x4 sc = *(const f32x4*)(scale + 4 * lane + 256 * j), sh = *(const f32x4*)(shift + 4 * lane + 256 * j); va[j] = va[j] * (sc + 1.0f) + sh;
                    v2u w; w.x = pk2(va[j][0], va[j][1]); w.y = pk2(va[j][2], va[j][3]); if (LIVE_) *(v2u*)(XN + (size_t)row * D + 4 * lane + 256 * j) = w; }
                }
                { const int row_ = rowb + NGW, row = row_ < NTOK ? row_ : NTOK - 1; const bool LIVE_ = row_ < NTOK;
                float* hrow = row < NLAT ? hlat + (size_t)row * D : hctx + (size_t)(row - NLAT) * D;
                const int mi = row < NLAT ? (row >> 11) : 8; const float* shift = mv + mi * 6144, *scale = shift + 1024;

                if (l == 0) {
                    const float* src = row < NLAT ? INP(I_X) + (size_t)row * D : INP(I_CTX) + (size_t)(row - NLAT) * D;
#pragma unroll
                    for (int j = 0; j < 4; ++j) vb2[j] = *(const f32x4*)(src + 4 * lane + 256 * j);
                    if (row < NLAT) { const int t = row & 2047;
                        if (t != pe_t) { pe_t = t; const int prow = t >> 6, pcol = t & 63;
#pragma unroll 1
                            for (int j = 0; j < 4; ++j)
#pragma unroll
                                for (int e = 0; e < 4; ++e) { const int col = 4 * lane + 256 * j + e, part = col >> 9, within = col & 511, i = within & 255;
                                    const float omega = __builtin_amdgcn_exp2f((float)i * (-13.287712379549449f / 256.0f)); const float rev = (float)(part ? pcol : prow) * omega * 0.15915494309189535f;
                                    const float pv = (within >> 8) ? __builtin_amdgcn_cosf(rev) : __builtin_amdgcn_sinf(rev);
                                    if (j == 0) pe[0][e] = pv; else if (j == 1) pe[1][e] = pv; else if (j == 2) pe[2][e] = pv; else pe[3][e] = pv; } }
#pragma unroll
                        for (int j = 0; j < 4; ++j) vb2[j] += pe[j]; }
#pragma unroll
                    for (int j = 0; j < 4; ++j) if (LIVE_) *(f32x4*)(hrow + 4 * lane + 256 * j) = vb2[j];
                } else {
#pragma unroll
                    for (int j = 0; j < 4; ++j) vb2[j] = *(const f32x4*)(hrow + 4 * lane + 256 * j);
                }
                ln_rows(vb2);
#pragma unroll
                for (int j = 0; j < 4; ++j) { const f32x4 sc = *(const f32x4*)(scale + 4 * lane + 256 * j), sh = *(const f32x4*)(shift + 4 * lane + 256 * j); vb2[j] = vb2[j] * (sc + 1.0f) + sh;
                    v2u w; w.x = pk2(vb2[j][0], vb2[j][1]); w.y = pk2(vb2[j][2], vb2[j][3]); if (LIVE_) *(v2u*)(XN + (size_t)row * D + 4 * lane + 256 * j) = w; }
                }
                float pa[16], pb_[16];
                { f32x2 vp[4][4];
#pragma unroll
                  for (int j = 0; j < 4; ++j)
#pragma unroll
                      for (int e = 0; e < 4; ++e) vp[j][e] = (f32x2){va[j][e], vb2[j][e]};
#pragma unroll
                  for (int o = 0; o < 16; ++o) { f32x2 sr = (f32x2){0.f, 0.f};
#pragma unroll
                    for (int j = 0; j < 4; ++j) { const f32x4 w = *(const LAS f32x4*)(wab + o * 1024 + 4 * lane + 256 * j);
#pragma unroll
                        for (int e = 0; e < 4; ++e) sr += vp[j][e] * w[e]; }
                    pa[o] = sr[0]; pb_[o] = sr[1]; if ((o & 3) == 3) asm volatile("" ::: "memory"); } }
                const float t0_ = reduce16(pa, lane), t1_ = reduce16(pb_, lane);
                if ((lane & 3) == 0) { AB[(size_t)rowb * 16 + (lane >> 2)] = t0_ + bin[OFF_A + (lane >> 2)]; if (rowb + NGW < NTOK) AB[(size_t)(rowb + NGW) * 16 + (lane >> 2)] = t1_ + bin[OFF_A + (lane >> 2)]; }
            }
        } }
        SEAM(pb + 0);

        for (int rep_ = 0; rep_ <= (int)PH_REP(2); ++rep_) { if (rep_) GRID_BAR();
        if (PH_ON(2) && IN(pb + 1)) { PH_BEGIN(); const float* mv = modv + (size_t)l * 9 * 6144; (void)mv; unsigned* const moecnt = ctl + CW_MOE + l * 16 * 64; (void)moecnt;
            SchedInA S{X.G, X.bid, (const char*)XN, (const char*)WIN};
            EpiInA E{PQKV, PZ, PCONF, PSGU, PFFT, PFFTC, binv};
            pg8::gemm_phase<EpiInA, SchedInA, true, true>(lds, Gemm{1024, 1024, 1024}, S, E);
        } }
        SEAM(pb + 1);

        for (int rep_ = 0; rep_ <= (int)PH_REP(3); ++rep_) { if (rep_) GRID_BAR();
        if (PH_ON(3) && IN(pb + 2)) { PH_BEGIN(); const float* mv = modv + (size_t)l * 9 * 6144; (void)mv; unsigned* const moecnt = ctl + CW_MOE + l * 16 * 64; (void)moecnt;
            {
                const int vb = X.bid, NB2 = X.G, gw2 = gw, NGW2 = NGW;
                { SchedFftCtx S{NB2, vb, (const char*)DFTC, (const char*)PFFTC}; EpiBf16<0> E{BR + (size_t)2 * NTOK * 512, 512, nullptr};
                  pg8::gemm_phase<EpiBf16<0>, SchedFftCtx, true, true>(lds, Gemm{512, 512, 512}, S, E); }
                __syncthreads();
                {
                    typedef short v4i16_t __attribute__((ext_vector_type(4)));
                    LAS unsigned char* tl = lds + X.wave * 8192;
                    const int r16 = lane & 15, quad = lane >> 4;
                    bf16x8 m1[4][2];
#pragma unroll
                    for (int mt = 0; mt < 4; ++mt)
#pragma unroll
                        for (int ks = 0; ks < 2; ++ks) { float o[8]; const int k1 = 16 * (mt & 1) + r16, ri = mt >> 1;
#pragma unroll
                            for (int e = 0; e < 8; ++e) { const int t1 = 8 * quad + e; float sn, cs; fsincospi((float)((k1 * t1) & 31) * (1.0f / 16.0f), &sn, &cs);
                                o[e] = ri == 0 ? (ks == 0 ? cs : -sn) : (ks == 0 ? -sn : -cs); }
                            m1[mt][ks] = __builtin_bit_cast(bf16x8, pack8(o)); }
                    float twc[2][4][4], tws[2][4][4];
#pragma unroll
                    for (int ml = 0; ml < 2; ++ml)
#pragma unroll
                        for (int c = 0; c < 4; ++c)
#pragma unroll
                            for (int r = 0; r < 4; ++r) { const int k1 = 16 * ml + r16, t2 = 16 * c + 4 * quad + r; fsincospi((float)(k1 * t2) * (1.0f / 1024.0f), &tws[ml][c][r], &twc[ml][c][r]); }
                    const unsigned tbase = (unsigned)(size_t)tl;
                    for (int it = gw2; it < NB * 512; it += NGW2) {
                        const int b = it >> 9, col = it & 511;
                        const bf16* src = PFFT + (size_t)it * 4096;
                        v4u ld[8];
#pragma unroll
                        for (int i = 0; i < 8; ++i) ld[i] = *(const v4u*)(src + (i * 64 + lane) * 8);
#pragma unroll
                        for (int i = 0; i < 8; ++i) *(LAS v4u*)(tl + (i * 64 + lane) * 16) = ld[i];
                        LDS_WAIT();
                        bf16* dst = (b < 4 ? F1A + (size_t)(b * 512 + col) * 4096 : F1B + (size_t)((b - 4) * 512 + col) * 4096);
#pragma unroll
                        for (int c = 0; c < 4; ++c) {
                            bf16x8 af[2];
#pragma unroll
                            for (int ks = 0; ks < 2; ++ks) { v4i16_t h[2];
#pragma unroll
                                for (int t = 0; t < 2; ++t) h[t] = __builtin_amdgcn_ds_read_tr16_b64_v4i16((LAS v4i16_t*)(tl + ks * 4096 + (8 * quad + 4 * t + (r16 >> 2)) * 128 + (16 * c + 4 * (lane & 3)) * 2));
                                bf16x8 f; f[0] = h[0][0]; f[1] = h[0][1]; f[2] = h[0][2]; f[3] = h[0][3]; f[4] = h[1][0]; f[5] = h[1][1]; f[6] = h[1][2]; f[7] = h[1][3]; af[ks] = f; }
                            f32x4 acc[4];
#pragma unroll
                            for (int mt = 0; mt < 4; ++mt) { acc[mt] = (f32x4){0.f, 0.f, 0.f, 0.f};
#pragma unroll
                                for (int ks = 0; ks < 2; ++ks) acc[mt] = __builtin_amdgcn_mfma_f32_16x16x32_bf16(af[ks], m1[mt][ks], acc[mt], 0, 0, 0); }
#pragma unroll
                            for (int ml = 0; ml < 2; ++ml) { const int k1 = 16 * ml + r16; float pr[4], pi[4];
#pragma unroll
                                for (int r = 0; r < 4; ++r) { const float ar = acc[ml][r], ai = acc[ml + 2][r]; pr[r] = ar * twc[ml][c][r] + ai * tws[ml][c][r]; pi[r] = ai * twc[ml][c][r] - ar * tws[ml][c][r]; }
                                v2u w0, w1; w0.x = pk2(pr[0], pr[1]); w0.y = pk2(pr[2], pr[3]); w1.x = pk2(pi[0], pi[1]); w1.y = pk2(pi[2], pi[3]);
                                *(v2u*)(dst + k1 * 128 + 16 * c + 4 * quad) = w0; *(v2u*)(dst + k1 * 128 + 64 + 16 * c + 4 * quad) = w1; }
                        }
                        LDS_WAIT();
                    }
                    (void)tbase;
                    __syncthreads();
                }
                {
                    LAS float* cwl = (LAS float*)lds;
                    const float* cw = INP(I_GCONV) + (size_t)l * 5 * 1536;
                    for (int i = tid; i < 5 * 1536 / 4; i += 512) *(LAS f32x4*)(cwl + 4 * i) = *(const f32x4*)(cw + 4 * i);
                    __syncthreads();
                    for (int row = gw2; row < NTOK; row += NGW2) {
                        int t, T; if (row < NLAT) { t = row & 2047; T = 2048; } else { t = (row - NLAT) & 255; T = 256; }
                        v4u xr[3][5];
#pragma unroll
                        for (int seg = 0; seg < 3; ++seg)
#pragma unroll
                            for (int j = 0; j < 5; ++j) { const int tt = t + j - 2; xr[seg][j] = (tt >= 0 && tt < T) ? *(const v4u*)(PQKV + (size_t)(row + j - 2) * 1536 + seg * 512 + 8 * lane) : (v4u){0u, 0u, 0u, 0u}; }
                        float av = 0.f, bv = 0.f; if (lane < 8) { av = AB[(size_t)row * 16 + lane]; bv = AB[(size_t)row * 16 + 8 + lane]; }
#pragma unroll
                        for (int seg = 0; seg < 3; ++seg) { const int ch = seg * 512 + 8 * lane; float a[8];
#pragma unroll
                            for (int e = 0; e < 8; ++e) a[e] = 0.f;
#pragma unroll
                            for (int j = 0; j < 5; ++j) { float xv[8]; unpack8(xr[seg][j], xv);
                                const f32x4 w0 = *(const LAS f32x4*)(cwl + j * 1536 + ch), w1 = *(const LAS f32x4*)(cwl + j * 1536 + ch + 4);
#pragma unroll
                                for (int e = 0; e < 4; ++e) { a[e] += w0[e] * xv[e]; a[4 + e] += w1[e] * xv[4 + e]; } }
                            float ss = 0.f;
#pragma unroll
                            for (int e = 0; e < 8; ++e) { a[e] = siluf_(a[e]); ss += a[e] * a[e]; }
                            if (seg < 2) { ss = g16_sum(ss); const float sc = __builtin_amdgcn_rsqf(ss + LN_EPS) * (seg == 0 ? 0.08838834764831845f : 1.0f);
#pragma unroll
                                for (int e = 0; e < 8; ++e) a[e] *= sc; }
                            *(v4u*)(QKV + (size_t)row * 1536 + ch) = pack8(a); }
                        if (lane < 8) { const float xs = av + INP(I_GDT)[l * 8 + lane]; const float sp = xs > 20.f ? xs : __logf(1.0f + __expf(xs));
                            GB[(size_t)row * 16 + lane] = -__expf(INP(I_GALOG)[l * 8 + lane]) * sp; GB[(size_t)row * 16 + 8 + lane] = __builtin_amdgcn_rcpf(1.0f + __expf(-bv)); }
                    }
                    __syncthreads();
                }
                {
                    LAS bf16* xs = (LAS bf16*)lds;
                    LAS float* wl = (LAS float*)(lds + 63488);
                    const float* dw = INP(I_CDWW) + (size_t)l * 31 * 512; const float* dwb = INP(I_CDWB) + l * 512, *lg = INP(I_CLNG) + l * 512, *lb = INP(I_CLNB) + l * 512;
                    bf16* B1 = BR + (size_t)1 * NTOK * 512;
                    for (int i = tid; i < 31 * 512 / 4; i += 512) *(LAS f32x4*)(wl + 4 * i) = *(const f32x4*)(dw + 4 * i);
                    const int ch = 8 * lane, tq = X.wave;
                    f32x4 bia0 = *(const f32x4*)(dwb + ch), bia1 = *(const f32x4*)(dwb + ch + 4);
                    const f32x4 g0 = *(const f32x4*)(lg + ch), g1 = *(const f32x4*)(lg + ch + 4), b0 = *(const f32x4*)(lb + ch), b1 = *(const f32x4*)(lb + ch + 4);
                    for (int tile = vb; tile < nrows2 / 32; tile += NB2) {
                        const int t0 = tile * 32; int rbase, T; if (t0 < NLAT) { rbase = t0 & ~2047; T = 2048; } else { rbase = NLAT + ((t0 - NLAT) & ~255); T = 256; }
                        __syncthreads();
                        for (int i = tid; i < 62 * 64; i += 512) { const int r = i >> 6, c = i & 63, srow = t0 - 15 + r;
                            *(LAS v4u*)(xs + r * 512 + 8 * c) = (srow >= rbase && srow < rbase + T) ? *(const v4u*)(PCONF + (size_t)srow * 512 + 8 * c) : (v4u){0u, 0u, 0u, 0u}; }
                        __syncthreads();
                        float acc[4][8];
#pragma unroll
                        for (int k = 0; k < 4; ++k)
#pragma unroll
                            for (int e = 0; e < 4; ++e) { acc[k][e] = bia0[e]; acc[k][4 + e] = bia1[e]; }
#pragma unroll 1
                        for (int j = 0; j < 31; ++j) {
                            const f32x4 w0 = *(const LAS f32x4*)(wl + j * 512 + ch), w1 = *(const LAS f32x4*)(wl + j * 512 + ch + 4);
#pragma unroll
                            for (int k = 0; k < 4; ++k) { float xv[8]; unpack8(*(const LAS v4u*)(xs + (tq * 4 + k + j) * 512 + ch), xv);
#pragma unroll
                                for (int e = 0; e < 4; ++e) { acc[k][e] += w0[e] * xv[e]; acc[k][4 + e] += w1[e] * xv[4 + e]; } }
                        }
#pragma unroll
                        for (int k = 0; k < 4; ++k) { float s1 = 0.f;
#pragma unroll
                            for (int e = 0; e < 8; ++e) s1 += acc[k][e];
                            const float mean = g16_sum(s1) * (1.0f / 128.0f); float s2 = 0.f;
#pragma unroll
                            for (int e = 0; e < 8; ++e) { acc[k][e] -= mean; s2 += acc[k][e] * acc[k][e]; }
                            const float rstd = __builtin_amdgcn_rsqf(g16_sum(s2) * (1.0f / 128.0f) + LN_EPS); float o[8];
#pragma unroll
                            for (int e = 0; e < 4; ++e) { o[e] = siluf_(acc[k][e] * rstd * g0[e] + b0[e]); o[4 + e] = siluf_(acc[k][4 + e] * rstd * g1[e] + b1[e]); }
                            *(v4u*)(B1 + (size_t)(t0 + tq * 4 + k) * 512 + ch) = pack8(o); }
                    }
                    __syncthreads();
                }
                {
                    LAS bf16* vnT = (LAS bf16*)lds;
                    const float* lg = INP(I_SLNG) + l * 512, *lb = INP(I_SLNB) + l * 512;
                    bf16* B3 = BR + (size_t)3 * NTOK * 512;
                    const int nitems = (nrows2 / 128) * 4, r16 = lane & 15, quad = lane >> 4, w = X.wave;
                    for (int it = vb; it < nitems; it += NB2) {
                        const int chunk = it >> 2, g = it & 3, r0 = chunk * 128;
                        unsigned raw[16];
#pragma unroll
                        for (int i = 0; i < 16; ++i) raw[i] = *(const unsigned*)(PSGU + (size_t)(r0 + w * 16 + i) * 1024 + 512 + g * 128 + 2 * lane);
                        const int c = g * 128 + 2 * lane; const float lg0 = lg[c], lg1 = lg[c + 1], lb0 = lb[c], lb1 = lb[c + 1];
                        __syncthreads();
                        { float sv[16];
#pragma unroll
                          for (int i = 0; i < 16; ++i) sv[i] = bflo(raw[i]) + bfhi(raw[i]);
                          const float ts = reduce16(sv, lane) * (1.0f / 128.0f); float mean[16];
#pragma unroll
                          for (int i = 0; i < 16; ++i) { mean[i] = __shfl(ts, 4 * i); const float v0 = bflo(raw[i]) - mean[i], v1 = bfhi(raw[i]) - mean[i]; sv[i] = v0 * v0 + v1 * v1; }
                          const float tv = reduce16(sv, lane) * (1.0f / 128.0f);
#pragma unroll
                          for (int i = 0; i < 16; ++i) { const float rstd = __builtin_amdgcn_rsqf(__shfl(tv, 4 * i) + LN_EPS); const float v0 = bflo(raw[i]) - mean[i], v1 = bfhi(raw[i]) - mean[i];
                            vnT[(2 * lane) * 136 + w * 16 + i] = (bf16)f2bf(v0 * rstd * lg0 + lb0); vnT[(2 * lane + 1) * 136 + w * 16 + i] = (bf16)f2bf(v1 * rstd * lg1 + lb1); } }
                        bf16x8 wf[4];
                        { const float* wsrc = INP(I_SWS) + ((size_t)(l * 4 + g) * 128 + 16 * w + r16) * 128 + quad * 8;
#pragma unroll
                          for (int ks = 0; ks < 4; ++ks) { const f32x4 x0 = *(const f32x4*)(wsrc + 32 * ks), x1 = *(const f32x4*)(wsrc + 32 * ks + 4);
                              v4u pk; pk.x = pk2(x0[0], x0[1]); pk.y = pk2(x0[2], x0[3]); pk.z = pk2(x1[0], x1[1]); pk.w = pk2(x1[2], x1[3]); wf[ks] = __builtin_bit_cast(bf16x8, pk); } }
                        const float bs = INP(I_SBS)[(l * 4 + g) * 128 + 16 * w + r16];
                        __syncthreads();
                        const size_t prow = (size_t)(r0 + 16 * w + r16);
#pragma unroll
                        for (int nt = 0; nt < 8; ++nt) { f32x4 acc = (f32x4){0.f, 0.f, 0.f, 0.f};
#pragma unroll
                            for (int ks = 0; ks < 4; ++ks) { const bf16x8 vf = *(const LAS bf16x8*)(vnT + (16 * nt + r16) * 136 + 32 * ks + quad * 8); acc = __builtin_amdgcn_mfma_f32_16x16x32_bf16(vf, wf[ks], acc, 0, 0, 0); }
                            const v2u uw = *(const v2u*)(PSGU + prow * 1024 + g * 128 + 16 * nt + quad * 4);
                            v2u o; o.x = pk2(bflo(uw.x) * (acc[0] + bs), bfhi(uw.x) * (acc[1] + bs)); o.y = pk2(bflo(uw.y) * (acc[2] + bs), bfhi(uw.y) * (acc[3] + bs));
                            *(v2u*)(B3 + prow * 512 + g * 128 + 16 * nt + quad * 4) = o; }
                    }
                    __syncthreads();
                }
            }
        } }
        SEAM(pb + 2);

        for (int rep_ = 0; rep_ <= (int)PH_REP(4); ++rep_) { if (rep_) GRID_BAR();
        if (PH_ON(4) && IN(pb + 3)) { PH_BEGIN(); const float* mv = modv + (size_t)l * 9 * 6144; (void)mv; unsigned* const moecnt = ctl + CW_MOE + l * 16 * 64; (void)moecnt;
            {
                const int r16 = lane & 15, quad = lane >> 4;
                bf16x8 m2[4][4];
#pragma unroll
                for (int jt = 0; jt < 4; ++jt)
#pragma unroll
                    for (int ks = 0; ks < 4; ++ks) { float o[8]; const int k2 = 16 * jt + r16;
#pragma unroll
                        for (int e = 0; e < 8; ++e) { const int t2 = 32 * (ks & 1) + 8 * quad + e; float sn, cs; fsincospi((float)((k2 * t2) & 63) * (1.0f / 32.0f), &sn, &cs); o[e] = ((ks >> 1) ? sn : cs) * 0.022097086912079608f; }
                        m2[jt][ks] = __builtin_bit_cast(bf16x8, pack8(o)); }
                bf16* B2 = BR + (size_t)2 * NTOK * 512;
                const int nq5 = 9216 - 4 * NGW;
                const bool bal = nq5 > 0 && nq5 < NGW;
                for (int it = bal ? gw - nq5 : gw; it < 8192; it += bal ? NGW - nq5 : NGW) {
                    if (it < 0) break;
                    const int b = it >> 10, k1 = (it >> 5) & 31, ct = it & 31;
                    const bf16* f1 = (b < 4 ? F1A + (size_t)(b * 512 + 16 * ct + r16) * 4096 : F1B + (size_t)((b - 4) * 512 + 16 * ct + r16) * 4096) + k1 * 128 + 8 * quad;
                    bf16x8 af[4];
#pragma unroll
                    for (int ks = 0; ks < 4; ++ks) af[ks] = *(const bf16x8*)(f1 + 32 * ks);
#pragma unroll
                    for (int jt = 0; jt < 4; ++jt) { f32x4 acc = (f32x4){0.f, 0.f, 0.f, 0.f};
#pragma unroll
                        for (int ks = 0; ks < 4; ++ks) acc = __builtin_amdgcn_mfma_f32_16x16x32_bf16(af[ks], m2[jt][ks], acc, 0, 0, 0);
                        v2u w; w.x = pk2(acc[0], acc[1]); w.y = pk2(acc[2], acc[3]);
                        *(v2u*)(B2 + (size_t)(b * 2048 + k1 + 32 * (16 * jt + r16)) * 512 + 16 * ct + 4 * quad) = w; }
                }
            }
            for (int qi = gw; qi < 9216; qi += NGW) {
                int lane_l = lane; asm volatile("" : "+v"(lane_l));
                const int r16 = lane_l & 15, quad = lane_l >> 4;
                LAS float* const Mt = (LAS float*)(lds + X.wave * 16384);
                LAS float* const gcl = (LAS float*)(lds + 132096 + X.wave * 1024);
                const int item = qi >> 2, q = qi & 3, cidx = item % 36, chain = item / 36, dir = chain & 1, hh = (chain >> 1) & 3, b = chain >> 3;
                const int row0 = cidx < 4 ? NLAT + b * CTXL + cidx * 64 : b * SEQ + (cidx - 4) * 64;
                const int rb = row0 + (dir ? 63 : 0); const long sg = dir ? -1 : 1;
                const float ga = GB[(size_t)(rb + sg * lane_l) * 16 + dir * 4 + hh], be = GB[(size_t)(rb + sg * lane_l) * 16 + 8 + dir * 4 + hh];
                float gc = ga;
#pragma unroll
                for (int o = 1; o < 64; o <<= 1) { const float tu = __shfl_up(gc, o); gc += (lane_l >= o) ? tu : 0.f; }
                const float gl = __shfl(gc, 63);
                gcl[lane_l] = gc; gcl[64 + lane_l] = be;
                const float scl = q >= 2 ? be * __expf(gc) : be;
                bf16x8 Kf[4][4];
                { const bf16* kp = QKV + (size_t)(rb + sg * r16) * 1536 + 512 + hh * 128 + quad * 8; const long ms = sg * 16 * 1536;
#pragma unroll
                  for (int mi = 0; mi < 4; ++mi)
#pragma unroll
                      for (int ks = 0; ks < 4; ++ks) Kf[mi][ks] = *(const bf16x8*)(kp + mi * ms + ks * 32); }
                LDS_WAIT();
                if (q == 0) {
                    bf16x8 Qf[4][4];
                    { const bf16* qp = QKV + (size_t)(rb + sg * r16) * 1536 + hh * 128 + quad * 8; const long ms = sg * 16 * 1536;
#pragma unroll
                      for (int mi = 0; mi < 4; ++mi)
#pragma unroll
                          for (int ks = 0; ks < 4; ++ks) Qf[mi][ks] = *(const bf16x8*)(qp + mi * ms + ks * 32); }
                    bf16* ait = AIT + (size_t)item * 4096 + r16 * 64 + quad * 4;
#pragma unroll
                    for (int mi = 0; mi < 4; ++mi) { const float gci = gcl[16 * mi + r16];
#pragma unroll
                        for (int nj = 0; nj < 4; ++nj) {
                            v2u w; w.x = 0u; w.y = 0u;
                            if (nj <= mi) {
                                f32x4 c = (f32x4){0.f, 0.f, 0.f, 0.f};
#pragma unroll
                                for (int ks = 0; ks < 4; ++ks) c = __builtin_amdgcn_mfma_f32_16x16x32_bf16(Kf[nj][ks], Qf[mi][ks], c, 0, 0, 0);
                                const f32x4 gcj = *(const LAS f32x4*)(gcl + 16 * nj + quad * 4); float o4[4];
#pragma unroll
                                for (int r = 0; r < 4; ++r) { const bool incl = (nj < mi) || (quad * 4 + r <= r16); o4[r] = incl ? c[r] * __expf(gci - gcj[r]) : 0.f; }
                                w.x = pk2(o4[0], o4[1]); w.y = pk2(o4[2], o4[3]); }
                            *(v2u*)(ait + mi * 16 * 64 + 16 * nj) = w; }
                    }
                }
                if (q == 1) { SIT[(size_t)item * 192 + lane_l] = __expf(gc); SIT[(size_t)item * 192 + 64 + lane_l] = __expf(gl - gc); if (lane_l == 0) SIT[(size_t)item * 192 + 128] = __expf(gl); }
                asm volatile("" ::: "memory");
                { LAS float* mw = Mt + r16 * 64 + quad * 4;
#pragma unroll
                  for (int mi = 0; mi < 4; ++mi) {
                    const f32x4 gci = *(const LAS f32x4*)(gcl + 16 * mi + quad * 4), bei = *(const LAS f32x4*)(gcl + 64 + 16 * mi + quad * 4);
#pragma unroll
                    for (int nj = 0; nj <= mi; ++nj) {
                        f32x4 c = (f32x4){0.f, 0.f, 0.f, 0.f};
#pragma unroll
                        for (int ks = 0; ks < 4; ++ks) c = __builtin_amdgcn_mfma_f32_16x16x32_bf16(Kf[mi][ks], Kf[nj][ks], c, 0, 0, 0);
                        const float gcj = gcl[16 * nj + r16]; f32x4 mv4;
#pragma unroll
                        for (int r = 0; r < 4; ++r) { const bool strict = (nj < mi) || (r16 < quad * 4 + r); mv4[r] = strict ? -(bei[r] * c[r] * __expf(gci[r] - gcj)) : 0.f; }
                        *(LAS f32x4*)(mw + (16 * nj) * 64 + 16 * mi) = mv4;
                    }
                  } }
                asm volatile("" ::: "memory");
                LDS_WAIT();
                float Xs[64];
                { const bf16* src = QKV + (size_t)rb * 1536 + (q < 2 ? 1024 + 64 * q : 512 + 64 * (q - 2)) + hh * 128 + lane_l; const long sstep = sg * 1536;
                  bf16 raw[64];
#pragma unroll
                  for (int sidx = 0; sidx < 64; ++sidx) { raw[sidx] = *src; src += sstep; }
                  asm volatile("" ::: "memory");
#pragma unroll
                  for (int sidx = 0; sidx < 64; ++sidx) { const float sc = __builtin_bit_cast(float, __builtin_amdgcn_readlane(__builtin_bit_cast(int, scl), sidx)); Xs[sidx] = bf1(raw[sidx]) * sc; } }
#pragma unroll
                for (int g4 = 0; g4 < 16; ++g4) {
                    f32x4 acc = (f32x4){Xs[4 * g4], Xs[4 * g4 + 1], Xs[4 * g4 + 2], Xs[4 * g4 + 3]};
#pragma unroll
                    for (int c0 = 0; c0 < 4 * g4; c0 += 16) {
                        f32x4 mb[16];
#pragma unroll
                        for (int e = 0; e < 16; ++e) if (c0 + e < 4 * g4) mb[e] = *(const LAS f32x4*)(Mt + (c0 + e) * 64 + 4 * g4);
                        LDS_WAIT();
#pragma unroll
                        for (int e = 0; e < 16; ++e) if (c0 + e < 4 * g4) acc += mb[e] * Xs[c0 + e];
                    }
                    const f32x4 m0 = *(const LAS f32x4*)(Mt + (4 * g4) * 64 + 4 * g4), m1 = *(const LAS f32x4*)(Mt + (4 * g4 + 1) * 64 + 4 * g4), m2 = *(const LAS f32x4*)(Mt + (4 * g4 + 2) * 64 + 4 * g4);
                    LDS_WAIT();
                    const float x0 = acc[0], x1 = acc[1] + m0[1] * x0, x2 = acc[2] + m0[2] * x0 + m1[2] * x1, x3 = acc[3] + m0[3] * x0 + m1[3] * x1 + m2[3] * x2;
                    Xs[4 * g4] = x0; Xs[4 * g4 + 1] = x1; Xs[4 * g4 + 2] = x2; Xs[4 * g4 + 3] = x3;
                }
                if (q < 2) {
                    bf16* u0 = UIT + (size_t)item * 8192 + (size_t)(64 * q + lane_l) * 64;
#pragma unroll
                    for (int p = 0; p < 8; ++p) { float c0[8];
#pragma unroll
                        for (int e = 0; e < 8; ++e) c0[e] = Xs[8 * p + e];
                        *(v4u*)(u0 + 8 * p) = pack8(c0); }
                } else {
                    bf16* w0 = WIT + (size_t)item * 8192 + 64 * (q - 2) + lane_l;
#pragma unroll
                    for (int sidx = 0; sidx < 64; ++sidx) { w0[sidx * 128] = (bf16)f2bf(Xs[sidx]); if ((sidx & 15) == 15) asm volatile("" ::: "memory"); }
                    asm volatile("" ::: "memory");
                    if (dir == 0) {
                        const bf16* src = QKV + (size_t)row0 * 1536 + 512 + hh * 128 + 64 * (q - 2) + lane_l;
                        bf16* k0 = KIT + ((size_t)((b * 4 + hh) * 36 + cidx)) * 8192 + (size_t)(64 * (q - 2) + lane_l) * 64;
                        unsigned kw[64];
#pragma unroll
                        for (int e = 0; e < 64; ++e) kw[e] = src[(size_t)e * 1536];
                        asm volatile("" ::: "memory");
#pragma unroll
                        for (int p = 0; p < 8; ++p) { v4u lo; lo.x = kw[8 * p] | (kw[8 * p + 1] << 16); lo.y = kw[8 * p + 2] | (kw[8 * p + 3] << 16); lo.z = kw[8 * p + 4] | (kw[8 * p + 5] << 16); lo.w = kw[8 * p + 6] | (kw[8 * p + 7] << 16);
                            *(v4u*)(k0 + 8 * p) = lo; }
                    }
                }
                LDS_WAIT();
            }
        } }
        SEAM(pb + 3);

        for (int rep_ = 0; rep_ <= (int)PH_REP(5); ++rep_) { if (rep_) GRID_BAR();
        if (PH_ON(5) && IN(pb + 4)) { PH_BEGIN(); const float* mv = modv + (size_t)l * 9 * 6144; (void)mv; unsigned* const moecnt = ctl + CW_MOE + l * 16 * 64; (void)moecnt;
            LAS bf16* const STl = (LAS bf16*)lds;
            LAS bf16* const VNl = (LAS bf16*)(lds + 8704);
            LAS bf16* const VSl = (LAS bf16*)(lds + 13312);
            const int w = X.wave, mt = w & 3, role = w >> 2, r16 = lane & 15, quad = lane >> 4;
            for (int blk = X.bid; blk < 256; blk += X.G) {
                const int item = (blk & 7) * 32 + (blk >> 3);
                const int chain = item >> 2, slice = item & 3, dir = chain & 1, hh = (chain >> 1) & 3, b = chain >> 3;
                bf16* const O = dir ? OB : OF;
                __syncthreads();
                for (int i = tid; i < 32 * 136 / 2; i += 512) ((LAS unsigned*)STl)[i] = 0u;
                __syncthreads();
                f32x4 Sacc[2]; Sacc[0] = (f32x4){0.f, 0.f, 0.f, 0.f}; Sacc[1] = (f32x4){0.f, 0.f, 0.f, 0.f};
#define GDN_LOAD(P, step_) do { const int cidx_ = dir ? ((step_) < 4 ? 3 - (step_) : 39 - (step_)) : (step_); const int item_ = chain * 36 + cidx_, kti_ = (chain >> 1) * 36 + cidx_; \
                    const int row0_ = cidx_ < 4 ? NLAT + b * CTXL + cidx_ * 64 : b * SEQ + (cidx_ - 4) * 64; \
                    const bf16* xp_ = role ? QKV + (size_t)(row0_ + (dir ? 63 - (16 * mt + r16) : 16 * mt + r16)) * 1536 + hh * 128 + quad * 8 : WIT + (size_t)item_ * 8192 + (16 * mt + r16) * 128 + quad * 8; \
                    _Pragma("unroll") for (int ks = 0; ks < 4; ++ks) P##Xf[ks] = *(const bf16x8*)(xp_ + 32 * ks); \
                    { const bf16* kp_ = KIT + (size_t)kti_ * 8192 + (16 * w + r16) * 64 + (dir ? 56 - quad * 8 : quad * 8); \
                      _Pragma("unroll") for (int ks = 0; ks < 2; ++ks) P##Kx[ks] = *(const v4u*)(kp_ + (dir ? -32 * ks : 32 * ks)); } \
                    const float* sp_ = SIT + (size_t)item_ * 192; P##sc4 = *(const f32x4*)(sp_ + (role ? 0 : 64) + 16 * mt + quad * 4); P##egl = sp_[128]; \
                      \
                    { const bf16* a0_ = role ? AIT + (size_t)item_ * 4096 + (16 * mt + r16) * 64 + quad * 8 : UIT + (size_t)item_ * 8192 + (size_t)(slice * 32 + r16) * 64 + 16 * mt + quad * 4; \
                      const bf16* a1_ = role ? a0_ + 32 : a0_ + 16 * 64; \
                      P##Ax[0] = *(const v2u*)a0_; P##Ax[1] = *(const v2u*)(a0_ + 4); P##Ax[2] = *(const v2u*)a1_; P##Ax[3] = *(const v2u*)(a1_ + 4); } } while (0)
#define GDN_BAR() do { asm volatile("s_waitcnt lgkmcnt(0)" ::: "memory"); __builtin_amdgcn_s_barrier(); asm volatile("" ::: "memory"); } while (0)
#define GDN_STEP(P, step_) do { const int cidx = dir ? ((step_) < 4 ? 3 - (step_) : 39 - (step_)) : (step_); \
                    const int row0 = cidx < 4 ? NLAT + b * CTXL + cidx * 64 : b * SEQ + (cidx - 4) * 64; \
                      \
                    f32x4 x1[2]; x1[0] = (f32x4){0.f, 0.f, 0.f, 0.f}; x1[1] = (f32x4){0.f, 0.f, 0.f, 0.f}; \
                    { bf16x8 bfr[2][4]; \
                      _Pragma("unroll") for (int n_ = 0; n_ < 2; ++n_) _Pragma("unroll") for (int ks = 0; ks < 4; ++ks) bfr[n_][ks] = *(const LAS bf16x8*)(STl + (16 * n_ + r16) * 136 + 32 * ks + quad * 8); \
                      asm volatile("s_waitcnt lgkmcnt(0)" ::: "memory"); \
                      _Pragma("unroll") for (int ks = 0; ks < 4; ++ks) { x1[0] = __builtin_amdgcn_mfma_f32_16x16x32_bf16(P##Xf[ks], bfr[0][ks], x1[0], 0, 0, 0); x1[1] = __builtin_amdgcn_mfma_f32_16x16x32_bf16(P##Xf[ks], bfr[1][ks], x1[1], 0, 0, 0); } } \
                    if (role == 0) { \
                        _Pragma("unroll") for (int n_ = 0; n_ < 2; ++n_) { f32x4 vn; vn[0] = bflo(P##Ax[2 * n_].x) - x1[n_][0]; vn[1] = bfhi(P##Ax[2 * n_].x) - x1[n_][1]; vn[2] = bflo(P##Ax[2 * n_].y) - x1[n_][2]; vn[3] = bfhi(P##Ax[2 * n_].y) - x1[n_][3]; \
                            v2u p; p.x = pk2(vn[0], vn[1]); p.y = pk2(vn[2], vn[3]); *(LAS v2u*)(VNl + (16 * n_ + r16) * 72 + 16 * mt + quad * 4) = p; \
                            v2u q; q.x = pk2(vn[0] * P##sc4[0], vn[1] * P##sc4[1]); q.y = pk2(vn[2] * P##sc4[2], vn[3] * P##sc4[3]); *(LAS v2u*)(VSl + (16 * n_ + r16) * 72 + 16 * mt + quad * 4) = q; } } \
                    else { x1[0] = x1[0] * P##sc4; x1[1] = x1[1] * P##sc4; } \
                    bf16x8 kt_[2]; \
                    _Pragma("unroll") for (int ks = 0; ks < 2; ++ks) { const v4u kx_ = P##Kx[ks]; v4u kr_; \
                        kr_.x = dir ? ((kx_.w >> 16) | (kx_.w << 16)) : kx_.x; kr_.y = dir ? ((kx_.z >> 16) | (kx_.z << 16)) : kx_.y; kr_.z = dir ? ((kx_.y >> 16) | (kx_.y << 16)) : kx_.z; kr_.w = dir ? ((kx_.x >> 16) | (kx_.x << 16)) : kx_.w; \
                        kt_[ks] = __builtin_bit_cast(bf16x8, kr_); } \
                    GDN_BAR(); \
                      \
                    bf16x8 vsf[2][2]; \
                    _Pragma("unroll") for (int n2 = 0; n2 < 2; ++n2) { vsf[n2][0] = *(const LAS bf16x8*)(VSl + (16 * n2 + r16) * 72 + quad * 8); vsf[n2][1] = *(const LAS bf16x8*)(VSl + (16 * n2 + r16) * 72 + 32 + quad * 8); } \
                    if (role) { bf16x8 vb[2][2]; \
                        _Pragma("unroll") for (int n_ = 0; n_ < 2; ++n_) { vb[n_][0] = *(const LAS bf16x8*)(VNl + (16 * n_ + r16) * 72 + quad * 8); vb[n_][1] = *(const LAS bf16x8*)(VNl + (16 * n_ + r16) * 72 + 32 + quad * 8); } \
                        asm volatile("s_waitcnt lgkmcnt(0)" ::: "memory"); \
                        v4u af0_; af0_.x = P##Ax[0].x; af0_.y = P##Ax[0].y; af0_.z = P##Ax[1].x; af0_.w = P##Ax[1].y; v4u af1_; af1_.x = P##Ax[2].x; af1_.y = P##Ax[2].y; af1_.z = P##Ax[3].x; af1_.w = P##Ax[3].y; \
                        const bf16x8 Af0_ = __builtin_bit_cast(bf16x8, af0_), Af1_ = __builtin_bit_cast(bf16x8, af1_); \
                        _Pragma("unroll") for (int n_ = 0; n_ < 2; ++n_) { f32x4 oa = __builtin_amdgcn_mfma_f32_16x16x32_bf16(Af0_, vb[n_][0], x1[n_], 0, 0, 0); oa = __builtin_amdgcn_mfma_f32_16x16x32_bf16(Af1_, vb[n_][1], oa, 0, 0, 0); \
                            bf16* op = O + (size_t)(row0 + (dir ? 63 - (16 * mt + quad * 4) : 16 * mt + quad * 4)) * 512 + hh * 128 + slice * 32 + 16 * n_ + r16; const long ostep = dir ? -512 : 512; \
                            _Pragma("unroll") for (int j = 0; j < 4; ++j) op[j * ostep] = (bf16)f2bf(oa[j]); } } \
                    else { asm volatile("s_waitcnt lgkmcnt(0)" ::: "memory"); } \
                    _Pragma("unroll") for (int n2 = 0; n2 < 2; ++n2) { \
                        f32x4 sa = Sacc[n2] * P##egl; sa = __builtin_amdgcn_mfma_f32_16x16x32_bf16(kt_[0], vsf[n2][0], sa, 0, 0, 0); sa = __builtin_amdgcn_mfma_f32_16x16x32_bf16(kt_[1], vsf[n2][1], sa, 0, 0, 0); Sacc[n2] = sa; \
                        v2u p; p.x = pk2(sa[0], sa[1]); p.y = pk2(sa[2], sa[3]); *(LAS v2u*)(STl + (16 * n2 + r16) * 136 + 16 * w + quad * 4) = p; } \
                    GDN_BAR(); } while (0)
#define GDN_DECL(P) bf16x8 P##Xf[4]; v4u P##Kx[2]; v2u P##Ax[4]; f32x4 P##sc4; float P##egl
                GDN_DECL(sa_); GDN_DECL(sb_);
                GDN_LOAD(sa_, 0);
                for (int step = 0; step < 36; step += 2) {
                    GDN_LOAD(sb_, step + 1); GDN_STEP(sa_, step);
                    { const int s2 = step + 2 < 36 ? step + 2 : 35; GDN_LOAD(sa_, s2); } GDN_STEP(sb_, step + 1);
                }
#undef GDN_STEP
#undef GDN_BAR
#undef GDN_DECL
#undef GDN_LOAD
            }
        } }
        SEAM(pb + 4);

        for (int rep_ = 0; rep_ <= (int)PH_REP(6); ++rep_) { if (rep_) GRID_BAR();
        if (PH_ON(6) && IN(pb + 5)) { PH_BEGIN(); const float* mv = modv + (size_t)l * 9 * 6144; (void)mv; unsigned* const moecnt = ctl + CW_MOE + l * 16 * 64; (void)moecnt;
            const float* nw = INP(I_GNORM) + l * 128; const int ch = 8 * lane;
            const f32x4 nw0 = *(const f32x4*)(nw + (ch & 127)), nw1 = *(const f32x4*)(nw + (ch & 127) + 4);
            constexpr int ERT = 9;
            for (int rowb = gw; rowb < nrows2; rowb += ERT * NGW) {
                v4u lf[ERT], lb[ERT], lz[ERT];
#pragma unroll
                for (int k = 0; k < ERT; ++k) { const int row_ = rowb + k * NGW, row = row_ < nrows2 ? row_ : nrows2 - 1; lf[k] = *(const v4u*)(OF + (size_t)row * 512 + ch); lb[k] = *(const v4u*)(OB + (size_t)row * 512 + ch); lz[k] = *(const v4u*)(PZ + (size_t)row * 512 + ch); }
#pragma unroll
                for (int k = 0; k < ERT; ++k) { const int row_ = rowb + k * NGW, row = row_ < nrows2 ? row_ : nrows2 - 1; {
                    float of[8], ob[8], z[8], o[8]; unpack8(lf[k], of); unpack8(lb[k], ob); unpack8(lz[k], z); float ss = 0.f;
#pragma unroll
                    for (int e = 0; e < 8; ++e) { of[e] += ob[e]; ss += of[e] * of[e]; }
                    const float rs = __builtin_amdgcn_rsqf(g16_sum(ss) * (1.0f / 128.0f) + LN_EPS);
#pragma unroll
                    for (int e = 0; e < 4; ++e) { o[e] = of[e] * rs * nw0[e] * z[e]; o[4 + e] = of[4 + e] * rs * nw1[e] * z[4 + e]; }
                    if (row_ < nrows2) *(v4u*)(BR + (size_t)row * 512 + ch) = pack8(o); } }
            }
        } }
        SEAM(pb + 5);

        for (int rep_ = 0; rep_ <= (int)PH_REP(7); ++rep_) { if (rep_) GRID_BAR();
        if (PH_ON(7) && IN(pb + 6)) { PH_BEGIN(); const float* mv = modv + (size_t)l * 9 * 6144; (void)mv; unsigned* const moecnt = ctl + CW_MOE + l * 16 * 64; (void)moecnt;
            SchedBranch S{X.G, X.bid, npan2, (const char*)BR, (const char*)WBR};
            EpiBf16<0> E{GT, 4096, nullptr};
            pg8::gemm_phase<EpiBf16<0>, SchedBranch, true, true>(lds, Gemm{512, 512, 512}, S, E);
        } }
        SEAM(pb + 6);

        for (int rep_ = 0; rep_ <= (int)PH_REP(8); ++rep_) { if (rep_) GRID_BAR();
        if (PH_ON(8) && IN(pb + 7)) { PH_BEGIN(); const float* mv = modv + (size_t)l * 9 * 6144; (void)mv; unsigned* const moecnt = ctl + CW_MOE + l * 16 * 64; (void)moecnt;
            SchedGrid S{X.G, X.bid, npan2, 16, (const char*)XN, (const char*)(WIN + (size_t)5120 * 1024), (size_t)256 * 1024 * 2, (size_t)256 * 1024 * 2};
            EpiGateMerge E{GT, (bf16*)MERGED, binv + 5120};
            pg8::gemm_phase<EpiGateMerge, SchedGrid, true, true>(lds, Gemm{1024, 1024, 1024}, S, E);
        } }
        SEAM(pb + 7);

        for (int rep_ = 0; rep_ <= (int)PH_REP(9); ++rep_) { if (rep_) GRID_BAR();
        if (PH_ON(9) && IN(pb + 8)) { PH_BEGIN(); const float* mv = modv + (size_t)l * 9 * 6144; (void)mv; unsigned* const moecnt = ctl + CW_MOE + l * 16 * 64; (void)moecnt;
            SchedGrid S{X.G, X.bid, npan2, 4, (const char*)MERGED, (const char*)WOUT, (size_t)256 * 1024 * 2, (size_t)256 * 1024 * 2};
            EpiBf16<0> E{(bf16*)YB, 1024, INP(I_BOUT) + l * 1024};
            pg8::gemm_phase<EpiBf16<0>, SchedGrid, true, true>(lds, Gemm{1024, 1024, 1024}, S, E);
            __syncthreads();
            { LAS float* const wscr = (LAS float*)(lds + X.wave * 8448);
              const int first = npan2 * 4 > X.G ? npan2 * 4 - X.G : 0;
              if (X.bid >= first) { const int gwc = (X.bid - first) * NWAVES + X.wave, ngwc = (X.G - first) * NWAVES;
              for (int it = gwc; it < 12288; it += ngwc) {
                if (it < 8192) { const int e = it >> 9, rb = (it & 3) + 4 * ((it >> 3) & 7), kb = ((it >> 2) & 1) + 2 * ((it >> 6) & 7), row0 = rb * 32, j = row0 >> 8, w = row0 & 255;
                    const float* src = (w < 128 ? INP(I_EWG) : INP(I_EWU)) + ((size_t)(l * 16 + e) * 1024) * 512;
                    cvt_item(src, 512, 128 * j + (w & 127) + (lane & 31), kb * 64, WGU + ((size_t)e * 1024 + row0) * 1024, 1024, wscr, lane); }
                else { const int i2 = it - 8192; const int e = i2 >> 8, rb = (i2 & 3) + 4 * ((i2 >> 3) & 7), kb = ((i2 >> 2) & 1) + 2 * ((i2 >> 6) & 3);
                    cvt_item(INP(I_EWD) + ((size_t)(l * 16 + e) * 512) * 1024, 1024, rb * 32 + (lane & 31), kb * 64, WDN + ((size_t)e * 1024 + rb * 32) * 512, 512, wscr, lane); }
              } } }
        } }
        SEAM(pb + 8);

        for (int rep_ = 0; rep_ <= (int)PH_REP(10); ++rep_) { if (rep_) GRID_BAR();
        if (PH_ON(10) && IN(pb + 9)) { PH_BEGIN(); const float* mv = modv + (size_t)l * 9 * 6144; (void)mv; unsigned* const moecnt = ctl + CW_MOE + l * 16 * 64; (void)moecnt;
            LAS float* wr_ = (LAS float*)lds;
            volatile LAS unsigned* lcnt = (volatile LAS unsigned*)(lds + 100352);
            __syncthreads();
            if (tid < 32) lcnt[tid] = 0u;
            { f32x4 rq[10];
#pragma unroll
              for (int j = 0; j < 2; ++j) rq[j] = *(const f32x4*)(INP(I_RGW) + (size_t)l * 4096 + (size_t)(tid + 512 * j) * 4);
#pragma unroll
              for (int j = 0; j < 8; ++j) rq[2 + j] = *(const f32x4*)(INP(I_REW) + (size_t)l * 16384 + (size_t)(tid + 512 * (j & 1)) * 16 + 4 * (j >> 1));
#pragma unroll
              for (int j = 0; j < 2; ++j) { LAS float* p = wr_ + tid + 512 * j; p[0] = rq[j][0]; p[1024] = rq[j][1]; p[2048] = rq[j][2]; p[3072] = rq[j][3]; }
#pragma unroll
              for (int j = 0; j < 8; ++j) { LAS float* p = wr_ + (4 + 4 * (j >> 1)) * 1024 + tid + 512 * (j & 1); p[0] = rq[2 + j][0]; p[1024] = rq[2 + j][1]; p[2048] = rq[2 + j][2]; p[3072] = rq[2 + j][3]; } }
            __syncthreads();
            const float* g1 = INP(I_LN1G) + l * 1024, *b1 = INP(I_LN1B) + l * 1024;
            constexpr int RT = 2;
            for (int rowb = gw; rowb < nrows2; rowb += RT * NGW) {
                f32x4 v[RT][4];
#pragma unroll
                for (int q = 0; q < RT; ++q) { const int row_ = rowb + q * NGW, row = row_ < nrows2 ? row_ : nrows2 - 1; const bool live = row_ < nrows2;
                    float* hrow = row < NLAT ? hlat + (size_t)row * D : hctx + (size_t)(row - NLAT) * D;
                    const int mi = row < NLAT ? (row >> 11) : 8; const float* mrow = mv + mi * 6144;
#pragma unroll
                    for (int j = 0; j < 4; ++j) { const int c = 4 * lane + 256 * j; const v2u yw = *(const v2u*)((const bf16*)YB + (size_t)row * D + c); const f32x4 yv = (f32x4){bflo(yw.x), bfhi(yw.x), bflo(yw.y), bfhi(yw.y)}; v[q][j] = *(const f32x4*)(hrow + c) * DN_ALPHA + *(const f32x4*)(mrow + 2048 + c) * yv; }
                    ln_rows(v[q]);
#pragma unroll
                    for (int j = 0; j < 4; ++j) { const int c = 4 * lane + 256 * j; v[q][j] = v[q][j] * *(const f32x4*)(g1 + c) + *(const f32x4*)(b1 + c); if (live) *(f32x4*)(hrow + c) = v[q][j]; }
                    ln_rows(v[q]);
#pragma unroll
                    for (int j = 0; j < 4; ++j) { const int c = 4 * lane + 256 * j; v[q][j] = v[q][j] * (*(const f32x4*)(mrow + 4096 + c) + 1.0f) + *(const f32x4*)(mrow + 3072 + c);
                        v2u w; w.x = pk2(v[q][j][0], v[q][j][1]); w.y = pk2(v[q][j][2], v[q][j][3]); if (live) *(v2u*)(XN + (size_t)row * D + c) = w; }
                    asm volatile("" ::: "memory"); }
                static_assert(RT == 2, "the two rows of a trip ride in the two halves of packed f32 operations");
                float pg[RT][4], pe[RT][16];
                { f32x2 vp[4][4];
#pragma unroll
                  for (int j = 0; j < 4; ++j)
#pragma unroll
                      for (int e = 0; e < 4; ++e) vp[j][e] = (f32x2){v[0][j][e], v[1][j][e]};
#pragma unroll
                  for (int o = 0; o < 20; ++o) { f32x2 sr = (f32x2){0.f, 0.f};
#pragma unroll
                    for (int j = 0; j < 4; ++j) { const f32x4 w = *(const LAS f32x4*)(wr_ + o * 1024 + 4 * lane + 256 * j);
#pragma unroll
                        for (int e = 0; e < 4; ++e) sr += vp[j][e] * w[e]; }
                    if (o < 4) { pg[0][o] = sr[0]; pg[1][o] = sr[1]; } else { pe[0][o - 4] = sr[0]; pe[1][o - 4] = sr[1]; }
                    if ((o & 3) == 3) asm volatile("" ::: "memory"); } }
#pragma unroll
                for (int q = 0; q < RT; ++q) { const int row = rowb + q * NGW;
                float tg = reduce4(pg[q], lane), te = reduce16(pe[q], lane);
                tg += INP(I_RGB)[l * 4 + ((lane >> 4) & 3)]; te += INP(I_REB)[l * 16 + ((lane >> 2) & 15)];
                float lg[20];
#pragma unroll
                for (int o = 0; o < 4; ++o) lg[o] = __shfl(tg, o * 16);
#pragma unroll
                for (int o = 0; o < 16; ++o) lg[4 + o] = __shfl(te, o * 4);
                int gs = 0; float gm = lg[0];
#pragma unroll
                for (int o = 1; o < 4; ++o) if (lg[o] > gm) { gm = lg[o]; gs = o; }
                float den = 0.f;
#pragma unroll
                for (int o = 0; o < 4; ++o) den += __expf(lg[o] - gm);
                const float gp = __builtin_amdgcn_rcpf(den);
                float el[4];
#pragma unroll
                for (int o = 0; o < 4; ++o) el[o] = gs == 0 ? lg[4 + o] : gs == 1 ? lg[8 + o] : gs == 2 ? lg[12 + o] : lg[16 + o];
                int i0 = 0; float v0 = el[0];
#pragma unroll
                for (int o = 1; o < 4; ++o) if (el[o] > v0) { v0 = el[o]; i0 = o; }
                int i1 = -1; float v1 = 0.f;
#pragma unroll
                for (int o = 0; o < 4; ++o) if (o != i0 && (i1 < 0 || el[o] > v1)) { v1 = el[o]; i1 = o; }
                const float ex = __expf(v1 - v0), rz = __builtin_amdgcn_rcpf(1.0f + ex), w0 = gp * rz, w1 = gp * ex * rz;
                const int e0 = gs * 4 + i0, e1 = gs * 4 + i1;
                if (lane == 0 && row < nrows2) {
                    const unsigned p0 = __hip_atomic_fetch_add((LAS unsigned*)lcnt + e0, 1u, __ATOMIC_RELAXED, __HIP_MEMORY_SCOPE_WORKGROUP);
                    const unsigned p1 = __hip_atomic_fetch_add((LAS unsigned*)lcnt + e1, 1u, __ATOMIC_RELAXED, __HIP_MEMORY_SCOPE_WORKGROUP);
                    float* rt = ROUTE + (size_t)row * 8;
                    rt[0] = __builtin_bit_cast(float, e0); rt[1] = __builtin_bit_cast(float, e1); rt[2] = w0; rt[3] = w1; rt[4] = __builtin_bit_cast(float, (int)p0); rt[5] = __builtin_bit_cast(float, (int)p1);
                }
                asm volatile("" ::: "memory"); }
            }
            __syncthreads();
            if (tid < 16) { const unsigned c = lcnt[tid]; lcnt[16 + tid] = c ? __hip_atomic_fetch_add(moecnt + 64 * tid, c, __ATOMIC_RELAXED, __HIP_MEMORY_SCOPE_AGENT) : 0u; }
            __syncthreads();
            for (int row = gw; row < nrows2; row += NGW) {
                if (lane == 0) { float* rt = ROUTE + (size_t)row * 8; const int e0 = __builtin_bit_cast(int, rt[0]), e1 = __builtin_bit_cast(int, rt[1]);
                    const int q0 = __builtin_bit_cast(int, rt[4]) + (int)lcnt[16 + e0], q1 = __builtin_bit_cast(int, rt[5]) + (int)lcnt[16 + e1];
                    rt[4] = __builtin_bit_cast(float, q0); rt[5] = __builtin_bit_cast(float, q1);
                    ELIST[(size_t)e0 * NTOK + q0] = row; ELIST[(size_t)e1 * NTOK + q1] = row; }
            }
        } }
        SEAM(pb + 9);


        for (int rep_ = 0; rep_ <= (int)PH_REP(12); ++rep_) { if (rep_) GRID_BAR();
        if (PH_ON(12) && IN(pb + 11)) { PH_BEGIN(); const float* mv = modv + (size_t)l * 9 * 6144; (void)mv; unsigned* const moecnt = ctl + CW_MOE + l * 16 * 64; (void)moecnt;
            SchedMoeG S; S.G = X.G; S.c = X.bid; S.a0 = (const char*)XN; S.w0 = (const char*)WGU; S.wstep_e = (size_t)1024 * 1024 * 2; S.wstep_n = (size_t)256 * 1024 * 2; S.list = ELIST; S.init(moecnt, (LAS unsigned*)(lds + LDSCTL_OFF + 64));
            EpiMoe1 E{HID};
            pg8::gemm_phase<EpiMoe1, SchedMoeG, true, true>(lds, Gemm{1024, 1024, 1024}, S, E);
        } }
        SEAM(pb + 11);

        for (int rep_ = 0; rep_ <= (int)PH_REP(13); ++rep_) { if (rep_) GRID_BAR();
        if (PH_ON(13) && IN(pb + 12)) { PH_BEGIN(); const float* mv = modv + (size_t)l * 9 * 6144; (void)mv; unsigned* const moecnt = ctl + CW_MOE + l * 16 * 64; (void)moecnt;
            SchedMoe S; S.G = X.G; S.c = X.bid; S.a0 = (const char*)HID; S.w0 = (const char*)WDN; S.astep = (size_t)256 * 512 * 2; S.wstep_e = (size_t)1024 * 512 * 2; S.wstep_n = (size_t)256 * 512 * 2; S.init(moecnt);
            EpiBf16<0> E{MO, 1024, nullptr};
            pg8::gemm_phase<EpiBf16<0>, SchedMoe, true, true>(lds, Gemm{512, 512, 512}, S, E);
        } }
        SEAM(pb + 12);

        for (int rep_ = 0; rep_ <= (int)PH_REP(14); ++rep_) { if (rep_) GRID_BAR();
        if (PH_ON(14) && IN(pb + 13)) { PH_BEGIN(); const float* mv = modv + (size_t)l * 9 * 6144; (void)mv; unsigned* const moecnt = ctl + CW_MOE + l * 16 * 64; (void)moecnt;
            unsigned pre[16]; { unsigned s = 0;
#pragma unroll
                for (int e = 0; e < 16; ++e) { pre[e] = s; s += ((__hip_atomic_load(moecnt + 64 * e, __ATOMIC_RELAXED, __HIP_MEMORY_SCOPE_AGENT) + 255u) >> 8) << 8; } }
            const float* g2 = INP(I_LN2G) + l * 1024, *b2 = INP(I_LN2B) + l * 1024;
            for (int rowb = gw; rowb < nrows2; rowb += 3 * NGW) {
                int re0[3], re1[3], rp0[3], rp1[3]; float rw0[3], rw1[3];
#pragma unroll
                for (int k = 0; k < 3; ++k) { const int row_ = rowb + k * NGW, row = row_ < nrows2 ? row_ : nrows2 - 1; const float* rt = ROUTE + (size_t)row * 8;
                    re0[k] = __builtin_bit_cast(int, rt[0]); re1[k] = __builtin_bit_cast(int, rt[1]); rw0[k] = rt[2]; rw1[k] = rt[3]; rp0[k] = __builtin_bit_cast(int, rt[4]); rp1[k] = __builtin_bit_cast(int, rt[5]); }
                v2u ma[3][4], mb[3][4]; f32x4 hv[3][4];
#pragma unroll
                for (int k = 0; k < 3; ++k) { const int row_ = rowb + k * NGW, row = row_ < nrows2 ? row_ : nrows2 - 1; {
                    const int e0 = re0[k], e1 = re1[k]; unsigned ba0 = 0, ba1 = 0;
#pragma unroll
                    for (int q = 0; q < 16; ++q) { ba0 = (q == e0) ? pre[q] : ba0; ba1 = (q == e1) ? pre[q] : ba1; }
                    const bf16* m0 = MO + (size_t)(ba0 + (unsigned)rp0[k]) * D, *m1 = MO + (size_t)(ba1 + (unsigned)rp1[k]) * D;
                    const float* hrow = row < NLAT ? hlat + (size_t)row * D : hctx + (size_t)(row - NLAT) * D;
#pragma unroll
                    for (int j = 0; j < 4; ++j) { const int c = 4 * lane + 256 * j; ma[k][j] = *(const v2u*)(m0 + c); mb[k][j] = *(const v2u*)(m1 + c); hv[k][j] = *(const f32x4*)(hrow + c); } } }
#pragma unroll
                for (int k = 0; k < 3; ++k) { const int row_ = rowb + k * NGW, row = row_ < nrows2 ? row_ : nrows2 - 1; {
                    float* hrow = row < NLAT ? hlat + (size_t)row * D : hctx + (size_t)(row - NLAT) * D;
                    const int mi = row < NLAT ? (row >> 11) : 8; const float* mrow = mv + mi * 6144; const float w0 = rw0[k], w1 = rw1[k];
                    f32x4 v[4];
#pragma unroll
                    for (int j = 0; j < 4; ++j) { const int c = 4 * lane + 256 * j; const v2u a = ma[k][j], b = mb[k][j];
                        f32x4 mm; mm[0] = w0 * bflo(a.x) + w1 * bflo(b.x); mm[1] = w0 * bfhi(a.x) + w1 * bfhi(b.x); mm[2] = w0 * bflo(a.y) + w1 * bflo(b.y); mm[3] = w0 * bfhi(a.y) + w1 * bfhi(b.y);
                        v[j] = hv[k][j] * DN_ALPHA + *(const f32x4*)(mrow + 5120 + c) * mm; }
                    ln_rows(v);
                    if (row_ < nrows2) {
#pragma unroll
                    for (int j = 0; j < 4; ++j) { const int c = 4 * lane + 256 * j; *(f32x4*)(hrow + c) = v[j] * *(const f32x4*)(g2 + c) + *(const f32x4*)(b2 + c); } } } }
            }
        } }
        SEAM(pb + 13);
    }
#if TPROBE
    {
        GRID_BAR(); STAMP(NPHASES); GRID_BAR();
        unsigned* ts = (unsigned*)(args.ws + WS_CTL) + CW_TS; float T = 0.f;
        for (int l2 = 0; l2 < 2; ++l2) { const int p = (TPA) == 100 ? 0 : 1 + NPH_LAYER * l2 + (TPA);
            if ((TPA) != 100 || l2 == 0) T += (float)(__hip_atomic_load(ts + p + 1, __ATOMIC_RELAXED, __HIP_MEMORY_SCOPE_AGENT) - __hip_atomic_load(ts + p, __ATOMIC_RELAXED, __HIP_MEMORY_SCOPE_AGENT)) * 0.01f; }
        for (size_t i = (size_t)blockIdx.x * 512 + threadIdx.x; i < (size_t)NLAT * D; i += (size_t)gridDim.x * 512) { const int j = (int)(i >> 19);
            if (T >= (float)(TOFF) + 20.0f * (float)(j + 1)) args.out[i] += 0.2f; }
    }
#endif
#undef IN
#undef SEAM
}

extern "C" void kernel_launch(void* const* d_in, const int* in_sizes, int n_in, void* d_out, int out_size, void* d_ws, size_t ws_size, hipStream_t stream) {
    static int grid = 0;
    if (grid == 0) {
        if (n_in != 34 || out_size != NLAT * D || ws_size < WS_END) { fprintf(stderr, "kernel_launch: unexpected problem (n_in %d out %d ws %zu)\n", n_in, out_size, ws_size); grid = -1; return; }
        int dev = 0, cus = 0, per_cu = 0;
        if (hipGetDevice(&dev) != hipSuccess || hipDeviceGetAttribute(&cus, hipDeviceAttributeMultiprocessorCount, dev) != hipSuccess) { grid = -1; return; }
        if (hipFuncSetAttribute((const void*)fwd, hipFuncAttributeMaxDynamicSharedMemorySize, LDS_BYTES) != hipSuccess) { fprintf(stderr, "kernel_launch: hipFuncSetAttribute failed\n"); grid = -1; return; }
        if (hipOccupancyMaxActiveBlocksPerMultiprocessor(&per_cu, (const void*)fwd, NWAVES * 64, LDS_BYTES) != hipSuccess || per_cu < 1) { fprintf(stderr, "kernel_launch: occupancy query reports %d\n", per_cu); }
        (void)hipGetLastError();
        grid = cus;
    }
    if (grid < 0) return;
    if (hipMemsetAsync((char*)d_ws + WS_CTL, 0, CTL_ZERO_BYTES, stream) != hipSuccess) return;
    Args a{};
    for (int i = 0; i < 34; ++i) a.in[i] = (const float*)d_in[i];
    a.out = (float*)d_out; a.ws = (unsigned char*)d_ws;
#if MK_ONE_LAUNCH
    a.ph_lo = 0; a.ph_hi = NPHASES;
    hipLaunchKernelGGL(fwd, dim3(grid), dim3(NWAVES * 64), LDS_BYTES, stream, a);
#else
    for (int p = 0; p < NPHASES; ++p) { a.ph_lo = p; a.ph_hi = p + 1; hipLaunchKernelGGL(fwd, dim3(grid), dim3(NWAVES * 64), LDS_BYTES, stream, a); }
#endif
}
```

```cpp
#include <hip/hip_runtime.h>
#include <cstdio>
#include <cstdint>

#define GAS __attribute__((address_space(1)))
#define LAS __attribute__((address_space(3)))
typedef unsigned short bf16;
typedef unsigned v4u __attribute__((ext_vector_type(4)));
typedef unsigned v2u __attribute__((ext_vector_type(2)));
typedef float f32x4 __attribute__((ext_vector_type(4)));
typedef float f32x2 __attribute__((ext_vector_type(2)));
typedef short bf16x8 __attribute__((ext_vector_type(8)));

constexpr int D = 1024, NB = 8, SEQ = 2048, CTXL = 256, NLAT = NB * SEQ, NCTX = NB * CTXL, NTOK = NLAT + NCTX;
constexpr int OFF_Q = 0, OFF_K = 512, OFF_V = 1024, OFF_Z = 1536, OFF_A = 2048, OFF_B = 2056, OFF_CONF = 2064, OFF_FFT = 3088, OFF_SGU = 3600, OFF_GATE = 4624, N_IN = 8720;
constexpr int NWROWS = 9216;
constexpr float LN_EPS = 1e-6f;
constexpr float DN_ALPHA = 1.4142135623730951f;
constexpr int NWAVES = 8;
constexpr int NPH_LAYER = 14, NPHASES = 1 + 2 * NPH_LAYER;

#ifndef PHMASK
#define PHMASK 0xFFFFFFFFu
#endif
#define PH_ON(k) (((PHMASK) >> (k)) & 1u)
#ifndef REPMASK
#define REPMASK 0u
#endif
#define PH_REP(k) (((REPMASK) >> (k)) & 1u)
#ifndef TPA
#define TPA -1
#endif
#ifndef TPB
#define TPB -1
#endif
#ifndef TOFF
#define TOFF 0
#endif
#define TPROBE ((TPA) >= 0 || (TPB) >= 0)
#ifndef CPART
#define CPART 15
#endif
#ifndef MK_ONE_LAUNCH
#define MK_ONE_LAUNCH 1
#endif

constexpr size_t MiB = 1u << 20;
constexpr size_t WS_CTL = 0, CTL_ZERO_BYTES = 128 * 1024;
constexpr size_t WS_MODV = 1 * MiB;
constexpr size_t WS_BIN = 1 * MiB + 512 * 1024;
constexpr size_t WS_ROUTE = WS_BIN + 64 * 1024;
constexpr size_t WS_HCTX = 3 * MiB;
constexpr size_t WS_XN = 11 * MiB;
constexpr size_t WS_WIN = 47 * MiB;
constexpr size_t WS_WBR = 65 * MiB;
constexpr size_t WS_WOUT = 69 * MiB;
constexpr size_t WS_DFTL = 71 * MiB;
constexpr size_t WS_DFTC = 87 * MiB;
constexpr size_t WS_F1B = 71 * MiB;
constexpr size_t WS_R2 = 88 * MiB;
constexpr size_t WS_PQKV = WS_R2;
constexpr size_t WS_PCONF = WS_R2 + 54 * MiB;
constexpr size_t WS_PZ = WS_R2 + 72 * MiB;
constexpr size_t WS_PSGU = WS_R2 + 90 * MiB;
constexpr size_t WS_PFFT = WS_R2 + 126 * MiB;
constexpr size_t WS_PFFTC = WS_R2 + 158 * MiB;
constexpr size_t WS_AB = WS_R2 + 162 * MiB;
constexpr size_t WS_WIT = WS_R2;
constexpr size_t WS_UIT = WS_R2 + 36 * MiB;
constexpr size_t WS_AIT = WS_R2 + 90 * MiB;
constexpr size_t WS_KIT = WS_R2 + 108 * MiB;
constexpr size_t WS_SIT = WS_R2 + 126 * MiB;
constexpr size_t WS_OF = WS_R2 + 128 * MiB;
constexpr size_t WS_OB = WS_R2 + 146 * MiB;
constexpr size_t WS_G = WS_R2;
constexpr size_t WS_WGU = WS_R2;
constexpr size_t WS_WDN = WS_R2 + 32 * MiB;
constexpr size_t WS_XG = WS_R2 + 48 * MiB;
constexpr size_t WS_R3 = WS_R2 + 164 * MiB;
constexpr size_t WS_QKV = WS_R3;
constexpr size_t WS_GB = WS_R3 + 54 * MiB;
constexpr size_t WS_BR = WS_R3 + 72 * MiB;
constexpr size_t WS_F1A = WS_BR;
constexpr size_t WS_MERGED = WS_R3;
constexpr size_t WS_Y = WS_R3 + 72 * MiB;
constexpr size_t WS_HID = WS_R3;
constexpr size_t WS_MO = WS_R3 + 40 * MiB;
constexpr size_t WS_LIST = WS_R3 + 144 * MiB;
constexpr size_t WS_END = WS_LIST + 2 * MiB;
static_assert(WS_END <= 405 * MiB, "workspace map");
constexpr int CW_BAR = 4096;
constexpr int CW_MOE = 16384;

constexpr int RING_BYTES = 131072;
constexpr int LDSCTL_OFF = RING_BYTES, MISC_OFF = LDSCTL_OFF + 320;
constexpr int LDS_BYTES = 147456;

#define LDS_WAIT() asm volatile("s_waitcnt lgkmcnt(0)" ::: "memory")
#define VM_WAIT() asm volatile("s_waitcnt vmcnt(0)" ::: "memory")
typedef __bf16 bf16x2_t __attribute__((ext_vector_type(2)));
__device__ __forceinline__ unsigned pk2(float lo, float hi) { const f32x2 v = {lo, hi}; const bf16x2_t b = __builtin_convertvector(v, bf16x2_t); return __builtin_bit_cast(unsigned, b); }
__device__ __forceinline__ unsigned f2bf(float f) { return pk2(f, 0.0f) & 0xffffu; }
__device__ __forceinline__ float bflo(unsigned w) { return __builtin_bit_cast(float, w << 16); }
__device__ __forceinline__ float bfhi(unsigned w) { return __builtin_bit_cast(float, w & 0xffff0000u); }
__device__ __forceinline__ float bf1(bf16 b) { return __builtin_bit_cast(float, ((unsigned)b) << 16); }
__device__ __forceinline__ void unpack8(const v4u w, float (&o)[8]) { o[0] = bflo(w.x); o[1] = bfhi(w.x); o[2] = bflo(w.y); o[3] = bfhi(w.y); o[4] = bflo(w.z); o[5] = bfhi(w.z); o[6] = bflo(w.w); o[7] = bfhi(w.w); }
__device__ __forceinline__ v4u pack8(const float (&o)[8]) { v4u w; w.x = pk2(o[0], o[1]); w.y = pk2(o[2], o[3]); w.z = pk2(o[4], o[5]); w.w = pk2(o[6], o[7]); return w; }
__device__ __forceinline__ void fsincospi(float x, float* sn, float* cs) { *sn = __builtin_amdgcn_sinf(0.5f * x); *cs = __builtin_amdgcn_cosf(0.5f * x); }
__device__ __forceinline__ float sigmoidf_(float x) { return __builtin_amdgcn_rcpf(1.0f + __expf(-x)); }
__device__ __forceinline__ float siluf_(float x) { return x * __builtin_amdgcn_rcpf(1.0f + __expf(-x)); }
__device__ __forceinline__ float gelu_tanh(float x) { const float u = 0.7978845608028654f * (x + 0.044715f * x * x * x); return x * __builtin_amdgcn_rcpf(1.0f + __expf(-2.0f * u)); }
__device__ __forceinline__ float wave_sum(float v) {
#pragma unroll
    for (int o = 1; o < 64; o <<= 1) v += __shfl_xor(v, o);
    return v;
}
__device__ __forceinline__ float reduce16(const float (&v)[16], int lane) {
    const bool b5 = (lane & 32) != 0, b4 = (lane & 16) != 0, b3 = (lane & 8) != 0, b2 = (lane & 4) != 0;
    float a[8], b[4], c[2];
#pragma unroll
    for (int i = 0; i < 8; ++i) a[i] = (b5 ? v[i + 8] : v[i]) + __shfl_xor(b5 ? v[i] : v[i + 8], 32);
#pragma unroll
    for (int i = 0; i < 4; ++i) b[i] = (b4 ? a[i + 4] : a[i]) + __shfl_xor(b4 ? a[i] : a[i + 4], 16);
#pragma unroll
    for (int i = 0; i < 2; ++i) c[i] = (b3 ? b[i + 2] : b[i]) + __shfl_xor(b3 ? b[i] : b[i + 2], 8);
    float d = (b2 ? c[1] : c[0]) + __shfl_xor(b2 ? c[0] : c[1], 4);
    d += __shfl_xor(d, 2); d += __shfl_xor(d, 1);
    return d;
}
__device__ __forceinline__ float reduce4(const float (&v)[4], int lane) {
    const bool b5 = (lane & 32) != 0, b4 = (lane & 16) != 0; float a[2];
#pragma unroll
    for (int i = 0; i < 2; ++i) a[i] = (b5 ? v[i + 2] : v[i]) + __shfl_xor(b5 ? v[i] : v[i + 2], 32);
    float d = (b4 ? a[1] : a[0]) + __shfl_xor(b4 ? a[0] : a[1], 16);
    d += __shfl_xor(d, 8); d += __shfl_xor(d, 4); d += __shfl_xor(d, 2); d += __shfl_xor(d, 1);
    return d;
}
__device__ __forceinline__ float g16_sum(float v) {
#pragma unroll
    for (int o = 1; o < 16; o <<= 1) v += __shfl_xor(v, o);
    return v;
}

namespace pg8 {
constexpr int BM = 256, BK = 64, HALF = 128, HTB = HALF * BK * 2, STAGE_BYTES = 8 * HTB;
__host__ __device__ __forceinline__ int lds_byte(int r, int c) { const int st = (r >> 4) * 2 + (c >> 5), rr = r & 15, cc = c & 31, ob = rr * 64 + cc * 2; return st * 1024 + (ob ^ (((ob >> 9) & 1) << 5)); }
__host__ __device__ __forceinline__ void stage_rc(int b, int& R, int& C) { const int st = b / 1024, sb = b % 1024, swz = sb ^ (((sb >> 9) & 1) << 5); R = (st >> 1) * 16 + swz / 64; C = (st & 1) * 32 + (swz % 64) / 2; }
__host__ __device__ __forceinline__ int perm32(int rho) { const int n = rho >> 4, i = rho & 15; return 8 * (i >> 2) + 4 * n + (i & 3); }

struct Unit { int pm, pn, aux, ax2; const char* a; const char* b; };
struct Gemm { int K, lda, ldb; };

__device__ __forceinline__ void map_tile(int L, int nM, int nN, int& pm, int& pn) {
    const int nwg = nM * nN; int wgid = L; { const int q = nwg / 8, r = nwg % 8, xcd = wgid % 8, off = wgid / 8; wgid = (xcd < r ? xcd * (q + 1) : r * (q + 1) + (xcd - r) * q) + off; }
    const int nig = 8 * nN, gid = wgid / nig, fm = gid * 8, gsz = (nM - fm) < 8 ? (nM - fm) : 8;
    pm = fm + ((wgid % nig) % gsz); pn = (wgid % nig) / gsz;
}
__device__ __forceinline__ unsigned cvt_pk_bf16(float lo, float hi) { unsigned r; asm volatile("v_cvt_pk_bf16_f32 %0, %1, %2" : "=v"(r) : "v"(lo), "v"(hi)); return r; }

template <class Epi, class Sched, bool ALIGN_EPI, bool SP2>
__device__ __forceinline__ void gemm_phase(LAS unsigned char* lds, const Gemm g, const Sched& S, const Epi& E) {
    int tid_l = threadIdx.x; asm volatile("" : "+v"(tid_l));
    const int tid = tid_l, wid = __builtin_amdgcn_readfirstlane(tid >> 6), lane = tid & 63, wr = wid >> 2, wc = wid & 3, fr = lane & 15, fq = lane >> 4;
    const int K = g.K, nt = K / BK;
    unsigned voffA[2], voffB[2];
#pragma unroll
    for (int i = 0; i < 2; ++i) { int R, C; stage_rc(tid * 16 + i * 8192, R, C); const int Rb = Epi::PERM ? ((R & ~31) + perm32(R & 31)) : R;
        voffA[i] = (unsigned)(R * g.lda + C) * 2u; voffB[i] = (unsigned)(Rb * g.ldb + C) * 2u; }
    static_assert(!Sched::GATHER || SP2, "gathered A rows: only the SP2 loop");
    unsigned vA[2][2], vAn[2][2];
#define PG8_GCALC(dst, u_) do { _Pragma("unroll") for (int i_ = 0; i_ < 2; ++i_) { int R_, C_; stage_rc(tid * 16 + i_ * 8192, R_, C_); _Pragma("unroll") for (int h_ = 0; h_ < 2; ++h_) dst[h_][i_] = S.arow(u_, R_ + 128 * h_) + (unsigned)C_ * 2u; } } while (0)
#define PG8_STAGE_A(bufoff, base, h, nextsel) do { if constexpr (Sched::GATHER) { unsigned vs_[2]; vs_[0] = (nextsel) ? vAn[h][0] : vA[h][0]; vs_[1] = (nextsel) ? vAn[h][1] : vA[h][1]; PG8_STAGE(bufoff, base, vs_); } \
        else { PG8_STAGE(bufoff, (base) + (h) * hstepA, voffA); } } while (0)
    const size_t kstep = (size_t)(BK * 2);
    const size_t hstepA = (size_t)HALF * g.lda * 2, hstepB = (size_t)HALF * g.ldb * 2;
    const unsigned ldsw = (unsigned)wid * 1024u;
    const int aoff = lds_byte(wr * 64 + fr, fq * 8), boff = lds_byte(wc * 32 + fr, fq * 8);
#define PG8_SA(b, h) (((b) * 2 + (h)) * HTB)
#define PG8_SB(b, h) ((4 + (b) * 2 + (h)) * HTB)
#define PG8_STAGE(bufoff, gbase, voff) do { _Pragma("unroll") for (int _i = 0; _i < 2; ++_i) \
        __builtin_amdgcn_global_load_lds((const unsigned*)((const char*)(gbase) + (voff)[_i]), (LAS unsigned*)(lds + (bufoff) + ldsw + _i * 8192), 16, 0, 0); } while (0)
#define PG8_LDA(dst, b, h) do { _Pragma("unroll") for (int m = 0; m < 4; ++m) _Pragma("unroll") for (int k = 0; k < 2; ++k) dst[m][k] = *(const LAS bf16x8*)(lds + PG8_SA(b, h) + aoff + m * 2048 + k * 1024); } while (0)
#define PG8_LDB(dst, b, h) do { _Pragma("unroll") for (int n = 0; n < 2; ++n) _Pragma("unroll") for (int k = 0; k < 2; ++k) dst[n][k] = *(const LAS bf16x8*)(lds + PG8_SB(b, h) + boff + n * 2048 + k * 1024); } while (0)
#define PG8_MMA(ai, bj, At, Bt) do { __builtin_amdgcn_s_setprio(1); _Pragma("unroll") for (int m = 0; m < 4; ++m) _Pragma("unroll") for (int n = 0; n < 2; ++n) _Pragma("unroll") for (int k = 0; k < 2; ++k) \
        acc[ai][bj][m][n] = __builtin_amdgcn_mfma_f32_16x16x32_bf16(Bt[n][k], At[m][k], acc[ai][bj][m][n], 0, 0, 0); __builtin_amdgcn_s_setprio(0); } while (0)
#define PG8_WAIT_V(n) asm volatile("s_waitcnt vmcnt(" #n ")" ::: "memory")
#define PG8_WAIT_L(n) asm volatile("s_waitcnt lgkmcnt(" #n ")" ::: "memory")
#define PG8_BAR __builtin_amdgcn_s_barrier()
#define PG8_SCHED __builtin_amdgcn_sched_barrier(0)
    Unit cur, nxt; int ui = 0;
    if (!S.next(0, cur)) return;
    f32x4 acc[2][2][4][2];
#pragma unroll
    for (int a = 0; a < 2; ++a)
#pragma unroll
        for (int b = 0; b < 2; ++b)
#pragma unroll
            for (int m = 0; m < 4; ++m)
#pragma unroll
                for (int n = 0; n < 2; ++n) acc[a][b][m][n] = (f32x4){0.f, 0.f, 0.f, 0.f};
    bf16x8 At[4][2], B0[2][2], B1[2][2];
    const char* cA = cur.a; const char* cB = cur.b;
    if constexpr (SP2) {
        if constexpr (Sched::GATHER) { PG8_GCALC(vA, cur); }
        PG8_STAGE(PG8_SB(0, 0), cB, voffB); PG8_STAGE(PG8_SB(0, 1), cB + hstepB, voffB); PG8_STAGE_A(PG8_SA(0, 0), cA, 0, false); PG8_STAGE_A(PG8_SA(0, 1), cA, 1, false);
        if (wr == 1) PG8_BAR;
        PG8_WAIT_V(2); PG8_BAR;
        PG8_STAGE(PG8_SB(1, 0), cB + kstep, voffB); PG8_STAGE_A(PG8_SA(1, 0), cA + kstep, 0, false); PG8_STAGE(PG8_SB(1, 1), cB + hstepB + kstep, voffB);
        PG8_WAIT_V(6); PG8_BAR;
    } else {
        PG8_STAGE(PG8_SB(0, 0), cB, voffB); PG8_STAGE(PG8_SA(0, 0), cA, voffA); PG8_STAGE(PG8_SB(0, 1), cB + hstepB, voffB); PG8_STAGE(PG8_SA(0, 1), cA + hstepA, voffA);
        if (wr == 1) PG8_BAR;
        PG8_WAIT_V(4); PG8_BAR;
        PG8_STAGE(PG8_SB(1, 0), cB + kstep, voffB); PG8_STAGE(PG8_SA(1, 0), cA + kstep, voffA); PG8_STAGE(PG8_SB(1, 1), cB + hstepB + kstep, voffB);
        PG8_WAIT_V(6); PG8_BAR;
    }
    for (;;) {
        const bool has_next = S.next(ui + 1, nxt);
        const char* nA = has_next ? nxt.a : cA; const char* nB = has_next ? nxt.b : cB;
        if constexpr (Sched::GATHER) { if (has_next) { PG8_GCALC(vAn, nxt); } else {
#pragma unroll
            for (int h_ = 0; h_ < 2; ++h_)
#pragma unroll
                for (int i_ = 0; i_ < 2; ++i_) vAn[h_][i_] = vA[h_][i_]; } }
        for (int t = 0; t < nt; t += 2) {
            const bool last = (t == nt - 2);
            const char* a1 = cA + (size_t)(t + 1) * kstep;
            const char* a2 = last ? nA : cA + (size_t)(t + 2) * kstep; const char* b2 = last ? nB : cB + (size_t)(t + 2) * kstep;
            const char* a3 = a2 + kstep; const char* b3 = b2 + kstep;
            if constexpr (SP2) {
            PG8_LDB(B0, 0, 0); PG8_LDB(B1, 0, 1); PG8_SCHED; PG8_LDA(At, 0, 0); PG8_STAGE_A(PG8_SA(1, 1), a1, 1, false);
            PG8_WAIT_V(8); PG8_WAIT_L(0); PG8_BAR; PG8_MMA(0, 0, At, B0); PG8_MMA(0, 1, At, B1); PG8_BAR; PG8_SCHED;
            PG8_LDA(At, 0, 1); PG8_STAGE(PG8_SB(0, 0), b2, voffB); PG8_STAGE(PG8_SB(0, 1), b2 + hstepB, voffB); PG8_STAGE_A(PG8_SA(0, 0), a2, 0, last);
            PG8_WAIT_V(8); PG8_WAIT_L(0); PG8_BAR; PG8_MMA(1, 0, At, B0); PG8_MMA(1, 1, At, B1); PG8_BAR; PG8_SCHED;
            PG8_LDB(B0, 1, 0); PG8_LDB(B1, 1, 1); PG8_SCHED; PG8_LDA(At, 1, 0); PG8_STAGE_A(PG8_SA(0, 1), a2, 1, last);
            PG8_WAIT_V(8); PG8_WAIT_L(0); PG8_BAR; PG8_MMA(0, 0, At, B0); PG8_MMA(0, 1, At, B1); PG8_BAR; PG8_SCHED;
            PG8_LDA(At, 1, 1); PG8_STAGE(PG8_SB(1, 0), b3, voffB); PG8_STAGE(PG8_SB(1, 1), b3 + hstepB, voffB); PG8_STAGE_A(PG8_SA(1, 0), a3, 0, last);
            PG8_WAIT_V(8); PG8_WAIT_L(0); PG8_BAR; PG8_MMA(1, 0, At, B0); PG8_MMA(1, 1, At, B1); PG8_BAR; PG8_SCHED;
            } else {
            PG8_LDB(B0, 0, 0); PG8_SCHED; PG8_LDA(At, 0, 0); PG8_STAGE(PG8_SA(1, 1), a1 + hstepA, voffA);
            PG8_WAIT_L(8); PG8_BAR; PG8_WAIT_L(0); PG8_MMA(0, 0, At, B0); PG8_BAR; PG8_SCHED;
            PG8_LDB(B1, 0, 1); PG8_STAGE(PG8_SB(0, 0), b2, voffB);
            PG8_BAR; PG8_WAIT_L(0); PG8_MMA(0, 1, At, B1); PG8_BAR;
            PG8_LDA(At, 0, 1); PG8_STAGE(PG8_SA(0, 0), a2, voffA);
            PG8_BAR; PG8_WAIT_L(0); PG8_MMA(1, 0, At, B0); PG8_BAR; PG8_SCHED;
            PG8_STAGE(PG8_SB(0, 1), b2 + hstepB, voffB);
            PG8_WAIT_V(6); PG8_BAR; PG8_MMA(1, 1, At, B1); PG8_BAR;
            PG8_LDB(B0, 1, 0); PG8_SCHED; PG8_LDA(At, 1, 0); PG8_STAGE(PG8_SA(0, 1), a2 + hstepA, voffA);
            PG8_WAIT_L(8); PG8_BAR; PG8_WAIT_L(0); PG8_MMA(0, 0, At, B0); PG8_BAR; PG8_SCHED;
            PG8_LDB(B1, 1, 1); PG8_STAGE(PG8_SB(1, 0), b3, voffB);
            PG8_BAR; PG8_WAIT_L(0); PG8_MMA(0, 1, At, B1); PG8_BAR;
            PG8_LDA(At, 1, 1); PG8_STAGE(PG8_SA(1, 0), a3, voffA);
            PG8_BAR; PG8_WAIT_L(0); PG8_MMA(1, 0, At, B0); PG8_BAR; PG8_SCHED;
            PG8_STAGE(PG8_SB(1, 1), b3 + hstepB, voffB);
            PG8_WAIT_V(6); PG8_BAR; PG8_MMA(1, 1, At, B1); PG8_BAR;
            }
        }
        if constexpr (ALIGN_EPI) { if (wr == 0) PG8_BAR; }
        E(acc, cur, wr, wc, fr, fq);
        if (!has_next) break;
#pragma unroll
        for (int a = 0; a < 2; ++a)
#pragma unroll
            for (int b = 0; b < 2; ++b)
#pragma unroll
                for (int m = 0; m < 4; ++m)
#pragma unroll
                    for (int n = 0; n < 2; ++n) acc[a][b][m][n] = (f32x4){0.f, 0.f, 0.f, 0.f};
        cur = nxt; cA = nA; cB = nB; ++ui;
        if constexpr (Sched::GATHER) {
#pragma unroll
            for (int h_ = 0; h_ < 2; ++h_)
#pragma unroll
                for (int i_ = 0; i_ < 2; ++i_) vA[h_][i_] = vAn[h_][i_]; }
        if constexpr (ALIGN_EPI) { if (wr == 1) PG8_BAR; }
    }
    PG8_WAIT_V(0);
    if constexpr (!ALIGN_EPI) { if (wr == 0) PG8_BAR; }
    PG8_BAR;
#undef PG8_SA
#undef PG8_SB
#undef PG8_STAGE
#undef PG8_STAGE_A
#undef PG8_GCALC
#undef PG8_LDA
#undef PG8_LDB
#undef PG8_MMA
#undef PG8_WAIT_V
#undef PG8_WAIT_L
#undef PG8_BAR
#undef PG8_SCHED
}
}
using pg8::Unit;
using pg8::Gemm;
typedef f32x4 AccT[2][2][4][2];

#define XB_TMO      128
#define XB_XCNT(j)  (256  + 64 * (j))
#define XB_XSUB(j)  (1280 + 64 * (j))
#define XB_XGEN(j)  (2304 + 64 * (j))
#define XB_TOP      3328
#define XB_TOPGEN   3392
#define XCD_BAR_WORDS 3456
#define XB_SPIN_CAP (1u << 18)
__device__ __forceinline__ unsigned xb_ld(unsigned* p)              { return __hip_atomic_load(p, __ATOMIC_RELAXED, __HIP_MEMORY_SCOPE_AGENT); }
__device__ __forceinline__ unsigned xb_add(unsigned* p, unsigned v) { return __hip_atomic_fetch_add(p, v, __ATOMIC_RELAXED, __HIP_MEMORY_SCOPE_AGENT); }
__device__ __forceinline__ unsigned xb_xcc_id() { return (unsigned)__builtin_amdgcn_s_getreg((3 << 11) | 20) & 0xFu; }
#define XB_SPIN(cond, bar) do { unsigned _sp = 0; while (cond) { __builtin_amdgcn_s_sleep(1); \
    if ((++_sp & 255u) == 0u) { if (xb_ld(&(bar)[XB_TMO])) break; if (_sp > XB_SPIN_CAP) { atomicAdd(&(bar)[XB_TMO], 1u); break; } } } } while (0)
struct XcdBarrier { unsigned* bar; unsigned x; volatile LAS unsigned* st; };
__device__ __forceinline__ XcdBarrier xcd_barrier_post(unsigned* bar, volatile LAS unsigned* st) {
    XcdBarrier b; b.bar = bar; b.x = xb_xcc_id(); b.st = st;
    if (threadIdx.x == 0) (void)xb_add(&bar[XB_XCNT(b.x)], 1u);
    return b;
}
__device__ __forceinline__ void xcd_barrier_complete(unsigned* bar, unsigned x, unsigned& nloc, unsigned& nx) {
    const unsigned G = gridDim.x * gridDim.y * gridDim.z;
    unsigned sum, cnt, mine, sp = 0u;
    for (;;) {
        sum = 0u; cnt = 0u; mine = 0u;
#pragma unroll
        for (unsigned j = 0; j < 16; ++j) { const unsigned c = xb_ld(&bar[XB_XCNT(j)]); sum += c; cnt += (c > 0u) ? 1u : 0u; mine = (j == x) ? c : mine; }
        if (sum == G) break;
        __builtin_amdgcn_s_sleep(1);
        if ((++sp & 255u) == 0u) { if (xb_ld(&bar[XB_TMO])) break; if (sp > XB_SPIN_CAP) { atomicAdd(&bar[XB_TMO], 1u); break; } }
    }
    nloc = mine > 0u ? mine : 1u; nx = cnt > 0u ? cnt : 1u;
}
__device__ __forceinline__ void xcd_barrier(const XcdBarrier& b) {
    asm volatile("s_waitcnt vmcnt(0)" ::: "memory");
    __syncthreads();
    if (threadIdx.x == 0) {
        unsigned* bar = b.bar;
        __builtin_amdgcn_s_waitcnt(0);
        unsigned nloc = b.st[0], nx = b.st[1];
        if (nloc == 0u) { xcd_barrier_complete(bar, b.x, nloc, nx); b.st[0] = nloc; b.st[1] = nx; }
        const unsigned old = xb_add(&bar[XB_XSUB(b.x)], 1u);
        const unsigned gen = old / nloc;
        if (old + 1u == (gen + 1u) * nloc) {
            __builtin_amdgcn_fence(__ATOMIC_RELEASE, "agent");
            asm volatile("s_waitcnt vmcnt(0)" ::: "memory");
            const unsigned og = xb_add(&bar[XB_TOP], 1u);
            const unsigned tg = og / nx;
            if (og + 1u == (tg + 1u) * nx) xb_add(&bar[XB_TOPGEN], 1u);
            else XB_SPIN(xb_ld(&bar[XB_TOPGEN]) == tg, bar);
            __builtin_amdgcn_fence(__ATOMIC_ACQUIRE, "agent");
            xb_add(&bar[XB_XGEN(b.x)], 1u);
            asm volatile("s_waitcnt vmcnt(0)" ::: "memory");
        } else {
            XB_SPIN(xb_ld(&bar[XB_XGEN(b.x)]) == gen, bar);
            __builtin_amdgcn_fence(__ATOMIC_ACQUIRE, "agent");
            asm volatile("s_waitcnt vmcnt(0)" ::: "memory");
        }
    }
    __syncthreads();
}

struct Args { const float* in[34]; float* out; unsigned char* ws; int ph_lo, ph_hi; };
enum { I_X = 0, I_C, I_CTX, I_CCTX, I_WMOD, I_BMOD, I_WIN, I_BIN, I_GCONV, I_GALOG, I_GDT, I_GNORM, I_CDWW, I_CDWB, I_CLNG, I_CLNB, I_SLNG, I_SLNB, I_SWS, I_SBS,
       I_WBR, I_WOUT, I_BOUT, I_LN1G, I_LN1B, I_LN2G, I_LN2B, I_RGW, I_RGB, I_REW, I_REB, I_EWG, I_EWU, I_EWD };

__device__ __forceinline__ int xcd_chunk(int L, int U) { const int q = U >> 3, r = U & 7, x = L & 7, off = L >> 3; return (x < r ? x * (q + 1) : r * (q + 1) + (x - r) * q) + off; }
struct SchedInA {
    static constexpr bool GATHER = false;
    int G, c; const char* xn; const char* w;
    __device__ __forceinline__ bool next(int i, Unit& u) const {
        const int L = i * G + c; const size_t tstep = (size_t)256 * 1024 * 2;
        if (L < 1152) { int pm, pn; pg8::map_tile(L, 72, 16, pm, pn); u.pm = pm; u.pn = pn; u.aux = 0; u.a = xn + (size_t)pm * tstep; u.b = w + (size_t)pn * tstep; return true; }
        if (L < 1440) { const int q = xcd_chunk(L - 1152, 288), pm = 16 + (q & 3), pn = q >> 2;        u.pm = pm; u.pn = pn; u.aux = 1; u.a = w + (size_t)pm * tstep; u.b = xn + (size_t)pn * tstep; return true; }
        return false;
    }
};
struct SchedGrid {
    static constexpr bool GATHER = false;
    int G, c, nM, nN; const char* a0; const char* b0; size_t astep, bstep;
    __device__ __forceinline__ bool next(int i, Unit& u) const {
        const int L = i * G + c; if (L >= nM * nN) return false;
        int pm, pn; pg8::map_tile(L, nM, nN, pm, pn); u.pm = pm; u.pn = pn; u.aux = 0; u.a = a0 + (size_t)pm * astep; u.b = b0 + (size_t)pn * bstep; return true;
    }
};
struct SchedFftLat {
    static constexpr bool GATHER = false;
    int G, c; const char* dft; const char* pf;
    __device__ __forceinline__ bool next(int i, Unit& u) const {
        const int L = i * G + c; if (L >= 128) return false;
        const int b = L >> 4, kt = (L >> 1) & 7, pn = L & 1;
        u.pm = b * 8 + kt; u.pn = pn; u.aux = 0; u.a = dft + (size_t)kt * (256 * 4096 * 2); u.b = pf + (size_t)b * (512 * 4096 * 2) + (size_t)pn * (256 * 4096 * 2); return true;
    }
};
struct SchedFftCtx {
    static constexpr bool GATHER = false;
    int G, c; const char* dft; const char* pf;
    __device__ __forceinline__ bool next(int i, Unit& u) const {
        const int L = i * G + (G - 1 - c); if (L >= 16) return false;
        const int b = L >> 1, pn = L & 1;
        u.pm = 64 + b; u.pn = pn; u.aux = 0; u.a = dft; u.b = pf + (size_t)b * (512 * 512 * 2) + (size_t)pn * (256 * 512 * 2); return true;
    }
};
struct SchedBranch {
    static constexpr bool GATHER = false;
    int G, c, nM; const char* br; const char* wbr;
    __device__ __forceinline__ bool next(int j, Unit& u) const {
        const int L = j * G + c; if (L >= nM * 16) return false;
        int pm, pn; pg8::map_tile(L, nM, 16, pm, pn);
        u.pm = pm; u.pn = pn; u.aux = 0; u.a = br + (size_t)(pn >> 2) * ((size_t)NTOK * 512 * 2) + (size_t)pm * (256 * 512 * 2); u.b = wbr + (size_t)pn * (256 * 512 * 2); return true;
    }
};
struct SchedMoe {
    static constexpr bool GATHER = false;
    int G, c; unsigned pre[17]; const char* a0; const char* w0; size_t astep, wstep_e, wstep_n;
    __device__ __forceinline__ void init(const unsigned* cnt  ) {
        unsigned s = 0;
#pragma unroll
        for (int e = 0; e < 16; ++e) { pre[e] = s; s += ((unsigned)__builtin_amdgcn_readfirstlane((int)__hip_atomic_load(cnt + 64 * e, __ATOMIC_RELAXED, __HIP_MEMORY_SCOPE_AGENT)) + 255u) >> 8; }
        pre[16] = s;
    }
    __device__ __forceinline__ bool next(int i, Unit& u) const {
        const int L = i * G + c; if (L >= (int)pre[16] * 4) return false;
        const int jt = L >> 2, pn = L & 3; int e = 0;
#pragma unroll
        for (int k = 1; k < 16; ++k) e += ((unsigned)jt >= pre[k]) ? 1 : 0;
        u.pm = jt; u.pn = pn; u.aux = e; u.a = a0 + (size_t)jt * astep; u.b = w0 + (size_t)e * wstep_e + (size_t)pn * wstep_n; return true;
    }
};

struct SchedMoeG {
    static constexpr bool GATHER = true;
    int G, c; const LAS unsigned* pre; const char* a0; const char* w0; size_t wstep_e, wstep_n; const int* list; const unsigned* cnt;
    __device__ __forceinline__ void init(const unsigned* cnt_  , LAS unsigned* pre_) { cnt = cnt_; pre = pre_;
        if (threadIdx.x < 16) pre_[17 + threadIdx.x] = __hip_atomic_load(cnt_ + 64 * threadIdx.x, __ATOMIC_RELAXED, __HIP_MEMORY_SCOPE_AGENT);
        __syncthreads();
        if (threadIdx.x == 0) { unsigned s = 0;
            for (int e = 0; e < 16; ++e) { pre_[e] = s; s += (pre_[17 + e] + 255u) >> 8; }
            pre_[16] = s; }
        __syncthreads();
    }
    __device__ __forceinline__ bool next(int i, Unit& u) const {
        const int L = i * G + c; if (L >= (int)pre[16] * 4) return false;
        const int jt = L >> 2, pn = L & 3; int e = 0; unsigned pe = 0;
#pragma unroll
        for (int k = 1; k < 16; ++k) { const unsigned pk = pre[k]; const bool ge = (unsigned)jt >= pk; e += ge ? 1 : 0; pe = ge ? pk : pe; }
        e = __builtin_amdgcn_readfirstlane(e); pe = (unsigned)__builtin_amdgcn_readfirstlane((int)pe);
        u.pm = jt; u.pn = pn; u.aux = e; u.ax2 = (jt - (int)pe) * 256; u.a = a0; u.b = w0 + (size_t)e * wstep_e + (size_t)pn * wstep_n; return true;
    }
    __device__ __forceinline__ unsigned arow(const Unit& u, int r) const {
        const unsigned n = pre[17 + u.aux]; const unsigned pos = (unsigned)(u.ax2 + r);
        const int tok = pos < n ? list[(size_t)u.aux * NTOK + pos] : 0; return (unsigned)tok * 2048u;
    }
};

struct EpiInA {
    static constexpr bool PERM = true;
    bf16 *pqkv, *pz, *pconf, *psgu, *pfft, *pfftc; const float* bias;
    __device__ __forceinline__ void operator()(const AccT& acc, const Unit& u, int wr, int wc, int fr, int fq) const {
        if (u.aux == 0) {
            const int row0 = u.pm * 256 + wr * 64 + fr, cb = wc * 32 + 8 * fq, bcol0 = u.pn * 256 + cb;
            f32x4 bv[2][2];
#pragma unroll
            for (int bj = 0; bj < 2; ++bj)
#pragma unroll
                for (int n = 0; n < 2; ++n) bv[bj][n] = *(const f32x4*)(bias + bcol0 + bj * 128 + 4 * n);
            if (u.pn < 8) {
                const bool isz = u.pn >= 6;
#pragma unroll
                for (int ai = 0; ai < 2; ++ai)
#pragma unroll
                    for (int m = 0; m < 4; ++m) { const int row = row0 + ai * 128 + m * 16;
                        bf16* rowp = isz ? (pz + (size_t)row * 512 + (u.pn - 6) * 256 + cb) : (pqkv + (size_t)row * 1536 + u.pn * 256 + cb);
#pragma unroll
                        for (int bj = 0; bj < 2; ++bj) { f32x4 v0 = acc[ai][bj][m][0] + bv[bj][0], v1 = acc[ai][bj][m][1] + bv[bj][1];
                            if (isz) {
#pragma unroll
                                for (int j = 0; j < 4; ++j) { v0[j] = siluf_(v0[j]); v1[j] = siluf_(v1[j]); } }
                            v4u w; w.x = pk2(v0[0], v0[1]); w.y = pk2(v0[2], v0[3]); w.z = pk2(v1[0], v1[1]); w.w = pk2(v1[2], v1[3]);
                            *(v4u*)(rowp + bj * 128) = w; } }
            } else if (u.pn < 12) {
#pragma unroll
                for (int ai = 0; ai < 2; ++ai)
#pragma unroll
                    for (int m = 0; m < 4; ++m) { const int row = row0 + ai * 128 + m * 16;
                        const f32x4 a0 = acc[ai][0][m][0] + bv[0][0], a1 = acc[ai][0][m][1] + bv[0][1], g0 = acc[ai][1][m][0] + bv[1][0], g1 = acc[ai][1][m][1] + bv[1][1];
                        float o[8];
#pragma unroll
                        for (int j = 0; j < 4; ++j) { o[j] = a0[j] * sigmoidf_(g0[j]); o[4 + j] = a1[j] * sigmoidf_(g1[j]); }
                        *(v4u*)(pconf + (size_t)row * 512 + (u.pn - 8) * 128 + cb) = pack8(o); }
            } else {
#pragma unroll
                for (int ai = 0; ai < 2; ++ai)
#pragma unroll
                    for (int m = 0; m < 4; ++m) { const int row = row0 + ai * 128 + m * 16;
                        bf16* rowp = psgu + (size_t)row * 1024 + (u.pn - 12) * 256 + cb;
#pragma unroll
                        for (int bj = 0; bj < 2; ++bj) { f32x4 v0 = acc[ai][bj][m][0] + bv[bj][0], v1 = acc[ai][bj][m][1] + bv[bj][1];
#pragma unroll
                            for (int j = 0; j < 4; ++j) { v0[j] = gelu_tanh(v0[j]); v1[j] = gelu_tanh(v1[j]); }
                            v4u w; w.x = pk2(v0[0], v0[1]); w.y = pk2(v0[2], v0[3]); w.z = pk2(v1[0], v1[1]); w.w = pk2(v1[2], v1[3]);
                            *(v4u*)(rowp + bj * 128) = w; } }
            }
        } else {
            const int jrow0 = (u.pm - 16) * 256 + wr * 64 + fr, tok0 = u.pn * 256 + wc * 32 + 8 * fq;
#pragma unroll
            for (int ai = 0; ai < 2; ++ai)
#pragma unroll
                for (int m = 0; m < 4; ++m) { const int jrow = jrow0 + ai * 128 + m * 16; const float bb = bias[4096 + jrow]; const int cs = jrow >> 9, rr = jrow & 511;
#pragma unroll
                    for (int bj = 0; bj < 2; ++bj) { const int tok = tok0 + bj * 128; bf16* dst;
                        if (tok < NLAT) { const int b = tok >> 11, t = tok & 2047; dst = pfft + ((size_t)(b * 512 + rr)) * 4096 + cs * 2048 + t; }
                        else { const int tc = tok - NLAT, b = tc >> 8, t = tc & 255; dst = pfftc + ((size_t)(b * 512 + rr)) * 512 + cs * 256 + t; }
                        const f32x4 v0 = acc[ai][bj][m][0] + bb, v1 = acc[ai][bj][m][1] + bb;
                        v4u w; w.x = pk2(v0[0], v0[1]); w.y = pk2(v0[2], v0[3]); w.z = pk2(v1[0], v1[1]); w.w = pk2(v1[2], v1[3]);
                        *(v4u*)dst = w; } }
        }
    }
};
template <int ACT  > struct EpiBf16 {
    static constexpr bool PERM = true;
    bf16* O; int ldc; const float* bias;
    __device__ __forceinline__ void operator()(const AccT& acc, const Unit& u, int wr, int wc, int fr, int fq) const {
        const int row0 = u.pm * 256 + wr * 64 + fr, col0 = u.pn * 256 + wc * 32 + 8 * fq;
        f32x4 bv[2][2];
#pragma unroll
        for (int bj = 0; bj < 2; ++bj)
#pragma unroll
            for (int n = 0; n < 2; ++n) bv[bj][n] = bias ? *(const f32x4*)(bias + col0 + bj * 128 + 4 * n) : (f32x4){0.f, 0.f, 0.f, 0.f};
#pragma unroll
        for (int ai = 0; ai < 2; ++ai)
#pragma unroll
            for (int m = 0; m < 4; ++m) { bf16* rowp = O + (size_t)(row0 + ai * 128 + m * 16) * ldc + col0;
#pragma unroll
                for (int bj = 0; bj < 2; ++bj) { f32x4 v0 = acc[ai][bj][m][0] + bv[bj][0], v1 = acc[ai][bj][m][1] + bv[bj][1];
                    if (ACT == 1) {
#pragma unroll
                        for (int j = 0; j < 4; ++j) { v0[j] = sigmoidf_(v0[j]); v1[j] = sigmoidf_(v1[j]); } }
                    v4u w; w.x = pk2(v0[0], v0[1]); w.y = pk2(v0[2], v0[3]); w.z = pk2(v1[0], v1[1]); w.w = pk2(v1[2], v1[3]);
                    *(v4u*)(rowp + bj * 128) = w; } }
    }
};
struct EpiF32 {
    static constexpr bool PERM = false;
    float* C; int ldc; const float* bias;
    __device__ __forceinline__ void operator()(const AccT& acc, const Unit& u, int wr, int wc, int fr, int fq) const {
        const int row0 = u.pm * 256 + wr * 64 + fr, col0 = u.pn * 256 + wc * 32 + 4 * fq;
        f32x4 bv[2][2];
#pragma unroll
        for (int bj = 0; bj < 2; ++bj)
#pragma unroll
            for (int n = 0; n < 2; ++n) bv[bj][n] = *(const f32x4*)(bias + col0 + bj * 128 + n * 16);
#pragma unroll
        for (int ai = 0; ai < 2; ++ai)
#pragma unroll
            for (int m = 0; m < 4; ++m) { float* rowp = C + (size_t)(row0 + ai * 128 + m * 16) * ldc + col0;
#pragma unroll
                for (int bj = 0; bj < 2; ++bj)
#pragma unroll
                    for (int n = 0; n < 2; ++n) *(f32x4*)(rowp + bj * 128 + n * 16) = acc[ai][bj][m][n] + bv[bj][n]; }
    }
};
struct EpiGateMerge {
    static constexpr bool PERM = true;
    const bf16* P; bf16* mbf; const float* bias;
    __device__ __forceinline__ void operator()(const AccT& acc, const Unit& u, int wr, int wc, int fr, int fq) const {
        const int row0 = u.pm * 256 + wr * 64 + fr, cb = wc * 32 + 8 * fq, d0 = u.pn * 64 + wc * 16 + 4 * fq;
        f32x4 bv[2][2];
#pragma unroll
        for (int bj = 0; bj < 2; ++bj)
#pragma unroll
            for (int n = 0; n < 2; ++n) bv[bj][n] = *(const f32x4*)(bias + u.pn * 256 + cb + bj * 128 + 4 * n);
#pragma unroll
        for (int ai = 0; ai < 2; ++ai)
#pragma unroll
            for (int m = 0; m < 4; ++m) { const size_t row = (size_t)(row0 + ai * 128 + m * 16); const bf16* pr = P + row * 4096 + d0;
                f32x4 o = (f32x4){0.f, 0.f, 0.f, 0.f};
#pragma unroll
                for (int bj = 0; bj < 2; ++bj)
#pragma unroll
                    for (int n = 0; n < 2; ++n) { const v2u pw = *(const v2u*)(pr + (2 * bj + n) * 1024); const f32x4 g = acc[ai][bj][m][n] + bv[bj][n];
                        o[0] += sigmoidf_(g[0]) * bflo(pw.x); o[1] += sigmoidf_(g[1]) * bfhi(pw.x); o[2] += sigmoidf_(g[2]) * bflo(pw.y); o[3] += sigmoidf_(g[3]) * bfhi(pw.y); }
                v2u w; w.x = pk2(o[0], o[1]); w.y = pk2(o[2], o[3]); *(v2u*)(mbf + row * 1024 + d0) = w; }
    }
};
struct EpiMoe1 {
    static constexpr bool PERM = true;
    bf16* hid;
    __device__ __forceinline__ void operator()(const AccT& acc, const Unit& u, int wr, int wc, int fr, int fq) const {
        const int row0 = u.pm * 256 + wr * 64 + fr, cb = wc * 32 + 8 * fq;
#pragma unroll
        for (int ai = 0; ai < 2; ++ai)
#pragma unroll
            for (int m = 0; m < 4; ++m) { const int row = row0 + ai * 128 + m * 16;
                const f32x4 g0 = acc[ai][0][m][0], g1 = acc[ai][0][m][1], u0 = acc[ai][1][m][0], u1 = acc[ai][1][m][1];
                float o[8];
#pragma unroll
                for (int j = 0; j < 4; ++j) { o[j] = siluf_(g0[j]) * u0[j]; o[4 + j] = siluf_(g1[j]) * u1[j]; }
                *(v4u*)(hid + (size_t)row * 512 + u.pn * 128 + cb) = pack8(o); }
    }
};

struct Ctx {
    LAS unsigned char* lds; int tid, lane, wave, G, bid;
};

__device__ __forceinline__ int gate_srccol(int r) { const int q = r - 5120, t = q >> 8, c = q & 255, bj = c >> 7, wc = (c >> 5) & 3, fq = (c >> 3) & 3, n = (c >> 2) & 1, j = c & 3;
    return OFF_GATE + (2 * bj + n) * 1024 + 64 * t + 16 * wc + 4 * fq + j; }
__device__ __forceinline__ void cvt_tile(const Ctx& X, const float* src, int ld, int k0, bf16* dst, int Kp) {
    LAS float* tile = (LAS float*)X.lds;
#pragma unroll
    for (int i = 0; i < 8; ++i) { const int kk = (X.tid >> 6) + 8 * i, nn = X.tid & 63; tile[kk * 65 + nn] = src[(size_t)(k0 + kk) * ld + nn]; }
    __syncthreads();
    { const int n = X.tid >> 3, kc = X.tid & 7; float o[8];
#pragma unroll
      for (int j = 0; j < 8; ++j) o[j] = tile[(8 * kc + j) * 65 + n];
      *(v4u*)(dst + (size_t)n * Kp + k0 + 8 * kc) = pack8(o); }
    __syncthreads();
}

__device__ __forceinline__ void cvt_item(const float* src, int ld, int srccol, int k0, bf16* dst, int Kp, LAS float* scr, int lane) {
    float tv[32];
#pragma unroll
    for (int i = 0; i < 32; ++i) { const int kk = 2 * i + (lane >> 5); tv[i] = src[(size_t)(k0 + kk) * ld + srccol]; }
#pragma unroll
    for (int i = 0; i < 32; ++i) { const int kk = 2 * i + (lane >> 5); scr[kk * 33 + (lane & 31)] = tv[i]; }
    LDS_WAIT(); asm volatile("" ::: "memory");
    const int c = lane & 7;
#pragma unroll
    for (int j = 0; j < 4; ++j) { const int n = (lane >> 3) + 8 * j; const LAS float* sp = scr + (8 * c) * 33 + n; float o[8];
#pragma unroll
        for (int e = 0; e < 8; ++e) o[e] = sp[e * 33];
        *(v4u*)(dst + (size_t)n * Kp + k0 + 8 * c) = pack8(o); }
    LDS_WAIT(); asm volatile("" ::: "memory");
}

__device__ __forceinline__ void cvt_item4(const float* src, int ld, int col4, int k0, bf16* dst, int Kp, LAS float* scr, int lane) {
    f32x4 v[8]; const int kq = lane >> 3, n4 = 4 * (lane & 7);
#pragma unroll
    for (int i = 0; i < 8; ++i) v[i] = *(const f32x4*)(src + (size_t)(k0 + kq + 8 * i) * ld + col4);
#pragma unroll
    for (int i = 0; i < 8; ++i) { LAS float* p = scr + (kq + 8 * i) * 33 + n4; p[0] = v[i][0]; p[1] = v[i][1]; p[2] = v[i][2]; p[3] = v[i][3]; }
    LDS_WAIT(); asm volatile("" ::: "memory");
    const int c = lane & 7;
#pragma unroll
    for (int j = 0; j < 4; ++j) { const int n = (lane >> 3) + 8 * j; const LAS float* sp = scr + (8 * c) * 33 + n; float o[8];
#pragma unroll
        for (int e = 0; e < 8; ++e) o[e] = sp[e * 33];
        *(v4u*)(dst + (size_t)n * Kp + k0 + 8 * c) = pack8(o); }
    LDS_WAIT(); asm volatile("" ::: "memory");
}

__device__ __forceinline__ void ln_rows(f32x4 (&v)[4]) {
    float s = 0.f;
#pragma unroll
    for (int j = 0; j < 4; ++j) s += (v[j][0] + v[j][1]) + (v[j][2] + v[j][3]);
    const float mean = wave_sum(s) * (1.f / D); float s2 = 0.f;
#pragma unroll
    for (int j = 0; j < 4; ++j) { v[j] = v[j] - mean; s2 += (v[j][0] * v[j][0] + v[j][1] * v[j][1]) + (v[j][2] * v[j][2] + v[j][3] * v[j][3]); }
    const float rstd = __builtin_amdgcn_rsqf(wave_sum(s2) * (1.f / D) + LN_EPS);
#pragma unroll
    for (int j = 0; j < 4; ++j) v[j] = v[j] * rstd;
}

#define PH_BEGIN() \
    int tid_l = threadIdx.x; asm volatile("" : "+v"(tid_l)); const int tid = tid_l, lane = tid & 63; \
    Ctx X; X.lds = lds; X.tid = tid; X.lane = lane; X.wave = __builtin_amdgcn_readfirstlane(tid >> 6); X.G = gridDim.x; X.bid = blockIdx.x; \
    const int gw = X.bid * NWAVES + X.wave, NGW = X.G * NWAVES; (void)gw; (void)NGW; \
    const __attribute__((address_space(4))) char* kp = (const __attribute__((address_space(4))) char*)__builtin_amdgcn_kernarg_segment_ptr(); asm volatile("" : "+s"(kp)); \
    unsigned char* const ws = *(unsigned char* const __attribute__((address_space(4)))*)(kp + 280); \
    float* const hlat = *(float* const __attribute__((address_space(4)))*)(kp + 272); (void)hlat; \
    float* const hctx = (float*)(ws + WS_HCTX); (void)hctx; \
    float* const modv = (float*)(ws + WS_MODV); (void)modv; \
    float* const binv = (float*)(ws + WS_BIN); (void)binv; \
    bf16* const XN = (bf16*)(ws + WS_XN); (void)XN; \
    bf16* const WIN = (bf16*)(ws + WS_WIN); (void)WIN; \
    bf16* const WBR = (bf16*)(ws + WS_WBR); (void)WBR; \
    bf16* const WOUT = (bf16*)(ws + WS_WOUT); (void)WOUT; \
    bf16* const F1A = (bf16*)(ws + WS_F1A); (void)F1A; bf16* const F1B = (bf16*)(ws + WS_F1B); (void)F1B; \
    bf16* const DFTC = (bf16*)(ws + WS_DFTC); (void)DFTC; \
    bf16* const PQKV = (bf16*)(ws + WS_PQKV); (void)PQKV; \
    bf16* const PCONF = (bf16*)(ws + WS_PCONF); (void)PCONF; \
    bf16* const PZ = (bf16*)(ws + WS_PZ); (void)PZ; \
    bf16* const PSGU = (bf16*)(ws + WS_PSGU); (void)PSGU; \
    bf16* const PFFT = (bf16*)(ws + WS_PFFT); (void)PFFT; \
    bf16* const PFFTC = (bf16*)(ws + WS_PFFTC); (void)PFFTC; \
    float* const AB = (float*)(ws + WS_AB); (void)AB; \
    bf16* const OF = (bf16*)(ws + WS_OF); (void)OF; \
    bf16* const OB = (bf16*)(ws + WS_OB); (void)OB; \
    bf16* const WIT = (bf16*)(ws + WS_WIT); (void)WIT; \
    bf16* const UIT = (bf16*)(ws + WS_UIT); (void)UIT; \
    bf16* const AIT = (bf16*)(ws + WS_AIT); (void)AIT; \
    bf16* const KIT = (bf16*)(ws + WS_KIT); (void)KIT; \
    float* const SIT = (float*)(ws + WS_SIT); (void)SIT; \
    bf16* const GT = (bf16*)(ws + WS_G); (void)GT; \
    bf16* const WGU = (bf16*)(ws + WS_WGU); (void)WGU; \
    bf16* const WDN = (bf16*)(ws + WS_WDN); (void)WDN; \
    bf16* const XG = (bf16*)(ws + WS_XG); (void)XG; \
    bf16* const QKV = (bf16*)(ws + WS_QKV); (void)QKV; \
    float* const GB = (float*)(ws + WS_GB); (void)GB; \
    bf16* const BR = (bf16*)(ws + WS_BR); (void)BR; \
    float* const MERGED = (float*)(ws + WS_MERGED); (void)MERGED; \
    float* const YB = (float*)(ws + WS_Y); (void)YB; \
    bf16* const HID = (bf16*)(ws + WS_HID); (void)HID; \
    bf16* const MO = (bf16*)(ws + WS_MO); (void)MO; \
    float* const ROUTE = (float*)(ws + WS_ROUTE); (void)ROUTE; int* const ELIST = (int*)(ws + WS_LIST); (void)ELIST; \
    unsigned* const ctl = (unsigned*)(ws + WS_CTL); (void)ctl;
#define INP(i) (*(const float* const __attribute__((address_space(4)))*)(kp + 8 * (i)))
__global__ void __launch_bounds__(NWAVES * 64, 2) fwd(Args args) {
    extern __shared__ __attribute__((aligned(16))) unsigned char lds_raw[];
    LAS unsigned char* const lds = (LAS unsigned char*)lds_raw;
    volatile LAS unsigned* MISC = (volatile LAS unsigned*)(lds + MISC_OFF);
    for (int u = threadIdx.x; u < (LDS_BYTES - LDSCTL_OFF) / 4; u += NWAVES * 64) ((LAS unsigned*)(lds + LDSCTL_OFF))[u] = 0u;
    __syncthreads();
#if MK_ONE_LAUNCH
    XcdBarrier bar = xcd_barrier_post((unsigned*)(args.ws + WS_CTL) + CW_BAR, MISC + 8);
#define GRID_BAR() xcd_barrier(bar)
#else
#define GRID_BAR() do { } while (0)
#endif
    const int lo = args.ph_lo, hi = args.ph_hi;
#define IN(k) (lo <= (k) && (k) < hi)
#define CW_TS 20000
#if TPROBE
#define STAMP(k) do { if (blockIdx.x == 0 && threadIdx.x == 0) __hip_atomic_store((unsigned*)(args.ws + WS_CTL) + CW_TS + (k), (unsigned)__builtin_amdgcn_s_memrealtime(), __ATOMIC_RELAXED, __HIP_MEMORY_SCOPE_AGENT); } while (0)
#else
#define STAMP(k) do { } while (0)
#endif
#define SEAM(k) do { if (IN(k) && IN((k) + 1)) GRID_BAR(); STAMP((k) + 1); } while (0)
    STAMP(0);

    for (int rep0_ = 0; rep0_ <= (int)PH_REP(0); ++rep0_) { if (rep0_) GRID_BAR();
    if (PH_ON(0) && IN(0)) { PH_BEGIN();
        for (int idx = X.bid * 512 + tid; idx < 256 * 512 / 8; idx += X.G * 512) {
            const int k = idx >> 6, j0 = (idx & 63) * 8; float o[8];
#pragma unroll
            for (int e = 0; e < 8; ++e) { const int j = j0 + e, t = j & 255, a = (k * t) & 255; float s, c; fsincospi((float)a * (1.0f / 128.0f), &s, &c);
                o[e] = (j < 256 ? c : -s) * 0.0625f; }
            *(v4u*)(DFTC + (size_t)k * 512 + j0) = pack8(o);
        }
        {
            LAS float* sc = (LAS float*)lds;
            LAS float* red = (LAS float*)(lds + 36864);
            { float cv[18];
#pragma unroll
              for (int j = 0; j < 18; ++j) { const int r = j >> 1, k = tid + 512 * (j & 1); cv[j] = r < 8 ? INP(I_C)[r * 1024 + k] : INP(I_CCTX)[k]; }
#pragma unroll
              for (int j = 0; j < 18; ++j) sc[tid + 512 * j] = siluf_(cv[j]); }
            __syncthreads();
            for (int it = X.bid; it < 192; it += X.G) {
                const int l = it / 96, j = (it % 96) * 64 + lane; const float* W = INP(I_WMOD) + (size_t)l * 1024 * 6144 + j;
                float a[9];
#pragma unroll
                for (int r = 0; r < 9; ++r) a[r] = 0.f;
                const int kb = X.wave * 128;
                float wv[2][32];
#pragma unroll
                for (int i = 0; i < 32; ++i) wv[0][i] = W[(size_t)(kb + i) * 6144];
#pragma unroll
                for (int b = 0; b < 4; ++b) {
                    if (b < 3) {
#pragma unroll
                        for (int i = 0; i < 32; ++i) wv[(b + 1) & 1][i] = W[(size_t)(kb + 32 * (b + 1) + i) * 6144]; }
#pragma unroll
                    for (int i = 0; i < 32; i += 4) {
#pragma unroll
                        for (int r = 0; r < 9; ++r) { const f32x4 sv = *(const LAS f32x4*)(sc + r * 1024 + kb + 32 * b + i);
                            a[r] += (sv[0] * wv[b & 1][i] + sv[1] * wv[b & 1][i + 1]) + (sv[2] * wv[b & 1][i + 2] + sv[3] * wv[b & 1][i + 3]); } }
                }
#pragma unroll
                for (int r = 0; r < 9; ++r) red[(X.wave * 9 + r) * 64 + lane] = a[r];
                __syncthreads();
                for (int o = tid; o < 9 * 64; o += 512) { const int r = o >> 6, jj = o & 63; float s = 0.f;
#pragma unroll
                    for (int w = 0; w < 8; ++w) s += red[(w * 9 + r) * 64 + jj];
                    const int jc = (it % 96) * 64 + jj; modv[((size_t)l * 9 + r) * 6144 + jc] = s + INP(I_BMOD)[l * 6144 + jc]; }
                __syncthreads();
            }
        }
    } }
    SEAM(0);

    for (int l = 0; l < 2; ++l) {
        const int pb = 1 + NPH_LAYER * l;
        const int nrows2 = (l == 1) ? NLAT : NTOK;
        const int npan2 = nrows2 / 256;

        for (int rep_ = 0; rep_ <= (int)PH_REP(1); ++rep_) { if (rep_) GRID_BAR();
        if (PH_ON(1) && IN(pb + 0)) { PH_BEGIN(); const float* mv = modv + (size_t)l * 9 * 6144; (void)mv; unsigned* const moecnt = ctl + CW_MOE + l * 16 * 64; (void)moecnt;
            const float* win = INP(I_WIN) + (size_t)l * 1024 * N_IN;
            const float* bin = INP(I_BIN) + (size_t)l * N_IN;
#define FOLD_LOAD(it_) do { const int kb_ = (it_) >> 2, g_ = (it_) & 3; _Pragma("unroll") for (int j = 0; j < 4; ++j) { const int i = tid + 512 * j, kk = i >> 7, c = i & 127; wpre[j] = win[(size_t)(kb_ * 16 + kk) * N_IN + OFF_FFT + g_ * 128 + c]; } } while (0)
            float wpre[4]; FOLD_LOAD(X.bid < 256 ? X.bid : 255);
            LAS float* const wscr = (LAS float*)(lds + X.wave * 8448);
            for (int it = gw; it < 4096 + 1024 + 512 + 144; it += NGW) {
                if (it >= 5632) { const int r = (it - 5632) * 64 + lane;
                    if (r < 4096 || r >= 5120) { float v;
                        if (r < 2048) v = bin[r];
                        else if (r < 3072) { const int q = r - 2048, j = q >> 8, w = q & 255; v = bin[OFF_CONF + (w >= 128 ? 512 : 0) + 128 * j + (w & 127)]; }
                        else if (r < 4096) v = bin[OFF_SGU + (r - 3072)];
                        else v = bin[gate_srccol(r)];
                        binv[r] = v; }
                    continue; }
                const float* src; int ld, col, k0, Kp; bf16* dst; const int n4 = lane & 31;
                if (it < 4096) { const int rb_ = (it & 3) + 4 * ((it >> 3) & 63), rb = rb_ < 128 ? rb_ : rb_ + 32, row0 = rb * 32;
                    if (row0 < 2048) col = row0 + n4;
                    else if (row0 < 3072) { const int q = row0 - 2048, j = q >> 8, w = q & 255; col = OFF_CONF + (w >= 128 ? 512 : 0) + 128 * j + (w & 127) + n4; }
                    else if (row0 < 4096) col = OFF_SGU + (row0 - 3072) + n4;
                    else col = gate_srccol(row0 + n4);
                    src = win; ld = N_IN; k0 = (((it >> 2) & 1) + 2 * (it >> 9)) * 64; dst = WIN + (size_t)row0 * 1024; Kp = 1024; }
                else if (it < 5120) { const int q = it - 4096, i = q >> 8, nb = (q & 3) + 4 * ((q >> 3) & 7);
                    src = INP(I_WBR) + ((size_t)(l * 4 + i) * 512) * 1024; ld = 1024; col = nb * 32 + n4; k0 = (((q >> 2) & 1) + 2 * ((q >> 6) & 3)) * 64; dst = WBR + ((size_t)i * 1024 + nb * 32) * 512; Kp = 512; }
                else { const int q = it - 5120, nb = (q & 3) + 4 * ((q >> 3) & 7);
                    src = INP(I_WOUT) + (size_t)l * 1024 * 1024; ld = 1024; col = nb * 32 + n4; k0 = (((q >> 2) & 1) + 2 * (q >> 6)) * 64; dst = WOUT + (size_t)nb * 32 * 1024; Kp = 1024; }
                cvt_item(src, ld, col, k0, dst, Kp, wscr, lane);
            }
            LAS float* wab = (LAS float*)lds;
            f32x4 wq[8]; bool wq_have = false;
#pragma unroll
            for (int j = 0; j < 8; ++j) wq[j] = (f32x4){0.f, 0.f, 0.f, 0.f};
#define WAB_LOAD() do { _Pragma("unroll") for (int j = 0; j < 8; ++j) wq[j] = *(const f32x4*)(win + (size_t)(tid + 512 * (j & 1)) * N_IN + OFF_A + 4 * (j >> 1)); } while (0)
            for (int it = X.bid; it < 256; it += X.G) {
                const int kb = it >> 2, g = it & 3; LAS float* Wt = (LAS float*)(lds + 69632); LAS f32x2* cst = (LAS f32x2*)(lds + 69632 + 10240); LAS float* bl = (LAS float*)(cst + 128);
                if (it != X.bid) FOLD_LOAD(it);
#pragma unroll
                for (int j = 0; j < 4; ++j) { const int i = tid + 512 * j, kk = i >> 7, c = i & 127; Wt[c * 20 + kk] = wpre[j]; }
                if (tid < 128) { float sn, cn; fsincospi((float)tid * (1.0f / 64.0f), &sn, &cn); cst[tid] = (f32x2){cn * 0.08838834764831845f, sn * 0.08838834764831845f}; }
                else if (tid < 256 && kb == 0) bl[tid - 128] = bin[OFF_FFT + g * 128 + (tid - 128)];
                __syncthreads();
                if (!wq_have) { WAB_LOAD(); wq_have = true; }
                const int m = tid & 127, ks = tid >> 7; f32x2 acc[4];
#pragma unroll
                for (int kk = 0; kk < 4; ++kk) acc[kk] = (f32x2){0.f, 0.f};
                { int a = 0;
#pragma unroll 8
                for (int c = 0; c < 128; ++c) { const f32x2 t = cst[a]; const f32x4 w = *(const LAS f32x4*)(Wt + c * 20 + ks * 4);
#pragma unroll
                    for (int kk = 0; kk < 4; ++kk) acc[kk] += t * w[kk];
                    a = (a + m) & 127; } }
                bf16* dc = WIN + (size_t)(4096 + g * 128 + m) * 1024 + kb * 16 + ks * 4; bf16* dsn = dc + (size_t)512 * 1024;
                { v2u o; o.x = pk2(acc[0][0], acc[1][0]); o.y = pk2(acc[2][0], acc[3][0]); *(v2u*)dc = o; o.x = pk2(acc[0][1], acc[1][1]); o.y = pk2(acc[2][1], acc[3][1]); *(v2u*)dsn = o; }
                if (kb == 0 && tid < 256) {
                    const int cs = tid >> 7; float sb = 0.f; int a = 0;
#pragma unroll 8
                    for (int c = 0; c < 128; ++c) { const f32x2 t = cst[a]; sb += bl[c] * (cs ? t[1] : t[0]); a = (a + m) & 127; }
                    binv[4096 + cs * 512 + g * 128 + m] = sb; }
                if (it + X.G < 256) __syncthreads();
            }
            if (!wq_have) { __syncthreads(); WAB_LOAD(); }
#pragma unroll
            for (int j = 0; j < 8; ++j) { LAS float* p = wab + (4 * (j >> 1)) * 1024 + tid + 512 * (j & 1); p[0] = wq[j][0]; p[1024] = wq[j][1]; p[2048] = wq[j][2]; p[3072] = wq[j][3]; }
            __syncthreads();
#undef FOLD_LOAD
#undef WAB_LOAD
            f32x4 pe[4]; int pe_t = -1;
#pragma unroll
            for (int j = 0; j < 4; ++j) pe[j] = (f32x4){0.f, 0.f, 0.f, 0.f};
            for (int rowb = gw; rowb < NTOK; rowb += 2 * NGW) {
                f32x4 va[4], vb2[4];
                { const int row_ = rowb + 0, row = row_ < NTOK ? row_ : NTOK - 1; const bool LIVE_ = row_ < NTOK;
                float* hrow = row < NLAT ? hlat + (size_t)row * D : hctx + (size_t)(row - NLAT) * D;
                const int mi = row < NLAT ? (row >> 11) : 8; const float* shift = mv + mi * 6144, *scale = shift + 1024;

                if (l == 0) {
                    const float* src = row < NLAT ? INP(I_X) + (size_t)row * D : INP(I_CTX) + (size_t)(row - NLAT) * D;
#pragma unroll
                    for (int j = 0; j < 4; ++j) va[j] = *(const f32x4*)(src + 4 * lane + 256 * j);
                    if (row < NLAT) { const int t = row & 2047;
                        if (t != pe_t) { pe_t = t; const int prow = t >> 6, pcol = t & 63;
#pragma unroll 1
                            for (int j = 0; j < 4; ++j)
#pragma unroll
                                for (int e = 0; e < 4; ++e) { const int col = 4 * lane + 256 * j + e, part = col >> 9, within = col & 511, i = within & 255;
                                    const float omega = __builtin_amdgcn_exp2f((float)i * (-13.287712379549449f / 256.0f)); const float rev = (float)(part ? pcol : prow) * omega * 0.15915494309189535f;
                                    const float pv = (within >> 8) ? __builtin_amdgcn_cosf(rev) : __builtin_amdgcn_sinf(rev);
                                    if (j == 0) pe[0][e] = pv; else if (j == 1) pe[1][e] = pv; else if (j == 2) pe[2][e] = pv; else pe[3][e] = pv; } }
#pragma unroll
                        for (int j = 0; j < 4; ++j) va[j] += pe[j]; }
#pragma unroll
                    for (int j = 0; j < 4; ++j) if (LIVE_) *(f32x4*)(hrow + 4 * lane + 256 * j) = va[j];
                } else {
#pragma unroll
                    for (int j = 0; j < 4; ++j) va[j] = *(const f32x4*)(hrow + 4 * lane + 256 * j);
                }
                f32x4 scv[4], shv[4];
#pragma unroll
                for (int j = 0; j < 4; ++j) { scv[j] = *(const f32x4*)(scale + 4 * lane + 256 * j); shv[j] = *(const f32x4*)(shift + 4 * lane + 256 * j); }
                ln_rows(va);
#pragma unroll
                for (int j = 0; j < 4; ++j) { const f32x4 sc = scv[j], sh = shv[j]; va[j] = va[j] * (sc + 1.0f) + sh;
                    v2u w; w.x = pk2(va[j][0], va[j][1]); w.y = pk2(va[j][2], va[j][3]); if (LIVE_) *(v2u*)(XN + (size_t)row * D + 4 * lane + 256 * j) = w; }
                }
                { const int row_ = rowb + NGW, row = row_ < NTOK ? row_ : NTOK - 1; const bool LIVE_ = row_ < NTOK;
                float* hrow = row < NLAT ? hlat + (size_t)row * D : hctx + (size_t)(row - NLAT) * D;
                const int mi = row < NLAT ? (row >> 11) : 8; const float* shift = mv + mi * 6144, *scale = shift + 1024;

                if (l == 0) {
                    const float* src = row < NLAT ? INP(I_X) + (size_t)row * D : INP(I_CTX) + (size_t)(row - NLAT) * D;
#pragma unroll
                    for (int j = 0; j < 4; ++j) vb2[j] = *(const f32x4*)(src + 4 * lane + 256 * j);
                    if (row < NLAT) { const int t = row & 2047;
                        if (t != pe_t) { pe_t = t; const int prow = t >> 6, pcol = t & 63;
#pragma unroll 1
                            for (int j = 0; j < 4; ++j)
#pragma unroll
                                for (int e = 0; e < 4; ++e) { const int col = 4 * lane + 256 * j + e, part = col >> 9, within = col & 511, i = within & 255;
                                    const float omega = __builtin_amdgcn_exp2f((float)i * (-13.287712379549449f / 256.0f)); const float rev = (float)(part ? pcol : prow) * omega * 0.15915494309189535f;
                                    const float pv = (within >> 8) ? __builtin_amdgcn_cosf(rev) : __builtin_amdgcn_sinf(rev);
                                    if (j == 0) pe[0][e] = pv; else if (j == 1) pe[1][e] = pv; else if (j == 2) pe[2][e] = pv; else pe[3][e] = pv; } }
#pragma unroll
                        for (int j = 0; j < 4; ++j) vb2[j] += pe[j]; }
#pragma unroll
                    for (int j = 0; j < 4; ++j) if (LIVE_) *(f32x4*)(hrow + 4 * lane + 256 * j) = vb2[j];
                } else {
#pragma unroll
                    for (int j = 0; j < 4; ++j) vb2[j] = *(const f32x4*)(hrow + 4 * lane + 256 * j);
                }
                f32x4 scv[4], shv[4];
#pragma unroll
                for (int j = 0; j < 4; ++j) { scv[j] = *(const f32x4*)(scale + 4 * lane + 256 * j); shv[j] = *(const f32x4*)(shift + 4 * lane + 256 * j); }
                ln_rows(vb2);
#pragma unroll
                for (int j = 0; j < 4; ++j) { const f32x4 sc = scv[j], sh = shv[j]; vb2[j] = vb2[j] * (sc + 1.0f) + sh;
                    v2u w; w.x = pk2(vb2[j][0], vb2[j][1]); w.y = pk2(vb2[j][2], vb2[j][3]); if (LIVE_) *(v2u*)(XN + (size_t)row * D + 4 * lane + 256 * j) = w; }
                }
                float pa[16], pb_[16];
                { f32x2 vp[4][4];
#pragma unroll
                  for (int j = 0; j < 4; ++j)
#pragma unroll
                      for (int e = 0; e < 4; ++e) vp[j][e] = (f32x2){va[j][e], vb2[j][e]};
#pragma unroll
                  for (int o = 0; o < 16; ++o) { f32x2 sr = (f32x2){0.f, 0.f};
#pragma unroll
                    for (int j = 0; j < 4; ++j) { const f32x4 w = *(const LAS f32x4*)(wab + o * 1024 + 4 * lane + 256 * j);
#pragma unroll
                        for (int e = 0; e < 4; ++e) sr += vp[j][e] * w[e]; }
                    pa[o] = sr[0]; pb_[o] = sr[1]; if ((o & 3) == 3) asm volatile("" ::: "memory"); } }
                const float t0_ = reduce16(pa, lane), t1_ = reduce16(pb_, lane);
                if ((lane & 3) == 0) { AB[(size_t)rowb * 16 + (lane >> 2)] = t0_ + bin[OFF_A + (lane >> 2)]; if (rowb + NGW < NTOK) AB[(size_t)(rowb + NGW) * 16 + (lane >> 2)] = t1_ + bin[OFF_A + (lane >> 2)]; }
            }
        } }
        SEAM(pb + 0);

        for (int rep_ = 0; rep_ <= (int)PH_REP(2); ++rep_) { if (rep_) GRID_BAR();
        if (PH_ON(2) && IN(pb + 1)) { PH_BEGIN(); const float* mv = modv + (size_t)l * 9 * 6144; (void)mv; unsigned* const moecnt = ctl + CW_MOE + l * 16 * 64; (void)moecnt;
            SchedInA S{X.G, X.bid, (const char*)XN, (const char*)WIN};
            EpiInA E{PQKV, PZ, PCONF, PSGU, PFFT, PFFTC, binv};
            pg8::gemm_phase<EpiInA, SchedInA, true, true>(lds, Gemm{1024, 1024, 1024}, S, E);
        } }
        SEAM(pb + 1);

        for (int rep_ = 0; rep_ <= (int)PH_REP(3); ++rep_) { if (rep_) GRID_BAR();
        if (PH_ON(3) && IN(pb + 2)) { PH_BEGIN(); const float* mv = modv + (size_t)l * 9 * 6144; (void)mv; unsigned* const moecnt = ctl + CW_MOE + l * 16 * 64; (void)moecnt;
            {
                const int vb = X.bid, NB2 = X.G, gw2 = gw, NGW2 = NGW;
                { SchedFftCtx S{NB2, vb, (const char*)DFTC, (const char*)PFFTC}; EpiBf16<0> E{BR + (size_t)2 * NTOK * 512, 512, nullptr};
                  pg8::gemm_phase<EpiBf16<0>, SchedFftCtx, true, true>(lds, Gemm{512, 512, 512}, S, E); }
                __syncthreads();
                {
                    typedef short v4i16_t __attribute__((ext_vector_type(4)));
                    LAS unsigned char* tl = lds + X.wave * 8192;
                    const int r16 = lane & 15, quad = lane >> 4;
                    bf16x8 m1[4][2];
#pragma unroll
                    for (int mt = 0; mt < 4; ++mt)
#pragma unroll
                        for (int ks = 0; ks < 2; ++ks) { float o[8]; const int k1 = 16 * (mt & 1) + r16, ri = mt >> 1;
#pragma unroll
                            for (int e = 0; e < 8; ++e) { const int t1 = 8 * quad + e; float sn, cs; fsincospi((float)((k1 * t1) & 31) * (1.0f / 16.0f), &sn, &cs);
                                o[e] = ri == 0 ? (ks == 0 ? cs : -sn) : (ks == 0 ? -sn : -cs); }
                            m1[mt][ks] = __builtin_bit_cast(bf16x8, pack8(o)); }
                    float twc[2][4][4], tws[2][4][4];
#pragma unroll
                    for (int ml = 0; ml < 2; ++ml)
#pragma unroll
                        for (int c = 0; c < 4; ++c)
#pragma unroll
                            for (int r = 0; r < 4; ++r) { const int k1 = 16 * ml + r16, t2 = 16 * c + 4 * quad + r; fsincospi((float)(k1 * t2) * (1.0f / 1024.0f), &tws[ml][c][r], &twc[ml][c][r]); }
                    const unsigned tbase = (unsigned)(size_t)tl;
                    for (int it = gw2; it < NB * 512; it += NGW2) {
                        const int b = it >> 9, col = it & 511;
                        const bf16* src = PFFT + (size_t)it * 4096;
                        v4u ld[8];
#pragma unroll
                        for (int i = 0; i < 8; ++i) ld[i] = *(const v4u*)(src + (i * 64 + lane) * 8);
#pragma unroll
                        for (int i = 0; i < 8; ++i) *(LAS v4u*)(tl + (i * 64 + lane) * 16) = ld[i];
                        LDS_WAIT();
                        bf16* dst = (b < 4 ? F1A + (size_t)(b * 512 + col) * 4096 : F1B + (size_t)((b - 4) * 512 + col) * 4096);
#pragma unroll
                        for (int c = 0; c < 4; ++c) {
                            bf16x8 af[2];
#pragma unroll
                            for (int ks = 0; ks < 2; ++ks) { v4i16_t h[2];
#pragma unroll
                                for (int t = 0; t < 2; ++t) h[t] = __builtin_amdgcn_ds_read_tr16_b64_v4i16((LAS v4i16_t*)(tl + ks * 4096 + (8 * quad + 4 * t + (r16 >> 2)) * 128 + (16 * c + 4 * (lane & 3)) * 2));
                                bf16x8 f; f[0] = h[0][0]; f[1] = h[0][1]; f[2] = h[0][2]; f[3] = h[0][3]; f[4] = h[1][0]; f[5] = h[1][1]; f[6] = h[1][2]; f[7] = h[1][3]; af[ks] = f; }
                            f32x4 acc[4];
#pragma unroll
                            for (int mt = 0; mt < 4; ++mt) { acc[mt] = (f32x4){0.f, 0.f, 0.f, 0.f};
#pragma unroll
                                for (int ks = 0; ks < 2; ++ks) acc[mt] = __builtin_amdgcn_mfma_f32_16x16x32_bf16(af[ks], m1[mt][ks], acc[mt], 0, 0, 0); }
#pragma unroll
                            for (int ml = 0; ml < 2; ++ml) { const int k1 = 16 * ml + r16; float pr[4], pi[4];
#pragma unroll
                                for (int r = 0; r < 4; ++r) { const float ar = acc[ml][r], ai = acc[ml + 2][r]; pr[r] = ar * twc[ml][c][r] + ai * tws[ml][c][r]; pi[r] = ai * twc[ml][c][r] - ar * tws[ml][c][r]; }
                                v2u w0, w1; w0.x = pk2(pr[0], pr[1]); w0.y = pk2(pr[2], pr[3]); w1.x = pk2(pi[0], pi[1]); w1.y = pk2(pi[2], pi[3]);
                                *(v2u*)(dst + k1 * 128 + 16 * c + 4 * quad) = w0; *(v2u*)(dst + k1 * 128 + 64 + 16 * c + 4 * quad) = w1; }
                        }
                        LDS_WAIT();
                    }
                    (void)tbase;
                    __syncthreads();
                }
                {
                    LAS float* cwl = (LAS float*)lds;
                    const float* cw = INP(I_GCONV) + (size_t)l * 5 * 1536;
                    { f32x4 t4[4];
#pragma unroll
                      for (int j = 0; j < 4; ++j) { const int i = tid + 512 * j; t4[j] = *(const f32x4*)(cw + 4 * (i < 1920 ? i : 0)); }
#pragma unroll
                      for (int j = 0; j < 4; ++j) { const int i = tid + 512 * j; if (i < 1920) *(LAS f32x4*)(cwl + 4 * i) = t4[j]; } }
                    __syncthreads();
                    const float gdt_l = INP(I_GDT)[l * 8 + (lane & 7)], nega_l = -__expf(INP(I_GALOG)[l * 8 + (lane & 7)]);
                    for (int row = gw2; row < NTOK; row += NGW2) {
                        int t, T; if (row < NLAT) { t = row & 2047; T = 2048; } else { t = (row - NLAT) & 255; T = 256; }
                        v4u xr[3][5];
#pragma unroll
                        for (int seg = 0; seg < 3; ++seg)
#pragma unroll
                            for (int j = 0; j < 5; ++j) { const int tt = t + j - 2; xr[seg][j] = (tt >= 0 && tt < T) ? *(const v4u*)(PQKV + (size_t)(row + j - 2) * 1536 + seg * 512 + 8 * lane) : (v4u){0u, 0u, 0u, 0u}; }
                        float av = 0.f, bv = 0.f; if (lane < 8) { av = AB[(size_t)row * 16 + lane]; bv = AB[(size_t)row * 16 + 8 + lane]; }
#pragma unroll
                        for (int seg = 0; seg < 3; ++seg) { const int ch = seg * 512 + 8 * lane; float a[8];
#pragma unroll
                            for (int e = 0; e < 8; ++e) a[e] = 0.f;
#pragma unroll
                            for (int j = 0; j < 5; ++j) { float xv[8]; unpack8(xr[seg][j], xv);
                                const f32x4 w0 = *(const LAS f32x4*)(cwl + j * 1536 + ch), w1 = *(const LAS f32x4*)(cwl + j * 1536 + ch + 4);
#pragma unroll
                                for (int e = 0; e < 4; ++e) { a[e] += w0[e] * xv[e]; a[4 + e] += w1[e] * xv[4 + e]; } }
                            float ss = 0.f;
#pragma unroll
                            for (int e = 0; e < 8; ++e) { a[e] = siluf_(a[e]); ss += a[e] * a[e]; }
                            if (seg < 2) { ss = g16_sum(ss); const float sc = __builtin_amdgcn_rsqf(ss + LN_EPS) * (seg == 0 ? 0.08838834764831845f : 1.0f);
#pragma unroll
                                for (int e = 0; e < 8; ++e) a[e] *= sc; }
                            *(v4u*)(QKV + (size_t)row * 1536 + ch) = pack8(a); }
                        if (lane < 8) { const float xs = av + gdt_l; const float sp = xs > 20.f ? xs : __logf(1.0f + __expf(xs));
                            GB[(size_t)row * 16 + lane] = nega_l * sp; GB[(size_t)row * 16 + 8 + lane] = __builtin_amdgcn_rcpf(1.0f + __expf(-bv)); }
                    }
                    __syncthreads();
                }
                {
                    LAS bf16* xs = (LAS bf16*)lds;
                    LAS float* wl = (LAS float*)(lds + 63488);
                    const float* dw = INP(I_CDWW) + (size_t)l * 31 * 512; const float* dwb = INP(I_CDWB) + l * 512, *lg = INP(I_CLNG) + l * 512, *lb = INP(I_CLNB) + l * 512;
                    bf16* B1 = BR + (size_t)1 * NTOK * 512;
                    { f32x4 t8[8];
#pragma unroll
                      for (int j = 0; j < 8; ++j) { const int i = tid + 512 * j; t8[j] = *(const f32x4*)(dw + 4 * (i < 3968 ? i : 0)); }
#pragma unroll
                      for (int j = 0; j < 8; ++j) { const int i = tid + 512 * j; if (i < 3968) *(LAS f32x4*)(wl + 4 * i) = t8[j]; } }
                    const int ch = 8 * lane, tq = X.wave;
                    f32x4 bia0 = *(const f32x4*)(dwb + ch), bia1 = *(const f32x4*)(dwb + ch + 4);
                    const f32x4 g0 = *(const f32x4*)(lg + ch), g1 = *(const f32x4*)(lg + ch + 4), b0 = *(const f32x4*)(lb + ch), b1 = *(const f32x4*)(lb + ch + 4);
                    for (int tile = vb; tile < nrows2 / 32; tile += NB2) {
                        const int t0 = tile * 32; int rbase, T; if (t0 < NLAT) { rbase = t0 & ~2047; T = 2048; } else { rbase = NLAT + ((t0 - NLAT) & ~255); T = 256; }
                        __syncthreads();
                        { v4u tl8[8];
#pragma unroll
                          for (int j = 0; j < 8; ++j) { const int i = tid + 512 * j, r = i >> 6, c = i & 63, srow = t0 - 15 + r; const bool ok = i < 62 * 64 && srow >= rbase && srow < rbase + T;
                              tl8[j] = *(const v4u*)(PCONF + (size_t)(ok ? srow : t0) * 512 + 8 * c); if (!ok) tl8[j] = (v4u){0u, 0u, 0u, 0u}; }
#pragma unroll
                          for (int j = 0; j < 8; ++j) { const int i = tid + 512 * j, r = i >> 6, c = i & 63; if (i < 62 * 64) *(LAS v4u*)(xs + r * 512 + 8 * c) = tl8[j]; } }
                        __syncthreads();
                        float acc[4][8];
#pragma unroll
                        for (int k = 0; k < 4; ++k)
#pragma unroll
                            for (int e = 0; e < 4; ++e) { acc[k][e] = bia0[e]; acc[k][4 + e] = bia1[e]; }
#pragma unroll 1
                        for (int j = 0; j < 31; ++j) {
                            const f32x4 w0 = *(const LAS f32x4*)(wl + j * 512 + ch), w1 = *(const LAS f32x4*)(wl + j * 512 + ch + 4);
#pragma unroll
                            for (int k = 0; k < 4; ++k) { float xv[8]; unpack8(*(const LAS v4u*)(xs + (tq * 4 + k + j) * 512 + ch), xv);
#pragma unroll
                                for (int e = 0; e < 4; ++e) { acc[k][e] += w0[e] * xv[e]; acc[k][4 + e] += w1[e] * xv[4 + e]; } }
                        }
#pragma unroll
                        for (int k = 0; k < 4; ++k) { float s1 = 0.f;
#pragma unroll
                            for (int e = 0; e < 8; ++e) s1 += acc[k][e];
                            const float mean = g16_sum(s1) * (1.0f / 128.0f); float s2 = 0.f;
#pragma unroll
                            for (int e = 0; e < 8; ++e) { acc[k][e] -= mean; s2 += acc[k][e] * acc[k][e]; }
                            const float rstd = __builtin_amdgcn_rsqf(g16_sum(s2) * (1.0f / 128.0f) + LN_EPS); float o[8];
#pragma unroll
                            for (int e = 0; e < 4; ++e) { o[e] = siluf_(acc[k][e] * rstd * g0[e] + b0[e]); o[4 + e] = siluf_(acc[k][4 + e] * rstd * g1[e] + b1[e]); }
                            *(v4u*)(B1 + (size_t)(t0 + tq * 4 + k) * 512 + ch) = pack8(o); }
                    }
                    __syncthreads();
                }
                {
                    LAS bf16* vnT = (LAS bf16*)lds;
                    const float* lg = INP(I_SLNG) + l * 512, *lb = INP(I_SLNB) + l * 512;
                    bf16* B3 = BR + (size_t)3 * NTOK * 512;
                    const int nitems = (nrows2 / 128) * 4, r16 = lane & 15, quad = lane >> 4, w = X.wave;
                    for (int it = vb; it < nitems; it += NB2) {
                        const int chunk = it >> 2, g = it & 3, r0 = chunk * 128;
                        unsigned raw[16];
#pragma unroll
                        for (int i = 0; i < 16; ++i) raw[i] = *(const unsigned*)(PSGU + (size_t)(r0 + w * 16 + i) * 1024 + 512 + g * 128 + 2 * lane);
                        const int c = g * 128 + 2 * lane; const float lg0 = lg[c], lg1 = lg[c + 1], lb0 = lb[c], lb1 = lb[c + 1];
                        __syncthreads();
                        { float sv[16];
#pragma unroll
                          for (int i = 0; i < 16; ++i) sv[i] = bflo(raw[i]) + bfhi(raw[i]);
                          const float ts = reduce16(sv, lane) * (1.0f / 128.0f); float mean[16];
#pragma unroll
                          for (int i = 0; i < 16; ++i) { mean[i] = __shfl(ts, 4 * i); const float v0 = bflo(raw[i]) - mean[i], v1 = bfhi(raw[i]) - mean[i]; sv[i] = v0 * v0 + v1 * v1; }
                          const float tv = reduce16(sv, lane) * (1.0f / 128.0f);
#pragma unroll
                          for (int i = 0; i < 16; ++i) { const float rstd = __builtin_amdgcn_rsqf(__shfl(tv, 4 * i) + LN_EPS); const float v0 = bflo(raw[i]) - mean[i], v1 = bfhi(raw[i]) - mean[i];
                            vnT[(2 * lane) * 136 + w * 16 + i] = (bf16)f2bf(v0 * rstd * lg0 + lb0); vnT[(2 * lane + 1) * 136 + w * 16 + i] = (bf16)f2bf(v1 * rstd * lg1 + lb1); } }
                        bf16x8 wf[4];
                        { const float* wsrc = INP(I_SWS) + ((size_t)(l * 4 + g) * 128 + 16 * w + r16) * 128 + quad * 8;
#pragma unroll
                          for (int ks = 0; ks < 4; ++ks) { const f32x4 x0 = *(const f32x4*)(wsrc + 32 * ks), x1 = *(const f32x4*)(wsrc + 32 * ks + 4);
                              v4u pk; pk.x = pk2(x0[0], x0[1]); pk.y = pk2(x0[2], x0[3]); pk.z = pk2(x1[0], x1[1]); pk.w = pk2(x1[2], x1[3]); wf[ks] = __builtin_bit_cast(bf16x8, pk); } }
                        const float bs = INP(I_SBS)[(l * 4 + g) * 128 + 16 * w + r16];
                        __syncthreads();
                        const size_t prow = (size_t)(r0 + 16 * w + r16);
#pragma unroll
                        for (int nt = 0; nt < 8; ++nt) { f32x4 acc = (f32x4){0.f, 0.f, 0.f, 0.f};
#pragma unroll
                            for (int ks = 0; ks < 4; ++ks) { const bf16x8 vf = *(const LAS bf16x8*)(vnT + (16 * nt + r16) * 136 + 32 * ks + quad * 8); acc = __builtin_amdgcn_mfma_f32_16x16x32_bf16(vf, wf[ks], acc, 0, 0, 0); }
                            const v2u uw = *(const v2u*)(PSGU + prow * 1024 + g * 128 + 16 * nt + quad * 4);
                            v2u o; o.x = pk2(bflo(uw.x) * (acc[0] + bs), bfhi(uw.x) * (acc[1] + bs)); o.y = pk2(bflo(uw.y) * (acc[2] + bs), bfhi(uw.y) * (acc[3] + bs));
                            *(v2u*)(B3 + prow * 512 + g * 128 + 16 * nt + quad * 4) = o; }
                    }
                    __syncthreads();
                }
            }
        } }
        SEAM(pb + 2);

        for (int rep_ = 0; rep_ <= (int)PH_REP(4); ++rep_) { if (rep_) GRID_BAR();
        if (PH_ON(4) && IN(pb + 3)) { PH_BEGIN(); const float* mv = modv + (size_t)l * 9 * 6144; (void)mv; unsigned* const moecnt = ctl + CW_MOE + l * 16 * 64; (void)moecnt;
            {
                const int r16 = lane & 15, quad = lane >> 4;
                bf16x8 m2[4][4];
#pragma unroll
                for (int jt = 0; jt < 4; ++jt)
#pragma unroll
                    for (int ks = 0; ks < 4; ++ks) { float o[8]; const int k2 = 16 * jt + r16;
#pragma unroll
                        for (int e = 0; e < 8; ++e) { const int t2 = 32 * (ks & 1) + 8 * quad + e; float sn, cs; fsincospi((float)((k2 * t2) & 63) * (1.0f / 32.0f), &sn, &cs); o[e] = ((ks >> 1) ? sn : cs) * 0.022097086912079608f; }
                        m2[jt][ks] = __builtin_bit_cast(bf16x8, pack8(o)); }
                bf16* B2 = BR + (size_t)2 * NTOK * 512;
                const int nq5 = 9216 - 4 * NGW;
                const bool bal = nq5 > 0 && nq5 < NGW;
                for (int it = bal ? gw - nq5 : gw; it < 8192; it += bal ? NGW - nq5 : NGW) {
                    if (it < 0) break;
                    const int b = it >> 10, k1 = (it >> 5) & 31, ct = it & 31;
                    const bf16* f1 = (b < 4 ? F1A + (size_t)(b * 512 + 16 * ct + r16) * 4096 : F1B + (size_t)((b - 4) * 512 + 16 * ct + r16) * 4096) + k1 * 128 + 8 * quad;
                    bf16x8 af[4];
#pragma unroll
                    for (int ks = 0; ks < 4; ++ks) af[ks] = *(const bf16x8*)(f1 + 32 * ks);
#pragma unroll
                    for (int jt = 0; jt < 4; ++jt) { f32x4 acc = (f32x4){0.f, 0.f, 0.f, 0.f};
#pragma unroll
                        for (int ks = 0; ks < 4; ++ks) acc = __builtin_amdgcn_mfma_f32_16x16x32_bf16(af[ks], m2[jt][ks], acc, 0, 0, 0);
                        v2u w; w.x = pk2(acc[0], acc[1]); w.y = pk2(acc[2], acc[3]);
                        *(v2u*)(B2 + (size_t)(b * 2048 + k1 + 32 * (16 * jt + r16)) * 512 + 16 * ct + 4 * quad) = w; }
                }
            }
            for (int qi = gw; qi < 9216; qi += NGW) {
                int lane_l = lane; asm volatile("" : "+v"(lane_l));
                const int r16 = lane_l & 15, quad = lane_l >> 4;
                LAS float* const Mt = (LAS float*)(lds + X.wave * 16384);
                LAS float* const gcl = (LAS float*)(lds + 132096 + X.wave * 1024);
                const int item = qi >> 2, q = qi & 3, cidx = item % 36, chain = item / 36, dir = chain & 1, hh = (chain >> 1) & 3, b = chain >> 3;
                const int row0 = cidx < 4 ? NLAT + b * CTXL + cidx * 64 : b * SEQ + (cidx - 4) * 64;
                const int rb = row0 + (dir ? 63 : 0); const long sg = dir ? -1 : 1;
                const float ga = GB[(size_t)(rb + sg * lane_l) * 16 + dir * 4 + hh], be = GB[(size_t)(rb + sg * lane_l) * 16 + 8 + dir * 4 + hh];
                float gc = ga;
#pragma unroll
                for (int o = 1; o < 64; o <<= 1) { const float tu = __shfl_up(gc, o); gc += (lane_l >= o) ? tu : 0.f; }
                const float gl = __shfl(gc, 63);
                gcl[lane_l] = gc; gcl[64 + lane_l] = be;
                const float scl = q >= 2 ? be * __expf(gc) : be;
                bf16x8 Kf[4][4];
                { const bf16* kp = QKV + (size_t)(rb + sg * r16) * 1536 + 512 + hh * 128 + quad * 8; const long ms = sg * 16 * 1536;
#pragma unroll
                  for (int mi = 0; mi < 4; ++mi)
#pragma unroll
                      for (int ks = 0; ks < 4; ++ks) Kf[mi][ks] = *(const bf16x8*)(kp + mi * ms + ks * 32); }
                LDS_WAIT();
                if (q == 0) {
                    bf16x8 Qf[4][4];
                    { const bf16* qp = QKV + (size_t)(rb + sg * r16) * 1536 + hh * 128 + quad * 8; const long ms = sg * 16 * 1536;
#pragma unroll
                      for (int mi = 0; mi < 4; ++mi)
#pragma unroll
                          for (int ks = 0; ks < 4; ++ks) Qf[mi][ks] = *(const bf16x8*)(qp + mi * ms + ks * 32); }
                    bf16* ait = AIT + (size_t)item * 4096 + r16 * 64 + quad * 4;
#pragma unroll
                    for (int mi = 0; mi < 4; ++mi) { const float gci = gcl[16 * mi + r16];
#pragma unroll
                        for (int nj = 0; nj < 4; ++nj) {
                            v2u w; w.x = 0u; w.y = 0u;
                            if (nj <= mi) {
                                f32x4 c = (f32x4){0.f, 0.f, 0.f, 0.f};
#pragma unroll
                                for (int ks = 0; ks < 4; ++ks) c = __builtin_amdgcn_mfma_f32_16x16x32_bf16(Kf[nj][ks], Qf[mi][ks], c, 0, 0, 0);
                                const f32x4 gcj = *(const LAS f32x4*)(gcl + 16 * nj + quad * 4); float o4[4];
#pragma unroll
                                for (int r = 0; r < 4; ++r) { const bool incl = (nj < mi) || (quad * 4 + r <= r16); o4[r] = incl ? c[r] * __expf(gci - gcj[r]) : 0.f; }
                                w.x = pk2(o4[0], o4[1]); w.y = pk2(o4[2], o4[3]); }
                            *(v2u*)(ait + mi * 16 * 64 + 16 * nj) = w; }
                    }
                }
                if (q == 1) { SIT[(size_t)item * 192 + lane_l] = __expf(gc); SIT[(size_t)item * 192 + 64 + lane_l] = __expf(gl - gc); if (lane_l == 0) SIT[(size_t)item * 192 + 128] = __expf(gl); }
                asm volatile("" ::: "memory");
                { LAS float* mw = Mt + r16 * 64 + quad * 4;
#pragma unroll
                  for (int mi = 0; mi < 4; ++mi) {
                    const f32x4 gci = *(const LAS f32x4*)(gcl + 16 * mi + quad * 4), bei = *(const LAS f32x4*)(gcl + 64 + 16 * mi + quad * 4);
#pragma unroll
                    for (int nj = 0; nj <= mi; ++nj) {
                        f32x4 c = (f32x4){0.f, 0.f, 0.f, 0.f};
#pragma unroll
                        for (int ks = 0; ks < 4; ++ks) c = __builtin_amdgcn_mfma_f32_16x16x32_bf16(Kf[mi][ks], Kf[nj][ks], c, 0, 0, 0);
                        const float gcj = gcl[16 * nj + r16]; f32x4 mv4;
#pragma unroll
                        for (int r = 0; r < 4; ++r) { const bool strict = (nj < mi) || (r16 < quad * 4 + r); mv4[r] = strict ? -(bei[r] * c[r] * __expf(gci[r] - gcj)) : 0.f; }
                        *(LAS f32x4*)(mw + (16 * nj) * 64 + 16 * mi) = mv4;
                    }
                  } }
                asm volatile("" ::: "memory");
                LDS_WAIT();
                float Xs[64];
                { const bf16* src = QKV + (size_t)rb * 1536 + (q < 2 ? 1024 + 64 * q : 512 + 64 * (q - 2)) + hh * 128 + lane_l; const long sstep = sg * 1536;
                  bf16 raw[64];
#pragma unroll
                  for (int sidx = 0; sidx < 64; ++sidx) { raw[sidx] = *src; src += sstep; }
                  asm volatile("" ::: "memory");
#pragma unroll
                  for (int sidx = 0; sidx < 64; ++sidx) { const float sc = __builtin_bit_cast(float, __builtin_amdgcn_readlane(__builtin_bit_cast(int, scl), sidx)); Xs[sidx] = bf1(raw[sidx]) * sc; } }
#pragma unroll
                for (int g4 = 0; g4 < 16; ++g4) {
                    f32x4 acc = (f32x4){Xs[4 * g4], Xs[4 * g4 + 1], Xs[4 * g4 + 2], Xs[4 * g4 + 3]};
#pragma unroll
                    for (int c0 = 0; c0 < 4 * g4; c0 += 16) {
                        f32x4 mb[16];
#pragma unroll
                        for (int e = 0; e < 16; ++e) if (c0 + e < 4 * g4) mb[e] = *(const LAS f32x4*)(Mt + (c0 + e) * 64 + 4 * g4);
                        LDS_WAIT();
#pragma unroll
                        for (int e = 0; e < 16; ++e) if (c0 + e < 4 * g4) acc += mb[e] * Xs[c0 + e];
                    }
                    const f32x4 m0 = *(const LAS f32x4*)(Mt + (4 * g4) * 64 + 4 * g4), m1 = *(const LAS f32x4*)(Mt + (4 * g4 + 1) * 64 + 4 * g4), m2 = *(const LAS f32x4*)(Mt + (4 * g4 + 2) * 64 + 4 * g4);
                    LDS_WAIT();
                    const float x0 = acc[0], x1 = acc[1] + m0[1] * x0, x2 = acc[2] + m0[2] * x0 + m1[2] * x1, x3 = acc[3] + m0[3] * x0 + m1[3] * x1 + m2[3] * x2;
                    Xs[4 * g4] = x0; Xs[4 * g4 + 1] = x1; Xs[4 * g4 + 2] = x2; Xs[4 * g4 + 3] = x3;
                }
                if (q < 2) {
                    bf16* u0 = UIT + (size_t)item * 8192 + (size_t)(64 * q + lane_l) * 64;
#pragma unroll
                    for (int p = 0; p < 8; ++p) { float c0[8];
#pragma unroll
                        for (int e = 0; e < 8; ++e) c0[e] = Xs[8 * p + e];
                        *(v4u*)(u0 + 8 * p) = pack8(c0); }
                } else {
                    bf16* w0 = WIT + (size_t)item * 8192 + 64 * (q - 2) + lane_l;
#pragma unroll
                    for (int sidx = 0; sidx < 64; ++sidx) { w0[sidx * 128] = (bf16)f2bf(Xs[sidx]); if ((sidx & 15) == 15) asm volatile("" ::: "memory"); }
                    asm volatile("" ::: "memory");
                    if (dir == 0) {
                        const bf16* src = QKV + (size_t)row0 * 1536 + 512 + hh * 128 + 64 * (q - 2) + lane_l;
                        bf16* k0 = KIT + ((size_t)((b * 4 + hh) * 36 + cidx)) * 8192 + (size_t)(64 * (q - 2) + lane_l) * 64;
                        unsigned kw[64];
#pragma unroll
                        for (int e = 0; e < 64; ++e) kw[e] = src[(size_t)e * 1536];
                        asm volatile("" ::: "memory");
#pragma unroll
                        for (int p = 0; p < 8; ++p) { v4u lo; lo.x = kw[8 * p] | (kw[8 * p + 1] << 16); lo.y = kw[8 * p + 2] | (kw[8 * p + 3] << 16); lo.z = kw[8 * p + 4] | (kw[8 * p + 5] << 16); lo.w = kw[8 * p + 6] | (kw[8 * p + 7] << 16);
                            *(v4u*)(k0 + 8 * p) = lo; }
                    }
                }
                LDS_WAIT();
            }
        } }
        SEAM(pb + 3);

        for (int rep_ = 0; rep_ <= (int)PH_REP(5); ++rep_) { if (rep_) GRID_BAR();
        if (PH_ON(5) && IN(pb + 4)) { PH_BEGIN(); const float* mv = modv + (size_t)l * 9 * 6144; (void)mv; unsigned* const moecnt = ctl + CW_MOE + l * 16 * 64; (void)moecnt;
            LAS bf16* const STl = (LAS bf16*)lds;
            LAS bf16* const VNl = (LAS bf16*)(lds + 8704);
            LAS bf16* const VSl = (LAS bf16*)(lds + 13312);
            const int w = X.wave, mt = w & 3, role = w >> 2, r16 = lane & 15, quad = lane >> 4;
            for (int blk = X.bid; blk < 256; blk += X.G) {
                const int item = (blk & 7) * 32 + (blk >> 3);
                const int chain = item >> 2, slice = item & 3, dir = chain & 1, hh = (chain >> 1) & 3, b = chain >> 3;
                bf16* const O = dir ? OB : OF;
                __syncthreads();
                for (int i = tid; i < 32 * 136 / 2; i += 512) ((LAS unsigned*)STl)[i] = 0u;
                __syncthreads();
                f32x4 Sacc[2]; Sacc[0] = (f32x4){0.f, 0.f, 0.f, 0.f}; Sacc[1] = (f32x4){0.f, 0.f, 0.f, 0.f};
#define GDN_LOAD(P, step_) do { const int cidx_ = dir ? ((step_) < 4 ? 3 - (step_) : 39 - (step_)) : (step_); const int item_ = chain * 36 + cidx_, kti_ = (chain >> 1) * 36 + cidx_; \
                    const int row0_ = cidx_ < 4 ? NLAT + b * CTXL + cidx_ * 64 : b * SEQ + (cidx_ - 4) * 64; \
                    const bf16* xp_ = role ? QKV + (size_t)(row0_ + (dir ? 63 - (16 * mt + r16) : 16 * mt + r16)) * 1536 + hh * 128 + quad * 8 : WIT + (size_t)item_ * 8192 + (16 * mt + r16) * 128 + quad * 8; \
                    _Pragma("unroll") for (int ks = 0; ks < 4; ++ks) P##Xf[ks] = *(const bf16x8*)(xp_ + 32 * ks); \
                    { const bf16* kp_ = KIT + (size_t)kti_ * 8192 + (16 * w + r16) * 64 + (dir ? 56 - quad * 8 : quad * 8); \
                      _Pragma("unroll") for (int ks = 0; ks < 2; ++ks) P##Kx[ks] = *(const v4u*)(kp_ + (dir ? -32 * ks : 32 * ks)); } \
                    const float* sp_ = SIT + (size_t)item_ * 192; P##sc4 = *(const f32x4*)(sp_ + (role ? 0 : 64) + 16 * mt + quad * 4); P##egl = sp_[128]; \
                      \
                    { const bf16* a0_ = role ? AIT + (size_t)item_ * 4096 + (16 * mt + r16) * 64 + quad * 8 : UIT + (size_t)item_ * 8192 + (size_t)(slice * 32 + r16) * 64 + 16 * mt + quad * 4; \
                      const bf16* a1_ = role ? a0_ + 32 : a0_ + 16 * 64; \
                      P##Ax[0] = *(const v2u*)a0_; P##Ax[1] = *(const v2u*)(a0_ + 4); P##Ax[2] = *(const v2u*)a1_; P##Ax[3] = *(const v2u*)(a1_ + 4); } } while (0)
#define GDN_BAR() do { asm volatile("s_waitcnt lgkmcnt(0)" ::: "memory"); __builtin_amdgcn_s_barrier(); asm volatile("" ::: "memory"); } while (0)
#define GDN_STEP(P, step_) do { const int cidx = dir ? ((step_) < 4 ? 3 - (step_) : 39 - (step_)) : (step_); \
                    const int row0 = cidx < 4 ? NLAT + b * CTXL + cidx * 64 : b * SEQ + (cidx - 4) * 64; \
                      \
                    f32x4 x1[2]; x1[0] = (f32x4){0.f, 0.f, 0.f, 0.f}; x1[1] = (f32x4){0.f, 0.f, 0.f, 0.f}; \
                    { bf16x8 bfr[2][4]; \
                      _Pragma("unroll") for (int n_ = 0; n_ < 2; ++n_) _Pragma("unroll") for (int ks = 0; ks < 4; ++ks) bfr[n_][ks] = *(const LAS bf16x8*)(STl + (16 * n_ + r16) * 136 + 32 * ks + quad * 8); \
                      asm volatile("s_waitcnt lgkmcnt(0)" ::: "memory"); \
                      _Pragma("unroll") for (int ks = 0; ks < 4; ++ks) { x1[0] = __builtin_amdgcn_mfma_f32_16x16x32_bf16(P##Xf[ks], bfr[0][ks], x1[0], 0, 0, 0); x1[1] = __builtin_amdgcn_mfma_f32_16x16x32_bf16(P##Xf[ks], bfr[1][ks], x1[1], 0, 0, 0); } } \
                    if (role == 0) { \
                        _Pragma("unroll") for (int n_ = 0; n_ < 2; ++n_) { f32x4 vn; vn[0] = bflo(P##Ax[2 * n_].x) - x1[n_][0]; vn[1] = bfhi(P##Ax[2 * n_].x) - x1[n_][1]; vn[2] = bflo(P##Ax[2 * n_].y) - x1[n_][2]; vn[3] = bfhi(P##Ax[2 * n_].y) - x1[n_][3]; \
                            v2u p; p.x = pk2(vn[0], vn[1]); p.y = pk2(vn[2], vn[3]); *(LAS v2u*)(VNl + (16 * n_ + r16) * 72 + 16 * mt + quad * 4) = p; \
                            v2u q; q.x = pk2(vn[0] * P##sc4[0], vn[1] * P##sc4[1]); q.y = pk2(vn[2] * P##sc4[2], vn[3] * P##sc4[3]); *(LAS v2u*)(VSl + (16 * n_ + r16) * 72 + 16 * mt + quad * 4) = q; } } \
                    else { x1[0] = x1[0] * P##sc4; x1[1] = x1[1] * P##sc4; } \
                    bf16x8 kt_[2]; \
                    _Pragma("unroll") for (int ks = 0; ks < 2; ++ks) { const v4u kx_ = P##Kx[ks]; v4u kr_; \
                        kr_.x = dir ? ((kx_.w >> 16) | (kx_.w << 16)) : kx_.x; kr_.y = dir ? ((kx_.z >> 16) | (kx_.z << 16)) : kx_.y; kr_.z = dir ? ((kx_.y >> 16) | (kx_.y << 16)) : kx_.z; kr_.w = dir ? ((kx_.x >> 16) | (kx_.x << 16)) : kx_.w; \
                        kt_[ks] = __builtin_bit_cast(bf16x8, kr_); } \
                    GDN_BAR(); \
                      \
                    bf16x8 vsf[2][2]; \
                    _Pragma("unroll") for (int n2 = 0; n2 < 2; ++n2) { vsf[n2][0] = *(const LAS bf16x8*)(VSl + (16 * n2 + r16) * 72 + quad * 8); vsf[n2][1] = *(const LAS bf16x8*)(VSl + (16 * n2 + r16) * 72 + 32 + quad * 8); } \
                    if (role) { bf16x8 vb[2][2]; \
                        _Pragma("unroll") for (int n_ = 0; n_ < 2; ++n_) { vb[n_][0] = *(const LAS bf16x8*)(VNl + (16 * n_ + r16) * 72 + quad * 8); vb[n_][1] = *(const LAS bf16x8*)(VNl + (16 * n_ + r16) * 72 + 32 + quad * 8); } \
                        asm volatile("s_waitcnt lgkmcnt(0)" ::: "memory"); \
                        v4u af0_; af0_.x = P##Ax[0].x; af0_.y = P##Ax[0].y; af0_.z = P##Ax[1].x; af0_.w = P##Ax[1].y; v4u af1_; af1_.x = P##Ax[2].x; af1_.y = P##Ax[2].y; af1_.z = P##Ax[3].x; af1_.w = P##Ax[3].y; \
                        const bf16x8 Af0_ = __builtin_bit_cast(bf16x8, af0_), Af1_ = __builtin_bit_cast(bf16x8, af1_); \
                        _Pragma("unroll") for (int n_ = 0; n_ < 2; ++n_) { f32x4 oa = __builtin_amdgcn_mfma_f32_16x16x32_bf16(Af0_, vb[n_][0], x1[n_], 0, 0, 0); oa = __builtin_amdgcn_mfma_f32_16x16x32_bf16(Af1_, vb[n_][1], oa, 0, 0, 0); \
                            bf16* op = O + (size_t)(row0 + (dir ? 63 - (16 * mt + quad * 4) : 16 * mt + quad * 4)) * 512 + hh * 128 + slice * 32 + 16 * n_ + r16; const long ostep = dir ? -512 : 512; \
                            _Pragma("unroll") for (int j = 0; j < 4; ++j) op[j * ostep] = (bf16)f2bf(oa[j]); } } \
                    else { asm volatile("s_waitcnt lgkmcnt(0)" ::: "memory"); } \
                    _Pragma("unroll") for (int n2 = 0; n2 < 2; ++n2) { \
                        f32x4 sa = Sacc[n2] * P##egl; sa = __builtin_amdgcn_mfma_f32_16x16x32_bf16(kt_[0], vsf[n2][0], sa, 0, 0, 0); sa = __builtin_amdgcn_mfma_f32_16x16x32_bf16(kt_[1], vsf[n2][1], sa, 0, 0, 0); Sacc[n2] = sa; \
                        v2u p; p.x = pk2(sa[0], sa[1]); p.y = pk2(sa[2], sa[3]); *(LAS v2u*)(STl + (16 * n2 + r16) * 136 + 16 * w + quad * 4) = p; } \
                    GDN_BAR(); } while (0)
#define GDN_DECL(P) bf16x8 P##Xf[4]; v4u P##Kx[2]; v2u P##Ax[4]; f32x4 P##sc4; float P##egl
                GDN_DECL(sa_); GDN_DECL(sb_);
                GDN_LOAD(sa_, 0);
                for (int step = 0; step < 36; step += 2) {
                    GDN_LOAD(sb_, step + 1); GDN_STEP(sa_, step);
                    { const int s2 = step + 2 < 36 ? step + 2 : 35; GDN_LOAD(sa_, s2); } GDN_STEP(sb_, step + 1);
                }
#undef GDN_STEP
#undef GDN_BAR
#undef GDN_DECL
#undef GDN_LOAD
            }
        } }
        SEAM(pb + 4);

        for (int rep_ = 0; rep_ <= (int)PH_REP(6); ++rep_) { if (rep_) GRID_BAR();
        if (PH_ON(6) && IN(pb + 5)) { PH_BEGIN(); const float* mv = modv + (size_t)l * 9 * 6144; (void)mv; unsigned* const moecnt = ctl + CW_MOE + l * 16 * 64; (void)moecnt;
            const float* nw = INP(I_GNORM) + l * 128; const int ch = 8 * lane;
            const f32x4 nw0 = *(const f32x4*)(nw + (ch & 127)), nw1 = *(const f32x4*)(nw + (ch & 127) + 4);
            constexpr int ERT = 9;
            for (int rowb = gw; rowb < nrows2; rowb += ERT * NGW) {
                v4u lf[ERT], lb[ERT], lz[ERT];
#pragma unroll
                for (int k = 0; k < ERT; ++k) { const int row_ = rowb + k * NGW, row = row_ < nrows2 ? row_ : nrows2 - 1; lf[k] = *(const v4u*)(OF + (size_t)row * 512 + ch); lb[k] = *(const v4u*)(OB + (size_t)row * 512 + ch); lz[k] = *(const v4u*)(PZ + (size_t)row * 512 + ch); }
#pragma unroll
                for (int k = 0; k < ERT; ++k) { const int row_ = rowb + k * NGW, row = row_ < nrows2 ? row_ : nrows2 - 1; {
                    float of[8], ob[8], z[8], o[8]; unpack8(lf[k], of); unpack8(lb[k], ob); unpack8(lz[k], z); float ss = 0.f;
#pragma unroll
                    for (int e = 0; e < 8; ++e) { of[e] += ob[e]; ss += of[e] * of[e]; }
                    const float rs = __builtin_amdgcn_rsqf(g16_sum(ss) * (1.0f / 128.0f) + LN_EPS);
#pragma unroll
                    for (int e = 0; e < 4; ++e) { o[e] = of[e] * rs * nw0[e] * z[e]; o[4 + e] = of[4 + e] * rs * nw1[e] * z[4 + e]; }
                    if (row_ < nrows2) *(v4u*)(BR + (size_t)row * 512 + ch) = pack8(o); } }
            }
        } }
        SEAM(pb + 5);

        for (int rep_ = 0; rep_ <= (int)PH_REP(7); ++rep_) { if (rep_) GRID_BAR();
        if (PH_ON(7) && IN(pb + 6)) { PH_BEGIN(); const float* mv = modv + (size_t)l * 9 * 6144; (void)mv; unsigned* const moecnt = ctl + CW_MOE + l * 16 * 64; (void)moecnt;
            SchedBranch S{X.G, X.bid, npan2, (const char*)BR, (const char*)WBR};
            EpiBf16<0> E{GT, 4096, nullptr};
            pg8::gemm_phase<EpiBf16<0>, SchedBranch, true, true>(lds, Gemm{512, 512, 512}, S, E);
        } }
        SEAM(pb + 6);

        for (int rep_ = 0; rep_ <= (int)PH_REP(8); ++rep_) { if (rep_) GRID_BAR();
        if (PH_ON(8) && IN(pb + 7)) { PH_BEGIN(); const float* mv = modv + (size_t)l * 9 * 6144; (void)mv; unsigned* const moecnt = ctl + CW_MOE + l * 16 * 64; (void)moecnt;
            SchedGrid S{X.G, X.bid, npan2, 16, (const char*)XN, (const char*)(WIN + (size_t)5120 * 1024), (size_t)256 * 1024 * 2, (size_t)256 * 1024 * 2};
            EpiGateMerge E{GT, (bf16*)MERGED, binv + 5120};
            pg8::gemm_phase<EpiGateMerge, SchedGrid, true, true>(lds, Gemm{1024, 1024, 1024}, S, E);
        } }
        SEAM(pb + 7);

        for (int rep_ = 0; rep_ <= (int)PH_REP(9); ++rep_) { if (rep_) GRID_BAR();
        if (PH_ON(9) && IN(pb + 8)) { PH_BEGIN(); const float* mv = modv + (size_t)l * 9 * 6144; (void)mv; unsigned* const moecnt = ctl + CW_MOE + l * 16 * 64; (void)moecnt;
            SchedGrid S{X.G, X.bid, npan2, 4, (const char*)MERGED, (const char*)WOUT, (size_t)256 * 1024 * 2, (size_t)256 * 1024 * 2};
            EpiBf16<0> E{(bf16*)YB, 1024, INP(I_BOUT) + l * 1024};
            pg8::gemm_phase<EpiBf16<0>, SchedGrid, true, true>(lds, Gemm{1024, 1024, 1024}, S, E);
            __syncthreads();
            { LAS float* const wscr = (LAS float*)(lds + X.wave * 8448);
              const int first = npan2 * 4 > X.G ? npan2 * 4 - X.G : 0;
              if (X.bid >= first) { const int gwc = (X.bid - first) * NWAVES + X.wave, ngwc = (X.G - first) * NWAVES;
              for (int it = gwc; it < 12288; it += ngwc) {
                if (it < 8192) { const int e = it >> 9, rb = (it & 3) + 4 * ((it >> 3) & 7), kb = ((it >> 2) & 1) + 2 * ((it >> 6) & 7), row0 = rb * 32, j = row0 >> 8, w = row0 & 255;
                    const float* src = (w < 128 ? INP(I_EWG) : INP(I_EWU)) + ((size_t)(l * 16 + e) * 1024) * 512;
                    cvt_item(src, 512, 128 * j + (w & 127) + (lane & 31), kb * 64, WGU + ((size_t)e * 1024 + row0) * 1024, 1024, wscr, lane); }
                else { const int i2 = it - 8192; const int e = i2 >> 8, rb = (i2 & 3) + 4 * ((i2 >> 3) & 7), kb = ((i2 >> 2) & 1) + 2 * ((i2 >> 6) & 3);
                    cvt_item(INP(I_EWD) + ((size_t)(l * 16 + e) * 512) * 1024, 1024, rb * 32 + (lane & 31), kb * 64, WDN + ((size_t)e * 1024 + rb * 32) * 512, 512, wscr, lane); }
              } } }
        } }
        SEAM(pb + 8);

        for (int rep_ = 0; rep_ <= (int)PH_REP(10); ++rep_) { if (rep_) GRID_BAR();
        if (PH_ON(10) && IN(pb + 9)) { PH_BEGIN(); const float* mv = modv + (size_t)l * 9 * 6144; (void)mv; unsigned* const moecnt = ctl + CW_MOE + l * 16 * 64; (void)moecnt;
            LAS float* wr_ = (LAS float*)lds;
            volatile LAS unsigned* lcnt = (volatile LAS unsigned*)(lds + 100352);
            __syncthreads();
            if (tid < 32) lcnt[tid] = 0u;
            { f32x4 rq[10];
#pragma unroll
              for (int j = 0; j < 2; ++j) rq[j] = *(const f32x4*)(INP(I_RGW) + (size_t)l * 4096 + (size_t)(tid + 512 * j) * 4);
#pragma unroll
              for (int j = 0; j < 8; ++j) rq[2 + j] = *(const f32x4*)(INP(I_REW) + (size_t)l * 16384 + (size_t)(tid + 512 * (j & 1)) * 16 + 4 * (j >> 1));
#pragma unroll
              for (int j = 0; j < 2; ++j) { LAS float* p = wr_ + tid + 512 * j; p[0] = rq[j][0]; p[1024] = rq[j][1]; p[2048] = rq[j][2]; p[3072] = rq[j][3]; }
#pragma unroll
              for (int j = 0; j < 8; ++j) { LAS float* p = wr_ + (4 + 4 * (j >> 1)) * 1024 + tid + 512 * (j & 1); p[0] = rq[2 + j][0]; p[1024] = rq[2 + j][1]; p[2048] = rq[2 + j][2]; p[3072] = rq[2 + j][3]; } }
            __syncthreads();
            const float* g1 = INP(I_LN1G) + l * 1024, *b1 = INP(I_LN1B) + l * 1024;
            const float rgb_l = INP(I_RGB)[l * 4 + ((lane >> 4) & 3)], reb_l = INP(I_REB)[l * 16 + ((lane >> 2) & 15)];
            constexpr int RT = 2;
            for (int rowb = gw; rowb < nrows2; rowb += RT * NGW) {
                f32x4 v[RT][4];
#pragma unroll
                for (int q = 0; q < RT; ++q) { const int row_ = rowb + q * NGW, row = row_ < nrows2 ? row_ : nrows2 - 1; const bool live = row_ < nrows2;
                    float* hrow = row < NLAT ? hlat + (size_t)row * D : hctx + (size_t)(row - NLAT) * D;
                    const int mi = row < NLAT ? (row >> 11) : 8; const float* mrow = mv + mi * 6144;
                    v2u yw[4]; f32x4 hv[4], gt[4], g1v[4], b1v[4], scv[4], shv[4];
#pragma unroll
                    for (int j = 0; j < 4; ++j) { const int c = 4 * lane + 256 * j; yw[j] = *(const v2u*)((const bf16*)YB + (size_t)row * D + c); hv[j] = *(const f32x4*)(hrow + c); gt[j] = *(const f32x4*)(mrow + 2048 + c); }
#pragma unroll
                    for (int j = 0; j < 4; ++j) { const int c = 4 * lane + 256 * j; g1v[j] = *(const f32x4*)(g1 + c); b1v[j] = *(const f32x4*)(b1 + c); scv[j] = *(const f32x4*)(mrow + 4096 + c); shv[j] = *(const f32x4*)(mrow + 3072 + c); }
#pragma unroll
                    for (int j = 0; j < 4; ++j) { const f32x4 yv = (f32x4){bflo(yw[j].x), bfhi(yw[j].x), bflo(yw[j].y), bfhi(yw[j].y)}; v[q][j] = hv[j] * DN_ALPHA + gt[j] * yv; }
                    ln_rows(v[q]);
#pragma unroll
                    for (int j = 0; j < 4; ++j) { const int c = 4 * lane + 256 * j; v[q][j] = v[q][j] * g1v[j] + b1v[j]; if (live) *(f32x4*)(hrow + c) = v[q][j]; }
                    ln_rows(v[q]);
#pragma unroll
                    for (int j = 0; j < 4; ++j) { const int c = 4 * lane + 256 * j; v[q][j] = v[q][j] * (scv[j] + 1.0f) + shv[j];
                        v2u w; w.x = pk2(v[q][j][0], v[q][j][1]); w.y = pk2(v[q][j][2], v[q][j][3]); if (live) *(v2u*)(XN + (size_t)row * D + c) = w; }
                    asm volatile("" ::: "memory"); }
                static_assert(RT == 2, "the two rows of a trip ride in the two halves of packed f32 operations");
                float pg[RT][4], pe[RT][16];
                { f32x2 vp[4][4];
#pragma unroll
                  for (int j = 0; j < 4; ++j)
#pragma unroll
                      for (int e = 0; e < 4; ++e) vp[j][e] = (f32x2){v[0][j][e], v[1][j][e]};
#pragma unroll
                  for (int o = 0; o < 20; ++o) { f32x2 sr = (f32x2){0.f, 0.f};
#pragma unroll
                    for (int j = 0; j < 4; ++j) { const f32x4 w = *(const LAS f32x4*)(wr_ + o * 1024 + 4 * lane + 256 * j);
#pragma unroll
                        for (int e = 0; e < 4; ++e) sr += vp[j][e] * w[e]; }
                    if (o < 4) { pg[0][o] = sr[0]; pg[1][o] = sr[1]; } else { pe[0][o - 4] = sr[0]; pe[1][o - 4] = sr[1]; }
                    if ((o & 3) == 3) asm volatile("" ::: "memory"); } }
#pragma unroll
                for (int q = 0; q < RT; ++q) { const int row = rowb + q * NGW;
                float tg = reduce4(pg[q], lane), te = reduce16(pe[q], lane);
                tg += rgb_l; te += reb_l;
                float lg[20];
#pragma unroll
                for (int o = 0; o < 4; ++o) lg[o] = __shfl(tg, o * 16);
#pragma unroll
                for (int o = 0; o < 16; ++o) lg[4 + o] = __shfl(te, o * 4);
                int gs = 0; float gm = lg[0];
#pragma unroll
                for (int o = 1; o < 4; ++o) if (lg[o] > gm) { gm = lg[o]; gs = o; }
                float den = 0.f;
#pragma unroll
                for (int o = 0; o < 4; ++o) den += __expf(lg[o] - gm);
                const float gp = __builtin_amdgcn_rcpf(den);
                float el[4];
#pragma unroll
                for (int o = 0; o < 4; ++o) el[o] = gs == 0 ? lg[4 + o] : gs == 1 ? lg[8 + o] : gs == 2 ? lg[12 + o] : lg[16 + o];
                int i0 = 0; float v0 = el[0];
#pragma unroll
                for (int o = 1; o < 4; ++o) if (el[o] > v0) { v0 = el[o]; i0 = o; }
                int i1 = -1; float v1 = 0.f;
#pragma unroll
                for (int o = 0; o < 4; ++o) if (o != i0 && (i1 < 0 || el[o] > v1)) { v1 = el[o]; i1 = o; }
                const float ex = __expf(v1 - v0), rz = __builtin_amdgcn_rcpf(1.0f + ex), w0 = gp * rz, w1 = gp * ex * rz;
                const int e0 = gs * 4 + i0, e1 = gs * 4 + i1;
                if (lane == 0 && row < nrows2) {
                    const unsigned p0 = __hip_atomic_fetch_add((LAS unsigned*)lcnt + e0, 1u, __ATOMIC_RELAXED, __HIP_MEMORY_SCOPE_WORKGROUP);
                    const unsigned p1 = __hip_atomic_fetch_add((LAS unsigned*)lcnt + e1, 1u, __ATOMIC_RELAXED, __HIP_MEMORY_SCOPE_WORKGROUP);
                    float* rt = ROUTE + (size_t)row * 8;
                    rt[0] = __builtin_bit_cast(float, e0); rt[1] = __builtin_bit_cast(float, e1); rt[2] = w0; rt[3] = w1; rt[4] = __builtin_bit_cast(float, (int)p0); rt[5] = __builtin_bit_cast(float, (int)p1);
                }
                asm volatile("" ::: "memory"); }
            }
            __syncthreads();
            if (tid < 16) { const unsigned c = lcnt[tid]; lcnt[16 + tid] = c ? __hip_atomic_fetch_add(moecnt + 64 * tid, c, __ATOMIC_RELAXED, __HIP_MEMORY_SCOPE_AGENT) : 0u; }
            __syncthreads();
            for (int row = gw + lane * NGW; row < nrows2; row += 64 * NGW) {
                { float* rt = ROUTE + (size_t)row * 8; const int e0 = __builtin_bit_cast(int, rt[0]), e1 = __builtin_bit_cast(int, rt[1]);
                    const int q0 = __builtin_bit_cast(int, rt[4]) + (int)lcnt[16 + e0], q1 = __builtin_bit_cast(int, rt[5]) + (int)lcnt[16 + e1];
                    rt[4] = __builtin_bit_cast(float, q0); rt[5] = __builtin_bit_cast(float, q1);
                    ELIST[(size_t)e0 * NTOK + q0] = row; ELIST[(size_t)e1 * NTOK + q1] = row; }
            }
        } }
        SEAM(pb + 9);


        for (int rep_ = 0; rep_ <= (int)PH_REP(12); ++rep_) { if (rep_) GRID_BAR();
        if (PH_ON(12) && IN(pb + 11)) { PH_BEGIN(); const float* mv = modv + (size_t)l * 9 * 6144; (void)mv; unsigned* const moecnt = ctl + CW_MOE + l * 16 * 64; (void)moecnt;
            SchedMoeG S; S.G = X.G; S.c = X.bid; S.a0 = (const char*)XN; S.w0 = (const char*)WGU; S.wstep_e = (size_t)1024 * 1024 * 2; S.wstep_n = (size_t)256 * 1024 * 2; S.list = ELIST; S.init(moecnt, (LAS unsigned*)(lds + LDSCTL_OFF + 64));
            EpiMoe1 E{HID};
            pg8::gemm_phase<EpiMoe1, SchedMoeG, true, true>(lds, Gemm{1024, 1024, 1024}, S, E);
        } }
        SEAM(pb + 11);

        for (int rep_ = 0; rep_ <= (int)PH_REP(13); ++rep_) { if (rep_) GRID_BAR();
        if (PH_ON(13) && IN(pb + 12)) { PH_BEGIN(); const float* mv = modv + (size_t)l * 9 * 6144; (void)mv; unsigned* const moecnt = ctl + CW_MOE + l * 16 * 64; (void)moecnt;
            SchedMoe S; S.G = X.G; S.c = X.bid; S.a0 = (const char*)HID; S.w0 = (const char*)WDN; S.astep = (size_t)256 * 512 * 2; S.wstep_e = (size_t)1024 * 512 * 2; S.wstep_n = (size_t)256 * 512 * 2; S.init(moecnt);
            EpiBf16<0> E{MO, 1024, nullptr};
            pg8::gemm_phase<EpiBf16<0>, SchedMoe, true, true>(lds, Gemm{512, 512, 512}, S, E);
        } }
        SEAM(pb + 12);

        for (int rep_ = 0; rep_ <= (int)PH_REP(14); ++rep_) { if (rep_) GRID_BAR();
        if (PH_ON(14) && IN(pb + 13)) { PH_BEGIN(); const float* mv = modv + (size_t)l * 9 * 6144; (void)mv; unsigned* const moecnt = ctl + CW_MOE + l * 16 * 64; (void)moecnt;
            unsigned pre[16]; { unsigned s = 0;
#pragma unroll
                for (int e = 0; e < 16; ++e) { pre[e] = s; s += ((__hip_atomic_load(moecnt + 64 * e, __ATOMIC_RELAXED, __HIP_MEMORY_SCOPE_AGENT) + 255u) >> 8) << 8; } }
            const float* g2 = INP(I_LN2G) + l * 1024, *b2 = INP(I_LN2B) + l * 1024;
            for (int rowb = gw; rowb < nrows2; rowb += 3 * NGW) {
                int re0[3], re1[3], rp0[3], rp1[3]; float rw0[3], rw1[3];
#pragma unroll
                for (int k = 0; k < 3; ++k) { const int row_ = rowb + k * NGW, row = row_ < nrows2 ? row_ : nrows2 - 1; const float* rt = ROUTE + (size_t)row * 8;
                    re0[k] = __builtin_bit_cast(int, rt[0]); re1[k] = __builtin_bit_cast(int, rt[1]); rw0[k] = rt[2]; rw1[k] = rt[3]; rp0[k] = __builtin_bit_cast(int, rt[4]); rp1[k] = __builtin_bit_cast(int, rt[5]); }
                v2u ma[3][4], mb[3][4]; f32x4 hv[3][4];
#pragma unroll
                for (int k = 0; k < 3; ++k) { const int row_ = rowb + k * NGW, row = row_ < nrows2 ? row_ : nrows2 - 1; {
                    const int e0 = re0[k], e1 = re1[k]; unsigned ba0 = 0, ba1 = 0;
#pragma unroll
                    for (int q = 0; q < 16; ++q) { ba0 = (q == e0) ? pre[q] : ba0; ba1 = (q == e1) ? pre[q] : ba1; }
                    const bf16* m0 = MO + (size_t)(ba0 + (unsigned)rp0[k]) * D, *m1 = MO + (size_t)(ba1 + (unsigned)rp1[k]) * D;
                    const float* hrow = row < NLAT ? hlat + (size_t)row * D : hctx + (size_t)(row - NLAT) * D;
#pragma unroll
                    for (int j = 0; j < 4; ++j) { const int c = 4 * lane + 256 * j; ma[k][j] = *(const v2u*)(m0 + c); mb[k][j] = *(const v2u*)(m1 + c); hv[k][j] = *(const f32x4*)(hrow + c); } } }
#pragma unroll
                for (int k = 0; k < 3; ++k) { const int row_ = rowb + k * NGW, row = row_ < nrows2 ? row_ : nrows2 - 1; {
                    float* hrow = row < NLAT ? hlat + (size_t)row * D : hctx + (size_t)(row - NLAT) * D;
                    const int mi = row < NLAT ? (row >> 11) : 8; const float* mrow = mv + mi * 6144; const float w0 = rw0[k], w1 = rw1[k];
                    f32x4 v[4], gtv[4], g2v[4], b2v[4];
#pragma unroll
                    for (int j = 0; j < 4; ++j) { const int c = 4 * lane + 256 * j; gtv[j] = *(const f32x4*)(mrow + 5120 + c); g2v[j] = *(const f32x4*)(g2 + c); b2v[j] = *(const f32x4*)(b2 + c); }
#pragma unroll
                    for (int j = 0; j < 4; ++j) { const v2u a = ma[k][j], b = mb[k][j];
                        f32x4 mm; mm[0] = w0 * bflo(a.x) + w1 * bflo(b.x); mm[1] = w0 * bfhi(a.x) + w1 * bfhi(b.x); mm[2] = w0 * bflo(a.y) + w1 * bflo(b.y); mm[3] = w0 * bfhi(a.y) + w1 * bfhi(b.y);
                        v[j] = hv[k][j] * DN_ALPHA + gtv[j] * mm; }
                    ln_rows(v);
                    if (row_ < nrows2) {
#pragma unroll
                    for (int j = 0; j < 4; ++j) { const int c = 4 * lane + 256 * j; *(f32x4*)(hrow + c) = v[j] * g2v[j] + b2v[j]; } } } }
            }
        } }
        SEAM(pb + 13);
    }
#if TPROBE
    {
        GRID_BAR(); STAMP(NPHASES); GRID_BAR();
        unsigned* ts = (unsigned*)(args.ws + WS_CTL) + CW_TS; float T = 0.f;
        for (int l2 = 0; l2 < 2; ++l2) { const int p = (TPA) == 100 ? 0 : 1 + NPH_LAYER * l2 + (TPA);
            if ((TPA) != 100 || l2 == 0) T += (float)(__hip_atomic_load(ts + p + 1, __ATOMIC_RELAXED, __HIP_MEMORY_SCOPE_AGENT) - __hip_atomic_load(ts + p, __ATOMIC_RELAXED, __HIP_MEMORY_SCOPE_AGENT)) * 0.01f; }
        for (size_t i = (size_t)blockIdx.x * 512 + threadIdx.x; i < (size_t)NLAT * D; i += (size_t)gridDim.x * 512) { const int j = (int)(i >> 19);
            if (T >= (float)(TOFF) + 20.0f * (float)(j + 1)) args.out[i] += 0.2f; }
    }
#endif
#undef IN
#undef SEAM
}

extern "C" void kernel_launch(void* const* d_in, const int* in_sizes, int n_in, void* d_out, int out_size, void* d_ws, size_t ws_size, hipStream_t stream) {
    static int grid = 0;
    if (grid == 0) {
        if (n_in != 34 || out_size != NLAT * D || ws_size < WS_END) { fprintf(stderr, "kernel_launch: unexpected problem (n_in %d out %d ws %zu)\n", n_in, out_size, ws_size); grid = -1; return; }
        int dev = 0, cus = 0, per_cu = 0;
        if (hipGetDevice(&dev) != hipSuccess || hipDeviceGetAttribute(&cus, hipDeviceAttributeMultiprocessorCount, dev) != hipSuccess) { grid = -1; return; }
        if (hipFuncSetAttribute((const void*)fwd, hipFuncAttributeMaxDynamicSharedMemorySize, LDS_BYTES) != hipSuccess) { fprintf(stderr, "kernel_launch: hipFuncSetAttribute failed\n"); grid = -1; return; }
        if (hipOccupancyMaxActiveBlocksPerMultiprocessor(&per_cu, (const void*)fwd, NWAVES * 64, LDS_BYTES) != hipSuccess || per_cu < 1) { fprintf(stderr, "kernel_launch: occupancy query reports %d\n", per_cu); }
        (void)hipGetLastError();
        grid = cus;
    }
    if (grid < 0) return;
    if (hipMemsetAsync((char*)d_ws + WS_CTL, 0, CTL_ZERO_BYTES, stream) != hipSuccess) return;
    Args a{};
    for (int i = 0; i < 34; ++i) a.in[i] = (const float*)d_in[i];
    a.out = (float*)d_out; a.ws = (unsigned char*)d_ws;
#if MK_ONE_LAUNCH
    a.ph_lo = 0; a.ph_hi = NPHASES;
    hipLaunchKernelGGL(fwd, dim3(grid), dim3(NWAVES * 64), LDS_BYTES, stream, a);
#else
    for (int p = 0; p < NPHASES; ++p) { a.ph_lo = p; a.ph_hi = p + 1; hipLaunchKernelGGL(fwd, dim3(grid), dim3(NWAVES * 64), LDS_BYTES, stream, a); }
#endif
}
```

```cpp
#include <hip/hip_runtime.h>
#include <cstdio>
#include <cstdint>

#define GAS __attribute__((address_space(1)))
#define LAS __attribute__((address_space(3)))
typedef unsigned short bf16;
typedef unsigned v4u __attribute__((ext_vector_type(4)));
typedef unsigned v2u __attribute__((ext_vector_type(2)));
typedef float f32x4 __attribute__((ext_vector_type(4)));
typedef float f32x2 __attribute__((ext_vector_type(2)));
typedef short bf16x8 __attribute__((ext_vector_type(8)));

constexpr int D = 1024, NB = 8, SEQ = 2048, CTXL = 256, NLAT = NB * SEQ, NCTX = NB * CTXL, NTOK = NLAT + NCTX;
constexpr int OFF_Q = 0, OFF_K = 512, OFF_V = 1024, OFF_Z = 1536, OFF_A = 2048, OFF_B = 2056, OFF_CONF = 2064, OFF_FFT = 3088, OFF_SGU = 3600, OFF_GATE = 4624, N_IN = 8720;
constexpr int NWROWS = 9216;
constexpr float LN_EPS = 1e-6f;
constexpr float DN_ALPHA = 1.4142135623730951f;
constexpr int NWAVES = 8;
constexpr int NPH_LAYER = 14, NPHASES = 1 + 2 * NPH_LAYER;

#ifndef PHMASK
#define PHMASK 0xFFFFFFFFu
#endif
#define PH_ON(k) (((PHMASK) >> (k)) & 1u)
#ifndef REPMASK
#define REPMASK 0u
#endif
#define PH_REP(k) (((REPMASK) >> (k)) & 1u)
#ifndef TPA
#define TPA -1
#endif
#ifndef TPB
#define TPB -1
#endif
#ifndef TOFF
#define TOFF 0
#endif
#define TPROBE ((TPA) >= 0 || (TPB) >= 0)
#ifndef CPART
#define CPART 15
#endif
#ifndef MK_ONE_LAUNCH
#define MK_ONE_LAUNCH 1
#endif

constexpr size_t MiB = 1u << 20;
constexpr size_t WS_CTL = 0, CTL_ZERO_BYTES = 128 * 1024;
constexpr size_t WS_MODV = 1 * MiB;
constexpr size_t WS_BIN = 1 * MiB + 512 * 1024;
constexpr size_t WS_ROUTE = WS_BIN + 64 * 1024;
constexpr size_t WS_HCTX = 3 * MiB;
constexpr size_t WS_XN = 11 * MiB;
constexpr size_t WS_WIN = 47 * MiB;
constexpr size_t WS_WBR = 65 * MiB;
constexpr size_t WS_WOUT = 69 * MiB;
constexpr size_t WS_DFTL = 71 * MiB;
constexpr size_t WS_DFTC = 87 * MiB;
constexpr size_t WS_F1B = 71 * MiB;
constexpr size_t WS_R2 = 88 * MiB;
constexpr size_t WS_PQKV = WS_R2;
constexpr size_t WS_PCONF = WS_R2 + 54 * MiB;
constexpr size_t WS_PZ = WS_R2 + 72 * MiB;
constexpr size_t WS_PSGU = WS_R2 + 90 * MiB;
constexpr size_t WS_PFFT = WS_R2 + 126 * MiB;
constexpr size_t WS_PFFTC = WS_R2 + 158 * MiB;
constexpr size_t WS_AB = WS_R2 + 162 * MiB;
constexpr size_t WS_WIT = WS_R2;
constexpr size_t WS_UIT = WS_R2 + 36 * MiB;
constexpr size_t WS_AIT = WS_R2 + 90 * MiB;
constexpr size_t WS_KIT = WS_R2 + 108 * MiB;
constexpr size_t WS_SIT = WS_R2 + 126 * MiB;
constexpr size_t WS_OF = WS_R2 + 128 * MiB;
constexpr size_t WS_OB = WS_R2 + 146 * MiB;
constexpr size_t WS_G = WS_R2;
constexpr size_t WS_WGU = WS_R2;
constexpr size_t WS_WDN = WS_R2 + 32 * MiB;
constexpr size_t WS_XG = WS_R2 + 48 * MiB;
constexpr size_t WS_R3 = WS_R2 + 164 * MiB;
constexpr size_t WS_QKV = WS_R3;
constexpr size_t WS_GB = WS_R3 + 54 * MiB;
constexpr size_t WS_BR = WS_R3 + 72 * MiB;
constexpr size_t WS_F1A = WS_BR;
constexpr size_t WS_MERGED = WS_R3;
constexpr size_t WS_Y = WS_R3 + 72 * MiB;
constexpr size_t WS_HID = WS_R3;
constexpr size_t WS_MO = WS_R3 + 40 * MiB;
constexpr size_t WS_LIST = WS_R3 + 144 * MiB;
constexpr size_t WS_END = WS_LIST + 2 * MiB;
static_assert(WS_END <= 405 * MiB, "workspace map");
constexpr int CW_BAR = 4096;
constexpr int CW_MOE = 16384;

constexpr int RING_BYTES = 131072;
constexpr int LDSCTL_OFF = RING_BYTES, MISC_OFF = LDSCTL_OFF + 320;
constexpr int LDS_BYTES = 147456;

#define LDS_WAIT() asm volatile("s_waitcnt lgkmcnt(0)" ::: "memory")
#define VM_WAIT() asm volatile("s_waitcnt vmcnt(0)" ::: "memory")
typedef __bf16 bf16x2_t __attribute__((ext_vector_type(2)));
__device__ __forceinline__ unsigned pk2(float lo, float hi) { const f32x2 v = {lo, hi}; const bf16x2_t b = __builtin_convertvector(v, bf16x2_t); return __builtin_bit_cast(unsigned, b); }
__device__ __forceinline__ unsigned f2bf(float f) { return pk2(f, 0.0f) & 0xffffu; }
__device__ __forceinline__ float bflo(unsigned w) { return __builtin_bit_cast(float, w << 16); }
__device__ __forceinline__ float bfhi(unsigned w) { return __builtin_bit_cast(float, w & 0xffff0000u); }
__device__ __forceinline__ float bf1(bf16 b) { return __builtin_bit_cast(float, ((unsigned)b) << 16); }
__device__ __forceinline__ void unpack8(const v4u w, float (&o)[8]) { o[0] = bflo(w.x); o[1] = bfhi(w.x); o[2] = bflo(w.y); o[3] = bfhi(w.y); o[4] = bflo(w.z); o[5] = bfhi(w.z); o[6] = bflo(w.w); o[7] = bfhi(w.w); }
__device__ __forceinline__ v4u pack8(const float (&o)[8]) { v4u w; w.x = pk2(o[0], o[1]); w.y = pk2(o[2], o[3]); w.z = pk2(o[4], o[5]); w.w = pk2(o[6], o[7]); return w; }
__device__ __forceinline__ void fsincospi(float x, float* sn, float* cs) { *sn = __builtin_amdgcn_sinf(0.5f * x); *cs = __builtin_amdgcn_cosf(0.5f * x); }
__device__ __forceinline__ float sigmoidf_(float x) { return __builtin_amdgcn_rcpf(1.0f + __expf(-x)); }
__device__ __forceinline__ float siluf_(float x) { return x * __builtin_amdgcn_rcpf(1.0f + __expf(-x)); }
__device__ __forceinline__ float gelu_tanh(float x) { const float u = 0.7978845608028654f * (x + 0.044715f * x * x * x); return x * __builtin_amdgcn_rcpf(1.0f + __expf(-2.0f * u)); }
__device__ __forceinline__ float wave_sum(float v) {
#pragma unroll
    for (int o = 1; o < 64; o <<= 1) v += __shfl_xor(v, o);
    return v;
}
__device__ __forceinline__ float reduce16(const float (&v)[16], int lane) {
    const bool b5 = (lane & 32) != 0, b4 = (lane & 16) != 0, b3 = (lane & 8) != 0, b2 = (lane & 4) != 0;
    float a[8], b[4], c[2];
#pragma unroll
    for (int i = 0; i < 8; ++i) a[i] = (b5 ? v[i + 8] : v[i]) + __shfl_xor(b5 ? v[i] : v[i + 8], 32);
#pragma unroll
    for (int i = 0; i < 4; ++i) b[i] = (b4 ? a[i + 4] : a[i]) + __shfl_xor(b4 ? a[i] : a[i + 4], 16);
#pragma unroll
    for (int i = 0; i < 2; ++i) c[i] = (b3 ? b[i + 2] : b[i]) + __shfl_xor(b3 ? b[i] : b[i + 2], 8);
    float d = (b2 ? c[1] : c[0]) + __shfl_xor(b2 ? c[0] : c[1], 4);
    d += __shfl_xor(d, 2); d += __shfl_xor(d, 1);
    return d;
}
__device__ __forceinline__ float reduce4(const float (&v)[4], int lane) {
    const bool b5 = (lane & 32) != 0, b4 = (lane & 16) != 0; float a[2];
#pragma unroll
    for (int i = 0; i < 2; ++i) a[i] = (b5 ? v[i + 2] : v[i]) + __shfl_xor(b5 ? v[i] : v[i + 2], 32);
    float d = (b4 ? a[1] : a[0]) + __shfl_xor(b4 ? a[0] : a[1], 16);
    d += __shfl_xor(d, 8); d += __shfl_xor(d, 4); d += __shfl_xor(d, 2); d += __shfl_xor(d, 1);
    return d;
}
__device__ __forceinline__ float g16_sum(float v) {
#pragma unroll
    for (int o = 1; o < 16; o <<= 1) v += __shfl_xor(v, o);
    return v;
}

namespace pg8 {
constexpr int BM = 256, BK = 64, HALF = 128, HTB = HALF * BK * 2, STAGE_BYTES = 8 * HTB;
__host__ __device__ __forceinline__ int lds_byte(int r, int c) { const int st = (r >> 4) * 2 + (c >> 5), rr = r & 15, cc = c & 31, ob = rr * 64 + cc * 2; return st * 1024 + (ob ^ (((ob >> 9) & 1) << 5)); }
__host__ __device__ __forceinline__ void stage_rc(int b, int& R, int& C) { const int st = b / 1024, sb = b % 1024, swz = sb ^ (((sb >> 9) & 1) << 5); R = (st >> 1) * 16 + swz / 64; C = (st & 1) * 32 + (swz % 64) / 2; }
__host__ __device__ __forceinline__ int perm32(int rho) { const int n = rho >> 4, i = rho & 15; return 8 * (i >> 2) + 4 * n + (i & 3); }

struct Unit { int pm, pn, aux, ax2; const char* a; const char* b; };
struct Gemm { int K, lda, ldb; };

__device__ __forceinline__ void map_tile(int L, int nM, int nN, int& pm, int& pn) {
    const int nwg = nM * nN; int wgid = L; { const int q = nwg / 8, r = nwg % 8, xcd = wgid % 8, off = wgid / 8; wgid = (xcd < r ? xcd * (q + 1) : r * (q + 1) + (xcd - r) * q) + off; }
    const int nig = 8 * nN, gid = wgid / nig, fm = gid * 8, gsz = (nM - fm) < 8 ? (nM - fm) : 8;
    pm = fm + ((wgid % nig) % gsz); pn = (wgid % nig) / gsz;
}
__device__ __forceinline__ unsigned cvt_pk_bf16(float lo, float hi) { unsigned r; asm volatile("v_cvt_pk_bf16_f32 %0, %1, %2" : "=v"(r) : "v"(lo), "v"(hi)); return r; }

template <class Epi, class Sched, bool ALIGN_EPI, bool SP2>
__device__ __forceinline__ void gemm_phase(LAS unsigned char* lds, const Gemm g, const Sched& S, const Epi& E) {
    int tid_l = threadIdx.x; asm volatile("" : "+v"(tid_l));
    const int tid = tid_l, wid = __builtin_amdgcn_readfirstlane(tid >> 6), lane = tid & 63, wr = wid >> 2, wc = wid & 3, fr = lane & 15, fq = lane >> 4;
    const int K = g.K, nt = K / BK;
    unsigned voffA[2], voffB[2];
#pragma unroll
    for (int i = 0; i < 2; ++i) { int R, C; stage_rc(tid * 16 + i * 8192, R, C); const int Rb = Epi::PERM ? ((R & ~31) + perm32(R & 31)) : R;
        voffA[i] = (unsigned)(R * g.lda + C) * 2u; voffB[i] = (unsigned)(Rb * g.ldb + C) * 2u; }
    static_assert(!Sched::GATHER || SP2, "gathered A rows: only the SP2 loop");
    unsigned vA[2][2], vAn[2][2];
#define PG8_GCALC(dst, u_) do { _Pragma("unroll") for (int i_ = 0; i_ < 2; ++i_) { int R_, C_; stage_rc(tid * 16 + i_ * 8192, R_, C_); _Pragma("unroll") for (int h_ = 0; h_ < 2; ++h_) dst[h_][i_] = S.arow(u_, R_ + 128 * h_) + (unsigned)C_ * 2u; } } while (0)
#define PG8_STAGE_A(bufoff, base, h, nextsel) do { if constexpr (Sched::GATHER) { unsigned vs_[2]; vs_[0] = (nextsel) ? vAn[h][0] : vA[h][0]; vs_[1] = (nextsel) ? vAn[h][1] : vA[h][1]; PG8_STAGE(bufoff, base, vs_); } \
        else { PG8_STAGE(bufoff, (base) + (h) * hstepA, voffA); } } while (0)
    const size_t kstep = (size_t)(BK * 2);
    const size_t hstepA = (size_t)HALF * g.lda * 2, hstepB = (size_t)HALF * g.ldb * 2;
    const unsigned ldsw = (unsigned)wid * 1024u;
    const int aoff = lds_byte(wr * 64 + fr, fq * 8), boff = lds_byte(wc * 32 + fr, fq * 8);
#define PG8_SA(b, h) (((b) * 2 + (h)) * HTB)
#define PG8_SB(b, h) ((4 + (b) * 2 + (h)) * HTB)
#define PG8_STAGE(bufoff, gbase, voff) do { _Pragma("unroll") for (int _i = 0; _i < 2; ++_i) \
        __builtin_amdgcn_global_load_lds((const unsigned*)((const char*)(gbase) + (voff)[_i]), (LAS unsigned*)(lds + (bufoff) + ldsw + _i * 8192), 16, 0, 0); } while (0)
#define PG8_LDA(dst, b, h) do { _Pragma("unroll") for (int m = 0; m < 4; ++m) _Pragma("unroll") for (int k = 0; k < 2; ++k) dst[m][k] = *(const LAS bf16x8*)(lds + PG8_SA(b, h) + aoff + m * 2048 + k * 1024); } while (0)
#define PG8_LDB(dst, b, h) do { _Pragma("unroll") for (int n = 0; n < 2; ++n) _Pragma("unroll") for (int k = 0; k < 2; ++k) dst[n][k] = *(const LAS bf16x8*)(lds + PG8_SB(b, h) + boff + n * 2048 + k * 1024); } while (0)
#define PG8_MMA(ai, bj, At, Bt) do { __builtin_amdgcn_s_setprio(1); _Pragma("unroll") for (int m = 0; m < 4; ++m) _Pragma("unroll") for (int n = 0; n < 2; ++n) _Pragma("unroll") for (int k = 0; k < 2; ++k) \
        acc[ai][bj][m][n] = __builtin_amdgcn_mfma_f32_16x16x32_bf16(Bt[n][k], At[m][k], acc[ai][bj][m][n], 0, 0, 0); __builtin_amdgcn_s_setprio(0); } while (0)
#define PG8_WAIT_V(n) asm volatile("s_waitcnt vmcnt(" #n ")" ::: "memory")
#define PG8_WAIT_L(n) asm volatile("s_waitcnt lgkmcnt(" #n ")" ::: "memory")
#define PG8_BAR __builtin_amdgcn_s_barrier()
#define PG8_SCHED __builtin_amdgcn_sched_barrier(0)
    Unit cur, nxt; int ui = 0;
    if (!S.next(0, cur)) return;
    f32x4 acc[2][2][4][2];
#pragma unroll
    for (int a = 0; a < 2; ++a)
#pragma unroll
        for (int b = 0; b < 2; ++b)
#pragma unroll
            for (int m = 0; m < 4; ++m)
#pragma unroll
                for (int n = 0; n < 2; ++n) acc[a][b][m][n] = (f32x4){0.f, 0.f, 0.f, 0.f};
    bf16x8 At[4][2], B0[2][2], B1[2][2];
    const char* cA = cur.a; const char* cB = cur.b;
    if constexpr (SP2) {
        if constexpr (Sched::GATHER) { PG8_GCALC(vA, cur); }
        PG8_STAGE(PG8_SB(0, 0), cB, voffB); PG8_STAGE(PG8_SB(0, 1), cB + hstepB, voffB); PG8_STAGE_A(PG8_SA(0, 0), cA, 0, false); PG8_STAGE_A(PG8_SA(0, 1), cA, 1, false);
        if (wr == 1) PG8_BAR;
        PG8_WAIT_V(2); PG8_BAR;
        PG8_STAGE(PG8_SB(1, 0), cB + kstep, voffB); PG8_STAGE_A(PG8_SA(1, 0), cA + kstep, 0, false); PG8_STAGE(PG8_SB(1, 1), cB + hstepB + kstep, voffB);
        PG8_WAIT_V(6); PG8_BAR;
    } else {
        PG8_STAGE(PG8_SB(0, 0), cB, voffB); PG8_STAGE(PG8_SA(0, 0), cA, voffA); PG8_STAGE(PG8_SB(0, 1), cB + hstepB, voffB); PG8_STAGE(PG8_SA(0, 1), cA + hstepA, voffA);
        if (wr == 1) PG8_BAR;
        PG8_WAIT_V(4); PG8_BAR;
        PG8_STAGE(PG8_SB(1, 0), cB + kstep, voffB); PG8_STAGE(PG8_SA(1, 0), cA + kstep, voffA); PG8_STAGE(PG8_SB(1, 1), cB + hstepB + kstep, voffB);
        PG8_WAIT_V(6); PG8_BAR;
    }
    for (;;) {
        const bool has_next = S.next(ui + 1, nxt);
        const char* nA = has_next ? nxt.a : cA; const char* nB = has_next ? nxt.b : cB;
        if constexpr (Sched::GATHER) { if (has_next) { PG8_GCALC(vAn, nxt); } else {
#pragma unroll
            for (int h_ = 0; h_ < 2; ++h_)
#pragma unroll
                for (int i_ = 0; i_ < 2; ++i_) vAn[h_][i_] = vA[h_][i_]; } }
        for (int t = 0; t < nt; t += 2) {
            const bool last = (t == nt - 2);
            const char* a1 = cA + (size_t)(t + 1) * kstep;
            const char* a2 = last ? nA : cA + (size_t)(t + 2) * kstep; const char* b2 = last ? nB : cB + (size_t)(t + 2) * kstep;
            const char* a3 = a2 + kstep; const char* b3 = b2 + kstep;
            if constexpr (SP2) {
            PG8_LDB(B0, 0, 0); PG8_LDB(B1, 0, 1); PG8_SCHED; PG8_LDA(At, 0, 0); PG8_STAGE_A(PG8_SA(1, 1), a1, 1, false);
            PG8_WAIT_V(8); PG8_WAIT_L(0); PG8_BAR; PG8_MMA(0, 0, At, B0); PG8_MMA(0, 1, At, B1); PG8_BAR; PG8_SCHED;
            PG8_LDA(At, 0, 1); PG8_STAGE(PG8_SB(0, 0), b2, voffB); PG8_STAGE(PG8_SB(0, 1), b2 + hstepB, voffB); PG8_STAGE_A(PG8_SA(0, 0), a2, 0, last);
            PG8_WAIT_V(8); PG8_WAIT_L(0); PG8_BAR; PG8_MMA(1, 0, At, B0); PG8_MMA(1, 1, At, B1); PG8_BAR; PG8_SCHED;
            PG8_LDB(B0, 1, 0); PG8_LDB(B1, 1, 1); PG8_SCHED; PG8_LDA(At, 1, 0); PG8_STAGE_A(PG8_SA(0, 1), a2, 1, last);
            PG8_WAIT_V(8); PG8_WAIT_L(0); PG8_BAR; PG8_MMA(0, 0, At, B0); PG8_MMA(0, 1, At, B1); PG8_BAR; PG8_SCHED;
            PG8_LDA(At, 1, 1); PG8_STAGE(PG8_SB(1, 0), b3, voffB); PG8_STAGE(PG8_SB(1, 1), b3 + hstepB, voffB); PG8_STAGE_A(PG8_SA(1, 0), a3, 0, last);
            PG8_WAIT_V(8); PG8_WAIT_L(0); PG8_BAR; PG8_MMA(1, 0, At, B0); PG8_MMA(1, 1, At, B1); PG8_BAR; PG8_SCHED;
            } else {
            PG8_LDB(B0, 0, 0); PG8_SCHED; PG8_LDA(At, 0, 0); PG8_STAGE(PG8_SA(1, 1), a1 + hstepA, voffA);
            PG8_WAIT_L(8); PG8_BAR; PG8_WAIT_L(0); PG8_MMA(0, 0, At, B0); PG8_BAR; PG8_SCHED;
            PG8_LDB(B1, 0, 1); PG8_STAGE(PG8_SB(0, 0), b2, voffB);
            PG8_BAR; PG8_WAIT_L(0); PG8_MMA(0, 1, At, B1); PG8_BAR;
            PG8_LDA(At, 0, 1); PG8_STAGE(PG8_SA(0, 0), a2, voffA);
            PG8_BAR; PG8_WAIT_L(0); PG8_MMA(1, 0, At, B0); PG8_BAR; PG8_SCHED;
            PG8_STAGE(PG8_SB(0, 1), b2 + hstepB, voffB);
            PG8_WAIT_V(6); PG8_BAR; PG8_MMA(1, 1, At, B1); PG8_BAR;
            PG8_LDB(B0, 1, 0); PG8_SCHED; PG8_LDA(At, 1, 0); PG8_STAGE(PG8_SA(0, 1), a2 + hstepA, voffA);
            PG8_WAIT_L(8); PG8_BAR; PG8_WAIT_L(0); PG8_MMA(0, 0, At, B0); PG8_BAR; PG8_SCHED;
            PG8_LDB(B1, 1, 1); PG8_STAGE(PG8_SB(1, 0), b3, voffB);
            PG8_BAR; PG8_WAIT_L(0); PG8_MMA(0, 1, At, B1); PG8_BAR;
            PG8_LDA(At, 1, 1); PG8_STAGE(PG8_SA(1, 0), a3, voffA);
            PG8_BAR; PG8_WAIT_L(0); PG8_MMA(1, 0, At, B0); PG8_BAR; PG8_SCHED;
            PG8_STAGE(PG8_SB(1, 1), b3 + hstepB, voffB);
            PG8_WAIT_V(6); PG8_BAR; PG8_MMA(1, 1, At, B1); PG8_BAR;
            }
        }
        if constexpr (ALIGN_EPI) { if (wr == 0) PG8_BAR; }
        E(acc, cur, wr, wc, fr, fq);
        if (!has_next) break;
#pragma unroll
        for (int a = 0; a < 2; ++a)
#pragma unroll
            for (int b = 0; b < 2; ++b)
#pragma unroll
                for (int m = 0; m < 4; ++m)
#pragma unroll
                    for (int n = 0; n < 2; ++n) acc[a][b][m][n] = (f32x4){0.f, 0.f, 0.f, 0.f};
        cur = nxt; cA = nA; cB = nB; ++ui;
        if constexpr (Sched::GATHER) {
#pragma unroll
            for (int h_ = 0; h_ < 2; ++h_)
#pragma unroll
                for (int i_ = 0; i_ < 2; ++i_) vA[h_][i_] = vAn[h_][i_]; }
        if constexpr (ALIGN_EPI) { if (wr == 1) PG8_BAR; }
    }
    PG8_WAIT_V(0);
    if constexpr (!ALIGN_EPI) { if (wr == 0) PG8_BAR; }
    PG8_BAR;
#undef PG8_SA
#undef PG8_SB
#undef PG8_STAGE
#undef PG8_STAGE_A
#undef PG8_GCALC
#undef PG8_LDA
#undef PG8_LDB
#undef PG8_MMA
#undef PG8_WAIT_V
#undef PG8_WAIT_L
#undef PG8_BAR
#undef PG8_SCHED
}
}
using pg8::Unit;
using pg8::Gemm;
typedef f32x4 AccT[2][2][4][2];

#define XB_TMO      128
#define XB_XCNT(j)  (256  + 64 * (j))
#define XB_XSUB(j)  (1280 + 64 * (j))
#define XB_XGEN(j)  (2304 + 64 * (j))
#define XB_TOP      3328
#define XB_TOPGEN   3392
#define XCD_BAR_WORDS 3456
#define XB_SPIN_CAP (1u << 18)
__device__ __forceinline__ unsigned xb_ld(unsigned* p)              { return __hip_atomic_load(p, __ATOMIC_RELAXED, __HIP_MEMORY_SCOPE_AGENT); }
__device__ __forceinline__ unsigned xb_add(unsigned* p, unsigned v) { return __hip_atomic_fetch_add(p, v, __ATOMIC_RELAXED, __HIP_MEMORY_SCOPE_AGENT); }
__device__ __forceinline__ unsigned xb_xcc_id() { return (unsigned)__builtin_amdgcn_s_getreg((3 << 11) | 20) & 0xFu; }
#define XB_SPIN(cond, bar) do { unsigned _sp = 0; while (cond) { __builtin_amdgcn_s_sleep(1); \
    if ((++_sp & 255u) == 0u) { if (xb_ld(&(bar)[XB_TMO])) break; if (_sp > XB_SPIN_CAP) { atomicAdd(&(bar)[XB_TMO], 1u); break; } } } } while (0)
struct XcdBarrier { unsigned* bar; unsigned x; volatile LAS unsigned* st; };
__device__ __forceinline__ XcdBarrier xcd_barrier_post(unsigned* bar, volatile LAS unsigned* st) {
    XcdBarrier b; b.bar = bar; b.x = xb_xcc_id(); b.st = st;
    if (threadIdx.x == 0) (void)xb_add(&bar[XB_XCNT(b.x)], 1u);
    return b;
}
__device__ __forceinline__ void xcd_barrier_complete(unsigned* bar, unsigned x, unsigned& nloc, unsigned& nx) {
    const unsigned G = gridDim.x * gridDim.y * gridDim.z;
    unsigned sum, cnt, mine, sp = 0u;
    for (;;) {
        sum = 0u; cnt = 0u; mine = 0u;
#pragma unroll
        for (unsigned j = 0; j < 16; ++j) { const unsigned c = xb_ld(&bar[XB_XCNT(j)]); sum += c; cnt += (c > 0u) ? 1u : 0u; mine = (j == x) ? c : mine; }
        if (sum == G) break;
        __builtin_amdgcn_s_sleep(1);
        if ((++sp & 255u) == 0u) { if (xb_ld(&bar[XB_TMO])) break; if (sp > XB_SPIN_CAP) { atomicAdd(&bar[XB_TMO], 1u); break; } }
    }
    nloc = mine > 0u ? mine : 1u; nx = cnt > 0u ? cnt : 1u;
}
__device__ __forceinline__ void xcd_barrier(const XcdBarrier& b) {
    asm volatile("s_waitcnt vmcnt(0)" ::: "memory");
    __syncthreads();
    if (threadIdx.x == 0) {
        unsigned* bar = b.bar;
        __builtin_amdgcn_s_waitcnt(0);
        unsigned nloc = b.st[0], nx = b.st[1];
        if (nloc == 0u) { xcd_barrier_complete(bar, b.x, nloc, nx); b.st[0] = nloc; b.st[1] = nx; }
        const unsigned old = xb_add(&bar[XB_XSUB(b.x)], 1u);
        const unsigned gen = old / nloc;
        if (old + 1u == (gen + 1u) * nloc) {
            __builtin_amdgcn_fence(__ATOMIC_RELEASE, "agent");
            asm volatile("s_waitcnt vmcnt(0)" ::: "memory");
            const unsigned og = xb_add(&bar[XB_TOP], 1u);
            const unsigned tg = og / nx;
            if (og + 1u == (tg + 1u) * nx) xb_add(&bar[XB_TOPGEN], 1u);
            else XB_SPIN(xb_ld(&bar[XB_TOPGEN]) == tg, bar);
            __builtin_amdgcn_fence(__ATOMIC_ACQUIRE, "agent");
            xb_add(&bar[XB_XGEN(b.x)], 1u);
            asm volatile("s_waitcnt vmcnt(0)" ::: "memory");
        } else {
            XB_SPIN(xb_ld(&bar[XB_XGEN(b.x)]) == gen, bar);
            __builtin_amdgcn_fence(__ATOMIC_ACQUIRE, "agent");
            asm volatile("s_waitcnt vmcnt(0)" ::: "memory");
        }
    }
    __syncthreads();
}

struct Args { const float* in[34]; float* out; unsigned char* ws; int ph_lo, ph_hi; };
enum { I_X = 0, I_C, I_CTX, I_CCTX, I_WMOD, I_BMOD, I_WIN, I_BIN, I_GCONV, I_GALOG, I_GDT, I_GNORM, I_CDWW, I_CDWB, I_CLNG, I_CLNB, I_SLNG, I_SLNB, I_SWS, I_SBS,
       I_WBR, I_WOUT, I_BOUT, I_LN1G, I_LN1B, I_LN2G, I_LN2B, I_RGW, I_RGB, I_REW, I_REB, I_EWG, I_EWU, I_EWD };

__device__ __forceinline__ int xcd_chunk(int L, int U) { const int q = U >> 3, r = U & 7, x = L & 7, off = L >> 3; return (x < r ? x * (q + 1) : r * (q + 1) + (x - r) * q) + off; }
struct SchedInA {
    static constexpr bool GATHER = false;
    int G, c; const char* xn; const char* w;
    __device__ __forceinline__ bool next(int i, Unit& u) const {
        const int L = i * G + c; const size_t tstep = (size_t)256 * 1024 * 2;
        if (L < 1152) { int pm, pn; pg8::map_tile(L, 72, 16, pm, pn); u.pm = pm; u.pn = pn; u.aux = 0; u.a = xn + (size_t)pm * tstep; u.b = w + (size_t)pn * tstep; return true; }
        if (L < 1440) { const int q = xcd_chunk(L - 1152, 288), pm = 16 + (q & 3), pn = q >> 2;        u.pm = pm; u.pn = pn; u.aux = 1; u.a = w + (size_t)pm * tstep; u.b = xn + (size_t)pn * tstep; return true; }
        return false;
    }
};
struct SchedGrid {
    static constexpr bool GATHER = false;
    int G, c, nM, nN; const char* a0; const char* b0; size_t astep, bstep;
    __device__ __forceinline__ bool next(int i, Unit& u) const {
        const int L = i * G + c; if (L >= nM * nN) return false;
        int pm, pn; pg8::map_tile(L, nM, nN, pm, pn); u.pm = pm; u.pn = pn; u.aux = 0; u.a = a0 + (size_t)pm * astep; u.b = b0 + (size_t)pn * bstep; return true;
    }
};
struct SchedFftLat {
    static constexpr bool GATHER = false;
    int G, c; const char* dft; const char* pf;
    __device__ __forceinline__ bool next(int i, Unit& u) const {
        const int L = i * G + c; if (L >= 128) return false;
        const int b = L >> 4, kt = (L >> 1) & 7, pn = L & 1;
        u.pm = b * 8 + kt; u.pn = pn; u.aux = 0; u.a = dft + (size_t)kt * (256 * 4096 * 2); u.b = pf + (size_t)b * (512 * 4096 * 2) + (size_t)pn * (256 * 4096 * 2); return true;
    }
};
struct SchedFftCtx {
    static constexpr bool GATHER = false;
    int G, c; const char* dft; const char* pf;
    __device__ __forceinline__ bool next(int i, Unit& u) const {
        const int L = i * G + (G - 1 - c); if (L >= 16) return false;
        const int b = L >> 1, pn = L & 1;
        u.pm = 64 + b; u.pn = pn; u.aux = 0; u.a = dft; u.b = pf + (size_t)b * (512 * 512 * 2) + (size_t)pn * (256 * 512 * 2); return true;
    }
};
struct SchedBranch {
    static constexpr bool GATHER = false;
    int G, c, nM; const char* br; const char* wbr;
    __device__ __forceinline__ bool next(int j, Unit& u) const {
        const int L = j * G + c; if (L >= nM * 16) return false;
        int pm, pn; pg8::map_tile(L, nM, 16, pm, pn);
        u.pm = pm; u.pn = pn; u.aux = 0; u.a = br + (size_t)(pn >> 2) * ((size_t)NTOK * 512 * 2) + (size_t)pm * (256 * 512 * 2); u.b = wbr + (size_t)pn * (256 * 512 * 2); return true;
    }
};
struct SchedMoe {
    static constexpr bool GATHER = false;
    int G, c; unsigned pre[17]; const char* a0; const char* w0; size_t astep, wstep_e, wstep_n;
    __device__ __forceinline__ void init(const unsigned* cnt  ) {
        unsigned s = 0;
#pragma unroll
        for (int e = 0; e < 16; ++e) { pre[e] = s; s += ((unsigned)__builtin_amdgcn_readfirstlane((int)__hip_atomic_load(cnt + 64 * e, __ATOMIC_RELAXED, __HIP_MEMORY_SCOPE_AGENT)) + 255u) >> 8; }
        pre[16] = s;
    }
    __device__ __forceinline__ bool next(int i, Unit& u) const {
        const int L = i * G + c; if (L >= (int)pre[16] * 4) return false;
        const int jt = L >> 2, pn = L & 3; int e = 0;
#pragma unroll
        for (int k = 1; k < 16; ++k) e += ((unsigned)jt >= pre[k]) ? 1 : 0;
        u.pm = jt; u.pn = pn; u.aux = e; u.a = a0 + (size_t)jt * astep; u.b = w0 + (size_t)e * wstep_e + (size_t)pn * wstep_n; return true;
    }
};

struct SchedMoeG {
    static constexpr bool GATHER = true;
    int G, c; const LAS unsigned* pre; const char* a0; const char* w0; size_t wstep_e, wstep_n; const int* list; const unsigned* cnt;
    __device__ __forceinline__ void init(const unsigned* cnt_  , LAS unsigned* pre_) { cnt = cnt_; pre = pre_;
        if (threadIdx.x < 16) pre_[17 + threadIdx.x] = __hip_atomic_load(cnt_ + 64 * threadIdx.x, __ATOMIC_RELAXED, __HIP_MEMORY_SCOPE_AGENT);
        __syncthreads();
        if (threadIdx.x == 0) { unsigned s = 0;
            for (int e = 0; e < 16; ++e) { pre_[e] = s; s += (pre_[17 + e] + 255u) >> 8; }
            pre_[16] = s; }
        __syncthreads();
    }
    __device__ __forceinline__ bool next(int i, Unit& u) const {
        const int L = i * G + c; if (L >= (int)pre[16] * 4) return false;
        const int jt = L >> 2, pn = L & 3; int e = 0; unsigned pe = 0;
#pragma unroll
        for (int k = 1; k < 16; ++k) { const unsigned pk = pre[k]; const bool ge = (unsigned)jt >= pk; e += ge ? 1 : 0; pe = ge ? pk : pe; }
        e = __builtin_amdgcn_readfirstlane(e); pe = (unsigned)__builtin_amdgcn_readfirstlane((int)pe);
        u.pm = jt; u.pn = pn; u.aux = e; u.ax2 = (jt - (int)pe) * 256; u.a = a0; u.b = w0 + (size_t)e * wstep_e + (size_t)pn * wstep_n; return true;
    }
    __device__ __forceinline__ unsigned arow(const Unit& u, int r) const {
        const unsigned n = pre[17 + u.aux]; const unsigned pos = (unsigned)(u.ax2 + r);
        const int tok = pos < n ? list[(size_t)u.aux * NTOK + pos] : 0; return (unsigned)tok * 2048u;
    }
};

struct EpiInA {
    static constexpr bool PERM = true;
    bf16 *pqkv, *pz, *pconf, *psgu, *pfft, *pfftc; const float* bias;
    __device__ __forceinline__ void operator()(const AccT& acc, const Unit& u, int wr, int wc, int fr, int fq) const {
        if (u.aux == 0) {
            const int row0 = u.pm * 256 + wr * 64 + fr, cb = wc * 32 + 8 * fq, bcol0 = u.pn * 256 + cb;
            f32x4 bv[2][2];
#pragma unroll
            for (int bj = 0; bj < 2; ++bj)
#pragma unroll
                for (int n = 0; n < 2; ++n) bv[bj][n] = *(const f32x4*)(bias + bcol0 + bj * 128 + 4 * n);
            if (u.pn < 8) {
                const bool isz = u.pn >= 6;
#pragma unroll
                for (int ai = 0; ai < 2; ++ai)
#pragma unroll
                    for (int m = 0; m < 4; ++m) { const int row = row0 + ai * 128 + m * 16;
                        bf16* rowp = isz ? (pz + (size_t)row * 512 + (u.pn - 6) * 256 + cb) : (pqkv + (size_t)row * 1536 + u.pn * 256 + cb);
#pragma unroll
                        for (int bj = 0; bj < 2; ++bj) { f32x4 v0 = acc[ai][bj][m][0] + bv[bj][0], v1 = acc[ai][bj][m][1] + bv[bj][1];
                            if (isz) {
#pragma unroll
                                for (int j = 0; j < 4; ++j) { v0[j] = siluf_(v0[j]); v1[j] = siluf_(v1[j]); } }
                            v4u w; w.x = pk2(v0[0], v0[1]); w.y = pk2(v0[2], v0[3]); w.z = pk2(v1[0], v1[1]); w.w = pk2(v1[2], v1[3]);
                            *(v4u*)(rowp + bj * 128) = w; } }
            } else if (u.pn < 12) {
#pragma unroll
                for (int ai = 0; ai < 2; ++ai)
#pragma unroll
                    for (int m = 0; m < 4; ++m) { const int row = row0 + ai * 128 + m * 16;
                        const f32x4 a0 = acc[ai][0][m][0] + bv[0][0], a1 = acc[ai][0][m][1] + bv[0][1], g0 = acc[ai][1][m][0] + bv[1][0], g1 = acc[ai][1][m][1] + bv[1][1];
                        float o[8];
#pragma unroll
                        for (int j = 0; j < 4; ++j) { o[j] = a0[j] * sigmoidf_(g0[j]); o[4 + j] = a1[j] * sigmoidf_(g1[j]); }
                        *(v4u*)(pconf + (size_t)row * 512 + (u.pn - 8) * 128 + cb) = pack8(o); }
            } else {
#pragma unroll
                for (int ai = 0; ai < 2; ++ai)
#pragma unroll
                    for (int m = 0; m < 4; ++m) { const int row = row0 + ai * 128 + m * 16;
                        bf16* rowp = psgu + (size_t)row * 1024 + (u.pn - 12) * 256 + cb;
#pragma unroll
                        for (int bj = 0; bj < 2; ++bj) { f32x4 v0 = acc[ai][bj][m][0] + bv[bj][0], v1 = acc[ai][bj][m][1] + bv[bj][1];
#pragma unroll
                            for (int j = 0; j < 4; ++j) { v0[j] = gelu_tanh(v0[j]); v1[j] = gelu_tanh(v1[j]); }
                            v4u w; w.x = pk2(v0[0], v0[1]); w.y = pk2(v0[2], v0[3]); w.z = pk2(v1[0], v1[1]); w.w = pk2(v1[2], v1[3]);
                            *(v4u*)(rowp + bj * 128) = w; } }
            }
        } else {
            const int jrow0 = (u.pm - 16) * 256 + wr * 64 + fr, tok0 = u.pn * 256 + wc * 32 + 8 * fq;
#pragma unroll
            for (int ai = 0; ai < 2; ++ai)
#pragma unroll
                for (int m = 0; m < 4; ++m) { const int jrow = jrow0 + ai * 128 + m * 16; const float bb = bias[4096 + jrow]; const int cs = jrow >> 9, rr = jrow & 511;
#pragma unroll
                    for (int bj = 0; bj < 2; ++bj) { const int tok = tok0 + bj * 128; bf16* dst;
                        if (tok < NLAT) { const int b = tok >> 11, t = tok & 2047; dst = pfft + ((size_t)(b * 512 + rr)) * 4096 + cs * 2048 + t; }
                        else { const int tc = tok - NLAT, b = tc >> 8, t = tc & 255; dst = pfftc + ((size_t)(b * 512 + rr)) * 512 + cs * 256 + t; }
                        const f32x4 v0 = acc[ai][bj][m][0] + bb, v1 = acc[ai][bj][m][1] + bb;
                        v4u w; w.x = pk2(v0[0], v0[1]); w.y = pk2(v0[2], v0[3]); w.z = pk2(v1[0], v1[1]); w.w = pk2(v1[2], v1[3]);
                        *(v4u*)dst = w; } }
        }
    }
};
template <int ACT  > struct EpiBf16 {
    static constexpr bool PERM = true;
    bf16* O; int ldc; const float* bias;
    __device__ __forceinline__ void operator()(const AccT& acc, const Unit& u, int wr, int wc, int fr, int fq) const {
        const int row0 = u.pm * 256 + wr * 64 + fr, col0 = u.pn * 256 + wc * 32 + 8 * fq;
        f32x4 bv[2][2];
#pragma unroll
        for (int bj = 0; bj < 2; ++bj)
#pragma unroll
            for (int n = 0; n < 2; ++n) bv[bj][n] = bias ? *(const f32x4*)(bias + col0 + bj * 128 + 4 * n) : (f32x4){0.f, 0.f, 0.f, 0.f};
#pragma unroll
        for (int ai = 0; ai < 2; ++ai)
#pragma unroll
            for (int m = 0; m < 4; ++m) { bf16* rowp = O + (size_t)(row0 + ai * 128 + m * 16) * ldc + col0;
#pragma unroll
                for (int bj = 0; bj < 2; ++bj) { f32x4 v0 = acc[ai][bj][m][0] + bv[bj][0], v1 = acc[ai][bj][m][1] + bv[bj][1];
                    if (ACT == 1) {
#pragma unroll
                        for (int j = 0; j < 4; ++j) { v0[j] = sigmoidf_(v0[j]); v1[j] = sigmoidf_(v1[j]); } }
                    v4u w; w.x = pk2(v0[0], v0[1]); w.y = pk2(v0[2], v0[3]); w.z = pk2(v1[0], v1[1]); w.w = pk2(v1[2], v1[3]);
                    *(v4u*)(rowp + bj * 128) = w; } }
    }
};
struct EpiF32 {
    static constexpr bool PERM = false;
    float* C; int ldc; const float* bias;
    __device__ __forceinline__ void operator()(const AccT& acc, const Unit& u, int wr, int wc, int fr, int fq) const {
        const int row0 = u.pm * 256 + wr * 64 + fr, col0 = u.pn * 256 + wc * 32 + 4 * fq;
        f32x4 bv[2][2];
#pragma unroll
        for (int bj = 0; bj < 2; ++bj)
#pragma unroll
            for (int n = 0; n < 2; ++n) bv[bj][n] = *(const f32x4*)(bias + col0 + bj * 128 + n * 16);
#pragma unroll
        for (int ai = 0; ai < 2; ++ai)
#pragma unroll
            for (int m = 0; m < 4; ++m) { float* rowp = C + (size_t)(row0 + ai * 128 + m * 16) * ldc + col0;
#pragma unroll
                for (int bj = 0; bj < 2; ++bj)
#pragma unroll
                    for (int n = 0; n < 2; ++n) *(f32x4*)(rowp + bj * 128 + n * 16) = acc[ai][bj][m][n] + bv[bj][n]; }
    }
};
struct EpiGateMerge {
    static constexpr bool PERM = true;
    const bf16* P; bf16* mbf; const float* bias;
    __device__ __forceinline__ void operator()(const AccT& acc, const Unit& u, int wr, int wc, int fr, int fq) const {
        const int row0 = u.pm * 256 + wr * 64 + fr, cb = wc * 32 + 8 * fq, d0 = u.pn * 64 + wc * 16 + 4 * fq;
        f32x4 bv[2][2];
#pragma unroll
        for (int bj = 0; bj < 2; ++bj)
#pragma unroll
            for (int n = 0; n < 2; ++n) bv[bj][n] = *(const f32x4*)(bias + u.pn * 256 + cb + bj * 128 + 4 * n);
#pragma unroll
        for (int ai = 0; ai < 2; ++ai)
#pragma unroll
            for (int m = 0; m < 4; ++m) { const size_t row = (size_t)(row0 + ai * 128 + m * 16); const bf16* pr = P + row * 4096 + d0;
                f32x4 o = (f32x4){0.f, 0.f, 0.f, 0.f};
#pragma unroll
                for (int bj = 0; bj < 2; ++bj)
#pragma unroll
                    for (int n = 0; n < 2; ++n) { const v2u pw = *(const v2u*)(pr + (2 * bj + n) * 1024); const f32x4 g = acc[ai][bj][m][n] + bv[bj][n];
                        o[0] += sigmoidf_(g[0]) * bflo(pw.x); o[1] += sigmoidf_(g[1]) * bfhi(pw.x); o[2] += sigmoidf_(g[2]) * bflo(pw.y); o[3] += sigmoidf_(g[3]) * bfhi(pw.y); }
                v2u w; w.x = pk2(o[0], o[1]); w.y = pk2(o[2], o[3]); *(v2u*)(mbf + row * 1024 + d0) = w; }
    }
};
struct EpiMoe1 {
    static constexpr bool PERM = true;
    bf16* hid;
    __device__ __forceinline__ void operator()(const AccT& acc, const Unit& u, int wr, int wc, int fr, int fq) const {
        const int row0 = u.pm * 256 + wr * 64 + fr, cb = wc * 32 + 8 * fq;
#pragma unroll
        for (int ai = 0; ai < 2; ++ai)
#pragma unroll
            for (int m = 0; m < 4; ++m) { const int row = row0 + ai * 128 + m * 16;
                const f32x4 g0 = acc[ai][0][m][0], g1 = acc[ai][0][m][1], u0 = acc[ai][1][m][0], u1 = acc[ai][1][m][1];
                float o[8];
#pragma unroll
                for (int j = 0; j < 4; ++j) { o[j] = siluf_(g0[j]) * u0[j]; o[4 + j] = siluf_(g1[j]) * u1[j]; }
                *(v4u*)(hid + (size_t)row * 512 + u.pn * 128 + cb) = pack8(o); }
    }
};

struct Ctx {
    LAS unsigned char* lds; int tid, lane, wave, G, bid;
};

__device__ __forceinline__ int gate_srccol(int r) { const int q = r - 5120, t = q >> 8, c = q & 255, bj = c >> 7, wc = (c >> 5) & 3, fq = (c >> 3) & 3, n = (c >> 2) & 1, j = c & 3;
    return OFF_GATE + (2 * bj + n) * 1024 + 64 * t + 16 * wc + 4 * fq + j; }
__device__ __forceinline__ void cvt_tile(const Ctx& X, const float* src, int ld, int k0, bf16* dst, int Kp) {
    LAS float* tile = (LAS float*)X.lds;
#pragma unroll
    for (int i = 0; i < 8; ++i) { const int kk = (X.tid >> 6) + 8 * i, nn = X.tid & 63; tile[kk * 65 + nn] = src[(size_t)(k0 + kk) * ld + nn]; }
    __syncthreads();
    { const int n = X.tid >> 3, kc = X.tid & 7; float o[8];
#pragma unroll
      for (int j = 0; j < 8; ++j) o[j] = tile[(8 * kc + j) * 65 + n];
      *(v4u*)(dst + (size_t)n * Kp + k0 + 8 * kc) = pack8(o); }
    __syncthreads();
}

__device__ __forceinline__ void cvt_item(const float* src, int ld, int srccol, int k0, bf16* dst, int Kp, LAS float* scr, int lane) {
    float tv[32];
#pragma unroll
    for (int i = 0; i < 32; ++i) { const int kk = 2 * i + (lane >> 5); tv[i] = src[(size_t)(k0 + kk) * ld + srccol]; }
#pragma unroll
    for (int i = 0; i < 32; ++i) { const int kk = 2 * i + (lane >> 5); scr[kk * 33 + (lane & 31)] = tv[i]; }
    LDS_WAIT(); asm volatile("" ::: "memory");
    const int c = lane & 7;
#pragma unroll
    for (int j = 0; j < 4; ++j) { const int n = (lane >> 3) + 8 * j; const LAS float* sp = scr + (8 * c) * 33 + n; float o[8];
#pragma unroll
        for (int e = 0; e < 8; ++e) o[e] = sp[e * 33];
        *(v4u*)(dst + (size_t)n * Kp + k0 + 8 * c) = pack8(o); }
    LDS_WAIT(); asm volatile("" ::: "memory");
}

__device__ __forceinline__ void cvt_item4(const float* src, int ld, int col4, int k0, bf16* dst, int Kp, LAS float* scr, int lane) {
    f32x4 v[8]; const int kq = lane >> 3, n4 = 4 * (lane & 7);
#pragma unroll
    for (int i = 0; i < 8; ++i) v[i] = *(const f32x4*)(src + (size_t)(k0 + kq + 8 * i) * ld + col4);
#pragma unroll
    for (int i = 0; i < 8; ++i) { LAS float* p = scr + (kq + 8 * i) * 33 + n4; p[0] = v[i][0]; p[1] = v[i][1]; p[2] = v[i][2]; p[3] = v[i][3]; }
    LDS_WAIT(); asm volatile("" ::: "memory");
    const int c = lane & 7;
#pragma unroll
    for (int j = 0; j < 4; ++j) { const int n = (lane >> 3) + 8 * j; const LAS float* sp = scr + (8 * c) * 33 + n; float o[8];
#pragma unroll
        for (int e = 0; e < 8; ++e) o[e] = sp[e * 33];
        *(v4u*)(dst + (size_t)n * Kp + k0 + 8 * c) = pack8(o); }
    LDS_WAIT(); asm volatile("" ::: "memory");
}

__device__ __forceinline__ void ln_rows(f32x4 (&v)[4]) {
    float s = 0.f;
#pragma unroll
    for (int j = 0; j < 4; ++j) s += (v[j][0] + v[j][1]) + (v[j][2] + v[j][3]);
    const float mean = wave_sum(s) * (1.f / D); float s2 = 0.f;
#pragma unroll
    for (int j = 0; j < 4; ++j) { v[j] = v[j] - mean; s2 += (v[j][0] * v[j][0] + v[j][1] * v[j][1]) + (v[j][2] * v[j][2] + v[j][3] * v[j][3]); }
    const float rstd = __builtin_amdgcn_rsqf(wave_sum(s2) * (1.f / D) + LN_EPS);
#pragma unroll
    for (int j = 0; j < 4; ++j) v[j] = v[j] * rstd;
}

#define PH_BEGIN() \
    int tid_l = threadIdx.x; asm volatile("" : "+v"(tid_l)); const int tid = tid_l, lane = tid & 63; \
    Ctx X; X.lds = lds; X.tid = tid; X.lane = lane; X.wave = __builtin_amdgcn_readfirstlane(tid >> 6); X.G = gridDim.x; X.bid = blockIdx.x; \
    const int gw = X.bid * NWAVES + X.wave, NGW = X.G * NWAVES; (void)gw; (void)NGW; \
    const __attribute__((address_space(4))) char* kp = (const __attribute__((address_space(4))) char*)__builtin_amdgcn_kernarg_segment_ptr(); asm volatile("" : "+s"(kp)); \
    unsigned char* const ws = *(unsigned char* const __attribute__((address_space(4)))*)(kp + 280); \
    float* const hlat = *(float* const __attribute__((address_space(4)))*)(kp + 272); (void)hlat; \
    float* const hctx = (float*)(ws + WS_HCTX); (void)hctx; \
    float* const modv = (float*)(ws + WS_MODV); (void)modv; \
    float* const binv = (float*)(ws + WS_BIN); (void)binv; \
    bf16* const XN = (bf16*)(ws + WS_XN); (void)XN; \
    bf16* const WIN = (bf16*)(ws + WS_WIN); (void)WIN; \
    bf16* const WBR = (bf16*)(ws + WS_WBR); (void)WBR; \
    bf16* const WOUT = (bf16*)(ws + WS_WOUT); (void)WOUT; \
    bf16* const F1A = (bf16*)(ws + WS_F1A); (void)F1A; bf16* const F1B = (bf16*)(ws + WS_F1B); (void)F1B; \
    bf16* const DFTC = (bf16*)(ws + WS_DFTC); (void)DFTC; \
    bf16* const PQKV = (bf16*)(ws + WS_PQKV); (void)PQKV; \
    bf16* const PCONF = (bf16*)(ws + WS_PCONF); (void)PCONF; \
    bf16* const PZ = (bf16*)(ws + WS_PZ); (void)PZ; \
    bf16* const PSGU = (bf16*)(ws + WS_PSGU); (void)PSGU; \
    bf16* const PFFT = (bf16*)(ws + WS_PFFT); (void)PFFT; \
    bf16* const PFFTC = (bf16*)(ws + WS_PFFTC); (void)PFFTC; \
    float* const AB = (float*)(ws + WS_AB); (void)AB; \
    bf16* const OF = (bf16*)(ws + WS_OF); (void)OF; \
    bf16* const OB = (bf16*)(ws + WS_OB); (void)OB; \
    bf16* const WIT = (bf16*)(ws + WS_WIT); (void)WIT; \
    bf16* const UIT = (bf16*)(ws + WS_UIT); (void)UIT; \
    bf16* const AIT = (bf16*)(ws + WS_AIT); (void)AIT; \
    bf16* const KIT = (bf16*)(ws + WS_KIT); (void)KIT; \
    float* const SIT = (float*)(ws + WS_SIT); (void)SIT; \
    bf16* const GT = (bf16*)(ws + WS_G); (void)GT; \
    bf16* const WGU = (bf16*)(ws + WS_WGU); (void)WGU; \
    bf16* const WDN = (bf16*)(ws + WS_WDN); (void)WDN; \
    bf16* const XG = (bf16*)(ws + WS_XG); (void)XG; \
    bf16* const QKV = (bf16*)(ws + WS_QKV); (void)QKV; \
    float* const GB = (float*)(ws + WS_GB); (void)GB; \
    bf16* const BR = (bf16*)(ws + WS_BR); (void)BR; \
    float* const MERGED = (float*)(ws + WS_MERGED); (void)MERGED; \
    float* const YB = (float*)(ws + WS_Y); (void)YB; \
    bf16* const HID = (bf16*)(ws + WS_HID); (void)HID; \
    bf16* const MO = (bf16*)(ws + WS_MO); (void)MO; \
    float* const ROUTE = (float*)(ws + WS_ROUTE); (void)ROUTE; int* const ELIST = (int*)(ws + WS_LIST); (void)ELIST; \
    unsigned* const ctl = (unsigned*)(ws + WS_CTL); (void)ctl;
#define INP(i) (*(const float* const __attribute__((address_space(4)))*)(kp + 8 * (i)))
__global__ void __launch_bounds__(NWAVES * 64, 2) fwd(Args args) {
    extern __shared__ __attribute__((aligned(16))) unsigned char lds_raw[];
    LAS unsigned char* const lds = (LAS unsigned char*)lds_raw;
    volatile LAS unsigned* MISC = (volatile LAS unsigned*)(lds + MISC_OFF);
    for (int u = threadIdx.x; u < (LDS_BYTES - LDSCTL_OFF) / 4; u += NWAVES * 64) ((LAS unsigned*)(lds + LDSCTL_OFF))[u] = 0u;
    __syncthreads();
#if MK_ONE_LAUNCH
    XcdBarrier bar = xcd_barrier_post((unsigned*)(args.ws + WS_CTL) + CW_BAR, MISC + 8);
#define GRID_BAR() xcd_barrier(bar)
#else
#define GRID_BAR() do { } while (0)
#endif
    const int lo = args.ph_lo, hi = args.ph_hi;
#define IN(k) (lo <= (k) && (k) < hi)
#define CW_TS 20000
#if TPROBE
#define STAMP(k) do { if (blockIdx.x == 0 && threadIdx.x == 0) __hip_atomic_store((unsigned*)(args.ws + WS_CTL) + CW_TS + (k), (unsigned)__builtin_amdgcn_s_memrealtime(), __ATOMIC_RELAXED, __HIP_MEMORY_SCOPE_AGENT); } while (0)
#else
#define STAMP(k) do { } while (0)
#endif
#define SEAM(k) do { if (IN(k) && IN((k) + 1)) GRID_BAR(); STAMP((k) + 1); } while (0)
    STAMP(0);

    for (int rep0_ = 0; rep0_ <= (int)PH_REP(0); ++rep0_) { if (rep0_) GRID_BAR();
    if (PH_ON(0) && IN(0)) { PH_BEGIN();
        for (int idx = X.bid * 512 + tid; idx < 256 * 512 / 8; idx += X.G * 512) {
            const int k = idx >> 6, j0 = (idx & 63) * 8; float o[8];
#pragma unroll
            for (int e = 0; e < 8; ++e) { const int j = j0 + e, t = j & 255, a = (k * t) & 255; float s, c; fsincospi((float)a * (1.0f / 128.0f), &s, &c);
                o[e] = (j < 256 ? c : -s) * 0.0625f; }
            *(v4u*)(DFTC + (size_t)k * 512 + j0) = pack8(o);
        }
        {
            LAS float* sc = (LAS float*)lds;
            LAS float* red = (LAS float*)(lds + 36864);
            { float cv[18];
#pragma unroll
              for (int j = 0; j < 18; ++j) { const int r = j >> 1, k = tid + 512 * (j & 1); cv[j] = r < 8 ? INP(I_C)[r * 1024 + k] : INP(I_CCTX)[k]; }
#pragma unroll
              for (int j = 0; j < 18; ++j) sc[tid + 512 * j] = siluf_(cv[j]); }
            __syncthreads();
            for (int it = X.bid; it < 192; it += X.G) {
                const int l = it / 96, j = (it % 96) * 64 + lane; const float* W = INP(I_WMOD) + (size_t)l * 1024 * 6144 + j;
                float a[9];
#pragma unroll
                for (int r = 0; r < 9; ++r) a[r] = 0.f;
                const int kb = X.wave * 128;
                float wv[2][32];
#pragma unroll
                for (int i = 0; i < 32; ++i) wv[0][i] = W[(size_t)(kb + i) * 6144];
#pragma unroll
                for (int b = 0; b < 4; ++b) {
                    if (b < 3) {
#pragma unroll
                        for (int i = 0; i < 32; ++i) wv[(b + 1) & 1][i] = W[(size_t)(kb + 32 * (b + 1) + i) * 6144]; }
#pragma unroll
                    for (int i = 0; i < 32; i += 4) {
#pragma unroll
                        for (int r = 0; r < 9; ++r) { const f32x4 sv = *(const LAS f32x4*)(sc + r * 1024 + kb + 32 * b + i);
                            a[r] += (sv[0] * wv[b & 1][i] + sv[1] * wv[b & 1][i + 1]) + (sv[2] * wv[b & 1][i + 2] + sv[3] * wv[b & 1][i + 3]); } }
                }
#pragma unroll
                for (int r = 0; r < 9; ++r) red[(X.wave * 9 + r) * 64 + lane] = a[r];
                __syncthreads();
                for (int o = tid; o < 9 * 64; o += 512) { const int r = o >> 6, jj = o & 63; float s = 0.f;
#pragma unroll
                    for (int w = 0; w < 8; ++w) s += red[(w * 9 + r) * 64 + jj];
                    const int jc = (it % 96) * 64 + jj; modv[((size_t)l * 9 + r) * 6144 + jc] = s + INP(I_BMOD)[l * 6144 + jc]; }
                __syncthreads();
            }
        }
    } }
    SEAM(0);

    for (int l = 0; l < 2; ++l) {
        const int pb = 1 + NPH_LAYER * l;
        const int nrows2 = (l == 1) ? NLAT : NTOK;
        const int npan2 = nrows2 / 256;

        for (int rep_ = 0; rep_ <= (int)PH_REP(1); ++rep_) { if (rep_) GRID_BAR();
        if (PH_ON(1) && IN(pb + 0)) { PH_BEGIN(); const float* mv = modv + (size_t)l * 9 * 6144; (void)mv; unsigned* const moecnt = ctl + CW_MOE + l * 16 * 64; (void)moecnt;
            const float* win = INP(I_WIN) + (size_t)l * 1024 * N_IN;
            const float* bin = INP(I_BIN) + (size_t)l * N_IN;
#define FOLD_LOAD(it_) do { const int kb_ = (it_) >> 2, g_ = (it_) & 3; _Pragma("unroll") for (int j = 0; j < 4; ++j) { const int i = tid + 512 * j, kk = i >> 7, c = i & 127; wpre[j] = win[(size_t)(kb_ * 16 + kk) * N_IN + OFF_FFT + g_ * 128 + c]; } } while (0)
            float wpre[4]; FOLD_LOAD(X.bid < 256 ? X.bid : 255);
            LAS float* const wscr = (LAS float*)(lds + X.wave * 8448);
            for (int it = gw; it < 4096 + 1024 + 512 + 144; it += NGW) {
                if (it >= 5632) { const int r = (it - 5632) * 64 + lane;
                    if (r < 4096 || r >= 5120) { float v;
                        if (r < 2048) v = bin[r];
                        else if (r < 3072) { const int q = r - 2048, j = q >> 8, w = q & 255; v = bin[OFF_CONF + (w >= 128 ? 512 : 0) + 128 * j + (w & 127)]; }
                        else if (r < 4096) v = bin[OFF_SGU + (r - 3072)];
                        else v = bin[gate_srccol(r)];
                        binv[r] = v; }
                    continue; }
                const float* src; int ld, col, k0, Kp; bf16* dst; const int n4 = lane & 31;
                if (it < 4096) { const int rb_ = (it & 3) + 4 * ((it >> 3) & 63), rb = rb_ < 128 ? rb_ : rb_ + 32, row0 = rb * 32;
                    if (row0 < 2048) col = row0 + n4;
                    else if (row0 < 3072) { const int q = row0 - 2048, j = q >> 8, w = q & 255; col = OFF_CONF + (w >= 128 ? 512 : 0) + 128 * j + (w & 127) + n4; }
                    else if (row0 < 4096) col = OFF_SGU + (row0 - 3072) + n4;
                    else col = gate_srccol(row0 + n4);
                    src = win; ld = N_IN; k0 = (((it >> 2) & 1) + 2 * (it >> 9)) * 64; dst = WIN + (size_t)row0 * 1024; Kp = 1024; }
                else if (it < 5120) { const int q = it - 4096, i = q >> 8, nb = (q & 3) + 4 * ((q >> 3) & 7);
                    src = INP(I_WBR) + ((size_t)(l * 4 + i) * 512) * 1024; ld = 1024; col = nb * 32 + n4; k0 = (((q >> 2) & 1) + 2 * ((q >> 6) & 3)) * 64; dst = WBR + ((size_t)i * 1024 + nb * 32) * 512; Kp = 512; }
                else { const int q = it - 5120, nb = (q & 3) + 4 * ((q >> 3) & 7);
                    src = INP(I_WOUT) + (size_t)l * 1024 * 1024; ld = 1024; col = nb * 32 + n4; k0 = (((q >> 2) & 1) + 2 * (q >> 6)) * 64; dst = WOUT + (size_t)nb * 32 * 1024; Kp = 1024; }
                cvt_item(src, ld, col, k0, dst, Kp, wscr, lane);
            }
            LAS float* wab = (LAS float*)lds;
            f32x4 wq[8]; bool wq_have = false;
#pragma unroll
            for (int j = 0; j < 8; ++j) wq[j] = (f32x4){0.f, 0.f, 0.f, 0.f};
#define WAB_LOAD() do { _Pragma("unroll") for (int j = 0; j < 8; ++j) wq[j] = *(const f32x4*)(win + (size_t)(tid + 512 * (j & 1)) * N_IN + OFF_A + 4 * (j >> 1)); } while (0)
            for (int it = X.bid; it < 256; it += X.G) {
                const int kb = it >> 2, g = it & 3; LAS float* Wt = (LAS float*)(lds + 69632); LAS f32x2* cst = (LAS f32x2*)(lds + 69632 + 10240); LAS float* bl = (LAS float*)(cst + 128);
                if (it != X.bid) FOLD_LOAD(it);
#pragma unroll
                for (int j = 0; j < 4; ++j) { const int i = tid + 512 * j, kk = i >> 7, c = i & 127; Wt[c * 20 + kk] = wpre[j]; }
                if (tid < 128) { float sn, cn; fsincospi((float)tid * (1.0f / 64.0f), &sn, &cn); cst[tid] = (f32x2){cn * 0.08838834764831845f, sn * 0.08838834764831845f}; }
                else if (tid < 256 && kb == 0) bl[tid - 128] = bin[OFF_FFT + g * 128 + (tid - 128)];
                __syncthreads();
                if (!wq_have) { WAB_LOAD(); wq_have = true; }
                const int m = tid & 127, ks = tid >> 7; f32x2 acc[4];
#pragma unroll
                for (int kk = 0; kk < 4; ++kk) acc[kk] = (f32x2){0.f, 0.f};
                { int a = 0;
#pragma unroll 8
                for (int c = 0; c < 128; ++c) { const f32x2 t = cst[a]; const f32x4 w = *(const LAS f32x4*)(Wt + c * 20 + ks * 4);
#pragma unroll
                    for (int kk = 0; kk < 4; ++kk) acc[kk] += t * w[kk];
                    a = (a + m) & 127; } }
                bf16* dc = WIN + (size_t)(4096 + g * 128 + m) * 1024 + kb * 16 + ks * 4; bf16* dsn = dc + (size_t)512 * 1024;
                { v2u o; o.x = pk2(acc[0][0], acc[1][0]); o.y = pk2(acc[2][0], acc[3][0]); *(v2u*)dc = o; o.x = pk2(acc[0][1], acc[1][1]); o.y = pk2(acc[2][1], acc[3][1]); *(v2u*)dsn = o; }
                if (kb == 0 && tid < 256) {
                    const int cs = tid >> 7; float sb = 0.f; int a = 0;
#pragma unroll 8
                    for (int c = 0; c < 128; ++c) { const f32x2 t = cst[a]; sb += bl[c] * (cs ? t[1] : t[0]); a = (a + m) & 127; }
                    binv[4096 + cs * 512 + g * 128 + m] = sb; }
                if (it + X.G < 256) __syncthreads();
            }
            if (!wq_have) { __syncthreads(); WAB_LOAD(); }
#pragma unroll
            for (int j = 0; j < 8; ++j) { LAS float* p = wab + (4 * (j >> 1)) * 1024 + tid + 512 * (j & 1); p[0] = wq[j][0]; p[1024] = wq[j][1]; p[2048] = wq[j][2]; p[3072] = wq[j][3]; }
            __syncthreads();
#undef FOLD_LOAD
#undef WAB_LOAD
            f32x4 pe[4]; int pe_t = -1;
#pragma unroll
            for (int j = 0; j < 4; ++j) pe[j] = (f32x4){0.f, 0.f, 0.f, 0.f};
            for (int rowb = gw; rowb < NTOK; rowb += 2 * NGW) {
                f32x4 va[4], vb2[4];
                { const int row_ = rowb + 0, row = row_ < NTOK ? row_ : NTOK - 1; const bool LIVE_ = row_ < NTOK;
                float* hrow = row < NLAT ? hlat + (size_t)row * D : hctx + (size_t)(row - NLAT) * D;
                const int mi = row < NLAT ? (row >> 11) : 8; const float* shift = mv + mi * 6144, *scale = shift + 1024;

                if (l == 0) {
                    const float* src = row < NLAT ? INP(I_X) + (size_t)row * D : INP(I_CTX) + (size_t)(row - NLAT) * D;
#pragma unroll
                    for (int j = 0; j < 4; ++j) va[j] = *(const f32x4*)(src + 4 * lane + 256 * j);
                    if (row < NLAT) { const int t = row & 2047;
                        if (t != pe_t) { pe_t = t; const int prow = t >> 6, pcol = t & 63;
#pragma unroll 1
                            for (int j = 0; j < 4; ++j)
#pragma unroll
                                for (int e = 0; e < 4; ++e) { const int col = 4 * lane + 256 * j + e, part = col >> 9, within = col & 511, i = within & 255;
                                    const float omega = __builtin_amdgcn_exp2f((float)i * (-13.287712379549449f / 256.0f)); const float rev = (float)(part ? pcol : prow) * omega * 0.15915494309189535f;
                                    const float pv = (within >> 8) ? __builtin_amdgcn_cosf(rev) : __builtin_amdgcn_sinf(rev);
                                    if (j == 0) pe[0][e] = pv; else if (j == 1) pe[1][e] = pv; else if (j == 2) pe[2][e] = pv; else pe[3][e] = pv; } }
#pragma unroll
                        for (int j = 0; j < 4; ++j) va[j] += pe[j]; }
#pragma unroll
                    for (int j = 0; j < 4; ++j) if (LIVE_) *(f32x4*)(hrow + 4 * lane + 256 * j) = va[j];
                } else {
#pragma unroll
                    for (int j = 0; j < 4; ++j) va[j] = *(const f32x4*)(hrow + 4 * lane + 256 * j);
                }
                f32x4 scv[4], shv[4];
#pragma unroll
                for (int j = 0; j < 4; ++j) { scv[j] = *(const f32x4*)(scale + 4 * lane + 256 * j); shv[j] = *(const f32x4*)(shift + 4 * lane + 256 * j); }
                ln_rows(va);
#pragma unroll
                for (int j = 0; j < 4; ++j) { const f32x4 sc = scv[j], sh = shv[j]; va[j] = va[j] * (sc + 1.0f) + sh;
                    v2u w; w.x = pk2(va[j][0], va[j][1]); w.y = pk2(va[j][2], va[j][3]); if (LIVE_) *(v2u*)(XN + (size_t)row * D + 4 * lane + 256 * j) = w; }
                }
                { const int row_ = rowb + NGW, row = row_ < NTOK ? row_ : NTOK - 1; const bool LIVE_ = row_ < NTOK;
                float* hrow = row < NLAT ? hlat + (size_t)row * D : hctx + (size_t)(row - NLAT) * D;
                const int mi = row < NLAT ? (row >> 11) : 8; const float* shift = mv + mi * 6144, *scale = shift + 1024;

                if (l == 0) {
                    const float* src = row < NLAT ? INP(I_X) + (size_t)row * D : INP(I_CTX) + (size_t)(row - NLAT) * D;
#pragma unroll
                    for (int j = 0; j < 4; ++j) vb2[j] = *(const f32x4*)(src + 4 * lane + 256 * j);
                    if (row < NLAT) { const int t = row & 2047;
                        if (t != pe_t) { pe_t = t; const int prow = t >> 6, pcol = t & 63;
#pragma unroll 1
                            for (int j = 0; j < 4; ++j)
#pragma unroll
                                for (int e = 0; e < 4; ++e) { const int col = 4 * lane + 256 * j + e, part = col >> 9, within = col & 511, i = within & 255;
                                    const float omega = __builtin_amdgcn_exp2f((float)i * (-13.287712379549449f / 256.0f)); const float rev = (float)(part ? pcol : prow) * omega * 0.15915494309189535f;
                                    const float pv = (within >> 8) ? __builtin_amdgcn_cosf(rev) : __builtin_amdgcn_sinf(rev);
                                    if (j == 0) pe[0][e] = pv; else if (j == 1) pe[1][e] = pv; else if (j == 2) pe[2][e] = pv; else pe[3][e] = pv; } }
#pragma unroll
                        for (int j = 0; j < 4; ++j) vb2[j] += pe[j]; }
#pragma unroll
                    for (int j = 0; j < 4; ++j) if (LIVE_) *(f32x4*)(hrow + 4 * lane + 256 * j) = vb2[j];
                } else {
#pragma unroll
                    for (int j = 0; j < 4; ++j) vb2[j] = *(const f32x4*)(hrow + 4 * lane + 256 * j);
                }
                f32x4 scv[4], shv[4];
#pragma unroll
                for (int j = 0; j < 4; ++j) { scv[j] = *(const f32x4*)(scale + 4 * lane + 256 * j); shv[j] = *(const f32x4*)(shift + 4 * lane + 256 * j); }
                ln_rows(vb2);
#pragma unroll
                for (int j = 0; j < 4; ++j) { const f32x4 sc = scv[j], sh = shv[j]; vb2[j] = vb2[j] * (sc + 1.0f) + sh;
                    v2u w; w.x = pk2(vb2[j][0], vb2[j][1]); w.y = pk2(vb2[j][2], vb2[j][3]); if (LIVE_) *(v2u*)(XN + (size_t)row * D + 4 * lane + 256 * j) = w; }
                }
                float pa[16], pb_[16];
                { f32x2 vp[4][4];
#pragma unroll
                  for (int j = 0; j < 4; ++j)
#pragma unroll
                      for (int e = 0; e < 4; ++e) vp[j][e] = (f32x2){va[j][e], vb2[j][e]};
#pragma unroll
                  for (int o = 0; o < 16; ++o) { f32x2 sr = (f32x2){0.f, 0.f};
#pragma unroll
                    for (int j = 0; j < 4; ++j) { const f32x4 w = *(const LAS f32x4*)(wab + o * 1024 + 4 * lane + 256 * j);
#pragma unroll
                        for (int e = 0; e < 4; ++e) sr += vp[j][e] * w[e]; }
                    pa[o] = sr[0]; pb_[o] = sr[1]; if ((o & 3) == 3) asm volatile("" ::: "memory"); } }
                const float t0_ = reduce16(pa, lane), t1_ = reduce16(pb_, lane);
                if ((lane & 3) == 0) { AB[(size_t)rowb * 16 + (lane >> 2)] = t0_ + bin[OFF_A + (lane >> 2)]; if (rowb + NGW < NTOK) AB[(size_t)(rowb + NGW) * 16 + (lane >> 2)] = t1_ + bin[OFF_A + (lane >> 2)]; }
            }
        } }
        SEAM(pb + 0);

        for (int rep_ = 0; rep_ <= (int)PH_REP(2); ++rep_) { if (rep_) GRID_BAR();
        if (PH_ON(2) && IN(pb + 1)) { PH_BEGIN(); const float* mv = modv + (size_t)l * 9 * 6144; (void)mv; unsigned* const moecnt = ctl + CW_MOE + l * 16 * 64; (void)moecnt;
            SchedInA S{X.G, X.bid, (const char*)XN, (const char*)WIN};
            EpiInA E{PQKV, PZ, PCONF, PSGU, PFFT, PFFTC, binv};
            pg8::gemm_phase<EpiInA, SchedInA, true, true>(lds, Gemm{1024, 1024, 1024}, S, E);
        } }
        SEAM(pb + 1);

        for (int rep_ = 0; rep_ <= (int)PH_REP(3); ++rep_) { if (rep_) GRID_BAR();
        if (PH_ON(3) && IN(pb + 2)) { PH_BEGIN(); const float* mv = modv + (size_t)l * 9 * 6144; (void)mv; unsigned* const moecnt = ctl + CW_MOE + l * 16 * 64; (void)moecnt;
            {
                const int vb = X.bid, NB2 = X.G, gw2 = gw, NGW2 = NGW;
                if (l == 0) { SchedFftCtx S{NB2, vb, (const char*)DFTC, (const char*)PFFTC}; EpiBf16<0> E{BR + (size_t)2 * NTOK * 512, 512, nullptr};
                  pg8::gemm_phase<EpiBf16<0>, SchedFftCtx, true, true>(lds, Gemm{512, 512, 512}, S, E); }
                __syncthreads();
                {
                    typedef short v4i16_t __attribute__((ext_vector_type(4)));
                    LAS unsigned char* tl = lds + X.wave * 8192;
                    const int r16 = lane & 15, quad = lane >> 4;
                    bf16x8 m1[4][2];
#pragma unroll
                    for (int mt = 0; mt < 4; ++mt)
#pragma unroll
                        for (int ks = 0; ks < 2; ++ks) { float o[8]; const int k1 = 16 * (mt & 1) + r16, ri = mt >> 1;
#pragma unroll
                            for (int e = 0; e < 8; ++e) { const int t1 = 8 * quad + e; float sn, cs; fsincospi((float)((k1 * t1) & 31) * (1.0f / 16.0f), &sn, &cs);
                                o[e] = ri == 0 ? (ks == 0 ? cs : -sn) : (ks == 0 ? -sn : -cs); }
                            m1[mt][ks] = __builtin_bit_cast(bf16x8, pack8(o)); }
                    float twc[2][4][4], tws[2][4][4];
#pragma unroll
                    for (int ml = 0; ml < 2; ++ml)
#pragma unroll
                        for (int c = 0; c < 4; ++c)
#pragma unroll
                            for (int r = 0; r < 4; ++r) { const int k1 = 16 * ml + r16, t2 = 16 * c + 4 * quad + r; fsincospi((float)(k1 * t2) * (1.0f / 1024.0f), &tws[ml][c][r], &twc[ml][c][r]); }
                    const unsigned tbase = (unsigned)(size_t)tl;
                    for (int it = gw2; it < NB * 512; it += NGW2) {
                        const int b = it >> 9, col = it & 511;
                        const bf16* src = PFFT + (size_t)it * 4096;
                        v4u ld[8];
#pragma unroll
                        for (int i = 0; i < 8; ++i) ld[i] = *(const v4u*)(src + (i * 64 + lane) * 8);
#pragma unroll
                        for (int i = 0; i < 8; ++i) *(LAS v4u*)(tl + (i * 64 + lane) * 16) = ld[i];
                        LDS_WAIT();
                        bf16* dst = (b < 4 ? F1A + (size_t)(b * 512 + col) * 4096 : F1B + (size_t)((b - 4) * 512 + col) * 4096);
#pragma unroll
                        for (int c = 0; c < 4; ++c) {
                            bf16x8 af[2];
#pragma unroll
                            for (int ks = 0; ks < 2; ++ks) { v4i16_t h[2];
#pragma unroll
                                for (int t = 0; t < 2; ++t) h[t] = __builtin_amdgcn_ds_read_tr16_b64_v4i16((LAS v4i16_t*)(tl + ks * 4096 + (8 * quad + 4 * t + (r16 >> 2)) * 128 + (16 * c + 4 * (lane & 3)) * 2));
                                bf16x8 f; f[0] = h[0][0]; f[1] = h[0][1]; f[2] = h[0][2]; f[3] = h[0][3]; f[4] = h[1][0]; f[5] = h[1][1]; f[6] = h[1][2]; f[7] = h[1][3]; af[ks] = f; }
                            f32x4 acc[4];
#pragma unroll
                            for (int mt = 0; mt < 4; ++mt) { acc[mt] = (f32x4){0.f, 0.f, 0.f, 0.f};
#pragma unroll
                                for (int ks = 0; ks < 2; ++ks) acc[mt] = __builtin_amdgcn_mfma_f32_16x16x32_bf16(af[ks], m1[mt][ks], acc[mt], 0, 0, 0); }
#pragma unroll
                            for (int ml = 0; ml < 2; ++ml) { const int k1 = 16 * ml + r16; float pr[4], pi[4];
#pragma unroll
                                for (int r = 0; r < 4; ++r) { const float ar = acc[ml][r], ai = acc[ml + 2][r]; pr[r] = ar * twc[ml][c][r] + ai * tws[ml][c][r]; pi[r] = ai * twc[ml][c][r] - ar * tws[ml][c][r]; }
                                v2u w0, w1; w0.x = pk2(pr[0], pr[1]); w0.y = pk2(pr[2], pr[3]); w1.x = pk2(pi[0], pi[1]); w1.y = pk2(pi[2], pi[3]);
                                *(v2u*)(dst + k1 * 128 + 16 * c + 4 * quad) = w0; *(v2u*)(dst + k1 * 128 + 64 + 16 * c + 4 * quad) = w1; }
                        }
                        LDS_WAIT();
                    }
                    (void)tbase;
                    __syncthreads();
                }
                {
                    LAS float* cwl = (LAS float*)lds;
                    const float* cw = INP(I_GCONV) + (size_t)l * 5 * 1536;
                    { f32x4 t4[4];
#pragma unroll
                      for (int j = 0; j < 4; ++j) { const int i = tid + 512 * j; t4[j] = *(const f32x4*)(cw + 4 * (i < 1920 ? i : 0)); }
#pragma unroll
                      for (int j = 0; j < 4; ++j) { const int i = tid + 512 * j; if (i < 1920) *(LAS f32x4*)(cwl + 4 * i) = t4[j]; } }
                    __syncthreads();
                    const float gdt_l = INP(I_GDT)[l * 8 + (lane & 7)], nega_l = -__expf(INP(I_GALOG)[l * 8 + (lane & 7)]);
                    for (int row = gw2; row < NTOK; row += NGW2) {
                        int t, T; if (row < NLAT) { t = row & 2047; T = 2048; } else { t = (row - NLAT) & 255; T = 256; }
                        v4u xr[3][5];
#pragma unroll
                        for (int seg = 0; seg < 3; ++seg)
#pragma unroll
                            for (int j = 0; j < 5; ++j) { const int tt = t + j - 2; xr[seg][j] = (tt >= 0 && tt < T) ? *(const v4u*)(PQKV + (size_t)(row + j - 2) * 1536 + seg * 512 + 8 * lane) : (v4u){0u, 0u, 0u, 0u}; }
                        float av = 0.f, bv = 0.f; if (lane < 8) { av = AB[(size_t)row * 16 + lane]; bv = AB[(size_t)row * 16 + 8 + lane]; }
#pragma unroll
                        for (int seg = 0; seg < 3; ++seg) { const int ch = seg * 512 + 8 * lane; float a[8];
#pragma unroll
                            for (int e = 0; e < 8; ++e) a[e] = 0.f;
#pragma unroll
                            for (int j = 0; j < 5; ++j) { float xv[8]; unpack8(xr[seg][j], xv);
                                const f32x4 w0 = *(const LAS f32x4*)(cwl + j * 1536 + ch), w1 = *(const LAS f32x4*)(cwl + j * 1536 + ch + 4);
#pragma unroll
                                for (int e = 0; e < 4; ++e) { a[e] += w0[e] * xv[e]; a[4 + e] += w1[e] * xv[4 + e]; } }
                            float ss = 0.f;
#pragma unroll
                            for (int e = 0; e < 8; ++e) { a[e] = siluf_(a[e]); ss += a[e] * a[e]; }
                            if (seg < 2) { ss = g16_sum(ss); const float sc = __builtin_amdgcn_rsqf(ss + LN_EPS) * (seg == 0 ? 0.08838834764831845f : 1.0f);
#pragma unroll
                                for (int e = 0; e < 8; ++e) a[e] *= sc; }
                            *(v4u*)(QKV + (size_t)row * 1536 + ch) = pack8(a); }
                        if (lane < 8) { const float xs = av + gdt_l; const float sp = xs > 20.f ? xs : __logf(1.0f + __expf(xs));
                            GB[(size_t)row * 16 + lane] = nega_l * sp; GB[(size_t)row * 16 + 8 + lane] = __builtin_amdgcn_rcpf(1.0f + __expf(-bv)); }
                    }
                    __syncthreads();
                }
                {
                    LAS bf16* xs = (LAS bf16*)lds;
                    LAS float* wl = (LAS float*)(lds + 63488);
                    const float* dw = INP(I_CDWW) + (size_t)l * 31 * 512; const float* dwb = INP(I_CDWB) + l * 512, *lg = INP(I_CLNG) + l * 512, *lb = INP(I_CLNB) + l * 512;
                    bf16* B1 = BR + (size_t)1 * NTOK * 512;
                    { f32x4 t8[8];
#pragma unroll
                      for (int j = 0; j < 8; ++j) { const int i = tid + 512 * j; t8[j] = *(const f32x4*)(dw + 4 * (i < 3968 ? i : 0)); }
#pragma unroll
                      for (int j = 0; j < 8; ++j) { const int i = tid + 512 * j; if (i < 3968) *(LAS f32x4*)(wl + 4 * i) = t8[j]; } }
                    const int ch = 8 * lane, tq = X.wave;
                    f32x4 bia0 = *(const f32x4*)(dwb + ch), bia1 = *(const f32x4*)(dwb + ch + 4);
                    const f32x4 g0 = *(const f32x4*)(lg + ch), g1 = *(const f32x4*)(lg + ch + 4), b0 = *(const f32x4*)(lb + ch), b1 = *(const f32x4*)(lb + ch + 4);
                    for (int tile = vb; tile < nrows2 / 32; tile += NB2) {
                        const int t0 = tile * 32; int rbase, T; if (t0 < NLAT) { rbase = t0 & ~2047; T = 2048; } else { rbase = NLAT + ((t0 - NLAT) & ~255); T = 256; }
                        __syncthreads();
                        { v4u tl8[8];
#pragma unroll
                          for (int j = 0; j < 8; ++j) { const int i = tid + 512 * j, r = i >> 6, c = i & 63, srow = t0 - 15 + r; const bool ok = i < 62 * 64 && srow >= rbase && srow < rbase + T;
                              tl8[j] = *(const v4u*)(PCONF + (size_t)(ok ? srow : t0) * 512 + 8 * c); if (!ok) tl8[j] = (v4u){0u, 0u, 0u, 0u}; }
#pragma unroll
                          for (int j = 0; j < 8; ++j) { const int i = tid + 512 * j, r = i >> 6, c = i & 63; if (i < 62 * 64) *(LAS v4u*)(xs + r * 512 + 8 * c) = tl8[j]; } }
                        __syncthreads();
                        float acc[4][8];
#pragma unroll
                        for (int k = 0; k < 4; ++k)
#pragma unroll
                            for (int e = 0; e < 4; ++e) { acc[k][e] = bia0[e]; acc[k][4 + e] = bia1[e]; }
#pragma unroll 1
                        for (int j = 0; j < 31; ++j) {
                            const f32x4 w0 = *(const LAS f32x4*)(wl + j * 512 + ch), w1 = *(const LAS f32x4*)(wl + j * 512 + ch + 4);
#pragma unroll
                            for (int k = 0; k < 4; ++k) { float xv[8]; unpack8(*(const LAS v4u*)(xs + (tq * 4 + k + j) * 512 + ch), xv);
#pragma unroll
                                for (int e = 0; e < 4; ++e) { acc[k][e] += w0[e] * xv[e]; acc[k][4 + e] += w1[e] * xv[4 + e]; } }
                        }
#pragma unroll
                        for (int k = 0; k < 4; ++k) { float s1 = 0.f;
#pragma unroll
                            for (int e = 0; e < 8; ++e) s1 += acc[k][e];
                            const float mean = g16_sum(s1) * (1.0f / 128.0f); float s2 = 0.f;
#pragma unroll
                            for (int e = 0; e < 8; ++e) { acc[k][e] -= mean; s2 += acc[k][e] * acc[k][e]; }
                            const float rstd = __builtin_amdgcn_rsqf(g16_sum(s2) * (1.0f / 128.0f) + LN_EPS); float o[8];
#pragma unroll
                            for (int e = 0; e < 4; ++e) { o[e] = siluf_(acc[k][e] * rstd * g0[e] + b0[e]); o[4 + e] = siluf_(acc[k][4 + e] * rstd * g1[e] + b1[e]); }
                            *(v4u*)(B1 + (size_t)(t0 + tq * 4 + k) * 512 + ch) = pack8(o); }
                    }
                    __syncthreads();
                }
                {
                    LAS bf16* vnT = (LAS bf16*)lds;
                    const float* lg = INP(I_SLNG) + l * 512, *lb = INP(I_SLNB) + l * 512;
                    bf16* B3 = BR + (size_t)3 * NTOK * 512;
                    const int nitems = (nrows2 / 128) * 4, r16 = lane & 15, quad = lane >> 4, w = X.wave;
                    for (int it = (vb + NB2 - NB2 / 4) % NB2; it < nitems; it += NB2) {
                        const int chunk = it >> 2, g = it & 3, r0 = chunk * 128;
                        unsigned raw[16];
#pragma unroll
                        for (int i = 0; i < 16; ++i) raw[i] = *(const unsigned*)(PSGU + (size_t)(r0 + w * 16 + i) * 1024 + 512 + g * 128 + 2 * lane);
                        const int c = g * 128 + 2 * lane; const float lg0 = lg[c], lg1 = lg[c + 1], lb0 = lb[c], lb1 = lb[c + 1];
                        __syncthreads();
                        { float sv[16];
#pragma unroll
                          for (int i = 0; i < 16; ++i) sv[i] = bflo(raw[i]) + bfhi(raw[i]);
                          const float ts = reduce16(sv, lane) * (1.0f / 128.0f); float mean[16];
#pragma unroll
                          for (int i = 0; i < 16; ++i) { mean[i] = __shfl(ts, 4 * i); const float v0 = bflo(raw[i]) - mean[i], v1 = bfhi(raw[i]) - mean[i]; sv[i] = v0 * v0 + v1 * v1; }
                          const float tv = reduce16(sv, lane) * (1.0f / 128.0f);
#pragma unroll
                          for (int i = 0; i < 16; ++i) { const float rstd = __builtin_amdgcn_rsqf(__shfl(tv, 4 * i) + LN_EPS); const float v0 = bflo(raw[i]) - mean[i], v1 = bfhi(raw[i]) - mean[i];
                            vnT[(2 * lane) * 136 + w * 16 + i] = (bf16)f2bf(v0 * rstd * lg0 + lb0); vnT[(2 * lane + 1) * 136 + w * 16 + i] = (bf16)f2bf(v1 * rstd * lg1 + lb1); } }
                        bf16x8 wf[4];
                        { const float* wsrc = INP(I_SWS) + ((size_t)(l * 4 + g) * 128 + 16 * w + r16) * 128 + quad * 8;
#pragma unroll
                          for (int ks = 0; ks < 4; ++ks) { const f32x4 x0 = *(const f32x4*)(wsrc + 32 * ks), x1 = *(const f32x4*)(wsrc + 32 * ks + 4);
                              v4u pk; pk.x = pk2(x0[0], x0[1]); pk.y = pk2(x0[2], x0[3]); pk.z = pk2(x1[0], x1[1]); pk.w = pk2(x1[2], x1[3]); wf[ks] = __builtin_bit_cast(bf16x8, pk); } }
                        const float bs = INP(I_SBS)[(l * 4 + g) * 128 + 16 * w + r16];
                        __syncthreads();
                        const size_t prow = (size_t)(r0 + 16 * w + r16);
#pragma unroll
                        for (int nt = 0; nt < 8; ++nt) { f32x4 acc = (f32x4){0.f, 0.f, 0.f, 0.f};
#pragma unroll
                            for (int ks = 0; ks < 4; ++ks) { const bf16x8 vf = *(const LAS bf16x8*)(vnT + (16 * nt + r16) * 136 + 32 * ks + quad * 8); acc = __builtin_amdgcn_mfma_f32_16x16x32_bf16(vf, wf[ks], acc, 0, 0, 0); }
                            const v2u uw = *(const v2u*)(PSGU + prow * 1024 + g * 128 + 16 * nt + quad * 4);
                            v2u o; o.x = pk2(bflo(uw.x) * (acc[0] + bs), bfhi(uw.x) * (acc[1] + bs)); o.y = pk2(bflo(uw.y) * (acc[2] + bs), bfhi(uw.y) * (acc[3] + bs));
                            *(v2u*)(B3 + prow * 512 + g * 128 + 16 * nt + quad * 4) = o; }
                    }
                    __syncthreads();
                }
            }
        } }
        SEAM(pb + 2);

        for (int rep_ = 0; rep_ <= (int)PH_REP(4); ++rep_) { if (rep_) GRID_BAR();
        if (PH_ON(4) && IN(pb + 3)) { PH_BEGIN(); const float* mv = modv + (size_t)l * 9 * 6144; (void)mv; unsigned* const moecnt = ctl + CW_MOE + l * 16 * 64; (void)moecnt;
            {
                const int r16 = lane & 15, quad = lane >> 4;
                bf16x8 m2[4][4];
#pragma unroll
                for (int jt = 0; jt < 4; ++jt)
#pragma unroll
                    for (int ks = 0; ks < 4; ++ks) { float o[8]; const int k2 = 16 * jt + r16;
#pragma unroll
                        for (int e = 0; e < 8; ++e) { const int t2 = 32 * (ks & 1) + 8 * quad + e; float sn, cs; fsincospi((float)((k2 * t2) & 63) * (1.0f / 32.0f), &sn, &cs); o[e] = ((ks >> 1) ? sn : cs) * 0.022097086912079608f; }
                        m2[jt][ks] = __builtin_bit_cast(bf16x8, pack8(o)); }
                bf16* B2 = BR + (size_t)2 * NTOK * 512;
                const int nq5 = 9216 - 4 * NGW;
                const bool bal = nq5 > 0 && nq5 < NGW;
                for (int it = bal ? gw - nq5 : gw; it < 8192; it += bal ? NGW - nq5 : NGW) {
                    if (it < 0) break;
                    const int b = it >> 10, k1 = (it >> 5) & 31, ct = it & 31;
                    const bf16* f1 = (b < 4 ? F1A + (size_t)(b * 512 + 16 * ct + r16) * 4096 : F1B + (size_t)((b - 4) * 512 + 16 * ct + r16) * 4096) + k1 * 128 + 8 * quad;
                    bf16x8 af[4];
#pragma unroll
                    for (int ks = 0; ks < 4; ++ks) af[ks] = *(const bf16x8*)(f1 + 32 * ks);
#pragma unroll
                    for (int jt = 0; jt < 4; ++jt) { f32x4 acc = (f32x4){0.f, 0.f, 0.f, 0.f};
#pragma unroll
                        for (int ks = 0; ks < 4; ++ks) acc = __builtin_amdgcn_mfma_f32_16x16x32_bf16(af[ks], m2[jt][ks], acc, 0, 0, 0);
                        v2u w; w.x = pk2(acc[0], acc[1]); w.y = pk2(acc[2], acc[3]);
                        *(v2u*)(B2 + (size_t)(b * 2048 + k1 + 32 * (16 * jt + r16)) * 512 + 16 * ct + 4 * quad) = w; }
                }
            }
            for (int qi = gw; qi < 9216; qi += NGW) {
                int lane_l = lane; asm volatile("" : "+v"(lane_l));
                const int r16 = lane_l & 15, quad = lane_l >> 4;
                LAS float* const Mt = (LAS float*)(lds + X.wave * 16384);
                LAS float* const gcl = (LAS float*)(lds + 132096 + X.wave * 1024);
                const int item = qi >> 2, q = qi & 3, cidx = item % 36, chain = item / 36, dir = chain & 1, hh = (chain >> 1) & 3, b = chain >> 3;
                const int row0 = cidx < 4 ? NLAT + b * CTXL + cidx * 64 : b * SEQ + (cidx - 4) * 64;
                const int rb = row0 + (dir ? 63 : 0); const long sg = dir ? -1 : 1;
                const float ga = GB[(size_t)(rb + sg * lane_l) * 16 + dir * 4 + hh], be = GB[(size_t)(rb + sg * lane_l) * 16 + 8 + dir * 4 + hh];
                float gc = ga;
#pragma unroll
                for (int o = 1; o < 64; o <<= 1) { const float tu = __shfl_up(gc, o); gc += (lane_l >= o) ? tu : 0.f; }
                const float gl = __shfl(gc, 63);
                gcl[lane_l] = gc; gcl[64 + lane_l] = be;
                const float scl = q >= 2 ? be * __expf(gc) : be;
                bf16x8 Kf[4][4];
                { const bf16* kp = QKV + (size_t)(rb + sg * r16) * 1536 + 512 + hh * 128 + quad * 8; const long ms = sg * 16 * 1536;
#pragma unroll
                  for (int mi = 0; mi < 4; ++mi)
#pragma unroll
                      for (int ks = 0; ks < 4; ++ks) Kf[mi][ks] = *(const bf16x8*)(kp + mi * ms + ks * 32); }
                LDS_WAIT();
                if (q == 0) {
                    bf16x8 Qf[4][4];
                    { const bf16* qp = QKV + (size_t)(rb + sg * r16) * 1536 + hh * 128 + quad * 8; const long ms = sg * 16 * 1536;
#pragma unroll
                      for (int mi = 0; mi < 4; ++mi)
#pragma unroll
                          for (int ks = 0; ks < 4; ++ks) Qf[mi][ks] = *(const bf16x8*)(qp + mi * ms + ks * 32); }
                    bf16* ait = AIT + (size_t)item * 4096 + r16 * 64 + quad * 4;
#pragma unroll
                    for (int mi = 0; mi < 4; ++mi) { const float gci = gcl[16 * mi + r16];
#pragma unroll
                        for (int nj = 0; nj < 4; ++nj) {
                            v2u w; w.x = 0u; w.y = 0u;
                            if (nj <= mi) {
                                f32x4 c = (f32x4){0.f, 0.f, 0.f, 0.f};
#pragma unroll
                                for (int ks = 0; ks < 4; ++ks) c = __builtin_amdgcn_mfma_f32_16x16x32_bf16(Kf[nj][ks], Qf[mi][ks], c, 0, 0, 0);
                                const f32x4 gcj = *(const LAS f32x4*)(gcl + 16 * nj + quad * 4); float o4[4];
#pragma unroll
                                for (int r = 0; r < 4; ++r) { const bool incl = (nj < mi) || (quad * 4 + r <= r16); o4[r] = incl ? c[r] * __expf(gci - gcj[r]) : 0.f; }
                                w.x = pk2(o4[0], o4[1]); w.y = pk2(o4[2], o4[3]); }
                            *(v2u*)(ait + mi * 16 * 64 + 16 * nj) = w; }
                    }
                }
                if (q == 1) { SIT[(size_t)item * 192 + lane_l] = __expf(gc); SIT[(size_t)item * 192 + 64 + lane_l] = __expf(gl - gc); if (lane_l == 0) SIT[(size_t)item * 192 + 128] = __expf(gl); }
                asm volatile("" ::: "memory");
                { LAS float* mw = Mt + r16 * 64 + quad * 4;
#pragma unroll
                  for (int mi = 0; mi < 4; ++mi) {
                    const f32x4 gci = *(const LAS f32x4*)(gcl + 16 * mi + quad * 4), bei = *(const LAS f32x4*)(gcl + 64 + 16 * mi + quad * 4);
#pragma unroll
                    for (int nj = 0; nj <= mi; ++nj) {
                        f32x4 c = (f32x4){0.f, 0.f, 0.f, 0.f};
#pragma unroll
                        for (int ks = 0; ks < 4; ++ks) c = __builtin_amdgcn_mfma_f32_16x16x32_bf16(Kf[mi][ks], Kf[nj][ks], c, 0, 0, 0);
                        const float gcj = gcl[16 * nj + r16]; f32x4 mv4;
#pragma unroll
                        for (int r = 0; r < 4; ++r) { const bool strict = (nj < mi) || (r16 < quad * 4 + r); mv4[r] = strict ? -(bei[r] * c[r] * __expf(gci[r] - gcj)) : 0.f; }
                        *(LAS f32x4*)(mw + (16 * nj) * 64 + 16 * mi) = mv4;
                    }
                  } }
                asm volatile("" ::: "memory");
                LDS_WAIT();
                float Xs[64];
                { const bf16* src = QKV + (size_t)rb * 1536 + (q < 2 ? 1024 + 64 * q : 512 + 64 * (q - 2)) + hh * 128 + lane_l; const long sstep = sg * 1536;
                  bf16 raw[64];
#pragma unroll
                  for (int sidx = 0; sidx < 64; ++sidx) { raw[sidx] = *src; src += sstep; }
                  asm volatile("" ::: "memory");
#pragma unroll
                  for (int sidx = 0; sidx < 64; ++sidx) { const float sc = __builtin_bit_cast(float, __builtin_amdgcn_readlane(__builtin_bit_cast(int, scl), sidx)); Xs[sidx] = bf1(raw[sidx]) * sc; } }
#pragma unroll
                for (int g4 = 0; g4 < 16; ++g4) {
                    f32x4 acc = (f32x4){Xs[4 * g4], Xs[4 * g4 + 1], Xs[4 * g4 + 2], Xs[4 * g4 + 3]};
#pragma unroll
                    for (int c0 = 0; c0 < 4 * g4; c0 += 16) {
                        f32x4 mb[16];
#pragma unroll
                        for (int e = 0; e < 16; ++e) if (c0 + e < 4 * g4) mb[e] = *(const LAS f32x4*)(Mt + (c0 + e) * 64 + 4 * g4);
                        LDS_WAIT();
#pragma unroll
                        for (int e = 0; e < 16; ++e) if (c0 + e < 4 * g4) acc += mb[e] * Xs[c0 + e];
                    }
                    const f32x4 m0 = *(const LAS f32x4*)(Mt + (4 * g4) * 64 + 4 * g4), m1 = *(const LAS f32x4*)(Mt + (4 * g4 + 1) * 64 + 4 * g4), m2 = *(const LAS f32x4*)(Mt + (4 * g4 + 2) * 64 + 4 * g4);
                    LDS_WAIT();
                    const float x0 = acc[0], x1 = acc[1] + m0[1] * x0, x2 = acc[2] + m0[2] * x0 + m1[2] * x1, x3 = acc[3] + m0[3] * x0 + m1[3] * x1 + m2[3] * x2;
                    Xs[4 * g4] = x0; Xs[4 * g4 + 1] = x1; Xs[4 * g4 + 2] = x2; Xs[4 * g4 + 3] = x3;
                }
                if (q < 2) {
                    bf16* u0 = UIT + (size_t)item * 8192 + (size_t)(64 * q + lane_l) * 64;
#pragma unroll
                    for (int p = 0; p < 8; ++p) { float c0[8];
#pragma unroll
                        for (int e = 0; e < 8; ++e) c0[e] = Xs[8 * p + e];
                        *(v4u*)(u0 + 8 * p) = pack8(c0); }
                } else {
                    bf16* w0 = WIT + (size_t)item * 8192 + 64 * (q - 2) + lane_l;
#pragma unroll
                    for (int sidx = 0; sidx < 64; ++sidx) { w0[sidx * 128] = (bf16)f2bf(Xs[sidx]); if ((sidx & 15) == 15) asm volatile("" ::: "memory"); }
                    asm volatile("" ::: "memory");
                    if (dir == 0) {
                        const bf16* src = QKV + (size_t)row0 * 1536 + 512 + hh * 128 + 64 * (q - 2) + lane_l;
                        bf16* k0 = KIT + ((size_t)((b * 4 + hh) * 36 + cidx)) * 8192 + (size_t)(64 * (q - 2) + lane_l) * 64;
                        unsigned kw[64];
#pragma unroll
                        for (int e = 0; e < 64; ++e) kw[e] = src[(size_t)e * 1536];
                        asm volatile("" ::: "memory");
#pragma unroll
                        for (int p = 0; p < 8; ++p) { v4u lo; lo.x = kw[8 * p] | (kw[8 * p + 1] << 16); lo.y = kw[8 * p + 2] | (kw[8 * p + 3] << 16); lo.z = kw[8 * p + 4] | (kw[8 * p + 5] << 16); lo.w = kw[8 * p + 6] | (kw[8 * p + 7] << 16);
                            *(v4u*)(k0 + 8 * p) = lo; }
                    }
                }
                LDS_WAIT();
            }
        } }
        SEAM(pb + 3);

        for (int rep_ = 0; rep_ <= (int)PH_REP(5); ++rep_) { if (rep_) GRID_BAR();
        if (PH_ON(5) && IN(pb + 4)) { PH_BEGIN(); const float* mv = modv + (size_t)l * 9 * 6144; (void)mv; unsigned* const moecnt = ctl + CW_MOE + l * 16 * 64; (void)moecnt;
            LAS bf16* const STl = (LAS bf16*)lds;
            LAS bf16* const VNl = (LAS bf16*)(lds + 8704);
            LAS bf16* const VSl = (LAS bf16*)(lds + 13312);
            const int w = X.wave, mt = w & 3, role = w >> 2, r16 = lane & 15, quad = lane >> 4;
            for (int blk = X.bid; blk < 256; blk += X.G) {
                const int item = (blk & 7) * 32 + (blk >> 3);
                const int chain = item >> 2, slice = item & 3, dir = chain & 1, hh = (chain >> 1) & 3, b = chain >> 3;
                bf16* const O = dir ? OB : OF;
                __syncthreads();
                for (int i = tid; i < 32 * 136 / 2; i += 512) ((LAS unsigned*)STl)[i] = 0u;
                __syncthreads();
                f32x4 Sacc[2]; Sacc[0] = (f32x4){0.f, 0.f, 0.f, 0.f}; Sacc[1] = (f32x4){0.f, 0.f, 0.f, 0.f};
#define GDN_LOAD(P, step_) do { const int cidx_ = dir ? ((step_) < 4 ? 3 - (step_) : 39 - (step_)) : (step_); const int item_ = chain * 36 + cidx_, kti_ = (chain >> 1) * 36 + cidx_; \
                    const int row0_ = cidx_ < 4 ? NLAT + b * CTXL + cidx_ * 64 : b * SEQ + (cidx_ - 4) * 64; \
                    const bf16* xp_ = role ? QKV + (size_t)(row0_ + (dir ? 63 - (16 * mt + r16) : 16 * mt + r16)) * 1536 + hh * 128 + quad * 8 : WIT + (size_t)item_ * 8192 + (16 * mt + r16) * 128 + quad * 8; \
                    _Pragma("unroll") for (int ks = 0; ks < 4; ++ks) P##Xf[ks] = *(const bf16x8*)(xp_ + 32 * ks); \
                    { const bf16* kp_ = KIT + (size_t)kti_ * 8192 + (16 * w + r16) * 64 + (dir ? 56 - quad * 8 : quad * 8); \
                      _Pragma("unroll") for (int ks = 0; ks < 2; ++ks) P##Kx[ks] = *(const v4u*)(kp_ + (dir ? -32 * ks : 32 * ks)); } \
                    const float* sp_ = SIT + (size_t)item_ * 192; P##sc4 = *(const f32x4*)(sp_ + (role ? 0 : 64) + 16 * mt + quad * 4); P##egl = sp_[128]; \
                      \
                    { const bf16* a0_ = role ? AIT + (size_t)item_ * 4096 + (16 * mt + r16) * 64 + quad * 8 : UIT + (size_t)item_ * 8192 + (size_t)(slice * 32 + r16) * 64 + 16 * mt + quad * 4; \
                      const bf16* a1_ = role ? a0_ + 32 : a0_ + 16 * 64; \
                      P##Ax[0] = *(const v2u*)a0_; P##Ax[1] = *(const v2u*)(a0_ + 4); P##Ax[2] = *(const v2u*)a1_; P##Ax[3] = *(const v2u*)(a1_ + 4); } } while (0)
#define GDN_BAR() do { asm volatile("s_waitcnt lgkmcnt(0)" ::: "memory"); __builtin_amdgcn_s_barrier(); asm volatile("" ::: "memory"); } while (0)
#define GDN_STEP(P, step_) do { const int cidx = dir ? ((step_) < 4 ? 3 - (step_) : 39 - (step_)) : (step_); \
                    const int row0 = cidx < 4 ? NLAT + b * CTXL + cidx * 64 : b * SEQ + (cidx - 4) * 64; \
                      \
                    f32x4 x1[2]; x1[0] = (f32x4){0.f, 0.f, 0.f, 0.f}; x1[1] = (f32x4){0.f, 0.f, 0.f, 0.f}; \
                    { bf16x8 bfr[2][4]; \
                      _Pragma("unroll") for (int n_ = 0; n_ < 2; ++n_) _Pragma("unroll") for (int ks = 0; ks < 4; ++ks) bfr[n_][ks] = *(const LAS bf16x8*)(STl + (16 * n_ + r16) * 136 + 32 * ks + quad * 8); \
                      asm volatile("s_waitcnt lgkmcnt(0)" ::: "memory"); \
                      _Pragma("unroll") for (int ks = 0; ks < 4; ++ks) { x1[0] = __builtin_amdgcn_mfma_f32_16x16x32_bf16(P##Xf[ks], bfr[0][ks], x1[0], 0, 0, 0); x1[1] = __builtin_amdgcn_mfma_f32_16x16x32_bf16(P##Xf[ks], bfr[1][ks], x1[1], 0, 0, 0); } } \
                    if (role == 0) { \
                        _Pragma("unroll") for (int n_ = 0; n_ < 2; ++n_) { f32x4 vn; vn[0] = bflo(P##Ax[2 * n_].x) - x1[n_][0]; vn[1] = bfhi(P##Ax[2 * n_].x) - x1[n_][1]; vn[2] = bflo(P##Ax[2 * n_].y) - x1[n_][2]; vn[3] = bfhi(P##Ax[2 * n_].y) - x1[n_][3]; \
                            v2u p; p.x = pk2(vn[0], vn[1]); p.y = pk2(vn[2], vn[3]); *(LAS v2u*)(VNl + (16 * n_ + r16) * 72 + 16 * mt + quad * 4) = p; \
                            v2u q; q.x = pk2(vn[0] * P##sc4[0], vn[1] * P##sc4[1]); q.y = pk2(vn[2] * P##sc4[2], vn[3] * P##sc4[3]); *(LAS v2u*)(VSl + (16 * n_ + r16) * 72 + 16 * mt + quad * 4) = q; } } \
                    else { x1[0] = x1[0] * P##sc4; x1[1] = x1[1] * P##sc4; } \
                    bf16x8 kt_[2]; \
                    _Pragma("unroll") for (int ks = 0; ks < 2; ++ks) { const v4u kx_ = P##Kx[ks]; v4u kr_; \
                        kr_.x = dir ? ((kx_.w >> 16) | (kx_.w << 16)) : kx_.x; kr_.y = dir ? ((kx_.z >> 16) | (kx_.z << 16)) : kx_.y; kr_.z = dir ? ((kx_.y >> 16) | (kx_.y << 16)) : kx_.z; kr_.w = dir ? ((kx_.x >> 16) | (kx_.x << 16)) : kx_.w; \
                        kt_[ks] = __builtin_bit_cast(bf16x8, kr_); } \
                    GDN_BAR(); \
                      \
                    bf16x8 vsf[2][2]; \
                    _Pragma("unroll") for (int n2 = 0; n2 < 2; ++n2) { vsf[n2][0] = *(const LAS bf16x8*)(VSl + (16 * n2 + r16) * 72 + quad * 8); vsf[n2][1] = *(const LAS bf16x8*)(VSl + (16 * n2 + r16) * 72 + 32 + quad * 8); } \
                    if (role) { bf16x8 vb[2][2]; \
                        _Pragma("unroll") for (int n_ = 0; n_ < 2; ++n_) { vb[n_][0] = *(const LAS bf16x8*)(VNl + (16 * n_ + r16) * 72 + quad * 8); vb[n_][1] = *(const LAS bf16x8*)(VNl + (16 * n_ + r16) * 72 + 32 + quad * 8); } \
                        asm volatile("s_waitcnt lgkmcnt(0)" ::: "memory"); \
                        v4u af0_; af0_.x = P##Ax[0].x; af0_.y = P##Ax[0].y; af0_.z = P##Ax[1].x; af0_.w = P##Ax[1].y; v4u af1_; af1_.x = P##Ax[2].x; af1_.y = P##Ax[2].y; af1_.z = P##Ax[3].x; af1_.w = P##Ax[3].y; \
                        const bf16x8 Af0_ = __builtin_bit_cast(bf16x8, af0_), Af1_ = __builtin_bit_cast(bf16x8, af1_); \
                        _Pragma("unroll") for (int n_ = 0; n_ < 2; ++n_) { f32x4 oa = __builtin_amdgcn_mfma_f32_16x16x32_bf16(Af0_, vb[n_][0], x1[n_], 0, 0, 0); oa = __builtin_amdgcn_mfma_f32_16x16x32_bf16(Af1_, vb[n_][1], oa, 0, 0, 0); \
                            bf16* op = O + (size_t)(row0 + (dir ? 63 - (16 * mt + quad * 4) : 16 * mt + quad * 4)) * 512 + hh * 128 + slice * 32 + 16 * n_ + r16; const long ostep = dir ? -512 : 512; \
                            _Pragma("unroll") for (int j = 0; j < 4; ++j) op[j * ostep] = (bf16)f2bf(oa[j]); } } \
                    else { asm volatile("s_waitcnt lgkmcnt(0)" ::: "memory"); } \
                    _Pragma("unroll") for (int n2 = 0; n2 < 2; ++n2) { \
                        f32x4 sa = Sacc[n2] * P##egl; sa = __builtin_amdgcn_mfma_f32_16x16x32_bf16(kt_[0], vsf[n2][0], sa, 0, 0, 0); sa = __builtin_amdgcn_mfma_f32_16x16x32_bf16(kt_[1], vsf[n2][1], sa, 0, 0, 0); Sacc[n2] = sa; \
                        v2u p; p.x = pk2(sa[0], sa[1]); p.y = pk2(sa[2], sa[3]); *(LAS v2u*)(STl + (16 * n2 + r16) * 136 + 16 * w + quad * 4) = p; } \
                    GDN_BAR(); } while (0)
#define GDN_DECL(P) bf16x8 P##Xf[4]; v4u P##Kx[2]; v2u P##Ax[4]; f32x4 P##sc4; float P##egl
                GDN_DECL(sa_); GDN_DECL(sb_);
                GDN_LOAD(sa_, 0);
                for (int step = 0; step < 36; step += 2) {
                    GDN_LOAD(sb_, step + 1); GDN_STEP(sa_, step);
                    { const int s2 = step + 2 < 36 ? step + 2 : 35; GDN_LOAD(sa_, s2); } GDN_STEP(sb_, step + 1);
                }
#undef GDN_STEP
#undef GDN_BAR
#undef GDN_DECL
#undef GDN_LOAD
            }
        } }
        SEAM(pb + 4);

        for (int rep_ = 0; rep_ <= (int)PH_REP(6); ++rep_) { if (rep_) GRID_BAR();
        if (PH_ON(6) && IN(pb + 5)) { PH_BEGIN(); const float* mv = modv + (size_t)l * 9 * 6144; (void)mv; unsigned* const moecnt = ctl + CW_MOE + l * 16 * 64; (void)moecnt;
            const float* nw = INP(I_GNORM) + l * 128; const int ch = 8 * lane;
            const f32x4 nw0 = *(const f32x4*)(nw + (ch & 127)), nw1 = *(const f32x4*)(nw + (ch & 127) + 4);
            constexpr int ERT = 9;
            for (int rowb = gw; rowb < nrows2; rowb += ERT * NGW) {
                v4u lf[ERT], lb[ERT], lz[ERT];
#pragma unroll
                for (int k = 0; k < ERT; ++k) { const int row_ = rowb + k * NGW, row = row_ < nrows2 ? row_ : nrows2 - 1; lf[k] = *(const v4u*)(OF + (size_t)row * 512 + ch); lb[k] = *(const v4u*)(OB + (size_t)row * 512 + ch); lz[k] = *(const v4u*)(PZ + (size_t)row * 512 + ch); }
#pragma unroll
                for (int k = 0; k < ERT; ++k) { const int row_ = rowb + k * NGW, row = row_ < nrows2 ? row_ : nrows2 - 1; {
                    float of[8], ob[8], z[8], o[8]; unpack8(lf[k], of); unpack8(lb[k], ob); unpack8(lz[k], z); float ss = 0.f;
#pragma unroll
                    for (int e = 0; e < 8; ++e) { of[e] += ob[e]; ss += of[e] * of[e]; }
                    const float rs = __builtin_amdgcn_rsqf(g16_sum(ss) * (1.0f / 128.0f) + LN_EPS);
#pragma unroll
                    for (int e = 0; e < 4; ++e) { o[e] = of[e] * rs * nw0[e] * z[e]; o[4 + e] = of[4 + e] * rs * nw1[e] * z[4 + e]; }
                    if (row_ < nrows2) *(v4u*)(BR + (size_t)row * 512 + ch) = pack8(o); } }
            }
        } }
        SEAM(pb + 5);

        for (int rep_ = 0; rep_ <= (int)PH_REP(7); ++rep_) { if (rep_) GRID_BAR();
        if (PH_ON(7) && IN(pb + 6)) { PH_BEGIN(); const float* mv = modv + (size_t)l * 9 * 6144; (void)mv; unsigned* const moecnt = ctl + CW_MOE + l * 16 * 64; (void)moecnt;
            SchedBranch S{X.G, X.bid, npan2, (const char*)BR, (const char*)WBR};
            EpiBf16<0> E{GT, 4096, nullptr};
            pg8::gemm_phase<EpiBf16<0>, SchedBranch, true, true>(lds, Gemm{512, 512, 512}, S, E);
        } }
        SEAM(pb + 6);

        for (int rep_ = 0; rep_ <= (int)PH_REP(8); ++rep_) { if (rep_) GRID_BAR();
        if (PH_ON(8) && IN(pb + 7)) { PH_BEGIN(); const float* mv = modv + (size_t)l * 9 * 6144; (void)mv; unsigned* const moecnt = ctl + CW_MOE + l * 16 * 64; (void)moecnt;
            SchedGrid S{X.G, X.bid, npan2, 16, (const char*)XN, (const char*)(WIN + (size_t)5120 * 1024), (size_t)256 * 1024 * 2, (size_t)256 * 1024 * 2};
            EpiGateMerge E{GT, (bf16*)MERGED, binv + 5120};
            pg8::gemm_phase<EpiGateMerge, SchedGrid, true, true>(lds, Gemm{1024, 1024, 1024}, S, E);
        } }
        SEAM(pb + 7);

        for (int rep_ = 0; rep_ <= (int)PH_REP(9); ++rep_) { if (rep_) GRID_BAR();
        if (PH_ON(9) && IN(pb + 8)) { PH_BEGIN(); const float* mv = modv + (size_t)l * 9 * 6144; (void)mv; unsigned* const moecnt = ctl + CW_MOE + l * 16 * 64; (void)moecnt;
            SchedGrid S{X.G, X.bid, npan2, 4, (const char*)MERGED, (const char*)WOUT, (size_t)256 * 1024 * 2, (size_t)256 * 1024 * 2};
            EpiBf16<0> E{(bf16*)YB, 1024, INP(I_BOUT) + l * 1024};
            pg8::gemm_phase<EpiBf16<0>, SchedGrid, true, true>(lds, Gemm{1024, 1024, 1024}, S, E);
            __syncthreads();
            { LAS float* const wscr = (LAS float*)(lds + X.wave * 8448);
              const int first = npan2 * 4 > X.G ? npan2 * 4 - X.G : 0;
              if (X.bid >= first) { const int gwc = (X.bid - first) * NWAVES + X.wave, ngwc = (X.G - first) * NWAVES;
              for (int it = gwc; it < 12288; it += ngwc) {
                if (it < 8192) { const int e = it >> 9, rb = (it & 3) + 4 * ((it >> 3) & 7), kb = ((it >> 2) & 1) + 2 * ((it >> 6) & 7), row0 = rb * 32, j = row0 >> 8, w = row0 & 255;
                    const float* src = (w < 128 ? INP(I_EWG) : INP(I_EWU)) + ((size_t)(l * 16 + e) * 1024) * 512;
                    cvt_item(src, 512, 128 * j + (w & 127) + (lane & 31), kb * 64, WGU + ((size_t)e * 1024 + row0) * 1024, 1024, wscr, lane); }
                else { const int i2 = it - 8192; const int e = i2 >> 8, rb = (i2 & 3) + 4 * ((i2 >> 3) & 7), kb = ((i2 >> 2) & 1) + 2 * ((i2 >> 6) & 3);
                    cvt_item(INP(I_EWD) + ((size_t)(l * 16 + e) * 512) * 1024, 1024, rb * 32 + (lane & 31), kb * 64, WDN + ((size_t)e * 1024 + rb * 32) * 512, 512, wscr, lane); }
              } } }
        } }
        SEAM(pb + 8);

        for (int rep_ = 0; rep_ <= (int)PH_REP(10); ++rep_) { if (rep_) GRID_BAR();
        if (PH_ON(10) && IN(pb + 9)) { PH_BEGIN(); const float* mv = modv + (size_t)l * 9 * 6144; (void)mv; unsigned* const moecnt = ctl + CW_MOE + l * 16 * 64; (void)moecnt;
            LAS float* wr_ = (LAS float*)lds;
            volatile LAS unsigned* lcnt = (volatile LAS unsigned*)(lds + 100352);
            __syncthreads();
            if (tid < 32) lcnt[tid] = 0u;
            { f32x4 rq[10];
#pragma unroll
              for (int j = 0; j < 2; ++j) rq[j] = *(const f32x4*)(INP(I_RGW) + (size_t)l * 4096 + (size_t)(tid + 512 * j) * 4);
#pragma unroll
              for (int j = 0; j < 8; ++j) rq[2 + j] = *(const f32x4*)(INP(I_REW) + (size_t)l * 16384 + (size_t)(tid + 512 * (j & 1)) * 16 + 4 * (j >> 1));
#pragma unroll
              for (int j = 0; j < 2; ++j) { LAS float* p = wr_ + tid + 512 * j; p[0] = rq[j][0]; p[1024] = rq[j][1]; p[2048] = rq[j][2]; p[3072] = rq[j][3]; }
#pragma unroll
              for (int j = 0; j < 8; ++j) { LAS float* p = wr_ + (4 + 4 * (j >> 1)) * 1024 + tid + 512 * (j & 1); p[0] = rq[2 + j][0]; p[1024] = rq[2 + j][1]; p[2048] = rq[2 + j][2]; p[3072] = rq[2 + j][3]; } }
            __syncthreads();
            const float* g1 = INP(I_LN1G) + l * 1024, *b1 = INP(I_LN1B) + l * 1024;
            const float rgb_l = INP(I_RGB)[l * 4 + ((lane >> 4) & 3)], reb_l = INP(I_REB)[l * 16 + ((lane >> 2) & 15)];
            constexpr int RT = 2;
            for (int rowb = gw; rowb < nrows2; rowb += RT * NGW) {
                f32x4 v[RT][4];
#pragma unroll
                for (int q = 0; q < RT; ++q) { const int row_ = rowb + q * NGW, row = row_ < nrows2 ? row_ : nrows2 - 1; const bool live = row_ < nrows2;
                    float* hrow = row < NLAT ? hlat + (size_t)row * D : hctx + (size_t)(row - NLAT) * D;
                    const int mi = row < NLAT ? (row >> 11) : 8; const float* mrow = mv + mi * 6144;
                    v2u yw[4]; f32x4 hv[4], gt[4], g1v[4], b1v[4], scv[4], shv[4];
#pragma unroll
                    for (int j = 0; j < 4; ++j) { const int c = 4 * lane + 256 * j; yw[j] = *(const v2u*)((const bf16*)YB + (size_t)row * D + c); hv[j] = *(const f32x4*)(hrow + c); gt[j] = *(const f32x4*)(mrow + 2048 + c); }
#pragma unroll
                    for (int j = 0; j < 4; ++j) { const int c = 4 * lane + 256 * j; g1v[j] = *(const f32x4*)(g1 + c); b1v[j] = *(const f32x4*)(b1 + c); scv[j] = *(const f32x4*)(mrow + 4096 + c); shv[j] = *(const f32x4*)(mrow + 3072 + c); }
#pragma unroll
                    for (int j = 0; j < 4; ++j) { const f32x4 yv = (f32x4){bflo(yw[j].x), bfhi(yw[j].x), bflo(yw[j].y), bfhi(yw[j].y)}; v[q][j] = hv[j] * DN_ALPHA + gt[j] * yv; }
                    ln_rows(v[q]);
#pragma unroll
                    for (int j = 0; j < 4; ++j) { const int c = 4 * lane + 256 * j; v[q][j] = v[q][j] * g1v[j] + b1v[j]; if (live) *(f32x4*)(hrow + c) = v[q][j]; }
                    ln_rows(v[q]);
#pragma unroll
                    for (int j = 0; j < 4; ++j) { const int c = 4 * lane + 256 * j; v[q][j] = v[q][j] * (scv[j] + 1.0f) + shv[j];
                        v2u w; w.x = pk2(v[q][j][0], v[q][j][1]); w.y = pk2(v[q][j][2], v[q][j][3]); if (live) *(v2u*)(XN + (size_t)row * D + c) = w; }
                    asm volatile("" ::: "memory"); }
                static_assert(RT == 2, "the two rows of a trip ride in the two halves of packed f32 operations");
                float pg[RT][4], pe[RT][16];
                { f32x2 vp[4][4];
#pragma unroll
                  for (int j = 0; j < 4; ++j)
#pragma unroll
                      for (int e = 0; e < 4; ++e) vp[j][e] = (f32x2){v[0][j][e], v[1][j][e]};
#pragma unroll
                  for (int o = 0; o < 20; ++o) { f32x2 sr = (f32x2){0.f, 0.f};
#pragma unroll
                    for (int j = 0; j < 4; ++j) { const f32x4 w = *(const LAS f32x4*)(wr_ + o * 1024 + 4 * lane + 256 * j);
#pragma unroll
                        for (int e = 0; e < 4; ++e) sr += vp[j][e] * w[e]; }
                    if (o < 4) { pg[0][o] = sr[0]; pg[1][o] = sr[1]; } else { pe[0][o - 4] = sr[0]; pe[1][o - 4] = sr[1]; }
                    if ((o & 3) == 3) asm volatile("" ::: "memory"); } }
#pragma unroll
                for (int q = 0; q < RT; ++q) { const int row = rowb + q * NGW;
                float tg = reduce4(pg[q], lane), te = reduce16(pe[q], lane);
                tg += rgb_l; te += reb_l;
                float lg[20];
#pragma unroll
                for (int o = 0; o < 4; ++o) lg[o] = __shfl(tg, o * 16);
#pragma unroll
                for (int o = 0; o < 16; ++o) lg[4 + o] = __shfl(te, o * 4);
                int gs = 0; float gm = lg[0];
#pragma unroll
                for (int o = 1; o < 4; ++o) if (lg[o] > gm) { gm = lg[o]; gs = o; }
                float den = 0.f;
#pragma unroll
                for (int o = 0; o < 4; ++o) den += __expf(lg[o] - gm);
                const float gp = __builtin_amdgcn_rcpf(den);
                float el[4];
#pragma unroll
                for (int o = 0; o < 4; ++o) el[o] = gs == 0 ? lg[4 + o] : gs == 1 ? lg[8 + o] : gs == 2 ? lg[12 + o] : lg[16 + o];
                int i0 = 0; float v0 = el[0];
#pragma unroll
                for (int o = 1; o < 4; ++o) if (el[o] > v0) { v0 = el[o]; i0 = o; }
                int i1 = -1; float v1 = 0.f;
#pragma unroll
                for (int o = 0; o < 4; ++o) if (o != i0 && (i1 < 0 || el[o] > v1)) { v1 = el[o]; i1 = o; }
                const float ex = __expf(v1 - v0), rz = __builtin_amdgcn_rcpf(1.0f + ex), w0 = gp * rz, w1 = gp * ex * rz;
                const int e0 = gs * 4 + i0, e1 = gs * 4 + i1;
                if (lane == 0 && row < nrows2) {
                    const unsigned p0 = __hip_atomic_fetch_add((LAS unsigned*)lcnt + e0, 1u, __ATOMIC_RELAXED, __HIP_MEMORY_SCOPE_WORKGROUP);
                    const unsigned p1 = __hip_atomic_fetch_add((LAS unsigned*)lcnt + e1, 1u, __ATOMIC_RELAXED, __HIP_MEMORY_SCOPE_WORKGROUP);
                    float* rt = ROUTE + (size_t)row * 8;
                    rt[0] = __builtin_bit_cast(float, e0); rt[1] = __builtin_bit_cast(float, e1); rt[2] = w0; rt[3] = w1; rt[4] = __builtin_bit_cast(float, (int)p0); rt[5] = __builtin_bit_cast(float, (int)p1);
                }
                asm volatile("" ::: "memory"); }
            }
            __syncthreads();
            if (tid < 16) { const unsigned c = lcnt[tid]; lcnt[16 + tid] = c ? __hip_atomic_fetch_add(moecnt + 64 * tid, c, __ATOMIC_RELAXED, __HIP_MEMORY_SCOPE_AGENT) : 0u; }
            __syncthreads();
            for (int row = gw + lane * NGW; row < nrows2; row += 64 * NGW) {
                { float* rt = ROUTE + (size_t)row * 8; const int e0 = __builtin_bit_cast(int, rt[0]), e1 = __builtin_bit_cast(int, rt[1]);
                    const int q0 = __builtin_bit_cast(int, rt[4]) + (int)lcnt[16 + e0], q1 = __builtin_bit_cast(int, rt[5]) + (int)lcnt[16 + e1];
                    rt[4] = __builtin_bit_cast(float, q0); rt[5] = __builtin_bit_cast(float, q1);
                    ELIST[(size_t)e0 * NTOK + q0] = row; ELIST[(size_t)e1 * NTOK + q1] = row; }
            }
        } }
        SEAM(pb + 9);


        for (int rep_ = 0; rep_ <= (int)PH_REP(12); ++rep_) { if (rep_) GRID_BAR();
        if (PH_ON(12) && IN(pb + 11)) { PH_BEGIN(); const float* mv = modv + (size_t)l * 9 * 6144; (void)mv; unsigned* const moecnt = ctl + CW_MOE + l * 16 * 64; (void)moecnt;
            SchedMoeG S; S.G = X.G; S.c = X.bid; S.a0 = (const char*)XN; S.w0 = (const char*)WGU; S.wstep_e = (size_t)1024 * 1024 * 2; S.wstep_n = (size_t)256 * 1024 * 2; S.list = ELIST; S.init(moecnt, (LAS unsigned*)(lds + LDSCTL_OFF + 64));
            EpiMoe1 E{HID};
            pg8::gemm_phase<EpiMoe1, SchedMoeG, true, true>(lds, Gemm{1024, 1024, 1024}, S, E);
        } }
        SEAM(pb + 11);

        for (int rep_ = 0; rep_ <= (int)PH_REP(13); ++rep_) { if (rep_) GRID_BAR();
        if (PH_ON(13) && IN(pb + 12)) { PH_BEGIN(); const float* mv = modv + (size_t)l * 9 * 6144; (void)mv; unsigned* const moecnt = ctl + CW_MOE + l * 16 * 64; (void)moecnt;
            SchedMoe S; S.G = X.G; S.c = X.bid; S.a0 = (const char*)HID; S.w0 = (const char*)WDN; S.astep = (size_t)256 * 512 * 2; S.wstep_e = (size_t)1024 * 512 * 2; S.wstep_n = (size_t)256 * 512 * 2; S.init(moecnt);
            EpiBf16<0> E{MO, 1024, nullptr};
            pg8::gemm_phase<EpiBf16<0>, SchedMoe, true, true>(lds, Gemm{512, 512, 512}, S, E);
        } }
        SEAM(pb + 12);

        for (int rep_ = 0; rep_ <= (int)PH_REP(14); ++rep_) { if (rep_) GRID_BAR();
        if (PH_ON(14) && IN(pb + 13)) { PH_BEGIN(); const float* mv = modv + (size_t)l * 9 * 6144; (void)mv; unsigned* const moecnt = ctl + CW_MOE + l * 16 * 64; (void)moecnt;
            unsigned pre[16]; { unsigned s = 0;
#pragma unroll
                for (int e = 0; e < 16; ++e) { pre[e] = s; s += ((__hip_atomic_load(moecnt + 64 * e, __ATOMIC_RELAXED, __HIP_MEMORY_SCOPE_AGENT) + 255u) >> 8) << 8; } }
            const float* g2 = INP(I_LN2G) + l * 1024, *b2 = INP(I_LN2B) + l * 1024;
            for (int rowb = gw; rowb < nrows2; rowb += 3 * NGW) {
                int re0[3], re1[3], rp0[3], rp1[3]; float rw0[3], rw1[3];
#pragma unroll
                for (int k = 0; k < 3; ++k) { const int row_ = rowb + k * NGW, row = row_ < nrows2 ? row_ : nrows2 - 1; const float* rt = ROUTE + (size_t)row * 8;
                    re0[k] = __builtin_bit_cast(int, rt[0]); re1[k] = __builtin_bit_cast(int, rt[1]); rw0[k] = rt[2]; rw1[k] = rt[3]; rp0[k] = __builtin_bit_cast(int, rt[4]); rp1[k] = __builtin_bit_cast(int, rt[5]); }
                v2u ma[3][4], mb[3][4]; f32x4 hv[3][4];
#pragma unroll
                for (int k = 0; k < 3; ++k) { const int row_ = rowb + k * NGW, row = row_ < nrows2 ? row_ : nrows2 - 1; {
                    const int e0 = re0[k], e1 = re1[k]; unsigned ba0 = 0, ba1 = 0;
#pragma unroll
                    for (int q = 0; q < 16; ++q) { ba0 = (q == e0) ? pre[q] : ba0; ba1 = (q == e1) ? pre[q] : ba1; }
                    const bf16* m0 = MO + (size_t)(ba0 + (unsigned)rp0[k]) * D, *m1 = MO + (size_t)(ba1 + (unsigned)rp1[k]) * D;
                    const float* hrow = row < NLAT ? hlat + (size_t)row * D : hctx + (size_t)(row - NLAT) * D;
#pragma unroll
                    for (int j = 0; j < 4; ++j) { const int c = 4 * lane + 256 * j; ma[k][j] = *(const v2u*)(m0 + c); mb[k][j] = *(const v2u*)(m1 + c); hv[k][j] = *(const f32x4*)(hrow + c); } } }
#pragma unroll
                for (int k = 0; k < 3; ++k) { const int row_ = rowb + k * NGW, row = row_ < nrows2 ? row_ : nrows2 - 1; {
                    float* hrow = row < NLAT ? hlat + (size_t)row * D : hctx + (size_t)(row - NLAT) * D;
                    const int mi = row < NLAT ? (row >> 11) : 8; const float* mrow = mv + mi * 6144; const float w0 = rw0[k], w1 = rw1[k];
                    f32x4 v[4], gtv[4], g2v[4], b2v[4];
#pragma unroll
                    for (int j = 0; j < 4; ++j) { const int c = 4 * lane + 256 * j; gtv[j] = *(const f32x4*)(mrow + 5120 + c); g2v[j] = *(const f32x4*)(g2 + c); b2v[j] = *(const f32x4*)(b2 + c); }
#pragma unroll
                    for (int j = 0; j < 4; ++j) { const v2u a = ma[k][j], b = mb[k][j];
                        f32x4 mm; mm[0] = w0 * bflo(a.x) + w1 * bflo(b.x); mm[1] = w0 * bfhi(a.x) + w1 * bfhi(b.x); mm[2] = w0 * bflo(a.y) + w1 * bflo(b.y); mm[3] = w0 * bfhi(a.y) + w1 * bfhi(b.y);
                        v[j] = hv[k][j] * DN_ALPHA + gtv[j] * mm; }
                    ln_rows(v);
                    if (row_ < nrows2) {
#pragma unroll
                    for (int j = 0; j < 4; ++j) { const int c = 4 * lane + 256 * j; *(f32x4*)(hrow + c) = v[j] * g2v[j] + b2v[j]; } } } }
            }
        } }
        SEAM(pb + 13);
    }
#if TPROBE
    {
        GRID_BAR(); STAMP(NPHASES); GRID_BAR();
        unsigned* ts = (unsigned*)(args.ws + WS_CTL) + CW_TS; float T = 0.f;
        for (int l2 = 0; l2 < 2; ++l2) { const int p = (TPA) == 100 ? 0 : 1 + NPH_LAYER * l2 + (TPA);
            if ((TPA) != 100 || l2 == 0) T += (float)(__hip_atomic_load(ts + p + 1, __ATOMIC_RELAXED, __HIP_MEMORY_SCOPE_AGENT) - __hip_atomic_load(ts + p, __ATOMIC_RELAXED, __HIP_MEMORY_SCOPE_AGENT)) * 0.01f; }
        for (size_t i = (size_t)blockIdx.x * 512 + threadIdx.x; i < (size_t)NLAT * D; i += (size_t)gridDim.x * 512) { const int j = (int)(i >> 19);
            if (T >= (float)(TOFF) + 20.0f * (float)(j + 1)) args.out[i] += 0.2f; }
    }
#endif
#undef IN
#undef SEAM
}

extern "C" void kernel_launch(void* const* d_in, const int* in_sizes, int n_in, void* d_out, int out_size, void* d_ws, size_t ws_size, hipStream_t stream) {
    static int grid = 0;
    if (grid == 0) {
        if (n_in != 34 || out_size != NLAT * D || ws_size < WS_END) { fprintf(stderr, "kernel_launch: unexpected problem (n_in %d out %d ws %zu)\n", n_in, out_size, ws_size); grid = -1; return; }
        int dev = 0, cus = 0, per_cu = 0;
        if (hipGetDevice(&dev) != hipSuccess || hipDeviceGetAttribute(&cus, hipDeviceAttributeMultiprocessorCount, dev) != hipSuccess) { grid = -1; return; }
        if (hipFuncSetAttribute((const void*)fwd, hipFuncAttributeMaxDynamicSharedMemorySize, LDS_BYTES) != hipSuccess) { fprintf(stderr, "kernel_launch: hipFuncSetAttribute failed\n"); grid = -1; return; }
        if (hipOccupancyMaxActiveBlocksPerMultiprocessor(&per_cu, (const void*)fwd, NWAVES * 64, LDS_BYTES) != hipSuccess || per_cu < 1) { fprintf(stderr, "kernel_launch: occupancy query reports %d\n", per_cu); }
        (void)hipGetLastError();
        grid = cus;
    }
    if (grid < 0) return;
    if (hipMemsetAsync((char*)d_ws + WS_CTL, 0, CTL_ZERO_BYTES, stream) != hipSuccess) return;
    Args a{};
    for (int i = 0; i < 34; ++i) a.in[i] = (const float*)d_in[i];
    a.out = (float*)d_out; a.ws = (unsigned char*)d_ws;
#if MK_ONE_LAUNCH
    a.ph_lo = 0; a.ph_hi = NPHASES;
    hipLaunchKernelGGL(fwd, dim3(grid), dim3(NWAVES * 64), LDS_BYTES, stream, a);
#else
    for (int p = 0; p < NPHASES; ++p) { a.ph_lo = p; a.ph_hi = p + 1; hipLaunchKernelGGL(fwd, dim3(grid), dim3(NWAVES * 64), LDS_BYTES, stream, a); }
#endif
}
```

```cpp
#include <hip/hip_runtime.h>
#include <cstdio>
#include <cstdint>

#define GAS __attribute__((address_space(1)))
#define LAS __attribute__((address_space(3)))
typedef unsigned short bf16;
typedef unsigned v4u __attribute__((ext_vector_type(4)));
typedef unsigned v2u __attribute__((ext_vector_type(2)));
typedef float f32x4 __attribute__((ext_vector_type(4)));
typedef float f32x2 __attribute__((ext_vector_type(2)));
typedef short bf16x8 __attribute__((ext_vector_type(8)));

constexpr int D = 1024, NB = 8, SEQ = 2048, CTXL = 256, NLAT = NB * SEQ, NCTX = NB * CTXL, NTOK = NLAT + NCTX;
constexpr int OFF_Q = 0, OFF_K = 512, OFF_V = 1024, OFF_Z = 1536, OFF_A = 2048, OFF_B = 2056, OFF_CONF = 2064, OFF_FFT = 3088, OFF_SGU = 3600, OFF_GATE = 4624, N_IN = 8720;
constexpr int NWROWS = 9216;
constexpr float LN_EPS = 1e-6f;
constexpr float DN_ALPHA = 1.4142135623730951f;
constexpr int NWAVES = 8;
constexpr int NPH_LAYER = 14, NPHASES = 1 + 2 * NPH_LAYER;

#ifndef PHMASK
#define PHMASK 0xFFFFFFFFu
#endif
#define PH_ON(k) (((PHMASK) >> (k)) & 1u)
#ifndef REPMASK
#define REPMASK 0u
#endif
#define PH_REP(k) (((REPMASK) >> (k)) & 1u)
#ifndef TPA
#define TPA -1
#endif
#ifndef TPB
#define TPB -1
#endif
#ifndef TOFF
#define TOFF 0
#endif
#define TPROBE ((TPA) >= 0 || (TPB) >= 0)
#ifndef CPART
#define CPART 15
#endif
#ifndef MK_ONE_LAUNCH
#define MK_ONE_LAUNCH 1
#endif

constexpr size_t MiB = 1u << 20;
constexpr size_t WS_CTL = 0, CTL_ZERO_BYTES = 128 * 1024;
constexpr size_t WS_MODV = 1 * MiB;
constexpr size_t WS_BIN = 1 * MiB + 512 * 1024;
constexpr size_t WS_ROUTE = WS_BIN + 64 * 1024;
constexpr size_t WS_HCTX = 3 * MiB;
constexpr size_t WS_XN = 11 * MiB;
constexpr size_t WS_WIN = 47 * MiB;
constexpr size_t WS_WBR = 65 * MiB;
constexpr size_t WS_WOUT = 69 * MiB;
constexpr size_t WS_DFTL = 71 * MiB;
constexpr size_t WS_DFTC = 87 * MiB;
constexpr size_t WS_F1B = 71 * MiB;
constexpr size_t WS_R2 = 88 * MiB;
constexpr size_t WS_PQKV = WS_R2;
constexpr size_t WS_PCONF = WS_R2 + 54 * MiB;
constexpr size_t WS_PZ = WS_R2 + 72 * MiB;
constexpr size_t WS_PSGU = WS_R2 + 90 * MiB;
constexpr size_t WS_PFFT = WS_R2 + 126 * MiB;
constexpr size_t WS_PFFTC = WS_R2 + 158 * MiB;
constexpr size_t WS_AB = WS_R2 + 162 * MiB;
constexpr size_t WS_WIT = WS_R2;
constexpr size_t WS_UIT = WS_R2 + 36 * MiB;
constexpr size_t WS_AIT = WS_R2 + 90 * MiB;
constexpr size_t WS_KIT = WS_R2 + 108 * MiB;
constexpr size_t WS_SIT = WS_R2 + 126 * MiB;
constexpr size_t WS_OF = WS_R2 + 128 * MiB;
constexpr size_t WS_OB = WS_R2 + 146 * MiB;
constexpr size_t WS_G = WS_R2;
constexpr size_t WS_WGU = WS_R2;
constexpr size_t WS_WDN = WS_R2 + 32 * MiB;
constexpr size_t WS_XG = WS_R2 + 48 * MiB;
constexpr size_t WS_R3 = WS_R2 + 164 * MiB;
constexpr size_t WS_QKV = WS_R3;
constexpr size_t WS_GB = WS_R3 + 54 * MiB;
constexpr size_t WS_BR = WS_R3 + 72 * MiB;
constexpr size_t WS_F1A = WS_BR;
constexpr size_t WS_MERGED = WS_R3;
constexpr size_t WS_Y = WS_R3 + 72 * MiB;
constexpr size_t WS_HID = WS_R3;
constexpr size_t WS_MO = WS_R3 + 40 * MiB;
constexpr size_t WS_LIST = WS_R3 + 144 * MiB;
constexpr size_t WS_END = WS_LIST + 2 * MiB;
static_assert(WS_END <= 405 * MiB, "workspace map");
constexpr int CW_BAR = 4096;
constexpr int CW_MOE = 16384;

constexpr int RING_BYTES = 131072;
constexpr int LDSCTL_OFF = RING_BYTES, MISC_OFF = LDSCTL_OFF + 320;
constexpr int LDS_BYTES = 147456;

#define LDS_WAIT() asm volatile("s_waitcnt lgkmcnt(0)" ::: "memory")
#define VM_WAIT() asm volatile("s_waitcnt vmcnt(0)" ::: "memory")
typedef __bf16 bf16x2_t __attribute__((ext_vector_type(2)));
__device__ __forceinline__ unsigned pk2(float lo, float hi) { const f32x2 v = {lo, hi}; const bf16x2_t b = __builtin_convertvector(v, bf16x2_t); return __builtin_bit_cast(unsigned, b); }
__device__ __forceinline__ unsigned f2bf(float f) { return pk2(f, 0.0f) & 0xffffu; }
__device__ __forceinline__ float bflo(unsigned w) { return __builtin_bit_cast(float, w << 16); }
__device__ __forceinline__ float bfhi(unsigned w) { return __builtin_bit_cast(float, w & 0xffff0000u); }
__device__ __forceinline__ float bf1(bf16 b) { return __builtin_bit_cast(float, ((unsigned)b) << 16); }
__device__ __forceinline__ void unpack8(const v4u w, float (&o)[8]) { o[0] = bflo(w.x); o[1] = bfhi(w.x); o[2] = bflo(w.y); o[3] = bfhi(w.y); o[4] = bflo(w.z); o[5] = bfhi(w.z); o[6] = bflo(w.w); o[7] = bfhi(w.w); }
__device__ __forceinline__ v4u pack8(const float (&o)[8]) { v4u w; w.x = pk2(o[0], o[1]); w.y = pk2(o[2], o[3]); w.z = pk2(o[4], o[5]); w.w = pk2(o[6], o[7]); return w; }
__device__ __forceinline__ void fsincospi(float x, float* sn, float* cs) { *sn = __builtin_amdgcn_sinf(0.5f * x); *cs = __builtin_amdgcn_cosf(0.5f * x); }
__device__ __forceinline__ float sigmoidf_(float x) { return __builtin_amdgcn_rcpf(1.0f + __expf(-x)); }
__device__ __forceinline__ float siluf_(float x) { return x * __builtin_amdgcn_rcpf(1.0f + __expf(-x)); }
__device__ __forceinline__ float gelu_tanh(float x) { const float u = 0.7978845608028654f * (x + 0.044715f * x * x * x); return x * __builtin_amdgcn_rcpf(1.0f + __expf(-2.0f * u)); }
__device__ __forceinline__ float wave_sum(float v) {
#pragma unroll
    for (int o = 1; o < 64; o <<= 1) v += __shfl_xor(v, o);
    return v;
}
__device__ __forceinline__ float reduce16(const float (&v)[16], int lane) {
    const bool b5 = (lane & 32) != 0, b4 = (lane & 16) != 0, b3 = (lane & 8) != 0, b2 = (lane & 4) != 0;
    float a[8], b[4], c[2];
#pragma unroll
    for (int i = 0; i < 8; ++i) a[i] = (b5 ? v[i + 8] : v[i]) + __shfl_xor(b5 ? v[i] : v[i + 8], 32);
#pragma unroll
    for (int i = 0; i < 4; ++i) b[i] = (b4 ? a[i + 4] : a[i]) + __shfl_xor(b4 ? a[i] : a[i + 4], 16);
#pragma unroll
    for (int i = 0; i < 2; ++i) c[i] = (b3 ? b[i + 2] : b[i]) + __shfl_xor(b3 ? b[i] : b[i + 2], 8);
    float d = (b2 ? c[1] : c[0]) + __shfl_xor(b2 ? c[0] : c[1], 4);
    d += __shfl_xor(d, 2); d += __shfl_xor(d, 1);
    return d;
}
__device__ __forceinline__ float reduce4(const float (&v)[4], int lane) {
    const bool b5 = (lane & 32) != 0, b4 = (lane & 16) != 0; float a[2];
#pragma unroll
    for (int i = 0; i < 2; ++i) a[i] = (b5 ? v[i + 2] : v[i]) + __shfl_xor(b5 ? v[i] : v[i + 2], 32);
    float d = (b4 ? a[1] : a[0]) + __shfl_xor(b4 ? a[0] : a[1], 16);
    d += __shfl_xor(d, 8); d += __shfl_xor(d, 4); d += __shfl_xor(d, 2); d += __shfl_xor(d, 1);
    return d;
}
__device__ __forceinline__ float g16_sum(float v) {
#pragma unroll
    for (int o = 1; o < 16; o <<= 1) v += __shfl_xor(v, o);
    return v;
}

namespace pg8 {
constexpr int BM = 256, BK = 64, HALF = 128, HTB = HALF * BK * 2, STAGE_BYTES = 8 * HTB;
__host__ __device__ __forceinline__ int lds_byte(int r, int c) { const int st = (r >> 4) * 2 + (c >> 5), rr = r & 15, cc = c & 31, ob = rr * 64 + cc * 2; return st * 1024 + (ob ^ (((ob >> 9) & 1) << 5)); }
__host__ __device__ __forceinline__ void stage_rc(int b, int& R, int& C) { const int st = b / 1024, sb = b % 1024, swz = sb ^ (((sb >> 9) & 1) << 5); R = (st >> 1) * 16 + swz / 64; C = (st & 1) * 32 + (swz % 64) / 2; }
__host__ __device__ __forceinline__ int perm32(int rho) { const int n = rho >> 4, i = rho & 15; return 8 * (i >> 2) + 4 * n + (i & 3); }

struct Unit { int pm, pn, aux, ax2; const char* a; const char* b; };
struct Gemm { int K, lda, ldb; };

__device__ __forceinline__ void map_tile(int L, int nM, int nN, int& pm, int& pn) {
    const int nwg = nM * nN; int wgid = L; { const int q = nwg / 8, r = nwg % 8, xcd = wgid % 8, off = wgid / 8; wgid = (xcd < r ? xcd * (q + 1) : r * (q + 1) + (xcd - r) * q) + off; }
    const int nig = 8 * nN, gid = wgid / nig, fm = gid * 8, gsz = (nM - fm) < 8 ? (nM - fm) : 8;
    pm = fm + ((wgid % nig) % gsz); pn = (wgid % nig) / gsz;
}
__device__ __forceinline__ unsigned cvt_pk_bf16(float lo, float hi) { unsigned r; asm volatile("v_cvt_pk_bf16_f32 %0, %1, %2" : "=v"(r) : "v"(lo), "v"(hi)); return r; }

template <class Epi, class Sched, bool ALIGN_EPI, bool SP2>
__device__ __forceinline__ void gemm_phase(LAS unsigned char* lds, const Gemm g, const Sched& S, const Epi& E) {
    int tid_l = threadIdx.x; asm volatile("" : "+v"(tid_l));
    const int tid = tid_l, wid = __builtin_amdgcn_readfirstlane(tid >> 6), lane = tid & 63, wr = wid >> 2, wc = wid & 3, fr = lane & 15, fq = lane >> 4;
    const int K = g.K, nt = K / BK;
    unsigned voffA[2], voffB[2];
#pragma unroll
    for (int i = 0; i < 2; ++i) { int R, C; stage_rc(tid * 16 + i * 8192, R, C); const int Rb = Epi::PERM ? ((R & ~31) + perm32(R & 31)) : R;
        voffA[i] = (unsigned)(R * g.lda + C) * 2u; voffB[i] = (unsigned)(Rb * g.ldb + C) * 2u; }
    static_assert(!Sched::GATHER || SP2, "gathered A rows: only the SP2 loop");
    unsigned vA[2][2], vAn[2][2];
#define PG8_GCALC(dst, u_) do { _Pragma("unroll") for (int i_ = 0; i_ < 2; ++i_) { int R_, C_; stage_rc(tid * 16 + i_ * 8192, R_, C_); _Pragma("unroll") for (int h_ = 0; h_ < 2; ++h_) dst[h_][i_] = S.arow(u_, R_ + 128 * h_) + (unsigned)C_ * 2u; } } while (0)
#define PG8_STAGE_A(bufoff, base, h, nextsel) do { if constexpr (Sched::GATHER) { unsigned vs_[2]; vs_[0] = (nextsel) ? vAn[h][0] : vA[h][0]; vs_[1] = (nextsel) ? vAn[h][1] : vA[h][1]; PG8_STAGE(bufoff, base, vs_); } \
        else { PG8_STAGE(bufoff, (base) + (h) * hstepA, voffA); } } while (0)
    const size_t kstep = (size_t)(BK * 2);
    const size_t hstepA = (size_t)HALF * g.lda * 2, hstepB = (size_t)HALF * g.ldb * 2;
    const unsigned ldsw = (unsigned)wid * 1024u;
    const int aoff = lds_byte(wr * 64 + fr, fq * 8), boff = lds_byte(wc * 32 + fr, fq * 8);
#define PG8_SA(b, h) (((b) * 2 + (h)) * HTB)
#define PG8_SB(b, h) ((4 + (b) * 2 + (h)) * HTB)
#define PG8_STAGE(bufoff, gbase, voff) do { _Pragma("unroll") for (int _i = 0; _i < 2; ++_i) \
        __builtin_amdgcn_global_load_lds((const unsigned*)((const char*)(gbase) + (voff)[_i]), (LAS unsigned*)(lds + (bufoff) + ldsw + _i * 8192), 16, 0, 0); } while (0)
#define PG8_LDA(dst, b, h) do { _Pragma("unroll") for (int m = 0; m < 4; ++m) _Pragma("unroll") for (int k = 0; k < 2; ++k) dst[m][k] = *(const LAS bf16x8*)(lds + PG8_SA(b, h) + aoff + m * 2048 + k * 1024); } while (0)
#define PG8_LDB(dst, b, h) do { _Pragma("unroll") for (int n = 0; n < 2; ++n) _Pragma("unroll") for (int k = 0; k < 2; ++k) dst[n][k] = *(const LAS bf16x8*)(lds + PG8_SB(b, h) + boff + n * 2048 + k * 1024); } while (0)
#define PG8_MMA(ai, bj, At, Bt) do { __builtin_amdgcn_s_setprio(1); _Pragma("unroll") for (int m = 0; m < 4; ++m) _Pragma("unroll") for (int n = 0; n < 2; ++n) _Pragma("unroll") for (int k = 0; k < 2; ++k) \
        acc[ai][bj][m][n] = __builtin_amdgcn_mfma_f32_16x16x32_bf16(Bt[n][k], At[m][k], acc[ai][bj][m][n], 0, 0, 0); __builtin_amdgcn_s_setprio(0); } while (0)
#define PG8_WAIT_V(n) asm volatile("s_waitcnt vmcnt(" #n ")" ::: "memory")
#define PG8_WAIT_L(n) asm volatile("s_waitcnt lgkmcnt(" #n ")" ::: "memory")
#define PG8_BAR __builtin_amdgcn_s_barrier()
#define PG8_SCHED __builtin_amdgcn_sched_barrier(0)
    Unit cur, nxt; int ui = 0;
    if (!S.next(0, cur)) return;
    f32x4 acc[2][2][4][2];
#pragma unroll
    for (int a = 0; a < 2; ++a)
#pragma unroll
        for (int b = 0; b < 2; ++b)
#pragma unroll
            for (int m = 0; m < 4; ++m)
#pragma unroll
                for (int n = 0; n < 2; ++n) acc[a][b][m][n] = (f32x4){0.f, 0.f, 0.f, 0.f};
    bf16x8 At[4][2], B0[2][2], B1[2][2];
    const char* cA = cur.a; const char* cB = cur.b;
    if constexpr (SP2) {
        if constexpr (Sched::GATHER) { PG8_GCALC(vA, cur); }
        PG8_STAGE(PG8_SB(0, 0), cB, voffB); PG8_STAGE(PG8_SB(0, 1), cB + hstepB, voffB); PG8_STAGE_A(PG8_SA(0, 0), cA, 0, false); PG8_STAGE_A(PG8_SA(0, 1), cA, 1, false);
        if (wr == 1) PG8_BAR;
        PG8_WAIT_V(2); PG8_BAR;
        PG8_STAGE(PG8_SB(1, 0), cB + kstep, voffB); PG8_STAGE_A(PG8_SA(1, 0), cA + kstep, 0, false); PG8_STAGE(PG8_SB(1, 1), cB + hstepB + kstep, voffB);
        PG8_WAIT_V(6); PG8_BAR;
    } else {
        PG8_STAGE(PG8_SB(0, 0), cB, voffB); PG8_STAGE(PG8_SA(0, 0), cA, voffA); PG8_STAGE(PG8_SB(0, 1), cB + hstepB, voffB); PG8_STAGE(PG8_SA(0, 1), cA + hstepA, voffA);
        if (wr == 1) PG8_BAR;
        PG8_WAIT_V(4); PG8_BAR;
        PG8_STAGE(PG8_SB(1, 0), cB + kstep, voffB); PG8_STAGE(PG8_SA(1, 0), cA + kstep, voffA); PG8_STAGE(PG8_SB(1, 1), cB + hstepB + kstep, voffB);
        PG8_WAIT_V(6); PG8_BAR;
    }
    for (;;) {
        const bool has_next = S.next(ui + 1, nxt);
        const char* nA = has_next ? nxt.a : cA; const char* nB = has_next ? nxt.b : cB;
        if constexpr (Sched::GATHER) { if (has_next) { PG8_GCALC(vAn, nxt); } else {
#pragma unroll
            for (int h_ = 0; h_ < 2; ++h_)
#pragma unroll
                for (int i_ = 0; i_ < 2; ++i_) vAn[h_][i_] = vA[h_][i_]; } }
        for (int t = 0; t < nt; t += 2) {
            const bool last = (t == nt - 2);
            const char* a1 = cA + (size_t)(t + 1) * kstep;
            const char* a2 = last ? nA : cA + (size_t)(t + 2) * kstep; const char* b2 = last ? nB : cB + (size_t)(t + 2) * kstep;
            const char* a3 = a2 + kstep; const char* b3 = b2 + kstep;
            if constexpr (SP2) {
            PG8_LDB(B0, 0, 0); PG8_LDB(B1, 0, 1); PG8_SCHED; PG8_LDA(At, 0, 0); PG8_STAGE_A(PG8_SA(1, 1), a1, 1, false);
            PG8_WAIT_V(8); PG8_WAIT_L(0); PG8_BAR; PG8_MMA(0, 0, At, B0); PG8_MMA(0, 1, At, B1); PG8_BAR; PG8_SCHED;
            PG8_LDA(At, 0, 1); PG8_STAGE(PG8_SB(0, 0), b2, voffB); PG8_STAGE(PG8_SB(0, 1), b2 + hstepB, voffB); PG8_STAGE_A(PG8_SA(0, 0), a2, 0, last);
            PG8_WAIT_V(8); PG8_WAIT_L(0); PG8_BAR; PG8_MMA(1, 0, At, B0); PG8_MMA(1, 1, At, B1); PG8_BAR; PG8_SCHED;
            PG8_LDB(B0, 1, 0); PG8_LDB(B1, 1, 1); PG8_SCHED; PG8_LDA(At, 1, 0); PG8_STAGE_A(PG8_SA(0, 1), a2, 1, last);
            PG8_WAIT_V(8); PG8_WAIT_L(0); PG8_BAR; PG8_MMA(0, 0, At, B0); PG8_MMA(0, 1, At, B1); PG8_BAR; PG8_SCHED;
            PG8_LDA(At, 1, 1); PG8_STAGE(PG8_SB(1, 0), b3, voffB); PG8_STAGE(PG8_SB(1, 1), b3 + hstepB, voffB); PG8_STAGE_A(PG8_SA(1, 0), a3, 0, last);
            PG8_WAIT_V(8); PG8_WAIT_L(0); PG8_BAR; PG8_MMA(1, 0, At, B0); PG8_MMA(1, 1, At, B1); PG8_BAR; PG8_SCHED;
            } else {
            PG8_LDB(B0, 0, 0); PG8_SCHED; PG8_LDA(At, 0, 0); PG8_STAGE(PG8_SA(1, 1), a1 + hstepA, voffA);
            PG8_WAIT_L(8); PG8_BAR; PG8_WAIT_L(0); PG8_MMA(0, 0, At, B0); PG8_BAR; PG8_SCHED;
            PG8_LDB(B1, 0, 1); PG8_STAGE(PG8_SB(0, 0), b2, voffB);
            PG8_BAR; PG8_WAIT_L(0); PG8_MMA(0, 1, At, B1); PG8_BAR;
            PG8_LDA(At, 0, 1); PG8_STAGE(PG8_SA(0, 0), a2, voffA);
            PG8_BAR; PG8_WAIT_L(0); PG8_MMA(1, 0, At, B0); PG8_BAR; PG8_SCHED;
            PG8_STAGE(PG8_SB(0, 1), b2 + hstepB, voffB);
            PG8_WAIT_V(6); PG8_BAR; PG8_MMA(1, 1, At, B1); PG8_BAR;
            PG8_LDB(B0, 1, 0); PG8_SCHED; PG8_LDA(At, 1, 0); PG8_STAGE(PG8_SA(0, 1), a2 + hstepA, voffA);
            PG8_WAIT_L(8); PG8_BAR; PG8_WAIT_L(0); PG8_MMA(0, 0, At, B0); PG8_BAR; PG8_SCHED;
            PG8_LDB(B1, 1, 1); PG8_STAGE(PG8_SB(1, 0), b3, voffB);
            PG8_BAR; PG8_WAIT_L(0); PG8_MMA(0, 1, At, B1); PG8_BAR;
            PG8_LDA(At, 1, 1); PG8_STAGE(PG8_SA(1, 0), a3, voffA);
            PG8_BAR; PG8_WAIT_L(0); PG8_MMA(1, 0, At, B0); PG8_BAR; PG8_SCHED;
            PG8_STAGE(PG8_SB(1, 1), b3 + hstepB, voffB);
            PG8_WAIT_V(6); PG8_BAR; PG8_MMA(1, 1, At, B1); PG8_BAR;
            }
        }
        if constexpr (ALIGN_EPI) { if (wr == 0) PG8_BAR; }
        E(acc, cur, wr, wc, fr, fq);
        if (!has_next) break;
#pragma unroll
        for (int a = 0; a < 2; ++a)
#pragma unroll
            for (int b = 0; b < 2; ++b)
#pragma unroll
                for (int m = 0; m < 4; ++m)
#pragma unroll
                    for (int n = 0; n < 2; ++n) acc[a][b][m][n] = (f32x4){0.f, 0.f, 0.f, 0.f};
        cur = nxt; cA = nA; cB = nB; ++ui;
        if constexpr (Sched::GATHER) {
#pragma unroll
            for (int h_ = 0; h_ < 2; ++h_)
#pragma unroll
                for (int i_ = 0; i_ < 2; ++i_) vA[h_][i_] = vAn[h_][i_]; }
        if constexpr (ALIGN_EPI) { if (wr == 1) PG8_BAR; }
    }
    PG8_WAIT_V(0);
    if constexpr (!ALIGN_EPI) { if (wr == 0) PG8_BAR; }
    PG8_BAR;
#undef PG8_SA
#undef PG8_SB
#undef PG8_STAGE
#undef PG8_STAGE_A
#undef PG8_GCALC
#undef PG8_LDA
#undef PG8_LDB
#undef PG8_MMA
#undef PG8_WAIT_V
#undef PG8_WAIT_L
#undef PG8_BAR
#undef PG8_SCHED
}
}
using pg8::Unit;
using pg8::Gemm;
typedef f32x4 AccT[2][2][4][2];

#define XB_TMO      128
#define XB_XCNT(j)  (256  + 64 * (j))
#define XB_XSUB(j)  (1280 + 64 * (j))
#define XB_XGEN(j)  (2304 + 64 * (j))
#define XB_TOP      3328
#define XB_TOPGEN   3392
#define XCD_BAR_WORDS 3456
#define XB_SPIN_CAP (1u << 18)
__device__ __forceinline__ unsigned xb_ld(unsigned* p)              { return __hip_atomic_load(p, __ATOMIC_RELAXED, __HIP_MEMORY_SCOPE_AGENT); }
__device__ __forceinline__ unsigned xb_add(unsigned* p, unsigned v) { return __hip_atomic_fetch_add(p, v, __ATOMIC_RELAXED, __HIP_MEMORY_SCOPE_AGENT); }
__device__ __forceinline__ unsigned xb_xcc_id() { return (unsigned)__builtin_amdgcn_s_getreg((3 << 11) | 20) & 0xFu; }
#define XB_SPIN(cond, bar) do { unsigned _sp = 0; while (cond) { __builtin_amdgcn_s_sleep(1); \
    if ((++_sp & 255u) == 0u) { if (xb_ld(&(bar)[XB_TMO])) break; if (_sp > XB_SPIN_CAP) { atomicAdd(&(bar)[XB_TMO], 1u); break; } } } } while (0)
struct XcdBarrier { unsigned* bar; unsigned x; volatile LAS unsigned* st; };
__device__ __forceinline__ XcdBarrier xcd_barrier_post(unsigned* bar, volatile LAS unsigned* st) {
    XcdBarrier b; b.bar = bar; b.x = xb_xcc_id(); b.st = st;
    if (threadIdx.x == 0) (void)xb_add(&bar[XB_XCNT(b.x)], 1u);
    return b;
}
__device__ __forceinline__ void xcd_barrier_complete(unsigned* bar, unsigned x, unsigned& nloc, unsigned& nx) {
    const unsigned G = gridDim.x * gridDim.y * gridDim.z;
    unsigned sum, cnt, mine, sp = 0u;
    for (;;) {
        sum = 0u; cnt = 0u; mine = 0u;
#pragma unroll
        for (unsigned j = 0; j < 16; ++j) { const unsigned c = xb_ld(&bar[XB_XCNT(j)]); sum += c; cnt += (c > 0u) ? 1u : 0u; mine = (j == x) ? c : mine; }
        if (sum == G) break;
        __builtin_amdgcn_s_sleep(1);
        if ((++sp & 255u) == 0u) { if (xb_ld(&bar[XB_TMO])) break; if (sp > XB_SPIN_CAP) { atomicAdd(&bar[XB_TMO], 1u); break; } }
    }
    nloc = mine > 0u ? mine : 1u; nx = cnt > 0u ? cnt : 1u;
}
__device__ __forceinline__ void xcd_barrier(const XcdBarrier& b) {
    asm volatile("s_waitcnt vmcnt(0)" ::: "memory");
    __syncthreads();
    if (threadIdx.x == 0) {
        unsigned* bar = b.bar;
        __builtin_amdgcn_s_waitcnt(0);
        unsigned nloc = b.st[0], nx = b.st[1];
        if (nloc == 0u) { xcd_barrier_complete(bar, b.x, nloc, nx); b.st[0] = nloc; b.st[1] = nx; }
        const unsigned old = xb_add(&bar[XB_XSUB(b.x)], 1u);
        const unsigned gen = old / nloc;
        if (old + 1u == (gen + 1u) * nloc) {
            __builtin_amdgcn_fence(__ATOMIC_RELEASE, "agent");
            asm volatile("s_waitcnt vmcnt(0)" ::: "memory");
            const unsigned og = xb_add(&bar[XB_TOP], 1u);
            const unsigned tg = og / nx;
            if (og + 1u == (tg + 1u) * nx) xb_add(&bar[XB_TOPGEN], 1u);
            else XB_SPIN(xb_ld(&bar[XB_TOPGEN]) == tg, bar);
            __builtin_amdgcn_fence(__ATOMIC_ACQUIRE, "agent");
            xb_add(&bar[XB_XGEN(b.x)], 1u);
            asm volatile("s_waitcnt vmcnt(0)" ::: "memory");
        } else {
            XB_SPIN(xb_ld(&bar[XB_XGEN(b.x)]) == gen, bar);
            __builtin_amdgcn_fence(__ATOMIC_ACQUIRE, "agent");
            asm volatile("s_waitcnt vmcnt(0)" ::: "memory");
        }
    }
    __syncthreads();
}

struct Args { const float* in[34]; float* out; unsigned char* ws; int ph_lo, ph_hi; };
enum { I_X = 0, I_C, I_CTX, I_CCTX, I_WMOD, I_BMOD, I_WIN, I_BIN, I_GCONV, I_GALOG, I_GDT, I_GNORM, I_CDWW, I_CDWB, I_CLNG, I_CLNB, I_SLNG, I_SLNB, I_SWS, I_SBS,
       I_WBR, I_WOUT, I_BOUT, I_LN1G, I_LN1B, I_LN2G, I_LN2B, I_RGW, I_RGB, I_REW, I_REB, I_EWG, I_EWU, I_EWD };

__device__ __forceinline__ int xcd_chunk(int L, int U) { const int q = U >> 3, r = U & 7, x = L & 7, off = L >> 3; return (x < r ? x * (q + 1) : r * (q + 1) + (x - r) * q) + off; }
struct SchedInA {
    static constexpr bool GATHER = false;
    int G, c; const char* xn; const char* w;
    __device__ __forceinline__ bool next(int i, Unit& u) const {
        const int L = i * G + c; const size_t tstep = (size_t)256 * 1024 * 2;
        if (L < 1152) { int pm, pn; pg8::map_tile(L, 72, 16, pm, pn); u.pm = pm; u.pn = pn; u.aux = 0; u.a = xn + (size_t)pm * tstep; u.b = w + (size_t)pn * tstep; return true; }
        if (L < 1440) { const int q = xcd_chunk(L - 1152, 288), pm = 16 + (q & 3), pn = q >> 2;        u.pm = pm; u.pn = pn; u.aux = 1; u.a = w + (size_t)pm * tstep; u.b = xn + (size_t)pn * tstep; return true; }
        return false;
    }
};
struct SchedGrid {
    static constexpr bool GATHER = false;
    int G, c, nM, nN; const char* a0; const char* b0; size_t astep, bstep;
    __device__ __forceinline__ bool next(int i, Unit& u) const {
        const int L = i * G + c; if (L >= nM * nN) return false;
        int pm, pn; pg8::map_tile(L, nM, nN, pm, pn); u.pm = pm; u.pn = pn; u.aux = 0; u.a = a0 + (size_t)pm * astep; u.b = b0 + (size_t)pn * bstep; return true;
    }
};
struct SchedFftLat {
    static constexpr bool GATHER = false;
    int G, c; const char* dft; const char* pf;
    __device__ __forceinline__ bool next(int i, Unit& u) const {
        const int L = i * G + c; if (L >= 128) return false;
        const int b = L >> 4, kt = (L >> 1) & 7, pn = L & 1;
        u.pm = b * 8 + kt; u.pn = pn; u.aux = 0; u.a = dft + (size_t)kt * (256 * 4096 * 2); u.b = pf + (size_t)b * (512 * 4096 * 2) + (size_t)pn * (256 * 4096 * 2); return true;
    }
};
struct SchedFftCtx {
    static constexpr bool GATHER = false;
    int G, c; const char* dft; const char* pf;
    __device__ __forceinline__ bool next(int i, Unit& u) const {
        const int L = i * G + (G - 1 - c); if (L >= 16) return false;
        const int b = L >> 1, pn = L & 1;
        u.pm = 64 + b; u.pn = pn; u.aux = 0; u.a = dft; u.b = pf + (size_t)b * (512 * 512 * 2) + (size_t)pn * (256 * 512 * 2); return true;
    }
};
struct SchedBranch {
    static constexpr bool GATHER = false;
    int G, c, nM; const char* br; const char* wbr;
    __device__ __forceinline__ bool next(int j, Unit& u) const {
        const int L = j * G + c; if (L >= nM * 16) return false;
        int pm, pn; pg8::map_tile(L, nM, 16, pm, pn);
        u.pm = pm; u.pn = pn; u.aux = 0; u.a = br + (size_t)(pn >> 2) * ((size_t)NTOK * 512 * 2) + (size_t)pm * (256 * 512 * 2); u.b = wbr + (size_t)pn * (256 * 512 * 2); return true;
    }
};
struct SchedMoe {
    static constexpr bool GATHER = false;
    int G, c; unsigned pre[17]; const char* a0; const char* w0; size_t astep, wstep_e, wstep_n;
    __device__ __forceinline__ void init(const unsigned* cnt  ) {
        unsigned s = 0;
#pragma unroll
        for (int e = 0; e < 16; ++e) { pre[e] = s; s += ((unsigned)__builtin_amdgcn_readfirstlane((int)__hip_atomic_load(cnt + 64 * e, __ATOMIC_RELAXED, __HIP_MEMORY_SCOPE_AGENT)) + 255u) >> 8; }
        pre[16] = s;
    }
    __device__ __forceinline__ bool next(int i, Unit& u) const {
        const int L = i * G + c; if (L >= (int)pre[16] * 4) return false;
        const int jt = L >> 2, pn = L & 3; int e = 0;
#pragma unroll
        for (int k = 1; k < 16; ++k) e += ((unsigned)jt >= pre[k]) ? 1 : 0;
        u.pm = jt; u.pn = pn; u.aux = e; u.a = a0 + (size_t)jt * astep; u.b = w0 + (size_t)e * wstep_e + (size_t)pn * wstep_n; return true;
    }
};

struct SchedMoeG {
    static constexpr bool GATHER = true;
    int G, c; const LAS unsigned* pre; const char* a0; const char* w0; size_t wstep_e, wstep_n; const int* list; const unsigned* cnt;
    __device__ __forceinline__ void init(const unsigned* cnt_  , LAS unsigned* pre_) { cnt = cnt_; pre = pre_;
        if (threadIdx.x < 16) pre_[17 + threadIdx.x] = __hip_atomic_load(cnt_ + 64 * threadIdx.x, __ATOMIC_RELAXED, __HIP_MEMORY_SCOPE_AGENT);
        __syncthreads();
        if (threadIdx.x == 0) { unsigned s = 0;
            for (int e = 0; e < 16; ++e) { pre_[e] = s; s += (pre_[17 + e] + 255u) >> 8; }
            pre_[16] = s; }
        __syncthreads();
    }
    __device__ __forceinline__ bool next(int i, Unit& u) const {
        const int L = i * G + c; if (L >= (int)pre[16] * 4) return false;
        const int jt = L >> 2, pn = L & 3; int e = 0; unsigned pe = 0;
#pragma unroll
        for (int k = 1; k < 16; ++k) { const unsigned pk = pre[k]; const bool ge = (unsigned)jt >= pk; e += ge ? 1 : 0; pe = ge ? pk : pe; }
        e = __builtin_amdgcn_readfirstlane(e); pe = (unsigned)__builtin_amdgcn_readfirstlane((int)pe);
        u.pm = jt; u.pn = pn; u.aux = e; u.ax2 = (jt - (int)pe) * 256; u.a = a0; u.b = w0 + (size_t)e * wstep_e + (size_t)pn * wstep_n; return true;
    }
    __device__ __forceinline__ unsigned arow(const Unit& u, int r) const {
        const unsigned n = pre[17 + u.aux]; const unsigned pos = (unsigned)(u.ax2 + r);
        const int tok = pos < n ? list[(size_t)u.aux * NTOK + pos] : 0; return (unsigned)tok * 2048u;
    }
};

struct EpiInA {
    static constexpr bool PERM = true;
    bf16 *pqkv, *pz, *pconf, *psgu, *pfft, *pfftc; const float* bias;
    __device__ __forceinline__ void operator()(const AccT& acc, const Unit& u, int wr, int wc, int fr, int fq) const {
        if (u.aux == 0) {
            const int row0 = u.pm * 256 + wr * 64 + fr, cb = wc * 32 + 8 * fq, bcol0 = u.pn * 256 + cb;
            f32x4 bv[2][2];
#pragma unroll
            for (int bj = 0; bj < 2; ++bj)
#pragma unroll
                for (int n = 0; n < 2; ++n) bv[bj][n] = *(const f32x4*)(bias + bcol0 + bj * 128 + 4 * n);
            if (u.pn < 8) {
                const bool isz = u.pn >= 6;
#pragma unroll
                for (int ai = 0; ai < 2; ++ai)
#pragma unroll
                    for (int m = 0; m < 4; ++m) { const int row = row0 + ai * 128 + m * 16;
                        bf16* rowp = isz ? (pz + (size_t)row * 512 + (u.pn - 6) * 256 + cb) : (pqkv + (size_t)row * 1536 + u.pn * 256 + cb);
#pragma unroll
                        for (int bj = 0; bj < 2; ++bj) { f32x4 v0 = acc[ai][bj][m][0] + bv[bj][0], v1 = acc[ai][bj][m][1] + bv[bj][1];
                            if (isz) {
#pragma unroll
                                for (int j = 0; j < 4; ++j) { v0[j] = siluf_(v0[j]); v1[j] = siluf_(v1[j]); } }
                            v4u w; w.x = pk2(v0[0], v0[1]); w.y = pk2(v0[2], v0[3]); w.z = pk2(v1[0], v1[1]); w.w = pk2(v1[2], v1[3]);
                            *(v4u*)(rowp + bj * 128) = w; } }
            } else if (u.pn < 12) {
#pragma unroll
                for (int ai = 0; ai < 2; ++ai)
#pragma unroll
                    for (int m = 0; m < 4; ++m) { const int row = row0 + ai * 128 + m * 16;
                        const f32x4 a0 = acc[ai][0][m][0] + bv[0][0], a1 = acc[ai][0][m][1] + bv[0][1], g0 = acc[ai][1][m][0] + bv[1][0], g1 = acc[ai][1][m][1] + bv[1][1];
                        float o[8];
#pragma unroll
                        for (int j = 0; j < 4; ++j) { o[j] = a0[j] * sigmoidf_(g0[j]); o[4 + j] = a1[j] * sigmoidf_(g1[j]); }
                        *(v4u*)(pconf + (size_t)row * 512 + (u.pn - 8) * 128 + cb) = pack8(o); }
            } else {
#pragma unroll
                for (int ai = 0; ai < 2; ++ai)
#pragma unroll
                    for (int m = 0; m < 4; ++m) { const int row = row0 + ai * 128 + m * 16;
                        bf16* rowp = psgu + (size_t)row * 1024 + (u.pn - 12) * 256 + cb;
#pragma unroll
                        for (int bj = 0; bj < 2; ++bj) { f32x4 v0 = acc[ai][bj][m][0] + bv[bj][0], v1 = acc[ai][bj][m][1] + bv[bj][1];
#pragma unroll
                            for (int j = 0; j < 4; ++j) { v0[j] = gelu_tanh(v0[j]); v1[j] = gelu_tanh(v1[j]); }
                            v4u w; w.x = pk2(v0[0], v0[1]); w.y = pk2(v0[2], v0[3]); w.z = pk2(v1[0], v1[1]); w.w = pk2(v1[2], v1[3]);
                            *(v4u*)(rowp + bj * 128) = w; } }
            }
        } else {
            const int jrow0 = (u.pm - 16) * 256 + wr * 64 + fr, tok0 = u.pn * 256 + wc * 32 + 8 * fq;
#pragma unroll
            for (int ai = 0; ai < 2; ++ai)
#pragma unroll
                for (int m = 0; m < 4; ++m) { const int jrow = jrow0 + ai * 128 + m * 16; const float bb = bias[4096 + jrow]; const int cs = jrow >> 9, rr = jrow & 511;
#pragma unroll
                    for (int bj = 0; bj < 2; ++bj) { const int tok = tok0 + bj * 128; bf16* dst;
                        if (tok < NLAT) { const int b = tok >> 11, t = tok & 2047; dst = pfft + ((size_t)(b * 512 + rr)) * 4096 + cs * 2048 + t; }
                        else { const int tc = tok - NLAT, b = tc >> 8, t = tc & 255; dst = pfftc + ((size_t)(b * 512 + rr)) * 512 + cs * 256 + t; }
                        const f32x4 v0 = acc[ai][bj][m][0] + bb, v1 = acc[ai][bj][m][1] + bb;
                        v4u w; w.x = pk2(v0[0], v0[1]); w.y = pk2(v0[2], v0[3]); w.z = pk2(v1[0], v1[1]); w.w = pk2(v1[2], v1[3]);
                        *(v4u*)dst = w; } }
        }
    }
};
template <int ACT  > struct EpiBf16 {
    static constexpr bool PERM = true;
    bf16* O; int ldc; const float* bias;
    __device__ __forceinline__ void operator()(const AccT& acc, const Unit& u, int wr, int wc, int fr, int fq) const {
        const int row0 = u.pm * 256 + wr * 64 + fr, col0 = u.pn * 256 + wc * 32 + 8 * fq;
        f32x4 bv[2][2];
#pragma unroll
        for (int bj = 0; bj < 2; ++bj)
#pragma unroll
            for (int n = 0; n < 2; ++n) bv[bj][n] = bias ? *(const f32x4*)(bias + col0 + bj * 128 + 4 * n) : (f32x4){0.f, 0.f, 0.f, 0.f};
#pragma unroll
        for (int ai = 0; ai < 2; ++ai)
#pragma unroll
            for (int m = 0; m < 4; ++m) { bf16* rowp = O + (size_t)(row0 + ai * 128 + m * 16) * ldc + col0;
#pragma unroll
                for (int bj = 0; bj < 2; ++bj) { f32x4 v0 = acc[ai][bj][m][0] + bv[bj][0], v1 = acc[ai][bj][m][1] + bv[bj][1];
                    if (ACT == 1) {
#pragma unroll
                        for (int j = 0; j < 4; ++j) { v0[j] = sigmoidf_(v0[j]); v1[j] = sigmoidf_(v1[j]); } }
                    v4u w; w.x = pk2(v0[0], v0[1]); w.y = pk2(v0[2], v0[3]); w.z = pk2(v1[0], v1[1]); w.w = pk2(v1[2], v1[3]);
                    *(v4u*)(rowp + bj * 128) = w; } }
    }
};
struct EpiF32 {
    static constexpr bool PERM = false;
    float* C; int ldc; const float* bias;
    __device__ __forceinline__ void operator()(const AccT& acc, const Unit& u, int wr, int wc, int fr, int fq) const {
        const int row0 = u.pm * 256 + wr * 64 + fr, col0 = u.pn * 256 + wc * 32 + 4 * fq;
        f32x4 bv[2][2];
#pragma unroll
        for (int bj = 0; bj < 2; ++bj)
#pragma unroll
            for (int n = 0; n < 2; ++n) bv[bj][n] = *(const f32x4*)(bias + col0 + bj * 128 + n * 16);
#pragma unroll
        for (int ai = 0; ai < 2; ++ai)
#pragma unroll
            for (int m = 0; m < 4; ++m) { float* rowp = C + (size_t)(row0 + ai * 128 + m * 16) * ldc + col0;
#pragma unroll
                for (int bj = 0; bj < 2; ++bj)
#pragma unroll
                    for (int n = 0; n < 2; ++n) *(f32x4*)(rowp + bj * 128 + n * 16) = acc[ai][bj][m][n] + bv[bj][n]; }
    }
};
struct EpiGateMerge {
    static constexpr bool PERM = true;
    const bf16* P; bf16* mbf; const float* bias;
    __device__ __forceinline__ void operator()(const AccT& acc, const Unit& u, int wr, int wc, int fr, int fq) const {
        const int row0 = u.pm * 256 + wr * 64 + fr, cb = wc * 32 + 8 * fq, d0 = u.pn * 64 + wc * 16 + 4 * fq;
        f32x4 bv[2][2];
#pragma unroll
        for (int bj = 0; bj < 2; ++bj)
#pragma unroll
            for (int n = 0; n < 2; ++n) bv[bj][n] = *(const f32x4*)(bias + u.pn * 256 + cb + bj * 128 + 4 * n);
#pragma unroll
        for (int ai = 0; ai < 2; ++ai)
#pragma unroll
            for (int m = 0; m < 4; ++m) { const size_t row = (size_t)(row0 + ai * 128 + m * 16); const bf16* pr = P + row * 4096 + d0;
                f32x4 o = (f32x4){0.f, 0.f, 0.f, 0.f};
#pragma unroll
                for (int bj = 0; bj < 2; ++bj)
#pragma unroll
                    for (int n = 0; n < 2; ++n) { const v2u pw = *(const v2u*)(pr + (2 * bj + n) * 1024); const f32x4 g = acc[ai][bj][m][n] + bv[bj][n];
                        o[0] += sigmoidf_(g[0]) * bflo(pw.x); o[1] += sigmoidf_(g[1]) * bfhi(pw.x); o[2] += sigmoidf_(g[2]) * bflo(pw.y); o[3] += sigmoidf_(g[3]) * bfhi(pw.y); }
                v2u w; w.x = pk2(o[0], o[1]); w.y = pk2(o[2], o[3]); *(v2u*)(mbf + row * 1024 + d0) = w; }
    }
};
struct EpiMoe1 {
    static constexpr bool PERM = true;
    bf16* hid;
    __device__ __forceinline__ void operator()(const AccT& acc, const Unit& u, int wr, int wc, int fr, int fq) const {
        const int row0 = u.pm * 256 + wr * 64 + fr, cb = wc * 32 + 8 * fq;
#pragma unroll
        for (int ai = 0; ai < 2; ++ai)
#pragma unroll
            for (int m = 0; m < 4; ++m) { const int row = row0 + ai * 128 + m * 16;
                const f32x4 g0 = acc[ai][0][m][0], g1 = acc[ai][0][m][1], u0 = acc[ai][1][m][0], u1 = acc[ai][1][m][1];
                float o[8];
#pragma unroll
                for (int j = 0; j < 4; ++j) { o[j] = siluf_(g0[j]) * u0[j]; o[4 + j] = siluf_(g1[j]) * u1[j]; }
                *(v4u*)(hid + (size_t)row * 512 + u.pn * 128 + cb) = pack8(o); }
    }
};

struct Ctx {
    LAS unsigned char* lds; int tid, lane, wave, G, bid;
};

__device__ __forceinline__ int gate_srccol(int r) { const int q = r - 5120, t = q >> 8, c = q & 255, bj = c >> 7, wc = (c >> 5) & 3, fq = (c >> 3) & 3, n = (c >> 2) & 1, j = c & 3;
    return OFF_GATE + (2 * bj + n) * 1024 + 64 * t + 16 * wc + 4 * fq + j; }
__device__ __forceinline__ void cvt_tile(const Ctx& X, const float* src, int ld, int k0, bf16* dst, int Kp) {
    LAS float* tile = (LAS float*)X.lds;
#pragma unroll
    for (int i = 0; i < 8; ++i) { const int kk = (X.tid >> 6) + 8 * i, nn = X.tid & 63; tile[kk * 65 + nn] = src[(size_t)(k0 + kk) * ld + nn]; }
    __syncthreads();
    { const int n = X.tid >> 3, kc = X.tid & 7; float o[8];
#pragma unroll
      for (int j = 0; j < 8; ++j) o[j] = tile[(8 * kc + j) * 65 + n];
      *(v4u*)(dst + (size_t)n * Kp + k0 + 8 * kc) = pack8(o); }
    __syncthreads();
}

__device__ __forceinline__ void cvt_item(const float* src, int ld, int srccol, int k0, bf16* dst, int Kp, LAS float* scr, int lane) {
    float tv[32];
#pragma unroll
    for (int i = 0; i < 32; ++i) { const int kk = 2 * i + (lane >> 5); tv[i] = src[(size_t)(k0 + kk) * ld + srccol]; }
#pragma unroll
    for (int i = 0; i < 32; ++i) { const int kk = 2 * i + (lane >> 5); scr[kk * 33 + (lane & 31)] = tv[i]; }
    LDS_WAIT(); asm volatile("" ::: "memory");
    const int c = lane & 7;
#pragma unroll
    for (int j = 0; j < 4; ++j) { const int n = (lane >> 3) + 8 * j; const LAS float* sp = scr + (8 * c) * 33 + n; float o[8];
#pragma unroll
        for (int e = 0; e < 8; ++e) o[e] = sp[e * 33];
        *(v4u*)(dst + (size_t)n * Kp + k0 + 8 * c) = pack8(o); }
    LDS_WAIT(); asm volatile("" ::: "memory");
}

__device__ __forceinline__ void cvt_item4(const float* src, int ld, int col4, int k0, bf16* dst, int Kp, LAS float* scr, int lane) {
    f32x4 v[8]; const int kq = lane >> 3, n4 = 4 * (lane & 7);
#pragma unroll
    for (int i = 0; i < 8; ++i) v[i] = *(const f32x4*)(src + (size_t)(k0 + kq + 8 * i) * ld + col4);
#pragma unroll
    for (int i = 0; i < 8; ++i) { LAS float* p = scr + (kq + 8 * i) * 33 + n4; p[0] = v[i][0]; p[1] = v[i][1]; p[2] = v[i][2]; p[3] = v[i][3]; }
    LDS_WAIT(); asm volatile("" ::: "memory");
    const int c = lane & 7;
#pragma unroll
    for (int j = 0; j < 4; ++j) { const int n = (lane >> 3) + 8 * j; const LAS float* sp = scr + (8 * c) * 33 + n; float o[8];
#pragma unroll
        for (int e = 0; e < 8; ++e) o[e] = sp[e * 33];
        *(v4u*)(dst + (size_t)n * Kp + k0 + 8 * c) = pack8(o); }
    LDS_WAIT(); asm volatile("" ::: "memory");
}

__device__ __forceinline__ void ln_rows(f32x4 (&v)[4]) {
    float s = 0.f;
#pragma unroll
    for (int j = 0; j < 4; ++j) s += (v[j][0] + v[j][1]) + (v[j][2] + v[j][3]);
    const float mean = wave_sum(s) * (1.f / D); float s2 = 0.f;
#pragma unroll
    for (int j = 0; j < 4; ++j) { v[j] = v[j] - mean; s2 += (v[j][0] * v[j][0] + v[j][1] * v[j][1]) + (v[j][2] * v[j][2] + v[j][3] * v[j][3]); }
    const float rstd = __builtin_amdgcn_rsqf(wave_sum(s2) * (1.f / D) + LN_EPS);
#pragma unroll
    for (int j = 0; j < 4; ++j) v[j] = v[j] * rstd;
}

#define PH_BEGIN() \
    int tid_l = threadIdx.x; asm volatile("" : "+v"(tid_l)); const int tid = tid_l, lane = tid & 63; \
    Ctx X; X.lds = lds; X.tid = tid; X.lane = lane; X.wave = __builtin_amdgcn_readfirstlane(tid >> 6); X.G = gridDim.x; X.bid = blockIdx.x; \
    const int gw = X.bid * NWAVES + X.wave, NGW = X.G * NWAVES; (void)gw; (void)NGW; \
    const __attribute__((address_space(4))) char* kp = (const __attribute__((address_space(4))) char*)__builtin_amdgcn_kernarg_segment_ptr(); asm volatile("" : "+s"(kp)); \
    unsigned char* const ws = *(unsigned char* const __attribute__((address_space(4)))*)(kp + 280); \
    float* const hlat = *(float* const __attribute__((address_space(4)))*)(kp + 272); (void)hlat; \
    float* const hctx = (float*)(ws + WS_HCTX); (void)hctx; \
    float* const modv = (float*)(ws + WS_MODV); (void)modv; \
    float* const binv = (float*)(ws + WS_BIN); (void)binv; \
    bf16* const XN = (bf16*)(ws + WS_XN); (void)XN; \
    bf16* const WIN = (bf16*)(ws + WS_WIN); (void)WIN; \
    bf16* const WBR = (bf16*)(ws + WS_WBR); (void)WBR; \
    bf16* const WOUT = (bf16*)(ws + WS_WOUT); (void)WOUT; \
    bf16* const F1A = (bf16*)(ws + WS_F1A); (void)F1A; bf16* const F1B = (bf16*)(ws + WS_F1B); (void)F1B; \
    bf16* const DFTC = (bf16*)(ws + WS_DFTC); (void)DFTC; \
    bf16* const PQKV = (bf16*)(ws + WS_PQKV); (void)PQKV; \
    bf16* const PCONF = (bf16*)(ws + WS_PCONF); (void)PCONF; \
    bf16* const PZ = (bf16*)(ws + WS_PZ); (void)PZ; \
    bf16* const PSGU = (bf16*)(ws + WS_PSGU); (void)PSGU; \
    bf16* const PFFT = (bf16*)(ws + WS_PFFT); (void)PFFT; \
    bf16* const PFFTC = (bf16*)(ws + WS_PFFTC); (void)PFFTC; \
    float* const AB = (float*)(ws + WS_AB); (void)AB; \
    bf16* const OF = (bf16*)(ws + WS_OF); (void)OF; \
    bf16* const OB = (bf16*)(ws + WS_OB); (void)OB; \
    bf16* const WIT = (bf16*)(ws + WS_WIT); (void)WIT; \
    bf16* const UIT = (bf16*)(ws + WS_UIT); (void)UIT; \
    bf16* const AIT = (bf16*)(ws + WS_AIT); (void)AIT; \
    bf16* const KIT = (bf16*)(ws + WS_KIT); (void)KIT; \
    float* const SIT = (float*)(ws + WS_SIT); (void)SIT; \
    bf16* const GT = (bf16*)(ws + WS_G); (void)GT; \
    bf16* const WGU = (bf16*)(ws + WS_WGU); (void)WGU; \
    bf16* const WDN = (bf16*)(ws + WS_WDN); (void)WDN; \
    bf16* const XG = (bf16*)(ws + WS_XG); (void)XG; \
    bf16* const QKV = (bf16*)(ws + WS_QKV); (void)QKV; \
    float* const GB = (float*)(ws + WS_GB); (void)GB; \
    bf16* const BR = (bf16*)(ws + WS_BR); (void)BR; \
    float* const MERGED = (float*)(ws + WS_MERGED); (void)MERGED; \
    float* const YB = (float*)(ws + WS_Y); (void)YB; \
    bf16* const HID = (bf16*)(ws + WS_HID); (void)HID; \
    bf16* const MO = (bf16*)(ws + WS_MO); (void)MO; \
    float* const ROUTE = (float*)(ws + WS_ROUTE); (void)ROUTE; int* const ELIST = (int*)(ws + WS_LIST); (void)ELIST; \
    unsigned* const ctl = (unsigned*)(ws + WS_CTL); (void)ctl;
#define INP(i) (*(const float* const __attribute__((address_space(4)))*)(kp + 8 * (i)))
__global__ void __launch_bounds__(NWAVES * 64, 2) fwd(Args args) {
    extern __shared__ __attribute__((aligned(16))) unsigned char lds_raw[];
    LAS unsigned char* const lds = (LAS unsigned char*)lds_raw;
    volatile LAS unsigned* MISC = (volatile LAS unsigned*)(lds + MISC_OFF);
    for (int u = threadIdx.x; u < (LDS_BYTES - LDSCTL_OFF) / 4; u += NWAVES * 64) ((LAS unsigned*)(lds + LDSCTL_OFF))[u] = 0u;
    __syncthreads();
#if MK_ONE_LAUNCH
    XcdBarrier bar = xcd_barrier_post((unsigned*)(args.ws + WS_CTL) + CW_BAR, MISC + 8);
#define GRID_BAR() xcd_barrier(bar)
#else
#define GRID_BAR() do { } while (0)
#endif
    const int lo = args.ph_lo, hi = args.ph_hi;
#define IN(k) (lo <= (k) && (k) < hi)
#define CW_TS 20000
#if TPROBE
#define STAMP(k) do { if (blockIdx.x == 0 && threadIdx.x == 0) __hip_atomic_store((unsigned*)(args.ws + WS_CTL) + CW_TS + (k), (unsigned)__builtin_amdgcn_s_memrealtime(), __ATOMIC_RELAXED, __HIP_MEMORY_SCOPE_AGENT); } while (0)
#else
#define STAMP(k) do { } while (0)
#endif
#define SEAM(k) do { if (IN(k) && IN((k) + 1)) GRID_BAR(); STAMP((k) + 1); } while (0)
    STAMP(0);

    for (int rep0_ = 0; rep0_ <= (int)PH_REP(0); ++rep0_) { if (rep0_) GRID_BAR();
    if (PH_ON(0) && IN(0)) { PH_BEGIN();
        for (int idx = X.bid * 512 + tid; idx < 256 * 512 / 8; idx += X.G * 512) {
            const int k = idx >> 6, j0 = (idx & 63) * 8; float o[8];
#pragma unroll
            for (int e = 0; e < 8; ++e) { const int j = j0 + e, t = j & 255, a = (k * t) & 255; float s, c; fsincospi((float)a * (1.0f / 128.0f), &s, &c);
                o[e] = (j < 256 ? c : -s) * 0.0625f; }
            *(v4u*)(DFTC + (size_t)k * 512 + j0) = pack8(o);
        }
        {
            LAS float* sc = (LAS float*)lds;
            LAS float* red = (LAS float*)(lds + 36864);
            { float cv[18];
#pragma unroll
              for (int j = 0; j < 18; ++j) { const int r = j >> 1, k = tid + 512 * (j & 1); cv[j] = r < 8 ? INP(I_C)[r * 1024 + k] : INP(I_CCTX)[k]; }
#pragma unroll
              for (int j = 0; j < 18; ++j) sc[tid + 512 * j] = siluf_(cv[j]); }
            __syncthreads();
            for (int it = X.bid; it < 192; it += X.G) {
                const int l = it / 96, j = (it % 96) * 64 + lane; const float* W = INP(I_WMOD) + (size_t)l * 1024 * 6144 + j;
                float a[9];
#pragma unroll
                for (int r = 0; r < 9; ++r) a[r] = 0.f;
                const int kb = X.wave * 128;
                float wv[2][32];
#pragma unroll
                for (int i = 0; i < 32; ++i) wv[0][i] = W[(size_t)(kb + i) * 6144];
#pragma unroll
                for (int b = 0; b < 4; ++b) {
                    if (b < 3) {
#pragma unroll
                        for (int i = 0; i < 32; ++i) wv[(b + 1) & 1][i] = W[(size_t)(kb + 32 * (b + 1) + i) * 6144]; }
#pragma unroll
                    for (int i = 0; i < 32; i += 4) {
#pragma unroll
                        for (int r = 0; r < 9; ++r) { const f32x4 sv = *(const LAS f32x4*)(sc + r * 1024 + kb + 32 * b + i);
                            a[r] += (sv[0] * wv[b & 1][i] + sv[1] * wv[b & 1][i + 1]) + (sv[2] * wv[b & 1][i + 2] + sv[3] * wv[b & 1][i + 3]); } }
                }
#pragma unroll
                for (int r = 0; r < 9; ++r) red[(X.wave * 9 + r) * 64 + lane] = a[r];
                __syncthreads();
                for (int o = tid; o < 9 * 64; o += 512) { const int r = o >> 6, jj = o & 63; float s = 0.f;
#pragma unroll
                    for (int w = 0; w < 8; ++w) s += red[(w * 9 + r) * 64 + jj];
                    const int jc = (it % 96) * 64 + jj; modv[((size_t)l * 9 + r) * 6144 + jc] = s + INP(I_BMOD)[l * 6144 + jc]; }
                __syncthreads();
            }
        }
    } }
    SEAM(0);

    for (int l = 0; l < 2; ++l) {
        const int pb = 1 + NPH_LAYER * l;
        const int nrows2 = (l == 1) ? NLAT : NTOK;
        const int npan2 = nrows2 / 256;

        for (int rep_ = 0; rep_ <= (int)PH_REP(1); ++rep_) { if (rep_) GRID_BAR();
        if (PH_ON(1) && IN(pb + 0)) { PH_BEGIN(); const float* mv = modv + (size_t)l * 9 * 6144; (void)mv; unsigned* const moecnt = ctl + CW_MOE + l * 16 * 64; (void)moecnt;
            const float* win = INP(I_WIN) + (size_t)l * 1024 * N_IN;
            const float* bin = INP(I_BIN) + (size_t)l * N_IN;
#define FOLD_LOAD(it_) do { const int kb_ = (it_) >> 2, g_ = (it_) & 3; _Pragma("unroll") for (int j = 0; j < 4; ++j) { const int i = tid + 512 * j, kk = i >> 7, c = i & 127; wpre[j] = win[(size_t)(kb_ * 16 + kk) * N_IN + OFF_FFT + g_ * 128 + c]; } } while (0)
            float wpre[4]; FOLD_LOAD(X.bid < 256 ? X.bid : 255);
            LAS float* const wscr = (LAS float*)(lds + X.wave * 8448);
            for (int it = gw; it < 4096 + 1024 + 512 + 144; it += NGW) {
                if (it >= 5632) { const int r = (it - 5632) * 64 + lane;
                    if (r < 4096 || r >= 5120) { float v;
                        if (r < 2048) v = bin[r];
                        else if (r < 3072) { const int q = r - 2048, j = q >> 8, w = q & 255; v = bin[OFF_CONF + (w >= 128 ? 512 : 0) + 128 * j + (w & 127)]; }
                        else if (r < 4096) v = bin[OFF_SGU + (r - 3072)];
                        else v = bin[gate_srccol(r)];
                        binv[r] = v; }
                    continue; }
                const float* src; int ld, col, k0, Kp; bf16* dst; const int n4 = lane & 31;
                if (it < 4096) { const int rb_ = (it & 3) + 4 * ((it >> 3) & 63), rb = rb_ < 128 ? rb_ : rb_ + 32, row0 = rb * 32;
                    if (row0 < 2048) col = row0 + n4;
                    else if (row0 < 3072) { const int q = row0 - 2048, j = q >> 8, w = q & 255; col = OFF_CONF + (w >= 128 ? 512 : 0) + 128 * j + (w & 127) + n4; }
                    else if (row0 < 4096) col = OFF_SGU + (row0 - 3072) + n4;
                    else col = gate_srccol(row0 + n4);
                    src = win; ld = N_IN; k0 = (((it >> 2) & 1) + 2 * (it >> 9)) * 64; dst = WIN + (size_t)row0 * 1024; Kp = 1024; }
                else if (it < 5120) { const int q = it - 4096, i = q >> 8, nb = (q & 3) + 4 * ((q >> 3) & 7);
                    src = INP(I_WBR) + ((size_t)(l * 4 + i) * 512) * 1024; ld = 1024; col = nb * 32 + n4; k0 = (((q >> 2) & 1) + 2 * ((q >> 6) & 3)) * 64; dst = WBR + ((size_t)i * 1024 + nb * 32) * 512; Kp = 512; }
                else { const int q = it - 5120, nb = (q & 3) + 4 * ((q >> 3) & 7);
                    src = INP(I_WOUT) + (size_t)l * 1024 * 1024; ld = 1024; col = nb * 32 + n4; k0 = (((q >> 2) & 1) + 2 * (q >> 6)) * 64; dst = WOUT + (size_t)nb * 32 * 1024; Kp = 1024; }
                cvt_item(src, ld, col, k0, dst, Kp, wscr, lane);
            }
            LAS float* wab = (LAS float*)lds;
            f32x4 wq[8]; bool wq_have = false;
#pragma unroll
            for (int j = 0; j < 8; ++j) wq[j] = (f32x4){0.f, 0.f, 0.f, 0.f};
#define WAB_LOAD() do { _Pragma("unroll") for (int j = 0; j < 8; ++j) wq[j] = *(const f32x4*)(win + (size_t)(tid + 512 * (j & 1)) * N_IN + OFF_A + 4 * (j >> 1)); } while (0)
            for (int it = X.bid; it < 256; it += X.G) {
                const int kb = it >> 2, g = it & 3; LAS float* Wt = (LAS float*)(lds + 69632); LAS f32x2* cst = (LAS f32x2*)(lds + 69632 + 10240); LAS float* bl = (LAS float*)(cst + 128);
                if (it != X.bid) FOLD_LOAD(it);
#pragma unroll
                for (int j = 0; j < 4; ++j) { const int i = tid + 512 * j, kk = i >> 7, c = i & 127; Wt[c * 20 + kk] = wpre[j]; }
                if (tid < 128) { float sn, cn; fsincospi((float)tid * (1.0f / 64.0f), &sn, &cn); cst[tid] = (f32x2){cn * 0.08838834764831845f, sn * 0.08838834764831845f}; }
                else if (tid < 256 && kb == 0) bl[tid - 128] = bin[OFF_FFT + g * 128 + (tid - 128)];
                __syncthreads();
                if (!wq_have) { WAB_LOAD(); wq_have = true; }
                const int m = tid & 127, ks = tid >> 7; f32x2 acc[4];
#pragma unroll
                for (int kk = 0; kk < 4; ++kk) acc[kk] = (f32x2){0.f, 0.f};
                { int a = 0;
#pragma unroll 8
                for (int c = 0; c < 128; ++c) { const f32x2 t = cst[a]; const f32x4 w = *(const LAS f32x4*)(Wt + c * 20 + ks * 4);
#pragma unroll
                    for (int kk = 0; kk < 4; ++kk) acc[kk] += t * w[kk];
                    a = (a + m) & 127; } }
                bf16* dc = WIN + (size_t)(4096 + g * 128 + m) * 1024 + kb * 16 + ks * 4; bf16* dsn = dc + (size_t)512 * 1024;
                { v2u o; o.x = pk2(acc[0][0], acc[1][0]); o.y = pk2(acc[2][0], acc[3][0]); *(v2u*)dc = o; o.x = pk2(acc[0][1], acc[1][1]); o.y = pk2(acc[2][1], acc[3][1]); *(v2u*)dsn = o; }
                if (kb == 0 && tid < 256) {
                    const int cs = tid >> 7; float sb = 0.f; int a = 0;
#pragma unroll 8
                    for (int c = 0; c < 128; ++c) { const f32x2 t = cst[a]; sb += bl[c] * (cs ? t[1] : t[0]); a = (a + m) & 127; }
                    binv[4096 + cs * 512 + g * 128 + m] = sb; }
                if (it + X.G < 256) __syncthreads();
            }
            if (!wq_have) { __syncthreads(); WAB_LOAD(); }
#pragma unroll
            for (int j = 0; j < 8; ++j) { LAS float* p = wab + (4 * (j >> 1)) * 1024 + tid + 512 * (j & 1); p[0] = wq[j][0]; p[1024] = wq[j][1]; p[2048] = wq[j][2]; p[3072] = wq[j][3]; }
            __syncthreads();
#undef FOLD_LOAD
#undef WAB_LOAD
            f32x4 pe[4]; int pe_t = -1;
#pragma unroll
            for (int j = 0; j < 4; ++j) pe[j] = (f32x4){0.f, 0.f, 0.f, 0.f};
            for (int rowb = gw; rowb < NTOK; rowb += 2 * NGW) {
                f32x4 va[4], vb2[4];
                { const int row_ = rowb + 0, row = row_ < NTOK ? row_ : NTOK - 1; const bool LIVE_ = row_ < NTOK;
                float* hrow = row < NLAT ? hlat + (size_t)row * D : hctx + (size_t)(row - NLAT) * D;
                const int mi = row < NLAT ? (row >> 11) : 8; const float* shift = mv + mi * 6144, *scale = shift + 1024;

                if (l == 0) {
                    const float* src = row < NLAT ? INP(I_X) + (size_t)row * D : INP(I_CTX) + (size_t)(row - NLAT) * D;
#pragma unroll
                    for (int j = 0; j < 4; ++j) va[j] = *(const f32x4*)(src + 4 * lane + 256 * j);
                    if (row < NLAT) { const int t = row & 2047;
                        if (t != pe_t) { pe_t = t; const int prow = t >> 6, pcol = t & 63;
#pragma unroll 1
                            for (int j = 0; j < 4; ++j)
#pragma unroll
                                for (int e = 0; e < 4; ++e) { const int col = 4 * lane + 256 * j + e, part = col >> 9, within = col & 511, i = within & 255;
                                    const float omega = __builtin_amdgcn_exp2f((float)i * (-13.287712379549449f / 256.0f)); const float rev = (float)(part ? pcol : prow) * omega * 0.15915494309189535f;
                                    const float pv = (within >> 8) ? __builtin_amdgcn_cosf(rev) : __builtin_amdgcn_sinf(rev);
                                    if (j == 0) pe[0][e] = pv; else if (j == 1) pe[1][e] = pv; else if (j == 2) pe[2][e] = pv; else pe[3][e] = pv; } }
#pragma unroll
                        for (int j = 0; j < 4; ++j) va[j] += pe[j]; }
#pragma unroll
                    for (int j = 0; j < 4; ++j) if (LIVE_) *(f32x4*)(hrow + 4 * lane + 256 * j) = va[j];
                } else {
#pragma unroll
                    for (int j = 0; j < 4; ++j) va[j] = *(const f32x4*)(hrow + 4 * lane + 256 * j);
                }
                f32x4 scv[4], shv[4];
#pragma unroll
                for (int j = 0; j < 4; ++j) { scv[j] = *(const f32x4*)(scale + 4 * lane + 256 * j); shv[j] = *(const f32x4*)(shift + 4 * lane + 256 * j); }
                ln_rows(va);
#pragma unroll
                for (int j = 0; j < 4; ++j) { const f32x4 sc = scv[j], sh = shv[j]; va[j] = va[j] * (sc + 1.0f) + sh;
                    v2u w; w.x = pk2(va[j][0], va[j][1]); w.y = pk2(va[j][2], va[j][3]); if (LIVE_) *(v2u*)(XN + (size_t)row * D + 4 * lane + 256 * j) = w; }
                }
                { const int row_ = rowb + NGW, row = row_ < NTOK ? row_ : NTOK - 1; const bool LIVE_ = row_ < NTOK;
                float* hrow = row < NLAT ? hlat + (size_t)row * D : hctx + (size_t)(row - NLAT) * D;
                const int mi = row < NLAT ? (row >> 11) : 8; const float* shift = mv + mi * 6144, *scale = shift + 1024;

                if (l == 0) {
                    const float* src = row < NLAT ? INP(I_X) + (size_t)row * D : INP(I_CTX) + (size_t)(row - NLAT) * D;
#pragma unroll
                    for (int j = 0; j < 4; ++j) vb2[j] = *(const f32x4*)(src + 4 * lane + 256 * j);
                    if (row < NLAT) { const int t = row & 2047;
                        if (t != pe_t) { pe_t = t; const int prow = t >> 6, pcol = t & 63;
#pragma unroll 1
                            for (int j = 0; j < 4; ++j)
#pragma unroll
                                for (int e = 0; e < 4; ++e) { const int col = 4 * lane + 256 * j + e, part = col >> 9, within = col & 511, i = within & 255;
                                    const float omega = __builtin_amdgcn_exp2f((float)i * (-13.287712379549449f / 256.0f)); const float rev = (float)(part ? pcol : prow) * omega * 0.15915494309189535f;
                                    const float pv = (within >> 8) ? __builtin_amdgcn_cosf(rev) : __builtin_amdgcn_sinf(rev);
                                    if (j == 0) pe[0][e] = pv; else if (j == 1) pe[1][e] = pv; else if (j == 2) pe[2][e] = pv; else pe[3][e] = pv; } }
#pragma unroll
                        for (int j = 0; j < 4; ++j) vb2[j] += pe[j]; }
#pragma unroll
                    for (int j = 0; j < 4; ++j) if (LIVE_) *(f32x4*)(hrow + 4 * lane + 256 * j) = vb2[j];
                } else {
#pragma unroll
                    for (int j = 0; j < 4; ++j) vb2[j] = *(const f32x4*)(hrow + 4 * lane + 256 * j);
                }
                f32x4 scv[4], shv[4];
#pragma unroll
                for (int j = 0; j < 4; ++j) { scv[j] = *(const f32x4*)(scale + 4 * lane + 256 * j); shv[j] = *(const f32x4*)(shift + 4 * lane + 256 * j); }
                ln_rows(vb2);
#pragma unroll
                for (int j = 0; j < 4; ++j) { const f32x4 sc = scv[j], sh = shv[j]; vb2[j] = vb2[j] * (sc + 1.0f) + sh;
                    v2u w; w.x = pk2(vb2[j][0], vb2[j][1]); w.y = pk2(vb2[j][2], vb2[j][3]); if (LIVE_) *(v2u*)(XN + (size_t)row * D + 4 * lane + 256 * j) = w; }
                }
                float pa[16], pb_[16];
                { f32x2 vp[4][4];
#pragma unroll
                  for (int j = 0; j < 4; ++j)
#pragma unroll
                      for (int e = 0; e < 4; ++e) vp[j][e] = (f32x2){va[j][e], vb2[j][e]};
#pragma unroll
                  for (int o = 0; o < 16; ++o) { f32x2 sr = (f32x2){0.f, 0.f};
#pragma unroll
                    for (int j = 0; j < 4; ++j) { const f32x4 w = *(const LAS f32x4*)(wab + o * 1024 + 4 * lane + 256 * j);
#pragma unroll
                        for (int e = 0; e < 4; ++e) sr += vp[j][e] * w[e]; }
                    pa[o] = sr[0]; pb_[o] = sr[1]; if ((o & 3) == 3) asm volatile("" ::: "memory"); } }
                const float t0_ = reduce16(pa, lane), t1_ = reduce16(pb_, lane);
                if ((lane & 3) == 0) { AB[(size_t)rowb * 16 + (lane >> 2)] = t0_ + bin[OFF_A + (lane >> 2)]; if (rowb + NGW < NTOK) AB[(size_t)(rowb + NGW) * 16 + (lane >> 2)] = t1_ + bin[OFF_A + (lane >> 2)]; }
            }
        } }
        SEAM(pb + 0);

        for (int rep_ = 0; rep_ <= (int)PH_REP(2); ++rep_) { if (rep_) GRID_BAR();
        if (PH_ON(2) && IN(pb + 1)) { PH_BEGIN(); const float* mv = modv + (size_t)l * 9 * 6144; (void)mv; unsigned* const moecnt = ctl + CW_MOE + l * 16 * 64; (void)moecnt;
            SchedInA S{X.G, X.bid, (const char*)XN, (const char*)WIN};
            EpiInA E{PQKV, PZ, PCONF, PSGU, PFFT, PFFTC, binv};
            pg8::gemm_phase<EpiInA, SchedInA, true, true>(lds, Gemm{1024, 1024, 1024}, S, E);
        } }
        SEAM(pb + 1);

        for (int rep_ = 0; rep_ <= (int)PH_REP(3); ++rep_) { if (rep_) GRID_BAR();
        if (PH_ON(3) && IN(pb + 2)) { PH_BEGIN(); const float* mv = modv + (size_t)l * 9 * 6144; (void)mv; unsigned* const moecnt = ctl + CW_MOE + l * 16 * 64; (void)moecnt;
            {
                const int vb = X.bid, NB2 = X.G, gw2 = gw, NGW2 = NGW;
                if (l == 0) { SchedFftCtx S{NB2, vb, (const char*)DFTC, (const char*)PFFTC}; EpiBf16<0> E{BR + (size_t)2 * NTOK * 512, 512, nullptr};
                  pg8::gemm_phase<EpiBf16<0>, SchedFftCtx, true, true>(lds, Gemm{512, 512, 512}, S, E); }
                __syncthreads();
                {
                    typedef short v4i16_t __attribute__((ext_vector_type(4)));
                    LAS unsigned char* tl = lds + X.wave * 8192;
                    const int r16 = lane & 15, quad = lane >> 4;
                    bf16x8 m1[4][2];
#pragma unroll
                    for (int mt = 0; mt < 4; ++mt)
#pragma unroll
                        for (int ks = 0; ks < 2; ++ks) { float o[8]; const int k1 = 16 * (mt & 1) + r16, ri = mt >> 1;
#pragma unroll
                            for (int e = 0; e < 8; ++e) { const int t1 = 8 * quad + e; float sn, cs; fsincospi((float)((k1 * t1) & 31) * (1.0f / 16.0f), &sn, &cs);
                                o[e] = ri == 0 ? (ks == 0 ? cs : -sn) : (ks == 0 ? -sn : -cs); }
                            m1[mt][ks] = __builtin_bit_cast(bf16x8, pack8(o)); }
                    float twc[2][4][4], tws[2][4][4];
#pragma unroll
                    for (int ml = 0; ml < 2; ++ml)
#pragma unroll
                        for (int c = 0; c < 4; ++c)
#pragma unroll
                            for (int r = 0; r < 4; ++r) { const int k1 = 16 * ml + r16, t2 = 16 * c + 4 * quad + r; fsincospi((float)(k1 * t2) * (1.0f / 1024.0f), &tws[ml][c][r], &twc[ml][c][r]); }
                    const unsigned tbase = (unsigned)(size_t)tl;
                    for (int it = gw2; it < NB * 512; it += NGW2) {
                        const int b = it >> 9, col = it & 511;
                        const bf16* src = PFFT + (size_t)it * 4096;
                        v4u ld[8];
#pragma unroll
                        for (int i = 0; i < 8; ++i) ld[i] = *(const v4u*)(src + (i * 64 + lane) * 8);
#pragma unroll
                        for (int i = 0; i < 8; ++i) *(LAS v4u*)(tl + (i * 64 + lane) * 16) = ld[i];
                        LDS_WAIT();
                        bf16* dst = (b < 4 ? F1A + (size_t)(b * 512 + col) * 4096 : F1B + (size_t)((b - 4) * 512 + col) * 4096);
#pragma unroll
                        for (int c = 0; c < 4; ++c) {
                            bf16x8 af[2];
#pragma unroll
                            for (int ks = 0; ks < 2; ++ks) { v4i16_t h[2];
#pragma unroll
                                for (int t = 0; t < 2; ++t) h[t] = __builtin_amdgcn_ds_read_tr16_b64_v4i16((LAS v4i16_t*)(tl + ks * 4096 + (8 * quad + 4 * t + (r16 >> 2)) * 128 + (16 * c + 4 * (lane & 3)) * 2));
                                bf16x8 f; f[0] = h[0][0]; f[1] = h[0][1]; f[2] = h[0][2]; f[3] = h[0][3]; f[4] = h[1][0]; f[5] = h[1][1]; f[6] = h[1][2]; f[7] = h[1][3]; af[ks] = f; }
                            f32x4 acc[4];
#pragma unroll
                            for (int mt = 0; mt < 4; ++mt) { acc[mt] = (f32x4){0.f, 0.f, 0.f, 0.f};
#pragma unroll
                                for (int ks = 0; ks < 2; ++ks) acc[mt] = __builtin_amdgcn_mfma_f32_16x16x32_bf16(af[ks], m1[mt][ks], acc[mt], 0, 0, 0); }
#pragma unroll
                            for (int ml = 0; ml < 2; ++ml) { const int k1 = 16 * ml + r16; float pr[4], pi[4];
#pragma unroll
                                for (int r = 0; r < 4; ++r) { const float ar = acc[ml][r], ai = acc[ml + 2][r]; pr[r] = ar * twc[ml][c][r] + ai * tws[ml][c][r]; pi[r] = ai * twc[ml][c][r] - ar * tws[ml][c][r]; }
                                v2u w0, w1; w0.x = pk2(pr[0], pr[1]); w0.y = pk2(pr[2], pr[3]); w1.x = pk2(pi[0], pi[1]); w1.y = pk2(pi[2], pi[3]);
                                *(v2u*)(dst + k1 * 128 + 16 * c + 4 * quad) = w0; *(v2u*)(dst + k1 * 128 + 64 + 16 * c + 4 * quad) = w1; }
                        }
                        LDS_WAIT();
                    }
                    (void)tbase;
                    __syncthreads();
                }
                {
                    LAS float* cwl = (LAS float*)lds;
                    const float* cw = INP(I_GCONV) + (size_t)l * 5 * 1536;
                    { f32x4 t4[4];
#pragma unroll
                      for (int j = 0; j < 4; ++j) { const int i = tid + 512 * j; t4[j] = *(const f32x4*)(cw + 4 * (i < 1920 ? i : 0)); }
#pragma unroll
                      for (int j = 0; j < 4; ++j) { const int i = tid + 512 * j; if (i < 1920) *(LAS f32x4*)(cwl + 4 * i) = t4[j]; } }
                    __syncthreads();
                    const float gdt_l = INP(I_GDT)[l * 8 + (lane & 7)], nega_l = -__expf(INP(I_GALOG)[l * 8 + (lane & 7)]);
                    for (int row = gw2; row < NTOK; row += NGW2) {
                        int t, T; if (row < NLAT) { t = row & 2047; T = 2048; } else { t = (row - NLAT) & 255; T = 256; }
                        v4u xr[3][5];
#pragma unroll
                        for (int seg = 0; seg < 3; ++seg)
#pragma unroll
                            for (int j = 0; j < 5; ++j) { const int tt = t + j - 2; xr[seg][j] = (tt >= 0 && tt < T) ? *(const v4u*)(PQKV + (size_t)(row + j - 2) * 1536 + seg * 512 + 8 * lane) : (v4u){0u, 0u, 0u, 0u}; }
                        float av = 0.f, bv = 0.f; if (lane < 8) { av = AB[(size_t)row * 16 + lane]; bv = AB[(size_t)row * 16 + 8 + lane]; }
#pragma unroll
                        for (int seg = 0; seg < 3; ++seg) { const int ch = seg * 512 + 8 * lane; float a[8];
#pragma unroll
                            for (int e = 0; e < 8; ++e) a[e] = 0.f;
#pragma unroll
                            for (int j = 0; j < 5; ++j) { float xv[8]; unpack8(xr[seg][j], xv);
                                const f32x4 w0 = *(const LAS f32x4*)(cwl + j * 1536 + ch), w1 = *(const LAS f32x4*)(cwl + j * 1536 + ch + 4);
#pragma unroll
                                for (int e = 0; e < 4; ++e) { a[e] += w0[e] * xv[e]; a[4 + e] += w1[e] * xv[4 + e]; } }
                            float ss = 0.f;
#pragma unroll
                            for (int e = 0; e < 8; ++e) { a[e] = siluf_(a[e]); ss += a[e] * a[e]; }
                            if (seg < 2) { ss = g16_sum(ss); const float sc = __builtin_amdgcn_rsqf(ss + LN_EPS) * (seg == 0 ? 0.08838834764831845f : 1.0f);
#pragma unroll
                                for (int e = 0; e < 8; ++e) a[e] *= sc; }
                            *(v4u*)(QKV + (size_t)row * 1536 + ch) = pack8(a); }
                        if (lane < 8) { const float xs = av + gdt_l; const float sp = xs > 20.f ? xs : __logf(1.0f + __expf(xs));
                            GB[(size_t)row * 16 + lane] = nega_l * sp; GB[(size_t)row * 16 + 8 + lane] = __builtin_amdgcn_rcpf(1.0f + __expf(-bv)); }
                    }
                    __syncthreads();
                }
                {
                    LAS bf16* xs = (LAS bf16*)lds;
                    LAS float* wl = (LAS float*)(lds + 63488);
                    const float* dw = INP(I_CDWW) + (size_t)l * 31 * 512; const float* dwb = INP(I_CDWB) + l * 512, *lg = INP(I_CLNG) + l * 512, *lb = INP(I_CLNB) + l * 512;
                    bf16* B1 = BR + (size_t)1 * NTOK * 512;
                    { f32x4 t8[8];
#pragma unroll
                      for (int j = 0; j < 8; ++j) { const int i = tid + 512 * j; t8[j] = *(const f32x4*)(dw + 4 * (i < 3968 ? i : 0)); }
#pragma unroll
                      for (int j = 0; j < 8; ++j) { const int i = tid + 512 * j; if (i < 3968) *(LAS f32x4*)(wl + 4 * i) = t8[j]; } }
                    const int ch = 8 * lane, tq = X.wave;
                    f32x4 bia0 = *(const f32x4*)(dwb + ch), bia1 = *(const f32x4*)(dwb + ch + 4);
                    const f32x4 g0 = *(const f32x4*)(lg + ch), g1 = *(const f32x4*)(lg + ch + 4), b0 = *(const f32x4*)(lb + ch), b1 = *(const f32x4*)(lb + ch + 4);
                    for (int tile = vb; tile < nrows2 / 32; tile += NB2) {
                        const int t0 = tile * 32; int rbase, T; if (t0 < NLAT) { rbase = t0 & ~2047; T = 2048; } else { rbase = NLAT + ((t0 - NLAT) & ~255); T = 256; }
                        __syncthreads();
                        { v4u tl8[8];
#pragma unroll
                          for (int j = 0; j < 8; ++j) { const int i = tid + 512 * j, r = i >> 6, c = i & 63, srow = t0 - 15 + r; const bool ok = i < 62 * 64 && srow >= rbase && srow < rbase + T;
                              tl8[j] = *(const v4u*)(PCONF + (size_t)(ok ? srow : t0) * 512 + 8 * c); if (!ok) tl8[j] = (v4u){0u, 0u, 0u, 0u}; }
#pragma unroll
                          for (int j = 0; j < 8; ++j) { const int i = tid + 512 * j, r = i >> 6, c = i & 63; if (i < 62 * 64) *(LAS v4u*)(xs + r * 512 + 8 * c) = tl8[j]; } }
                        __syncthreads();
                        float acc[4][8];
#pragma unroll
                        for (int k = 0; k < 4; ++k)
#pragma unroll
                            for (int e = 0; e < 4; ++e) { acc[k][e] = bia0[e]; acc[k][4 + e] = bia1[e]; }
#pragma unroll 1
                        for (int j = 0; j < 31; ++j) {
                            const f32x4 w0 = *(const LAS f32x4*)(wl + j * 512 + ch), w1 = *(const LAS f32x4*)(wl + j * 512 + ch + 4);
#pragma unroll
                            for (int k = 0; k < 4; ++k) { float xv[8]; unpack8(*(const LAS v4u*)(xs + (tq * 4 + k + j) * 512 + ch), xv);
#pragma unroll
                                for (int e = 0; e < 4; ++e) { acc[k][e] += w0[e] * xv[e]; acc[k][4 + e] += w1[e] * xv[4 + e]; } }
                        }
#pragma unroll
                        for (int k = 0; k < 4; ++k) { float s1 = 0.f;
#pragma unroll
                            for (int e = 0; e < 8; ++e) s1 += acc[k][e];
                            const float mean = g16_sum(s1) * (1.0f / 128.0f); float s2 = 0.f;
#pragma unroll
                            for (int e = 0; e < 8; ++e) { acc[k][e] -= mean; s2 += acc[k][e] * acc[k][e]; }
                            const float rstd = __builtin_amdgcn_rsqf(g16_sum(s2) * (1.0f / 128.0f) + LN_EPS); float o[8];
#pragma unroll
                            for (int e = 0; e < 4; ++e) { o[e] = siluf_(acc[k][e] * rstd * g0[e] + b0[e]); o[4 + e] = siluf_(acc[k][4 + e] * rstd * g1[e] + b1[e]); }
                            *(v4u*)(B1 + (size_t)(t0 + tq * 4 + k) * 512 + ch) = pack8(o); }
                    }
                    __syncthreads();
                }
                {
                    LAS bf16* vnT = (LAS bf16*)lds;
                    const float* lg = INP(I_SLNG) + l * 512, *lb = INP(I_SLNB) + l * 512;
                    bf16* B3 = BR + (size_t)3 * NTOK * 512;
                    const int nitems = (nrows2 / 128) * 4, r16 = lane & 15, quad = lane >> 4, w = X.wave;
                    for (int it = (vb + NB2 - NB2 / 4) % NB2; it < nitems; it += NB2) {
                        const int chunk = it >> 2, g = it & 3, r0 = chunk * 128;
                        unsigned raw[16];
#pragma unroll
                        for (int i = 0; i < 16; ++i) raw[i] = *(const unsigned*)(PSGU + (size_t)(r0 + w * 16 + i) * 1024 + 512 + g * 128 + 2 * lane);
                        const int c = g * 128 + 2 * lane; const float lg0 = lg[c], lg1 = lg[c + 1], lb0 = lb[c], lb1 = lb[c + 1];
                        __syncthreads();
                        { float sv[16];
#pragma unroll
                          for (int i = 0; i < 16; ++i) sv[i] = bflo(raw[i]) + bfhi(raw[i]);
                          const float ts = reduce16(sv, lane) * (1.0f / 128.0f); float mean[16];
#pragma unroll
                          for (int i = 0; i < 16; ++i) { mean[i] = __shfl(ts, 4 * i); const float v0 = bflo(raw[i]) - mean[i], v1 = bfhi(raw[i]) - mean[i]; sv[i] = v0 * v0 + v1 * v1; }
                          const float tv = reduce16(sv, lane) * (1.0f / 128.0f);
#pragma unroll
                          for (int i = 0; i < 16; ++i) { const float rstd = __builtin_amdgcn_rsqf(__shfl(tv, 4 * i) + LN_EPS); const float v0 = bflo(raw[i]) - mean[i], v1 = bfhi(raw[i]) - mean[i];
                            vnT[(2 * lane) * 136 + w * 16 + i] = (bf16)f2bf(v0 * rstd * lg0 + lb0); vnT[(2 * lane + 1) * 136 + w * 16 + i] = (bf16)f2bf(v1 * rstd * lg1 + lb1); } }
                        bf16x8 wf[4];
                        { const float* wsrc = INP(I_SWS) + ((size_t)(l * 4 + g) * 128 + 16 * w + r16) * 128 + quad * 8;
#pragma unroll
                          for (int ks = 0; ks < 4; ++ks) { const f32x4 x0 = *(const f32x4*)(wsrc + 32 * ks), x1 = *(const f32x4*)(wsrc + 32 * ks + 4);
                              v4u pk; pk.x = pk2(x0[0], x0[1]); pk.y = pk2(x0[2], x0[3]); pk.z = pk2(x1[0], x1[1]); pk.w = pk2(x1[2], x1[3]); wf[ks] = __builtin_bit_cast(bf16x8, pk); } }
                        const float bs = INP(I_SBS)[(l * 4 + g) * 128 + 16 * w + r16];
                        __syncthreads();
                        const size_t prow = (size_t)(r0 + 16 * w + r16);
#pragma unroll
                        for (int nt = 0; nt < 8; ++nt) { f32x4 acc = (f32x4){0.f, 0.f, 0.f, 0.f};
#pragma unroll
                            for (int ks = 0; ks < 4; ++ks) { const bf16x8 vf = *(const LAS bf16x8*)(vnT + (16 * nt + r16) * 136 + 32 * ks + quad * 8); acc = __builtin_amdgcn_mfma_f32_16x16x32_bf16(vf, wf[ks], acc, 0, 0, 0); }
                            const v2u uw = *(const v2u*)(PSGU + prow * 1024 + g * 128 + 16 * nt + quad * 4);
                            v2u o; o.x = pk2(bflo(uw.x) * (acc[0] + bs), bfhi(uw.x) * (acc[1] + bs)); o.y = pk2(bflo(uw.y) * (acc[2] + bs), bfhi(uw.y) * (acc[3] + bs));
                            *(v2u*)(B3 + prow * 512 + g * 128 + 16 * nt + quad * 4) = o; }
                    }
                    __syncthreads();
                }
            }
        } }
        SEAM(pb + 2);

        for (int rep_ = 0; rep_ <= (int)PH_REP(4); ++rep_) { if (rep_) GRID_BAR();
        if (PH_ON(4) && IN(pb + 3)) { PH_BEGIN(); const float* mv = modv + (size_t)l * 9 * 6144; (void)mv; unsigned* const moecnt = ctl + CW_MOE + l * 16 * 64; (void)moecnt;
            {
                const int r16 = lane & 15, quad = lane >> 4;
                bf16x8 m2[4][4];
#pragma unroll
                for (int jt = 0; jt < 4; ++jt)
#pragma unroll
                    for (int ks = 0; ks < 4; ++ks) { float o[8]; const int k2 = 16 * jt + r16;
#pragma unroll
                        for (int e = 0; e < 8; ++e) { const int t2 = 32 * (ks & 1) + 8 * quad + e; float sn, cs; fsincospi((float)((k2 * t2) & 63) * (1.0f / 32.0f), &sn, &cs); o[e] = ((ks >> 1) ? sn : cs) * 0.022097086912079608f; }
                        m2[jt][ks] = __builtin_bit_cast(bf16x8, pack8(o)); }
                bf16* B2 = BR + (size_t)2 * NTOK * 512;
                const int nq5 = 9216 - 4 * NGW;
                const bool bal = nq5 > 0 && nq5 < NGW;
                for (int it = bal ? gw - nq5 : gw; it < 8192; it += bal ? NGW - nq5 : NGW) {
                    if (it < 0) break;
                    const int b = it >> 10, k1 = (it >> 5) & 31, ct = it & 31;
                    const bf16* f1 = (b < 4 ? F1A + (size_t)(b * 512 + 16 * ct + r16) * 4096 : F1B + (size_t)((b - 4) * 512 + 16 * ct + r16) * 4096) + k1 * 128 + 8 * quad;
                    bf16x8 af[4];
#pragma unroll
                    for (int ks = 0; ks < 4; ++ks) af[ks] = *(const bf16x8*)(f1 + 32 * ks);
#pragma unroll
                    for (int jt = 0; jt < 4; ++jt) { f32x4 acc = (f32x4){0.f, 0.f, 0.f, 0.f};
#pragma unroll
                        for (int ks = 0; ks < 4; ++ks) acc = __builtin_amdgcn_mfma_f32_16x16x32_bf16(af[ks], m2[jt][ks], acc, 0, 0, 0);
                        v2u w; w.x = pk2(acc[0], acc[1]); w.y = pk2(acc[2], acc[3]);
                        *(v2u*)(B2 + (size_t)(b * 2048 + k1 + 32 * (16 * jt + r16)) * 512 + 16 * ct + 4 * quad) = w; }
                }
            }
            for (int qi = gw; qi < 9216; qi += NGW) {
                int lane_l = lane; asm volatile("" : "+v"(lane_l));
                const int r16 = lane_l & 15, quad = lane_l >> 4;
                LAS float* const Mt = (LAS float*)(lds + X.wave * 16384);
                LAS float* const gcl = (LAS float*)(lds + 132096 + X.wave * 1024);
                const int item = qi >> 2, q = qi & 3, cidx = item % 36, chain = item / 36, dir = chain & 1, hh = (chain >> 1) & 3, b = chain >> 3;
                const int row0 = cidx < 4 ? NLAT + b * CTXL + cidx * 64 : b * SEQ + (cidx - 4) * 64;
                const int rb = row0 + (dir ? 63 : 0); const long sg = dir ? -1 : 1;
                const float ga = GB[(size_t)(rb + sg * lane_l) * 16 + dir * 4 + hh], be = GB[(size_t)(rb + sg * lane_l) * 16 + 8 + dir * 4 + hh];
                float gc = ga;
#pragma unroll
                for (int o = 1; o < 64; o <<= 1) { const float tu = __shfl_up(gc, o); gc += (lane_l >= o) ? tu : 0.f; }
                const float gl = __shfl(gc, 63);
                gcl[lane_l] = gc; gcl[64 + lane_l] = be;
                const float scl = q >= 2 ? be * __expf(gc) : be;
                bf16x8 Kf[4][4];
                { const bf16* kp = QKV + (size_t)(rb + sg * r16) * 1536 + 512 + hh * 128 + quad * 8; const long ms = sg * 16 * 1536;
#pragma unroll
                  for (int mi = 0; mi < 4; ++mi)
#pragma unroll
                      for (int ks = 0; ks < 4; ++ks) Kf[mi][ks] = *(const bf16x8*)(kp + mi * ms + ks * 32); }
                LDS_WAIT();
                if (q == 0) {
                    bf16x8 Qf[4][4];
                    { const bf16* qp = QKV + (size_t)(rb + sg * r16) * 1536 + hh * 128 + quad * 8; const long ms = sg * 16 * 1536;
#pragma unroll
                      for (int mi = 0; mi < 4; ++mi)
#pragma unroll
                          for (int ks = 0; ks < 4; ++ks) Qf[mi][ks] = *(const bf16x8*)(qp + mi * ms + ks * 32); }
                    bf16* ait = AIT + (size_t)item * 4096 + r16 * 64 + quad * 4;
#pragma unroll
                    for (int mi = 0; mi < 4; ++mi) { const float gci = gcl[16 * mi + r16];
#pragma unroll
                        for (int nj = 0; nj < 4; ++nj) {
                            v2u w; w.x = 0u; w.y = 0u;
                            if (nj <= mi) {
                                f32x4 c = (f32x4){0.f, 0.f, 0.f, 0.f};
#pragma unroll
                                for (int ks = 0; ks < 4; ++ks) c = __builtin_amdgcn_mfma_f32_16x16x32_bf16(Kf[nj][ks], Qf[mi][ks], c, 0, 0, 0);
                                const f32x4 gcj = *(const LAS f32x4*)(gcl + 16 * nj + quad * 4); float o4[4];
#pragma unroll
                                for (int r = 0; r < 4; ++r) { const bool incl = (nj < mi) || (quad * 4 + r <= r16); o4[r] = incl ? c[r] * __expf(gci - gcj[r]) : 0.f; }
                                w.x = pk2(o4[0], o4[1]); w.y = pk2(o4[2], o4[3]); }
                            *(v2u*)(ait + mi * 16 * 64 + 16 * nj) = w; }
                    }
                }
                if (q == 1) { SIT[(size_t)item * 192 + lane_l] = __expf(gc); SIT[(size_t)item * 192 + 64 + lane_l] = __expf(gl - gc); if (lane_l == 0) SIT[(size_t)item * 192 + 128] = __expf(gl); }
                asm volatile("" ::: "memory");
                { LAS float* mw = Mt + r16 * 64 + quad * 4;
#pragma unroll
                  for (int mi = 0; mi < 4; ++mi) {
                    const f32x4 gci = *(const LAS f32x4*)(gcl + 16 * mi + quad * 4), bei = *(const LAS f32x4*)(gcl + 64 + 16 * mi + quad * 4);
#pragma unroll
                    for (int nj = 0; nj <= mi; ++nj) {
                        f32x4 c = (f32x4){0.f, 0.f, 0.f, 0.f};
#pragma unroll
                        for (int ks = 0; ks < 4; ++ks) c = __builtin_amdgcn_mfma_f32_16x16x32_bf16(Kf[mi][ks], Kf[nj][ks], c, 0, 0, 0);
                        const float gcj = gcl[16 * nj + r16]; f32x4 mv4;
#pragma unroll
                        for (int r = 0; r < 4; ++r) { const bool strict = (nj < mi) || (r16 < quad * 4 + r); mv4[r] = strict ? -(bei[r] * c[r] * __expf(gci[r] - gcj)) : 0.f; }
                        *(LAS f32x4*)(mw + (16 * nj) * 64 + 16 * mi) = mv4;
                    }
                  } }
                asm volatile("" ::: "memory");
                LDS_WAIT();
                float Xs[64];
                { const bf16* src = QKV + (size_t)rb * 1536 + (q < 2 ? 1024 + 64 * q : 512 + 64 * (q - 2)) + hh * 128 + lane_l; const long sstep = sg * 1536;
                  bf16 raw[64];
#pragma unroll
                  for (int sidx = 0; sidx < 64; ++sidx) { raw[sidx] = *src; src += sstep; }
                  asm volatile("" ::: "memory");
#pragma unroll
                  for (int sidx = 0; sidx < 64; ++sidx) { const float sc = __builtin_bit_cast(float, __builtin_amdgcn_readlane(__builtin_bit_cast(int, scl), sidx)); Xs[sidx] = bf1(raw[sidx]) * sc; } }
#pragma unroll
                for (int g4 = 0; g4 < 16; ++g4) {
                    f32x4 acc = (f32x4){Xs[4 * g4], Xs[4 * g4 + 1], Xs[4 * g4 + 2], Xs[4 * g4 + 3]};
#pragma unroll
                    for (int c0 = 0; c0 < 4 * g4; c0 += 16) {
                        f32x4 mb[16];
#pragma unroll
                        for (int e = 0; e < 16; ++e) if (c0 + e < 4 * g4) mb[e] = *(const LAS f32x4*)(Mt + (c0 + e) * 64 + 4 * g4);
                        LDS_WAIT();
#pragma unroll
                        for (int e = 0; e < 16; ++e) if (c0 + e < 4 * g4) acc += mb[e] * Xs[c0 + e];
                    }
                    const f32x4 m0 = *(const LAS f32x4*)(Mt + (4 * g4) * 64 + 4 * g4), m1 = *(const LAS f32x4*)(Mt + (4 * g4 + 1) * 64 + 4 * g4), m2 = *(const LAS f32x4*)(Mt + (4 * g4 + 2) * 64 + 4 * g4);
                    LDS_WAIT();
                    const float x0 = acc[0], x1 = acc[1] + m0[1] * x0, x2 = acc[2] + m0[2] * x0 + m1[2] * x1, x3 = acc[3] + m0[3] * x0 + m1[3] * x1 + m2[3] * x2;
                    Xs[4 * g4] = x0; Xs[4 * g4 + 1] = x1; Xs[4 * g4 + 2] = x2; Xs[4 * g4 + 3] = x3;
                }
                if (q < 2) {
                    bf16* u0 = UIT + (size_t)item * 8192 + (size_t)(64 * q + lane_l) * 64;
#pragma unroll
                    for (int p = 0; p < 8; ++p) { float c0[8];
#pragma unroll
                        for (int e = 0; e < 8; ++e) c0[e] = Xs[8 * p + e];
                        *(v4u*)(u0 + 8 * p) = pack8(c0); }
                } else {
                    bf16* w0 = WIT + (size_t)item * 8192 + 64 * (q - 2) + lane_l;
#pragma unroll
                    for (int sidx = 0; sidx < 64; ++sidx) { w0[sidx * 128] = (bf16)f2bf(Xs[sidx]); if ((sidx & 15) == 15) asm volatile("" ::: "memory"); }
                    asm volatile("" ::: "memory");
                    if (dir == 0) {
                        const bf16* src = QKV + (size_t)row0 * 1536 + 512 + hh * 128 + 64 * (q - 2) + lane_l;
                        bf16* k0 = KIT + ((size_t)((b * 4 + hh) * 36 + cidx)) * 8192 + (size_t)(64 * (q - 2) + lane_l) * 64;
                        unsigned kw[64];
#pragma unroll
                        for (int e = 0; e < 64; ++e) kw[e] = src[(size_t)e * 1536];
                        asm volatile("" ::: "memory");
#pragma unroll
                        for (int p = 0; p < 8; ++p) { v4u lo; lo.x = kw[8 * p] | (kw[8 * p + 1] << 16); lo.y = kw[8 * p + 2] | (kw[8 * p + 3] << 16); lo.z = kw[8 * p + 4] | (kw[8 * p + 5] << 16); lo.w = kw[8 * p + 6] | (kw[8 * p + 7] << 16);
                            *(v4u*)(k0 + 8 * p) = lo; }
                    }
                }
                LDS_WAIT();
            }
        } }
        SEAM(pb + 3);

        for (int rep_ = 0; rep_ <= (int)PH_REP(5); ++rep_) { if (rep_) GRID_BAR();
        if (PH_ON(5) && IN(pb + 4)) { PH_BEGIN(); const float* mv = modv + (size_t)l * 9 * 6144; (void)mv; unsigned* const moecnt = ctl + CW_MOE + l * 16 * 64; (void)moecnt;
            LAS bf16* const STl = (LAS bf16*)lds;
            LAS bf16* const VNl = (LAS bf16*)(lds + 8704);
            LAS bf16* const VSl = (LAS bf16*)(lds + 13312);
            LAS bf16* const OTl = (LAS bf16*)(lds + 17920);
            const int w = X.wave, mt = w & 3, role = w >> 2, r16 = lane & 15, quad = lane >> 4;
            for (int blk = X.bid; blk < 256; blk += X.G) {
                const int item = (blk & 7) * 32 + (blk >> 3);
                const int chain = item >> 2, slice = item & 3, dir = chain & 1, hh = (chain >> 1) & 3, b = chain >> 3;
                bf16* const O = dir ? OB : OF;
                __syncthreads();
                for (int i = tid; i < 32 * 136 / 2; i += 512) ((LAS unsigned*)STl)[i] = 0u;
                __syncthreads();
                f32x4 Sacc[2]; Sacc[0] = (f32x4){0.f, 0.f, 0.f, 0.f}; Sacc[1] = (f32x4){0.f, 0.f, 0.f, 0.f};
#define GDN_LOAD(P, step_) do { const int cidx_ = dir ? ((step_) < 4 ? 3 - (step_) : 39 - (step_)) : (step_); const int item_ = chain * 36 + cidx_, kti_ = (chain >> 1) * 36 + cidx_; \
                    const int row0_ = cidx_ < 4 ? NLAT + b * CTXL + cidx_ * 64 : b * SEQ + (cidx_ - 4) * 64; \
                    const bf16* xp_ = role ? QKV + (size_t)(row0_ + (dir ? 63 - (16 * mt + r16) : 16 * mt + r16)) * 1536 + hh * 128 + quad * 8 : WIT + (size_t)item_ * 8192 + (16 * mt + r16) * 128 + quad * 8; \
                    _Pragma("unroll") for (int ks = 0; ks < 4; ++ks) P##Xf[ks] = *(const bf16x8*)(xp_ + 32 * ks); \
                    { const bf16* kp_ = KIT + (size_t)kti_ * 8192 + (16 * w + r16) * 64 + (dir ? 56 - quad * 8 : quad * 8); \
                      _Pragma("unroll") for (int ks = 0; ks < 2; ++ks) P##Kx[ks] = *(const v4u*)(kp_ + (dir ? -32 * ks : 32 * ks)); } \
                    const float* sp_ = SIT + (size_t)item_ * 192; P##sc4 = *(const f32x4*)(sp_ + (role ? 0 : 64) + 16 * mt + quad * 4); P##egl = sp_[128]; \
                      \
                    { const bf16* a0_ = role ? AIT + (size_t)item_ * 4096 + (16 * mt + r16) * 64 + quad * 8 : UIT + (size_t)item_ * 8192 + (size_t)(slice * 32 + r16) * 64 + 16 * mt + quad * 4; \
                      const bf16* a1_ = role ? a0_ + 32 : a0_ + 16 * 64; \
                      P##Ax[0] = *(const v2u*)a0_; P##Ax[1] = *(const v2u*)(a0_ + 4); P##Ax[2] = *(const v2u*)a1_; P##Ax[3] = *(const v2u*)(a1_ + 4); } } while (0)
#define GDN_BAR() do { asm volatile("s_waitcnt lgkmcnt(0)" ::: "memory"); __builtin_amdgcn_s_barrier(); asm volatile("" ::: "memory"); } while (0)
#define GDN_STEP(P, step_) do { const int cidx = dir ? ((step_) < 4 ? 3 - (step_) : 39 - (step_)) : (step_); \
                    const int row0 = cidx < 4 ? NLAT + b * CTXL + cidx * 64 : b * SEQ + (cidx - 4) * 64; \
                      \
                    f32x4 x1[2]; x1[0] = (f32x4){0.f, 0.f, 0.f, 0.f}; x1[1] = (f32x4){0.f, 0.f, 0.f, 0.f}; \
                    { bf16x8 bfr[2][4]; \
                      _Pragma("unroll") for (int n_ = 0; n_ < 2; ++n_) _Pragma("unroll") for (int ks = 0; ks < 4; ++ks) bfr[n_][ks] = *(const LAS bf16x8*)(STl + (16 * n_ + r16) * 136 + 32 * ks + quad * 8); \
                      asm volatile("s_waitcnt lgkmcnt(0)" ::: "memory"); \
                      _Pragma("unroll") for (int ks = 0; ks < 4; ++ks) { x1[0] = __builtin_amdgcn_mfma_f32_16x16x32_bf16(P##Xf[ks], bfr[0][ks], x1[0], 0, 0, 0); x1[1] = __builtin_amdgcn_mfma_f32_16x16x32_bf16(P##Xf[ks], bfr[1][ks], x1[1], 0, 0, 0); } } \
                    if (role == 0) { \
                        _Pragma("unroll") for (int n_ = 0; n_ < 2; ++n_) { f32x4 vn; vn[0] = bflo(P##Ax[2 * n_].x) - x1[n_][0]; vn[1] = bfhi(P##Ax[2 * n_].x) - x1[n_][1]; vn[2] = bflo(P##Ax[2 * n_].y) - x1[n_][2]; vn[3] = bfhi(P##Ax[2 * n_].y) - x1[n_][3]; \
                            v2u p; p.x = pk2(vn[0], vn[1]); p.y = pk2(vn[2], vn[3]); *(LAS v2u*)(VNl + (16 * n_ + r16) * 72 + 16 * mt + quad * 4) = p; \
                            v2u q; q.x = pk2(vn[0] * P##sc4[0], vn[1] * P##sc4[1]); q.y = pk2(vn[2] * P##sc4[2], vn[3] * P##sc4[3]); *(LAS v2u*)(VSl + (16 * n_ + r16) * 72 + 16 * mt + quad * 4) = q; } } \
                    else { x1[0] = x1[0] * P##sc4; x1[1] = x1[1] * P##sc4; } \
                    bf16x8 kt_[2]; \
                    _Pragma("unroll") for (int ks = 0; ks < 2; ++ks) { const v4u kx_ = P##Kx[ks]; v4u kr_; \
                        kr_.x = dir ? ((kx_.w >> 16) | (kx_.w << 16)) : kx_.x; kr_.y = dir ? ((kx_.z >> 16) | (kx_.z << 16)) : kx_.y; kr_.z = dir ? ((kx_.y >> 16) | (kx_.y << 16)) : kx_.z; kr_.w = dir ? ((kx_.x >> 16) | (kx_.x << 16)) : kx_.w; \
                        kt_[ks] = __builtin_bit_cast(bf16x8, kr_); } \
                    GDN_BAR(); \
                      \
                    bf16x8 vsf[2][2]; \
                    _Pragma("unroll") for (int n2 = 0; n2 < 2; ++n2) { vsf[n2][0] = *(const LAS bf16x8*)(VSl + (16 * n2 + r16) * 72 + quad * 8); vsf[n2][1] = *(const LAS bf16x8*)(VSl + (16 * n2 + r16) * 72 + 32 + quad * 8); } \
                    if (role) { bf16x8 vb[2][2]; \
                        _Pragma("unroll") for (int n_ = 0; n_ < 2; ++n_) { vb[n_][0] = *(const LAS bf16x8*)(VNl + (16 * n_ + r16) * 72 + quad * 8); vb[n_][1] = *(const LAS bf16x8*)(VNl + (16 * n_ + r16) * 72 + 32 + quad * 8); } \
                        asm volatile("s_waitcnt lgkmcnt(0)" ::: "memory"); \
                        v4u af0_; af0_.x = P##Ax[0].x; af0_.y = P##Ax[0].y; af0_.z = P##Ax[1].x; af0_.w = P##Ax[1].y; v4u af1_; af1_.x = P##Ax[2].x; af1_.y = P##Ax[2].y; af1_.z = P##Ax[3].x; af1_.w = P##Ax[3].y; \
                        const bf16x8 Af0_ = __builtin_bit_cast(bf16x8, af0_), Af1_ = __builtin_bit_cast(bf16x8, af1_); \
                        _Pragma("unroll") for (int n_ = 0; n_ < 2; ++n_) { f32x4 oa = __builtin_amdgcn_mfma_f32_16x16x32_bf16(Af0_, vb[n_][0], x1[n_], 0, 0, 0); oa = __builtin_amdgcn_mfma_f32_16x16x32_bf16(Af1_, vb[n_][1], oa, 0, 0, 0); \
                            LAS bf16* ot_ = OTl + (16 * mt + quad * 4) * 36 + 16 * n_ + r16; \
                            _Pragma("unroll") for (int j = 0; j < 4; ++j) ot_[j * 36] = (bf16)f2bf(oa[j]); } } \
                    else { asm volatile("s_waitcnt lgkmcnt(0)" ::: "memory"); } \
                    _Pragma("unroll") for (int n2 = 0; n2 < 2; ++n2) { \
                        f32x4 sa = Sacc[n2] * P##egl; sa = __builtin_amdgcn_mfma_f32_16x16x32_bf16(kt_[0], vsf[n2][0], sa, 0, 0, 0); sa = __builtin_amdgcn_mfma_f32_16x16x32_bf16(kt_[1], vsf[n2][1], sa, 0, 0, 0); Sacc[n2] = sa; \
                        v2u p; p.x = pk2(sa[0], sa[1]); p.y = pk2(sa[2], sa[3]); *(LAS v2u*)(STl + (16 * n2 + r16) * 136 + 16 * w + quad * 4) = p; } \
                    GDN_BAR(); \
                      \
                    { const int tk_ = 8 * w + (lane >> 3), pc_ = lane & 7; const v2u ov_ = *(const LAS v2u*)(OTl + tk_ * 36 + 4 * pc_); \
                      *(v2u*)(O + (size_t)(row0 + (dir ? 63 - tk_ : tk_)) * 512 + hh * 128 + slice * 32 + 4 * pc_) = ov_; } } while (0)
#define GDN_DECL(P) bf16x8 P##Xf[4]; v4u P##Kx[2]; v2u P##Ax[4]; f32x4 P##sc4; float P##egl
                GDN_DECL(sa_); GDN_DECL(sb_);
                GDN_LOAD(sa_, 0);
                *(v2u*)(ws + WS_END + ((size_t)X.bid * 512 + tid) * 8) = (v2u){0u, 0u};
                for (int step = 0; step < 36; step += 2) {
                    GDN_LOAD(sb_, step + 1); GDN_STEP(sa_, step);
                    { const int s2 = step + 2 < 36 ? step + 2 : 35; GDN_LOAD(sa_, s2); } GDN_STEP(sb_, step + 1);
                }
#undef GDN_STEP
#undef GDN_BAR
#undef GDN_DECL
#undef GDN_LOAD
            }
        } }
        SEAM(pb + 4);

        for (int rep_ = 0; rep_ <= (int)PH_REP(6); ++rep_) { if (rep_) GRID_BAR();
        if (PH_ON(6) && IN(pb + 5)) { PH_BEGIN(); const float* mv = modv + (size_t)l * 9 * 6144; (void)mv; unsigned* const moecnt = ctl + CW_MOE + l * 16 * 64; (void)moecnt;
            const float* nw = INP(I_GNORM) + l * 128; const int ch = 8 * lane;
            const f32x4 nw0 = *(const f32x4*)(nw + (ch & 127)), nw1 = *(const f32x4*)(nw + (ch & 127) + 4);
            constexpr int ERT = 9;
            for (int rowb = gw; rowb < nrows2; rowb += ERT * NGW) {
                v4u lf[ERT], lb[ERT], lz[ERT];
#pragma unroll
                for (int k = 0; k < ERT; ++k) { const int row_ = rowb + k * NGW, row = row_ < nrows2 ? row_ : nrows2 - 1; lf[k] = *(const v4u*)(OF + (size_t)row * 512 + ch); lb[k] = *(const v4u*)(OB + (size_t)row * 512 + ch); lz[k] = *(const v4u*)(PZ + (size_t)row * 512 + ch); }
#pragma unroll
                for (int k = 0; k < ERT; ++k) { const int row_ = rowb + k * NGW, row = row_ < nrows2 ? row_ : nrows2 - 1; {
                    float of[8], ob[8], z[8], o[8]; unpack8(lf[k], of); unpack8(lb[k], ob); unpack8(lz[k], z); float ss = 0.f;
#pragma unroll
                    for (int e = 0; e < 8; ++e) { of[e] += ob[e]; ss += of[e] * of[e]; }
                    const float rs = __builtin_amdgcn_rsqf(g16_sum(ss) * (1.0f / 128.0f) + LN_EPS);
#pragma unroll
                    for (int e = 0; e < 4; ++e) { o[e] = of[e] * rs * nw0[e] * z[e]; o[4 + e] = of[4 + e] * rs * nw1[e] * z[4 + e]; }
                    if (row_ < nrows2) *(v4u*)(BR + (size_t)row * 512 + ch) = pack8(o); } }
            }
        } }
        SEAM(pb + 5);

        for (int rep_ = 0; rep_ <= (int)PH_REP(7); ++rep_) { if (rep_) GRID_BAR();
        if (PH_ON(7) && IN(pb + 6)) { PH_BEGIN(); const float* mv = modv + (size_t)l * 9 * 6144; (void)mv; unsigned* const moecnt = ctl + CW_MOE + l * 16 * 64; (void)moecnt;
            SchedBranch S{X.G, X.bid, npan2, (const char*)BR, (const char*)WBR};
            EpiBf16<0> E{GT, 4096, nullptr};
            pg8::gemm_phase<EpiBf16<0>, SchedBranch, true, true>(lds, Gemm{512, 512, 512}, S, E);
        } }
        SEAM(pb + 6);

        for (int rep_ = 0; rep_ <= (int)PH_REP(8); ++rep_) { if (rep_) GRID_BAR();
        if (PH_ON(8) && IN(pb + 7)) { PH_BEGIN(); const float* mv = modv + (size_t)l * 9 * 6144; (void)mv; unsigned* const moecnt = ctl + CW_MOE + l * 16 * 64; (void)moecnt;
            SchedGrid S{X.G, X.bid, npan2, 16, (const char*)XN, (const char*)(WIN + (size_t)5120 * 1024), (size_t)256 * 1024 * 2, (size_t)256 * 1024 * 2};
            EpiGateMerge E{GT, (bf16*)MERGED, binv + 5120};
            pg8::gemm_phase<EpiGateMerge, SchedGrid, true, true>(lds, Gemm{1024, 1024, 1024}, S, E);
        } }
        SEAM(pb + 7);

        for (int rep_ = 0; rep_ <= (int)PH_REP(9); ++rep_) { if (rep_) GRID_BAR();
        if (PH_ON(9) && IN(pb + 8)) { PH_BEGIN(); const float* mv = modv + (size_t)l * 9 * 6144; (void)mv; unsigned* const moecnt = ctl + CW_MOE + l * 16 * 64; (void)moecnt;
            SchedGrid S{X.G, X.bid, npan2, 4, (const char*)MERGED, (const char*)WOUT, (size_t)256 * 1024 * 2, (size_t)256 * 1024 * 2};
            EpiBf16<0> E{(bf16*)YB, 1024, INP(I_BOUT) + l * 1024};
            pg8::gemm_phase<EpiBf16<0>, SchedGrid, true, true>(lds, Gemm{1024, 1024, 1024}, S, E);
            __syncthreads();
            { LAS float* const wscr = (LAS float*)(lds + X.wave * 8448);
              const int first = npan2 * 4 > X.G ? npan2 * 4 - X.G : 0;
              if (X.bid >= first) { const int gwc = (X.bid - first) * NWAVES + X.wave, ngwc = (X.G - first) * NWAVES;
              for (int it = gwc; it < 12288; it += ngwc) {
                if (it < 8192) { const int e = it >> 9, rb = (it & 3) + 4 * ((it >> 3) & 7), kb = ((it >> 2) & 1) + 2 * ((it >> 6) & 7), row0 = rb * 32, j = row0 >> 8, w = row0 & 255;
                    const float* src = (w < 128 ? INP(I_EWG) : INP(I_EWU)) + ((size_t)(l * 16 + e) * 1024) * 512;
                    cvt_item(src, 512, 128 * j + (w & 127) + (lane & 31), kb * 64, WGU + ((size_t)e * 1024 + row0) * 1024, 1024, wscr, lane); }
                else { const int i2 = it - 8192; const int e = i2 >> 8, rb = (i2 & 3) + 4 * ((i2 >> 3) & 7), kb = ((i2 >> 2) & 1) + 2 * ((i2 >> 6) & 3);
                    cvt_item(INP(I_EWD) + ((size_t)(l * 16 + e) * 512) * 1024, 1024, rb * 32 + (lane & 31), kb * 64, WDN + ((size_t)e * 1024 + rb * 32) * 512, 512, wscr, lane); }
              } } }
        } }
        SEAM(pb + 8);

        for (int rep_ = 0; rep_ <= (int)PH_REP(10); ++rep_) { if (rep_) GRID_BAR();
        if (PH_ON(10) && IN(pb + 9)) { PH_BEGIN(); const float* mv = modv + (size_t)l * 9 * 6144; (void)mv; unsigned* const moecnt = ctl + CW_MOE + l * 16 * 64; (void)moecnt;
            LAS float* wr_ = (LAS float*)lds;
            volatile LAS unsigned* lcnt = (volatile LAS unsigned*)(lds + 100352);
            __syncthreads();
            if (tid < 32) lcnt[tid] = 0u;
            { f32x4 rq[10];
#pragma unroll
              for (int j = 0; j < 2; ++j) rq[j] = *(const f32x4*)(INP(I_RGW) + (size_t)l * 4096 + (size_t)(tid + 512 * j) * 4);
#pragma unroll
              for (int j = 0; j < 8; ++j) rq[2 + j] = *(const f32x4*)(INP(I_REW) + (size_t)l * 16384 + (size_t)(tid + 512 * (j & 1)) * 16 + 4 * (j >> 1));
#pragma unroll
              for (int j = 0; j < 2; ++j) { LAS float* p = wr_ + tid + 512 * j; p[0] = rq[j][0]; p[1024] = rq[j][1]; p[2048] = rq[j][2]; p[3072] = rq[j][3]; }
#pragma unroll
              for (int j = 0; j < 8; ++j) { LAS float* p = wr_ + (4 + 4 * (j >> 1)) * 1024 + tid + 512 * (j & 1); p[0] = rq[2 + j][0]; p[1024] = rq[2 + j][1]; p[2048] = rq[2 + j][2]; p[3072] = rq[2 + j][3]; } }
            __syncthreads();
            const float* g1 = INP(I_LN1G) + l * 1024, *b1 = INP(I_LN1B) + l * 1024;
            const float rgb_l = INP(I_RGB)[l * 4 + ((lane >> 4) & 3)], reb_l = INP(I_REB)[l * 16 + ((lane >> 2) & 15)];
            constexpr int RT = 2;
            for (int rowb = gw; rowb < nrows2; rowb += RT * NGW) {
                f32x4 v[RT][4];
#pragma unroll
                for (int q = 0; q < RT; ++q) { const int row_ = rowb + q * NGW, row = row_ < nrows2 ? row_ : nrows2 - 1; const bool live = row_ < nrows2;
                    float* hrow = row < NLAT ? hlat + (size_t)row * D : hctx + (size_t)(row - NLAT) * D;
                    const int mi = row < NLAT ? (row >> 11) : 8; const float* mrow = mv + mi * 6144;
                    v2u yw[4]; f32x4 hv[4], gt[4], g1v[4], b1v[4], scv[4], shv[4];
#pragma unroll
                    for (int j = 0; j < 4; ++j) { const int c = 4 * lane + 256 * j; yw[j] = *(const v2u*)((const bf16*)YB + (size_t)row * D + c); hv[j] = *(const f32x4*)(hrow + c); gt[j] = *(const f32x4*)(mrow + 2048 + c); }
#pragma unroll
                    for (int j = 0; j < 4; ++j) { const int c = 4 * lane + 256 * j; g1v[j] = *(const f32x4*)(g1 + c); b1v[j] = *(const f32x4*)(b1 + c); scv[j] = *(const f32x4*)(mrow + 4096 + c); shv[j] = *(const f32x4*)(mrow + 3072 + c); }
#pragma unroll
                    for (int j = 0; j < 4; ++j) { const f32x4 yv = (f32x4){bflo(yw[j].x), bfhi(yw[j].x), bflo(yw[j].y), bfhi(yw[j].y)}; v[q][j] = hv[j] * DN_ALPHA + gt[j] * yv; }
                    ln_rows(v[q]);
#pragma unroll
                    for (int j = 0; j < 4; ++j) { const int c = 4 * lane + 256 * j; v[q][j] = v[q][j] * g1v[j] + b1v[j]; if (live) *(f32x4*)(hrow + c) = v[q][j]; }
                    ln_rows(v[q]);
#pragma unroll
                    for (int j = 0; j < 4; ++j) { const int c = 4 * lane + 256 * j; v[q][j] = v[q][j] * (scv[j] + 1.0f) + shv[j];
                        v2u w; w.x = pk2(v[q][j][0], v[q][j][1]); w.y = pk2(v[q][j][2], v[q][j][3]); if (live) *(v2u*)(XN + (size_t)row * D + c) = w; }
                    asm volatile("" ::: "memory"); }
                static_assert(RT == 2, "the two rows of a trip ride in the two halves of packed f32 operations");
                float pg[RT][4], pe[RT][16];
                { f32x2 vp[4][4];
#pragma unroll
                  for (int j = 0; j < 4; ++j)
#pragma unroll
                      for (int e = 0; e < 4; ++e) vp[j][e] = (f32x2){v[0][j][e], v[1][j][e]};
#pragma unroll
                  for (int o = 0; o < 20; ++o) { f32x2 sr = (f32x2){0.f, 0.f};
#pragma unroll
                    for (int j = 0; j < 4; ++j) { const f32x4 w = *(const LAS f32x4*)(wr_ + o * 1024 + 4 * lane + 256 * j);
#pragma unroll
                        for (int e = 0; e < 4; ++e) sr += vp[j][e] * w[e]; }
                    if (o < 4) { pg[0][o] = sr[0]; pg[1][o] = sr[1]; } else { pe[0][o - 4] = sr[0]; pe[1][o - 4] = sr[1]; }
                    if ((o & 3) == 3) asm volatile("" ::: "memory"); } }
#pragma unroll
                for (int q = 0; q < RT; ++q) { const int row = rowb + q * NGW;
                float tg = reduce4(pg[q], lane), te = reduce16(pe[q], lane);
                tg += rgb_l; te += reb_l;
                float lg[20];
#pragma unroll
                for (int o = 0; o < 4; ++o) lg[o] = __shfl(tg, o * 16);
#pragma unroll
                for (int o = 0; o < 16; ++o) lg[4 + o] = __shfl(te, o * 4);
                int gs = 0; float gm = lg[0];
#pragma unroll
                for (int o = 1; o < 4; ++o) if (lg[o] > gm) { gm = lg[o]; gs = o; }
                float den = 0.f;
#pragma unroll
                for (int o = 0; o < 4; ++o) den += __expf(lg[o] - gm);
                const float gp = __builtin_amdgcn_rcpf(den);
                float el[4];
#pragma unroll
                for (int o = 0; o < 4; ++o) el[o] = gs == 0 ? lg[4 + o] : gs == 1 ? lg[8 + o] : gs == 2 ? lg[12 + o] : lg[16 + o];
                int i0 = 0; float v0 = el[0];
#pragma unroll
                for (int o = 1; o < 4; ++o) if (el[o] > v0) { v0 = el[o]; i0 = o; }
                int i1 = -1; float v1 = 0.f;
#pragma unroll
                for (int o = 0; o < 4; ++o) if (o != i0 && (i1 < 0 || el[o] > v1)) { v1 = el[o]; i1 = o; }
                const float ex = __expf(v1 - v0), rz = __builtin_amdgcn_rcpf(1.0f + ex), w0 = gp * rz, w1 = gp * ex * rz;
                const int e0 = gs * 4 + i0, e1 = gs * 4 + i1;
                if (lane == 0 && row < nrows2) {
                    const unsigned p0 = __hip_atomic_fetch_add((LAS unsigned*)lcnt + e0, 1u, __ATOMIC_RELAXED, __HIP_MEMORY_SCOPE_WORKGROUP);
                    const unsigned p1 = __hip_atomic_fetch_add((LAS unsigned*)lcnt + e1, 1u, __ATOMIC_RELAXED, __HIP_MEMORY_SCOPE_WORKGROUP);
                    float* rt = ROUTE + (size_t)row * 8;
                    rt[0] = __builtin_bit_cast(float, e0); rt[1] = __builtin_bit_cast(float, e1); rt[2] = w0; rt[3] = w1; rt[4] = __builtin_bit_cast(float, (int)p0); rt[5] = __builtin_bit_cast(float, (int)p1);
                }
                asm volatile("" ::: "memory"); }
            }
            __syncthreads();
            if (tid < 16) { const unsigned c = lcnt[tid]; lcnt[16 + tid] = c ? __hip_atomic_fetch_add(moecnt + 64 * tid, c, __ATOMIC_RELAXED, __HIP_MEMORY_SCOPE_AGENT) : 0u; }
            __syncthreads();
            for (int row = gw + lane * NGW; row < nrows2; row += 64 * NGW) {
                { float* rt = ROUTE + (size_t)row * 8; const int e0 = __builtin_bit_cast(int, rt[0]), e1 = __builtin_bit_cast(int, rt[1]);
                    const int q0 = __builtin_bit_cast(int, rt[4]) + (int)lcnt[16 + e0], q1 = __builtin_bit_cast(int, rt[5]) + (int)lcnt[16 + e1];
                    rt[4] = __builtin_bit_cast(float, q0); rt[5] = __builtin_bit_cast(float, q1);
                    ELIST[(size_t)e0 * NTOK + q0] = row; ELIST[(size_t)e1 * NTOK + q1] = row; }
            }
        } }
        SEAM(pb + 9);


        for (int rep_ = 0; rep_ <= (int)PH_REP(12); ++rep_) { if (rep_) GRID_BAR();
        if (PH_ON(12) && IN(pb + 11)) { PH_BEGIN(); const float* mv = modv + (size_t)l * 9 * 6144; (void)mv; unsigned* const moecnt = ctl + CW_MOE + l * 16 * 64; (void)moecnt;
            SchedMoeG S; S.G = X.G; S.c = X.bid; S.a0 = (const char*)XN; S.w0 = (const char*)WGU; S.wstep_e = (size_t)1024 * 1024 * 2; S.wstep_n = (size_t)256 * 1024 * 2; S.list = ELIST; S.init(moecnt, (LAS unsigned*)(lds + LDSCTL_OFF + 64));
            EpiMoe1 E{HID};
            pg8::gemm_phase<EpiMoe1, SchedMoeG, true, true>(lds, Gemm{1024, 1024, 1024}, S, E);
        } }
        SEAM(pb + 11);

        for (int rep_ = 0; rep_ <= (int)PH_REP(13); ++rep_) { if (rep_) GRID_BAR();
        if (PH_ON(13) && IN(pb + 12)) { PH_BEGIN(); const float* mv = modv + (size_t)l * 9 * 6144; (void)mv; unsigned* const moecnt = ctl + CW_MOE + l * 16 * 64; (void)moecnt;
            SchedMoe S; S.G = X.G; S.c = X.bid; S.a0 = (const char*)HID; S.w0 = (const char*)WDN; S.astep = (size_t)256 * 512 * 2; S.wstep_e = (size_t)1024 * 512 * 2; S.wstep_n = (size_t)256 * 512 * 2; S.init(moecnt);
            EpiBf16<0> E{MO, 1024, nullptr};
            pg8::gemm_phase<EpiBf16<0>, SchedMoe, true, true>(lds, Gemm{512, 512, 512}, S, E);
        } }
        SEAM(pb + 12);

        for (int rep_ = 0; rep_ <= (int)PH_REP(14); ++rep_) { if (rep_) GRID_BAR();
        if (PH_ON(14) && IN(pb + 13)) { PH_BEGIN(); const float* mv = modv + (size_t)l * 9 * 6144; (void)mv; unsigned* const moecnt = ctl + CW_MOE + l * 16 * 64; (void)moecnt;
            unsigned pre[16]; { unsigned s = 0;
#pragma unroll
                for (int e = 0; e < 16; ++e) { pre[e] = s; s += ((__hip_atomic_load(moecnt + 64 * e, __ATOMIC_RELAXED, __HIP_MEMORY_SCOPE_AGENT) + 255u) >> 8) << 8; } }
            const float* g2 = INP(I_LN2G) + l * 1024, *b2 = INP(I_LN2B) + l * 1024;
            for (int rowb = gw; rowb < nrows2; rowb += 3 * NGW) {
                int re0[3], re1[3], rp0[3], rp1[3]; float rw0[3], rw1[3];
#pragma unroll
                for (int k = 0; k < 3; ++k) { const int row_ = rowb + k * NGW, row = row_ < nrows2 ? row_ : nrows2 - 1; const float* rt = ROUTE + (size_t)row * 8;
                    re0[k] = __builtin_bit_cast(int, rt[0]); re1[k] = __builtin_bit_cast(int, rt[1]); rw0[k] = rt[2]; rw1[k] = rt[3]; rp0[k] = __builtin_bit_cast(int, rt[4]); rp1[k] = __builtin_bit_cast(int, rt[5]); }
                v2u ma[3][4], mb[3][4]; f32x4 hv[3][4];
#pragma unroll
                for (int k = 0; k < 3; ++k) { const int row_ = rowb + k * NGW, row = row_ < nrows2 ? row_ : nrows2 - 1; {
                    const int e0 = re0[k], e1 = re1[k]; unsigned ba0 = 0, ba1 = 0;
#pragma unroll
                    for (int q = 0; q < 16; ++q) { ba0 = (q == e0) ? pre[q] : ba0; ba1 = (q == e1) ? pre[q] : ba1; }
                    const bf16* m0 = MO + (size_t)(ba0 + (unsigned)rp0[k]) * D, *m1 = MO + (size_t)(ba1 + (unsigned)rp1[k]) * D;
                    const float* hrow = row < NLAT ? hlat + (size_t)row * D : hctx + (size_t)(row - NLAT) * D;
#pragma unroll
                    for (int j = 0; j < 4; ++j) { const int c = 4 * lane + 256 * j; ma[k][j] = *(const v2u*)(m0 + c); mb[k][j] = *(const v2u*)(m1 + c); hv[k][j] = *(const f32x4*)(hrow + c); } } }
#pragma unroll
                for (int k = 0; k < 3; ++k) { const int row_ = rowb + k * NGW, row = row_ < nrows2 ? row_ : nrows2 - 1; {
                    float* hrow = row < NLAT ? hlat + (size_t)row * D : hctx + (size_t)(row - NLAT) * D;
                    const int mi = row < NLAT ? (row >> 11) : 8; const float* mrow = mv + mi * 6144; const float w0 = rw0[k], w1 = rw1[k];
                    f32x4 v[4], gtv[4], g2v[4], b2v[4];
#pragma unroll
                    for (int j = 0; j < 4; ++j) { const int c = 4 * lane + 256 * j; gtv[j] = *(const f32x4*)(mrow + 5120 + c); g2v[j] = *(const f32x4*)(g2 + c); b2v[j] = *(const f32x4*)(b2 + c); }
#pragma unroll
                    for (int j = 0; j < 4; ++j) { const v2u a = ma[k][j], b = mb[k][j];
                        f32x4 mm; mm[0] = w0 * bflo(a.x) + w1 * bflo(b.x); mm[1] = w0 * bfhi(a.x) + w1 * bfhi(b.x); mm[2] = w0 * bflo(a.y) + w1 * bflo(b.y); mm[3] = w0 * bfhi(a.y) + w1 * bfhi(b.y);
                        v[j] = hv[k][j] * DN_ALPHA + gtv[j] * mm; }
                    ln_rows(v);
                    if (row_ < nrows2) {
#pragma unroll
                    for (int j = 0; j < 4; ++j) { const int c = 4 * lane + 256 * j; *(f32x4*)(hrow + c) = v[j] * g2v[j] + b2v[j]; } } } }
            }
        } }
        SEAM(pb + 13);
    }
#if TPROBE
    {
        GRID_BAR(); STAMP(NPHASES); GRID_BAR();
        unsigned* ts = (unsigned*)(args.ws + WS_CTL) + CW_TS; float T = 0.f;
        for (int l2 = 0; l2 < 2; ++l2) { const int p = (TPA) == 100 ? 0 : 1 + NPH_LAYER * l2 + (TPA);
            if ((TPA) != 100 || l2 == 0) T += (float)(__hip_atomic_load(ts + p + 1, __ATOMIC_RELAXED, __HIP_MEMORY_SCOPE_AGENT) - __hip_atomic_load(ts + p, __ATOMIC_RELAXED, __HIP_MEMORY_SCOPE_AGENT)) * 0.01f; }
        for (size_t i = (size_t)blockIdx.x * 512 + threadIdx.x; i < (size_t)NLAT * D; i += (size_t)gridDim.x * 512) { const int j = (int)(i >> 19);
            if (T >= (float)(TOFF) + 20.0f * (float)(j + 1)) args.out[i] += 0.2f; }
    }
#endif
#undef IN
#undef SEAM
}

extern "C" void kernel_launch(void* const* d_in, const int* in_sizes, int n_in, void* d_out, int out_size, void* d_ws, size_t ws_size, hipStream_t stream) {
    static int grid = 0;
    if (grid == 0) {
        if (n_in != 34 || out_size != NLAT * D || ws_size < WS_END + MiB) { fprintf(stderr, "kernel_launch: unexpected problem (n_in %d out %d ws %zu)\n", n_in, out_size, ws_size); grid = -1; return; }
        int dev = 0, cus = 0, per_cu = 0;
        if (hipGetDevice(&dev) != hipSuccess || hipDeviceGetAttribute(&cus, hipDeviceAttributeMultiprocessorCount, dev) != hipSuccess) { grid = -1; return; }
        if (hipFuncSetAttribute((const void*)fwd, hipFuncAttributeMaxDynamicSharedMemorySize, LDS_BYTES) != hipSuccess) { fprintf(stderr, "kernel_launch: hipFuncSetAttribute failed\n"); grid = -1; return; }
        if (hipOccupancyMaxActiveBlocksPerMultiprocessor(&per_cu, (const void*)fwd, NWAVES * 64, LDS_BYTES) != hipSuccess || per_cu < 1) { fprintf(stderr, "kernel_launch: occupancy query reports %d\n", per_cu); }
        (void)hipGetLastError();
        grid = cus;
    }
    if (grid < 0) return;
    if (hipMemsetAsync((char*)d_ws + WS_CTL, 0, CTL_ZERO_BYTES, stream) != hipSuccess) return;
    Args a{};
    for (int i = 0; i < 34; ++i) a.in[i] = (const float*)d_in[i];
    a.out = (float*)d_out; a.ws = (unsigned char*)d_ws;
#if MK_ONE_LAUNCH
    a.ph_lo = 0; a.ph_hi = NPHASES;
    hipLaunchKernelGGL(fwd, dim3(grid), dim3(NWAVES * 64), LDS_BYTES, stream, a);
#else
    for (int p = 0; p < NPHASES; ++p) { a.ph_lo = p; a.ph_hi = p + 1; hipLaunchKernelGGL(fwd, dim3(grid), dim3(NWAVES * 64), LDS_BYTES, stream, a); }
#endif
}
```

```cpp
#include <hip/hip_runtime.h>
#include <cstdio>
#include <cstdint>

#define GAS __attribute__((address_space(1)))
#define LAS __attribute__((address_space(3)))
typedef unsigned short bf16;
typedef unsigned v4u __attribute__((ext_vector_type(4)));
typedef unsigned v2u __attribute__((ext_vector_type(2)));
typedef float f32x4 __attribute__((ext_vector_type(4)));
typedef float f32x2 __attribute__((ext_vector_type(2)));
typedef short bf16x8 __attribute__((ext_vector_type(8)));

constexpr int D = 1024, NB = 8, SEQ = 2048, CTXL = 256, NLAT = NB * SEQ, NCTX = NB * CTXL, NTOK = NLAT + NCTX;
constexpr int OFF_Q = 0, OFF_K = 512, OFF_V = 1024, OFF_Z = 1536, OFF_A = 2048, OFF_B = 2056, OFF_CONF = 2064, OFF_FFT = 3088, OFF_SGU = 3600, OFF_GATE = 4624, N_IN = 8720;
constexpr int NWROWS = 9216;
constexpr float LN_EPS = 1e-6f;
constexpr float DN_ALPHA = 1.4142135623730951f;
constexpr int NWAVES = 8;
constexpr int NPH_LAYER = 14, NPHASES = 1 + 2 * NPH_LAYER;

#ifndef PHMASK
#define PHMASK 0xFFFFFFFFu
#endif
#define PH_ON(k) (((PHMASK) >> (k)) & 1u)
#ifndef REPMASK
#define REPMASK 0u
#endif
#define PH_REP(k) (((REPMASK) >> (k)) & 1u)
#ifndef TPA
#define TPA -1
#endif
#ifndef TPB
#define TPB -1
#endif
#ifndef TOFF
#define TOFF 0
#endif
#define TPROBE ((TPA) >= 0 || (TPB) >= 0)
#ifndef CPART
#define CPART 15
#endif
#ifndef MK_ONE_LAUNCH
#define MK_ONE_LAUNCH 1
#endif

constexpr size_t MiB = 1u << 20;
constexpr size_t WS_CTL = 0, CTL_ZERO_BYTES = 128 * 1024;
constexpr size_t WS_MODV = 1 * MiB;
constexpr size_t WS_BIN = 1 * MiB + 512 * 1024;
constexpr size_t WS_ROUTE = WS_BIN + 64 * 1024;
constexpr size_t WS_HCTX = 3 * MiB;
constexpr size_t WS_XN = 11 * MiB;
constexpr size_t WS_WIN = 47 * MiB;
constexpr size_t WS_WBR = 65 * MiB;
constexpr size_t WS_WOUT = 69 * MiB;
constexpr size_t WS_DFTL = 71 * MiB;
constexpr size_t WS_DFTC = 87 * MiB;
constexpr size_t WS_F1B = 71 * MiB;
constexpr size_t WS_R2 = 88 * MiB;
constexpr size_t WS_PQKV = WS_R2;
constexpr size_t WS_PCONF = WS_R2 + 54 * MiB;
constexpr size_t WS_PZ = WS_R2 + 72 * MiB;
constexpr size_t WS_PSGU = WS_R2 + 90 * MiB;
constexpr size_t WS_PFFT = WS_R2 + 126 * MiB;
constexpr size_t WS_PFFTC = WS_R2 + 158 * MiB;
constexpr size_t WS_AB = WS_R2 + 162 * MiB;
constexpr size_t WS_WIT = WS_R2;
constexpr size_t WS_UIT = WS_R2 + 36 * MiB;
constexpr size_t WS_AIT = WS_R2 + 90 * MiB;
constexpr size_t WS_KIT = WS_R2 + 108 * MiB;
constexpr size_t WS_SIT = WS_R2 + 126 * MiB;
constexpr size_t WS_OF = WS_R2 + 128 * MiB;
constexpr size_t WS_OB = WS_R2 + 146 * MiB;
constexpr size_t WS_G = WS_R2;
constexpr size_t WS_WGU = WS_R2;
constexpr size_t WS_WDN = WS_R2 + 32 * MiB;
constexpr size_t WS_XG = WS_R2 + 48 * MiB;
constexpr size_t WS_R3 = WS_R2 + 164 * MiB;
constexpr size_t WS_QKV = WS_R3;
constexpr size_t WS_GB = WS_R3 + 54 * MiB;
constexpr size_t WS_BR = WS_R3 + 72 * MiB;
constexpr size_t WS_F1A = WS_BR;
constexpr size_t WS_MERGED = WS_R3;
constexpr size_t WS_Y = WS_R3 + 72 * MiB;
constexpr size_t WS_HID = WS_R3;
constexpr size_t WS_MO = WS_R3 + 40 * MiB;
constexpr size_t WS_LIST = WS_R3 + 144 * MiB;
constexpr size_t WS_END = WS_LIST + 2 * MiB;
static_assert(WS_END <= 405 * MiB, "workspace map");
constexpr int CW_BAR = 4096;
constexpr int CW_MOE = 16384;

constexpr int RING_BYTES = 131072;
constexpr int LDSCTL_OFF = RING_BYTES, MISC_OFF = LDSCTL_OFF + 320;
constexpr int LDS_BYTES = 147456;

#define LDS_WAIT() asm volatile("s_waitcnt lgkmcnt(0)" ::: "memory")
#define VM_WAIT() asm volatile("s_waitcnt vmcnt(0)" ::: "memory")
typedef __bf16 bf16x2_t __attribute__((ext_vector_type(2)));
__device__ __forceinline__ unsigned pk2(float lo, float hi) { const f32x2 v = {lo, hi}; const bf16x2_t b = __builtin_convertvector(v, bf16x2_t); return __builtin_bit_cast(unsigned, b); }
__device__ __forceinline__ unsigned f2bf(float f) { return pk2(f, 0.0f) & 0xffffu; }
__device__ __forceinline__ float bflo(unsigned w) { return __builtin_bit_cast(float, w << 16); }
__device__ __forceinline__ float bfhi(unsigned w) { return __builtin_bit_cast(float, w & 0xffff0000u); }
__device__ __forceinline__ float bf1(bf16 b) { return __builtin_bit_cast(float, ((unsigned)b) << 16); }
__device__ __forceinline__ void unpack8(const v4u w, float (&o)[8]) { o[0] = bflo(w.x); o[1] = bfhi(w.x); o[2] = bflo(w.y); o[3] = bfhi(w.y); o[4] = bflo(w.z); o[5] = bfhi(w.z); o[6] = bflo(w.w); o[7] = bfhi(w.w); }
__device__ __forceinline__ v4u pack8(const float (&o)[8]) { v4u w; w.x = pk2(o[0], o[1]); w.y = pk2(o[2], o[3]); w.z = pk2(o[4], o[5]); w.w = pk2(o[6], o[7]); return w; }
__device__ __forceinline__ void fsincospi(float x, float* sn, float* cs) { *sn = __builtin_amdgcn_sinf(0.5f * x); *cs = __builtin_amdgcn_cosf(0.5f * x); }
__device__ __forceinline__ float sigmoidf_(float x) { return __builtin_amdgcn_rcpf(1.0f + __expf(-x)); }
__device__ __forceinline__ float siluf_(float x) { return x * __builtin_amdgcn_rcpf(1.0f + __expf(-x)); }
__device__ __forceinline__ float gelu_tanh(float x) { const float u = 0.7978845608028654f * (x + 0.044715f * x * x * x); return x * __builtin_amdgcn_rcpf(1.0f + __expf(-2.0f * u)); }
__device__ __forceinline__ float wave_sum(float v) {
#pragma unroll
    for (int o = 1; o < 64; o <<= 1) v += __shfl_xor(v, o);
    return v;
}
__device__ __forceinline__ float reduce16(const float (&v)[16], int lane) {
    const bool b5 = (lane & 32) != 0, b4 = (lane & 16) != 0, b3 = (lane & 8) != 0, b2 = (lane & 4) != 0;
    float a[8], b[4], c[2];
#pragma unroll
    for (int i = 0; i < 8; ++i) a[i] = (b5 ? v[i + 8] : v[i]) + __shfl_xor(b5 ? v[i] : v[i + 8], 32);
#pragma unroll
    for (int i = 0; i < 4; ++i) b[i] = (b4 ? a[i + 4] : a[i]) + __shfl_xor(b4 ? a[i] : a[i + 4], 16);
#pragma unroll
    for (int i = 0; i < 2; ++i) c[i] = (b3 ? b[i + 2] : b[i]) + __shfl_xor(b3 ? b[i] : b[i + 2], 8);
    float d = (b2 ? c[1] : c[0]) + __shfl_xor(b2 ? c[0] : c[1], 4);
    d += __shfl_xor(d, 2); d += __shfl_xor(d, 1);
    return d;
}
__device__ __forceinline__ float reduce4(const float (&v)[4], int lane) {
    const bool b5 = (lane & 32) != 0, b4 = (lane & 16) != 0; float a[2];
#pragma unroll
    for (int i = 0; i < 2; ++i) a[i] = (b5 ? v[i + 2] : v[i]) + __shfl_xor(b5 ? v[i] : v[i + 2], 32);
    float d = (b4 ? a[1] : a[0]) + __shfl_xor(b4 ? a[0] : a[1], 16);
    d += __shfl_xor(d, 8); d += __shfl_xor(d, 4); d += __shfl_xor(d, 2); d += __shfl_xor(d, 1);
    return d;
}
__device__ __forceinline__ float g16_sum(float v) {
#pragma unroll
    for (int o = 1; o < 16; o <<= 1) v += __shfl_xor(v, o);
    return v;
}

namespace pg8 {
constexpr int BM = 256, BK = 64, HALF = 128, HTB = HALF * BK * 2, STAGE_BYTES = 8 * HTB;
__host__ __device__ __forceinline__ int lds_byte(int r, int c) { const int st = (r >> 4) * 2 + (c >> 5), rr = r & 15, cc = c & 31, ob = rr * 64 + cc * 2; return st * 1024 + (ob ^ (((ob >> 9) & 1) << 5)); }
__host__ __device__ __forceinline__ void stage_rc(int b, int& R, int& C) { const int st = b / 1024, sb = b % 1024, swz = sb ^ (((sb >> 9) & 1) << 5); R = (st >> 1) * 16 + swz / 64; C = (st & 1) * 32 + (swz % 64) / 2; }
__host__ __device__ __forceinline__ int perm32(int rho) { const int n = rho >> 4, i = rho & 15; return 8 * (i >> 2) + 4 * n + (i & 3); }

struct Unit { int pm, pn, aux, ax2; const char* a; const char* b; };
struct Gemm { int K, lda, ldb; };

__device__ __forceinline__ void map_tile(int L, int nM, int nN, int& pm, int& pn) {
    const int nwg = nM * nN; int wgid = L; { const int q = nwg / 8, r = nwg % 8, xcd = wgid % 8, off = wgid / 8; wgid = (xcd < r ? xcd * (q + 1) : r * (q + 1) + (xcd - r) * q) + off; }
    const int nig = 8 * nN, gid = wgid / nig, fm = gid * 8, gsz = (nM - fm) < 8 ? (nM - fm) : 8;
    pm = fm + ((wgid % nig) % gsz); pn = (wgid % nig) / gsz;
}
__device__ __forceinline__ unsigned cvt_pk_bf16(float lo, float hi) { unsigned r; asm volatile("v_cvt_pk_bf16_f32 %0, %1, %2" : "=v"(r) : "v"(lo), "v"(hi)); return r; }

template <class Epi, class Sched, bool ALIGN_EPI, bool SP2>
__device__ __forceinline__ void gemm_phase(LAS unsigned char* lds, const Gemm g, const Sched& S, const Epi& E) {
    int tid_l = threadIdx.x; asm volatile("" : "+v"(tid_l));
    const int tid = tid_l, wid = __builtin_amdgcn_readfirstlane(tid >> 6), lane = tid & 63, wr = wid >> 2, wc = wid & 3, fr = lane & 15, fq = lane >> 4;
    const int K = g.K, nt = K / BK;
    unsigned voffA[2], voffB[2];
#pragma unroll
    for (int i = 0; i < 2; ++i) { int R, C; stage_rc(tid * 16 + i * 8192, R, C); const int Rb = Epi::PERM ? ((R & ~31) + perm32(R & 31)) : R;
        voffA[i] = (unsigned)(R * g.lda + C) * 2u; voffB[i] = (unsigned)(Rb * g.ldb + C) * 2u; }
    static_assert(!Sched::GATHER || SP2, "gathered A rows: only the SP2 loop");
    unsigned vA[2][2], vAn[2][2];
#define PG8_GCALC(dst, u_) do { _Pragma("unroll") for (int i_ = 0; i_ < 2; ++i_) { int R_, C_; stage_rc(tid * 16 + i_ * 8192, R_, C_); _Pragma("unroll") for (int h_ = 0; h_ < 2; ++h_) dst[h_][i_] = S.arow(u_, R_ + 128 * h_) + (unsigned)C_ * 2u; } } while (0)
#define PG8_STAGE_A(bufoff, base, h, nextsel) do { if constexpr (Sched::GATHER) { unsigned vs_[2]; vs_[0] = (nextsel) ? vAn[h][0] : vA[h][0]; vs_[1] = (nextsel) ? vAn[h][1] : vA[h][1]; PG8_STAGE(bufoff, base, vs_); } \
        else { PG8_STAGE(bufoff, (base) + (h) * hstepA, voffA); } } while (0)
    const size_t kstep = (size_t)(BK * 2);
    const size_t hstepA = (size_t)HALF * g.lda * 2, hstepB = (size_t)HALF * g.ldb * 2;
    const unsigned ldsw = (unsigned)wid * 1024u;
    const int aoff = lds_byte(wr * 64 + fr, fq * 8), boff = lds_byte(wc * 32 + fr, fq * 8);
#define PG8_SA(b, h) (((b) * 2 + (h)) * HTB)
#define PG8_SB(b, h) ((4 + (b) * 2 + (h)) * HTB)
#define PG8_STAGE(bufoff, gbase, voff) do { _Pragma("unroll") for (int _i = 0; _i < 2; ++_i) \
        __builtin_amdgcn_global_load_lds((const unsigned*)((const char*)(gbase) + (voff)[_i]), (LAS unsigned*)(lds + (bufoff) + ldsw + _i * 8192), 16, 0, 0); } while (0)
#define PG8_LDA(dst, b, h) do { _Pragma("unroll") for (int m = 0; m < 4; ++m) _Pragma("unroll") for (int k = 0; k < 2; ++k) dst[m][k] = *(const LAS bf16x8*)(lds + PG8_SA(b, h) + aoff + m * 2048 + k * 1024); } while (0)
#define PG8_LDB(dst, b, h) do { _Pragma("unroll") for (int n = 0; n < 2; ++n) _Pragma("unroll") for (int k = 0; k < 2; ++k) dst[n][k] = *(const LAS bf16x8*)(lds + PG8_SB(b, h) + boff + n * 2048 + k * 1024); } while (0)
#define PG8_MMA(ai, bj, At, Bt) do { __builtin_amdgcn_s_setprio(1); _Pragma("unroll") for (int m = 0; m < 4; ++m) _Pragma("unroll") for (int n = 0; n < 2; ++n) _Pragma("unroll") for (int k = 0; k < 2; ++k) \
        acc[ai][bj][m][n] = __builtin_amdgcn_mfma_f32_16x16x32_bf16(Bt[n][k], At[m][k], acc[ai][bj][m][n], 0, 0, 0); __builtin_amdgcn_s_setprio(0); } while (0)
#define PG8_WAIT_V(n) asm volatile("s_waitcnt vmcnt(" #n ")" ::: "memory")
#define PG8_WAIT_L(n) asm volatile("s_waitcnt lgkmcnt(" #n ")" ::: "memory")
#define PG8_BAR __builtin_amdgcn_s_barrier()
#define PG8_SCHED __builtin_amdgcn_sched_barrier(0)
    Unit cur, nxt; int ui = 0;
    if (!S.next(0, cur)) return;
    f32x4 acc[2][2][4][2];
#pragma unroll
    for (int a = 0; a < 2; ++a)
#pragma unroll
        for (int b = 0; b < 2; ++b)
#pragma unroll
            for (int m = 0; m < 4; ++m)
#pragma unroll
                for (int n = 0; n < 2; ++n) acc[a][b][m][n] = (f32x4){0.f, 0.f, 0.f, 0.f};
    bf16x8 At[4][2], B0[2][2], B1[2][2];
    const char* cA = cur.a; const char* cB = cur.b;
    if constexpr (SP2) {
        if constexpr (Sched::GATHER) { PG8_GCALC(vA, cur); }
        PG8_STAGE(PG8_SB(0, 0), cB, voffB); PG8_STAGE(PG8_SB(0, 1), cB + hstepB, voffB); PG8_STAGE_A(PG8_SA(0, 0), cA, 0, false); PG8_STAGE_A(PG8_SA(0, 1), cA, 1, false);
        if (wr == 1) PG8_BAR;
        PG8_WAIT_V(2); PG8_BAR;
        PG8_STAGE(PG8_SB(1, 0), cB + kstep, voffB); PG8_STAGE_A(PG8_SA(1, 0), cA + kstep, 0, false); PG8_STAGE(PG8_SB(1, 1), cB + hstepB + kstep, voffB);
        PG8_WAIT_V(6); PG8_BAR;
    } else {
        PG8_STAGE(PG8_SB(0, 0), cB, voffB); PG8_STAGE(PG8_SA(0, 0), cA, voffA); PG8_STAGE(PG8_SB(0, 1), cB + hstepB, voffB); PG8_STAGE(PG8_SA(0, 1), cA + hstepA, voffA);
        if (wr == 1) PG8_BAR;
        PG8_WAIT_V(4); PG8_BAR;
        PG8_STAGE(PG8_SB(1, 0), cB + kstep, voffB); PG8_STAGE(PG8_SA(1, 0), cA + kstep, voffA); PG8_STAGE(PG8_SB(1, 1), cB + hstepB + kstep, voffB);
        PG8_WAIT_V(6); PG8_BAR;
    }
    for (;;) {
        const bool has_next = S.next(ui + 1, nxt);
        const char* nA = has_next ? nxt.a : cA; const char* nB = has_next ? nxt.b : cB;
        if constexpr (Sched::GATHER) { if (has_next) { PG8_GCALC(vAn, nxt); } else {
#pragma unroll
            for (int h_ = 0; h_ < 2; ++h_)
#pragma unroll
                for (int i_ = 0; i_ < 2; ++i_) vAn[h_][i_] = vA[h_][i_]; } }
        for (int t = 0; t < nt; t += 2) {
            const bool last = (t == nt - 2);
            const char* a1 = cA + (size_t)(t + 1) * kstep;
            const char* a2 = last ? nA : cA + (size_t)(t + 2) * kstep; const char* b2 = last ? nB : cB + (size_t)(t + 2) * kstep;
            const char* a3 = a2 + kstep; const char* b3 = b2 + kstep;
            if constexpr (SP2) {
            PG8_LDB(B0, 0, 0); PG8_LDB(B1, 0, 1); PG8_SCHED; PG8_LDA(At, 0, 0); PG8_STAGE_A(PG8_SA(1, 1), a1, 1, false);
            PG8_WAIT_V(8); PG8_WAIT_L(0); PG8_BAR; PG8_MMA(0, 0, At, B0); PG8_MMA(0, 1, At, B1); PG8_BAR; PG8_SCHED;
            PG8_LDA(At, 0, 1); PG8_STAGE(PG8_SB(0, 0), b2, voffB); PG8_STAGE(PG8_SB(0, 1), b2 + hstepB, voffB); PG8_STAGE_A(PG8_SA(0, 0), a2, 0, last);
            PG8_WAIT_V(8); PG8_WAIT_L(0); PG8_BAR; PG8_MMA(1, 0, At, B0); PG8_MMA(1, 1, At, B1); PG8_BAR; PG8_SCHED;
            PG8_LDB(B0, 1, 0); PG8_LDB(B1, 1, 1); PG8_SCHED; PG8_LDA(At, 1, 0); PG8_STAGE_A(PG8_SA(0, 1), a2, 1, last);
            PG8_WAIT_V(8); PG8_WAIT_L(0); PG8_BAR; PG8_MMA(0, 0, At, B0); PG8_MMA(0, 1, At, B1); PG8_BAR; PG8_SCHED;
            PG8_LDA(At, 1, 1); PG8_STAGE(PG8_SB(1, 0), b3, voffB); PG8_STAGE(PG8_SB(1, 1), b3 + hstepB, voffB); PG8_STAGE_A(PG8_SA(1, 0), a3, 0, last);
            PG8_WAIT_V(8); PG8_WAIT_L(0); PG8_BAR; PG8_MMA(1, 0, At, B0); PG8_MMA(1, 1, At, B1); PG8_BAR; PG8_SCHED;
            } else {
            PG8_LDB(B0, 0, 0); PG8_SCHED; PG8_LDA(At, 0, 0); PG8_STAGE(PG8_SA(1, 1), a1 + hstepA, voffA);
            PG8_WAIT_L(8); PG8_BAR; PG8_WAIT_L(0); PG8_MMA(0, 0, At, B0); PG8_BAR; PG8_SCHED;
            PG8_LDB(B1, 0, 1); PG8_STAGE(PG8_SB(0, 0), b2, voffB);
            PG8_BAR; PG8_WAIT_L(0); PG8_MMA(0, 1, At, B1); PG8_BAR;
            PG8_LDA(At, 0, 1); PG8_STAGE(PG8_SA(0, 0), a2, voffA);
            PG8_BAR; PG8_WAIT_L(0); PG8_MMA(1, 0, At, B0); PG8_BAR; PG8_SCHED;
            PG8_STAGE(PG8_SB(0, 1), b2 + hstepB, voffB);
            PG8_WAIT_V(6); PG8_BAR; PG8_MMA(1, 1, At, B1); PG8_BAR;
            PG8_LDB(B0, 1, 0); PG8_SCHED; PG8_LDA(At, 1, 0); PG8_STAGE(PG8_SA(0, 1), a2 + hstepA, voffA);
            PG8_WAIT_L(8); PG8_BAR; PG8_WAIT_L(0); PG8_MMA(0, 0, At, B0); PG8_BAR; PG8_SCHED;
            PG8_LDB(B1, 1, 1); PG8_STAGE(PG8_SB(1, 0), b3, voffB);
            PG8_BAR; PG8_WAIT_L(0); PG8_MMA(0, 1, At, B1); PG8_BAR;
            PG8_LDA(At, 1, 1); PG8_STAGE(PG8_SA(1, 0), a3, voffA);
            PG8_BAR; PG8_WAIT_L(0); PG8_MMA(1, 0, At, B0); PG8_BAR; PG8_SCHED;
            PG8_STAGE(PG8_SB(1, 1), b3 + hstepB, voffB);
            PG8_WAIT_V(6); PG8_BAR; PG8_MMA(1, 1, At, B1); PG8_BAR;
            }
        }
        if constexpr (ALIGN_EPI) { if (wr == 0) PG8_BAR; }
        E(acc, cur, wr, wc, fr, fq);
        if (!has_next) break;
#pragma unroll
        for (int a = 0; a < 2; ++a)
#pragma unroll
            for (int b = 0; b < 2; ++b)
#pragma unroll
                for (int m = 0; m < 4; ++m)
#pragma unroll
                    for (int n = 0; n < 2; ++n) acc[a][b][m][n] = (f32x4){0.f, 0.f, 0.f, 0.f};
        cur = nxt; cA = nA; cB = nB; ++ui;
        if constexpr (Sched::GATHER) {
#pragma unroll
            for (int h_ = 0; h_ < 2; ++h_)
#pragma unroll
                for (int i_ = 0; i_ < 2; ++i_) vA[h_][i_] = vAn[h_][i_]; }
        if constexpr (ALIGN_EPI) { if (wr == 1) PG8_BAR; }
    }
    PG8_WAIT_V(0);
    if constexpr (!ALIGN_EPI) { if (wr == 0) PG8_BAR; }
    PG8_BAR;
#undef PG8_SA
#undef PG8_SB
#undef PG8_STAGE
#undef PG8_STAGE_A
#undef PG8_GCALC
#undef PG8_LDA
#undef PG8_LDB
#undef PG8_MMA
#undef PG8_WAIT_V
#undef PG8_WAIT_L
#undef PG8_BAR
#undef PG8_SCHED
}
}
using pg8::Unit;
using pg8::Gemm;
typedef f32x4 AccT[2][2][4][2];

#define XB_TMO      128
#define XB_XCNT(j)  (256  + 64 * (j))
#define XB_XSUB(j)  (1280 + 64 * (j))
#define XB_XGEN(j)  (2304 + 64 * (j))
#define XB_TOP      3328
#define XB_TOPGEN   3392
#define XCD_BAR_WORDS 3456
#define XB_SPIN_CAP (1u << 18)
__device__ __forceinline__ unsigned xb_ld(unsigned* p)              { return __hip_atomic_load(p, __ATOMIC_RELAXED, __HIP_MEMORY_SCOPE_AGENT); }
__device__ __forceinline__ unsigned xb_add(unsigned* p, unsigned v) { return __hip_atomic_fetch_add(p, v, __ATOMIC_RELAXED, __HIP_MEMORY_SCOPE_AGENT); }
__device__ __forceinline__ unsigned xb_xcc_id() { return (unsigned)__builtin_amdgcn_s_getreg((3 << 11) | 20) & 0xFu; }
#define XB_SPIN(cond, bar) do { unsigned _sp = 0; while (cond) { __builtin_amdgcn_s_sleep(1); \
    if ((++_sp & 255u) == 0u) { if (xb_ld(&(bar)[XB_TMO])) break; if (_sp > XB_SPIN_CAP) { atomicAdd(&(bar)[XB_TMO], 1u); break; } } } } while (0)
struct XcdBarrier { unsigned* bar; unsigned x; volatile LAS unsigned* st; };
__device__ __forceinline__ XcdBarrier xcd_barrier_post(unsigned* bar, volatile LAS unsigned* st) {
    XcdBarrier b; b.bar = bar; b.x = xb_xcc_id(); b.st = st;
    if (threadIdx.x == 0) (void)xb_add(&bar[XB_XCNT(b.x)], 1u);
    return b;
}
__device__ __forceinline__ void xcd_barrier_complete(unsigned* bar, unsigned x, unsigned& nloc, unsigned& nx) {
    const unsigned G = gridDim.x * gridDim.y * gridDim.z;
    unsigned sum, cnt, mine, sp = 0u;
    for (;;) {
        sum = 0u; cnt = 0u; mine = 0u;
#pragma unroll
        for (unsigned j = 0; j < 16; ++j) { const unsigned c = xb_ld(&bar[XB_XCNT(j)]); sum += c; cnt += (c > 0u) ? 1u : 0u; mine = (j == x) ? c : mine; }
        if (sum == G) break;
        __builtin_amdgcn_s_sleep(1);
        if ((++sp & 255u) == 0u) { if (xb_ld(&bar[XB_TMO])) break; if (sp > XB_SPIN_CAP) { atomicAdd(&bar[XB_TMO], 1u); break; } }
    }
    nloc = mine > 0u ? mine : 1u; nx = cnt > 0u ? cnt : 1u;
}
__device__ __forceinline__ void xcd_barrier(const XcdBarrier& b) {
    asm volatile("s_waitcnt vmcnt(0)" ::: "memory");
    __syncthreads();
    if (threadIdx.x == 0) {
        unsigned* bar = b.bar;
        __builtin_amdgcn_s_waitcnt(0);
        unsigned nloc = b.st[0], nx = b.st[1];
        if (nloc == 0u) { xcd_barrier_complete(bar, b.x, nloc, nx); b.st[0] = nloc; b.st[1] = nx; }
        const unsigned old = xb_add(&bar[XB_XSUB(b.x)], 1u);
        const unsigned gen = old / nloc;
        if (old + 1u == (gen + 1u) * nloc) {
            __builtin_amdgcn_fence(__ATOMIC_RELEASE, "agent");
            asm volatile("s_waitcnt vmcnt(0)" ::: "memory");
            const unsigned og = xb_add(&bar[XB_TOP], 1u);
            const unsigned tg = og / nx;
            if (og + 1u == (tg + 1u) * nx) xb_add(&bar[XB_TOPGEN], 1u);
            else XB_SPIN(xb_ld(&bar[XB_TOPGEN]) == tg, bar);
            __builtin_amdgcn_fence(__ATOMIC_ACQUIRE, "agent");
            xb_add(&bar[XB_XGEN(b.x)], 1u);
            asm volatile("s_waitcnt vmcnt(0)" ::: "memory");
        } else {
            XB_SPIN(xb_ld(&bar[XB_XGEN(b.x)]) == gen, bar);
            __builtin_amdgcn_fence(__ATOMIC_ACQUIRE, "agent");
            asm volatile("s_waitcnt vmcnt(0)" ::: "memory");
        }
    }
    __syncthreads();
}

struct Args { const float* in[34]; float* out; unsigned char* ws; int ph_lo, ph_hi; };
enum { I_X = 0, I_C, I_CTX, I_CCTX, I_WMOD, I_BMOD, I_WIN, I_BIN, I_GCONV, I_GALOG, I_GDT, I_GNORM, I_CDWW, I_CDWB, I_CLNG, I_CLNB, I_SLNG, I_SLNB, I_SWS, I_SBS,
       I_WBR, I_WOUT, I_BOUT, I_LN1G, I_LN1B, I_LN2G, I_LN2B, I_RGW, I_RGB, I_REW, I_REB, I_EWG, I_EWU, I_EWD };

__device__ __forceinline__ int xcd_chunk(int L, int U) { const int q = U >> 3, r = U & 7, x = L & 7, off = L >> 3; return (x < r ? x * (q + 1) : r * (q + 1) + (x - r) * q) + off; }
struct SchedInA {
    static constexpr bool GATHER = false;
    int G, c; const char* xn; const char* w;
    __device__ __forceinline__ bool next(int i, Unit& u) const {
        const int L = i * G + c; const size_t tstep = (size_t)256 * 1024 * 2;
        if (L < 1152) { int pm, pn; pg8::map_tile(L, 72, 16, pm, pn); u.pm = pm; u.pn = pn; u.aux = 0; u.a = xn + (size_t)pm * tstep; u.b = w + (size_t)pn * tstep; return true; }
        if (L < 1440) { const int q = xcd_chunk(L - 1152, 288), pm = 16 + (q & 3), pn = q >> 2;        u.pm = pm; u.pn = pn; u.aux = 1; u.a = w + (size_t)pm * tstep; u.b = xn + (size_t)pn * tstep; return true; }
        return false;
    }
};
struct SchedGrid {
    static constexpr bool GATHER = false;
    int G, c, nM, nN; const char* a0; const char* b0; size_t astep, bstep;
    __device__ __forceinline__ bool next(int i, Unit& u) const {
        const int L = i * G + c; if (L >= nM * nN) return false;
        int pm, pn; pg8::map_tile(L, nM, nN, pm, pn); u.pm = pm; u.pn = pn; u.aux = 0; u.a = a0 + (size_t)pm * astep; u.b = b0 + (size_t)pn * bstep; return true;
    }
};
struct SchedFftLat {
    static constexpr bool GATHER = false;
    int G, c; const char* dft; const char* pf;
    __device__ __forceinline__ bool next(int i, Unit& u) const {
        const int L = i * G + c; if (L >= 128) return false;
        const int b = L >> 4, kt = (L >> 1) & 7, pn = L & 1;
        u.pm = b * 8 + kt; u.pn = pn; u.aux = 0; u.a = dft + (size_t)kt * (256 * 4096 * 2); u.b = pf + (size_t)b * (512 * 4096 * 2) + (size_t)pn * (256 * 4096 * 2); return true;
    }
};
struct SchedFftCtx {
    static constexpr bool GATHER = false;
    int G, c; const char* dft; const char* pf;
    __device__ __forceinline__ bool next(int i, Unit& u) const {
        const int L = i * G + (G - 1 - c); if (L >= 16) return false;
        const int b = L >> 1, pn = L & 1;
        u.pm = 64 + b; u.pn = pn; u.aux = 0; u.a = dft; u.b = pf + (size_t)b * (512 * 512 * 2) + (size_t)pn * (256 * 512 * 2); return true;
    }
};
struct SchedBranch {
    static constexpr bool GATHER = false;
    int G, c, nM; const char* br; const char* wbr;
    __device__ __forceinline__ bool next(int j, Unit& u) const {
        const int L = j * G + c; if (L >= nM * 16) return false;
        int pm, pn; pg8::map_tile(L, nM, 16, pm, pn);
        u.pm = pm; u.pn = pn; u.aux = 0; u.a = br + (size_t)(pn >> 2) * ((size_t)NTOK * 512 * 2) + (size_t)pm * (256 * 512 * 2); u.b = wbr + (size_t)pn * (256 * 512 * 2); return true;
    }
};
struct SchedMoe {
    static constexpr bool GATHER = false;
    int G, c; unsigned pre[17]; const char* a0; const char* w0; size_t astep, wstep_e, wstep_n;
    __device__ __forceinline__ void init(const unsigned* cnt  ) {
        unsigned s = 0;
#pragma unroll
        for (int e = 0; e < 16; ++e) { pre[e] = s; s += ((unsigned)__builtin_amdgcn_readfirstlane((int)__hip_atomic_load(cnt + 64 * e, __ATOMIC_RELAXED, __HIP_MEMORY_SCOPE_AGENT)) + 255u) >> 8; }
        pre[16] = s;
    }
    __device__ __forceinline__ bool next(int i, Unit& u) const {
        const int L = i * G + c; if (L >= (int)pre[16] * 4) return false;
        const int jt = L >> 2, pn = L & 3; int e = 0;
#pragma unroll
        for (int k = 1; k < 16; ++k) e += ((unsigned)jt >= pre[k]) ? 1 : 0;
        u.pm = jt; u.pn = pn; u.aux = e; u.a = a0 + (size_t)jt * astep; u.b = w0 + (size_t)e * wstep_e + (size_t)pn * wstep_n; return true;
    }
};

struct SchedMoeG {
    static constexpr bool GATHER = true;
    int G, c; const LAS unsigned* pre; const char* a0; const char* w0; size_t wstep_e, wstep_n; const int* list; const unsigned* cnt;
    __device__ __forceinline__ void init(const unsigned* cnt_  , LAS unsigned* pre_) { cnt = cnt_; pre = pre_;
        if (threadIdx.x < 16) pre_[17 + threadIdx.x] = __hip_atomic_load(cnt_ + 64 * threadIdx.x, __ATOMIC_RELAXED, __HIP_MEMORY_SCOPE_AGENT);
        __syncthreads();
        if (threadIdx.x == 0) { unsigned s = 0;
            for (int e = 0; e < 16; ++e) { pre_[e] = s; s += (pre_[17 + e] + 255u) >> 8; }
            pre_[16] = s; }
        __syncthreads();
    }
    __device__ __forceinline__ bool next(int i, Unit& u) const {
        const int L = i * G + c; if (L >= (int)pre[16] * 4) return false;
        const int jt = L >> 2, pn = L & 3; int e = 0; unsigned pe = 0;
#pragma unroll
        for (int k = 1; k < 16; ++k) { const unsigned pk = pre[k]; const bool ge = (unsigned)jt >= pk; e += ge ? 1 : 0; pe = ge ? pk : pe; }
        e = __builtin_amdgcn_readfirstlane(e); pe = (unsigned)__builtin_amdgcn_readfirstlane((int)pe);
        u.pm = jt; u.pn = pn; u.aux = e; u.ax2 = (jt - (int)pe) * 256; u.a = a0; u.b = w0 + (size_t)e * wstep_e + (size_t)pn * wstep_n; return true;
    }
    __device__ __forceinline__ unsigned arow(const Unit& u, int r) const {
        const unsigned n = pre[17 + u.aux]; const unsigned pos = (unsigned)(u.ax2 + r);
        const int tok = pos < n ? list[(size_t)u.aux * NTOK + pos] : 0; return (unsigned)tok * 2048u;
    }
};

struct EpiInA {
    static constexpr bool PERM = true;
    bf16 *pqkv, *pz, *pconf, *psgu, *pfft, *pfftc; const float* bias;
    __device__ __forceinline__ void operator()(const AccT& acc, const Unit& u, int wr, int wc, int fr, int fq) const {
        if (u.aux == 0) {
            const int row0 = u.pm * 256 + wr * 64 + fr, cb = wc * 32 + 8 * fq, bcol0 = u.pn * 256 + cb;
            f32x4 bv[2][2];
#pragma unroll
            for (int bj = 0; bj < 2; ++bj)
#pragma unroll
                for (int n = 0; n < 2; ++n) bv[bj][n] = *(const f32x4*)(bias + bcol0 + bj * 128 + 4 * n);
            if (u.pn < 8) {
                const bool isz = u.pn >= 6;
#pragma unroll
                for (int ai = 0; ai < 2; ++ai)
#pragma unroll
                    for (int m = 0; m < 4; ++m) { const int row = row0 + ai * 128 + m * 16;
                        bf16* rowp = isz ? (pz + (size_t)row * 512 + (u.pn - 6) * 256 + cb) : (pqkv + (size_t)row * 1536 + u.pn * 256 + cb);
#pragma unroll
                        for (int bj = 0; bj < 2; ++bj) { f32x4 v0 = acc[ai][bj][m][0] + bv[bj][0], v1 = acc[ai][bj][m][1] + bv[bj][1];
                            if (isz) {
#pragma unroll
                                for (int j = 0; j < 4; ++j) { v0[j] = siluf_(v0[j]); v1[j] = siluf_(v1[j]); } }
                            v4u w; w.x = pk2(v0[0], v0[1]); w.y = pk2(v0[2], v0[3]); w.z = pk2(v1[0], v1[1]); w.w = pk2(v1[2], v1[3]);
                            *(v4u*)(rowp + bj * 128) = w; } }
            } else if (u.pn < 12) {
#pragma unroll
                for (int ai = 0; ai < 2; ++ai)
#pragma unroll
                    for (int m = 0; m < 4; ++m) { const int row = row0 + ai * 128 + m * 16;
                        const f32x4 a0 = acc[ai][0][m][0] + bv[0][0], a1 = acc[ai][0][m][1] + bv[0][1], g0 = acc[ai][1][m][0] + bv[1][0], g1 = acc[ai][1][m][1] + bv[1][1];
                        float o[8];
#pragma unroll
                        for (int j = 0; j < 4; ++j) { o[j] = a0[j] * sigmoidf_(g0[j]); o[4 + j] = a1[j] * sigmoidf_(g1[j]); }
                        *(v4u*)(pconf + (size_t)row * 512 + (u.pn - 8) * 128 + cb) = pack8(o); }
            } else {
#pragma unroll
                for (int ai = 0; ai < 2; ++ai)
#pragma unroll
                    for (int m = 0; m < 4; ++m) { const int row = row0 + ai * 128 + m * 16;
                        bf16* rowp = psgu + (size_t)row * 1024 + (u.pn - 12) * 256 + cb;
#pragma unroll
                        for (int bj = 0; bj < 2; ++bj) { f32x4 v0 = acc[ai][bj][m][0] + bv[bj][0], v1 = acc[ai][bj][m][1] + bv[bj][1];
#pragma unroll
                            for (int j = 0; j < 4; ++j) { v0[j] = gelu_tanh(v0[j]); v1[j] = gelu_tanh(v1[j]); }
                            v4u w; w.x = pk2(v0[0], v0[1]); w.y = pk2(v0[2], v0[3]); w.z = pk2(v1[0], v1[1]); w.w = pk2(v1[2], v1[3]);
                            *(v4u*)(rowp + bj * 128) = w; } }
            }
        } else {
            const int jrow0 = (u.pm - 16) * 256 + wr * 64 + fr, tok0 = u.pn * 256 + wc * 32 + 8 * fq;
#pragma unroll
            for (int ai = 0; ai < 2; ++ai)
#pragma unroll
                for (int m = 0; m < 4; ++m) { const int jrow = jrow0 + ai * 128 + m * 16; const float bb = bias[4096 + jrow]; const int cs = jrow >> 9, rr = jrow & 511;
#pragma unroll
                    for (int bj = 0; bj < 2; ++bj) { const int tok = tok0 + bj * 128; bf16* dst;
                        if (tok < NLAT) { const int b = tok >> 11, t = tok & 2047; dst = pfft + ((size_t)(b * 512 + rr)) * 4096 + cs * 2048 + t; }
                        else { const int tc = tok - NLAT, b = tc >> 8, t = tc & 255; dst = pfftc + ((size_t)(b * 512 + rr)) * 512 + cs * 256 + t; }
                        const f32x4 v0 = acc[ai][bj][m][0] + bb, v1 = acc[ai][bj][m][1] + bb;
                        v4u w; w.x = pk2(v0[0], v0[1]); w.y = pk2(v0[2], v0[3]); w.z = pk2(v1[0], v1[1]); w.w = pk2(v1[2], v1[3]);
                        *(v4u*)dst = w; } }
        }
    }
};
template <int ACT  > struct EpiBf16 {
    static constexpr bool PERM = true;
    bf16* O; int ldc; const float* bias;
    __device__ __forceinline__ void operator()(const AccT& acc, const Unit& u, int wr, int wc, int fr, int fq) const {
        const int row0 = u.pm * 256 + wr * 64 + fr, col0 = u.pn * 256 + wc * 32 + 8 * fq;
        f32x4 bv[2][2];
#pragma unroll
        for (int bj = 0; bj < 2; ++bj)
#pragma unroll
            for (int n = 0; n < 2; ++n) bv[bj][n] = bias ? *(const f32x4*)(bias + col0 + bj * 128 + 4 * n) : (f32x4){0.f, 0.f, 0.f, 0.f};
#pragma unroll
        for (int ai = 0; ai < 2; ++ai)
#pragma unroll
            for (int m = 0; m < 4; ++m) { bf16* rowp = O + (size_t)(row0 + ai * 128 + m * 16) * ldc + col0;
#pragma unroll
                for (int bj = 0; bj < 2; ++bj) { f32x4 v0 = acc[ai][bj][m][0] + bv[bj][0], v1 = acc[ai][bj][m][1] + bv[bj][1];
                    if (ACT == 1) {
#pragma unroll
                        for (int j = 0; j < 4; ++j) { v0[j] = sigmoidf_(v0[j]); v1[j] = sigmoidf_(v1[j]); } }
                    v4u w; w.x = pk2(v0[0], v0[1]); w.y = pk2(v0[2], v0[3]); w.z = pk2(v1[0], v1[1]); w.w = pk2(v1[2], v1[3]);
                    *(v4u*)(rowp + bj * 128) = w; } }
    }
};
struct EpiF32 {
    static constexpr bool PERM = false;
    float* C; int ldc; const float* bias;
    __device__ __forceinline__ void operator()(const AccT& acc, const Unit& u, int wr, int wc, int fr, int fq) const {
        const int row0 = u.pm * 256 + wr * 64 + fr, col0 = u.pn * 256 + wc * 32 + 4 * fq;
        f32x4 bv[2][2];
#pragma unroll
        for (int bj = 0; bj < 2; ++bj)
#pragma unroll
            for (int n = 0; n < 2; ++n) bv[bj][n] = *(const f32x4*)(bias + col0 + bj * 128 + n * 16);
#pragma unroll
        for (int ai = 0; ai < 2; ++ai)
#pragma unroll
            for (int m = 0; m < 4; ++m) { float* rowp = C + (size_t)(row0 + ai * 128 + m * 16) * ldc + col0;
#pragma unroll
                for (int bj = 0; bj < 2; ++bj)
#pragma unroll
                    for (int n = 0; n < 2; ++n) *(f32x4*)(rowp + bj * 128 + n * 16) = acc[ai][bj][m][n] + bv[bj][n]; }
    }
};
struct EpiGateMerge {
    static constexpr bool PERM = true;
    const bf16* P; bf16* mbf; const float* bias;
    __device__ __forceinline__ void operator()(const AccT& acc, const Unit& u, int wr, int wc, int fr, int fq) const {
        const int row0 = u.pm * 256 + wr * 64 + fr, cb = wc * 32 + 8 * fq, d0 = u.pn * 64 + wc * 16 + 4 * fq;
        f32x4 bv[2][2];
#pragma unroll
        for (int bj = 0; bj < 2; ++bj)
#pragma unroll
            for (int n = 0; n < 2; ++n) bv[bj][n] = *(const f32x4*)(bias + u.pn * 256 + cb + bj * 128 + 4 * n);
#pragma unroll
        for (int ai = 0; ai < 2; ++ai)
#pragma unroll
            for (int m = 0; m < 4; ++m) { const size_t row = (size_t)(row0 + ai * 128 + m * 16); const bf16* pr = P + row * 4096 + d0;
                f32x4 o = (f32x4){0.f, 0.f, 0.f, 0.f};
#pragma unroll
                for (int bj = 0; bj < 2; ++bj)
#pragma unroll
                    for (int n = 0; n < 2; ++n) { const v2u pw = *(const v2u*)(pr + (2 * bj + n) * 1024); const f32x4 g = acc[ai][bj][m][n] + bv[bj][n];
                        o[0] += sigmoidf_(g[0]) * bflo(pw.x); o[1] += sigmoidf_(g[1]) * bfhi(pw.x); o[2] += sigmoidf_(g[2]) * bflo(pw.y); o[3] += sigmoidf_(g[3]) * bfhi(pw.y); }
                v2u w; w.x = pk2(o[0], o[1]); w.y = pk2(o[2], o[3]); *(v2u*)(mbf + row * 1024 + d0) = w; }
    }
};
struct EpiMoe1 {
    static constexpr bool PERM = true;
    bf16* hid;
    __device__ __forceinline__ void operator()(const AccT& acc, const Unit& u, int wr, int wc, int fr, int fq) const {
        const int row0 = u.pm * 256 + wr * 64 + fr, cb = wc * 32 + 8 * fq;
#pragma unroll
        for (int ai = 0; ai < 2; ++ai)
#pragma unroll
            for (int m = 0; m < 4; ++m) { const int row = row0 + ai * 128 + m * 16;
                const f32x4 g0 = acc[ai][0][m][0], g1 = acc[ai][0][m][1], u0 = acc[ai][1][m][0], u1 = acc[ai][1][m][1];
                float o[8];
#pragma unroll
                for (int j = 0; j < 4; ++j) { o[j] = siluf_(g0[j]) * u0[j]; o[4 + j] = siluf_(g1[j]) * u1[j]; }
                *(v4u*)(hid + (size_t)row * 512 + u.pn * 128 + cb) = pack8(o); }
    }
};

struct Ctx {
    LAS unsigned char* lds; int tid, lane, wave, G, bid;
};

__device__ __forceinline__ int gate_srccol(int r) { const int q = r - 5120, t = q >> 8, c = q & 255, bj = c >> 7, wc = (c >> 5) & 3, fq = (c >> 3) & 3, n = (c >> 2) & 1, j = c & 3;
    return OFF_GATE + (2 * bj + n) * 1024 + 64 * t + 16 * wc + 4 * fq + j; }
__device__ __forceinline__ void cvt_tile(const Ctx& X, const float* src, int ld, int k0, bf16* dst, int Kp) {
    LAS float* tile = (LAS float*)X.lds;
#pragma unroll
    for (int i = 0; i < 8; ++i) { const int kk = (X.tid >> 6) + 8 * i, nn = X.tid & 63; tile[kk * 65 + nn] = src[(size_t)(k0 + kk) * ld + nn]; }
    __syncthreads();
    { const int n = X.tid >> 3, kc = X.tid & 7; float o[8];
#pragma unroll
      for (int j = 0; j < 8; ++j) o[j] = tile[(8 * kc + j) * 65 + n];
      *(v4u*)(dst + (size_t)n * Kp + k0 + 8 * kc) = pack8(o); }
    __syncthreads();
}

__device__ __forceinline__ void cvt_item(const float* src, int ld, int srccol, int k0, bf16* dst, int Kp, LAS float* scr, int lane) {
    float tv[32];
#pragma unroll
    for (int i = 0; i < 32; ++i) { const int kk = 2 * i + (lane >> 5); tv[i] = src[(size_t)(k0 + kk) * ld + srccol]; }
#pragma unroll
    for (int i = 0; i < 32; ++i) { const int kk = 2 * i + (lane >> 5); scr[kk * 33 + (lane & 31)] = tv[i]; }
    LDS_WAIT(); asm volatile("" ::: "memory");
    const int c = lane & 7;
#pragma unroll
    for (int j = 0; j < 4; ++j) { const int n = (lane >> 3) + 8 * j; const LAS float* sp = scr + (8 * c) * 33 + n; float o[8];
#pragma unroll
        for (int e = 0; e < 8; ++e) o[e] = sp[e * 33];
        *(v4u*)(dst + (size_t)n * Kp + k0 + 8 * c) = pack8(o); }
    LDS_WAIT(); asm volatile("" ::: "memory");
}

__device__ __forceinline__ void cvt_item4(const float* src, int ld, int col4, int k0, bf16* dst, int Kp, LAS float* scr, int lane) {
    f32x4 v[8]; const int kq = lane >> 3, n4 = 4 * (lane & 7);
#pragma unroll
    for (int i = 0; i < 8; ++i) v[i] = *(const f32x4*)(src + (size_t)(k0 + kq + 8 * i) * ld + col4);
#pragma unroll
    for (int i = 0; i < 8; ++i) { LAS float* p = scr + (kq + 8 * i) * 33 + n4; p[0] = v[i][0]; p[1] = v[i][1]; p[2] = v[i][2]; p[3] = v[i][3]; }
    LDS_WAIT(); asm volatile("" ::: "memory");
    const int c = lane & 7;
#pragma unroll
    for (int j = 0; j < 4; ++j) { const int n = (lane >> 3) + 8 * j; const LAS float* sp = scr + (8 * c) * 33 + n; float o[8];
#pragma unroll
        for (int e = 0; e < 8; ++e) o[e] = sp[e * 33];
        *(v4u*)(dst + (size_t)n * Kp + k0 + 8 * c) = pack8(o); }
    LDS_WAIT(); asm volatile("" ::: "memory");
}

__device__ __forceinline__ void ln_rows(f32x4 (&v)[4]) {
    float s = 0.f;
#pragma unroll
    for (int j = 0; j < 4; ++j) s += (v[j][0] + v[j][1]) + (v[j][2] + v[j][3]);
    const float mean = wave_sum(s) * (1.f / D); float s2 = 0.f;
#pragma unroll
    for (int j = 0; j < 4; ++j) { v[j] = v[j] - mean; s2 += (v[j][0] * v[j][0] + v[j][1] * v[j][1]) + (v[j][2] * v[j][2] + v[j][3] * v[j][3]); }
    const float rstd = __builtin_amdgcn_rsqf(wave_sum(s2) * (1.f / D) + LN_EPS);
#pragma unroll
    for (int j = 0; j < 4; ++j) v[j] = v[j] * rstd;
}

#define PH_BEGIN() \
    int tid_l = threadIdx.x; asm volatile("" : "+v"(tid_l)); const int tid = tid_l, lane = tid & 63; \
    Ctx X; X.lds = lds; X.tid = tid; X.lane = lane; X.wave = __builtin_amdgcn_readfirstlane(tid >> 6); X.G = gridDim.x; X.bid = blockIdx.x; \
    const int gw = X.bid * NWAVES + X.wave, NGW = X.G * NWAVES; (void)gw; (void)NGW; \
    const __attribute__((address_space(4))) char* kp = (const __attribute__((address_space(4))) char*)__builtin_amdgcn_kernarg_segment_ptr(); asm volatile("" : "+s"(kp)); \
    unsigned char* const ws = *(unsigned char* const __attribute__((address_space(4)))*)(kp + 280); \
    float* const hlat = *(float* const __attribute__((address_space(4)))*)(kp + 272); (void)hlat; \
    float* const hctx = (float*)(ws + WS_HCTX); (void)hctx; \
    float* const modv = (float*)(ws + WS_MODV); (void)modv; \
    float* const binv = (float*)(ws + WS_BIN); (void)binv; \
    bf16* const XN = (bf16*)(ws + WS_XN); (void)XN; \
    bf16* const WIN = (bf16*)(ws + WS_WIN); (void)WIN; \
    bf16* const WBR = (bf16*)(ws + WS_WBR); (void)WBR; \
    bf16* const WOUT = (bf16*)(ws + WS_WOUT); (void)WOUT; \
    bf16* const F1A = (bf16*)(ws + WS_F1A); (void)F1A; bf16* const F1B = (bf16*)(ws + WS_F1B); (void)F1B; \
    bf16* const DFTC = (bf16*)(ws + WS_DFTC); (void)DFTC; \
    bf16* const PQKV = (bf16*)(ws + WS_PQKV); (void)PQKV; \
    bf16* const PCONF = (bf16*)(ws + WS_PCONF); (void)PCONF; \
    bf16* const PZ = (bf16*)(ws + WS_PZ); (void)PZ; \
    bf16* const PSGU = (bf16*)(ws + WS_PSGU); (void)PSGU; \
    bf16* const PFFT = (bf16*)(ws + WS_PFFT); (void)PFFT; \
    bf16* const PFFTC = (bf16*)(ws + WS_PFFTC); (void)PFFTC; \
    float* const AB = (float*)(ws + WS_AB); (void)AB; \
    bf16* const OF = (bf16*)(ws + WS_OF); (void)OF; \
    bf16* const OB = (bf16*)(ws + WS_OB); (void)OB; \
    bf16* const WIT = (bf16*)(ws + WS_WIT); (void)WIT; \
    bf16* const UIT = (bf16*)(ws + WS_UIT); (void)UIT; \
    bf16* const AIT = (bf16*)(ws + WS_AIT); (void)AIT; \
    bf16* const KIT = (bf16*)(ws + WS_KIT); (void)KIT; \
    float* const SIT = (float*)(ws + WS_SIT); (void)SIT; \
    bf16* const GT = (bf16*)(ws + WS_G); (void)GT; \
    bf16* const WGU = (bf16*)(ws + WS_WGU); (void)WGU; \
    bf16* const WDN = (bf16*)(ws + WS_WDN); (void)WDN; \
    bf16* const XG = (bf16*)(ws + WS_XG); (void)XG; \
    bf16* const QKV = (bf16*)(ws + WS_QKV); (void)QKV; \
    float* const GB = (float*)(ws + WS_GB); (void)GB; \
    bf16* const BR = (bf16*)(ws + WS_BR); (void)BR; \
    float* const MERGED = (float*)(ws + WS_MERGED); (void)MERGED; \
    float* const YB = (float*)(ws + WS_Y); (void)YB; \
    bf16* const HID = (bf16*)(ws + WS_HID); (void)HID; \
    bf16* const MO = (bf16*)(ws + WS_MO); (void)MO; \
    float* const ROUTE = (float*)(ws + WS_ROUTE); (void)ROUTE; int* const ELIST = (int*)(ws + WS_LIST); (void)ELIST; \
    unsigned* const ctl = (unsigned*)(ws + WS_CTL); (void)ctl;
#define INP(i) (*(const float* const __attribute__((address_space(4)))*)(kp + 8 * (i)))
__global__ void __launch_bounds__(NWAVES * 64, 2) fwd(Args args) {
    extern __shared__ __attribute__((aligned(16))) unsigned char lds_raw[];
    LAS unsigned char* const lds = (LAS unsigned char*)lds_raw;
    volatile LAS unsigned* MISC = (volatile LAS unsigned*)(lds + MISC_OFF);
    for (int u = threadIdx.x; u < (LDS_BYTES - LDSCTL_OFF) / 4; u += NWAVES * 64) ((LAS unsigned*)(lds + LDSCTL_OFF))[u] = 0u;
    __syncthreads();
#if MK_ONE_LAUNCH
    XcdBarrier bar = xcd_barrier_post((unsigned*)(args.ws + WS_CTL) + CW_BAR, MISC + 8);
#define GRID_BAR() xcd_barrier(bar)
#else
#define GRID_BAR() do { } while (0)
#endif
    const int lo = args.ph_lo, hi = args.ph_hi;
#define IN(k) (lo <= (k) && (k) < hi)
#define CW_TS 20000
#if TPROBE
#define STAMP(k) do { if (blockIdx.x == 0 && threadIdx.x == 0) __hip_atomic_store((unsigned*)(args.ws + WS_CTL) + CW_TS + (k), (unsigned)__builtin_amdgcn_s_memrealtime(), __ATOMIC_RELAXED, __HIP_MEMORY_SCOPE_AGENT); } while (0)
#else
#define STAMP(k) do { } while (0)
#endif
#define SEAM(k) do { if (IN(k) && IN((k) + 1)) GRID_BAR(); STAMP((k) + 1); } while (0)
    STAMP(0);

    for (int rep0_ = 0; rep0_ <= (int)PH_REP(0); ++rep0_) { if (rep0_) GRID_BAR();
    if (PH_ON(0) && IN(0)) { PH_BEGIN();
        for (int idx = X.bid * 512 + tid; idx < 256 * 512 / 8; idx += X.G * 512) {
            const int k = idx >> 6, j0 = (idx & 63) * 8; float o[8];
#pragma unroll
            for (int e = 0; e < 8; ++e) { const int j = j0 + e, t = j & 255, a = (k * t) & 255; float s, c; fsincospi((float)a * (1.0f / 128.0f), &s, &c);
                o[e] = (j < 256 ? c : -s) * 0.0625f; }
            *(v4u*)(DFTC + (size_t)k * 512 + j0) = pack8(o);
        }
        {
            LAS float* sc = (LAS float*)lds;
            LAS float* red = (LAS float*)(lds + 36864);
            { float cv[18];
#pragma unroll
              for (int j = 0; j < 18; ++j) { const int r = j >> 1, k = tid + 512 * (j & 1); cv[j] = r < 8 ? INP(I_C)[r * 1024 + k] : INP(I_CCTX)[k]; }
#pragma unroll
              for (int j = 0; j < 18; ++j) sc[tid + 512 * j] = siluf_(cv[j]); }
            __syncthreads();
            for (int it = X.bid; it < 192; it += X.G) {
                const int l = it / 96, j = (it % 96) * 64 + lane; const float* W = INP(I_WMOD) + (size_t)l * 1024 * 6144 + j;
                float a[9];
#pragma unroll
                for (int r = 0; r < 9; ++r) a[r] = 0.f;
                const int kb = X.wave * 128;
                float wv[2][32];
#pragma unroll
                for (int i = 0; i < 32; ++i) wv[0][i] = W[(size_t)(kb + i) * 6144];
#pragma unroll
                for (int b = 0; b < 4; ++b) {
                    if (b < 3) {
#pragma unroll
                        for (int i = 0; i < 32; ++i) wv[(b + 1) & 1][i] = W[(size_t)(kb + 32 * (b + 1) + i) * 6144]; }
#pragma unroll
                    for (int i = 0; i < 32; i += 4) {
#pragma unroll
                        for (int r = 0; r < 9; ++r) { const f32x4 sv = *(const LAS f32x4*)(sc + r * 1024 + kb + 32 * b + i);
                            a[r] += (sv[0] * wv[b & 1][i] + sv[1] * wv[b & 1][i + 1]) + (sv[2] * wv[b & 1][i + 2] + sv[3] * wv[b & 1][i + 3]); } }
                }
#pragma unroll
                for (int r = 0; r < 9; ++r) red[(X.wave * 9 + r) * 64 + lane] = a[r];
                __syncthreads();
                for (int o = tid; o < 9 * 64; o += 512) { const int r = o >> 6, jj = o & 63; float s = 0.f;
#pragma unroll
                    for (int w = 0; w < 8; ++w) s += red[(w * 9 + r) * 64 + jj];
                    const int jc = (it % 96) * 64 + jj; modv[((size_t)l * 9 + r) * 6144 + jc] = s + INP(I_BMOD)[l * 6144 + jc]; }
                __syncthreads();
            }
        }
    } }
    SEAM(0);

    for (int l = 0; l < 2; ++l) {
        const int pb = 1 + NPH_LAYER * l;
        const int nrows2 = (l == 1) ? NLAT : NTOK;
        const int npan2 = nrows2 / 256;

        for (int rep_ = 0; rep_ <= (int)PH_REP(1); ++rep_) { if (rep_) GRID_BAR();
        if (PH_ON(1) && IN(pb + 0)) { PH_BEGIN(); const float* mv = modv + (size_t)l * 9 * 6144; (void)mv; unsigned* const moecnt = ctl + CW_MOE + l * 16 * 64; (void)moecnt;
            const float* win = INP(I_WIN) + (size_t)l * 1024 * N_IN;
            const float* bin = INP(I_BIN) + (size_t)l * N_IN;
#define FOLD_LOAD(it_) do { const int kb_ = (it_) >> 2, g_ = (it_) & 3; _Pragma("unroll") for (int j = 0; j < 4; ++j) { const int i = tid + 512 * j, kk = i >> 7, c = i & 127; wpre[j] = win[(size_t)(kb_ * 16 + kk) * N_IN + OFF_FFT + g_ * 128 + c]; } } while (0)
            float wpre[4]; FOLD_LOAD(X.bid < 256 ? X.bid : 255);
            LAS float* const wscr = (LAS float*)(lds + X.wave * 8448);
            for (int it = gw; it < 4096 + 1024 + 512 + 144; it += NGW) {
                if (it >= 5632) { const int r = (it - 5632) * 64 + lane;
                    if (r < 4096 || r >= 5120) { float v;
                        if (r < 2048) v = bin[r];
                        else if (r < 3072) { const int q = r - 2048, j = q >> 8, w = q & 255; v = bin[OFF_CONF + (w >= 128 ? 512 : 0) + 128 * j + (w & 127)]; }
                        else if (r < 4096) v = bin[OFF_SGU + (r - 3072)];
                        else v = bin[gate_srccol(r)];
                        binv[r] = v; }
                    continue; }
                const float* src; int ld, col, k0, Kp; bf16* dst; const int n4 = lane & 31;
                if (it < 4096) { const int rb_ = (it & 3) + 4 * ((it >> 3) & 63), rb = rb_ < 128 ? rb_ : rb_ + 32, row0 = rb * 32;
                    if (row0 < 2048) col = row0 + n4;
                    else if (row0 < 3072) { const int q = row0 - 2048, j = q >> 8, w = q & 255; col = OFF_CONF + (w >= 128 ? 512 : 0) + 128 * j + (w & 127) + n4; }
                    else if (row0 < 4096) col = OFF_SGU + (row0 - 3072) + n4;
                    else col = gate_srccol(row0 + n4);
                    src = win; ld = N_IN; k0 = (((it >> 2) & 1) + 2 * (it >> 9)) * 64; dst = WIN + (size_t)row0 * 1024; Kp = 1024; }
                else if (it < 5120) { const int q = it - 4096, i = q >> 8, nb = (q & 3) + 4 * ((q >> 3) & 7);
                    src = INP(I_WBR) + ((size_t)(l * 4 + i) * 512) * 1024; ld = 1024; col = nb * 32 + n4; k0 = (((q >> 2) & 1) + 2 * ((q >> 6) & 3)) * 64; dst = WBR + ((size_t)i * 1024 + nb * 32) * 512; Kp = 512; }
                else { const int q = it - 5120, nb = (q & 3) + 4 * ((q >> 3) & 7);
                    src = INP(I_WOUT) + (size_t)l * 1024 * 1024; ld = 1024; col = nb * 32 + n4; k0 = (((q >> 2) & 1) + 2 * (q >> 6)) * 64; dst = WOUT + (size_t)nb * 32 * 1024; Kp = 1024; }
                cvt_item(src, ld, col, k0, dst, Kp, wscr, lane);
            }
            LAS float* wab = (LAS float*)lds;
            f32x4 wq[8]; bool wq_have = false;
#pragma unroll
            for (int j = 0; j < 8; ++j) wq[j] = (f32x4){0.f, 0.f, 0.f, 0.f};
#define WAB_LOAD() do { _Pragma("unroll") for (int j = 0; j < 8; ++j) wq[j] = *(const f32x4*)(win + (size_t)(tid + 512 * (j & 1)) * N_IN + OFF_A + 4 * (j >> 1)); } while (0)
            for (int it = X.bid; it < 256; it += X.G) {
                const int kb = it >> 2, g = it & 3; LAS float* Wt = (LAS float*)(lds + 69632); LAS f32x2* cst = (LAS f32x2*)(lds + 69632 + 10240); LAS float* bl = (LAS float*)(cst + 128);
                if (it != X.bid) FOLD_LOAD(it);
#pragma unroll
                for (int j = 0; j < 4; ++j) { const int i = tid + 512 * j, kk = i >> 7, c = i & 127; Wt[c * 20 + kk] = wpre[j]; }
                if (tid < 128) { float sn, cn; fsincospi((float)tid * (1.0f / 64.0f), &sn, &cn); cst[tid] = (f32x2){cn * 0.08838834764831845f, sn * 0.08838834764831845f}; }
                else if (tid < 256 && kb == 0) bl[tid - 128] = bin[OFF_FFT + g * 128 + (tid - 128)];
                __syncthreads();
                if (!wq_have) { WAB_LOAD(); wq_have = true; }
                const int m = tid & 127, ks = tid >> 7; f32x2 acc[4];
#pragma unroll
                for (int kk = 0; kk < 4; ++kk) acc[kk] = (f32x2){0.f, 0.f};
                { int a = 0;
#pragma unroll 8
                for (int c = 0; c < 128; ++c) { const f32x2 t = cst[a]; const f32x4 w = *(const LAS f32x4*)(Wt + c * 20 + ks * 4);
#pragma unroll
                    for (int kk = 0; kk < 4; ++kk) acc[kk] += t * w[kk];
                    a = (a + m) & 127; } }
                bf16* dc = WIN + (size_t)(4096 + g * 128 + m) * 1024 + kb * 16 + ks * 4; bf16* dsn = dc + (size_t)512 * 1024;
                { v2u o; o.x = pk2(acc[0][0], acc[1][0]); o.y = pk2(acc[2][0], acc[3][0]); *(v2u*)dc = o; o.x = pk2(acc[0][1], acc[1][1]); o.y = pk2(acc[2][1], acc[3][1]); *(v2u*)dsn = o; }
                if (kb == 0 && tid < 256) {
                    const int cs = tid >> 7; float sb = 0.f; int a = 0;
#pragma unroll 8
                    for (int c = 0; c < 128; ++c) { const f32x2 t = cst[a]; sb += bl[c] * (cs ? t[1] : t[0]); a = (a + m) & 127; }
                    binv[4096 + cs * 512 + g * 128 + m] = sb; }
                if (it + X.G < 256) __syncthreads();
            }
            if (!wq_have) { __syncthreads(); WAB_LOAD(); }
#pragma unroll
            for (int j = 0; j < 8; ++j) { LAS float* p = wab + (4 * (j >> 1)) * 1024 + tid + 512 * (j & 1); p[0] = wq[j][0]; p[1024] = wq[j][1]; p[2048] = wq[j][2]; p[3072] = wq[j][3]; }
            __syncthreads();
#undef FOLD_LOAD
#undef WAB_LOAD
            f32x4 pe[4]; int pe_t = -1;
#pragma unroll
            for (int j = 0; j < 4; ++j) pe[j] = (f32x4){0.f, 0.f, 0.f, 0.f};
            for (int rowb = gw; rowb < NTOK; rowb += 2 * NGW) {
                f32x4 va[4], vb2[4];
                { const int row_ = rowb + 0, row = row_ < NTOK ? row_ : NTOK - 1; const bool LIVE_ = row_ < NTOK;
                float* hrow = row < NLAT ? hlat + (size_t)row * D : hctx + (size_t)(row - NLAT) * D;
                const int mi = row < NLAT ? (row >> 11) : 8; const float* shift = mv + mi * 6144, *scale = shift + 1024;

                if (l == 0) {
                    const float* src = row < NLAT ? INP(I_X) + (size_t)row * D : INP(I_CTX) + (size_t)(row - NLAT) * D;
#pragma unroll
                    for (int j = 0; j < 4; ++j) va[j] = *(const f32x4*)(src + 4 * lane + 256 * j);
                    if (row < NLAT) { const int t = row & 2047;
                        if (t != pe_t) { pe_t = t; const int prow = t >> 6, pcol = t & 63;
#pragma unroll 1
                            for (int j = 0; j < 4; ++j)
#pragma unroll
                                for (int e = 0; e < 4; ++e) { const int col = 4 * lane + 256 * j + e, part = col >> 9, within = col & 511, i = within & 255;
                                    const float omega = __builtin_amdgcn_exp2f((float)i * (-13.287712379549449f / 256.0f)); const float rev = (float)(part ? pcol : prow) * omega * 0.15915494309189535f;
                                    const float pv = (within >> 8) ? __builtin_amdgcn_cosf(rev) : __builtin_amdgcn_sinf(rev);
                                    if (j == 0) pe[0][e] = pv; else if (j == 1) pe[1][e] = pv; else if (j == 2) pe[2][e] = pv; else pe[3][e] = pv; } }
#pragma unroll
                        for (int j = 0; j < 4; ++j) va[j] += pe[j]; }
#pragma unroll
                    for (int j = 0; j < 4; ++j) if (LIVE_) *(f32x4*)(hrow + 4 * lane + 256 * j) = va[j];
                } else {
#pragma unroll
                    for (int j = 0; j < 4; ++j) va[j] = *(const f32x4*)(hrow + 4 * lane + 256 * j);
                }
                f32x4 scv[4], shv[4];
#pragma unroll
                for (int j = 0; j < 4; ++j) { scv[j] = *(const f32x4*)(scale + 4 * lane + 256 * j); shv[j] = *(const f32x4*)(shift + 4 * lane + 256 * j); }
                ln_rows(va);
#pragma unroll
                for (int j = 0; j < 4; ++j) { const f32x4 sc = scv[j], sh = shv[j]; va[j] = va[j] * (sc + 1.0f) + sh;
                    v2u w; w.x = pk2(va[j][0], va[j][1]); w.y = pk2(va[j][2], va[j][3]); if (LIVE_) *(v2u*)(XN + (size_t)row * D + 4 * lane + 256 * j) = w; }
                }
                { const int row_ = rowb + NGW, row = row_ < NTOK ? row_ : NTOK - 1; const bool LIVE_ = row_ < NTOK;
                float* hrow = row < NLAT ? hlat + (size_t)row * D : hctx + (size_t)(row - NLAT) * D;
                const int mi = row < NLAT ? (row >> 11) : 8; const float* shift = mv + mi * 6144, *scale = shift + 1024;

                if (l == 0) {
                    const float* src = row < NLAT ? INP(I_X) + (size_t)row * D : INP(I_CTX) + (size_t)(row - NLAT) * D;
#pragma unroll
                    for (int j = 0; j < 4; ++j) vb2[j] = *(const f32x4*)(src + 4 * lane + 256 * j);
                    if (row < NLAT) { const int t = row & 2047;
                        if (t != pe_t) { pe_t = t; const int prow = t >> 6, pcol = t & 63;
#pragma unroll 1
                            for (int j = 0; j < 4; ++j)
#pragma unroll
                                for (int e = 0; e < 4; ++e) { const int col = 4 * lane + 256 * j + e, part = col >> 9, within = col & 511, i = within & 255;
                                    const float omega = __builtin_amdgcn_exp2f((float)i * (-13.287712379549449f / 256.0f)); const float rev = (float)(part ? pcol : prow) * omega * 0.15915494309189535f;
                                    const float pv = (within >> 8) ? __builtin_amdgcn_cosf(rev) : __builtin_amdgcn_sinf(rev);
                                    if (j == 0) pe[0][e] = pv; else if (j == 1) pe[1][e] = pv; else if (j == 2) pe[2][e] = pv; else pe[3][e] = pv; } }
#pragma unroll
                        for (int j = 0; j < 4; ++j) vb2[j] += pe[j]; }
#pragma unroll
                    for (int j = 0; j < 4; ++j) if (LIVE_) *(f32x4*)(hrow + 4 * lane + 256 * j) = vb2[j];
                } else {
#pragma unroll
                    for (int j = 0; j < 4; ++j) vb2[j] = *(const f32x4*)(hrow + 4 * lane + 256 * j);
                }
                f32x4 scv[4], shv[4];
#pragma unroll
                for (int j = 0; j < 4; ++j) { scv[j] = *(const f32x4*)(scale + 4 * lane + 256 * j); shv[j] = *(const f32x4*)(shift + 4 * lane + 256 * j); }
                ln_rows(vb2);
#pragma unroll
                for (int j = 0; j < 4; ++j) { const f32x4 sc = scv[j], sh = shv[j]; vb2[j] = vb2[j] * (sc + 1.0f) + sh;
                    v2u w; w.x = pk2(vb2[j][0], vb2[j][1]); w.y = pk2(vb2[j][2], vb2[j][3]); if (LIVE_) *(v2u*)(XN + (size_t)row * D + 4 * lane + 256 * j) = w; }
                }
                float pa[16], pb_[16];
                { f32x2 vp[4][4];
#pragma unroll
                  for (int j = 0; j < 4; ++j)
#pragma unroll
                      for (int e = 0; e < 4; ++e) vp[j][e] = (f32x2){va[j][e], vb2[j][e]};
#pragma unroll
                  for (int o = 0; o < 16; ++o) { f32x2 sr = (f32x2){0.f, 0.f};
#pragma unroll
                    for (int j = 0; j < 4; ++j) { const f32x4 w = *(const LAS f32x4*)(wab + o * 1024 + 4 * lane + 256 * j);
#pragma unroll
                        for (int e = 0; e < 4; ++e) sr += vp[j][e] * w[e]; }
                    pa[o] = sr[0]; pb_[o] = sr[1]; if ((o & 3) == 3) asm volatile("" ::: "memory"); } }
                const float t0_ = reduce16(pa, lane), t1_ = reduce16(pb_, lane);
                if ((lane & 3) == 0) { AB[(size_t)rowb * 16 + (lane >> 2)] = t0_ + bin[OFF_A + (lane >> 2)]; if (rowb + NGW < NTOK) AB[(size_t)(rowb + NGW) * 16 + (lane >> 2)] = t1_ + bin[OFF_A + (lane >> 2)]; }
            }
        } }
        SEAM(pb + 0);

        for (int rep_ = 0; rep_ <= (int)PH_REP(2); ++rep_) { if (rep_) GRID_BAR();
        if (PH_ON(2) && IN(pb + 1)) { PH_BEGIN(); const float* mv = modv + (size_t)l * 9 * 6144; (void)mv; unsigned* const moecnt = ctl + CW_MOE + l * 16 * 64; (void)moecnt;
            SchedInA S{X.G, X.bid, (const char*)XN, (const char*)WIN};
            EpiInA E{PQKV, PZ, PCONF, PSGU, PFFT, PFFTC, binv};
            pg8::gemm_phase<EpiInA, SchedInA, true, true>(lds, Gemm{1024, 1024, 1024}, S, E);
        } }
        SEAM(pb + 1);

        for (int rep_ = 0; rep_ <= (int)PH_REP(3); ++rep_) { if (rep_) GRID_BAR();
        if (PH_ON(3) && IN(pb + 2)) { PH_BEGIN(); const float* mv = modv + (size_t)l * 9 * 6144; (void)mv; unsigned* const moecnt = ctl + CW_MOE + l * 16 * 64; (void)moecnt;
            {
                const int vb = X.bid, NB2 = X.G, gw2 = gw, NGW2 = NGW;
                if (l == 0) { SchedFftCtx S{NB2, vb, (const char*)DFTC, (const char*)PFFTC}; EpiBf16<0> E{BR + (size_t)2 * NTOK * 512, 512, nullptr};
                  pg8::gemm_phase<EpiBf16<0>, SchedFftCtx, true, true>(lds, Gemm{512, 512, 512}, S, E); }
                __syncthreads();
                {
                    typedef short v4i16_t __attribute__((ext_vector_type(4)));
                    LAS unsigned char* tl = lds + X.wave * 8192;
                    const int r16 = lane & 15, quad = lane >> 4;
                    bf16x8 m1[4][2];
#pragma unroll
                    for (int mt = 0; mt < 4; ++mt)
#pragma unroll
                        for (int ks = 0; ks < 2; ++ks) { float o[8]; const int k1 = 16 * (mt & 1) + r16, ri = mt >> 1;
#pragma unroll
                            for (int e = 0; e < 8; ++e) { const int t1 = 8 * quad + e; float sn, cs; fsincospi((float)((k1 * t1) & 31) * (1.0f / 16.0f), &sn, &cs);
                                o[e] = ri == 0 ? (ks == 0 ? cs : -sn) : (ks == 0 ? -sn : -cs); }
                            m1[mt][ks] = __builtin_bit_cast(bf16x8, pack8(o)); }
                    float twc[2][4][4], tws[2][4][4];
#pragma unroll
                    for (int ml = 0; ml < 2; ++ml)
#pragma unroll
                        for (int c = 0; c < 4; ++c)
#pragma unroll
                            for (int r = 0; r < 4; ++r) { const int k1 = 16 * ml + r16, t2 = 16 * c + 4 * quad + r; fsincospi((float)(k1 * t2) * (1.0f / 1024.0f), &tws[ml][c][r], &twc[ml][c][r]); }
                    const unsigned tbase = (unsigned)(size_t)tl;
                    for (int it = gw2; it < NB * 512; it += NGW2) {
                        const int b = it >> 9, col = it & 511;
                        const bf16* src = PFFT + (size_t)it * 4096;
                        v4u ld[8];
#pragma unroll
                        for (int i = 0; i < 8; ++i) ld[i] = *(const v4u*)(src + (i * 64 + lane) * 8);
#pragma unroll
                        for (int i = 0; i < 8; ++i) *(LAS v4u*)(tl + (i * 64 + lane) * 16) = ld[i];
                        LDS_WAIT();
                        bf16* dst = (b < 4 ? F1A + (size_t)(b * 512 + col) * 4096 : F1B + (size_t)((b - 4) * 512 + col) * 4096);
#pragma unroll
                        for (int c = 0; c < 4; ++c) {
                            bf16x8 af[2];
#pragma unroll
                            for (int ks = 0; ks < 2; ++ks) { v4i16_t h[2];
#pragma unroll
                                for (int t = 0; t < 2; ++t) h[t] = __builtin_amdgcn_ds_read_tr16_b64_v4i16((LAS v4i16_t*)(tl + ks * 4096 + (8 * quad + 4 * t + (r16 >> 2)) * 128 + (16 * c + 4 * (lane & 3)) * 2));
                                bf16x8 f; f[0] = h[0][0]; f[1] = h[0][1]; f[2] = h[0][2]; f[3] = h[0][3]; f[4] = h[1][0]; f[5] = h[1][1]; f[6] = h[1][2]; f[7] = h[1][3]; af[ks] = f; }
                            f32x4 acc[4];
#pragma unroll
                            for (int mt = 0; mt < 4; ++mt) { acc[mt] = (f32x4){0.f, 0.f, 0.f, 0.f};
#pragma unroll
                                for (int ks = 0; ks < 2; ++ks) acc[mt] = __builtin_amdgcn_mfma_f32_16x16x32_bf16(af[ks], m1[mt][ks], acc[mt], 0, 0, 0); }
#pragma unroll
                            for (int ml = 0; ml < 2; ++ml) { const int k1 = 16 * ml + r16; float pr[4], pi[4];
#pragma unroll
                                for (int r = 0; r < 4; ++r) { const float ar = acc[ml][r], ai = acc[ml + 2][r]; pr[r] = ar * twc[ml][c][r] + ai * tws[ml][c][r]; pi[r] = ai * twc[ml][c][r] - ar * tws[ml][c][r]; }
                                v2u w0, w1; w0.x = pk2(pr[0], pr[1]); w0.y = pk2(pr[2], pr[3]); w1.x = pk2(pi[0], pi[1]); w1.y = pk2(pi[2], pi[3]);
                                *(v2u*)(dst + k1 * 128 + 16 * c + 4 * quad) = w0; *(v2u*)(dst + k1 * 128 + 64 + 16 * c + 4 * quad) = w1; }
                        }
                        LDS_WAIT();
                    }
                    (void)tbase;
                    __syncthreads();
                }
                {
                    LAS float* cwl = (LAS float*)lds;
                    const float* cw = INP(I_GCONV) + (size_t)l * 5 * 1536;
                    { f32x4 t4[4];
#pragma unroll
                      for (int j = 0; j < 4; ++j) { const int i = tid + 512 * j; t4[j] = *(const f32x4*)(cw + 4 * (i < 1920 ? i : 0)); }
#pragma unroll
                      for (int j = 0; j < 4; ++j) { const int i = tid + 512 * j; if (i < 1920) *(LAS f32x4*)(cwl + 4 * i) = t4[j]; } }
                    __syncthreads();
                    const float gdt_l = INP(I_GDT)[l * 8 + (lane & 7)], nega_l = -__expf(INP(I_GALOG)[l * 8 + (lane & 7)]);
                    for (int row = gw2; row < NTOK; row += NGW2) {
                        int t, T; if (row < NLAT) { t = row & 2047; T = 2048; } else { t = (row - NLAT) & 255; T = 256; }
                        v4u xr[3][5];
#pragma unroll
                        for (int seg = 0; seg < 3; ++seg)
#pragma unroll
                            for (int j = 0; j < 5; ++j) { const int tt = t + j - 2; xr[seg][j] = (tt >= 0 && tt < T) ? *(const v4u*)(PQKV + (size_t)(row + j - 2) * 1536 + seg * 512 + 8 * lane) : (v4u){0u, 0u, 0u, 0u}; }
                        float av = 0.f, bv = 0.f; if (lane < 8) { av = AB[(size_t)row * 16 + lane]; bv = AB[(size_t)row * 16 + 8 + lane]; }
#pragma unroll
                        for (int seg = 0; seg < 3; ++seg) { const int ch = seg * 512 + 8 * lane; float a[8];
#pragma unroll
                            for (int e = 0; e < 8; ++e) a[e] = 0.f;
#pragma unroll
                            for (int j = 0; j < 5; ++j) { float xv[8]; unpack8(xr[seg][j], xv);
                                const f32x4 w0 = *(const LAS f32x4*)(cwl + j * 1536 + ch), w1 = *(const LAS f32x4*)(cwl + j * 1536 + ch + 4);
#pragma unroll
                                for (int e = 0; e < 4; ++e) { a[e] += w0[e] * xv[e]; a[4 + e] += w1[e] * xv[4 + e]; } }
                            float ss = 0.f;
#pragma unroll
                            for (int e = 0; e < 8; ++e) { a[e] = siluf_(a[e]); ss += a[e] * a[e]; }
                            if (seg < 2) { ss = g16_sum(ss); const float sc = __builtin_amdgcn_rsqf(ss + LN_EPS) * (seg == 0 ? 0.08838834764831845f : 1.0f);
#pragma unroll
                                for (int e = 0; e < 8; ++e) a[e] *= sc; }
                            *(v4u*)(QKV + (size_t)row * 1536 + ch) = pack8(a); }
                        if (lane < 8) { const float xs = av + gdt_l; const float sp = xs > 20.f ? xs : __logf(1.0f + __expf(xs));
                            GB[(size_t)row * 16 + lane] = nega_l * sp; GB[(size_t)row * 16 + 8 + lane] = __builtin_amdgcn_rcpf(1.0f + __expf(-bv)); }
                    }
                    __syncthreads();
                }
                {
                    LAS bf16* xs = (LAS bf16*)lds;
                    LAS float* wl = (LAS float*)(lds + 63488);
                    const float* dw = INP(I_CDWW) + (size_t)l * 31 * 512; const float* dwb = INP(I_CDWB) + l * 512, *lg = INP(I_CLNG) + l * 512, *lb = INP(I_CLNB) + l * 512;
                    bf16* B1 = BR + (size_t)1 * NTOK * 512;
                    { f32x4 t8[8];
#pragma unroll
                      for (int j = 0; j < 8; ++j) { const int i = tid + 512 * j; t8[j] = *(const f32x4*)(dw + 4 * (i < 3968 ? i : 0)); }
#pragma unroll
                      for (int j = 0; j < 8; ++j) { const int i = tid + 512 * j; if (i < 3968) *(LAS f32x4*)(wl + 4 * i) = t8[j]; } }
                    const int ch = 8 * lane, tq = X.wave;
                    f32x4 bia0 = *(const f32x4*)(dwb + ch), bia1 = *(const f32x4*)(dwb + ch + 4);
                    const f32x4 g0 = *(const f32x4*)(lg + ch), g1 = *(const f32x4*)(lg + ch + 4), b0 = *(const f32x4*)(lb + ch), b1 = *(const f32x4*)(lb + ch + 4);
                    for (int tile = vb; tile < nrows2 / 32; tile += NB2) {
                        const int t0 = tile * 32; int rbase, T; if (t0 < NLAT) { rbase = t0 & ~2047; T = 2048; } else { rbase = NLAT + ((t0 - NLAT) & ~255); T = 256; }
                        __syncthreads();
                        { v4u tl8[8];
#pragma unroll
                          for (int j = 0; j < 8; ++j) { const int i = tid + 512 * j, r = i >> 6, c = i & 63, srow = t0 - 15 + r; const bool ok = i < 62 * 64 && srow >= rbase && srow < rbase + T;
                              tl8[j] = *(const v4u*)(PCONF + (size_t)(ok ? srow : t0) * 512 + 8 * c); if (!ok) tl8[j] = (v4u){0u, 0u, 0u, 0u}; }
#pragma unroll
                          for (int j = 0; j < 8; ++j) { const int i = tid + 512 * j, r = i >> 6, c = i & 63; if (i < 62 * 64) *(LAS v4u*)(xs + r * 512 + 8 * c) = tl8[j]; } }
                        __syncthreads();
                        float acc[4][8];
#pragma unroll
                        for (int k = 0; k < 4; ++k)
#pragma unroll
                            for (int e = 0; e < 4; ++e) { acc[k][e] = bia0[e]; acc[k][4 + e] = bia1[e]; }
#pragma unroll 1
                        for (int j = 0; j < 31; ++j) {
                            const f32x4 w0 = *(const LAS f32x4*)(wl + j * 512 + ch), w1 = *(const LAS f32x4*)(wl + j * 512 + ch + 4);
#pragma unroll
                            for (int k = 0; k < 4; ++k) { float xv[8]; unpack8(*(const LAS v4u*)(xs + (tq * 4 + k + j) * 512 + ch), xv);
#pragma unroll
                                for (int e = 0; e < 4; ++e) { acc[k][e] += w0[e] * xv[e]; acc[k][4 + e] += w1[e] * xv[4 + e]; } }
                        }
#pragma unroll
                        for (int k = 0; k < 4; ++k) { float s1 = 0.f;
#pragma unroll
                            for (int e = 0; e < 8; ++e) s1 += acc[k][e];
                            const float mean = g16_sum(s1) * (1.0f / 128.0f); float s2 = 0.f;
#pragma unroll
                            for (int e = 0; e < 8; ++e) { acc[k][e] -= mean; s2 += acc[k][e] * acc[k][e]; }
                            const float rstd = __builtin_amdgcn_rsqf(g16_sum(s2) * (1.0f / 128.0f) + LN_EPS); float o[8];
#pragma unroll
                            for (int e = 0; e < 4; ++e) { o[e] = siluf_(acc[k][e] * rstd * g0[e] + b0[e]); o[4 + e] = siluf_(acc[k][4 + e] * rstd * g1[e] + b1[e]); }
                            *(v4u*)(B1 + (size_t)(t0 + tq * 4 + k) * 512 + ch) = pack8(o); }
                    }
                    __syncthreads();
                }
                {
                    LAS bf16* vnT = (LAS bf16*)lds;
                    const float* lg = INP(I_SLNG) + l * 512, *lb = INP(I_SLNB) + l * 512;
                    bf16* B3 = BR + (size_t)3 * NTOK * 512;
                    const int nitems = (nrows2 / 128) * 4, r16 = lane & 15, quad = lane >> 4, w = X.wave;
                    for (int it = (vb + NB2 - NB2 / 4) % NB2; it < nitems; it += NB2) {
                        const int chunk = it >> 2, g = it & 3, r0 = chunk * 128;
                        unsigned raw[16];
#pragma unroll
                        for (int i = 0; i < 16; ++i) raw[i] = *(const unsigned*)(PSGU + (size_t)(r0 + w * 16 + i) * 1024 + 512 + g * 128 + 2 * lane);
                        const int c = g * 128 + 2 * lane; const float lg0 = lg[c], lg1 = lg[c + 1], lb0 = lb[c], lb1 = lb[c + 1];
                        __syncthreads();
                        { float sv[16];
#pragma unroll
                          for (int i = 0; i < 16; ++i) sv[i] = bflo(raw[i]) + bfhi(raw[i]);
                          const float ts = reduce16(sv, lane) * (1.0f / 128.0f); float mean[16];
#pragma unroll
                          for (int i = 0; i < 16; ++i) { mean[i] = __shfl(ts, 4 * i); const float v0 = bflo(raw[i]) - mean[i], v1 = bfhi(raw[i]) - mean[i]; sv[i] = v0 * v0 + v1 * v1; }
                          const float tv = reduce16(sv, lane) * (1.0f / 128.0f);
#pragma unroll
                          for (int i = 0; i < 16; ++i) { const float rstd = __builtin_amdgcn_rsqf(__shfl(tv, 4 * i) + LN_EPS); const float v0 = bflo(raw[i]) - mean[i], v1 = bfhi(raw[i]) - mean[i];
                            vnT[(2 * lane) * 136 + w * 16 + i] = (bf16)f2bf(v0 * rstd * lg0 + lb0); vnT[(2 * lane + 1) * 136 + w * 16 + i] = (bf16)f2bf(v1 * rstd * lg1 + lb1); } }
                        bf16x8 wf[4];
                        { const float* wsrc = INP(I_SWS) + ((size_t)(l * 4 + g) * 128 + 16 * w + r16) * 128 + quad * 8;
#pragma unroll
                          for (int ks = 0; ks < 4; ++ks) { const f32x4 x0 = *(const f32x4*)(wsrc + 32 * ks), x1 = *(const f32x4*)(wsrc + 32 * ks + 4);
                              v4u pk; pk.x = pk2(x0[0], x0[1]); pk.y = pk2(x0[2], x0[3]); pk.z = pk2(x1[0], x1[1]); pk.w = pk2(x1[2], x1[3]); wf[ks] = __builtin_bit_cast(bf16x8, pk); } }
                        const float bs = INP(I_SBS)[(l * 4 + g) * 128 + 16 * w + r16];
                        __syncthreads();
                        const size_t prow = (size_t)(r0 + 16 * w + r16);
#pragma unroll
                        for (int nt = 0; nt < 8; ++nt) { f32x4 acc = (f32x4){0.f, 0.f, 0.f, 0.f};
#pragma unroll
                            for (int ks = 0; ks < 4; ++ks) { const bf16x8 vf = *(const LAS bf16x8*)(vnT + (16 * nt + r16) * 136 + 32 * ks + quad * 8); acc = __builtin_amdgcn_mfma_f32_16x16x32_bf16(vf, wf[ks], acc, 0, 0, 0); }
                            const v2u uw = *(const v2u*)(PSGU + prow * 1024 + g * 128 + 16 * nt + quad * 4);
                            v2u o; o.x = pk2(bflo(uw.x) * (acc[0] + bs), bfhi(uw.x) * (acc[1] + bs)); o.y = pk2(bflo(uw.y) * (acc[2] + bs), bfhi(uw.y) * (acc[3] + bs));
                            *(v2u*)(B3 + prow * 512 + g * 128 + 16 * nt + quad * 4) = o; }
                    }
                    __syncthreads();
                }
            }
        } }
        SEAM(pb + 2);

        for (int rep_ = 0; rep_ <= (int)PH_REP(4); ++rep_) { if (rep_) GRID_BAR();
        if (PH_ON(4) && IN(pb + 3)) { PH_BEGIN(); const float* mv = modv + (size_t)l * 9 * 6144; (void)mv; unsigned* const moecnt = ctl + CW_MOE + l * 16 * 64; (void)moecnt;
            {
                const int r16 = lane & 15, quad = lane >> 4;
                bf16x8 m2[4][4];
#pragma unroll
                for (int jt = 0; jt < 4; ++jt)
#pragma unroll
                    for (int ks = 0; ks < 4; ++ks) { float o[8]; const int k2 = 16 * jt + r16;
#pragma unroll
                        for (int e = 0; e < 8; ++e) { const int t2 = 32 * (ks & 1) + 8 * quad + e; float sn, cs; fsincospi((float)((k2 * t2) & 63) * (1.0f / 32.0f), &sn, &cs); o[e] = ((ks >> 1) ? sn : cs) * 0.022097086912079608f; }
                        m2[jt][ks] = __builtin_bit_cast(bf16x8, pack8(o)); }
                bf16* B2 = BR + (size_t)2 * NTOK * 512;
                const int nq5 = 9216 - 4 * NGW;
                const bool bal = nq5 > 0 && nq5 < NGW;
                for (int it = bal ? gw - nq5 : gw; it < 8192; it += bal ? NGW - nq5 : NGW) {
                    if (it < 0) break;
                    const int b = it >> 10, k1 = (it >> 5) & 31, ct = it & 31;
                    const bf16* f1 = (b < 4 ? F1A + (size_t)(b * 512 + 16 * ct + r16) * 4096 : F1B + (size_t)((b - 4) * 512 + 16 * ct + r16) * 4096) + k1 * 128 + 8 * quad;
                    bf16x8 af[4];
#pragma unroll
                    for (int ks = 0; ks < 4; ++ks) af[ks] = *(const bf16x8*)(f1 + 32 * ks);
#pragma unroll
                    for (int jt = 0; jt < 4; ++jt) { f32x4 acc = (f32x4){0.f, 0.f, 0.f, 0.f};
#pragma unroll
                        for (int ks = 0; ks < 4; ++ks) acc = __builtin_amdgcn_mfma_f32_16x16x32_bf16(af[ks], m2[jt][ks], acc, 0, 0, 0);
                        v2u w; w.x = pk2(acc[0], acc[1]); w.y = pk2(acc[2], acc[3]);
                        *(v2u*)(B2 + (size_t)(b * 2048 + k1 + 32 * (16 * jt + r16)) * 512 + 16 * ct + 4 * quad) = w; }
                }
            }
            for (int qi = gw; qi < 9216; qi += NGW) {
                int lane_l = lane; asm volatile("" : "+v"(lane_l));
                const int r16 = lane_l & 15, quad = lane_l >> 4;
                LAS float* const Mt = (LAS float*)(lds + X.wave * 16384);
                LAS float* const gcl = (LAS float*)(lds + 132096 + X.wave * 1024);
                const int item = qi >> 2, q = qi & 3, cidx = item % 36, chain = item / 36, dir = chain & 1, hh = (chain >> 1) & 3, b = chain >> 3;
                const int row0 = cidx < 4 ? NLAT + b * CTXL + cidx * 64 : b * SEQ + (cidx - 4) * 64;
                const int rb = row0 + (dir ? 63 : 0); const long sg = dir ? -1 : 1;
                const float ga = GB[(size_t)(rb + sg * lane_l) * 16 + dir * 4 + hh], be = GB[(size_t)(rb + sg * lane_l) * 16 + 8 + dir * 4 + hh];
                float gc = ga;
#pragma unroll
                for (int o = 1; o < 64; o <<= 1) { const float tu = __shfl_up(gc, o); gc += (lane_l >= o) ? tu : 0.f; }
                const float gl = __shfl(gc, 63);
                gcl[lane_l] = gc; gcl[64 + lane_l] = be;
                const float scl = q >= 2 ? be * __expf(gc) : be;
                bf16x8 Kf[4][4];
                { const bf16* kp = QKV + (size_t)(rb + sg * r16) * 1536 + 512 + hh * 128 + quad * 8; const long ms = sg * 16 * 1536;
#pragma unroll
                  for (int mi = 0; mi < 4; ++mi)
#pragma unroll
                      for (int ks = 0; ks < 4; ++ks) Kf[mi][ks] = *(const bf16x8*)(kp + mi * ms + ks * 32); }
                LDS_WAIT();
                if (q == 0) {
                    bf16x8 Qf[4][4];
                    { const bf16* qp = QKV + (size_t)(rb + sg * r16) * 1536 + hh * 128 + quad * 8; const long ms = sg * 16 * 1536;
#pragma unroll
                      for (int mi = 0; mi < 4; ++mi)
#pragma unroll
                          for (int ks = 0; ks < 4; ++ks) Qf[mi][ks] = *(const bf16x8*)(qp + mi * ms + ks * 32); }
                    bf16* ait = AIT + (size_t)item * 4096 + r16 * 64 + quad * 4;
#pragma unroll
                    for (int mi = 0; mi < 4; ++mi) { const float gci = gcl[16 * mi + r16];
#pragma unroll
                        for (int nj = 0; nj < 4; ++nj) {
                            v2u w; w.x = 0u; w.y = 0u;
                            if (nj <= mi) {
                                f32x4 c = (f32x4){0.f, 0.f, 0.f, 0.f};
#pragma unroll
                                for (int ks = 0; ks < 4; ++ks) c = __builtin_amdgcn_mfma_f32_16x16x32_bf16(Kf[nj][ks], Qf[mi][ks], c, 0, 0, 0);
                                const f32x4 gcj = *(const LAS f32x4*)(gcl + 16 * nj + quad * 4); float o4[4];
#pragma unroll
                                for (int r = 0; r < 4; ++r) { const bool incl = (nj < mi) || (quad * 4 + r <= r16); o4[r] = incl ? c[r] * __expf(gci - gcj[r]) : 0.f; }
                                w.x = pk2(o4[0], o4[1]); w.y = pk2(o4[2], o4[3]); }
                            *(v2u*)(ait + mi * 16 * 64 + 16 * nj) = w; }
                    }
                }
                if (q == 1) { SIT[(size_t)item * 192 + lane_l] = __expf(gc); SIT[(size_t)item * 192 + 64 + lane_l] = __expf(gl - gc); if (lane_l == 0) SIT[(size_t)item * 192 + 128] = __expf(gl); }
                asm volatile("" ::: "memory");
                { LAS float* mw = Mt + r16 * 64 + quad * 4;
#pragma unroll
                  for (int mi = 0; mi < 4; ++mi) {
                    const f32x4 gci = *(const LAS f32x4*)(gcl + 16 * mi + quad * 4), bei = *(const LAS f32x4*)(gcl + 64 + 16 * mi + quad * 4);
#pragma unroll
                    for (int nj = 0; nj <= mi; ++nj) {
                        f32x4 c = (f32x4){0.f, 0.f, 0.f, 0.f};
#pragma unroll
                        for (int ks = 0; ks < 4; ++ks) c = __builtin_amdgcn_mfma_f32_16x16x32_bf16(Kf[mi][ks], Kf[nj][ks], c, 0, 0, 0);
                        const float gcj = gcl[16 * nj + r16]; f32x4 mv4;
#pragma unroll
                        for (int r = 0; r < 4; ++r) { const bool strict = (nj < mi) || (r16 < quad * 4 + r); mv4[r] = strict ? -(bei[r] * c[r] * __expf(gci[r] - gcj)) : 0.f; }
                        *(LAS f32x4*)(mw + (16 * nj) * 64 + 16 * mi) = mv4;
                    }
                  } }
                asm volatile("" ::: "memory");
                LDS_WAIT();
                float Xs[64];
                { const bf16* src = QKV + (size_t)rb * 1536 + (q < 2 ? 1024 + 64 * q : 512 + 64 * (q - 2)) + hh * 128 + lane_l; const long sstep = sg * 1536;
                  bf16 raw[64];
#pragma unroll
                  for (int sidx = 0; sidx < 64; ++sidx) { raw[sidx] = *src; src += sstep; }
                  asm volatile("" ::: "memory");
#pragma unroll
                  for (int sidx = 0; sidx < 64; ++sidx) { const float sc = __builtin_bit_cast(float, __builtin_amdgcn_readlane(__builtin_bit_cast(int, scl), sidx)); Xs[sidx] = bf1(raw[sidx]) * sc; } }
#pragma unroll
                for (int g4 = 0; g4 < 16; ++g4) {
                    f32x4 acc = (f32x4){Xs[4 * g4], Xs[4 * g4 + 1], Xs[4 * g4 + 2], Xs[4 * g4 + 3]};
#pragma unroll
                    for (int c0 = 0; c0 < 4 * g4; c0 += 16) {
                        f32x4 mb[16];
#pragma unroll
                        for (int e = 0; e < 16; ++e) if (c0 + e < 4 * g4) mb[e] = *(const LAS f32x4*)(Mt + (c0 + e) * 64 + 4 * g4);
                        LDS_WAIT();
#pragma unroll
                        for (int e = 0; e < 16; ++e) if (c0 + e < 4 * g4) acc += mb[e] * Xs[c0 + e];
                    }
                    const f32x4 m0 = *(const LAS f32x4*)(Mt + (4 * g4) * 64 + 4 * g4), m1 = *(const LAS f32x4*)(Mt + (4 * g4 + 1) * 64 + 4 * g4), m2 = *(const LAS f32x4*)(Mt + (4 * g4 + 2) * 64 + 4 * g4);
                    LDS_WAIT();
                    const float x0 = acc[0], x1 = acc[1] + m0[1] * x0, x2 = acc[2] + m0[2] * x0 + m1[2] * x1, x3 = acc[3] + m0[3] * x0 + m1[3] * x1 + m2[3] * x2;
                    Xs[4 * g4] = x0; Xs[4 * g4 + 1] = x1; Xs[4 * g4 + 2] = x2; Xs[4 * g4 + 3] = x3;
                }
                if (q < 2) {
                    bf16* u0 = UIT + (size_t)item * 8192 + (size_t)(64 * q + lane_l) * 64;
#pragma unroll
                    for (int p = 0; p < 8; ++p) { float c0[8];
#pragma unroll
                        for (int e = 0; e < 8; ++e) c0[e] = Xs[8 * p + e];
                        *(v4u*)(u0 + 8 * p) = pack8(c0); }
                } else {
                    bf16* w0 = WIT + (size_t)item * 8192 + 64 * (q - 2) + lane_l;
#pragma unroll
                    for (int sidx = 0; sidx < 64; ++sidx) { w0[sidx * 128] = (bf16)f2bf(Xs[sidx]); if ((sidx & 15) == 15) asm volatile("" ::: "memory"); }
                    asm volatile("" ::: "memory");
                    if (dir == 0) {
                        const bf16* src = QKV + (size_t)row0 * 1536 + 512 + hh * 128 + 64 * (q - 2) + lane_l;
                        bf16* k0 = KIT + ((size_t)((b * 4 + hh) * 36 + cidx)) * 8192 + ((size_t)(2 * (4 * (q - 2) + (lane_l >> 4))) * 64 + (lane_l & 15)) * 8;
                        unsigned kw[64];
#pragma unroll
                        for (int e = 0; e < 64; ++e) kw[e] = src[(size_t)e * 1536];
                        asm volatile("" ::: "memory");
#pragma unroll
                        for (int p = 0; p < 8; ++p) { v4u lo; lo.x = kw[8 * p] | (kw[8 * p + 1] << 16); lo.y = kw[8 * p + 2] | (kw[8 * p + 3] << 16); lo.z = kw[8 * p + 4] | (kw[8 * p + 5] << 16); lo.w = kw[8 * p + 6] | (kw[8 * p + 7] << 16);
                            *(v4u*)(k0 + ((p >> 2) * 64 + (p & 3) * 16) * 8) = lo; }
                    }
                }
                LDS_WAIT();
            }
        } }
        SEAM(pb + 3);

        for (int rep_ = 0; rep_ <= (int)PH_REP(5); ++rep_) { if (rep_) GRID_BAR();
        if (PH_ON(5) && IN(pb + 4)) { PH_BEGIN(); const float* mv = modv + (size_t)l * 9 * 6144; (void)mv; unsigned* const moecnt = ctl + CW_MOE + l * 16 * 64; (void)moecnt;
            LAS bf16* const STl = (LAS bf16*)lds;
            LAS bf16* const VNl = (LAS bf16*)(lds + 8704);
            LAS bf16* const VSl = (LAS bf16*)(lds + 13312);
            LAS bf16* const OTl = (LAS bf16*)(lds + 17920);
            const int w = X.wave, mt = w & 3, role = w >> 2, r16 = lane & 15, quad = lane >> 4;
            for (int blk = X.bid; blk < 256; blk += X.G) {
                const int item = (blk & 7) * 32 + (blk >> 3);
                const int chain = item >> 2, slice = item & 3, dir = chain & 1, hh = (chain >> 1) & 3, b = chain >> 3;
                bf16* const O = dir ? OB : OF;
                __syncthreads();
                for (int i = tid; i < 32 * 136 / 2; i += 512) ((LAS unsigned*)STl)[i] = 0u;
                __syncthreads();
                f32x4 Sacc[2]; Sacc[0] = (f32x4){0.f, 0.f, 0.f, 0.f}; Sacc[1] = (f32x4){0.f, 0.f, 0.f, 0.f};
#define GDN_LOAD(P, step_) do { const int cidx_ = dir ? ((step_) < 4 ? 3 - (step_) : 39 - (step_)) : (step_); const int item_ = chain * 36 + cidx_, kti_ = (chain >> 1) * 36 + cidx_; \
                    const int row0_ = cidx_ < 4 ? NLAT + b * CTXL + cidx_ * 64 : b * SEQ + (cidx_ - 4) * 64; \
                    const bf16* xp_ = role ? QKV + (size_t)(row0_ + (dir ? 63 - (16 * mt + r16) : 16 * mt + r16)) * 1536 + hh * 128 + quad * 8 : WIT + (size_t)item_ * 8192 + (16 * mt + r16) * 128 + quad * 8; \
                    _Pragma("unroll") for (int ks = 0; ks < 4; ++ks) P##Xf[ks] = *(const bf16x8*)(xp_ + 32 * ks); \
                    { const bf16* kp_ = KIT + (size_t)kti_ * 8192 + (dir ? ((2 * w + 1) * 64 + (3 - quad) * 16 + r16) * 8 : (2 * w * 64 + quad * 16 + r16) * 8);     \
                      _Pragma("unroll") for (int ks = 0; ks < 2; ++ks) P##Kx[ks] = *(const v4u*)(kp_ + (dir ? -512 * ks : 512 * ks)); } \
                    const float* sp_ = SIT + (size_t)item_ * 192; P##sc4 = *(const f32x4*)(sp_ + (role ? 0 : 64) + 16 * mt + quad * 4); P##egl = sp_[128]; \
                      \
                    { const bf16* a0_ = role ? AIT + (size_t)item_ * 4096 + (16 * mt + r16) * 64 + quad * 8 : UIT + (size_t)item_ * 8192 + (size_t)(slice * 32 + r16) * 64 + 16 * mt + quad * 4; \
                      const bf16* a1_ = role ? a0_ + 32 : a0_ + 16 * 64; \
                      P##Ax[0] = *(const v2u*)a0_; P##Ax[1] = *(const v2u*)(a0_ + 4); P##Ax[2] = *(const v2u*)a1_; P##Ax[3] = *(const v2u*)(a1_ + 4); } } while (0)
#define GDN_BAR() do { asm volatile("s_waitcnt lgkmcnt(0)" ::: "memory"); __builtin_amdgcn_s_barrier(); asm volatile("" ::: "memory"); } while (0)
#define GDN_STEP(P, step_) do { const int cidx = dir ? ((step_) < 4 ? 3 - (step_) : 39 - (step_)) : (step_); \
                    const int row0 = cidx < 4 ? NLAT + b * CTXL + cidx * 64 : b * SEQ + (cidx - 4) * 64; \
                      \
                    f32x4 x1[2]; x1[0] = (f32x4){0.f, 0.f, 0.f, 0.f}; x1[1] = (f32x4){0.f, 0.f, 0.f, 0.f}; \
                    { bf16x8 bfr[2][4]; \
                      _Pragma("unroll") for (int n_ = 0; n_ < 2; ++n_) _Pragma("unroll") for (int ks = 0; ks < 4; ++ks) bfr[n_][ks] = *(const LAS bf16x8*)(STl + (16 * n_ + r16) * 136 + 32 * ks + quad * 8); \
                      asm volatile("s_waitcnt lgkmcnt(0)" ::: "memory"); \
                      _Pragma("unroll") for (int ks = 0; ks < 4; ++ks) { x1[0] = __builtin_amdgcn_mfma_f32_16x16x32_bf16(P##Xf[ks], bfr[0][ks], x1[0], 0, 0, 0); x1[1] = __builtin_amdgcn_mfma_f32_16x16x32_bf16(P##Xf[ks], bfr[1][ks], x1[1], 0, 0, 0); } } \
                    if (role == 0) { \
                        _Pragma("unroll") for (int n_ = 0; n_ < 2; ++n_) { f32x4 vn; vn[0] = bflo(P##Ax[2 * n_].x) - x1[n_][0]; vn[1] = bfhi(P##Ax[2 * n_].x) - x1[n_][1]; vn[2] = bflo(P##Ax[2 * n_].y) - x1[n_][2]; vn[3] = bfhi(P##Ax[2 * n_].y) - x1[n_][3]; \
                            v2u p; p.x = pk2(vn[0], vn[1]); p.y = pk2(vn[2], vn[3]); *(LAS v2u*)(VNl + (16 * n_ + r16) * 72 + 16 * mt + quad * 4) = p; \
                            v2u q; q.x = pk2(vn[0] * P##sc4[0], vn[1] * P##sc4[1]); q.y = pk2(vn[2] * P##sc4[2], vn[3] * P##sc4[3]); *(LAS v2u*)(VSl + (16 * n_ + r16) * 72 + 16 * mt + quad * 4) = q; } } \
                    else { x1[0] = x1[0] * P##sc4; x1[1] = x1[1] * P##sc4; } \
                    bf16x8 kt_[2]; \
                    _Pragma("unroll") for (int ks = 0; ks < 2; ++ks) { const v4u kx_ = P##Kx[ks]; v4u kr_; \
                        kr_.x = dir ? ((kx_.w >> 16) | (kx_.w << 16)) : kx_.x; kr_.y = dir ? ((kx_.z >> 16) | (kx_.z << 16)) : kx_.y; kr_.z = dir ? ((kx_.y >> 16) | (kx_.y << 16)) : kx_.z; kr_.w = dir ? ((kx_.x >> 16) | (kx_.x << 16)) : kx_.w; \
                        kt_[ks] = __builtin_bit_cast(bf16x8, kr_); } \
                    GDN_BAR(); \
                      \
                    bf16x8 vsf[2][2]; \
                    _Pragma("unroll") for (int n2 = 0; n2 < 2; ++n2) { vsf[n2][0] = *(const LAS bf16x8*)(VSl + (16 * n2 + r16) * 72 + quad * 8); vsf[n2][1] = *(const LAS bf16x8*)(VSl + (16 * n2 + r16) * 72 + 32 + quad * 8); } \
                    if (role) { bf16x8 vb[2][2]; \
                        _Pragma("unroll") for (int n_ = 0; n_ < 2; ++n_) { vb[n_][0] = *(const LAS bf16x8*)(VNl + (16 * n_ + r16) * 72 + quad * 8); vb[n_][1] = *(const LAS bf16x8*)(VNl + (16 * n_ + r16) * 72 + 32 + quad * 8); } \
                        asm volatile("s_waitcnt lgkmcnt(0)" ::: "memory"); \
                        v4u af0_; af0_.x = P##Ax[0].x; af0_.y = P##Ax[0].y; af0_.z = P##Ax[1].x; af0_.w = P##Ax[1].y; v4u af1_; af1_.x = P##Ax[2].x; af1_.y = P##Ax[2].y; af1_.z = P##Ax[3].x; af1_.w = P##Ax[3].y; \
                        const bf16x8 Af0_ = __builtin_bit_cast(bf16x8, af0_), Af1_ = __builtin_bit_cast(bf16x8, af1_); \
                        _Pragma("unroll") for (int n_ = 0; n_ < 2; ++n_) { f32x4 oa = __builtin_amdgcn_mfma_f32_16x16x32_bf16(Af0_, vb[n_][0], x1[n_], 0, 0, 0); oa = __builtin_amdgcn_mfma_f32_16x16x32_bf16(Af1_, vb[n_][1], oa, 0, 0, 0); \
                            LAS bf16* ot_ = OTl + (16 * mt + quad * 4) * 36 + 16 * n_ + r16; \
                            _Pragma("unroll") for (int j = 0; j < 4; ++j) ot_[j * 36] = (bf16)f2bf(oa[j]); } } \
                    else { asm volatile("s_waitcnt lgkmcnt(0)" ::: "memory"); } \
                    _Pragma("unroll") for (int n2 = 0; n2 < 2; ++n2) { \
                        f32x4 sa = Sacc[n2] * P##egl; sa = __builtin_amdgcn_mfma_f32_16x16x32_bf16(kt_[0], vsf[n2][0], sa, 0, 0, 0); sa = __builtin_amdgcn_mfma_f32_16x16x32_bf16(kt_[1], vsf[n2][1], sa, 0, 0, 0); Sacc[n2] = sa; \
                        v2u p; p.x = pk2(sa[0], sa[1]); p.y = pk2(sa[2], sa[3]); *(LAS v2u*)(STl + (16 * n2 + r16) * 136 + 16 * w + quad * 4) = p; } \
                    GDN_BAR(); \
                      \
                    { const int tk_ = 8 * w + (lane >> 3), pc_ = lane & 7; const v2u ov_ = *(const LAS v2u*)(OTl + tk_ * 36 + 4 * pc_); \
                      *(v2u*)(O + (size_t)(row0 + (dir ? 63 - tk_ : tk_)) * 512 + hh * 128 + slice * 32 + 4 * pc_) = ov_; } } while (0)
#define GDN_DECL(P) bf16x8 P##Xf[4]; v4u P##Kx[2]; v2u P##Ax[4]; f32x4 P##sc4; float P##egl
                GDN_DECL(sa_); GDN_DECL(sb_);
                GDN_LOAD(sa_, 0);
                *(v2u*)(ws + WS_END + ((size_t)X.bid * 512 + tid) * 8) = (v2u){0u, 0u};
                for (int step = 0; step < 36; step += 2) {
                    GDN_LOAD(sb_, step + 1); GDN_STEP(sa_, step);
                    { const int s2 = step + 2 < 36 ? step + 2 : 35; GDN_LOAD(sa_, s2); } GDN_STEP(sb_, step + 1);
                }
#undef GDN_STEP
#undef GDN_BAR
#undef GDN_DECL
#undef GDN_LOAD
            }
        } }
        SEAM(pb + 4);

        for (int rep_ = 0; rep_ <= (int)PH_REP(6); ++rep_) { if (rep_) GRID_BAR();
        if (PH_ON(6) && IN(pb + 5)) { PH_BEGIN(); const float* mv = modv + (size_t)l * 9 * 6144; (void)mv; unsigned* const moecnt = ctl + CW_MOE + l * 16 * 64; (void)moecnt;
            const float* nw = INP(I_GNORM) + l * 128; const int ch = 8 * lane;
            const f32x4 nw0 = *(const f32x4*)(nw + (ch & 127)), nw1 = *(const f32x4*)(nw + (ch & 127) + 4);
            constexpr int ERT = 9;
            for (int rowb = gw; rowb < nrows2; rowb += ERT * NGW) {
                v4u lf[ERT], lb[ERT], lz[ERT];
#pragma unroll
                for (int k = 0; k < ERT; ++k) { const int row_ = rowb + k * NGW, row = row_ < nrows2 ? row_ : nrows2 - 1; lf[k] = *(const v4u*)(OF + (size_t)row * 512 + ch); lb[k] = *(const v4u*)(OB + (size_t)row * 512 + ch); lz[k] = *(const v4u*)(PZ + (size_t)row * 512 + ch); }
#pragma unroll
                for (int k = 0; k < ERT; ++k) { const int row_ = rowb + k * NGW, row = row_ < nrows2 ? row_ : nrows2 - 1; {
                    float of[8], ob[8], z[8], o[8]; unpack8(lf[k], of); unpack8(lb[k], ob); unpack8(lz[k], z); float ss = 0.f;
#pragma unroll
                    for (int e = 0; e < 8; ++e) { of[e] += ob[e]; ss += of[e] * of[e]; }
                    const float rs = __builtin_amdgcn_rsqf(g16_sum(ss) * (1.0f / 128.0f) + LN_EPS);
#pragma unroll
                    for (int e = 0; e < 4; ++e) { o[e] = of[e] * rs * nw0[e] * z[e]; o[4 + e] = of[4 + e] * rs * nw1[e] * z[4 + e]; }
                    if (row_ < nrows2) *(v4u*)(BR + (size_t)row * 512 + ch) = pack8(o); } }
            }
        } }
        SEAM(pb + 5);

        for (int rep_ = 0; rep_ <= (int)PH_REP(7); ++rep_) { if (rep_) GRID_BAR();
        if (PH_ON(7) && IN(pb + 6)) { PH_BEGIN(); const float* mv = modv + (size_t)l * 9 * 6144; (void)mv; unsigned* const moecnt = ctl + CW_MOE + l * 16 * 64; (void)moecnt;
            SchedBranch S{X.G, X.bid, npan2, (const char*)BR, (const char*)WBR};
            EpiBf16<0> E{GT, 4096, nullptr};
            pg8::gemm_phase<EpiBf16<0>, SchedBranch, true, true>(lds, Gemm{512, 512, 512}, S, E);
        } }
        SEAM(pb + 6);

        for (int rep_ = 0; rep_ <= (int)PH_REP(8); ++rep_) { if (rep_) GRID_BAR();
        if (PH_ON(8) && IN(pb + 7)) { PH_BEGIN(); const float* mv = modv + (size_t)l * 9 * 6144; (void)mv; unsigned* const moecnt = ctl + CW_MOE + l * 16 * 64; (void)moecnt;
            SchedGrid S{X.G, X.bid, npan2, 16, (const char*)XN, (const char*)(WIN + (size_t)5120 * 1024), (size_t)256 * 1024 * 2, (size_t)256 * 1024 * 2};
            EpiGateMerge E{GT, (bf16*)MERGED, binv + 5120};
            pg8::gemm_phase<EpiGateMerge, SchedGrid, true, true>(lds, Gemm{1024, 1024, 1024}, S, E);
        } }
        SEAM(pb + 7);

        for (int rep_ = 0; rep_ <= (int)PH_REP(9); ++rep_) { if (rep_) GRID_BAR();
        if (PH_ON(9) && IN(pb + 8)) { PH_BEGIN(); const float* mv = modv + (size_t)l * 9 * 6144; (void)mv; unsigned* const moecnt = ctl + CW_MOE + l * 16 * 64; (void)moecnt;
            SchedGrid S{X.G, X.bid, npan2, 4, (const char*)MERGED, (const char*)WOUT, (size_t)256 * 1024 * 2, (size_t)256 * 1024 * 2};
            EpiBf16<0> E{(bf16*)YB, 1024, INP(I_BOUT) + l * 1024};
            pg8::gemm_phase<EpiBf16<0>, SchedGrid, true, true>(lds, Gemm{1024, 1024, 1024}, S, E);
            __syncthreads();
            { LAS float* const wscr = (LAS float*)(lds + X.wave * 8448);
              const int first = npan2 * 4 > X.G ? npan2 * 4 - X.G : 0;
              if (X.bid >= first) { const int gwc = (X.bid - first) * NWAVES + X.wave, ngwc = (X.G - first) * NWAVES;
              for (int it = gwc; it < 12288; it += ngwc) {
                if (it < 8192) { const int e = it >> 9, rb = (it & 3) + 4 * ((it >> 3) & 7), kb = ((it >> 2) & 1) + 2 * ((it >> 6) & 7), row0 = rb * 32, j = row0 >> 8, w = row0 & 255;
                    const float* src = (w < 128 ? INP(I_EWG) : INP(I_EWU)) + ((size_t)(l * 16 + e) * 1024) * 512;
                    cvt_item(src, 512, 128 * j + (w & 127) + (lane & 31), kb * 64, WGU + ((size_t)e * 1024 + row0) * 1024, 1024, wscr, lane); }
                else { const int i2 = it - 8192; const int e = i2 >> 8, rb = (i2 & 3) + 4 * ((i2 >> 3) & 7), kb = ((i2 >> 2) & 1) + 2 * ((i2 >> 6) & 3);
                    cvt_item(INP(I_EWD) + ((size_t)(l * 16 + e) * 512) * 1024, 1024, rb * 32 + (lane & 31), kb * 64, WDN + ((size_t)e * 1024 + rb * 32) * 512, 512, wscr, lane); }
              } } }
        } }
        SEAM(pb + 8);

        for (int rep_ = 0; rep_ <= (int)PH_REP(10); ++rep_) { if (rep_) GRID_BAR();
        if (PH_ON(10) && IN(pb + 9)) { PH_BEGIN(); const float* mv = modv + (size_t)l * 9 * 6144; (void)mv; unsigned* const moecnt = ctl + CW_MOE + l * 16 * 64; (void)moecnt;
            LAS float* wr_ = (LAS float*)lds;
            volatile LAS unsigned* lcnt = (volatile LAS unsigned*)(lds + 100352);
            __syncthreads();
            if (tid < 32) lcnt[tid] = 0u;
            { f32x4 rq[10];
#pragma unroll
              for (int j = 0; j < 2; ++j) rq[j] = *(const f32x4*)(INP(I_RGW) + (size_t)l * 4096 + (size_t)(tid + 512 * j) * 4);
#pragma unroll
              for (int j = 0; j < 8; ++j) rq[2 + j] = *(const f32x4*)(INP(I_REW) + (size_t)l * 16384 + (size_t)(tid + 512 * (j & 1)) * 16 + 4 * (j >> 1));
#pragma unroll
              for (int j = 0; j < 2; ++j) { LAS float* p = wr_ + tid + 512 * j; p[0] = rq[j][0]; p[1024] = rq[j][1]; p[2048] = rq[j][2]; p[3072] = rq[j][3]; }
#pragma unroll
              for (int j = 0; j < 8; ++j) { LAS float* p = wr_ + (4 + 4 * (j >> 1)) * 1024 + tid + 512 * (j & 1); p[0] = rq[2 + j][0]; p[1024] = rq[2 + j][1]; p[2048] = rq[2 + j][2]; p[3072] = rq[2 + j][3]; } }
            __syncthreads();
            const float* g1 = INP(I_LN1G) + l * 1024, *b1 = INP(I_LN1B) + l * 1024;
            const float rgb_l = INP(I_RGB)[l * 4 + ((lane >> 4) & 3)], reb_l = INP(I_REB)[l * 16 + ((lane >> 2) & 15)];
            constexpr int RT = 2;
            for (int rowb = gw; rowb < nrows2; rowb += RT * NGW) {
                f32x4 v[RT][4];
#pragma unroll
                for (int q = 0; q < RT; ++q) { const int row_ = rowb + q * NGW, row = row_ < nrows2 ? row_ : nrows2 - 1; const bool live = row_ < nrows2;
                    float* hrow = row < NLAT ? hlat + (size_t)row * D : hctx + (size_t)(row - NLAT) * D;
                    const int mi = row < NLAT ? (row >> 11) : 8; const float* mrow = mv + mi * 6144;
                    v2u yw[4]; f32x4 hv[4], gt[4], g1v[4], b1v[4], scv[4], shv[4];
#pragma unroll
                    for (int j = 0; j < 4; ++j) { const int c = 4 * lane + 256 * j; yw[j] = *(const v2u*)((const bf16*)YB + (size_t)row * D + c); hv[j] = *(const f32x4*)(hrow + c); gt[j] = *(const f32x4*)(mrow + 2048 + c); }
#pragma unroll
                    for (int j = 0; j < 4; ++j) { const int c = 4 * lane + 256 * j; g1v[j] = *(const f32x4*)(g1 + c); b1v[j] = *(const f32x4*)(b1 + c); scv[j] = *(const f32x4*)(mrow + 4096 + c); shv[j] = *(const f32x4*)(mrow + 3072 + c); }
#pragma unroll
                    for (int j = 0; j < 4; ++j) { const f32x4 yv = (f32x4){bflo(yw[j].x), bfhi(yw[j].x), bflo(yw[j].y), bfhi(yw[j].y)}; v[q][j] = hv[j] * DN_ALPHA + gt[j] * yv; }
                    ln_rows(v[q]);
#pragma unroll
                    for (int j = 0; j < 4; ++j) { const int c = 4 * lane + 256 * j; v[q][j] = v[q][j] * g1v[j] + b1v[j]; if (live) *(f32x4*)(hrow + c) = v[q][j]; }
                    ln_rows(v[q]);
#pragma unroll
                    for (int j = 0; j < 4; ++j) { const int c = 4 * lane + 256 * j; v[q][j] = v[q][j] * (scv[j] + 1.0f) + shv[j];
                        v2u w; w.x = pk2(v[q][j][0], v[q][j][1]); w.y = pk2(v[q][j][2], v[q][j][3]); if (live) *(v2u*)(XN + (size_t)row * D + c) = w; }
                    asm volatile("" ::: "memory"); }
                static_assert(RT == 2, "the two rows of a trip ride in the two halves of packed f32 operations");
                float pg[RT][4], pe[RT][16];
                { f32x2 vp[4][4];
#pragma unroll
                  for (int j = 0; j < 4; ++j)
#pragma unroll
                      for (int e = 0; e < 4; ++e) vp[j][e] = (f32x2){v[0][j][e], v[1][j][e]};
#pragma unroll
                  for (int o = 0; o < 20; ++o) { f32x2 sr = (f32x2){0.f, 0.f};
#pragma unroll
                    for (int j = 0; j < 4; ++j) { const f32x4 w = *(const LAS f32x4*)(wr_ + o * 1024 + 4 * lane + 256 * j);
#pragma unroll
                        for (int e = 0; e < 4; ++e) sr += vp[j][e] * w[e]; }
                    if (o < 4) { pg[0][o] = sr[0]; pg[1][o] = sr[1]; } else { pe[0][o - 4] = sr[0]; pe[1][o - 4] = sr[1]; }
                    if ((o & 3) == 3) asm volatile("" ::: "memory"); } }
#pragma unroll
                for (int q = 0; q < RT; ++q) { const int row = rowb + q * NGW;
                float tg = reduce4(pg[q], lane), te = reduce16(pe[q], lane);
                tg += rgb_l; te += reb_l;
                float lg[20];
#pragma unroll
                for (int o = 0; o < 4; ++o) lg[o] = __shfl(tg, o * 16);
#pragma unroll
                for (int o = 0; o < 16; ++o) lg[4 + o] = __shfl(te, o * 4);
                int gs = 0; float gm = lg[0];
#pragma unroll
                for (int o = 1; o < 4; ++o) if (lg[o] > gm) { gm = lg[o]; gs = o; }
                float den = 0.f;
#pragma unroll
                for (int o = 0; o < 4; ++o) den += __expf(lg[o] - gm);
                const float gp = __builtin_amdgcn_rcpf(den);
                float el[4];
#pragma unroll
                for (int o = 0; o < 4; ++o) el[o] = gs == 0 ? lg[4 + o] : gs == 1 ? lg[8 + o] : gs == 2 ? lg[12 + o] : lg[16 + o];
                int i0 = 0; float v0 = el[0];
#pragma unroll
                for (int o = 1; o < 4; ++o) if (el[o] > v0) { v0 = el[o]; i0 = o; }
                int i1 = -1; float v1 = 0.f;
#pragma unroll
                for (int o = 0; o < 4; ++o) if (o != i0 && (i1 < 0 || el[o] > v1)) { v1 = el[o]; i1 = o; }
                const float ex = __expf(v1 - v0), rz = __builtin_amdgcn_rcpf(1.0f + ex), w0 = gp * rz, w1 = gp * ex * rz;
                const int e0 = gs * 4 + i0, e1 = gs * 4 + i1;
                if (lane == 0 && row < nrows2) {
                    const unsigned p0 = __hip_atomic_fetch_add((LAS unsigned*)lcnt + e0, 1u, __ATOMIC_RELAXED, __HIP_MEMORY_SCOPE_WORKGROUP);
                    const unsigned p1 = __hip_atomic_fetch_add((LAS unsigned*)lcnt + e1, 1u, __ATOMIC_RELAXED, __HIP_MEMORY_SCOPE_WORKGROUP);
                    float* rt = ROUTE + (size_t)row * 8;
                    rt[0] = __builtin_bit_cast(float, e0); rt[1] = __builtin_bit_cast(float, e1); rt[2] = w0; rt[3] = w1; rt[4] = __builtin_bit_cast(float, (int)p0); rt[5] = __builtin_bit_cast(float, (int)p1);
                }
                asm volatile("" ::: "memory"); }
            }
            __syncthreads();
            if (tid < 16) { const unsigned c = lcnt[tid]; lcnt[16 + tid] = c ? __hip_atomic_fetch_add(moecnt + 64 * tid, c, __ATOMIC_RELAXED, __HIP_MEMORY_SCOPE_AGENT) : 0u; }
            __syncthreads();
            for (int row = gw + lane * NGW; row < nrows2; row += 64 * NGW) {
                { float* rt = ROUTE + (size_t)row * 8; const int e0 = __builtin_bit_cast(int, rt[0]), e1 = __builtin_bit_cast(int, rt[1]);
                    const int q0 = __builtin_bit_cast(int, rt[4]) + (int)lcnt[16 + e0], q1 = __builtin_bit_cast(int, rt[5]) + (int)lcnt[16 + e1];
                    rt[4] = __builtin_bit_cast(float, q0); rt[5] = __builtin_bit_cast(float, q1);
                    ELIST[(size_t)e0 * NTOK + q0] = row; ELIST[(size_t)e1 * NTOK + q1] = row; }
            }
        } }
        SEAM(pb + 9);


        for (int rep_ = 0; rep_ <= (int)PH_REP(12); ++rep_) { if (rep_) GRID_BAR();
        if (PH_ON(12) && IN(pb + 11)) { PH_BEGIN(); const float* mv = modv + (size_t)l * 9 * 6144; (void)mv; unsigned* const moecnt = ctl + CW_MOE + l * 16 * 64; (void)moecnt;
            SchedMoeG S; S.G = X.G; S.c = X.bid; S.a0 = (const char*)XN; S.w0 = (const char*)WGU; S.wstep_e = (size_t)1024 * 1024 * 2; S.wstep_n = (size_t)256 * 1024 * 2; S.list = ELIST; S.init(moecnt, (LAS unsigned*)(lds + LDSCTL_OFF + 64));
            EpiMoe1 E{HID};
            pg8::gemm_phase<EpiMoe1, SchedMoeG, true, true>(lds, Gemm{1024, 1024, 1024}, S, E);
        } }
        SEAM(pb + 11);

        for (int rep_ = 0; rep_ <= (int)PH_REP(13); ++rep_) { if (rep_) GRID_BAR();
        if (PH_ON(13) && IN(pb + 12)) { PH_BEGIN(); const float* mv = modv + (size_t)l * 9 * 6144; (void)mv; unsigned* const moecnt = ctl + CW_MOE + l * 16 * 64; (void)moecnt;
            SchedMoe S; S.G = X.G; S.c = X.bid; S.a0 = (const char*)HID; S.w0 = (const char*)WDN; S.astep = (size_t)256 * 512 * 2; S.wstep_e = (size_t)1024 * 512 * 2; S.wstep_n = (size_t)256 * 512 * 2; S.init(moecnt);
            EpiBf16<0> E{MO, 1024, nullptr};
            pg8::gemm_phase<EpiBf16<0>, SchedMoe, true, true>(lds, Gemm{512, 512, 512}, S, E);
        } }
        SEAM(pb + 12);

        for (int rep_ = 0; rep_ <= (int)PH_REP(14); ++rep_) { if (rep_) GRID_BAR();
        if (PH_ON(14) && IN(pb + 13)) { PH_BEGIN(); const float* mv = modv + (size_t)l * 9 * 6144; (void)mv; unsigned* const moecnt = ctl + CW_MOE + l * 16 * 64; (void)moecnt;
            unsigned pre[16]; { unsigned s = 0;
#pragma unroll
                for (int e = 0; e < 16; ++e) { pre[e] = s; s += ((__hip_atomic_load(moecnt + 64 * e, __ATOMIC_RELAXED, __HIP_MEMORY_SCOPE_AGENT) + 255u) >> 8) << 8; } }
            const float* g2 = INP(I_LN2G) + l * 1024, *b2 = INP(I_LN2B) + l * 1024;
            for (int rowb = gw; rowb < nrows2; rowb += 3 * NGW) {
                int re0[3], re1[3], rp0[3], rp1[3]; float rw0[3], rw1[3];
#pragma unroll
                for (int k = 0; k < 3; ++k) { const int row_ = rowb + k * NGW, row = row_ < nrows2 ? row_ : nrows2 - 1; const float* rt = ROUTE + (size_t)row * 8;
                    re0[k] = __builtin_bit_cast(int, rt[0]); re1[k] = __builtin_bit_cast(int, rt[1]); rw0[k] = rt[2]; rw1[k] = rt[3]; rp0[k] = __builtin_bit_cast(int, rt[4]); rp1[k] = __builtin_bit_cast(int, rt[5]); }
                v2u ma[3][4], mb[3][4]; f32x4 hv[3][4];
#pragma unroll
                for (int k = 0; k < 3; ++k) { const int row_ = rowb + k * NGW, row = row_ < nrows2 ? row_ : nrows2 - 1; {
                    const int e0 = re0[k], e1 = re1[k]; unsigned ba0 = 0, ba1 = 0;
#pragma unroll
                    for (int q = 0; q < 16; ++q) { ba0 = (q == e0) ? pre[q] : ba0; ba1 = (q == e1) ? pre[q] : ba1; }
                    const bf16* m0 = MO + (size_t)(ba0 + (unsigned)rp0[k]) * D, *m1 = MO + (size_t)(ba1 + (unsigned)rp1[k]) * D;
                    const float* hrow = row < NLAT ? hlat + (size_t)row * D : hctx + (size_t)(row - NLAT) * D;
#pragma unroll
                    for (int j = 0; j < 4; ++j) { const int c = 4 * lane + 256 * j; ma[k][j] = *(const v2u*)(m0 + c); mb[k][j] = *(const v2u*)(m1 + c); hv[k][j] = *(const f32x4*)(hrow + c); } } }
#pragma unroll
                for (int k = 0; k < 3; ++k) { const int row_ = rowb + k * NGW, row = row_ < nrows2 ? row_ : nrows2 - 1; {
                    float* hrow = row < NLAT ? hlat + (size_t)row * D : hctx + (size_t)(row - NLAT) * D;
                    const int mi = row < NLAT ? (row >> 11) : 8; const float* mrow = mv + mi * 6144; const float w0 = rw0[k], w1 = rw1[k];
                    f32x4 v[4], gtv[4], g2v[4], b2v[4];
#pragma unroll
                    for (int j = 0; j < 4; ++j) { const int c = 4 * lane + 256 * j; gtv[j] = *(const f32x4*)(mrow + 5120 + c); g2v[j] = *(const f32x4*)(g2 + c); b2v[j] = *(const f32x4*)(b2 + c); }
#pragma unroll
                    for (int j = 0; j < 4; ++j) { const v2u a = ma[k][j], b = mb[k][j];
                        f32x4 mm; mm[0] = w0 * bflo(a.x) + w1 * bflo(b.x); mm[1] = w0 * bfhi(a.x) + w1 * bfhi(b.x); mm[2] = w0 * bflo(a.y) + w1 * bflo(b.y); mm[3] = w0 * bfhi(a.y) + w1 * bfhi(b.y);
                        v[j] = hv[k][j] * DN_ALPHA + gtv[j] * mm; }
                    ln_rows(v);
                    if (row_ < nrows2) {
#pragma unroll
                    for (int j = 0; j < 4; ++j) { const int c = 4 * lane + 256 * j; *(f32x4*)(hrow + c) = v[j] * g2v[j] + b2v[j]; } } } }
            }
        } }
        SEAM(pb + 13);
    }
#if TPROBE
    {
        GRID_BAR(); STAMP(NPHASES); GRID_BAR();
        unsigned* ts = (unsigned*)(args.ws + WS_CTL) + CW_TS; float T = 0.f;
        for (int l2 = 0; l2 < 2; ++l2) { const int p = (TPA) == 100 ? 0 : 1 + NPH_LAYER * l2 + (TPA);
            if ((TPA) != 100 || l2 == 0) T += (float)(__hip_atomic_load(ts + p + 1, __ATOMIC_RELAXED, __HIP_MEMORY_SCOPE_AGENT) - __hip_atomic_load(ts + p, __ATOMIC_RELAXED, __HIP_MEMORY_SCOPE_AGENT)) * 0.01f; }
        for (size_t i = (size_t)blockIdx.x * 512 + threadIdx.x; i < (size_t)NLAT * D; i += (size_t)gridDim.x * 512) { const int j = (int)(i >> 19);
            if (T >= (float)(TOFF) + 20.0f * (float)(j + 1)) args.out[i] += 0.2f; }
    }
#endif
#undef IN
#undef SEAM
}

extern "C" void kernel_launch(void* const* d_in, const int* in_sizes, int n_in, void* d_out, int out_size, void* d_ws, size_t ws_size, hipStream_t stream) {
    static int grid = 0;
    if (grid == 0) {
        if (n_in != 34 || out_size != NLAT * D || ws_size < WS_END + MiB) { fprintf(stderr, "kernel_launch: unexpected problem (n_in %d out %d ws %zu)\n", n_in, out_size, ws_size); grid = -1; return; }
        int dev = 0, cus = 0, per_cu = 0;
        if (hipGetDevice(&dev) != hipSuccess || hipDeviceGetAttribute(&cus, hipDeviceAttributeMultiprocessorCount, dev) != hipSuccess) { grid = -1; return; }
        if (hipFuncSetAttribute((const void*)fwd, hipFuncAttributeMaxDynamicSharedMemorySize, LDS_BYTES) != hipSuccess) { fprintf(stderr, "kernel_launch: hipFuncSetAttribute failed\n"); grid = -1; return; }
        if (hipOccupancyMaxActiveBlocksPerMultiprocessor(&per_cu, (const void*)fwd, NWAVES * 64, LDS_BYTES) != hipSuccess || per_cu < 1) { fprintf(stderr, "kernel_launch: occupancy query reports %d\n", per_cu); }
        (void)hipGetLastError();
        grid = cus;
    }
    if (grid < 0) return;
    if (hipMemsetAsync((char*)d_ws + WS_CTL, 0, CTL_ZERO_BYTES, stream) != hipSuccess) return;
    Args a{};
    for (int i = 0; i < 34; ++i) a.in[i] = (const float*)d_in[i];
    a.out = (float*)d_out; a.ws = (unsigned char*)d_ws;
#if MK_ONE_LAUNCH
    a.ph_lo = 0; a.ph_hi = NPHASES;
    hipLaunchKernelGGL(fwd, dim3(grid), dim3(NWAVES * 64), LDS_BYTES, stream, a);
#else
    for (int p = 0; p < NPHASES; ++p) { a.ph_lo = p; a.ph_hi = p + 1; hipLaunchKernelGGL(fwd, dim3(grid), dim3(NWAVES * 64), LDS_BYTES, stream, a); }
#endif
}
```

```cpp
#include <hip/hip_runtime.h>
#include <cstdio>
#include <cstdint>

#define GAS __attribute__((address_space(1)))
#define LAS __attribute__((address_space(3)))
typedef unsigned short bf16;
typedef unsigned v4u __attribute__((ext_vector_type(4)));
typedef unsigned v2u __attribute__((ext_vector_type(2)));
typedef float f32x4 __attribute__((ext_vector_type(4)));
typedef float f32x2 __attribute__((ext_vector_type(2)));
typedef short bf16x8 __attribute__((ext_vector_type(8)));

constexpr int D = 1024, NB = 8, SEQ = 2048, CTXL = 256, NLAT = NB * SEQ, NCTX = NB * CTXL, NTOK = NLAT + NCTX;
constexpr int OFF_Q = 0, OFF_K = 512, OFF_V = 1024, OFF_Z = 1536, OFF_A = 2048, OFF_B = 2056, OFF_CONF = 2064, OFF_FFT = 3088, OFF_SGU = 3600, OFF_GATE = 4624, N_IN = 8720;
constexpr int NWROWS = 9216;
constexpr float LN_EPS = 1e-6f;
constexpr float DN_ALPHA = 1.4142135623730951f;
constexpr int NWAVES = 8;
constexpr int NPH_LAYER = 14, NPHASES = 1 + 2 * NPH_LAYER;

#ifndef PHMASK
#define PHMASK 0xFFFFFFFFu
#endif
#define PH_ON(k) (((PHMASK) >> (k)) & 1u)
#ifndef REPMASK
#define REPMASK 0u
#endif
#define PH_REP(k) (((REPMASK) >> (k)) & 1u)
#ifndef TPA
#define TPA -1
#endif
#ifndef TPB
#define TPB -1
#endif
#ifndef TOFF
#define TOFF 0
#endif
#define TPROBE ((TPA) >= 0 || (TPB) >= 0)
#ifndef CPART
#define CPART 15
#endif
#ifndef MK_ONE_LAUNCH
#define MK_ONE_LAUNCH 1
#endif

constexpr size_t MiB = 1u << 20;
constexpr size_t WS_CTL = 0, CTL_ZERO_BYTES = 128 * 1024;
constexpr size_t WS_MODV = 1 * MiB;
constexpr size_t WS_BIN = 1 * MiB + 512 * 1024;
constexpr size_t WS_ROUTE = WS_BIN + 64 * 1024;
constexpr size_t WS_HCTX = 3 * MiB;
constexpr size_t WS_XN = 11 * MiB;
constexpr size_t WS_WIN = 47 * MiB;
constexpr size_t WS_WBR = 65 * MiB;
constexpr size_t WS_WOUT = 69 * MiB;
constexpr size_t WS_DFTL = 71 * MiB;
constexpr size_t WS_DFTC = 87 * MiB;
constexpr size_t WS_F1B = 71 * MiB;
constexpr size_t WS_R2 = 88 * MiB;
constexpr size_t WS_PQKV = WS_R2;
constexpr size_t WS_PCONF = WS_R2 + 54 * MiB;
constexpr size_t WS_PZ = WS_R2 + 72 * MiB;
constexpr size_t WS_PSGU = WS_R2 + 90 * MiB;
constexpr size_t WS_PFFT = WS_R2 + 126 * MiB;
constexpr size_t WS_PFFTC = WS_R2 + 158 * MiB;
constexpr size_t WS_AB = WS_R2 + 162 * MiB;
constexpr size_t WS_WIT = WS_R2;
constexpr size_t WS_UIT = WS_R2 + 36 * MiB;
constexpr size_t WS_AIT = WS_R2 + 90 * MiB;
constexpr size_t WS_KIT = WS_R2 + 108 * MiB;
constexpr size_t WS_SIT = WS_R2 + 126 * MiB;
constexpr size_t WS_OF = WS_R2 + 128 * MiB;
constexpr size_t WS_OB = WS_R2 + 146 * MiB;
constexpr size_t WS_G = WS_R2;
constexpr size_t WS_WGU = WS_R2;
constexpr size_t WS_WDN = WS_R2 + 32 * MiB;
constexpr size_t WS_XG = WS_R2 + 48 * MiB;
constexpr size_t WS_R3 = WS_R2 + 164 * MiB;
constexpr size_t WS_QKV = WS_R3;
constexpr size_t WS_GB = WS_R3 + 54 * MiB;
constexpr size_t WS_BR = WS_R3 + 72 * MiB;
constexpr size_t WS_F1A = WS_BR;
constexpr size_t WS_MERGED = WS_R3;
constexpr size_t WS_Y = WS_R3 + 72 * MiB;
constexpr size_t WS_HID = WS_R3;
constexpr size_t WS_MO = WS_R3 + 40 * MiB;
constexpr size_t WS_LIST = WS_R3 + 144 * MiB;
constexpr size_t WS_END = WS_LIST + 2 * MiB;
static_assert(WS_END <= 405 * MiB, "workspace map");
constexpr int CW_BAR = 4096;
constexpr int CW_MOE = 16384;

constexpr int RING_BYTES = 131072;
constexpr int LDSCTL_OFF = RING_BYTES, MISC_OFF = LDSCTL_OFF + 320;
constexpr int LDS_BYTES = 147456;

#define LDS_WAIT() asm volatile("s_waitcnt lgkmcnt(0)" ::: "memory")
#define VM_WAIT() asm volatile("s_waitcnt vmcnt(0)" ::: "memory")
typedef __bf16 bf16x2_t __attribute__((ext_vector_type(2)));
__device__ __forceinline__ unsigned pk2(float lo, float hi) { const f32x2 v = {lo, hi}; const bf16x2_t b = __builtin_convertvector(v, bf16x2_t); return __builtin_bit_cast(unsigned, b); }
__device__ __forceinline__ unsigned f2bf(float f) { return pk2(f, 0.0f) & 0xffffu; }
__device__ __forceinline__ float bflo(unsigned w) { return __builtin_bit_cast(float, w << 16); }
__device__ __forceinline__ float bfhi(unsigned w) { return __builtin_bit_cast(float, w & 0xffff0000u); }
__device__ __forceinline__ float bf1(bf16 b) { return __builtin_bit_cast(float, ((unsigned)b) << 16); }
__device__ __forceinline__ void unpack8(const v4u w, float (&o)[8]) { o[0] = bflo(w.x); o[1] = bfhi(w.x); o[2] = bflo(w.y); o[3] = bfhi(w.y); o[4] = bflo(w.z); o[5] = bfhi(w.z); o[6] = bflo(w.w); o[7] = bfhi(w.w); }
__device__ __forceinline__ v4u pack8(const float (&o)[8]) { v4u w; w.x = pk2(o[0], o[1]); w.y = pk2(o[2], o[3]); w.z = pk2(o[4], o[5]); w.w = pk2(o[6], o[7]); return w; }
__device__ __forceinline__ void fsincospi(float x, float* sn, float* cs) { *sn = __builtin_amdgcn_sinf(0.5f * x); *cs = __builtin_amdgcn_cosf(0.5f * x); }
__device__ __forceinline__ float sigmoidf_(float x) { return __builtin_amdgcn_rcpf(1.0f + __expf(-x)); }
__device__ __forceinline__ float siluf_(float x) { return x * __builtin_amdgcn_rcpf(1.0f + __expf(-x)); }
__device__ __forceinline__ float gelu_tanh(float x) { const float u = 0.7978845608028654f * (x + 0.044715f * x * x * x); return x * __builtin_amdgcn_rcpf(1.0f + __expf(-2.0f * u)); }
__device__ __forceinline__ float wave_sum(float v) {
#pragma unroll
    for (int o = 1; o < 64; o <<= 1) v += __shfl_xor(v, o);
    return v;
}
__device__ __forceinline__ float reduce16(const float (&v)[16], int lane) {
    const bool b5 = (lane & 32) != 0, b4 = (lane & 16) != 0, b3 = (lane & 8) != 0, b2 = (lane & 4) != 0;
    float a[8], b[4], c[2];
#pragma unroll
    for (int i = 0; i < 8; ++i) a[i] = (b5 ? v[i + 8] : v[i]) + __shfl_xor(b5 ? v[i] : v[i + 8], 32);
#pragma unroll
    for (int i = 0; i < 4; ++i) b[i] = (b4 ? a[i + 4] : a[i]) + __shfl_xor(b4 ? a[i] : a[i + 4], 16);
#pragma unroll
    for (int i = 0; i < 2; ++i) c[i] = (b3 ? b[i + 2] : b[i]) + __shfl_xor(b3 ? b[i] : b[i + 2], 8);
    float d = (b2 ? c[1] : c[0]) + __shfl_xor(b2 ? c[0] : c[1], 4);
    d += __shfl_xor(d, 2); d += __shfl_xor(d, 1);
    return d;
}
__device__ __forceinline__ float reduce4(const float (&v)[4], int lane) {
    const bool b5 = (lane & 32) != 0, b4 = (lane & 16) != 0; float a[2];
#pragma unroll
    for (int i = 0; i < 2; ++i) a[i] = (b5 ? v[i + 2] : v[i]) + __shfl_xor(b5 ? v[i] : v[i + 2], 32);
    float d = (b4 ? a[1] : a[0]) + __shfl_xor(b4 ? a[0] : a[1], 16);
    d += __shfl_xor(d, 8); d += __shfl_xor(d, 4); d += __shfl_xor(d, 2); d += __shfl_xor(d, 1);
    return d;
}
__device__ __forceinline__ float g16_sum(float v) {
#pragma unroll
    for (int o = 1; o < 16; o <<= 1) v += __shfl_xor(v, o);
    return v;
}

namespace pg8 {
constexpr int BM = 256, BK = 64, HALF = 128, HTB = HALF * BK * 2, STAGE_BYTES = 8 * HTB;
__host__ __device__ __forceinline__ int lds_byte(int r, int c) { const int st = (r >> 4) * 2 + (c >> 5), rr = r & 15, cc = c & 31, ob = rr * 64 + cc * 2; return st * 1024 + (ob ^ (((ob >> 9) & 1) << 5)); }
__host__ __device__ __forceinline__ void stage_rc(int b, int& R, int& C) { const int st = b / 1024, sb = b % 1024, swz = sb ^ (((sb >> 9) & 1) << 5); R = (st >> 1) * 16 + swz / 64; C = (st & 1) * 32 + (swz % 64) / 2; }
__host__ __device__ __forceinline__ int perm32(int rho) { const int n = rho >> 4, i = rho & 15; return 8 * (i >> 2) + 4 * n + (i & 3); }

struct Unit { int pm, pn, aux, ax2; const char* a; const char* b; };
struct Gemm { int K, lda, ldb; };

__device__ __forceinline__ void map_tile(int L, int nM, int nN, int& pm, int& pn) {
    const int nwg = nM * nN; int wgid = L; { const int q = nwg / 8, r = nwg % 8, xcd = wgid % 8, off = wgid / 8; wgid = (xcd < r ? xcd * (q + 1) : r * (q + 1) + (xcd - r) * q) + off; }
    const int nig = 8 * nN, gid = wgid / nig, fm = gid * 8, gsz = (nM - fm) < 8 ? (nM - fm) : 8;
    pm = fm + ((wgid % nig) % gsz); pn = (wgid % nig) / gsz;
}
__device__ __forceinline__ unsigned cvt_pk_bf16(float lo, float hi) { unsigned r; asm volatile("v_cvt_pk_bf16_f32 %0, %1, %2" : "=v"(r) : "v"(lo), "v"(hi)); return r; }

template <class Epi, class Sched, bool ALIGN_EPI, bool SP2>
__device__ __forceinline__ void gemm_phase(LAS unsigned char* lds, const Gemm g, const Sched& S, const Epi& E) {
    int tid_l = threadIdx.x; asm volatile("" : "+v"(tid_l));
    const int tid = tid_l, wid = __builtin_amdgcn_readfirstlane(tid >> 6), lane = tid & 63, wr = wid >> 2, wc = wid & 3, fr = lane & 15, fq = lane >> 4;
    const int K = g.K, nt = K / BK;
    unsigned voffA[2], voffB[2];
#pragma unroll
    for (int i = 0; i < 2; ++i) { int R, C; stage_rc(tid * 16 + i * 8192, R, C); const int Rb = Epi::PERM ? ((R & ~31) + perm32(R & 31)) : R;
        voffA[i] = (unsigned)(R * g.lda + C) * 2u; voffB[i] = (unsigned)(Rb * g.ldb + C) * 2u; }
    static_assert(!Sched::GATHER || SP2, "gathered A rows: only the SP2 loop");
    unsigned vA[2][2], vAn[2][2];
#define PG8_GCALC(dst, u_) do { _Pragma("unroll") for (int i_ = 0; i_ < 2; ++i_) { int R_, C_; stage_rc(tid * 16 + i_ * 8192, R_, C_); _Pragma("unroll") for (int h_ = 0; h_ < 2; ++h_) dst[h_][i_] = S.arow(u_, R_ + 128 * h_) + (unsigned)C_ * 2u; } } while (0)
#define PG8_STAGE_A(bufoff, base, h, nextsel) do { if constexpr (Sched::GATHER) { unsigned vs_[2]; vs_[0] = (nextsel) ? vAn[h][0] : vA[h][0]; vs_[1] = (nextsel) ? vAn[h][1] : vA[h][1]; PG8_STAGE(bufoff, base, vs_); } \
        else { PG8_STAGE(bufoff, (base) + (h) * hstepA, voffA); } } while (0)
    const size_t kstep = (size_t)(BK * 2);
    const size_t hstepA = (size_t)HALF * g.lda * 2, hstepB = (size_t)HALF * g.ldb * 2;
    const unsigned ldsw = (unsigned)wid * 1024u;
    const int aoff = lds_byte(wr * 64 + fr, fq * 8), boff = lds_byte(wc * 32 + fr, fq * 8);
#define PG8_SA(b, h) (((b) * 2 + (h)) * HTB)
#define PG8_SB(b, h) ((4 + (b) * 2 + (h)) * HTB)
#define PG8_STAGE(bufoff, gbase, voff) do { _Pragma("unroll") for (int _i = 0; _i < 2; ++_i) \
        __builtin_amdgcn_global_load_lds((const unsigned*)((const char*)(gbase) + (voff)[_i]), (LAS unsigned*)(lds + (bufoff) + ldsw + _i * 8192), 16, 0, 0); } while (0)
#define PG8_LDA(dst, b, h) do { _Pragma("unroll") for (int m = 0; m < 4; ++m) _Pragma("unroll") for (int k = 0; k < 2; ++k) dst[m][k] = *(const LAS bf16x8*)(lds + PG8_SA(b, h) + aoff + m * 2048 + k * 1024); } while (0)
#define PG8_LDB(dst, b, h) do { _Pragma("unroll") for (int n = 0; n < 2; ++n) _Pragma("unroll") for (int k = 0; k < 2; ++k) dst[n][k] = *(const LAS bf16x8*)(lds + PG8_SB(b, h) + boff + n * 2048 + k * 1024); } while (0)
#define PG8_MMA(ai, bj, At, Bt) do { __builtin_amdgcn_s_setprio(1); _Pragma("unroll") for (int m = 0; m < 4; ++m) _Pragma("unroll") for (int n = 0; n < 2; ++n) _Pragma("unroll") for (int k = 0; k < 2; ++k) \
        acc[ai][bj][m][n] = __builtin_amdgcn_mfma_f32_16x16x32_bf16(Bt[n][k], At[m][k], acc[ai][bj][m][n], 0, 0, 0); __builtin_amdgcn_s_setprio(0); } while (0)
#define PG8_WAIT_V(n) asm volatile("s_waitcnt vmcnt(" #n ")" ::: "memory")
#define PG8_WAIT_L(n) asm volatile("s_waitcnt lgkmcnt(" #n ")" ::: "memory")
#define PG8_BAR __builtin_amdgcn_s_barrier()
#define PG8_SCHED __builtin_amdgcn_sched_barrier(0)
    Unit cur, nxt; int ui = 0;
    if (!S.next(0, cur)) return;
    f32x4 acc[2][2][4][2];
#pragma unroll
    for (int a = 0; a < 2; ++a)
#pragma unroll
        for (int b = 0; b < 2; ++b)
#pragma unroll
            for (int m = 0; m < 4; ++m)
#pragma unroll
                for (int n = 0; n < 2; ++n) acc[a][b][m][n] = (f32x4){0.f, 0.f, 0.f, 0.f};
    bf16x8 At[4][2], B0[2][2], B1[2][2];
    const char* cA = cur.a; const char* cB = cur.b;
    if constexpr (SP2) {
        if constexpr (Sched::GATHER) { PG8_GCALC(vA, cur); }
        PG8_STAGE(PG8_SB(0, 0), cB, voffB); PG8_STAGE(PG8_SB(0, 1), cB + hstepB, voffB); PG8_STAGE_A(PG8_SA(0, 0), cA, 0, false); PG8_STAGE_A(PG8_SA(0, 1), cA, 1, false);
        if (wr == 1) PG8_BAR;
        PG8_WAIT_V(2); PG8_BAR;
        PG8_STAGE(PG8_SB(1, 0), cB + kstep, voffB); PG8_STAGE_A(PG8_SA(1, 0), cA + kstep, 0, false); PG8_STAGE(PG8_SB(1, 1), cB + hstepB + kstep, voffB);
        PG8_WAIT_V(6); PG8_BAR;
    } else {
        PG8_STAGE(PG8_SB(0, 0), cB, voffB); PG8_STAGE(PG8_SA(0, 0), cA, voffA); PG8_STAGE(PG8_SB(0, 1), cB + hstepB, voffB); PG8_STAGE(PG8_SA(0, 1), cA + hstepA, voffA);
        if (wr == 1) PG8_BAR;
        PG8_WAIT_V(4); PG8_BAR;
        PG8_STAGE(PG8_SB(1, 0), cB + kstep, voffB); PG8_STAGE(PG8_SA(1, 0), cA + kstep, voffA); PG8_STAGE(PG8_SB(1, 1), cB + hstepB + kstep, voffB);
        PG8_WAIT_V(6); PG8_BAR;
    }
    for (;;) {
        const bool has_next = S.next(ui + 1, nxt);
        const char* nA = has_next ? nxt.a : cA; const char* nB = has_next ? nxt.b : cB;
        if constexpr (Sched::GATHER) { if (has_next) { PG8_GCALC(vAn, nxt); } else {
#pragma unroll
            for (int h_ = 0; h_ < 2; ++h_)
#pragma unroll
                for (int i_ = 0; i_ < 2; ++i_) vAn[h_][i_] = vA[h_][i_]; } }
        for (int t = 0; t < nt; t += 2) {
            const bool last = (t == nt - 2);
            const char* a1 = cA + (size_t)(t + 1) * kstep;
            const char* a2 = last ? nA : cA + (size_t)(t + 2) * kstep; const char* b2 = last ? nB : cB + (size_t)(t + 2) * kstep;
            const char* a3 = a2 + kstep; const char* b3 = b2 + kstep;
            if constexpr (SP2) {
            PG8_LDB(B0, 0, 0); PG8_LDB(B1, 0, 1); PG8_SCHED; PG8_LDA(At, 0, 0); PG8_STAGE_A(PG8_SA(1, 1), a1, 1, false);
            PG8_WAIT_V(8); PG8_WAIT_L(0); PG8_BAR; PG8_MMA(0, 0, At, B0); PG8_MMA(0, 1, At, B1); PG8_BAR; PG8_SCHED;
            PG8_LDA(At, 0, 1); PG8_STAGE(PG8_SB(0, 0), b2, voffB); PG8_STAGE(PG8_SB(0, 1), b2 + hstepB, voffB); PG8_STAGE_A(PG8_SA(0, 0), a2, 0, last);
            PG8_WAIT_V(8); PG8_WAIT_L(0); PG8_BAR; PG8_MMA(1, 0, At, B0); PG8_MMA(1, 1, At, B1); PG8_BAR; PG8_SCHED;
            PG8_LDB(B0, 1, 0); PG8_LDB(B1, 1, 1); PG8_SCHED; PG8_LDA(At, 1, 0); PG8_STAGE_A(PG8_SA(0, 1), a2, 1, last);
            PG8_WAIT_V(8); PG8_WAIT_L(0); PG8_BAR; PG8_MMA(0, 0, At, B0); PG8_MMA(0, 1, At, B1); PG8_BAR; PG8_SCHED;
            PG8_LDA(At, 1, 1); PG8_STAGE(PG8_SB(1, 0), b3, voffB); PG8_STAGE(PG8_SB(1, 1), b3 + hstepB, voffB); PG8_STAGE_A(PG8_SA(1, 0), a3, 0, last);
            PG8_WAIT_V(8); PG8_WAIT_L(0); PG8_BAR; PG8_MMA(1, 0, At, B0); PG8_MMA(1, 1, At, B1); PG8_BAR; PG8_SCHED;
            } else {
            PG8_LDB(B0, 0, 0); PG8_SCHED; PG8_LDA(At, 0, 0); PG8_STAGE(PG8_SA(1, 1), a1 + hstepA, voffA);
            PG8_WAIT_L(8); PG8_BAR; PG8_WAIT_L(0); PG8_MMA(0, 0, At, B0); PG8_BAR; PG8_SCHED;
            PG8_LDB(B1, 0, 1); PG8_STAGE(PG8_SB(0, 0), b2, voffB);
            PG8_BAR; PG8_WAIT_L(0); PG8_MMA(0, 1, At, B1); PG8_BAR;
            PG8_LDA(At, 0, 1); PG8_STAGE(PG8_SA(0, 0), a2, voffA);
            PG8_BAR; PG8_WAIT_L(0); PG8_MMA(1, 0, At, B0); PG8_BAR; PG8_SCHED;
            PG8_STAGE(PG8_SB(0, 1), b2 + hstepB, voffB);
            PG8_WAIT_V(6); PG8_BAR; PG8_MMA(1, 1, At, B1); PG8_BAR;
            PG8_LDB(B0, 1, 0); PG8_SCHED; PG8_LDA(At, 1, 0); PG8_STAGE(PG8_SA(0, 1), a2 + hstepA, voffA);
            PG8_WAIT_L(8); PG8_BAR; PG8_WAIT_L(0); PG8_MMA(0, 0, At, B0); PG8_BAR; PG8_SCHED;
            PG8_LDB(B1, 1, 1); PG8_STAGE(PG8_SB(1, 0), b3, voffB);
            PG8_BAR; PG8_WAIT_L(0); PG8_MMA(0, 1, At, B1); PG8_BAR;
            PG8_LDA(At, 1, 1); PG8_STAGE(PG8_SA(1, 0), a3, voffA);
            PG8_BAR; PG8_WAIT_L(0); PG8_MMA(1, 0, At, B0); PG8_BAR; PG8_SCHED;
            PG8_STAGE(PG8_SB(1, 1), b3 + hstepB, voffB);
            PG8_WAIT_V(6); PG8_BAR; PG8_MMA(1, 1, At, B1); PG8_BAR;
            }
        }
        if constexpr (ALIGN_EPI) { if (wr == 0) PG8_BAR; }
        E(acc, cur, wr, wc, fr, fq);
        if (!has_next) break;
#pragma unroll
        for (int a = 0; a < 2; ++a)
#pragma unroll
            for (int b = 0; b < 2; ++b)
#pragma unroll
                for (int m = 0; m < 4; ++m)
#pragma unroll
                    for (int n = 0; n < 2; ++n) acc[a][b][m][n] = (f32x4){0.f, 0.f, 0.f, 0.f};
        cur = nxt; cA = nA; cB = nB; ++ui;
        if constexpr (Sched::GATHER) {
#pragma unroll
            for (int h_ = 0; h_ < 2; ++h_)
#pragma unroll
                for (int i_ = 0; i_ < 2; ++i_) vA[h_][i_] = vAn[h_][i_]; }
        if constexpr (ALIGN_EPI) { if (wr == 1) PG8_BAR; }
    }
    PG8_WAIT_V(0);
    if constexpr (!ALIGN_EPI) { if (wr == 0) PG8_BAR; }
    PG8_BAR;
#undef PG8_SA
#undef PG8_SB
#undef PG8_STAGE
#undef PG8_STAGE_A
#undef PG8_GCALC
#undef PG8_LDA
#undef PG8_LDB
#undef PG8_MMA
#undef PG8_WAIT_V
#undef PG8_WAIT_L
#undef PG8_BAR
#undef PG8_SCHED
}
}
using pg8::Unit;
using pg8::Gemm;
typedef f32x4 AccT[2][2][4][2];

#define XB_TMO      128
#define XB_XCNT(j)  (256  + 64 * (j))
#define XB_XSUB(j)  (1280 + 64 * (j))
#define XB_XGEN(j)  (2304 + 64 * (j))
#define XB_TOP      3328
#define XB_TOPGEN   3392
#define XCD_BAR_WORDS 3456
#define XB_SPIN_CAP (1u << 18)
__device__ __forceinline__ unsigned xb_ld(unsigned* p)              { return __hip_atomic_load(p, __ATOMIC_RELAXED, __HIP_MEMORY_SCOPE_AGENT); }
__device__ __forceinline__ unsigned xb_add(unsigned* p, unsigned v) { return __hip_atomic_fetch_add(p, v, __ATOMIC_RELAXED, __HIP_MEMORY_SCOPE_AGENT); }
__device__ __forceinline__ unsigned xb_xcc_id() { return (unsigned)__builtin_amdgcn_s_getreg((3 << 11) | 20) & 0xFu; }
#define XB_SPIN(cond, bar) do { unsigned _sp = 0; while (cond) { __builtin_amdgcn_s_sleep(1); \
    if ((++_sp & 255u) == 0u) { if (xb_ld(&(bar)[XB_TMO])) break; if (_sp > XB_SPIN_CAP) { atomicAdd(&(bar)[XB_TMO], 1u); break; } } } } while (0)
struct XcdBarrier { unsigned* bar; unsigned x; volatile LAS unsigned* st; };
__device__ __forceinline__ XcdBarrier xcd_barrier_post(unsigned* bar, volatile LAS unsigned* st) {
    XcdBarrier b; b.bar = bar; b.x = xb_xcc_id(); b.st = st;
    if (threadIdx.x == 0) (void)xb_add(&bar[XB_XCNT(b.x)], 1u);
    return b;
}
__device__ __forceinline__ void xcd_barrier_complete(unsigned* bar, unsigned x, unsigned& nloc, unsigned& nx) {
    const unsigned G = gridDim.x * gridDim.y * gridDim.z;
    unsigned sum, cnt, mine, sp = 0u;
    for (;;) {
        sum = 0u; cnt = 0u; mine = 0u;
#pragma unroll
        for (unsigned j = 0; j < 16; ++j) { const unsigned c = xb_ld(&bar[XB_XCNT(j)]); sum += c; cnt += (c > 0u) ? 1u : 0u; mine = (j == x) ? c : mine; }
        if (sum == G) break;
        __builtin_amdgcn_s_sleep(1);
        if ((++sp & 255u) == 0u) { if (xb_ld(&bar[XB_TMO])) break; if (sp > XB_SPIN_CAP) { atomicAdd(&bar[XB_TMO], 1u); break; } }
    }
    nloc = mine > 0u ? mine : 1u; nx = cnt > 0u ? cnt : 1u;
}
__device__ __forceinline__ void xcd_barrier(const XcdBarrier& b) {
    asm volatile("s_waitcnt vmcnt(0)" ::: "memory");
    __syncthreads();
    if (threadIdx.x == 0) {
        unsigned* bar = b.bar;
        __builtin_amdgcn_s_waitcnt(0);
        unsigned nloc = b.st[0], nx = b.st[1];
        if (nloc == 0u) { xcd_barrier_complete(bar, b.x, nloc, nx); b.st[0] = nloc; b.st[1] = nx; }
        const unsigned old = xb_add(&bar[XB_XSUB(b.x)], 1u);
        const unsigned gen = old / nloc;
        if (old + 1u == (gen + 1u) * nloc) {
            __builtin_amdgcn_fence(__ATOMIC_RELEASE, "agent");
            asm volatile("s_waitcnt vmcnt(0)" ::: "memory");
            const unsigned og = xb_add(&bar[XB_TOP], 1u);
            const unsigned tg = og / nx;
            if (og + 1u == (tg + 1u) * nx) xb_add(&bar[XB_TOPGEN], 1u);
            else XB_SPIN(xb_ld(&bar[XB_TOPGEN]) == tg, bar);
            __builtin_amdgcn_fence(__ATOMIC_ACQUIRE, "agent");
            xb_add(&bar[XB_XGEN(b.x)], 1u);
            asm volatile("s_waitcnt vmcnt(0)" ::: "memory");
        } else {
            XB_SPIN(xb_ld(&bar[XB_XGEN(b.x)]) == gen, bar);
            __builtin_amdgcn_fence(__ATOMIC_ACQUIRE, "agent");
            asm volatile("s_waitcnt vmcnt(0)" ::: "memory");
        }
    }
    __syncthreads();
}

struct Args { const float* in[34]; float* out; unsigned char* ws; int ph_lo, ph_hi; };
enum { I_X = 0, I_C, I_CTX, I_CCTX, I_WMOD, I_BMOD, I_WIN, I_BIN, I_GCONV, I_GALOG, I_GDT, I_GNORM, I_CDWW, I_CDWB, I_CLNG, I_CLNB, I_SLNG, I_SLNB, I_SWS, I_SBS,
       I_WBR, I_WOUT, I_BOUT, I_LN1G, I_LN1B, I_LN2G, I_LN2B, I_RGW, I_RGB, I_REW, I_REB, I_EWG, I_EWU, I_EWD };

__device__ __forceinline__ int xcd_chunk(int L, int U) { const int q = U >> 3, r = U & 7, x = L & 7, off = L >> 3; return (x < r ? x * (q + 1) : r * (q + 1) + (x - r) * q) + off; }
struct SchedInA {
    static constexpr bool GATHER = false;
    int G, c; const char* xn; const char* w;
    __device__ __forceinline__ bool next(int i, Unit& u) const {
        const int L = i * G + c; const size_t tstep = (size_t)256 * 1024 * 2;
        if (L < 1152) { int pm, pn; pg8::map_tile(L, 72, 16, pm, pn); u.pm = pm; u.pn = pn; u.aux = 0; u.a = xn + (size_t)pm * tstep; u.b = w + (size_t)pn * tstep; return true; }
        if (L < 1440) { const int q = xcd_chunk(L - 1152, 288), pm = 16 + (q & 3), pn = q >> 2;        u.pm = pm; u.pn = pn; u.aux = 1; u.a = w + (size_t)pm * tstep; u.b = xn + (size_t)pn * tstep; return true; }
        return false;
    }
};
struct SchedGrid {
    static constexpr bool GATHER = false;
    int G, c, nM, nN; const char* a0; const char* b0; size_t astep, bstep;
    __device__ __forceinline__ bool next(int i, Unit& u) const {
        const int L = i * G + c; if (L >= nM * nN) return false;
        int pm, pn; pg8::map_tile(L, nM, nN, pm, pn); u.pm = pm; u.pn = pn; u.aux = 0; u.a = a0 + (size_t)pm * astep; u.b = b0 + (size_t)pn * bstep; return true;
    }
};
struct SchedFftLat {
    static constexpr bool GATHER = false;
    int G, c; const char* dft; const char* pf;
    __device__ __forceinline__ bool next(int i, Unit& u) const {
        const int L = i * G + c; if (L >= 128) return false;
        const int b = L >> 4, kt = (L >> 1) & 7, pn = L & 1;
        u.pm = b * 8 + kt; u.pn = pn; u.aux = 0; u.a = dft + (size_t)kt * (256 * 4096 * 2); u.b = pf + (size_t)b * (512 * 4096 * 2) + (size_t)pn * (256 * 4096 * 2); return true;
    }
};
struct SchedFftCtx {
    static constexpr bool GATHER = false;
    int G, c; const char* dft; const char* pf;
    __device__ __forceinline__ bool next(int i, Unit& u) const {
        const int L = i * G + (G - 1 - c); if (L >= 16) return false;
        const int b = L >> 1, pn = L & 1;
        u.pm = 64 + b; u.pn = pn; u.aux = 0; u.a = dft; u.b = pf + (size_t)b * (512 * 512 * 2) + (size_t)pn * (256 * 512 * 2); return true;
    }
};
struct SchedBranch {
    static constexpr bool GATHER = false;
    int G, c, nM; const char* br; const char* wbr;
    __device__ __forceinline__ bool next(int j, Unit& u) const {
        const int L = j * G + c; if (L >= nM * 16) return false;
        int pm, pn; pg8::map_tile(L, nM, 16, pm, pn);
        u.pm = pm; u.pn = pn; u.aux = 0; u.a = br + (size_t)(pn >> 2) * ((size_t)NTOK * 512 * 2) + (size_t)pm * (256 * 512 * 2); u.b = wbr + (size_t)pn * (256 * 512 * 2); return true;
    }
};
struct SchedMoe {
    static constexpr bool GATHER = false;
    int G, c; unsigned pre[17]; const char* a0; const char* w0; size_t astep, wstep_e, wstep_n;
    __device__ __forceinline__ void init(const unsigned* cnt  ) {
        unsigned s = 0;
#pragma unroll
        for (int e = 0; e < 16; ++e) { pre[e] = s; s += ((unsigned)__builtin_amdgcn_readfirstlane((int)__hip_atomic_load(cnt + 64 * e, __ATOMIC_RELAXED, __HIP_MEMORY_SCOPE_AGENT)) + 255u) >> 8; }
        pre[16] = s;
    }
    __device__ __forceinline__ bool next(int i, Unit& u) const {
        const int L = i * G + c; if (L >= (int)pre[16] * 4) return false;
        const int jt = L >> 2, pn = L & 3; int e = 0;
#pragma unroll
        for (int k = 1; k < 16; ++k) e += ((unsigned)jt >= pre[k]) ? 1 : 0;
        u.pm = jt; u.pn = pn; u.aux = e; u.a = a0 + (size_t)jt * astep; u.b = w0 + (size_t)e * wstep_e + (size_t)pn * wstep_n; return true;
    }
};

struct SchedMoeG {
    static constexpr bool GATHER = true;
    int G, c; const LAS unsigned* pre; const char* a0; const char* w0; size_t wstep_e, wstep_n; const int* list; const unsigned* cnt;
    __device__ __forceinline__ void init(const unsigned* cnt_  , LAS unsigned* pre_) { cnt = cnt_; pre = pre_;
        if (threadIdx.x < 16) pre_[17 + threadIdx.x] = __hip_atomic_load(cnt_ + 64 * threadIdx.x, __ATOMIC_RELAXED, __HIP_MEMORY_SCOPE_AGENT);
        __syncthreads();
        if (threadIdx.x == 0) { unsigned s = 0;
            for (int e = 0; e < 16; ++e) { pre_[e] = s; s += (pre_[17 + e] + 255u) >> 8; }
            pre_[16] = s; }
        __syncthreads();
    }
    __device__ __forceinline__ bool next(int i, Unit& u) const {
        const int L = i * G + c; if (L >= (int)pre[16] * 4) return false;
        const int jt = L >> 2, pn = L & 3; int e = 0; unsigned pe = 0;
#pragma unroll
        for (int k = 1; k < 16; ++k) { const unsigned pk = pre[k]; const bool ge = (unsigned)jt >= pk; e += ge ? 1 : 0; pe = ge ? pk : pe; }
        e = __builtin_amdgcn_readfirstlane(e); pe = (unsigned)__builtin_amdgcn_readfirstlane((int)pe);
        u.pm = jt; u.pn = pn; u.aux = e; u.ax2 = (jt - (int)pe) * 256; u.a = a0; u.b = w0 + (size_t)e * wstep_e + (size_t)pn * wstep_n; return true;
    }
    __device__ __forceinline__ unsigned arow(const Unit& u, int r) const {
        const unsigned n = pre[17 + u.aux]; const unsigned pos = (unsigned)(u.ax2 + r);
        const int tok = pos < n ? list[(size_t)u.aux * NTOK + pos] : 0; return (unsigned)tok * 2048u;
    }
};

struct EpiInA {
    static constexpr bool PERM = true;
    bf16 *pqkv, *pz, *pconf, *psgu, *pfft, *pfftc; const float* bias;
    __device__ __forceinline__ void operator()(const AccT& acc, const Unit& u, int wr, int wc, int fr, int fq) const {
        if (u.aux == 0) {
            const int row0 = u.pm * 256 + wr * 64 + fr, cb = wc * 32 + 8 * fq, bcol0 = u.pn * 256 + cb;
            f32x4 bv[2][2];
#pragma unroll
            for (int bj = 0; bj < 2; ++bj)
#pragma unroll
                for (int n = 0; n < 2; ++n) bv[bj][n] = *(const f32x4*)(bias + bcol0 + bj * 128 + 4 * n);
            if (u.pn < 8) {
                const bool isz = u.pn >= 6;
#pragma unroll
                for (int ai = 0; ai < 2; ++ai)
#pragma unroll
                    for (int m = 0; m < 4; ++m) { const int row = row0 + ai * 128 + m * 16;
                        bf16* rowp = isz ? (pz + (size_t)row * 512 + (u.pn - 6) * 256 + cb) : (pqkv + (size_t)row * 1536 + u.pn * 256 + cb);
#pragma unroll
                        for (int bj = 0; bj < 2; ++bj) { f32x4 v0 = acc[ai][bj][m][0] + bv[bj][0], v1 = acc[ai][bj][m][1] + bv[bj][1];
                            if (isz) {
#pragma unroll
                                for (int j = 0; j < 4; ++j) { v0[j] = siluf_(v0[j]); v1[j] = siluf_(v1[j]); } }
                            v4u w; w.x = pk2(v0[0], v0[1]); w.y = pk2(v0[2], v0[3]); w.z = pk2(v1[0], v1[1]); w.w = pk2(v1[2], v1[3]);
                            *(v4u*)(rowp + bj * 128) = w; } }
            } else if (u.pn < 12) {
#pragma unroll
                for (int ai = 0; ai < 2; ++ai)
#pragma unroll
                    for (int m = 0; m < 4; ++m) { const int row = row0 + ai * 128 + m * 16;
                        const f32x4 a0 = acc[ai][0][m][0] + bv[0][0], a1 = acc[ai][0][m][1] + bv[0][1], g0 = acc[ai][1][m][0] + bv[1][0], g1 = acc[ai][1][m][1] + bv[1][1];
                        float o[8];
#pragma unroll
                        for (int j = 0; j < 4; ++j) { o[j] = a0[j] * sigmoidf_(g0[j]); o[4 + j] = a1[j] * sigmoidf_(g1[j]); }
                        *(v4u*)(pconf + (size_t)row * 512 + (u.pn - 8) * 128 + cb) = pack8(o); }
            } else {
#pragma unroll
                for (int ai = 0; ai < 2; ++ai)
#pragma unroll
                    for (int m = 0; m < 4; ++m) { const int row = row0 + ai * 128 + m * 16;
                        bf16* rowp = psgu + (size_t)row * 1024 + (u.pn - 12) * 256 + cb;
#pragma unroll
                        for (int bj = 0; bj < 2; ++bj) { f32x4 v0 = acc[ai][bj][m][0] + bv[bj][0], v1 = acc[ai][bj][m][1] + bv[bj][1];
#pragma unroll
                            for (int j = 0; j < 4; ++j) { v0[j] = gelu_tanh(v0[j]); v1[j] = gelu_tanh(v1[j]); }
                            v4u w; w.x = pk2(v0[0], v0[1]); w.y = pk2(v0[2], v0[3]); w.z = pk2(v1[0], v1[1]); w.w = pk2(v1[2], v1[3]);
                            *(v4u*)(rowp + bj * 128) = w; } }
            }
        } else {
            const int jrow0 = (u.pm - 16) * 256 + wr * 64 + fr, tok0 = u.pn * 256 + wc * 32 + 8 * fq;
#pragma unroll
            for (int ai = 0; ai < 2; ++ai)
#pragma unroll
                for (int m = 0; m < 4; ++m) { const int jrow = jrow0 + ai * 128 + m * 16; const float bb = bias[4096 + jrow]; const int cs = jrow >> 9, rr = jrow & 511;
#pragma unroll
                    for (int bj = 0; bj < 2; ++bj) { const int tok = tok0 + bj * 128; bf16* dst;
                        if (tok < NLAT) { const int b = tok >> 11, t = tok & 2047; dst = pfft + ((size_t)(b * 512 + rr)) * 4096 + cs * 2048 + t; }
                        else { const int tc = tok - NLAT, b = tc >> 8, t = tc & 255; dst = pfftc + ((size_t)(b * 512 + rr)) * 512 + cs * 256 + t; }
                        const f32x4 v0 = acc[ai][bj][m][0] + bb, v1 = acc[ai][bj][m][1] + bb;
                        v4u w; w.x = pk2(v0[0], v0[1]); w.y = pk2(v0[2], v0[3]); w.z = pk2(v1[0], v1[1]); w.w = pk2(v1[2], v1[3]);
                        *(v4u*)dst = w; } }
        }
    }
};
template <int ACT  > struct EpiBf16 {
    static constexpr bool PERM = true;
    bf16* O; int ldc; const float* bias;
    __device__ __forceinline__ void operator()(const AccT& acc, const Unit& u, int wr, int wc, int fr, int fq) const {
        const int row0 = u.pm * 256 + wr * 64 + fr, col0 = u.pn * 256 + wc * 32 + 8 * fq;
        f32x4 bv[2][2];
#pragma unroll
        for (int bj = 0; bj < 2; ++bj)
#pragma unroll
            for (int n = 0; n < 2; ++n) bv[bj][n] = bias ? *(const f32x4*)(bias + col0 + bj * 128 + 4 * n) : (f32x4){0.f, 0.f, 0.f, 0.f};
#pragma unroll
        for (int ai = 0; ai < 2; ++ai)
#pragma unroll
            for (int m = 0; m < 4; ++m) { bf16* rowp = O + (size_t)(row0 + ai * 128 + m * 16) * ldc + col0;
#pragma unroll
                for (int bj = 0; bj < 2; ++bj) { f32x4 v0 = acc[ai][bj][m][0] + bv[bj][0], v1 = acc[ai][bj][m][1] + bv[bj][1];
                    if (ACT == 1) {
#pragma unroll
                        for (int j = 0; j < 4; ++j) { v0[j] = sigmoidf_(v0[j]); v1[j] = sigmoidf_(v1[j]); } }
                    v4u w; w.x = pk2(v0[0], v0[1]); w.y = pk2(v0[2], v0[3]); w.z = pk2(v1[0], v1[1]); w.w = pk2(v1[2], v1[3]);
                    *(v4u*)(rowp + bj * 128) = w; } }
    }
};
struct EpiF32 {
    static constexpr bool PERM = false;
    float* C; int ldc; const float* bias;
    __device__ __forceinline__ void operator()(const AccT& acc, const Unit& u, int wr, int wc, int fr, int fq) const {
        const int row0 = u.pm * 256 + wr * 64 + fr, col0 = u.pn * 256 + wc * 32 + 4 * fq;
        f32x4 bv[2][2];
#pragma unroll
        for (int bj = 0; bj < 2; ++bj)
#pragma unroll
            for (int n = 0; n < 2; ++n) bv[bj][n] = *(const f32x4*)(bias + col0 + bj * 128 + n * 16);
#pragma unroll
        for (int ai = 0; ai < 2; ++ai)
#pragma unroll
            for (int m = 0; m < 4; ++m) { float* rowp = C + (size_t)(row0 + ai * 128 + m * 16) * ldc + col0;
#pragma unroll
                for (int bj = 0; bj < 2; ++bj)
#pragma unroll
                    for (int n = 0; n < 2; ++n) *(f32x4*)(rowp + bj * 128 + n * 16) = acc[ai][bj][m][n] + bv[bj][n]; }
    }
};
struct EpiGateMerge {
    static constexpr bool PERM = true;
    const bf16* P; bf16* mbf; const float* bias;
    __device__ __forceinline__ void operator()(const AccT& acc, const Unit& u, int wr, int wc, int fr, int fq) const {
        const int row0 = u.pm * 256 + wr * 64 + fr, cb = wc * 32 + 8 * fq, d0 = u.pn * 64 + wc * 16 + 4 * fq;
        f32x4 bv[2][2];
#pragma unroll
        for (int bj = 0; bj < 2; ++bj)
#pragma unroll
            for (int n = 0; n < 2; ++n) bv[bj][n] = *(const f32x4*)(bias + u.pn * 256 + cb + bj * 128 + 4 * n);
#pragma unroll
        for (int ai = 0; ai < 2; ++ai)
#pragma unroll
            for (int m = 0; m < 4; ++m) { const size_t row = (size_t)(row0 + ai * 128 + m * 16); const bf16* pr = P + row * 4096 + d0;
                f32x4 o = (f32x4){0.f, 0.f, 0.f, 0.f};
#pragma unroll
                for (int bj = 0; bj < 2; ++bj)
#pragma unroll
                    for (int n = 0; n < 2; ++n) { const v2u pw = *(const v2u*)(pr + (2 * bj + n) * 1024); const f32x4 g = acc[ai][bj][m][n] + bv[bj][n];
                        o[0] += sigmoidf_(g[0]) * bflo(pw.x); o[1] += sigmoidf_(g[1]) * bfhi(pw.x); o[2] += sigmoidf_(g[2]) * bflo(pw.y); o[3] += sigmoidf_(g[3]) * bfhi(pw.y); }
                v2u w; w.x = pk2(o[0], o[1]); w.y = pk2(o[2], o[3]); *(v2u*)(mbf + row * 1024 + d0) = w; }
    }
};
struct EpiMoe1 {
    static constexpr bool PERM = true;
    bf16* hid;
    __device__ __forceinline__ void operator()(const AccT& acc, const Unit& u, int wr, int wc, int fr, int fq) const {
        const int row0 = u.pm * 256 + wr * 64 + fr, cb = wc * 32 + 8 * fq;
#pragma unroll
        for (int ai = 0; ai < 2; ++ai)
#pragma unroll
            for (int m = 0; m < 4; ++m) { const int row = row0 + ai * 128 + m * 16;
                const f32x4 g0 = acc[ai][0][m][0], g1 = acc[ai][0][m][1], u0 = acc[ai][1][m][0], u1 = acc[ai][1][m][1];
                float o[8];
#pragma unroll
                for (int j = 0; j < 4; ++j) { o[j] = siluf_(g0[j]) * u0[j]; o[4 + j] = siluf_(g1[j]) * u1[j]; }
                *(v4u*)(hid + (size_t)row * 512 + u.pn * 128 + cb) = pack8(o); }
    }
};

struct Ctx {
    LAS unsigned char* lds; int tid, lane, wave, G, bid;
};

__device__ __forceinline__ int gate_srccol(int r) { const int q = r - 5120, t = q >> 8, c = q & 255, bj = c >> 7, wc = (c >> 5) & 3, fq = (c >> 3) & 3, n = (c >> 2) & 1, j = c & 3;
    return OFF_GATE + (2 * bj + n) * 1024 + 64 * t + 16 * wc + 4 * fq + j; }
__device__ __forceinline__ void cvt_tile(const Ctx& X, const float* src, int ld, int k0, bf16* dst, int Kp) {
    LAS float* tile = (LAS float*)X.lds;
#pragma unroll
    for (int i = 0; i < 8; ++i) { const int kk = (X.tid >> 6) + 8 * i, nn = X.tid & 63; tile[kk * 65 + nn] = src[(size_t)(k0 + kk) * ld + nn]; }
    __syncthreads();
    { const int n = X.tid >> 3, kc = X.tid & 7; float o[8];
#pragma unroll
      for (int j = 0; j < 8; ++j) o[j] = tile[(8 * kc + j) * 65 + n];
      *(v4u*)(dst + (size_t)n * Kp + k0 + 8 * kc) = pack8(o); }
    __syncthreads();
}

__device__ __forceinline__ void cvt_item(const float* src, int ld, int srccol, int k0, bf16* dst, int Kp, LAS float* scr, int lane) {
    float tv[32];
#pragma unroll
    for (int i = 0; i < 32; ++i) { const int kk = 2 * i + (lane >> 5); tv[i] = src[(size_t)(k0 + kk) * ld + srccol]; }
#pragma unroll
    for (int i = 0; i < 32; ++i) { const int kk = 2 * i + (lane >> 5); scr[kk * 33 + (lane & 31)] = tv[i]; }
    LDS_WAIT(); asm volatile("" ::: "memory");
    const int c = lane & 7;
#pragma unroll
    for (int j = 0; j < 4; ++j) { const int n = (lane >> 3) + 8 * j; const LAS float* sp = scr + (8 * c) * 33 + n; float o[8];
#pragma unroll
        for (int e = 0; e < 8; ++e) o[e] = sp[e * 33];
        *(v4u*)(dst + (size_t)n * Kp + k0 + 8 * c) = pack8(o); }
    LDS_WAIT(); asm volatile("" ::: "memory");
}

__device__ __forceinline__ void cvt_item4(const float* src, int ld, int col4, int k0, bf16* dst, int Kp, LAS float* scr, int lane) {
    f32x4 v[8]; const int kq = lane >> 3, n4 = 4 * (lane & 7);
#pragma unroll
    for (int i = 0; i < 8; ++i) v[i] = *(const f32x4*)(src + (size_t)(k0 + kq + 8 * i) * ld + col4);
#pragma unroll
    for (int i = 0; i < 8; ++i) { LAS float* p = scr + (kq + 8 * i) * 33 + n4; p[0] = v[i][0]; p[1] = v[i][1]; p[2] = v[i][2]; p[3] = v[i][3]; }
    LDS_WAIT(); asm volatile("" ::: "memory");
    const int c = lane & 7;
#pragma unroll
    for (int j = 0; j < 4; ++j) { const int n = (lane >> 3) + 8 * j; const LAS float* sp = scr + (8 * c) * 33 + n; float o[8];
#pragma unroll
        for (int e = 0; e < 8; ++e) o[e] = sp[e * 33];
        *(v4u*)(dst + (size_t)n * Kp + k0 + 8 * c) = pack8(o); }
    LDS_WAIT(); asm volatile("" ::: "memory");
}

__device__ __forceinline__ void ln_rows(f32x4 (&v)[4]) {
    float s = 0.f;
#pragma unroll
    for (int j = 0; j < 4; ++j) s += (v[j][0] + v[j][1]) + (v[j][2] + v[j][3]);
    const float mean = wave_sum(s) * (1.f / D); float s2 = 0.f;
#pragma unroll
    for (int j = 0; j < 4; ++j) { v[j] = v[j] - mean; s2 += (v[j][0] * v[j][0] + v[j][1] * v[j][1]) + (v[j][2] * v[j][2] + v[j][3] * v[j][3]); }
    const float rstd = __builtin_amdgcn_rsqf(wave_sum(s2) * (1.f / D) + LN_EPS);
#pragma unroll
    for (int j = 0; j < 4; ++j) v[j] = v[j] * rstd;
}

#define PH_BEGIN() \
    int tid_l = threadIdx.x; asm volatile("" : "+v"(tid_l)); const int tid = tid_l, lane = tid & 63; \
    Ctx X; X.lds = lds; X.tid = tid; X.lane = lane; X.wave = __builtin_amdgcn_readfirstlane(tid >> 6); X.G = gridDim.x; X.bid = blockIdx.x; \
    const int gw = X.bid * NWAVES + X.wave, NGW = X.G * NWAVES; (void)gw; (void)NGW; \
    const __attribute__((address_space(4))) char* kp = (const __attribute__((address_space(4))) char*)__builtin_amdgcn_kernarg_segment_ptr(); asm volatile("" : "+s"(kp)); \
    unsigned char* const ws = *(unsigned char* const __attribute__((address_space(4)))*)(kp + 280); \
    float* const hlat = *(float* const __attribute__((address_space(4)))*)(kp + 272); (void)hlat; \
    float* const hctx = (float*)(ws + WS_HCTX); (void)hctx; \
    float* const modv = (float*)(ws + WS_MODV); (void)modv; \
    float* const binv = (float*)(ws + WS_BIN); (void)binv; \
    bf16* const XN = (bf16*)(ws + WS_XN); (void)XN; \
    bf16* const WIN = (bf16*)(ws + WS_WIN); (void)WIN; \
    bf16* const WBR = (bf16*)(ws + WS_WBR); (void)WBR; \
    bf16* const WOUT = (bf16*)(ws + WS_WOUT); (void)WOUT; \
    bf16* const F1A = (bf16*)(ws + WS_F1A); (void)F1A; bf16* const F1B = (bf16*)(ws + WS_F1B); (void)F1B; \
    bf16* const DFTC = (bf16*)(ws + WS_DFTC); (void)DFTC; \
    bf16* const PQKV = (bf16*)(ws + WS_PQKV); (void)PQKV; \
    bf16* const PCONF = (bf16*)(ws + WS_PCONF); (void)PCONF; \
    bf16* const PZ = (bf16*)(ws + WS_PZ); (void)PZ; \
    bf16* const PSGU = (bf16*)(ws + WS_PSGU); (void)PSGU; \
    bf16* const PFFT = (bf16*)(ws + WS_PFFT); (void)PFFT; \
    bf16* const PFFTC = (bf16*)(ws + WS_PFFTC); (void)PFFTC; \
    float* const AB = (float*)(ws + WS_AB); (void)AB; \
    bf16* const OF = (bf16*)(ws + WS_OF); (void)OF; \
    bf16* const OB = (bf16*)(ws + WS_OB); (void)OB; \
    bf16* const WIT = (bf16*)(ws + WS_WIT); (void)WIT; \
    bf16* const UIT = (bf16*)(ws + WS_UIT); (void)UIT; \
    bf16* const AIT = (bf16*)(ws + WS_AIT); (void)AIT; \
    bf16* const KIT = (bf16*)(ws + WS_KIT); (void)KIT; \
    float* const SIT = (float*)(ws + WS_SIT); (void)SIT; \
    bf16* const GT = (bf16*)(ws + WS_G); (void)GT; \
    bf16* const WGU = (bf16*)(ws + WS_WGU); (void)WGU; \
    bf16* const WDN = (bf16*)(ws + WS_WDN); (void)WDN; \
    bf16* const XG = (bf16*)(ws + WS_XG); (void)XG; \
    bf16* const QKV = (bf16*)(ws + WS_QKV); (void)QKV; \
    float* const GB = (float*)(ws + WS_GB); (void)GB; \
    bf16* const BR = (bf16*)(ws + WS_BR); (void)BR; \
    float* const MERGED = (float*)(ws + WS_MERGED); (void)MERGED; \
    float* const YB = (float*)(ws + WS_Y); (void)YB; \
    bf16* const HID = (bf16*)(ws + WS_HID); (void)HID; \
    bf16* const MO = (bf16*)(ws + WS_MO); (void)MO; \
    float* const ROUTE = (float*)(ws + WS_ROUTE); (void)ROUTE; int* const ELIST = (int*)(ws + WS_LIST); (void)ELIST; \
    unsigned* const ctl = (unsigned*)(ws + WS_CTL); (void)ctl;
#define INP(i) (*(const float* const __attribute__((address_space(4)))*)(kp + 8 * (i)))
__global__ void __launch_bounds__(NWAVES * 64, 2) fwd(Args args) {
    extern __shared__ __attribute__((aligned(16))) unsigned char lds_raw[];
    LAS unsigned char* const lds = (LAS unsigned char*)lds_raw;
    volatile LAS unsigned* MISC = (volatile LAS unsigned*)(lds + MISC_OFF);
    for (int u = threadIdx.x; u < (LDS_BYTES - LDSCTL_OFF) / 4; u += NWAVES * 64) ((LAS unsigned*)(lds + LDSCTL_OFF))[u] = 0u;
    __syncthreads();
#if MK_ONE_LAUNCH
    XcdBarrier bar = xcd_barrier_post((unsigned*)(args.ws + WS_CTL) + CW_BAR, MISC + 8);
#define GRID_BAR() xcd_barrier(bar)
#else
#define GRID_BAR() do { } while (0)
#endif
    const int lo = args.ph_lo, hi = args.ph_hi;
#define IN(k) (lo <= (k) && (k) < hi)
#define CW_TS 20000
#if TPROBE
#define STAMP(k) do { if (blockIdx.x == 0 && threadIdx.x == 0) __hip_atomic_store((unsigned*)(args.ws + WS_CTL) + CW_TS + (k), (unsigned)__builtin_amdgcn_s_memrealtime(), __ATOMIC_RELAXED, __HIP_MEMORY_SCOPE_AGENT); } while (0)
#else
#define STAMP(k) do { } while (0)
#endif
#define SEAM(k) do { if (IN(k) && IN((k) + 1)) GRID_BAR(); STAMP((k) + 1); } while (0)
    STAMP(0);

    for (int rep0_ = 0; rep0_ <= (int)PH_REP(0); ++rep0_) { if (rep0_) GRID_BAR();
    if (PH_ON(0) && IN(0)) { PH_BEGIN();
        for (int idx = X.bid * 512 + tid; idx < 256 * 512 / 8; idx += X.G * 512) {
            const int k = idx >> 6, j0 = (idx & 63) * 8; float o[8];
#pragma unroll
            for (int e = 0; e < 8; ++e) { const int j = j0 + e, t = j & 255, a = (k * t) & 255; float s, c; fsincospi((float)a * (1.0f / 128.0f), &s, &c);
                o[e] = (j < 256 ? c : -s) * 0.0625f; }
            *(v4u*)(DFTC + (size_t)k * 512 + j0) = pack8(o);
        }
        {
            LAS float* sc = (LAS float*)lds;
            LAS float* red = (LAS float*)(lds + 36864);
            { float cv[18];
#pragma unroll
              for (int j = 0; j < 18; ++j) { const int r = j >> 1, k = tid + 512 * (j & 1); cv[j] = r < 8 ? INP(I_C)[r * 1024 + k] : INP(I_CCTX)[k]; }
#pragma unroll
              for (int j = 0; j < 18; ++j) sc[tid + 512 * j] = siluf_(cv[j]); }
            __syncthreads();
            for (int it = X.bid; it < 192; it += X.G) {
                const int l = it / 96, j = (it % 96) * 64 + lane; const float* W = INP(I_WMOD) + (size_t)l * 1024 * 6144 + j;
                float a[9];
#pragma unroll
                for (int r = 0; r < 9; ++r) a[r] = 0.f;
                const int kb = X.wave * 128;
                float wv[2][32];
#pragma unroll
                for (int i = 0; i < 32; ++i) wv[0][i] = W[(size_t)(kb + i) * 6144];
#pragma unroll
                for (int b = 0; b < 4; ++b) {
                    if (b < 3) {
#pragma unroll
                        for (int i = 0; i < 32; ++i) wv[(b + 1) & 1][i] = W[(size_t)(kb + 32 * (b + 1) + i) * 6144]; }
#pragma unroll
                    for (int i = 0; i < 32; i += 4) {
#pragma unroll
                        for (int r = 0; r < 9; ++r) { const f32x4 sv = *(const LAS f32x4*)(sc + r * 1024 + kb + 32 * b + i);
                            a[r] += (sv[0] * wv[b & 1][i] + sv[1] * wv[b & 1][i + 1]) + (sv[2] * wv[b & 1][i + 2] + sv[3] * wv[b & 1][i + 3]); } }
                }
#pragma unroll
                for (int r = 0; r < 9; ++r) red[(X.wave * 9 + r) * 64 + lane] = a[r];
                __syncthreads();
                for (int o = tid; o < 9 * 64; o += 512) { const int r = o >> 6, jj = o & 63; float s = 0.f;
#pragma unroll
                    for (int w = 0; w < 8; ++w) s += red[(w * 9 + r) * 64 + jj];
                    const int jc = (it % 96) * 64 + jj; modv[((size_t)l * 9 + r) * 6144 + jc] = s + INP(I_BMOD)[l * 6144 + jc]; }
                __syncthreads();
            }
        }
    } }
    SEAM(0);

    for (int l = 0; l < 2; ++l) {
        const int pb = 1 + NPH_LAYER * l;
        const int nrows2 = (l == 1) ? NLAT : NTOK;
        const int npan2 = nrows2 / 256;

        for (int rep_ = 0; rep_ <= (int)PH_REP(1); ++rep_) { if (rep_) GRID_BAR();
        if (PH_ON(1) && IN(pb + 0)) { PH_BEGIN(); const float* mv = modv + (size_t)l * 9 * 6144; (void)mv; unsigned* const moecnt = ctl + CW_MOE + l * 16 * 64; (void)moecnt;
            const float* win = INP(I_WIN) + (size_t)l * 1024 * N_IN;
            const float* bin = INP(I_BIN) + (size_t)l * N_IN;
#define FOLD_LOAD(it_) do { const int kb_ = (it_) >> 2, g_ = (it_) & 3; _Pragma("unroll") for (int j = 0; j < 4; ++j) { const int i = tid + 512 * j, kk = i >> 7, c = i & 127; wpre[j] = win[(size_t)(kb_ * 16 + kk) * N_IN + OFF_FFT + g_ * 128 + c]; } } while (0)
            float wpre[4]; FOLD_LOAD(X.bid < 256 ? X.bid : 255);
            LAS float* const wscr = (LAS float*)(lds + X.wave * 8448);
            for (int it = gw; it < 4096 + 1024 + 512 + 144; it += NGW) {
                if (it >= 5632) { const int r = (it - 5632) * 64 + lane;
                    if (r < 4096 || r >= 5120) { float v;
                        if (r < 2048) v = bin[r];
                        else if (r < 3072) { const int q = r - 2048, j = q >> 8, w = q & 255; v = bin[OFF_CONF + (w >= 128 ? 512 : 0) + 128 * j + (w & 127)]; }
                        else if (r < 4096) v = bin[OFF_SGU + (r - 3072)];
                        else v = bin[gate_srccol(r)];
                        binv[r] = v; }
                    continue; }
                const float* src; int ld, col, k0, Kp; bf16* dst; const int n4 = lane & 31;
                if (it < 4096) { const int rb_ = (it & 3) + 4 * ((it >> 3) & 63), rb = rb_ < 128 ? rb_ : rb_ + 32, row0 = rb * 32;
                    if (row0 < 2048) col = row0 + n4;
                    else if (row0 < 3072) { const int q = row0 - 2048, j = q >> 8, w = q & 255; col = OFF_CONF + (w >= 128 ? 512 : 0) + 128 * j + (w & 127) + n4; }
                    else if (row0 < 4096) col = OFF_SGU + (row0 - 3072) + n4;
                    else col = gate_srccol(row0 + n4);
                    src = win; ld = N_IN; k0 = (((it >> 2) & 1) + 2 * (it >> 9)) * 64; dst = WIN + (size_t)row0 * 1024; Kp = 1024; }
                else if (it < 5120) { const int q = it - 4096, i = q >> 8, nb = (q & 3) + 4 * ((q >> 3) & 7);
                    src = INP(I_WBR) + ((size_t)(l * 4 + i) * 512) * 1024; ld = 1024; col = nb * 32 + n4; k0 = (((q >> 2) & 1) + 2 * ((q >> 6) & 3)) * 64; dst = WBR + ((size_t)i * 1024 + nb * 32) * 512; Kp = 512; }
                else { const int q = it - 5120, nb = (q & 3) + 4 * ((q >> 3) & 7);
                    src = INP(I_WOUT) + (size_t)l * 1024 * 1024; ld = 1024; col = nb * 32 + n4; k0 = (((q >> 2) & 1) + 2 * (q >> 6)) * 64; dst = WOUT + (size_t)nb * 32 * 1024; Kp = 1024; }
                cvt_item(src, ld, col, k0, dst, Kp, wscr, lane);
            }
            LAS float* wab = (LAS float*)lds;
            f32x4 wq[8]; bool wq_have = false;
#pragma unroll
            for (int j = 0; j < 8; ++j) wq[j] = (f32x4){0.f, 0.f, 0.f, 0.f};
#define WAB_LOAD() do { _Pragma("unroll") for (int j = 0; j < 8; ++j) wq[j] = *(const f32x4*)(win + (size_t)(tid + 512 * (j & 1)) * N_IN + OFF_A + 4 * (j >> 1)); } while (0)
            for (int it = X.bid; it < 256; it += X.G) {
                const int kb = it >> 2, g = it & 3; LAS float* Wt = (LAS float*)(lds + 69632); LAS f32x2* cst = (LAS f32x2*)(lds + 69632 + 10240); LAS float* bl = (LAS float*)(cst + 128);
                if (it != X.bid) FOLD_LOAD(it);
#pragma unroll
                for (int j = 0; j < 4; ++j) { const int i = tid + 512 * j, kk = i >> 7, c = i & 127; Wt[c * 20 + kk] = wpre[j]; }
                if (tid < 128) { float sn, cn; fsincospi((float)tid * (1.0f / 64.0f), &sn, &cn); cst[tid] = (f32x2){cn * 0.08838834764831845f, sn * 0.08838834764831845f}; }
                else if (tid < 256 && kb == 0) bl[tid - 128] = bin[OFF_FFT + g * 128 + (tid - 128)];
                __syncthreads();
                if (!wq_have) { WAB_LOAD(); wq_have = true; }
                const int m = tid & 127, ks = tid >> 7; f32x2 acc[4];
#pragma unroll
                for (int kk = 0; kk < 4; ++kk) acc[kk] = (f32x2){0.f, 0.f};
                { int a = 0;
#pragma unroll 8
                for (int c = 0; c < 128; ++c) { const f32x2 t = cst[a]; const f32x4 w = *(const LAS f32x4*)(Wt + c * 20 + ks * 4);
#pragma unroll
                    for (int kk = 0; kk < 4; ++kk) acc[kk] += t * w[kk];
                    a = (a + m) & 127; } }
                bf16* dc = WIN + (size_t)(4096 + g * 128 + m) * 1024 + kb * 16 + ks * 4; bf16* dsn = dc + (size_t)512 * 1024;
                { v2u o; o.x = pk2(acc[0][0], acc[1][0]); o.y = pk2(acc[2][0], acc[3][0]); *(v2u*)dc = o; o.x = pk2(acc[0][1], acc[1][1]); o.y = pk2(acc[2][1], acc[3][1]); *(v2u*)dsn = o; }
                if (kb == 0 && tid < 256) {
                    const int cs = tid >> 7; float sb = 0.f; int a = 0;
#pragma unroll 8
                    for (int c = 0; c < 128; ++c) { const f32x2 t = cst[a]; sb += bl[c] * (cs ? t[1] : t[0]); a = (a + m) & 127; }
                    binv[4096 + cs * 512 + g * 128 + m] = sb; }
                if (it + X.G < 256) __syncthreads();
            }
            if (!wq_have) { __syncthreads(); WAB_LOAD(); }
#pragma unroll
            for (int j = 0; j < 8; ++j) { LAS float* p = wab + (4 * (j >> 1)) * 1024 + tid + 512 * (j & 1); p[0] = wq[j][0]; p[1024] = wq[j][1]; p[2048] = wq[j][2]; p[3072] = wq[j][3]; }
            __syncthreads();
#undef FOLD_LOAD
#undef WAB_LOAD
            f32x4 pe[4]; int pe_t = -1;
#pragma unroll
            for (int j = 0; j < 4; ++j) pe[j] = (f32x4){0.f, 0.f, 0.f, 0.f};
            for (int rowb = gw; rowb < NTOK; rowb += 2 * NGW) {
                f32x4 va[4], vb2[4], scvB[4], shvB[4];
                {
                    const int rB_ = rowb + NGW < NTOK ? rowb + NGW : NTOK - 1; const int miB = rB_ < NLAT ? (rB_ >> 11) : 8; const float* shB = mv + miB * 6144, *scB = shB + 1024;
                    const float* srcB = (l == 0) ? (rB_ < NLAT ? INP(I_X) + (size_t)rB_ * D : INP(I_CTX) + (size_t)(rB_ - NLAT) * D) : (rB_ < NLAT ? (const float*)hlat + (size_t)rB_ * D : (const float*)hctx + (size_t)(rB_ - NLAT) * D);
#pragma unroll
                    for (int j = 0; j < 4; ++j) { vb2[j] = *(const f32x4*)(srcB + 4 * lane + 256 * j); scvB[j] = *(const f32x4*)(scB + 4 * lane + 256 * j); shvB[j] = *(const f32x4*)(shB + 4 * lane + 256 * j); } }
                { const int row_ = rowb + 0, row = row_ < NTOK ? row_ : NTOK - 1; const bool LIVE_ = row_ < NTOK;
                float* hrow = row < NLAT ? hlat + (size_t)row * D : hctx + (size_t)(row - NLAT) * D;
                const int mi = row < NLAT ? (row >> 11) : 8; const float* shift = mv + mi * 6144, *scale = shift + 1024;

                if (l == 0) {
                    const float* src = row < NLAT ? INP(I_X) + (size_t)row * D : INP(I_CTX) + (size_t)(row - NLAT) * D;
#pragma unroll
                    for (int j = 0; j < 4; ++j) va[j] = *(const f32x4*)(src + 4 * lane + 256 * j);
                    if (row < NLAT) { const int t = row & 2047;
                        if (t != pe_t) { pe_t = t; const int prow = t >> 6, pcol = t & 63;
#pragma unroll 1
                            for (int j = 0; j < 4; ++j)
#pragma unroll
                                for (int e = 0; e < 4; ++e) { const int col = 4 * lane + 256 * j + e, part = col >> 9, within = col & 511, i = within & 255;
                                    const float omega = __builtin_amdgcn_exp2f((float)i * (-13.287712379549449f / 256.0f)); const float rev = (float)(part ? pcol : prow) * omega * 0.15915494309189535f;
                                    const float pv = (within >> 8) ? __builtin_amdgcn_cosf(rev) : __builtin_amdgcn_sinf(rev);
                                    if (j == 0) pe[0][e] = pv; else if (j == 1) pe[1][e] = pv; else if (j == 2) pe[2][e] = pv; else pe[3][e] = pv; } }
#pragma unroll
                        for (int j = 0; j < 4; ++j) va[j] += pe[j]; }
#pragma unroll
                    for (int j = 0; j < 4; ++j) if (LIVE_) *(f32x4*)(hrow + 4 * lane + 256 * j) = va[j];
                } else {
#pragma unroll
                    for (int j = 0; j < 4; ++j) va[j] = *(const f32x4*)(hrow + 4 * lane + 256 * j);
                }
                f32x4 scv[4], shv[4];
#pragma unroll
                for (int j = 0; j < 4; ++j) { scv[j] = *(const f32x4*)(scale + 4 * lane + 256 * j); shv[j] = *(const f32x4*)(shift + 4 * lane + 256 * j); }
                ln_rows(va);
#pragma unroll
                for (int j = 0; j < 4; ++j) { const f32x4 sc = scv[j], sh = shv[j]; va[j] = va[j] * (sc + 1.0f) + sh;
                    v2u w; w.x = pk2(va[j][0], va[j][1]); w.y = pk2(va[j][2], va[j][3]); if (LIVE_) *(v2u*)(XN + (size_t)row * D + 4 * lane + 256 * j) = w; }
                }
                { const int row_ = rowb + NGW, row = row_ < NTOK ? row_ : NTOK - 1; const bool LIVE_ = row_ < NTOK;
                float* hrow = row < NLAT ? hlat + (size_t)row * D : hctx + (size_t)(row - NLAT) * D;
                const int mi = row < NLAT ? (row >> 11) : 8; const float* shift = mv + mi * 6144, *scale = shift + 1024;

                if (l == 0) {
                    const float* src = row < NLAT ? INP(I_X) + (size_t)row * D : INP(I_CTX) + (size_t)(row - NLAT) * D;
                    if (row < NLAT) { const int t = row & 2047;
                        if (t != pe_t) { pe_t = t; const int prow = t >> 6, pcol = t & 63;
#pragma unroll 1
                            for (int j = 0; j < 4; ++j)
#pragma unroll
                                for (int e = 0; e < 4; ++e) { const int col = 4 * lane + 256 * j + e, part = col >> 9, within = col & 511, i = within & 255;
                                    const float omega = __builtin_amdgcn_exp2f((float)i * (-13.287712379549449f / 256.0f)); const float rev = (float)(part ? pcol : prow) * omega * 0.15915494309189535f;
                                    const float pv = (within >> 8) ? __builtin_amdgcn_cosf(rev) : __builtin_amdgcn_sinf(rev);
                                    if (j == 0) pe[0][e] = pv; else if (j == 1) pe[1][e] = pv; else if (j == 2) pe[2][e] = pv; else pe[3][e] = pv; } }
#pragma unroll
                        for (int j = 0; j < 4; ++j) vb2[j] += pe[j]; }
#pragma unroll
                    for (int j = 0; j < 4; ++j) if (LIVE_) *(f32x4*)(hrow + 4 * lane + 256 * j) = vb2[j];
                } else {
                }
                f32x4 scv[4], shv[4];
#pragma unroll
                for (int j = 0; j < 4; ++j) { scv[j] = scvB[j]; shv[j] = shvB[j]; }
                ln_rows(vb2);
#pragma unroll
                for (int j = 0; j < 4; ++j) { const f32x4 sc = scv[j], sh = shv[j]; vb2[j] = vb2[j] * (sc + 1.0f) + sh;
                    v2u w; w.x = pk2(vb2[j][0], vb2[j][1]); w.y = pk2(vb2[j][2], vb2[j][3]); if (LIVE_) *(v2u*)(XN + (size_t)row * D + 4 * lane + 256 * j) = w; }
                }
                float pa[16], pb_[16];
                { f32x2 vp[4][4];
#pragma unroll
                  for (int j = 0; j < 4; ++j)
#pragma unroll
                      for (int e = 0; e < 4; ++e) vp[j][e] = (f32x2){va[j][e], vb2[j][e]};
#pragma unroll
                  for (int o = 0; o < 16; ++o) { f32x2 sr = (f32x2){0.f, 0.f};
#pragma unroll
                    for (int j = 0; j < 4; ++j) { const f32x4 w = *(const LAS f32x4*)(wab + o * 1024 + 4 * lane + 256 * j);
#pragma unroll
                        for (int e = 0; e < 4; ++e) sr += vp[j][e] * w[e]; }
                    pa[o] = sr[0]; pb_[o] = sr[1]; if ((o & 3) == 3) asm volatile("" ::: "memory"); } }
                const float t0_ = reduce16(pa, lane), t1_ = reduce16(pb_, lane);
                if ((lane & 3) == 0) { AB[(size_t)rowb * 16 + (lane >> 2)] = t0_ + bin[OFF_A + (lane >> 2)]; if (rowb + NGW < NTOK) AB[(size_t)(rowb + NGW) * 16 + (lane >> 2)] = t1_ + bin[OFF_A + (lane >> 2)]; }
            }
        } }
        SEAM(pb + 0);

        for (int rep_ = 0; rep_ <= (int)PH_REP(2); ++rep_) { if (rep_) GRID_BAR();
        if (PH_ON(2) && IN(pb + 1)) { PH_BEGIN(); const float* mv = modv + (size_t)l * 9 * 6144; (void)mv; unsigned* const moecnt = ctl + CW_MOE + l * 16 * 64; (void)moecnt;
            SchedInA S{X.G, X.bid, (const char*)XN, (const char*)WIN};
            EpiInA E{PQKV, PZ, PCONF, PSGU, PFFT, PFFTC, binv};
            pg8::gemm_phase<EpiInA, SchedInA, true, true>(lds, Gemm{1024, 1024, 1024}, S, E);
        } }
        SEAM(pb + 1);

        for (int rep_ = 0; rep_ <= (int)PH_REP(3); ++rep_) { if (rep_) GRID_BAR();
        if (PH_ON(3) && IN(pb + 2)) { PH_BEGIN(); const float* mv = modv + (size_t)l * 9 * 6144; (void)mv; unsigned* const moecnt = ctl + CW_MOE + l * 16 * 64; (void)moecnt;
            {
                const int vb = X.bid, NB2 = X.G, gw2 = gw, NGW2 = NGW;
                if (l == 0) { SchedFftCtx S{NB2, vb, (const char*)DFTC, (const char*)PFFTC}; EpiBf16<0> E{BR + (size_t)2 * NTOK * 512, 512, nullptr};
                  pg8::gemm_phase<EpiBf16<0>, SchedFftCtx, true, true>(lds, Gemm{512, 512, 512}, S, E); }
                __syncthreads();
                {
                    typedef short v4i16_t __attribute__((ext_vector_type(4)));
                    LAS unsigned char* tl = lds + X.wave * 8192;
                    const int r16 = lane & 15, quad = lane >> 4;
                    bf16x8 m1[4][2];
#pragma unroll
                    for (int mt = 0; mt < 4; ++mt)
#pragma unroll
                        for (int ks = 0; ks < 2; ++ks) { float o[8]; const int k1 = 16 * (mt & 1) + r16, ri = mt >> 1;
#pragma unroll
                            for (int e = 0; e < 8; ++e) { const int t1 = 8 * quad + e; float sn, cs; fsincospi((float)((k1 * t1) & 31) * (1.0f / 16.0f), &sn, &cs);
                                o[e] = ri == 0 ? (ks == 0 ? cs : -sn) : (ks == 0 ? -sn : -cs); }
                            m1[mt][ks] = __builtin_bit_cast(bf16x8, pack8(o)); }
                    float twc[2][4][4], tws[2][4][4];
#pragma unroll
                    for (int ml = 0; ml < 2; ++ml)
#pragma unroll
                        for (int c = 0; c < 4; ++c)
#pragma unroll
                            for (int r = 0; r < 4; ++r) { const int k1 = 16 * ml + r16, t2 = 16 * c + 4 * quad + r; fsincospi((float)(k1 * t2) * (1.0f / 1024.0f), &tws[ml][c][r], &twc[ml][c][r]); }
                    const unsigned tbase = (unsigned)(size_t)tl;
                    for (int it = gw2; it < NB * 512; it += NGW2) {
                        const int b = it >> 9, col = it & 511;
                        const bf16* src = PFFT + (size_t)it * 4096;
                        v4u ld[8];
#pragma unroll
                        for (int i = 0; i < 8; ++i) ld[i] = *(const v4u*)(src + (i * 64 + lane) * 8);
#pragma unroll
                        for (int i = 0; i < 8; ++i) *(LAS v4u*)(tl + (i * 64 + lane) * 16) = ld[i];
                        LDS_WAIT();
                        bf16* dst = (b < 4 ? F1A + (size_t)(b * 512 + col) * 4096 : F1B + (size_t)((b - 4) * 512 + col) * 4096);
#pragma unroll
                        for (int c = 0; c < 4; ++c) {
                            bf16x8 af[2];
#pragma unroll
                            for (int ks = 0; ks < 2; ++ks) { v4i16_t h[2];
#pragma unroll
                                for (int t = 0; t < 2; ++t) h[t] = __builtin_amdgcn_ds_read_tr16_b64_v4i16((LAS v4i16_t*)(tl + ks * 4096 + (8 * quad + 4 * t + (r16 >> 2)) * 128 + (16 * c + 4 * (lane & 3)) * 2));
                                bf16x8 f; f[0] = h[0][0]; f[1] = h[0][1]; f[2] = h[0][2]; f[3] = h[0][3]; f[4] = h[1][0]; f[5] = h[1][1]; f[6] = h[1][2]; f[7] = h[1][3]; af[ks] = f; }
                            f32x4 acc[4];
#pragma unroll
                            for (int mt = 0; mt < 4; ++mt) { acc[mt] = (f32x4){0.f, 0.f, 0.f, 0.f};
#pragma unroll
                                for (int ks = 0; ks < 2; ++ks) acc[mt] = __builtin_amdgcn_mfma_f32_16x16x32_bf16(af[ks], m1[mt][ks], acc[mt], 0, 0, 0); }
#pragma unroll
                            for (int ml = 0; ml < 2; ++ml) { const int k1 = 16 * ml + r16; float pr[4], pi[4];
#pragma unroll
                                for (int r = 0; r < 4; ++r) { const float ar = acc[ml][r], ai = acc[ml + 2][r]; pr[r] = ar * twc[ml][c][r] + ai * tws[ml][c][r]; pi[r] = ai * twc[ml][c][r] - ar * tws[ml][c][r]; }
                                v2u w0, w1; w0.x = pk2(pr[0], pr[1]); w0.y = pk2(pr[2], pr[3]); w1.x = pk2(pi[0], pi[1]); w1.y = pk2(pi[2], pi[3]);
                                *(v2u*)(dst + k1 * 128 + 16 * c + 4 * quad) = w0; *(v2u*)(dst + k1 * 128 + 64 + 16 * c + 4 * quad) = w1; }
                        }
                        LDS_WAIT();
                    }
                    (void)tbase;
                    __syncthreads();
                }
                {
                    LAS float* cwl = (LAS float*)lds;
                    const float* cw = INP(I_GCONV) + (size_t)l * 5 * 1536;
                    { f32x4 t4[4];
#pragma unroll
                      for (int j = 0; j < 4; ++j) { const int i = tid + 512 * j; t4[j] = *(const f32x4*)(cw + 4 * (i < 1920 ? i : 0)); }
#pragma unroll
                      for (int j = 0; j < 4; ++j) { const int i = tid + 512 * j; if (i < 1920) *(LAS f32x4*)(cwl + 4 * i) = t4[j]; } }
                    __syncthreads();
                    const float gdt_l = INP(I_GDT)[l * 8 + (lane & 7)], nega_l = -__expf(INP(I_GALOG)[l * 8 + (lane & 7)]);
                    for (int row = gw2; row < NTOK; row += NGW2) {
                        int t, T; if (row < NLAT) { t = row & 2047; T = 2048; } else { t = (row - NLAT) & 255; T = 256; }
                        v4u xr[3][5];
#pragma unroll
                        for (int seg = 0; seg < 3; ++seg)
#pragma unroll
                            for (int j = 0; j < 5; ++j) { const int tt = t + j - 2; xr[seg][j] = (tt >= 0 && tt < T) ? *(const v4u*)(PQKV + (size_t)(row + j - 2) * 1536 + seg * 512 + 8 * lane) : (v4u){0u, 0u, 0u, 0u}; }
                        float av = 0.f, bv = 0.f; if (lane < 8) { av = AB[(size_t)row * 16 + lane]; bv = AB[(size_t)row * 16 + 8 + lane]; }
#pragma unroll
                        for (int seg = 0; seg < 3; ++seg) { const int ch = seg * 512 + 8 * lane; float a[8];
#pragma unroll
                            for (int e = 0; e < 8; ++e) a[e] = 0.f;
#pragma unroll
                            for (int j = 0; j < 5; ++j) { float xv[8]; unpack8(xr[seg][j], xv);
                                const f32x4 w0 = *(const LAS f32x4*)(cwl + j * 1536 + ch), w1 = *(const LAS f32x4*)(cwl + j * 1536 + ch + 4);
#pragma unroll
                                for (int e = 0; e < 4; ++e) { a[e] += w0[e] * xv[e]; a[4 + e] += w1[e] * xv[4 + e]; } }
                            float ss = 0.f;
#pragma unroll
                            for (int e = 0; e < 8; ++e) { a[e] = siluf_(a[e]); ss += a[e] * a[e]; }
                            if (seg < 2) { ss = g16_sum(ss); const float sc = __builtin_amdgcn_rsqf(ss + LN_EPS) * (seg == 0 ? 0.08838834764831845f : 1.0f);
#pragma unroll
                                for (int e = 0; e < 8; ++e) a[e] *= sc; }
                            *(v4u*)(QKV + (size_t)row * 1536 + ch) = pack8(a); }
                        if (lane < 8) { const float xs = av + gdt_l; const float sp = xs > 20.f ? xs : __logf(1.0f + __expf(xs));
                            GB[(size_t)row * 16 + lane] = nega_l * sp; GB[(size_t)row * 16 + 8 + lane] = __builtin_amdgcn_rcpf(1.0f + __expf(-bv)); }
                    }
                    __syncthreads();
                }
                {
                    LAS bf16* xs = (LAS bf16*)lds;
                    LAS float* wl = (LAS float*)(lds + 63488);
                    const float* dw = INP(I_CDWW) + (size_t)l * 31 * 512; const float* dwb = INP(I_CDWB) + l * 512, *lg = INP(I_CLNG) + l * 512, *lb = INP(I_CLNB) + l * 512;
                    bf16* B1 = BR + (size_t)1 * NTOK * 512;
                    { f32x4 t8[8];
#pragma unroll
                      for (int j = 0; j < 8; ++j) { const int i = tid + 512 * j; t8[j] = *(const f32x4*)(dw + 4 * (i < 3968 ? i : 0)); }
#pragma unroll
                      for (int j = 0; j < 8; ++j) { const int i = tid + 512 * j; if (i < 3968) *(LAS f32x4*)(wl + 4 * i) = t8[j]; } }
                    const int ch = 8 * lane, tq = X.wave;
                    f32x4 bia0 = *(const f32x4*)(dwb + ch), bia1 = *(const f32x4*)(dwb + ch + 4);
                    const f32x4 g0 = *(const f32x4*)(lg + ch), g1 = *(const f32x4*)(lg + ch + 4), b0 = *(const f32x4*)(lb + ch), b1 = *(const f32x4*)(lb + ch + 4);
                    for (int tile = vb; tile < nrows2 / 32; tile += NB2) {
                        const int t0 = tile * 32; int rbase, T; if (t0 < NLAT) { rbase = t0 & ~2047; T = 2048; } else { rbase = NLAT + ((t0 - NLAT) & ~255); T = 256; }
                        __syncthreads();
                        { v4u tl8[8];
#pragma unroll
                          for (int j = 0; j < 8; ++j) { const int i = tid + 512 * j, r = i >> 6, c = i & 63, srow = t0 - 15 + r; const bool ok = i < 62 * 64 && srow >= rbase && srow < rbase + T;
                              tl8[j] = *(const v4u*)(PCONF + (size_t)(ok ? srow : t0) * 512 + 8 * c); if (!ok) tl8[j] = (v4u){0u, 0u, 0u, 0u}; }
#pragma unroll
                          for (int j = 0; j < 8; ++j) { const int i = tid + 512 * j, r = i >> 6, c = i & 63; if (i < 62 * 64) *(LAS v4u*)(xs + r * 512 + 8 * c) = tl8[j]; } }
                        __syncthreads();
                        float acc[4][8];
#pragma unroll
                        for (int k = 0; k < 4; ++k)
#pragma unroll
                            for (int e = 0; e < 4; ++e) { acc[k][e] = bia0[e]; acc[k][4 + e] = bia1[e]; }
#pragma unroll 1
                        for (int j = 0; j < 31; ++j) {
                            const f32x4 w0 = *(const LAS f32x4*)(wl + j * 512 + ch), w1 = *(const LAS f32x4*)(wl + j * 512 + ch + 4);
#pragma unroll
                            for (int k = 0; k < 4; ++k) { float xv[8]; unpack8(*(const LAS v4u*)(xs + (tq * 4 + k + j) * 512 + ch), xv);
#pragma unroll
                                for (int e = 0; e < 4; ++e) { acc[k][e] += w0[e] * xv[e]; acc[k][4 + e] += w1[e] * xv[4 + e]; } }
                        }
#pragma unroll
                        for (int k = 0; k < 4; ++k) { float s1 = 0.f;
#pragma unroll
                            for (int e = 0; e < 8; ++e) s1 += acc[k][e];
                            const float mean = g16_sum(s1) * (1.0f / 128.0f); float s2 = 0.f;
#pragma unroll
                            for (int e = 0; e < 8; ++e) { acc[k][e] -= mean; s2 += acc[k][e] * acc[k][e]; }
                            const float rstd = __builtin_amdgcn_rsqf(g16_sum(s2) * (1.0f / 128.0f) + LN_EPS); float o[8];
#pragma unroll
                            for (int e = 0; e < 4; ++e) { o[e] = siluf_(acc[k][e] * rstd * g0[e] + b0[e]); o[4 + e] = siluf_(acc[k][4 + e] * rstd * g1[e] + b1[e]); }
                            *(v4u*)(B1 + (size_t)(t0 + tq * 4 + k) * 512 + ch) = pack8(o); }
                    }
                    __syncthreads();
                }
                {
                    LAS bf16* vnT = (LAS bf16*)lds;
                    const float* lg = INP(I_SLNG) + l * 512, *lb = INP(I_SLNB) + l * 512;
                    bf16* B3 = BR + (size_t)3 * NTOK * 512;
                    const int nitems = (nrows2 / 128) * 4, r16 = lane & 15, quad = lane >> 4, w = X.wave;
                    for (int it = (vb + NB2 - NB2 / 4) % NB2; it < nitems; it += NB2) {
                        const int chunk = it >> 2, g = it & 3, r0 = chunk * 128;
                        unsigned raw[16];
#pragma unroll
                        for (int i = 0; i < 16; ++i) raw[i] = *(const unsigned*)(PSGU + (size_t)(r0 + w * 16 + i) * 1024 + 512 + g * 128 + 2 * lane);
                        const int c = g * 128 + 2 * lane; const float lg0 = lg[c], lg1 = lg[c + 1], lb0 = lb[c], lb1 = lb[c + 1];
                        __syncthreads();
                        { float sv[16];
#pragma unroll
                          for (int i = 0; i < 16; ++i) sv[i] = bflo(raw[i]) + bfhi(raw[i]);
                          const float ts = reduce16(sv, lane) * (1.0f / 128.0f); float mean[16];
#pragma unroll
                          for (int i = 0; i < 16; ++i) { mean[i] = __shfl(ts, 4 * i); const float v0 = bflo(raw[i]) - mean[i], v1 = bfhi(raw[i]) - mean[i]; sv[i] = v0 * v0 + v1 * v1; }
                          const float tv = reduce16(sv, lane) * (1.0f / 128.0f);
#pragma unroll
                          for (int i = 0; i < 16; ++i) { const float rstd = __builtin_amdgcn_rsqf(__shfl(tv, 4 * i) + LN_EPS); const float v0 = bflo(raw[i]) - mean[i], v1 = bfhi(raw[i]) - mean[i];
                            vnT[(2 * lane) * 136 + w * 16 + i] = (bf16)f2bf(v0 * rstd * lg0 + lb0); vnT[(2 * lane + 1) * 136 + w * 16 + i] = (bf16)f2bf(v1 * rstd * lg1 + lb1); } }
                        bf16x8 wf[4];
                        { const float* wsrc = INP(I_SWS) + ((size_t)(l * 4 + g) * 128 + 16 * w + r16) * 128 + quad * 8;
#pragma unroll
                          for (int ks = 0; ks < 4; ++ks) { const f32x4 x0 = *(const f32x4*)(wsrc + 32 * ks), x1 = *(const f32x4*)(wsrc + 32 * ks + 4);
                              v4u pk; pk.x = pk2(x0[0], x0[1]); pk.y = pk2(x0[2], x0[3]); pk.z = pk2(x1[0], x1[1]); pk.w = pk2(x1[2], x1[3]); wf[ks] = __builtin_bit_cast(bf16x8, pk); } }
                        const float bs = INP(I_SBS)[(l * 4 + g) * 128 + 16 * w + r16];
                        __syncthreads();
                        const size_t prow = (size_t)(r0 + 16 * w + r16);
#pragma unroll
                        for (int nt = 0; nt < 8; ++nt) { f32x4 acc = (f32x4){0.f, 0.f, 0.f, 0.f};
#pragma unroll
                            for (int ks = 0; ks < 4; ++ks) { const bf16x8 vf = *(const LAS bf16x8*)(vnT + (16 * nt + r16) * 136 + 32 * ks + quad * 8); acc = __builtin_amdgcn_mfma_f32_16x16x32_bf16(vf, wf[ks], acc, 0, 0, 0); }
                            const v2u uw = *(const v2u*)(PSGU + prow * 1024 + g * 128 + 16 * nt + quad * 4);
                            v2u o; o.x = pk2(bflo(uw.x) * (acc[0] + bs), bfhi(uw.x) * (acc[1] + bs)); o.y = pk2(bflo(uw.y) * (acc[2] + bs), bfhi(uw.y) * (acc[3] + bs));
                            *(v2u*)(B3 + prow * 512 + g * 128 + 16 * nt + quad * 4) = o; }
                    }
                    __syncthreads();
                }
            }
        } }
        SEAM(pb + 2);

        for (int rep_ = 0; rep_ <= (int)PH_REP(4); ++rep_) { if (rep_) GRID_BAR();
        if (PH_ON(4) && IN(pb + 3)) { PH_BEGIN(); const float* mv = modv + (size_t)l * 9 * 6144; (void)mv; unsigned* const moecnt = ctl + CW_MOE + l * 16 * 64; (void)moecnt;
            {
                const int r16 = lane & 15, quad = lane >> 4;
                bf16x8 m2[4][4];
#pragma unroll
                for (int jt = 0; jt < 4; ++jt)
#pragma unroll
                    for (int ks = 0; ks < 4; ++ks) { float o[8]; const int k2 = 16 * jt + r16;
#pragma unroll
                        for (int e = 0; e < 8; ++e) { const int t2 = 32 * (ks & 1) + 8 * quad + e; float sn, cs; fsincospi((float)((k2 * t2) & 63) * (1.0f / 32.0f), &sn, &cs); o[e] = ((ks >> 1) ? sn : cs) * 0.022097086912079608f; }
                        m2[jt][ks] = __builtin_bit_cast(bf16x8, pack8(o)); }
                bf16* B2 = BR + (size_t)2 * NTOK * 512;
                const int nq5 = 9216 - 4 * NGW;
                const bool bal = nq5 > 0 && nq5 < NGW;
                for (int it = bal ? gw - nq5 : gw; it < 8192; it += bal ? NGW - nq5 : NGW) {
                    if (it < 0) break;
                    const int b = it >> 10, k1 = (it >> 5) & 31, ct = it & 31;
                    const bf16* f1 = (b < 4 ? F1A + (size_t)(b * 512 + 16 * ct + r16) * 4096 : F1B + (size_t)((b - 4) * 512 + 16 * ct + r16) * 4096) + k1 * 128 + 8 * quad;
                    bf16x8 af[4];
#pragma unroll
                    for (int ks = 0; ks < 4; ++ks) af[ks] = *(const bf16x8*)(f1 + 32 * ks);
#pragma unroll
                    for (int jt = 0; jt < 4; ++jt) { f32x4 acc = (f32x4){0.f, 0.f, 0.f, 0.f};
#pragma unroll
                        for (int ks = 0; ks < 4; ++ks) acc = __builtin_amdgcn_mfma_f32_16x16x32_bf16(af[ks], m2[jt][ks], acc, 0, 0, 0);
                        v2u w; w.x = pk2(acc[0], acc[1]); w.y = pk2(acc[2], acc[3]);
                        *(v2u*)(B2 + (size_t)(b * 2048 + k1 + 32 * (16 * jt + r16)) * 512 + 16 * ct + 4 * quad) = w; }
                }
            }
            for (int qi = gw; qi < 9216; qi += NGW) {
                int lane_l = lane; asm volatile("" : "+v"(lane_l));
                const int r16 = lane_l & 15, quad = lane_l >> 4;
                LAS float* const Mt = (LAS float*)(lds + X.wave * 16384);
                LAS float* const gcl = (LAS float*)(lds + 132096 + X.wave * 1024);
                const int item = qi >> 2, q = qi & 3, cidx = item % 36, chain = item / 36, dir = chain & 1, hh = (chain >> 1) & 3, b = chain >> 3;
                const int row0 = cidx < 4 ? NLAT + b * CTXL + cidx * 64 : b * SEQ + (cidx - 4) * 64;
                const int rb = row0 + (dir ? 63 : 0); const long sg = dir ? -1 : 1;
                const float ga = GB[(size_t)(rb + sg * lane_l) * 16 + dir * 4 + hh], be = GB[(size_t)(rb + sg * lane_l) * 16 + 8 + dir * 4 + hh];
                float gc = ga;
#pragma unroll
                for (int o = 1; o < 64; o <<= 1) { const float tu = __shfl_up(gc, o); gc += (lane_l >= o) ? tu : 0.f; }
                const float gl = __shfl(gc, 63);
                gcl[lane_l] = gc; gcl[64 + lane_l] = be;
                const float scl = q >= 2 ? be * __expf(gc) : be;
                bf16x8 Kf[4][4];
                { const bf16* kp = QKV + (size_t)(rb + sg * r16) * 1536 + 512 + hh * 128 + quad * 8; const long ms = sg * 16 * 1536;
#pragma unroll
                  for (int mi = 0; mi < 4; ++mi)
#pragma unroll
                      for (int ks = 0; ks < 4; ++ks) Kf[mi][ks] = *(const bf16x8*)(kp + mi * ms + ks * 32); }
                LDS_WAIT();
                if (q == 0) {
                    bf16x8 Qf[4][4];
                    { const bf16* qp = QKV + (size_t)(rb + sg * r16) * 1536 + hh * 128 + quad * 8; const long ms = sg * 16 * 1536;
#pragma unroll
                      for (int mi = 0; mi < 4; ++mi)
#pragma unroll
                          for (int ks = 0; ks < 4; ++ks) Qf[mi][ks] = *(const bf16x8*)(qp + mi * ms + ks * 32); }
                    bf16* ait = AIT + (size_t)item * 4096 + r16 * 64 + quad * 4;
#pragma unroll
                    for (int mi = 0; mi < 4; ++mi) { const float gci = gcl[16 * mi + r16];
#pragma unroll
                        for (int nj = 0; nj < 4; ++nj) {
                            v2u w; w.x = 0u; w.y = 0u;
                            if (nj <= mi) {
                                f32x4 c = (f32x4){0.f, 0.f, 0.f, 0.f};
#pragma unroll
                                for (int ks = 0; ks < 4; ++ks) c = __builtin_amdgcn_mfma_f32_16x16x32_bf16(Kf[nj][ks], Qf[mi][ks], c, 0, 0, 0);
                                const f32x4 gcj = *(const LAS f32x4*)(gcl + 16 * nj + quad * 4); float o4[4];
#pragma unroll
                                for (int r = 0; r < 4; ++r) { const bool incl = (nj < mi) || (quad * 4 + r <= r16); o4[r] = incl ? c[r] * __expf(gci - gcj[r]) : 0.f; }
                                w.x = pk2(o4[0], o4[1]); w.y = pk2(o4[2], o4[3]); }
                            *(v2u*)(ait + mi * 16 * 64 + 16 * nj) = w; }
                    }
                }
                if (q == 1) { SIT[(size_t)item * 192 + lane_l] = __expf(gc); SIT[(size_t)item * 192 + 64 + lane_l] = __expf(gl - gc); if (lane_l == 0) SIT[(size_t)item * 192 + 128] = __expf(gl); }
                asm volatile("" ::: "memory");
                { LAS float* mw = Mt + r16 * 64 + quad * 4;
#pragma unroll
                  for (int mi = 0; mi < 4; ++mi) {
                    const f32x4 gci = *(const LAS f32x4*)(gcl + 16 * mi + quad * 4), bei = *(const LAS f32x4*)(gcl + 64 + 16 * mi + quad * 4);
#pragma unroll
                    for (int nj = 0; nj <= mi; ++nj) {
                        f32x4 c = (f32x4){0.f, 0.f, 0.f, 0.f};
#pragma unroll
                        for (int ks = 0; ks < 4; ++ks) c = __builtin_amdgcn_mfma_f32_16x16x32_bf16(Kf[mi][ks], Kf[nj][ks], c, 0, 0, 0);
                        const float gcj = gcl[16 * nj + r16]; f32x4 mv4;
#pragma unroll
                        for (int r = 0; r < 4; ++r) { const bool strict = (nj < mi) || (r16 < quad * 4 + r); mv4[r] = strict ? -(bei[r] * c[r] * __expf(gci[r] - gcj)) : 0.f; }
                        *(LAS f32x4*)(mw + (16 * nj) * 64 + 16 * mi) = mv4;
                    }
                  } }
                asm volatile("" ::: "memory");
                LDS_WAIT();
                float Xs[64];
                { const bf16* src = QKV + (size_t)rb * 1536 + (q < 2 ? 1024 + 64 * q : 512 + 64 * (q - 2)) + hh * 128 + lane_l; const long sstep = sg * 1536;
                  bf16 raw[64];
#pragma unroll
                  for (int sidx = 0; sidx < 64; ++sidx) { raw[sidx] = *src; src += sstep; }
                  asm volatile("" ::: "memory");
#pragma unroll
                  for (int sidx = 0; sidx < 64; ++sidx) { const float sc = __builtin_bit_cast(float, __builtin_amdgcn_readlane(__builtin_bit_cast(int, scl), sidx)); Xs[sidx] = bf1(raw[sidx]) * sc; } }
#pragma unroll
                for (int g4 = 0; g4 < 16; ++g4) {
                    f32x4 acc = (f32x4){Xs[4 * g4], Xs[4 * g4 + 1], Xs[4 * g4 + 2], Xs[4 * g4 + 3]};
#pragma unroll
                    for (int c0 = 0; c0 < 4 * g4; c0 += 16) {
                        f32x4 mb[16];
#pragma unroll
                        for (int e = 0; e < 16; ++e) if (c0 + e < 4 * g4) mb[e] = *(const LAS f32x4*)(Mt + (c0 + e) * 64 + 4 * g4);
                        LDS_WAIT();
#pragma unroll
                        for (int e = 0; e < 16; ++e) if (c0 + e < 4 * g4) acc += mb[e] * Xs[c0 + e];
                    }
                    const f32x4 m0 = *(const LAS f32x4*)(Mt + (4 * g4) * 64 + 4 * g4), m1 = *(const LAS f32x4*)(Mt + (4 * g4 + 1) * 64 + 4 * g4), m2 = *(const LAS f32x4*)(Mt + (4 * g4 + 2) * 64 + 4 * g4);
                    LDS_WAIT();
                    const float x0 = acc[0], x1 = acc[1] + m0[1] * x0, x2 = acc[2] + m0[2] * x0 + m1[2] * x1, x3 = acc[3] + m0[3] * x0 + m1[3] * x1 + m2[3] * x2;
                    Xs[4 * g4] = x0; Xs[4 * g4 + 1] = x1; Xs[4 * g4 + 2] = x2; Xs[4 * g4 + 3] = x3;
                }
                if (q < 2) {
                    bf16* u0 = UIT + (size_t)item * 8192 + (size_t)(64 * q + lane_l) * 64;
#pragma unroll
                    for (int p = 0; p < 8; ++p) { float c0[8];
#pragma unroll
                        for (int e = 0; e < 8; ++e) c0[e] = Xs[8 * p + e];
                        *(v4u*)(u0 + 8 * p) = pack8(c0); }
                } else {
                    bf16* w0 = WIT + (size_t)item * 8192 + 64 * (q - 2) + lane_l;
#pragma unroll
                    for (int sidx = 0; sidx < 64; ++sidx) { w0[sidx * 128] = (bf16)f2bf(Xs[sidx]); if ((sidx & 15) == 15) asm volatile("" ::: "memory"); }
                    asm volatile("" ::: "memory");
                    if (dir == 0) {
                        const bf16* src = QKV + (size_t)row0 * 1536 + 512 + hh * 128 + 64 * (q - 2) + lane_l;
                        bf16* k0 = KIT + ((size_t)((b * 4 + hh) * 36 + cidx)) * 8192 + ((size_t)(2 * (4 * (q - 2) + (lane_l >> 4))) * 64 + (lane_l & 15)) * 8;
                        unsigned kw[64];
#pragma unroll
                        for (int e = 0; e < 64; ++e) kw[e] = src[(size_t)e * 1536];
                        asm volatile("" ::: "memory");
#pragma unroll
                        for (int p = 0; p < 8; ++p) { v4u lo; lo.x = kw[8 * p] | (kw[8 * p + 1] << 16); lo.y = kw[8 * p + 2] | (kw[8 * p + 3] << 16); lo.z = kw[8 * p + 4] | (kw[8 * p + 5] << 16); lo.w = kw[8 * p + 6] | (kw[8 * p + 7] << 16);
                            *(v4u*)(k0 + ((p >> 2) * 64 + (p & 3) * 16) * 8) = lo; }
                    }
                }
                LDS_WAIT();
            }
        } }
        SEAM(pb + 3);

        for (int rep_ = 0; rep_ <= (int)PH_REP(5); ++rep_) { if (rep_) GRID_BAR();
        if (PH_ON(5) && IN(pb + 4)) { PH_BEGIN(); const float* mv = modv + (size_t)l * 9 * 6144; (void)mv; unsigned* const moecnt = ctl + CW_MOE + l * 16 * 64; (void)moecnt;
            LAS bf16* const STl = (LAS bf16*)lds;
            LAS bf16* const VNl = (LAS bf16*)(lds + 8704);
            LAS bf16* const VSl = (LAS bf16*)(lds + 13312);
            LAS bf16* const OTl = (LAS bf16*)(lds + 17920);
            const int w = X.wave, mt = w & 3, role = w >> 2, r16 = lane & 15, quad = lane >> 4;
            for (int blk = X.bid; blk < 256; blk += X.G) {
                const int item = (blk & 7) * 32 + (blk >> 3);
                const int chain = item >> 2, slice = item & 3, dir = chain & 1, hh = (chain >> 1) & 3, b = chain >> 3;
                bf16* const O = dir ? OB : OF;
                __syncthreads();
                for (int i = tid; i < 32 * 136 / 2; i += 512) ((LAS unsigned*)STl)[i] = 0u;
                __syncthreads();
                f32x4 Sacc[2]; Sacc[0] = (f32x4){0.f, 0.f, 0.f, 0.f}; Sacc[1] = (f32x4){0.f, 0.f, 0.f, 0.f};
#define GDN_LOAD(P, step_) do { const int cidx_ = dir ? ((step_) < 4 ? 3 - (step_) : 39 - (step_)) : (step_); const int item_ = chain * 36 + cidx_, kti_ = (chain >> 1) * 36 + cidx_; \
                    const int row0_ = cidx_ < 4 ? NLAT + b * CTXL + cidx_ * 64 : b * SEQ + (cidx_ - 4) * 64; \
                    const bf16* xp_ = role ? QKV + (size_t)(row0_ + (dir ? 63 - (16 * mt + r16) : 16 * mt + r16)) * 1536 + hh * 128 + quad * 8 : WIT + (size_t)item_ * 8192 + (16 * mt + r16) * 128 + quad * 8; \
                    _Pragma("unroll") for (int ks = 0; ks < 4; ++ks) P##Xf[ks] = *(const bf16x8*)(xp_ + 32 * ks); \
                    { const bf16* kp_ = KIT + (size_t)kti_ * 8192 + (dir ? ((2 * w + 1) * 64 + (3 - quad) * 16 + r16) * 8 : (2 * w * 64 + quad * 16 + r16) * 8);     \
                      _Pragma("unroll") for (int ks = 0; ks < 2; ++ks) P##Kx[ks] = *(const v4u*)(kp_ + (dir ? -512 * ks : 512 * ks)); } \
                    const float* sp_ = SIT + (size_t)item_ * 192; P##sc4 = *(const f32x4*)(sp_ + (role ? 0 : 64) + 16 * mt + quad * 4); P##egl = sp_[128]; \
                      \
                    { const bf16* a0_ = role ? AIT + (size_t)item_ * 4096 + (16 * mt + r16) * 64 + quad * 8 : UIT + (size_t)item_ * 8192 + (size_t)(slice * 32 + r16) * 64 + 16 * mt + quad * 4; \
                      const bf16* a1_ = role ? a0_ + 32 : a0_ + 16 * 64; \
                      P##Ax[0] = *(const v2u*)a0_; P##Ax[1] = *(const v2u*)(a0_ + 4); P##Ax[2] = *(const v2u*)a1_; P##Ax[3] = *(const v2u*)(a1_ + 4); } } while (0)
#define GDN_BAR() do { asm volatile("s_waitcnt lgkmcnt(0)" ::: "memory"); __builtin_amdgcn_s_barrier(); asm volatile("" ::: "memory"); } while (0)
#define GDN_STEP(P, step_) do { const int cidx = dir ? ((step_) < 4 ? 3 - (step_) : 39 - (step_)) : (step_); \
                    const int row0 = cidx < 4 ? NLAT + b * CTXL + cidx * 64 : b * SEQ + (cidx - 4) * 64; \
                      \
                    f32x4 x1[2]; x1[0] = (f32x4){0.f, 0.f, 0.f, 0.f}; x1[1] = (f32x4){0.f, 0.f, 0.f, 0.f}; \
                    { bf16x8 bfr[2][4]; \
                      _Pragma("unroll") for (int n_ = 0; n_ < 2; ++n_) _Pragma("unroll") for (int ks = 0; ks < 4; ++ks) bfr[n_][ks] = *(const LAS bf16x8*)(STl + (16 * n_ + r16) * 136 + 32 * ks + quad * 8); \
                      asm volatile("s_waitcnt lgkmcnt(0)" ::: "memory"); \
                      _Pragma("unroll") for (int ks = 0; ks < 4; ++ks) { x1[0] = __builtin_amdgcn_mfma_f32_16x16x32_bf16(P##Xf[ks], bfr[0][ks], x1[0], 0, 0, 0); x1[1] = __builtin_amdgcn_mfma_f32_16x16x32_bf16(P##Xf[ks], bfr[1][ks], x1[1], 0, 0, 0); } } \
                    if (role == 0) { \
                        _Pragma("unroll") for (int n_ = 0; n_ < 2; ++n_) { f32x4 vn; vn[0] = bflo(P##Ax[2 * n_].x) - x1[n_][0]; vn[1] = bfhi(P##Ax[2 * n_].x) - x1[n_][1]; vn[2] = bflo(P##Ax[2 * n_].y) - x1[n_][2]; vn[3] = bfhi(P##Ax[2 * n_].y) - x1[n_][3]; \
                            v2u p; p.x = pk2(vn[0], vn[1]); p.y = pk2(vn[2], vn[3]); *(LAS v2u*)(VNl + (16 * n_ + r16) * 72 + 16 * mt + quad * 4) = p; \
                            v2u q; q.x = pk2(vn[0] * P##sc4[0], vn[1] * P##sc4[1]); q.y = pk2(vn[2] * P##sc4[2], vn[3] * P##sc4[3]); *(LAS v2u*)(VSl + (16 * n_ + r16) * 72 + 16 * mt + quad * 4) = q; } } \
                    else { x1[0] = x1[0] * P##sc4; x1[1] = x1[1] * P##sc4; } \
                    bf16x8 kt_[2]; \
                    _Pragma("unroll") for (int ks = 0; ks < 2; ++ks) { const v4u kx_ = P##Kx[ks]; v4u kr_; \
                        kr_.x = dir ? ((kx_.w >> 16) | (kx_.w << 16)) : kx_.x; kr_.y = dir ? ((kx_.z >> 16) | (kx_.z << 16)) : kx_.y; kr_.z = dir ? ((kx_.y >> 16) | (kx_.y << 16)) : kx_.z; kr_.w = dir ? ((kx_.x >> 16) | (kx_.x << 16)) : kx_.w; \
                        kt_[ks] = __builtin_bit_cast(bf16x8, kr_); } \
                    GDN_BAR(); \
                      \
                    bf16x8 vsf[2][2]; \
                    _Pragma("unroll") for (int n2 = 0; n2 < 2; ++n2) { vsf[n2][0] = *(const LAS bf16x8*)(VSl + (16 * n2 + r16) * 72 + quad * 8); vsf[n2][1] = *(const LAS bf16x8*)(VSl + (16 * n2 + r16) * 72 + 32 + quad * 8); } \
                    if (role) { bf16x8 vb[2][2]; \
                        _Pragma("unroll") for (int n_ = 0; n_ < 2; ++n_) { vb[n_][0] = *(const LAS bf16x8*)(VNl + (16 * n_ + r16) * 72 + quad * 8); vb[n_][1] = *(const LAS bf16x8*)(VNl + (16 * n_ + r16) * 72 + 32 + quad * 8); } \
                        asm volatile("s_waitcnt lgkmcnt(0)" ::: "memory"); \
                        v4u af0_; af0_.x = P##Ax[0].x; af0_.y = P##Ax[0].y; af0_.z = P##Ax[1].x; af0_.w = P##Ax[1].y; v4u af1_; af1_.x = P##Ax[2].x; af1_.y = P##Ax[2].y; af1_.z = P##Ax[3].x; af1_.w = P##Ax[3].y; \
                        const bf16x8 Af0_ = __builtin_bit_cast(bf16x8, af0_), Af1_ = __builtin_bit_cast(bf16x8, af1_); \
                        _Pragma("unroll") for (int n_ = 0; n_ < 2; ++n_) { f32x4 oa = __builtin_amdgcn_mfma_f32_16x16x32_bf16(Af0_, vb[n_][0], x1[n_], 0, 0, 0); oa = __builtin_amdgcn_mfma_f32_16x16x32_bf16(Af1_, vb[n_][1], oa, 0, 0, 0); \
                            LAS bf16* ot_ = OTl + (16 * mt + quad * 4) * 36 + 16 * n_ + r16; \
                            _Pragma("unroll") for (int j = 0; j < 4; ++j) ot_[j * 36] = (bf16)f2bf(oa[j]); } } \
                    else { asm volatile("s_waitcnt lgkmcnt(0)" ::: "memory"); } \
                    _Pragma("unroll") for (int n2 = 0; n2 < 2; ++n2) { \
                        f32x4 sa = Sacc[n2] * P##egl; sa = __builtin_amdgcn_mfma_f32_16x16x32_bf16(kt_[0], vsf[n2][0], sa, 0, 0, 0); sa = __builtin_amdgcn_mfma_f32_16x16x32_bf16(kt_[1], vsf[n2][1], sa, 0, 0, 0); Sacc[n2] = sa; \
                        v2u p; p.x = pk2(sa[0], sa[1]); p.y = pk2(sa[2], sa[3]); *(LAS v2u*)(STl + (16 * n2 + r16) * 136 + 16 * w + quad * 4) = p; } \
                    GDN_BAR(); \
                      \
                    { const int tk_ = 8 * w + (lane >> 3), pc_ = lane & 7; const v2u ov_ = *(const LAS v2u*)(OTl + tk_ * 36 + 4 * pc_); \
                      *(v2u*)(O + (size_t)(row0 + (dir ? 63 - tk_ : tk_)) * 512 + hh * 128 + slice * 32 + 4 * pc_) = ov_; } } while (0)
#define GDN_DECL(P) bf16x8 P##Xf[4]; v4u P##Kx[2]; v2u P##Ax[4]; f32x4 P##sc4; float P##egl
                GDN_DECL(sa_); GDN_DECL(sb_);
                GDN_LOAD(sa_, 0);
                *(v2u*)(ws + WS_END + ((size_t)X.bid * 512 + tid) * 8) = (v2u){0u, 0u};
                for (int step = 0; step < 36; step += 2) {
                    GDN_LOAD(sb_, step + 1); GDN_STEP(sa_, step);
                    { const int s2 = step + 2 < 36 ? step + 2 : 35; GDN_LOAD(sa_, s2); } GDN_STEP(sb_, step + 1);
                }
#undef GDN_STEP
#undef GDN_BAR
#undef GDN_DECL
#undef GDN_LOAD
            }
        } }
        SEAM(pb + 4);

        for (int rep_ = 0; rep_ <= (int)PH_REP(6); ++rep_) { if (rep_) GRID_BAR();
        if (PH_ON(6) && IN(pb + 5)) { PH_BEGIN(); const float* mv = modv + (size_t)l * 9 * 6144; (void)mv; unsigned* const moecnt = ctl + CW_MOE + l * 16 * 64; (void)moecnt;
            const float* nw = INP(I_GNORM) + l * 128; const int ch = 8 * lane;
            const f32x4 nw0 = *(const f32x4*)(nw + (ch & 127)), nw1 = *(const f32x4*)(nw + (ch & 127) + 4);
            constexpr int ERT = 9;
            for (int rowb = gw; rowb < nrows2; rowb += ERT * NGW) {
                v4u lf[ERT], lb[ERT], lz[ERT];
#pragma unroll
                for (int k = 0; k < ERT; ++k) { const int row_ = rowb + k * NGW, row = row_ < nrows2 ? row_ : nrows2 - 1; lf[k] = *(const v4u*)(OF + (size_t)row * 512 + ch); lb[k] = *(const v4u*)(OB + (size_t)row * 512 + ch); lz[k] = *(const v4u*)(PZ + (size_t)row * 512 + ch); }
#pragma unroll
                for (int k = 0; k < ERT; ++k) { const int row_ = rowb + k * NGW, row = row_ < nrows2 ? row_ : nrows2 - 1; {
                    float of[8], ob[8], z[8], o[8]; unpack8(lf[k], of); unpack8(lb[k], ob); unpack8(lz[k], z); float ss = 0.f;
#pragma unroll
                    for (int e = 0; e < 8; ++e) { of[e] += ob[e]; ss += of[e] * of[e]; }
                    const float rs = __builtin_amdgcn_rsqf(g16_sum(ss) * (1.0f / 128.0f) + LN_EPS);
#pragma unroll
                    for (int e = 0; e < 4; ++e) { o[e] = of[e] * rs * nw0[e] * z[e]; o[4 + e] = of[4 + e] * rs * nw1[e] * z[4 + e]; }
                    if (row_ < nrows2) *(v4u*)(BR + (size_t)row * 512 + ch) = pack8(o); } }
            }
        } }
        SEAM(pb + 5);

        for (int rep_ = 0; rep_ <= (int)PH_REP(7); ++rep_) { if (rep_) GRID_BAR();
        if (PH_ON(7) && IN(pb + 6)) { PH_BEGIN(); const float* mv = modv + (size_t)l * 9 * 6144; (void)mv; unsigned* const moecnt = ctl + CW_MOE + l * 16 * 64; (void)moecnt;
            SchedBranch S{X.G, X.bid, npan2, (const char*)BR, (const char*)WBR};
            EpiBf16<0> E{GT, 4096, nullptr};
            pg8::gemm_phase<EpiBf16<0>, SchedBranch, true, true>(lds, Gemm{512, 512, 512}, S, E);
        } }
        SEAM(pb + 6);

        for (int rep_ = 0; rep_ <= (int)PH_REP(8); ++rep_) { if (rep_) GRID_BAR();
        if (PH_ON(8) && IN(pb + 7)) { PH_BEGIN(); const float* mv = modv + (size_t)l * 9 * 6144; (void)mv; unsigned* const moecnt = ctl + CW_MOE + l * 16 * 64; (void)moecnt;
            SchedGrid S{X.G, X.bid, npan2, 16, (const char*)XN, (const char*)(WIN + (size_t)5120 * 1024), (size_t)256 * 1024 * 2, (size_t)256 * 1024 * 2};
            EpiGateMerge E{GT, (bf16*)MERGED, binv + 5120};
            pg8::gemm_phase<EpiGateMerge, SchedGrid, true, true>(lds, Gemm{1024, 1024, 1024}, S, E);
        } }
        SEAM(pb + 7);

        for (int rep_ = 0; rep_ <= (int)PH_REP(9); ++rep_) { if (rep_) GRID_BAR();
        if (PH_ON(9) && IN(pb + 8)) { PH_BEGIN(); const float* mv = modv + (size_t)l * 9 * 6144; (void)mv; unsigned* const moecnt = ctl + CW_MOE + l * 16 * 64; (void)moecnt;
            SchedGrid S{X.G, X.bid, npan2, 4, (const char*)MERGED, (const char*)WOUT, (size_t)256 * 1024 * 2, (size_t)256 * 1024 * 2};
            EpiBf16<0> E{(bf16*)YB, 1024, INP(I_BOUT) + l * 1024};
            pg8::gemm_phase<EpiBf16<0>, SchedGrid, true, true>(lds, Gemm{1024, 1024, 1024}, S, E);
            __syncthreads();
            { LAS float* const wscr = (LAS float*)(lds + X.wave * 8448);
              const int first = npan2 * 4 > X.G ? npan2 * 4 - X.G : 0;
              if (X.bid >= first) { const int gwc = (X.bid - first) * NWAVES + X.wave, ngwc = (X.G - first) * NWAVES;
              for (int it = gwc; it < 12288; it += ngwc) {
                if (it < 8192) { const int e = it >> 9, rb = (it & 3) + 4 * ((it >> 3) & 7), kb = ((it >> 2) & 1) + 2 * ((it >> 6) & 7), row0 = rb * 32, j = row0 >> 8, w = row0 & 255;
                    const float* src = (w < 128 ? INP(I_EWG) : INP(I_EWU)) + ((size_t)(l * 16 + e) * 1024) * 512;
                    cvt_item(src, 512, 128 * j + (w & 127) + (lane & 31), kb * 64, WGU + ((size_t)e * 1024 + row0) * 1024, 1024, wscr, lane); }
                else { const int i2 = it - 8192; const int e = i2 >> 8, rb = (i2 & 3) + 4 * ((i2 >> 3) & 7), kb = ((i2 >> 2) & 1) + 2 * ((i2 >> 6) & 3);
                    cvt_item(INP(I_EWD) + ((size_t)(l * 16 + e) * 512) * 1024, 1024, rb * 32 + (lane & 31), kb * 64, WDN + ((size_t)e * 1024 + rb * 32) * 512, 512, wscr, lane); }
              } } }
        } }
        SEAM(pb + 8);

        for (int rep_ = 0; rep_ <= (int)PH_REP(10); ++rep_) { if (rep_) GRID_BAR();
        if (PH_ON(10) && IN(pb + 9)) { PH_BEGIN(); const float* mv = modv + (size_t)l * 9 * 6144; (void)mv; unsigned* const moecnt = ctl + CW_MOE + l * 16 * 64; (void)moecnt;
            LAS float* wr_ = (LAS float*)lds;
            volatile LAS unsigned* lcnt = (volatile LAS unsigned*)(lds + 100352);
            __syncthreads();
            if (tid < 32) lcnt[tid] = 0u;
            { f32x4 rq[10];
#pragma unroll
              for (int j = 0; j < 2; ++j) rq[j] = *(const f32x4*)(INP(I_RGW) + (size_t)l * 4096 + (size_t)(tid + 512 * j) * 4);
#pragma unroll
              for (int j = 0; j < 8; ++j) rq[2 + j] = *(const f32x4*)(INP(I_REW) + (size_t)l * 16384 + (size_t)(tid + 512 * (j & 1)) * 16 + 4 * (j >> 1));
#pragma unroll
              for (int j = 0; j < 2; ++j) { LAS float* p = wr_ + tid + 512 * j; p[0] = rq[j][0]; p[1024] = rq[j][1]; p[2048] = rq[j][2]; p[3072] = rq[j][3]; }
#pragma unroll
              for (int j = 0; j < 8; ++j) { LAS float* p = wr_ + (4 + 4 * (j >> 1)) * 1024 + tid + 512 * (j & 1); p[0] = rq[2 + j][0]; p[1024] = rq[2 + j][1]; p[2048] = rq[2 + j][2]; p[3072] = rq[2 + j][3]; } }
            __syncthreads();
            const float* g1 = INP(I_LN1G) + l * 1024, *b1 = INP(I_LN1B) + l * 1024;
            const float rgb_l = INP(I_RGB)[l * 4 + ((lane >> 4) & 3)], reb_l = INP(I_REB)[l * 16 + ((lane >> 2) & 15)];
            constexpr int RT = 2;
            for (int rowb = gw; rowb < nrows2; rowb += RT * NGW) {
                f32x4 v[RT][4];
#pragma unroll
                for (int q = 0; q < RT; ++q) { const int row_ = rowb + q * NGW, row = row_ < nrows2 ? row_ : nrows2 - 1; const bool live = row_ < nrows2;
                    float* hrow = row < NLAT ? hlat + (size_t)row * D : hctx + (size_t)(row - NLAT) * D;
                    const int mi = row < NLAT ? (row >> 11) : 8; const float* mrow = mv + mi * 6144;
                    v2u yw[4]; f32x4 hv[4], gt[4], g1v[4], b1v[4], scv[4], shv[4];
#pragma unroll
                    for (int j = 0; j < 4; ++j) { const int c = 4 * lane + 256 * j; yw[j] = *(const v2u*)((const bf16*)YB + (size_t)row * D + c); hv[j] = *(const f32x4*)(hrow + c); gt[j] = *(const f32x4*)(mrow + 2048 + c); }
#pragma unroll
                    for (int j = 0; j < 4; ++j) { const int c = 4 * lane + 256 * j; g1v[j] = *(const f32x4*)(g1 + c); b1v[j] = *(const f32x4*)(b1 + c); scv[j] = *(const f32x4*)(mrow + 4096 + c); shv[j] = *(const f32x4*)(mrow + 3072 + c); }
#pragma unroll
                    for (int j = 0; j < 4; ++j) { const f32x4 yv = (f32x4){bflo(yw[j].x), bfhi(yw[j].x), bflo(yw[j].y), bfhi(yw[j].y)}; v[q][j] = hv[j] * DN_ALPHA + gt[j] * yv; }
                    ln_rows(v[q]);
#pragma unroll
                    for (int j = 0; j < 4; ++j) { const int c = 4 * lane + 256 * j; v[q][j] = v[q][j] * g1v[j] + b1v[j]; if (live) *(f32x4*)(hrow + c) = v[q][j]; }
                    ln_rows(v[q]);
#pragma unroll
                    for (int j = 0; j < 4; ++j) { const int c = 4 * lane + 256 * j; v[q][j] = v[q][j] * (scv[j] + 1.0f) + shv[j];
                        v2u w; w.x = pk2(v[q][j][0], v[q][j][1]); w.y = pk2(v[q][j][2], v[q][j][3]); if (live) *(v2u*)(XN + (size_t)row * D + c) = w; }
                    asm volatile("" ::: "memory"); }
                static_assert(RT == 2, "the two rows of a trip ride in the two halves of packed f32 operations");
                float pg[RT][4], pe[RT][16];
                { f32x2 vp[4][4];
#pragma unroll
                  for (int j = 0; j < 4; ++j)
#pragma unroll
                      for (int e = 0; e < 4; ++e) vp[j][e] = (f32x2){v[0][j][e], v[1][j][e]};
#pragma unroll
                  for (int o = 0; o < 20; ++o) { f32x2 sr = (f32x2){0.f, 0.f};
#pragma unroll
                    for (int j = 0; j < 4; ++j) { const f32x4 w = *(const LAS f32x4*)(wr_ + o * 1024 + 4 * lane + 256 * j);
#pragma unroll
                        for (int e = 0; e < 4; ++e) sr += vp[j][e] * w[e]; }
                    if (o < 4) { pg[0][o] = sr[0]; pg[1][o] = sr[1]; } else { pe[0][o - 4] = sr[0]; pe[1][o - 4] = sr[1]; }
                    if ((o & 3) == 3) asm volatile("" ::: "memory"); } }
#pragma unroll
                for (int q = 0; q < RT; ++q) { const int row = rowb + q * NGW;
                float tg = reduce4(pg[q], lane), te = reduce16(pe[q], lane);
                tg += rgb_l; te += reb_l;
                float lg[20];
#pragma unroll
                for (int o = 0; o < 4; ++o) lg[o] = __shfl(tg, o * 16);
#pragma unroll
                for (int o = 0; o < 16; ++o) lg[4 + o] = __shfl(te, o * 4);
                int gs = 0; float gm = lg[0];
#pragma unroll
                for (int o = 1; o < 4; ++o) if (lg[o] > gm) { gm = lg[o]; gs = o; }
                float den = 0.f;
#pragma unroll
                for (int o = 0; o < 4; ++o) den += __expf(lg[o] - gm);
                const float gp = __builtin_amdgcn_rcpf(den);
                float el[4];
#pragma unroll
                for (int o = 0; o < 4; ++o) el[o] = gs == 0 ? lg[4 + o] : gs == 1 ? lg[8 + o] : gs == 2 ? lg[12 + o] : lg[16 + o];
                int i0 = 0; float v0 = el[0];
#pragma unroll
                for (int o = 1; o < 4; ++o) if (el[o] > v0) { v0 = el[o]; i0 = o; }
                int i1 = -1; float v1 = 0.f;
#pragma unroll
                for (int o = 0; o < 4; ++o) if (o != i0 && (i1 < 0 || el[o] > v1)) { v1 = el[o]; i1 = o; }
                const float ex = __expf(v1 - v0), rz = __builtin_amdgcn_rcpf(1.0f + ex), w0 = gp * rz, w1 = gp * ex * rz;
                const int e0 = gs * 4 + i0, e1 = gs * 4 + i1;
                if (lane == 0 && row < nrows2) {
                    const unsigned p0 = __hip_atomic_fetch_add((LAS unsigned*)lcnt + e0, 1u, __ATOMIC_RELAXED, __HIP_MEMORY_SCOPE_WORKGROUP);
                    const unsigned p1 = __hip_atomic_fetch_add((LAS unsigned*)lcnt + e1, 1u, __ATOMIC_RELAXED, __HIP_MEMORY_SCOPE_WORKGROUP);
                    float* rt = ROUTE + (size_t)row * 8;
                    rt[0] = __builtin_bit_cast(float, e0); rt[1] = __builtin_bit_cast(float, e1); rt[2] = w0; rt[3] = w1; rt[4] = __builtin_bit_cast(float, (int)p0); rt[5] = __builtin_bit_cast(float, (int)p1);
                }
                asm volatile("" ::: "memory"); }
            }
            __syncthreads();
            if (tid < 16) { const unsigned c = lcnt[tid]; lcnt[16 + tid] = c ? __hip_atomic_fetch_add(moecnt + 64 * tid, c, __ATOMIC_RELAXED, __HIP_MEMORY_SCOPE_AGENT) : 0u; }
            __syncthreads();
            for (int row = gw + lane * NGW; row < nrows2; row += 64 * NGW) {
                { float* rt = ROUTE + (size_t)row * 8; const int e0 = __builtin_bit_cast(int, rt[0]), e1 = __builtin_bit_cast(int, rt[1]);
                    const int q0 = __builtin_bit_cast(int, rt[4]) + (int)lcnt[16 + e0], q1 = __builtin_bit_cast(int, rt[5]) + (int)lcnt[16 + e1];
                    rt[4] = __builtin_bit_cast(float, q0); rt[5] = __builtin_bit_cast(float, q1);
                    ELIST[(size_t)e0 * NTOK + q0] = row; ELIST[(size_t)e1 * NTOK + q1] = row; }
            }
        } }
        SEAM(pb + 9);


        for (int rep_ = 0; rep_ <= (int)PH_REP(12); ++rep_) { if (rep_) GRID_BAR();
        if (PH_ON(12) && IN(pb + 11)) { PH_BEGIN(); const float* mv = modv + (size_t)l * 9 * 6144; (void)mv; unsigned* const moecnt = ctl + CW_MOE + l * 16 * 64; (void)moecnt;
            SchedMoeG S; S.G = X.G; S.c = X.bid; S.a0 = (const char*)XN; S.w0 = (const char*)WGU; S.wstep_e = (size_t)1024 * 1024 * 2; S.wstep_n = (size_t)256 * 1024 * 2; S.list = ELIST; S.init(moecnt, (LAS unsigned*)(lds + LDSCTL_OFF + 64));
            EpiMoe1 E{HID};
            pg8::gemm_phase<EpiMoe1, SchedMoeG, true, true>(lds, Gemm{1024, 1024, 1024}, S, E);
        } }
        SEAM(pb + 11);

        for (int rep_ = 0; rep_ <= (int)PH_REP(13); ++rep_) { if (rep_) GRID_BAR();
        if (PH_ON(13) && IN(pb + 12)) { PH_BEGIN(); const float* mv = modv + (size_t)l * 9 * 6144; (void)mv; unsigned* const moecnt = ctl + CW_MOE + l * 16 * 64; (void)moecnt;
            SchedMoe S; S.G = X.G; S.c = X.bid; S.a0 = (const char*)HID; S.w0 = (const char*)WDN; S.astep = (size_t)256 * 512 * 2; S.wstep_e = (size_t)1024 * 512 * 2; S.wstep_n = (size_t)256 * 512 * 2; S.init(moecnt);
            EpiBf16<0> E{MO, 1024, nullptr};
            pg8::gemm_phase<EpiBf16<0>, SchedMoe, true, true>(lds, Gemm{512, 512, 512}, S, E);
        } }
        SEAM(pb + 12);

        for (int rep_ = 0; rep_ <= (int)PH_REP(14); ++rep_) { if (rep_) GRID_BAR();
        if (PH_ON(14) && IN(pb + 13)) { PH_BEGIN(); const float* mv = modv + (size_t)l * 9 * 6144; (void)mv; unsigned* const moecnt = ctl + CW_MOE + l * 16 * 64; (void)moecnt;
            unsigned pre[16]; { unsigned s = 0;
#pragma unroll
                for (int e = 0; e < 16; ++e) { pre[e] = s; s += ((__hip_atomic_load(moecnt + 64 * e, __ATOMIC_RELAXED, __HIP_MEMORY_SCOPE_AGENT) + 255u) >> 8) << 8; } }
            const float* g2 = INP(I_LN2G) + l * 1024, *b2 = INP(I_LN2B) + l * 1024;
            for (int rowb = gw; rowb < nrows2; rowb += 3 * NGW) {
                int re0[3], re1[3], rp0[3], rp1[3]; float rw0[3], rw1[3];
#pragma unroll
                for (int k = 0; k < 3; ++k) { const int row_ = rowb + k * NGW, row = row_ < nrows2 ? row_ : nrows2 - 1; const float* rt = ROUTE + (size_t)row * 8;
                    re0[k] = __builtin_bit_cast(int, rt[0]); re1[k] = __builtin_bit_cast(int, rt[1]); rw0[k] = rt[2]; rw1[k] = rt[3]; rp0[k] = __builtin_bit_cast(int, rt[4]); rp1[k] = __builtin_bit_cast(int, rt[5]); }
                v2u ma[3][4], mb[3][4]; f32x4 hv[3][4];
#pragma unroll
                for (int k = 0; k < 3; ++k) { const int row_ = rowb + k * NGW, row = row_ < nrows2 ? row_ : nrows2 - 1; {
                    const int e0 = re0[k], e1 = re1[k]; unsigned ba0 = 0, ba1 = 0;
#pragma unroll
                    for (int q = 0; q < 16; ++q) { ba0 = (q == e0) ? pre[q] : ba0; ba1 = (q == e1) ? pre[q] : ba1; }
                    const bf16* m0 = MO + (size_t)(ba0 + (unsigned)rp0[k]) * D, *m1 = MO + (size_t)(ba1 + (unsigned)rp1[k]) * D;
                    const float* hrow = row < NLAT ? hlat + (size_t)row * D : hctx + (size_t)(row - NLAT) * D;
#pragma unroll
                    for (int j = 0; j < 4; ++j) { const int c = 4 * lane + 256 * j; ma[k][j] = *(const v2u*)(m0 + c); mb[k][j] = *(const v2u*)(m1 + c); hv[k][j] = *(const f32x4*)(hrow + c); } } }
#pragma unroll
                for (int k = 0; k < 3; ++k) { const int row_ = rowb + k * NGW, row = row_ < nrows2 ? row_ : nrows2 - 1; {
                    float* hrow = row < NLAT ? hlat + (size_t)row * D : hctx + (size_t)(row - NLAT) * D;
                    const int mi = row < NLAT ? (row >> 11) : 8; const float* mrow = mv + mi * 6144; const float w0 = rw0[k], w1 = rw1[k];
                    f32x4 v[4], gtv[4], g2v[4], b2v[4];
#pragma unroll
                    for (int j = 0; j < 4; ++j) { const int c = 4 * lane + 256 * j; gtv[j] = *(const f32x4*)(mrow + 5120 + c); g2v[j] = *(const f32x4*)(g2 + c); b2v[j] = *(const f32x4*)(b2 + c); }
#pragma unroll
                    for (int j = 0; j < 4; ++j) { const v2u a = ma[k][j], b = mb[k][j];
                        f32x4 mm; mm[0] = w0 * bflo(a.x) + w1 * bflo(b.x); mm[1] = w0 * bfhi(a.x) + w1 * bfhi(b.x); mm[2] = w0 * bflo(a.y) + w1 * bflo(b.y); mm[3] = w0 * bfhi(a.y) + w1 * bfhi(b.y);
                        v[j] = hv[k][j] * DN_ALPHA + gtv[j] * mm; }
                    ln_rows(v);
                    if (row_ < nrows2) {
#pragma unroll
                    for (int j = 0; j < 4; ++j) { const int c = 4 * lane + 256 * j; *(f32x4*)(hrow + c) = v[j] * g2v[j] + b2v[j]; } } } }
            }
        } }
        SEAM(pb + 13);
    }
#if TPROBE
    {
        GRID_BAR(); STAMP(NPHASES); GRID_BAR();
        unsigned* ts = (unsigned*)(args.ws + WS_CTL) + CW_TS; float T = 0.f;
        for (int l2 = 0; l2 < 2; ++l2) { const int p = (TPA) == 100 ? 0 : 1 + NPH_LAYER * l2 + (TPA);
            if ((TPA) != 100 || l2 == 0) T += (float)(__hip_atomic_load(ts + p + 1, __ATOMIC_RELAXED, __HIP_MEMORY_SCOPE_AGENT) - __hip_atomic_load(ts + p, __ATOMIC_RELAXED, __HIP_MEMORY_SCOPE_AGENT)) * 0.01f; }
        for (size_t i = (size_t)blockIdx.x * 512 + threadIdx.x; i < (size_t)NLAT * D; i += (size_t)gridDim.x * 512) { const int j = (int)(i >> 19);
            if (T >= (float)(TOFF) + 20.0f * (float)(j + 1)) args.out[i] += 0.2f; }
    }
#endif
#undef IN
#undef SEAM
}

extern "C" void kernel_launch(void* const* d_in, const int* in_sizes, int n_in, void* d_out, int out_size, void* d_ws, size_t ws_size, hipStream_t stream) {
    static int grid = 0;
    if (grid == 0) {
        if (n_in != 34 || out_size != NLAT * D || ws_size < WS_END + MiB) { fprintf(stderr, "kernel_launch: unexpected problem (n_in %d out %d ws %zu)\n", n_in, out_size, ws_size); grid = -1; return; }
        int dev = 0, cus = 0, per_cu = 0;
        if (hipGetDevice(&dev) != hipSuccess || hipDeviceGetAttribute(&cus, hipDeviceAttributeMultiprocessorCount, dev) != hipSuccess) { grid = -1; return; }
        if (hipFuncSetAttribute((const void*)fwd, hipFuncAttributeMaxDynamicSharedMemorySize, LDS_BYTES) != hipSuccess) { fprintf(stderr, "kernel_launch: hipFuncSetAttribute failed\n"); grid = -1; return; }
        if (hipOccupancyMaxActiveBlocksPerMultiprocessor(&per_cu, (const void*)fwd, NWAVES * 64, LDS_BYTES) != hipSuccess || per_cu < 1) { fprintf(stderr, "kernel_launch: occupancy query reports %d\n", per_cu); }
        (void)hipGetLastError();
        grid = cus;
    }
    if (grid < 0) return;
    if (hipMemsetAsync((char*)d_ws + WS_CTL, 0, CTL_ZERO_BYTES, stream) != hipSuccess) return;
    Args a{};
    for (int i = 0; i < 34; ++i) a.in[i] = (const float*)d_in[i];
    a.out = (float*)d_out; a.ws = (unsigned char*)d_ws;
#if MK_ONE_LAUNCH
    a.ph_lo = 0; a.ph_hi = NPHASES;
    hipLaunchKernelGGL(fwd, dim3(grid), dim3(NWAVES * 64), LDS_BYTES, stream, a);
#else
    for (int p = 0; p < NPHASES; ++p) { a.ph_lo = p; a.ph_hi = p + 1; hipLaunchKernelGGL(fwd, dim3(grid), dim3(NWAVES * 64), LDS_BYTES, stream, a); }
#endif
}
```

```cpp
#include <hip/hip_runtime.h>
#include <cstdio>
#include <cstdint>

#define GAS __attribute__((address_space(1)))
#define LAS __attribute__((address_space(3)))
typedef unsigned short bf16;
typedef unsigned v4u __attribute__((ext_vector_type(4)));
typedef unsigned v2u __attribute__((ext_vector_type(2)));
typedef float f32x4 __attribute__((ext_vector_type(4)));
typedef float f32x2 __attribute__((ext_vector_type(2)));
typedef short bf16x8 __attribute__((ext_vector_type(8)));

constexpr int D = 1024, NB = 8, SEQ = 2048, CTXL = 256, NLAT = NB * SEQ, NCTX = NB * CTXL, NTOK = NLAT + NCTX;
constexpr int OFF_Q = 0, OFF_K = 512, OFF_V = 1024, OFF_Z = 1536, OFF_A = 2048, OFF_B = 2056, OFF_CONF = 2064, OFF_FFT = 3088, OFF_SGU = 3600, OFF_GATE = 4624, N_IN = 8720;
constexpr int NWROWS = 9216;
constexpr float LN_EPS = 1e-6f;
constexpr float DN_ALPHA = 1.4142135623730951f;
constexpr int NWAVES = 8;
constexpr int NPH_LAYER = 14, NPHASES = 1 + 2 * NPH_LAYER;

#ifndef PHMASK
#define PHMASK 0xFFFFFFFFu
#endif
#define PH_ON(k) (((PHMASK) >> (k)) & 1u)
#ifndef REPMASK
#define REPMASK 0u
#endif
#define PH_REP(k) (((REPMASK) >> (k)) & 1u)
#ifndef TPA
#define TPA -1
#endif
#ifndef TPB
#define TPB -1
#endif
#ifndef TOFF
#define TOFF 0
#endif
#define TPROBE ((TPA) >= 0 || (TPB) >= 0)
#ifndef CPART
#define CPART 15
#endif
#ifndef MK_ONE_LAUNCH
#define MK_ONE_LAUNCH 1
#endif

constexpr size_t MiB = 1u << 20;
constexpr size_t WS_CTL = 0, CTL_ZERO_BYTES = 128 * 1024;
constexpr size_t WS_MODV = 1 * MiB;
constexpr size_t WS_BIN = 1 * MiB + 512 * 1024;
constexpr size_t WS_ROUTE = WS_BIN + 64 * 1024;
constexpr size_t WS_HCTX = 3 * MiB;
constexpr size_t WS_XN = 11 * MiB;
constexpr size_t WS_WIN = 47 * MiB;
constexpr size_t WS_WBR = 65 * MiB;
constexpr size_t WS_WOUT = 69 * MiB;
constexpr size_t WS_DFTL = 71 * MiB;
constexpr size_t WS_DFTC = 87 * MiB;
constexpr size_t WS_F1B = 71 * MiB;
constexpr size_t WS_R2 = 88 * MiB;
constexpr size_t WS_PQKV = WS_R2;
constexpr size_t WS_PCONF = WS_R2 + 54 * MiB;
constexpr size_t WS_PZ = WS_R2 + 72 * MiB;
constexpr size_t WS_PSGU = WS_R2 + 90 * MiB;
constexpr size_t WS_PFFT = WS_R2 + 126 * MiB;
constexpr size_t WS_PFFTC = WS_R2 + 158 * MiB;
constexpr size_t WS_AB = WS_R2 + 162 * MiB;
constexpr size_t WS_WIT = WS_R2;
constexpr size_t WS_UIT = WS_R2 + 36 * MiB;
constexpr size_t WS_AIT = WS_R2 + 90 * MiB;
constexpr size_t WS_KIT = WS_R2 + 108 * MiB;
constexpr size_t WS_SIT = WS_R2 + 126 * MiB;
constexpr size_t WS_OF = WS_R2 + 128 * MiB;
constexpr size_t WS_OB = WS_R2 + 146 * MiB;
constexpr size_t WS_G = WS_R2;
constexpr size_t WS_WGU = WS_R2;
constexpr size_t WS_WDN = WS_R2 + 32 * MiB;
constexpr size_t WS_XG = WS_R2 + 48 * MiB;
constexpr size_t WS_R3 = WS_R2 + 164 * MiB;
constexpr size_t WS_QKV = WS_R3;
constexpr size_t WS_GB = WS_R3 + 54 * MiB;
constexpr size_t WS_BR = WS_R3 + 72 * MiB;
constexpr size_t WS_F1A = WS_BR;
constexpr size_t WS_MERGED = WS_R3;
constexpr size_t WS_Y = WS_R3 + 72 * MiB;
constexpr size_t WS_HID = WS_R3;
constexpr size_t WS_MO = WS_R3 + 40 * MiB;
constexpr size_t WS_LIST = WS_R3 + 144 * MiB;
constexpr size_t WS_END = WS_LIST + 2 * MiB;
static_assert(WS_END <= 405 * MiB, "workspace map");
constexpr int CW_BAR = 4096;
constexpr int CW_MOE = 16384;

constexpr int RING_BYTES = 131072;
constexpr int LDSCTL_OFF = RING_BYTES, MISC_OFF = LDSCTL_OFF + 320;
constexpr int LDS_BYTES = 147456;

#define LDS_WAIT() asm volatile("s_waitcnt lgkmcnt(0)" ::: "memory")
#define VM_WAIT() asm volatile("s_waitcnt vmcnt(0)" ::: "memory")
typedef __bf16 bf16x2_t __attribute__((ext_vector_type(2)));
__device__ __forceinline__ unsigned pk2(float lo, float hi) { const f32x2 v = {lo, hi}; const bf16x2_t b = __builtin_convertvector(v, bf16x2_t); return __builtin_bit_cast(unsigned, b); }
__device__ __forceinline__ unsigned f2bf(float f) { return pk2(f, 0.0f) & 0xffffu; }
__device__ __forceinline__ float bflo(unsigned w) { return __builtin_bit_cast(float, w << 16); }
__device__ __forceinline__ float bfhi(unsigned w) { return __builtin_bit_cast(float, w & 0xffff0000u); }
__device__ __forceinline__ float bf1(bf16 b) { return __builtin_bit_cast(float, ((unsigned)b) << 16); }
__device__ __forceinline__ void unpack8(const v4u w, float (&o)[8]) { o[0] = bflo(w.x); o[1] = bfhi(w.x); o[2] = bflo(w.y); o[3] = bfhi(w.y); o[4] = bflo(w.z); o[5] = bfhi(w.z); o[6] = bflo(w.w); o[7] = bfhi(w.w); }
__device__ __forceinline__ v4u pack8(const float (&o)[8]) { v4u w; w.x = pk2(o[0], o[1]); w.y = pk2(o[2], o[3]); w.z = pk2(o[4], o[5]); w.w = pk2(o[6], o[7]); return w; }
__device__ __forceinline__ void fsincospi(float x, float* sn, float* cs) { *sn = __builtin_amdgcn_sinf(0.5f * x); *cs = __builtin_amdgcn_cosf(0.5f * x); }
__device__ __forceinline__ float sigmoidf_(float x) { return __builtin_amdgcn_rcpf(1.0f + __expf(-x)); }
__device__ __forceinline__ float siluf_(float x) { return x * __builtin_amdgcn_rcpf(1.0f + __expf(-x)); }
__device__ __forceinline__ float gelu_tanh(float x) { const float u = 0.7978845608028654f * (x + 0.044715f * x * x * x); return x * __builtin_amdgcn_rcpf(1.0f + __expf(-2.0f * u)); }
__device__ __forceinline__ float wave_sum(float v) {
#pragma unroll
    for (int o = 1; o < 64; o <<= 1) v += __shfl_xor(v, o);
    return v;
}
__device__ __forceinline__ float reduce16(const float (&v)[16], int lane) {
    const bool b5 = (lane & 32) != 0, b4 = (lane & 16) != 0, b3 = (lane & 8) != 0, b2 = (lane & 4) != 0;
    float a[8], b[4], c[2];
#pragma unroll
    for (int i = 0; i < 8; ++i) a[i] = (b5 ? v[i + 8] : v[i]) + __shfl_xor(b5 ? v[i] : v[i + 8], 32);
#pragma unroll
    for (int i = 0; i < 4; ++i) b[i] = (b4 ? a[i + 4] : a[i]) + __shfl_xor(b4 ? a[i] : a[i + 4], 16);
#pragma unroll
    for (int i = 0; i < 2; ++i) c[i] = (b3 ? b[i + 2] : b[i]) + __shfl_xor(b3 ? b[i] : b[i + 2], 8);
    float d = (b2 ? c[1] : c[0]) + __shfl_xor(b2 ? c[0] : c[1], 4);
    d += __shfl_xor(d, 2); d += __shfl_xor(d, 1);
    return d;
}
__device__ __forceinline__ float reduce4(const float (&v)[4], int lane) {
    const bool b5 = (lane & 32) != 0, b4 = (lane & 16) != 0; float a[2];
#pragma unroll
    for (int i = 0; i < 2; ++i) a[i] = (b5 ? v[i + 2] : v[i]) + __shfl_xor(b5 ? v[i] : v[i + 2], 32);
    float d = (b4 ? a[1] : a[0]) + __shfl_xor(b4 ? a[0] : a[1], 16);
    d += __shfl_xor(d, 8); d += __shfl_xor(d, 4); d += __shfl_xor(d, 2); d += __shfl_xor(d, 1);
    return d;
}
__device__ __forceinline__ float g16_sum(float v) {
#pragma unroll
    for (int o = 1; o < 16; o <<= 1) v += __shfl_xor(v, o);
    return v;
}

namespace pg8 {
constexpr int BM = 256, BK = 64, HALF = 128, HTB = HALF * BK * 2, STAGE_BYTES = 8 * HTB;
__host__ __device__ __forceinline__ int lds_byte(int r, int c) { const int st = (r >> 4) * 2 + (c >> 5), rr = r & 15, cc = c & 31, ob = rr * 64 + cc * 2; return st * 1024 + (ob ^ (((ob >> 9) & 1) << 5)); }
__host__ __device__ __forceinline__ void stage_rc(int b, int& R, int& C) { const int st = b / 1024, sb = b % 1024, swz = sb ^ (((sb >> 9) & 1) << 5); R = (st >> 1) * 16 + swz / 64; C = (st & 1) * 32 + (swz % 64) / 2; }
__host__ __device__ __forceinline__ int perm32(int rho) { const int n = rho >> 4, i = rho & 15; return 8 * (i >> 2) + 4 * n + (i & 3); }

struct Unit { int pm, pn, aux, ax2; const char* a; const char* b; };
struct Gemm { int K, lda, ldb; };

__device__ __forceinline__ void map_tile(int L, int nM, int nN, int& pm, int& pn) {
    const int nwg = nM * nN; int wgid = L; { const int q = nwg / 8, r = nwg % 8, xcd = wgid % 8, off = wgid / 8; wgid = (xcd < r ? xcd * (q + 1) : r * (q + 1) + (xcd - r) * q) + off; }
    const int nig = 8 * nN, gid = wgid / nig, fm = gid * 8, gsz = (nM - fm) < 8 ? (nM - fm) : 8;
    pm = fm + ((wgid % nig) % gsz); pn = (wgid % nig) / gsz;
}
__device__ __forceinline__ unsigned cvt_pk_bf16(float lo, float hi) { unsigned r; asm volatile("v_cvt_pk_bf16_f32 %0, %1, %2" : "=v"(r) : "v"(lo), "v"(hi)); return r; }

template <class Epi, class Sched, bool ALIGN_EPI, bool SP2>
__device__ __forceinline__ void gemm_phase(LAS unsigned char* lds, const Gemm g, const Sched& S, const Epi& E) {
    int tid_l = threadIdx.x; asm volatile("" : "+v"(tid_l));
    const int tid = tid_l, wid = __builtin_amdgcn_readfirstlane(tid >> 6), lane = tid & 63, wr = wid >> 2, wc = wid & 3, fr = lane & 15, fq = lane >> 4;
    const int K = g.K, nt = K / BK;
    unsigned voffA[2], voffB[2];
#pragma unroll
    for (int i = 0; i < 2; ++i) { int R, C; stage_rc(tid * 16 + i * 8192, R, C); const int Rb = Epi::PERM ? ((R & ~31) + perm32(R & 31)) : R;
        voffA[i] = (unsigned)(R * g.lda + C) * 2u; voffB[i] = (unsigned)(Rb * g.ldb + C) * 2u; }
    static_assert(!Sched::GATHER || SP2, "gathered A rows: only the SP2 loop");
    unsigned vA[2][2], vAn[2][2];
#define PG8_GCALC(dst, u_) do { _Pragma("unroll") for (int i_ = 0; i_ < 2; ++i_) { int R_, C_; stage_rc(tid * 16 + i_ * 8192, R_, C_); _Pragma("unroll") for (int h_ = 0; h_ < 2; ++h_) dst[h_][i_] = S.arow(u_, R_ + 128 * h_) + (unsigned)C_ * 2u; } } while (0)
#define PG8_STAGE_A(bufoff, base, h, nextsel) do { if constexpr (Sched::GATHER) { unsigned vs_[2]; vs_[0] = (nextsel) ? vAn[h][0] : vA[h][0]; vs_[1] = (nextsel) ? vAn[h][1] : vA[h][1]; PG8_STAGE(bufoff, base, vs_); } \
        else { PG8_STAGE(bufoff, (base) + (h) * hstepA, voffA); } } while (0)
    const size_t kstep = (size_t)(BK * 2);
    const size_t hstepA = (size_t)HALF * g.lda * 2, hstepB = (size_t)HALF * g.ldb * 2;
    const unsigned ldsw = (unsigned)wid * 1024u;
    const int aoff = lds_byte(wr * 64 + fr, fq * 8), boff = lds_byte(wc * 32 + fr, fq * 8);
#define PG8_SA(b, h) (((b) * 2 + (h)) * HTB)
#define PG8_SB(b, h) ((4 + (b) * 2 + (h)) * HTB)
#define PG8_STAGE(bufoff, gbase, voff) do { _Pragma("unroll") for (int _i = 0; _i < 2; ++_i) \
        __builtin_amdgcn_global_load_lds((const unsigned*)((const char*)(gbase) + (voff)[_i]), (LAS unsigned*)(lds + (bufoff) + ldsw + _i * 8192), 16, 0, 0); } while (0)
#define PG8_LDA(dst, b, h) do { _Pragma("unroll") for (int m = 0; m < 4; ++m) _Pragma("unroll") for (int k = 0; k < 2; ++k) dst[m][k] = *(const LAS bf16x8*)(lds + PG8_SA(b, h) + aoff + m * 2048 + k * 1024); } while (0)
#define PG8_LDB(dst, b, h) do { _Pragma("unroll") for (int n = 0; n < 2; ++n) _Pragma("unroll") for (int k = 0; k < 2; ++k) dst[n][k] = *(const LAS bf16x8*)(lds + PG8_SB(b, h) + boff + n * 2048 + k * 1024); } while (0)
#define PG8_MMA(ai, bj, At, Bt) do { __builtin_amdgcn_s_setprio(1); _Pragma("unroll") for (int m = 0; m < 4; ++m) _Pragma("unroll") for (int n = 0; n < 2; ++n) _Pragma("unroll") for (int k = 0; k < 2; ++k) \
        acc[ai][bj][m][n] = __builtin_amdgcn_mfma_f32_16x16x32_bf16(Bt[n][k], At[m][k], acc[ai][bj][m][n], 0, 0, 0); __builtin_amdgcn_s_setprio(0); } while (0)
#define PG8_WAIT_V(n) asm volatile("s_waitcnt vmcnt(" #n ")" ::: "memory")
#define PG8_WAIT_L(n) asm volatile("s_waitcnt lgkmcnt(" #n ")" ::: "memory")
#define PG8_BAR __builtin_amdgcn_s_barrier()
#define PG8_SCHED __builtin_amdgcn_sched_barrier(0)
    Unit cur, nxt; int ui = 0;
    if (!S.next(0, cur)) return;
    f32x4 acc[2][2][4][2];
#pragma unroll
    for (int a = 0; a < 2; ++a)
#pragma unroll
        for (int b = 0; b < 2; ++b)
#pragma unroll
            for (int m = 0; m < 4; ++m)
#pragma unroll
                for (int n = 0; n < 2; ++n) acc[a][b][m][n] = (f32x4){0.f, 0.f, 0.f, 0.f};
    bf16x8 At[4][2], B0[2][2], B1[2][2];
    const char* cA = cur.a; const char* cB = cur.b;
    if constexpr (SP2) {
        if constexpr (Sched::GATHER) { PG8_GCALC(vA, cur); }
        PG8_STAGE(PG8_SB(0, 0), cB, voffB); PG8_STAGE(PG8_SB(0, 1), cB + hstepB, voffB); PG8_STAGE_A(PG8_SA(0, 0), cA, 0, false); PG8_STAGE_A(PG8_SA(0, 1), cA, 1, false);
        if (wr == 1) PG8_BAR;
        PG8_WAIT_V(2); PG8_BAR;
        PG8_STAGE(PG8_SB(1, 0), cB + kstep, voffB); PG8_STAGE_A(PG8_SA(1, 0), cA + kstep, 0, false); PG8_STAGE(PG8_SB(1, 1), cB + hstepB + kstep, voffB);
        PG8_WAIT_V(6); PG8_BAR;
    } else {
        PG8_STAGE(PG8_SB(0, 0), cB, voffB); PG8_STAGE(PG8_SA(0, 0), cA, voffA); PG8_STAGE(PG8_SB(0, 1), cB + hstepB, voffB); PG8_STAGE(PG8_SA(0, 1), cA + hstepA, voffA);
        if (wr == 1) PG8_BAR;
        PG8_WAIT_V(4); PG8_BAR;
        PG8_STAGE(PG8_SB(1, 0), cB + kstep, voffB); PG8_STAGE(PG8_SA(1, 0), cA + kstep, voffA); PG8_STAGE(PG8_SB(1, 1), cB + hstepB + kstep, voffB);
        PG8_WAIT_V(6); PG8_BAR;
    }
    for (;;) {
        const bool has_next = S.next(ui + 1, nxt);
        const char* nA = has_next ? nxt.a : cA; const char* nB = has_next ? nxt.b : cB;
        if constexpr (Sched::GATHER) { if (has_next) { PG8_GCALC(vAn, nxt); } else {
#pragma unroll
            for (int h_ = 0; h_ < 2; ++h_)
#pragma unroll
                for (int i_ = 0; i_ < 2; ++i_) vAn[h_][i_] = vA[h_][i_]; } }
        for (int t = 0; t < nt; t += 2) {
            const bool last = (t == nt - 2);
            const char* a1 = cA + (size_t)(t + 1) * kstep;
            const char* a2 = last ? nA : cA + (size_t)(t + 2) * kstep; const char* b2 = last ? nB : cB + (size_t)(t + 2) * kstep;
            const char* a3 = a2 + kstep; const char* b3 = b2 + kstep;
            if constexpr (SP2) {
            PG8_LDB(B0, 0, 0); PG8_LDB(B1, 0, 1); PG8_SCHED; PG8_LDA(At, 0, 0); PG8_STAGE_A(PG8_SA(1, 1), a1, 1, false);
            PG8_WAIT_V(8); PG8_WAIT_L(0); PG8_BAR; PG8_MMA(0, 0, At, B0); PG8_MMA(0, 1, At, B1); PG8_BAR; PG8_SCHED;
            PG8_LDA(At, 0, 1); PG8_STAGE(PG8_SB(0, 0), b2, voffB); PG8_STAGE(PG8_SB(0, 1), b2 + hstepB, voffB); PG8_STAGE_A(PG8_SA(0, 0), a2, 0, last);
            PG8_WAIT_V(8); PG8_WAIT_L(0); PG8_BAR; PG8_MMA(1, 0, At, B0); PG8_MMA(1, 1, At, B1); PG8_BAR; PG8_SCHED;
            PG8_LDB(B0, 1, 0); PG8_LDB(B1, 1, 1); PG8_SCHED; PG8_LDA(At, 1, 0); PG8_STAGE_A(PG8_SA(0, 1), a2, 1, last);
            PG8_WAIT_V(8); PG8_WAIT_L(0); PG8_BAR; PG8_MMA(0, 0, At, B0); PG8_MMA(0, 1, At, B1); PG8_BAR; PG8_SCHED;
            PG8_LDA(At, 1, 1); PG8_STAGE(PG8_SB(1, 0), b3, voffB); PG8_STAGE(PG8_SB(1, 1), b3 + hstepB, voffB); PG8_STAGE_A(PG8_SA(1, 0), a3, 0, last);
            PG8_WAIT_V(8); PG8_WAIT_L(0); PG8_BAR; PG8_MMA(1, 0, At, B0); PG8_MMA(1, 1, At, B1); PG8_BAR; PG8_SCHED;
            } else {
            PG8_LDB(B0, 0, 0); PG8_SCHED; PG8_LDA(At, 0, 0); PG8_STAGE(PG8_SA(1, 1), a1 + hstepA, voffA);
            PG8_WAIT_L(8); PG8_BAR; PG8_WAIT_L(0); PG8_MMA(0, 0, At, B0); PG8_BAR; PG8_SCHED;
            PG8_LDB(B1, 0, 1); PG8_STAGE(PG8_SB(0, 0), b2, voffB);
            PG8_BAR; PG8_WAIT_L(0); PG8_MMA(0, 1, At, B1); PG8_BAR;
            PG8_LDA(At, 0, 1); PG8_STAGE(PG8_SA(0, 0), a2, voffA);
            PG8_BAR; PG8_WAIT_L(0); PG8_MMA(1, 0, At, B0); PG8_BAR; PG8_SCHED;
            PG8_STAGE(PG8_SB(0, 1), b2 + hstepB, voffB);
            PG8_WAIT_V(6); PG8_BAR; PG8_MMA(1, 1, At, B1); PG8_BAR;
            PG8_LDB(B0, 1, 0); PG8_SCHED; PG8_LDA(At, 1, 0); PG8_STAGE(PG8_SA(0, 1), a2 + hstepA, voffA);
            PG8_WAIT_L(8); PG8_BAR; PG8_WAIT_L(0); PG8_MMA(0, 0, At, B0); PG8_BAR; PG8_SCHED;
            PG8_LDB(B1, 1, 1); PG8_STAGE(PG8_SB(1, 0), b3, voffB);
            PG8_BAR; PG8_WAIT_L(0); PG8_MMA(0, 1, At, B1); PG8_BAR;
            PG8_LDA(At, 1, 1); PG8_STAGE(PG8_SA(1, 0), a3, voffA);
            PG8_BAR; PG8_WAIT_L(0); PG8_MMA(1, 0, At, B0); PG8_BAR; PG8_SCHED;
            PG8_STAGE(PG8_SB(1, 1), b3 + hstepB, voffB);
            PG8_WAIT_V(6); PG8_BAR; PG8_MMA(1, 1, At, B1); PG8_BAR;
            }
        }
        if constexpr (ALIGN_EPI) { if (wr == 0) PG8_BAR; }
        E(acc, cur, wr, wc, fr, fq);
        if (!has_next) break;
#pragma unroll
        for (int a = 0; a < 2; ++a)
#pragma unroll
            for (int b = 0; b < 2; ++b)
#pragma unroll
                for (int m = 0; m < 4; ++m)
#pragma unroll
                    for (int n = 0; n < 2; ++n) acc[a][b][m][n] = (f32x4){0.f, 0.f, 0.f, 0.f};
        cur = nxt; cA = nA; cB = nB; ++ui;
        if constexpr (Sched::GATHER) {
#pragma unroll
            for (int h_ = 0; h_ < 2; ++h_)
#pragma unroll
                for (int i_ = 0; i_ < 2; ++i_) vA[h_][i_] = vAn[h_][i_]; }
        if constexpr (ALIGN_EPI) { if (wr == 1) PG8_BAR; }
    }
    PG8_WAIT_V(0);
    if constexpr (!ALIGN_EPI) { if (wr == 0) PG8_BAR; }
    PG8_BAR;
#undef PG8_SA
#undef PG8_SB
#undef PG8_STAGE
#undef PG8_STAGE_A
#undef PG8_GCALC
#undef PG8_LDA
#undef PG8_LDB
#undef PG8_MMA
#undef PG8_WAIT_V
#undef PG8_WAIT_L
#undef PG8_BAR
#undef PG8_SCHED
}
}
using pg8::Unit;
using pg8::Gemm;
typedef f32x4 AccT[2][2][4][2];

#define XB_TMO      128
#define XB_XCNT(j)  (256  + 64 * (j))
#define XB_XSUB(j)  (1280 + 64 * (j))
#define XB_XGEN(j)  (2304 + 64 * (j))
#define XB_TOP      3328
#define XB_TOPGEN   3392
#define XCD_BAR_WORDS 3456
#define XB_SPIN_CAP (1u << 18)
__device__ __forceinline__ unsigned xb_ld(unsigned* p)              { return __hip_atomic_load(p, __ATOMIC_RELAXED, __HIP_MEMORY_SCOPE_AGENT); }
__device__ __forceinline__ unsigned xb_add(unsigned* p, unsigned v) { return __hip_atomic_fetch_add(p, v, __ATOMIC_RELAXED, __HIP_MEMORY_SCOPE_AGENT); }
__device__ __forceinline__ unsigned xb_xcc_id() { return (unsigned)__builtin_amdgcn_s_getreg((3 << 11) | 20) & 0xFu; }
#define XB_SPIN(cond, bar) do { unsigned _sp = 0; while (cond) { __builtin_amdgcn_s_sleep(1); \
    if ((++_sp & 255u) == 0u) { if (xb_ld(&(bar)[XB_TMO])) break; if (_sp > XB_SPIN_CAP) { atomicAdd(&(bar)[XB_TMO], 1u); break; } } } } while (0)
struct XcdBarrier { unsigned* bar; unsigned x; volatile LAS unsigned* st; };
__device__ __forceinline__ XcdBarrier xcd_barrier_post(unsigned* bar, volatile LAS unsigned* st) {
    XcdBarrier b; b.bar = bar; b.x = xb_xcc_id(); b.st = st;
    if (threadIdx.x == 0) (void)xb_add(&bar[XB_XCNT(b.x)], 1u);
    return b;
}
__device__ __forceinline__ void xcd_barrier_complete(unsigned* bar, unsigned x, unsigned& nloc, unsigned& nx) {
    const unsigned G = gridDim.x * gridDim.y * gridDim.z;
    unsigned sum, cnt, mine, sp = 0u;
    for (;;) {
        sum = 0u; cnt = 0u; mine = 0u;
#pragma unroll
        for (unsigned j = 0; j < 16; ++j) { const unsigned c = xb_ld(&bar[XB_XCNT(j)]); sum += c; cnt += (c > 0u) ? 1u : 0u; mine = (j == x) ? c : mine; }
        if (sum == G) break;
        __builtin_amdgcn_s_sleep(1);
        if ((++sp & 255u) == 0u) { if (xb_ld(&bar[XB_TMO])) break; if (sp > XB_SPIN_CAP) { atomicAdd(&bar[XB_TMO], 1u); break; } }
    }
    nloc = mine > 0u ? mine : 1u; nx = cnt > 0u ? cnt : 1u;
}
__device__ __forceinline__ void xcd_barrier(const XcdBarrier& b) {
    asm volatile("s_waitcnt vmcnt(0)" ::: "memory");
    __syncthreads();
    if (threadIdx.x == 0) {
        unsigned* bar = b.bar;
        __builtin_amdgcn_s_waitcnt(0);
        unsigned nloc = b.st[0], nx = b.st[1];
        if (nloc == 0u) { xcd_barrier_complete(bar, b.x, nloc, nx); b.st[0] = nloc; b.st[1] = nx; }
        const unsigned old = xb_add(&bar[XB_XSUB(b.x)], 1u);
        const unsigned gen = old / nloc;
        if (old + 1u == (gen + 1u) * nloc) {
            __builtin_amdgcn_fence(__ATOMIC_RELEASE, "agent");
            asm volatile("s_waitcnt vmcnt(0)" ::: "memory");
            const unsigned og = xb_add(&bar[XB_TOP], 1u);
            const unsigned tg = og / nx;
            if (og + 1u == (tg + 1u) * nx) xb_add(&bar[XB_TOPGEN], 1u);
            else XB_SPIN(xb_ld(&bar[XB_TOPGEN]) == tg, bar);
            __builtin_amdgcn_fence(__ATOMIC_ACQUIRE, "agent");
            xb_add(&bar[XB_XGEN(b.x)], 1u);
            asm volatile("s_waitcnt vmcnt(0)" ::: "memory");
        } else {
            XB_SPIN(xb_ld(&bar[XB_XGEN(b.x)]) == gen, bar);
            __builtin_amdgcn_fence(__ATOMIC_ACQUIRE, "agent");
            asm volatile("s_waitcnt vmcnt(0)" ::: "memory");
        }
    }
    __syncthreads();
}

struct Args { const float* in[34]; float* out; unsigned char* ws; int ph_lo, ph_hi; };
enum { I_X = 0, I_C, I_CTX, I_CCTX, I_WMOD, I_BMOD, I_WIN, I_BIN, I_GCONV, I_GALOG, I_GDT, I_GNORM, I_CDWW, I_CDWB, I_CLNG, I_CLNB, I_SLNG, I_SLNB, I_SWS, I_SBS,
       I_WBR, I_WOUT, I_BOUT, I_LN1G, I_LN1B, I_LN2G, I_LN2B, I_RGW, I_RGB, I_REW, I_REB, I_EWG, I_EWU, I_EWD };

__device__ __forceinline__ int xcd_chunk(int L, int U) { const int q = U >> 3, r = U & 7, x = L & 7, off = L >> 3; return (x < r ? x * (q + 1) : r * (q + 1) + (x - r) * q) + off; }
struct SchedInA {
    static constexpr bool GATHER = false;
    int G, c; const char* xn; const char* w;
    __device__ __forceinline__ bool next(int i, Unit& u) const {
        const int L = i * G + c; const size_t tstep = (size_t)256 * 1024 * 2;
        if (L < 1152) { int pm, pn; pg8::map_tile(L, 72, 16, pm, pn); u.pm = pm; u.pn = pn; u.aux = 0; u.a = xn + (size_t)pm * tstep; u.b = w + (size_t)pn * tstep; return true; }
        if (L < 1440) { const int q = xcd_chunk(L - 1152, 288), pm = 16 + (q & 3), pn = q >> 2;        u.pm = pm; u.pn = pn; u.aux = 1; u.a = w + (size_t)pm * tstep; u.b = xn + (size_t)pn * tstep; return true; }
        return false;
    }
};
struct SchedGrid {
    static constexpr bool GATHER = false;
    int G, c, nM, nN; const char* a0; const char* b0; size_t astep, bstep;
    __device__ __forceinline__ bool next(int i, Unit& u) const {
        const int L = i * G + c; if (L >= nM * nN) return false;
        int pm, pn; pg8::map_tile(L, nM, nN, pm, pn); u.pm = pm; u.pn = pn; u.aux = 0; u.a = a0 + (size_t)pm * astep; u.b = b0 + (size_t)pn * bstep; return true;
    }
};
struct SchedFftLat {
    static constexpr bool GATHER = false;
    int G, c; const char* dft; const char* pf;
    __device__ __forceinline__ bool next(int i, Unit& u) const {
        const int L = i * G + c; if (L >= 128) return false;
        const int b = L >> 4, kt = (L >> 1) & 7, pn = L & 1;
        u.pm = b * 8 + kt; u.pn = pn; u.aux = 0; u.a = dft + (size_t)kt * (256 * 4096 * 2); u.b = pf + (size_t)b * (512 * 4096 * 2) + (size_t)pn * (256 * 4096 * 2); return true;
    }
};
struct SchedFftCtx {
    static constexpr bool GATHER = false;
    int G, c; const char* dft; const char* pf;
    __device__ __forceinline__ bool next(int i, Unit& u) const {
        const int L = i * G + (G - 1 - c); if (L >= 16) return false;
        const int b = L >> 1, pn = L & 1;
        u.pm = 64 + b; u.pn = pn; u.aux = 0; u.a = dft; u.b = pf + (size_t)b * (512 * 512 * 2) + (size_t)pn * (256 * 512 * 2); return true;
    }
};
struct SchedBranch {
    static constexpr bool GATHER = false;
    int G, c, nM; const char* br; const char* wbr;
    __device__ __forceinline__ bool next(int j, Unit& u) const {
        const int L = j * G + c; if (L >= nM * 16) return false;
        int pm, pn; pg8::map_tile(L, nM, 16, pm, pn);
        u.pm = pm; u.pn = pn; u.aux = 0; u.a = br + (size_t)(pn >> 2) * ((size_t)NTOK * 512 * 2) + (size_t)pm * (256 * 512 * 2); u.b = wbr + (size_t)pn * (256 * 512 * 2); return true;
    }
};
struct SchedMoe {
    static constexpr bool GATHER = false;
    int G, c; unsigned pre[17]; const char* a0; const char* w0; size_t astep, wstep_e, wstep_n;
    __device__ __forceinline__ void init(const unsigned* cnt  ) {
        unsigned s = 0;
#pragma unroll
        for (int e = 0; e < 16; ++e) { pre[e] = s; s += ((unsigned)__builtin_amdgcn_readfirstlane((int)__hip_atomic_load(cnt + 64 * e, __ATOMIC_RELAXED, __HIP_MEMORY_SCOPE_AGENT)) + 255u) >> 8; }
        pre[16] = s;
    }
    __device__ __forceinline__ bool next(int i, Unit& u) const {
        const int L = i * G + c; if (L >= (int)pre[16] * 4) return false;
        const int jt = L >> 2, pn = L & 3; int e = 0;
#pragma unroll
        for (int k = 1; k < 16; ++k) e += ((unsigned)jt >= pre[k]) ? 1 : 0;
        u.pm = jt; u.pn = pn; u.aux = e; u.a = a0 + (size_t)jt * astep; u.b = w0 + (size_t)e * wstep_e + (size_t)pn * wstep_n; return true;
    }
};

struct SchedMoeG {
    static constexpr bool GATHER = true;
    int G, c; const LAS unsigned* pre; const char* a0; const char* w0; size_t wstep_e, wstep_n; const int* list; const unsigned* cnt;
    __device__ __forceinline__ void init(const unsigned* cnt_  , LAS unsigned* pre_) { cnt = cnt_; pre = pre_;
        if (threadIdx.x < 16) pre_[17 + threadIdx.x] = __hip_atomic_load(cnt_ + 64 * threadIdx.x, __ATOMIC_RELAXED, __HIP_MEMORY_SCOPE_AGENT);
        __syncthreads();
        if (threadIdx.x == 0) { unsigned s = 0;
            for (int e = 0; e < 16; ++e) { pre_[e] = s; s += (pre_[17 + e] + 255u) >> 8; }
            pre_[16] = s; }
        __syncthreads();
    }
    __device__ __forceinline__ bool next(int i, Unit& u) const {
        const int L = i * G + c; if (L >= (int)pre[16] * 4) return false;
        const int jt = L >> 2, pn = L & 3; int e = 0; unsigned pe = 0;
#pragma unroll
        for (int k = 1; k < 16; ++k) { const unsigned pk = pre[k]; const bool ge = (unsigned)jt >= pk; e += ge ? 1 : 0; pe = ge ? pk : pe; }
        e = __builtin_amdgcn_readfirstlane(e); pe = (unsigned)__builtin_amdgcn_readfirstlane((int)pe);
        u.pm = jt; u.pn = pn; u.aux = e; u.ax2 = (jt - (int)pe) * 256; u.a = a0; u.b = w0 + (size_t)e * wstep_e + (size_t)pn * wstep_n; return true;
    }
    __device__ __forceinline__ unsigned arow(const Unit& u, int r) const {
        const unsigned n = pre[17 + u.aux]; const unsigned pos = (unsigned)(u.ax2 + r);
        const int tok = pos < n ? list[(size_t)u.aux * NTOK + pos] : 0; return (unsigned)tok * 2048u;
    }
};

struct EpiInA {
    static constexpr bool PERM = true;
    bf16 *pqkv, *pz, *pconf, *psgu, *pfft, *pfftc; const float* bias;
    __device__ __forceinline__ void operator()(const AccT& acc, const Unit& u, int wr, int wc, int fr, int fq) const {
        if (u.aux == 0) {
            const int row0 = u.pm * 256 + wr * 64 + fr, cb = wc * 32 + 8 * fq, bcol0 = u.pn * 256 + cb;
            f32x4 bv[2][2];
#pragma unroll
            for (int bj = 0; bj < 2; ++bj)
#pragma unroll
                for (int n = 0; n < 2; ++n) bv[bj][n] = *(const f32x4*)(bias + bcol0 + bj * 128 + 4 * n);
            if (u.pn < 8) {
                const bool isz = u.pn >= 6;
#pragma unroll
                for (int ai = 0; ai < 2; ++ai)
#pragma unroll
                    for (int m = 0; m < 4; ++m) { const int row = row0 + ai * 128 + m * 16;
                        bf16* rowp = isz ? (pz + (size_t)row * 512 + (u.pn - 6) * 256 + cb) : (pqkv + (size_t)row * 1536 + u.pn * 256 + cb);
#pragma unroll
                        for (int bj = 0; bj < 2; ++bj) { f32x4 v0 = acc[ai][bj][m][0] + bv[bj][0], v1 = acc[ai][bj][m][1] + bv[bj][1];
                            if (isz) {
#pragma unroll
                                for (int j = 0; j < 4; ++j) { v0[j] = siluf_(v0[j]); v1[j] = siluf_(v1[j]); } }
                            v4u w; w.x = pk2(v0[0], v0[1]); w.y = pk2(v0[2], v0[3]); w.z = pk2(v1[0], v1[1]); w.w = pk2(v1[2], v1[3]);
                            *(v4u*)(rowp + bj * 128) = w; } }
            } else if (u.pn < 12) {
#pragma unroll
                for (int ai = 0; ai < 2; ++ai)
#pragma unroll
                    for (int m = 0; m < 4; ++m) { const int row = row0 + ai * 128 + m * 16;
                        const f32x4 a0 = acc[ai][0][m][0] + bv[0][0], a1 = acc[ai][0][m][1] + bv[0][1], g0 = acc[ai][1][m][0] + bv[1][0], g1 = acc[ai][1][m][1] + bv[1][1];
                        float o[8];
#pragma unroll
                        for (int j = 0; j < 4; ++j) { o[j] = a0[j] * sigmoidf_(g0[j]); o[4 + j] = a1[j] * sigmoidf_(g1[j]); }
                        *(v4u*)(pconf + (size_t)row * 512 + (u.pn - 8) * 128 + cb) = pack8(o); }
            } else {
#pragma unroll
                for (int ai = 0; ai < 2; ++ai)
#pragma unroll
                    for (int m = 0; m < 4; ++m) { const int row = row0 + ai * 128 + m * 16;
                        bf16* rowp = psgu + (size_t)row * 1024 + (u.pn - 12) * 256 + cb;
#pragma unroll
                        for (int bj = 0; bj < 2; ++bj) { f32x4 v0 = acc[ai][bj][m][0] + bv[bj][0], v1 = acc[ai][bj][m][1] + bv[bj][1];
#pragma unroll
                            for (int j = 0; j < 4; ++j) { v0[j] = gelu_tanh(v0[j]); v1[j] = gelu_tanh(v1[j]); }
                            v4u w; w.x = pk2(v0[0], v0[1]); w.y = pk2(v0[2], v0[3]); w.z = pk2(v1[0], v1[1]); w.w = pk2(v1[2], v1[3]);
                            *(v4u*)(rowp + bj * 128) = w; } }
            }
        } else {
            const int jrow0 = (u.pm - 16) * 256 + wr * 64 + fr, tok0 = u.pn * 256 + wc * 32 + 8 * fq;
#pragma unroll
            for (int ai = 0; ai < 2; ++ai)
#pragma unroll
                for (int m = 0; m < 4; ++m) { const int jrow = jrow0 + ai * 128 + m * 16; const float bb = bias[4096 + jrow]; const int cs = jrow >> 9, rr = jrow & 511;
#pragma unroll
                    for (int bj = 0; bj < 2; ++bj) { const int tok = tok0 + bj * 128; bf16* dst;
                        if (tok < NLAT) { const int b = tok >> 11, t = tok & 2047; dst = pfft + ((size_t)(b * 512 + rr)) * 4096 + cs * 2048 + t; }
                        else { const int tc = tok - NLAT, b = tc >> 8, t = tc & 255; dst = pfftc + ((size_t)(b * 512 + rr)) * 512 + cs * 256 + t; }
                        const f32x4 v0 = acc[ai][bj][m][0] + bb, v1 = acc[ai][bj][m][1] + bb;
                        v4u w; w.x = pk2(v0[0], v0[1]); w.y = pk2(v0[2], v0[3]); w.z = pk2(v1[0], v1[1]); w.w = pk2(v1[2], v1[3]);
                        *(v4u*)dst = w; } }
        }
    }
};
template <int ACT  > struct EpiBf16 {
    static constexpr bool PERM = true;
    bf16* O; int ldc; const float* bias;
    __device__ __forceinline__ void operator()(const AccT& acc, const Unit& u, int wr, int wc, int fr, int fq) const {
        const int row0 = u.pm * 256 + wr * 64 + fr, col0 = u.pn * 256 + wc * 32 + 8 * fq;
        f32x4 bv[2][2];
#pragma unroll
        for (int bj = 0; bj < 2; ++bj)
#pragma unroll
            for (int n = 0; n < 2; ++n) bv[bj][n] = bias ? *(const f32x4*)(bias + col0 + bj * 128 + 4 * n) : (f32x4){0.f, 0.f, 0.f, 0.f};
#pragma unroll
        for (int ai = 0; ai < 2; ++ai)
#pragma unroll
            for (int m = 0; m < 4; ++m) { bf16* rowp = O + (size_t)(row0 + ai * 128 + m * 16) * ldc + col0;
#pragma unroll
                for (int bj = 0; bj < 2; ++bj) { f32x4 v0 = acc[ai][bj][m][0] + bv[bj][0], v1 = acc[ai][bj][m][1] + bv[bj][1];
                    if (ACT == 1) {
#pragma unroll
                        for (int j = 0; j < 4; ++j) { v0[j] = sigmoidf_(v0[j]); v1[j] = sigmoidf_(v1[j]); } }
                    v4u w; w.x = pk2(v0[0], v0[1]); w.y = pk2(v0[2], v0[3]); w.z = pk2(v1[0], v1[1]); w.w = pk2(v1[2], v1[3]);
                    *(v4u*)(rowp + bj * 128) = w; } }
    }
};
struct EpiF32 {
    static constexpr bool PERM = false;
    float* C; int ldc; const float* bias;
    __device__ __forceinline__ void operator()(const AccT& acc, const Unit& u, int wr, int wc, int fr, int fq) const {
        const int row0 = u.pm * 256 + wr * 64 + fr, col0 = u.pn * 256 + wc * 32 + 4 * fq;
        f32x4 bv[2][2];
#pragma unroll
        for (int bj = 0; bj < 2; ++bj)
#pragma unroll
            for (int n = 0; n < 2; ++n) bv[bj][n] = *(const f32x4*)(bias + col0 + bj * 128 + n * 16);
#pragma unroll
        for (int ai = 0; ai < 2; ++ai)
#pragma unroll
            for (int m = 0; m < 4; ++m) { float* rowp = C + (size_t)(row0 + ai * 128 + m * 16) * ldc + col0;
#pragma unroll
                for (int bj = 0; bj < 2; ++bj)
#pragma unroll
                    for (int n = 0; n < 2; ++n) *(f32x4*)(rowp + bj * 128 + n * 16) = acc[ai][bj][m][n] + bv[bj][n]; }
    }
};
struct EpiGateMerge {
    static constexpr bool PERM = true;
    const bf16* P; bf16* mbf; const float* bias;
    __device__ __forceinline__ void operator()(const AccT& acc, const Unit& u, int wr, int wc, int fr, int fq) const {
        const int row0 = u.pm * 256 + wr * 64 + fr, cb = wc * 32 + 8 * fq, d0 = u.pn * 64 + wc * 16 + 4 * fq;
        f32x4 bv[2][2];
#pragma unroll
        for (int bj = 0; bj < 2; ++bj)
#pragma unroll
            for (int n = 0; n < 2; ++n) bv[bj][n] = *(const f32x4*)(bias + u.pn * 256 + cb + bj * 128 + 4 * n);
#pragma unroll
        for (int ai = 0; ai < 2; ++ai)
#pragma unroll
            for (int m = 0; m < 4; ++m) { const size_t row = (size_t)(row0 + ai * 128 + m * 16); const bf16* pr = P + row * 4096 + d0;
                f32x4 o = (f32x4){0.f, 0.f, 0.f, 0.f};
#pragma unroll
                for (int bj = 0; bj < 2; ++bj)
#pragma unroll
                    for (int n = 0; n < 2; ++n) { const v2u pw = *(const v2u*)(pr + (2 * bj + n) * 1024); const f32x4 g = acc[ai][bj][m][n] + bv[bj][n];
                        o[0] += sigmoidf_(g[0]) * bflo(pw.x); o[1] += sigmoidf_(g[1]) * bfhi(pw.x); o[2] += sigmoidf_(g[2]) * bflo(pw.y); o[3] += sigmoidf_(g[3]) * bfhi(pw.y); }
                v2u w; w.x = pk2(o[0], o[1]); w.y = pk2(o[2], o[3]); *(v2u*)(mbf + row * 1024 + d0) = w; }
    }
};
struct EpiMoe1 {
    static constexpr bool PERM = true;
    bf16* hid;
    __device__ __forceinline__ void operator()(const AccT& acc, const Unit& u, int wr, int wc, int fr, int fq) const {
        const int row0 = u.pm * 256 + wr * 64 + fr, cb = wc * 32 + 8 * fq;
#pragma unroll
        for (int ai = 0; ai < 2; ++ai)
#pragma unroll
            for (int m = 0; m < 4; ++m) { const int row = row0 + ai * 128 + m * 16;
                const f32x4 g0 = acc[ai][0][m][0], g1 = acc[ai][0][m][1], u0 = acc[ai][1][m][0], u1 = acc[ai][1][m][1];
                float o[8];
#pragma unroll
                for (int j = 0; j < 4; ++j) { o[j] = siluf_(g0[j]) * u0[j]; o[4 + j] = siluf_(g1[j]) * u1[j]; }
                *(v4u*)(hid + (size_t)row * 512 + u.pn * 128 + cb) = pack8(o); }
    }
};

struct Ctx {
    LAS unsigned char* lds; int tid, lane, wave, G, bid;
};

__device__ __forceinline__ int gate_srccol(int r) { const int q = r - 5120, t = q >> 8, c = q & 255, bj = c >> 7, wc = (c >> 5) & 3, fq = (c >> 3) & 3, n = (c >> 2) & 1, j = c & 3;
    return OFF_GATE + (2 * bj + n) * 1024 + 64 * t + 16 * wc + 4 * fq + j; }
__device__ __forceinline__ void cvt_tile(const Ctx& X, const float* src, int ld, int k0, bf16* dst, int Kp) {
    LAS float* tile = (LAS float*)X.lds;
#pragma unroll
    for (int i = 0; i < 8; ++i) { const int kk = (X.tid >> 6) + 8 * i, nn = X.tid & 63; tile[kk * 65 + nn] = src[(size_t)(k0 + kk) * ld + nn]; }
    __syncthreads();
    { const int n = X.tid >> 3, kc = X.tid & 7; float o[8];
#pragma unroll
      for (int j = 0; j < 8; ++j) o[j] = tile[(8 * kc + j) * 65 + n];
      *(v4u*)(dst + (size_t)n * Kp + k0 + 8 * kc) = pack8(o); }
    __syncthreads();
}

__device__ __forceinline__ void cvt_item(const float* src, int ld, int srccol, int k0, bf16* dst, int Kp, LAS float* scr, int lane) {
    float tv[32];
#pragma unroll
    for (int i = 0; i < 32; ++i) { const int kk = 2 * i + (lane >> 5); tv[i] = src[(size_t)(k0 + kk) * ld + srccol]; }
#pragma unroll
    for (int i = 0; i < 32; ++i) { const int kk = 2 * i + (lane >> 5); scr[kk * 33 + (lane & 31)] = tv[i]; }
    LDS_WAIT(); asm volatile("" ::: "memory");
    const int c = lane & 7;
#pragma unroll
    for (int j = 0; j < 4; ++j) { const int n = (lane >> 3) + 8 * j; const LAS float* sp = scr + (8 * c) * 33 + n; float o[8];
#pragma unroll
        for (int e = 0; e < 8; ++e) o[e] = sp[e * 33];
        *(v4u*)(dst + (size_t)n * Kp + k0 + 8 * c) = pack8(o); }
    LDS_WAIT(); asm volatile("" ::: "memory");
}

__device__ __forceinline__ void cvt_item4(const float* src, int ld, int col4, int k0, bf16* dst, int Kp, LAS float* scr, int lane) {
    f32x4 v[8]; const int kq = lane >> 3, n4 = 4 * (lane & 7);
#pragma unroll
    for (int i = 0; i < 8; ++i) v[i] = *(const f32x4*)(src + (size_t)(k0 + kq + 8 * i) * ld + col4);
#pragma unroll
    for (int i = 0; i < 8; ++i) { LAS float* p = scr + (kq + 8 * i) * 33 + n4; p[0] = v[i][0]; p[1] = v[i][1]; p[2] = v[i][2]; p[3] = v[i][3]; }
    LDS_WAIT(); asm volatile("" ::: "memory");
    const int c = lane & 7;
#pragma unroll
    for (int j = 0; j < 4; ++j) { const int n = (lane >> 3) + 8 * j; const LAS float* sp = scr + (8 * c) * 33 + n; float o[8];
#pragma unroll
        for (int e = 0; e < 8; ++e) o[e] = sp[e * 33];
        *(v4u*)(dst + (size_t)n * Kp + k0 + 8 * c) = pack8(o); }
    LDS_WAIT(); asm volatile("" ::: "memory");
}

__device__ __forceinline__ void ln_rows(f32x4 (&v)[4]) {
    float s = 0.f;
#pragma unroll
    for (int j = 0; j < 4; ++j) s += (v[j][0] + v[j][1]) + (v[j][2] + v[j][3]);
    const float mean = wave_sum(s) * (1.f / D); float s2 = 0.f;
#pragma unroll
    for (int j = 0; j < 4; ++j) { v[j] = v[j] - mean; s2 += (v[j][0] * v[j][0] + v[j][1] * v[j][1]) + (v[j][2] * v[j][2] + v[j][3] * v[j][3]); }
    const float rstd = __builtin_amdgcn_rsqf(wave_sum(s2) * (1.f / D) + LN_EPS);
#pragma unroll
    for (int j = 0; j < 4; ++j) v[j] = v[j] * rstd;
}

#define PH_BEGIN() \
    int tid_l = threadIdx.x; asm volatile("" : "+v"(tid_l)); const int tid = tid_l, lane = tid & 63; \
    Ctx X; X.lds = lds; X.tid = tid; X.lane = lane; X.wave = __builtin_amdgcn_readfirstlane(tid >> 6); X.G = gridDim.x; X.bid = blockIdx.x; \
    const int gw = X.bid * NWAVES + X.wave, NGW = X.G * NWAVES; (void)gw; (void)NGW; \
    const __attribute__((address_space(4))) char* kp = (const __attribute__((address_space(4))) char*)__builtin_amdgcn_kernarg_segment_ptr(); asm volatile("" : "+s"(kp)); \
    unsigned char* const ws = *(unsigned char* const __attribute__((address_space(4)))*)(kp + 280); \
    float* const hlat = *(float* const __attribute__((address_space(4)))*)(kp + 272); (void)hlat; \
    float* const hctx = (float*)(ws + WS_HCTX); (void)hctx; \
    float* const modv = (float*)(ws + WS_MODV); (void)modv; \
    float* const binv = (float*)(ws + WS_BIN); (void)binv; \
    bf16* const XN = (bf16*)(ws + WS_XN); (void)XN; \
    bf16* const WIN = (bf16*)(ws + WS_WIN); (void)WIN; \
    bf16* const WBR = (bf16*)(ws + WS_WBR); (void)WBR; \
    bf16* const WOUT = (bf16*)(ws + WS_WOUT); (void)WOUT; \
    bf16* const F1A = (bf16*)(ws + WS_F1A); (void)F1A; bf16* const F1B = (bf16*)(ws + WS_F1B); (void)F1B; \
    bf16* const DFTC = (bf16*)(ws + WS_DFTC); (void)DFTC; \
    bf16* const PQKV = (bf16*)(ws + WS_PQKV); (void)PQKV; \
    bf16* const PCONF = (bf16*)(ws + WS_PCONF); (void)PCONF; \
    bf16* const PZ = (bf16*)(ws + WS_PZ); (void)PZ; \
    bf16* const PSGU = (bf16*)(ws + WS_PSGU); (void)PSGU; \
    bf16* const PFFT = (bf16*)(ws + WS_PFFT); (void)PFFT; \
    bf16* const PFFTC = (bf16*)(ws + WS_PFFTC); (void)PFFTC; \
    float* const AB = (float*)(ws + WS_AB); (void)AB; \
    bf16* const OF = (bf16*)(ws + WS_OF); (void)OF; \
    bf16* const OB = (bf16*)(ws + WS_OB); (void)OB; \
    bf16* const WIT = (bf16*)(ws + WS_WIT); (void)WIT; \
    bf16* const UIT = (bf16*)(ws + WS_UIT); (void)UIT; \
    bf16* const AIT = (bf16*)(ws + WS_AIT); (void)AIT; \
    bf16* const KIT = (bf16*)(ws + WS_KIT); (void)KIT; \
    float* const SIT = (float*)(ws + WS_SIT); (void)SIT; \
    bf16* const GT = (bf16*)(ws + WS_G); (void)GT; \
    bf16* const WGU = (bf16*)(ws + WS_WGU); (void)WGU; \
    bf16* const WDN = (bf16*)(ws + WS_WDN); (void)WDN; \
    bf16* const XG = (bf16*)(ws + WS_XG); (void)XG; \
    bf16* const QKV = (bf16*)(ws + WS_QKV); (void)QKV; \
    float* const GB = (float*)(ws + WS_GB); (void)GB; \
    bf16* const BR = (bf16*)(ws + WS_BR); (void)BR; \
    float* const MERGED = (float*)(ws + WS_MERGED); (void)MERGED; \
    float* const YB = (float*)(ws + WS_Y); (void)YB; \
    bf16* const HID = (bf16*)(ws + WS_HID); (void)HID; \
    bf16* const MO = (bf16*)(ws + WS_MO); (void)MO; \
    float* const ROUTE = (float*)(ws + WS_ROUTE); (void)ROUTE; int* const ELIST = (int*)(ws + WS_LIST); (void)ELIST; \
    unsigned* const ctl = (unsigned*)(ws + WS_CTL); (void)ctl;
#define INP(i) (*(const float* const __attribute__((address_space(4)))*)(kp + 8 * (i)))
__global__ void __launch_bounds__(NWAVES * 64, 2) fwd(Args args) {
    extern __shared__ __attribute__((aligned(16))) unsigned char lds_raw[];
    LAS unsigned char* const lds = (LAS unsigned char*)lds_raw;
    volatile LAS unsigned* MISC = (volatile LAS unsigned*)(lds + MISC_OFF);
    for (int u = threadIdx.x; u < (LDS_BYTES - LDSCTL_OFF) / 4; u += NWAVES * 64) ((LAS unsigned*)(lds + LDSCTL_OFF))[u] = 0u;
    __syncthreads();
#if MK_ONE_LAUNCH
    XcdBarrier bar = xcd_barrier_post((unsigned*)(args.ws + WS_CTL) + CW_BAR, MISC + 8);
#define GRID_BAR() xcd_barrier(bar)
#else
#define GRID_BAR() do { } while (0)
#endif
    const int lo = args.ph_lo, hi = args.ph_hi;
#define IN(k) (lo <= (k) && (k) < hi)
#define CW_TS 20000
#if TPROBE
#define STAMP(k) do { if (blockIdx.x == 0 && threadIdx.x == 0) __hip_atomic_store((unsigned*)(args.ws + WS_CTL) + CW_TS + (k), (unsigned)__builtin_amdgcn_s_memrealtime(), __ATOMIC_RELAXED, __HIP_MEMORY_SCOPE_AGENT); } while (0)
#else
#define STAMP(k) do { } while (0)
#endif
#define SEAM(k) do { if (IN(k) && IN((k) + 1)) GRID_BAR(); STAMP((k) + 1); } while (0)
    STAMP(0);

    for (int rep0_ = 0; rep0_ <= (int)PH_REP(0); ++rep0_) { if (rep0_) GRID_BAR();
    if (PH_ON(0) && IN(0)) { PH_BEGIN();
        for (int idx = X.bid * 512 + tid; idx < 256 * 512 / 8; idx += X.G * 512) {
            const int k = idx >> 6, j0 = (idx & 63) * 8; float o[8];
#pragma unroll
            for (int e = 0; e < 8; ++e) { const int j = j0 + e, t = j & 255, a = (k * t) & 255; float s, c; fsincospi((float)a * (1.0f / 128.0f), &s, &c);
                o[e] = (j < 256 ? c : -s) * 0.0625f; }
            *(v4u*)(DFTC + (size_t)k * 512 + j0) = pack8(o);
        }
        {
            LAS float* sc = (LAS float*)lds;
            LAS float* red = (LAS float*)(lds + 36864);
            { float cv[18];
#pragma unroll
              for (int j = 0; j < 18; ++j) { const int r = j >> 1, k = tid + 512 * (j & 1); cv[j] = r < 8 ? INP(I_C)[r * 1024 + k] : INP(I_CCTX)[k]; }
#pragma unroll
              for (int j = 0; j < 18; ++j) sc[tid + 512 * j] = siluf_(cv[j]); }
            __syncthreads();
            for (int it = X.bid; it < 192; it += X.G) {
                const int l = it / 96, j = (it % 96) * 64 + lane; const float* W = INP(I_WMOD) + (size_t)l * 1024 * 6144 + j;
                float a[9];
#pragma unroll
                for (int r = 0; r < 9; ++r) a[r] = 0.f;
                const int kb = X.wave * 128;
                float wv[2][32];
#pragma unroll
                for (int i = 0; i < 32; ++i) wv[0][i] = W[(size_t)(kb + i) * 6144];
#pragma unroll
                for (int b = 0; b < 4; ++b) {
                    if (b < 3) {
#pragma unroll
                        for (int i = 0; i < 32; ++i) wv[(b + 1) & 1][i] = W[(size_t)(kb + 32 * (b + 1) + i) * 6144]; }
#pragma unroll
                    for (int i = 0; i < 32; i += 4) {
#pragma unroll
                        for (int r = 0; r < 9; ++r) { const f32x4 sv = *(const LAS f32x4*)(sc + r * 1024 + kb + 32 * b + i);
                            a[r] += (sv[0] * wv[b & 1][i] + sv[1] * wv[b & 1][i + 1]) + (sv[2] * wv[b & 1][i + 2] + sv[3] * wv[b & 1][i + 3]); } }
                }
#pragma unroll
                for (int r = 0; r < 9; ++r) red[(X.wave * 9 + r) * 64 + lane] = a[r];
                __syncthreads();
                for (int o = tid; o < 9 * 64; o += 512) { const int r = o >> 6, jj = o & 63; float s = 0.f;
#pragma unroll
                    for (int w = 0; w < 8; ++w) s += red[(w * 9 + r) * 64 + jj];
                    const int jc = (it % 96) * 64 + jj; modv[((size_t)l * 9 + r) * 6144 + jc] = s + INP(I_BMOD)[l * 6144 + jc]; }
                __syncthreads();
            }
        }
    } }
    SEAM(0);

    for (int l = 0; l < 2; ++l) {
        const int pb = 1 + NPH_LAYER * l;
        const int nrows2 = (l == 1) ? NLAT : NTOK;
        const int npan2 = nrows2 / 256;

        for (int rep_ = 0; rep_ <= (int)PH_REP(1); ++rep_) { if (rep_) GRID_BAR();
        if (PH_ON(1) && IN(pb + 0)) { PH_BEGIN(); const float* mv = modv + (size_t)l * 9 * 6144; (void)mv; unsigned* const moecnt = ctl + CW_MOE + l * 16 * 64; (void)moecnt;
            const float* win = INP(I_WIN) + (size_t)l * 1024 * N_IN;
            const float* bin = INP(I_BIN) + (size_t)l * N_IN;
#define FOLD_LOAD(it_) do { const int kb_ = (it_) >> 2, g_ = (it_) & 3; _Pragma("unroll") for (int j = 0; j < 4; ++j) { const int i = tid + 512 * j, kk = i >> 7, c = i & 127; wpre[j] = win[(size_t)(kb_ * 16 + kk) * N_IN + OFF_FFT + g_ * 128 + c]; } } while (0)
            float wpre[4]; FOLD_LOAD(X.bid < 256 ? X.bid : 255);
            LAS float* const wscr = (LAS float*)(lds + X.wave * 8448);
            for (int it = gw; it < 4096 + 1024 + 512 + 144; it += NGW) {
                if (it >= 5632) { const int r = (it - 5632) * 64 + lane;
                    if (r < 4096 || r >= 5120) { float v;
                        if (r < 2048) v = bin[r];
                        else if (r < 3072) { const int q = r - 2048, j = q >> 8, w = q & 255; v = bin[OFF_CONF + (w >= 128 ? 512 : 0) + 128 * j + (w & 127)]; }
                        else if (r < 4096) v = bin[OFF_SGU + (r - 3072)];
                        else v = bin[gate_srccol(r)];
                        binv[r] = v; }
                    continue; }
                const float* src; int ld, col, k0, Kp; bf16* dst; const int n4 = lane & 31;
                if (it < 4096) { const int rb_ = (it & 3) + 4 * ((it >> 3) & 63), rb = rb_ < 128 ? rb_ : rb_ + 32, row0 = rb * 32;
                    if (row0 < 2048) col = row0 + n4;
                    else if (row0 < 3072) { const int q = row0 - 2048, j = q >> 8, w = q & 255; col = OFF_CONF + (w >= 128 ? 512 : 0) + 128 * j + (w & 127) + n4; }
                    else if (row0 < 4096) col = OFF_SGU + (row0 - 3072) + n4;
                    else col = gate_srccol(row0 + n4);
                    src = win; ld = N_IN; k0 = (((it >> 2) & 1) + 2 * (it >> 9)) * 64; dst = WIN + (size_t)row0 * 1024; Kp = 1024; }
                else if (it < 5120) { const int q = it - 4096, i = q >> 8, nb = (q & 3) + 4 * ((q >> 3) & 7);
                    src = INP(I_WBR) + ((size_t)(l * 4 + i) * 512) * 1024; ld = 1024; col = nb * 32 + n4; k0 = (((q >> 2) & 1) + 2 * ((q >> 6) & 3)) * 64; dst = WBR + ((size_t)i * 1024 + nb * 32) * 512; Kp = 512; }
                else { const int q = it - 5120, nb = (q & 3) + 4 * ((q >> 3) & 7);
                    src = INP(I_WOUT) + (size_t)l * 1024 * 1024; ld = 1024; col = nb * 32 + n4; k0 = (((q >> 2) & 1) + 2 * (q >> 6)) * 64; dst = WOUT + (size_t)nb * 32 * 1024; Kp = 1024; }
                cvt_item(src, ld, col, k0, dst, Kp, wscr, lane);
            }
            LAS float* wab = (LAS float*)lds;
            f32x4 wq[8]; bool wq_have = false;
#pragma unroll
            for (int j = 0; j < 8; ++j) wq[j] = (f32x4){0.f, 0.f, 0.f, 0.f};
#define WAB_LOAD() do { _Pragma("unroll") for (int j = 0; j < 8; ++j) wq[j] = *(const f32x4*)(win + (size_t)(tid + 512 * (j & 1)) * N_IN + OFF_A + 4 * (j >> 1)); } while (0)
            for (int it = X.bid; it < 256; it += X.G) {
                const int kb = it >> 2, g = it & 3; LAS float* Wt = (LAS float*)(lds + 69632); LAS f32x2* cst = (LAS f32x2*)(lds + 69632 + 10240); LAS float* bl = (LAS float*)(cst + 128);
                if (it != X.bid) FOLD_LOAD(it);
#pragma unroll
                for (int j = 0; j < 4; ++j) { const int i = tid + 512 * j, kk = i >> 7, c = i & 127; Wt[c * 20 + kk] = wpre[j]; }
                if (tid < 128) { float sn, cn; fsincospi((float)tid * (1.0f / 64.0f), &sn, &cn); cst[tid] = (f32x2){cn * 0.08838834764831845f, sn * 0.08838834764831845f}; }
                else if (tid < 256 && kb == 0) bl[tid - 128] = bin[OFF_FFT + g * 128 + (tid - 128)];
                __syncthreads();
                if (!wq_have) { WAB_LOAD(); wq_have = true; }
                const int m = tid & 127, ks = tid >> 7; f32x2 acc[4];
#pragma unroll
                for (int kk = 0; kk < 4; ++kk) acc[kk] = (f32x2){0.f, 0.f};
                { int a = 0;
#pragma unroll 8
                for (int c = 0; c < 128; ++c) { const f32x2 t = cst[a]; const f32x4 w = *(const LAS f32x4*)(Wt + c * 20 + ks * 4);
#pragma unroll
                    for (int kk = 0; kk < 4; ++kk) acc[kk] += t * w[kk];
                    a = (a + m) & 127; } }
                bf16* dc = WIN + (size_t)(4096 + g * 128 + m) * 1024 + kb * 16 + ks * 4; bf16* dsn = dc + (size_t)512 * 1024;
                { v2u o; o.x = pk2(acc[0][0], acc[1][0]); o.y = pk2(acc[2][0], acc[3][0]); *(v2u*)dc = o; o.x = pk2(acc[0][1], acc[1][1]); o.y = pk2(acc[2][1], acc[3][1]); *(v2u*)dsn = o; }
                if (kb == 0 && tid < 256) {
                    const int cs = tid >> 7; float sb = 0.f; int a = 0;
#pragma unroll 8
                    for (int c = 0; c < 128; ++c) { const f32x2 t = cst[a]; sb += bl[c] * (cs ? t[1] : t[0]); a = (a + m) & 127; }
                    binv[4096 + cs * 512 + g * 128 + m] = sb; }
                if (it + X.G < 256) __syncthreads();
            }
            if (!wq_have) { __syncthreads(); WAB_LOAD(); }
#pragma unroll
            for (int j = 0; j < 8; ++j) { LAS float* p = wab + (4 * (j >> 1)) * 1024 + tid + 512 * (j & 1); p[0] = wq[j][0]; p[1024] = wq[j][1]; p[2048] = wq[j][2]; p[3072] = wq[j][3]; }
            __syncthreads();
#undef FOLD_LOAD
#undef WAB_LOAD
            f32x4 pe[4]; int pe_t = -1;
#pragma unroll
            for (int j = 0; j < 4; ++j) pe[j] = (f32x4){0.f, 0.f, 0.f, 0.f};
            for (int rowb = gw; rowb < NTOK; rowb += 2 * NGW) {
                f32x4 va[4], vb2[4], scvB[4], shvB[4];
                {
                    const int rB_ = rowb + NGW < NTOK ? rowb + NGW : NTOK - 1; const int miB = rB_ < NLAT ? (rB_ >> 11) : 8; const float* shB = mv + miB * 6144, *scB = shB + 1024;
                    const float* srcB = (l == 0) ? (rB_ < NLAT ? INP(I_X) + (size_t)rB_ * D : INP(I_CTX) + (size_t)(rB_ - NLAT) * D) : (rB_ < NLAT ? (const float*)hlat + (size_t)rB_ * D : (const float*)hctx + (size_t)(rB_ - NLAT) * D);
#pragma unroll
                    for (int j = 0; j < 4; ++j) { vb2[j] = *(const f32x4*)(srcB + 4 * lane + 256 * j); scvB[j] = *(const f32x4*)(scB + 4 * lane + 256 * j); shvB[j] = *(const f32x4*)(shB + 4 * lane + 256 * j); } }
                { const int row_ = rowb + 0, row = row_ < NTOK ? row_ : NTOK - 1; const bool LIVE_ = row_ < NTOK;
                float* hrow = row < NLAT ? hlat + (size_t)row * D : hctx + (size_t)(row - NLAT) * D;
                const int mi = row < NLAT ? (row >> 11) : 8; const float* shift = mv + mi * 6144, *scale = shift + 1024;

                if (l == 0) {
                    const float* src = row < NLAT ? INP(I_X) + (size_t)row * D : INP(I_CTX) + (size_t)(row - NLAT) * D;
#pragma unroll
                    for (int j = 0; j < 4; ++j) va[j] = *(const f32x4*)(src + 4 * lane + 256 * j);
                    if (row < NLAT) { const int t = row & 2047;
                        if (t != pe_t) { pe_t = t; const int prow = t >> 6, pcol = t & 63;
#pragma unroll 1
                            for (int j = 0; j < 4; ++j)
#pragma unroll
                                for (int e = 0; e < 4; ++e) { const int col = 4 * lane + 256 * j + e, part = col >> 9, within = col & 511, i = within & 255;
                                    const float omega = __builtin_amdgcn_exp2f((float)i * (-13.287712379549449f / 256.0f)); const float rev = (float)(part ? pcol : prow) * omega * 0.15915494309189535f;
                                    const float pv = (within >> 8) ? __builtin_amdgcn_cosf(rev) : __builtin_amdgcn_sinf(rev);
                                    if (j == 0) pe[0][e] = pv; else if (j == 1) pe[1][e] = pv; else if (j == 2) pe[2][e] = pv; else pe[3][e] = pv; } }
#pragma unroll
                        for (int j = 0; j < 4; ++j) va[j] += pe[j]; }
#pragma unroll
                    for (int j = 0; j < 4; ++j) if (LIVE_) *(f32x4*)(hrow + 4 * lane + 256 * j) = va[j];
                } else {
#pragma unroll
                    for (int j = 0; j < 4; ++j) va[j] = *(const f32x4*)(hrow + 4 * lane + 256 * j);
                }
                f32x4 scv[4], shv[4];
#pragma unroll
                for (int j = 0; j < 4; ++j) { scv[j] = *(const f32x4*)(scale + 4 * lane + 256 * j); shv[j] = *(const f32x4*)(shift + 4 * lane + 256 * j); }
                ln_rows(va);
#pragma unroll
                for (int j = 0; j < 4; ++j) { const f32x4 sc = scv[j], sh = shv[j]; va[j] = va[j] * (sc + 1.0f) + sh;
                    v2u w; w.x = pk2(va[j][0], va[j][1]); w.y = pk2(va[j][2], va[j][3]); if (LIVE_) *(v2u*)(XN + (size_t)row * D + 4 * lane + 256 * j) = w; }
                }
                { const int row_ = rowb + NGW, row = row_ < NTOK ? row_ : NTOK - 1; const bool LIVE_ = row_ < NTOK;
                float* hrow = row < NLAT ? hlat + (size_t)row * D : hctx + (size_t)(row - NLAT) * D;
                const int mi = row < NLAT ? (row >> 11) : 8; const float* shift = mv + mi * 6144, *scale = shift + 1024;

                if (l == 0) {
                    const float* src = row < NLAT ? INP(I_X) + (size_t)row * D : INP(I_CTX) + (size_t)(row - NLAT) * D;
                    if (row < NLAT) { const int t = row & 2047;
                        if (t != pe_t) { pe_t = t; const int prow = t >> 6, pcol = t & 63;
#pragma unroll 1
                            for (int j = 0; j < 4; ++j)
#pragma unroll
                                for (int e = 0; e < 4; ++e) { const int col = 4 * lane + 256 * j + e, part = col >> 9, within = col & 511, i = within & 255;
                                    const float omega = __builtin_amdgcn_exp2f((float)i * (-13.287712379549449f / 256.0f)); const float rev = (float)(part ? pcol : prow) * omega * 0.15915494309189535f;
                                    const float pv = (within >> 8) ? __builtin_amdgcn_cosf(rev) : __builtin_amdgcn_sinf(rev);
                                    if (j == 0) pe[0][e] = pv; else if (j == 1) pe[1][e] = pv; else if (j == 2) pe[2][e] = pv; else pe[3][e] = pv; } }
#pragma unroll
                        for (int j = 0; j < 4; ++j) vb2[j] += pe[j]; }
#pragma unroll
                    for (int j = 0; j < 4; ++j) if (LIVE_) *(f32x4*)(hrow + 4 * lane + 256 * j) = vb2[j];
                } else {
                }
                f32x4 scv[4], shv[4];
#pragma unroll
                for (int j = 0; j < 4; ++j) { scv[j] = scvB[j]; shv[j] = shvB[j]; }
                ln_rows(vb2);
#pragma unroll
                for (int j = 0; j < 4; ++j) { const f32x4 sc = scv[j], sh = shv[j]; vb2[j] = vb2[j] * (sc + 1.0f) + sh;
                    v2u w; w.x = pk2(vb2[j][0], vb2[j][1]); w.y = pk2(vb2[j][2], vb2[j][3]); if (LIVE_) *(v2u*)(XN + (size_t)row * D + 4 * lane + 256 * j) = w; }
                }
                float pa[16], pb_[16];
                { f32x2 vp[4][4];
#pragma unroll
                  for (int j = 0; j < 4; ++j)
#pragma unroll
                      for (int e = 0; e < 4; ++e) vp[j][e] = (f32x2){va[j][e], vb2[j][e]};
#pragma unroll
                  for (int o = 0; o < 16; ++o) { f32x2 sr = (f32x2){0.f, 0.f};
#pragma unroll
                    for (int j = 0; j < 4; ++j) { const f32x4 w = *(const LAS f32x4*)(wab + o * 1024 + 4 * lane + 256 * j);
#pragma unroll
                        for (int e = 0; e < 4; ++e) sr += vp[j][e] * w[e]; }
                    pa[o] = sr[0]; pb_[o] = sr[1]; if ((o & 3) == 3) asm volatile("" ::: "memory"); } }
                const float t0_ = reduce16(pa, lane), t1_ = reduce16(pb_, lane);
                if ((lane & 3) == 0) { AB[(size_t)rowb * 16 + (lane >> 2)] = t0_ + bin[OFF_A + (lane >> 2)]; if (rowb + NGW < NTOK) AB[(size_t)(rowb + NGW) * 16 + (lane >> 2)] = t1_ + bin[OFF_A + (lane >> 2)]; }
            }
        } }
        SEAM(pb + 0);

        for (int rep_ = 0; rep_ <= (int)PH_REP(2); ++rep_) { if (rep_) GRID_BAR();
        if (PH_ON(2) && IN(pb + 1)) { PH_BEGIN(); const float* mv = modv + (size_t)l * 9 * 6144; (void)mv; unsigned* const moecnt = ctl + CW_MOE + l * 16 * 64; (void)moecnt;
            SchedInA S{X.G, X.bid, (const char*)XN, (const char*)WIN};
            EpiInA E{PQKV, PZ, PCONF, PSGU, PFFT, PFFTC, binv};
            pg8::gemm_phase<EpiInA, SchedInA, true, true>(lds, Gemm{1024, 1024, 1024}, S, E);
        } }
        SEAM(pb + 1);

        for (int rep_ = 0; rep_ <= (int)PH_REP(3); ++rep_) { if (rep_) GRID_BAR();
        if (PH_ON(3) && IN(pb + 2)) { PH_BEGIN(); const float* mv = modv + (size_t)l * 9 * 6144; (void)mv; unsigned* const moecnt = ctl + CW_MOE + l * 16 * 64; (void)moecnt;
            {
                const int vb = X.bid, NB2 = X.G, gw2 = gw, NGW2 = NGW;
                if (l == 0) { SchedFftCtx S{NB2, vb, (const char*)DFTC, (const char*)PFFTC}; EpiBf16<0> E{BR + (size_t)2 * NTOK * 512, 512, nullptr};
                  pg8::gemm_phase<EpiBf16<0>, SchedFftCtx, true, true>(lds, Gemm{512, 512, 512}, S, E); }
                __syncthreads();
                {
                    typedef short v4i16_t __attribute__((ext_vector_type(4)));
                    LAS unsigned char* tl = lds + X.wave * 8192;
                    const int r16 = lane & 15, quad = lane >> 4;
                    bf16x8 m1[4][2];
#pragma unroll
                    for (int mt = 0; mt < 4; ++mt)
#pragma unroll
                        for (int ks = 0; ks < 2; ++ks) { float o[8]; const int k1 = 16 * (mt & 1) + r16, ri = mt >> 1;
#pragma unroll
                            for (int e = 0; e < 8; ++e) { const int t1 = 8 * quad + e; float sn, cs; fsincospi((float)((k1 * t1) & 31) * (1.0f / 16.0f), &sn, &cs);
                                o[e] = ri == 0 ? (ks == 0 ? cs : -sn) : (ks == 0 ? -sn : -cs); }
                            m1[mt][ks] = __builtin_bit_cast(bf16x8, pack8(o)); }
                    float twc[2][4][4], tws[2][4][4];
#pragma unroll
                    for (int ml = 0; ml < 2; ++ml)
#pragma unroll
                        for (int c = 0; c < 4; ++c)
#pragma unroll
                            for (int r = 0; r < 4; ++r) { const int k1 = 16 * ml + r16, t2 = 16 * c + 4 * quad + r; fsincospi((float)(k1 * t2) * (1.0f / 1024.0f), &tws[ml][c][r], &twc[ml][c][r]); }
                    const unsigned tbase = (unsigned)(size_t)tl;
                    for (int it = gw2; it < NB * 512; it += NGW2) {
                        const int b = it >> 9, col = it & 511;
                        const bf16* src = PFFT + (size_t)it * 4096;
                        v4u ld[8];
#pragma unroll
                        for (int i = 0; i < 8; ++i) ld[i] = *(const v4u*)(src + (i * 64 + lane) * 8);
#pragma unroll
                        for (int i = 0; i < 8; ++i) *(LAS v4u*)(tl + (i * 64 + lane) * 16) = ld[i];
                        LDS_WAIT();
                        bf16* dst = (b < 4 ? F1A + (size_t)(b * 512 + col) * 4096 : F1B + (size_t)((b - 4) * 512 + col) * 4096);
#pragma unroll
                        for (int c = 0; c < 4; ++c) {
                            bf16x8 af[2];
#pragma unroll
                            for (int ks = 0; ks < 2; ++ks) { v4i16_t h[2];
#pragma unroll
                                for (int t = 0; t < 2; ++t) h[t] = __builtin_amdgcn_ds_read_tr16_b64_v4i16((LAS v4i16_t*)(tl + ks * 4096 + (8 * quad + 4 * t + (r16 >> 2)) * 128 + (16 * c + 4 * (lane & 3)) * 2));
                                bf16x8 f; f[0] = h[0][0]; f[1] = h[0][1]; f[2] = h[0][2]; f[3] = h[0][3]; f[4] = h[1][0]; f[5] = h[1][1]; f[6] = h[1][2]; f[7] = h[1][3]; af[ks] = f; }
                            f32x4 acc[4];
#pragma unroll
                            for (int mt = 0; mt < 4; ++mt) { acc[mt] = (f32x4){0.f, 0.f, 0.f, 0.f};
#pragma unroll
                                for (int ks = 0; ks < 2; ++ks) acc[mt] = __builtin_amdgcn_mfma_f32_16x16x32_bf16(af[ks], m1[mt][ks], acc[mt], 0, 0, 0); }
#pragma unroll
                            for (int ml = 0; ml < 2; ++ml) { const int k1 = 16 * ml + r16; float pr[4], pi[4];
#pragma unroll
                                for (int r = 0; r < 4; ++r) { const float ar = acc[ml][r], ai = acc[ml + 2][r]; pr[r] = ar * twc[ml][c][r] + ai * tws[ml][c][r]; pi[r] = ai * twc[ml][c][r] - ar * tws[ml][c][r]; }
                                v2u w0, w1; w0.x = pk2(pr[0], pr[1]); w0.y = pk2(pr[2], pr[3]); w1.x = pk2(pi[0], pi[1]); w1.y = pk2(pi[2], pi[3]);
                                *(v2u*)(dst + k1 * 128 + 16 * c + 4 * quad) = w0; *(v2u*)(dst + k1 * 128 + 64 + 16 * c + 4 * quad) = w1; }
                        }
                        LDS_WAIT();
                    }
                    (void)tbase;
                    __syncthreads();
                }
                {
                    LAS float* cwl = (LAS float*)lds;
                    const float* cw = INP(I_GCONV) + (size_t)l * 5 * 1536;
                    { f32x4 t4[4];
#pragma unroll
                      for (int j = 0; j < 4; ++j) { const int i = tid + 512 * j; t4[j] = *(const f32x4*)(cw + 4 * (i < 1920 ? i : 0)); }
#pragma unroll
                      for (int j = 0; j < 4; ++j) { const int i = tid + 512 * j; if (i < 1920) *(LAS f32x4*)(cwl + 4 * i) = t4[j]; } }
                    __syncthreads();
                    const float gdt_l = INP(I_GDT)[l * 8 + (lane & 7)], nega_l = -__expf(INP(I_GALOG)[l * 8 + (lane & 7)]);
                    for (int row = gw2; row < NTOK; row += NGW2) {
                        int t, T; if (row < NLAT) { t = row & 2047; T = 2048; } else { t = (row - NLAT) & 255; T = 256; }
                        v4u xr[3][5];
#pragma unroll
                        for (int seg = 0; seg < 3; ++seg)
#pragma unroll
                            for (int j = 0; j < 5; ++j) { const int tt = t + j - 2; xr[seg][j] = (tt >= 0 && tt < T) ? *(const v4u*)(PQKV + (size_t)(row + j - 2) * 1536 + seg * 512 + 8 * lane) : (v4u){0u, 0u, 0u, 0u}; }
                        float av = 0.f, bv = 0.f; if (lane < 8) { av = AB[(size_t)row * 16 + lane]; bv = AB[(size_t)row * 16 + 8 + lane]; }
#pragma unroll
                        for (int seg = 0; seg < 3; ++seg) { const int ch = seg * 512 + 8 * lane; float a[8];
#pragma unroll
                            for (int e = 0; e < 8; ++e) a[e] = 0.f;
#pragma unroll
                            for (int j = 0; j < 5; ++j) { float xv[8]; unpack8(xr[seg][j], xv);
                                const f32x4 w0 = *(const LAS f32x4*)(cwl + j * 1536 + ch), w1 = *(const LAS f32x4*)(cwl + j * 1536 + ch + 4);
#pragma unroll
                                for (int e = 0; e < 4; ++e) { a[e] += w0[e] * xv[e]; a[4 + e] += w1[e] * xv[4 + e]; } }
                            float ss = 0.f;
#pragma unroll
                            for (int e = 0; e < 8; ++e) { a[e] = siluf_(a[e]); ss += a[e] * a[e]; }
                            if (seg < 2) { ss = g16_sum(ss); const float sc = __builtin_amdgcn_rsqf(ss + LN_EPS) * (seg == 0 ? 0.08838834764831845f : 1.0f);
#pragma unroll
                                for (int e = 0; e < 8; ++e) a[e] *= sc; }
                            *(v4u*)(QKV + (size_t)row * 1536 + ch) = pack8(a); }
                        if (lane < 8) { const float xs = av + gdt_l; const float sp = xs > 20.f ? xs : __logf(1.0f + __expf(xs));
                            GB[(size_t)row * 16 + lane] = nega_l * sp; GB[(size_t)row * 16 + 8 + lane] = __builtin_amdgcn_rcpf(1.0f + __expf(-bv)); }
                    }
                    __syncthreads();
                }
                {
                    LAS bf16* xs = (LAS bf16*)lds;
                    LAS float* wl = (LAS float*)(lds + 63488);
                    const float* dw = INP(I_CDWW) + (size_t)l * 31 * 512; const float* dwb = INP(I_CDWB) + l * 512, *lg = INP(I_CLNG) + l * 512, *lb = INP(I_CLNB) + l * 512;
                    bf16* B1 = BR + (size_t)1 * NTOK * 512;
                    { f32x4 t8[8];
#pragma unroll
                      for (int j = 0; j < 8; ++j) { const int i = tid + 512 * j; t8[j] = *(const f32x4*)(dw + 4 * (i < 3968 ? i : 0)); }
#pragma unroll
                      for (int j = 0; j < 8; ++j) { const int i = tid + 512 * j; if (i < 3968) *(LAS f32x4*)(wl + 4 * i) = t8[j]; } }
                    const int ch = 8 * lane, tq = X.wave;
                    f32x4 bia0 = *(const f32x4*)(dwb + ch), bia1 = *(const f32x4*)(dwb + ch + 4);
                    const f32x4 g0 = *(const f32x4*)(lg + ch), g1 = *(const f32x4*)(lg + ch + 4), b0 = *(const f32x4*)(lb + ch), b1 = *(const f32x4*)(lb + ch + 4);
                    for (int tile = vb; tile < nrows2 / 32; tile += NB2) {
                        const int t0 = tile * 32; int rbase, T; if (t0 < NLAT) { rbase = t0 & ~2047; T = 2048; } else { rbase = NLAT + ((t0 - NLAT) & ~255); T = 256; }
                        __syncthreads();
                        { v4u tl8[8];
#pragma unroll
                          for (int j = 0; j < 8; ++j) { const int i = tid + 512 * j, r = i >> 6, c = i & 63, srow = t0 - 15 + r; const bool ok = i < 62 * 64 && srow >= rbase && srow < rbase + T;
                              tl8[j] = *(const v4u*)(PCONF + (size_t)(ok ? srow : t0) * 512 + 8 * c); if (!ok) tl8[j] = (v4u){0u, 0u, 0u, 0u}; }
#pragma unroll
                          for (int j = 0; j < 8; ++j) { const int i = tid + 512 * j, r = i >> 6, c = i & 63; if (i < 62 * 64) *(LAS v4u*)(xs + r * 512 + 8 * c) = tl8[j]; } }
                        __syncthreads();
                        float acc[4][8];
#pragma unroll
                        for (int k = 0; k < 4; ++k)
#pragma unroll
                            for (int e = 0; e < 4; ++e) { acc[k][e] = bia0[e]; acc[k][4 + e] = bia1[e]; }
#pragma unroll 1
                        for (int j = 0; j < 31; ++j) {
                            const f32x4 w0 = *(const LAS f32x4*)(wl + j * 512 + ch), w1 = *(const LAS f32x4*)(wl + j * 512 + ch + 4);
#pragma unroll
                            for (int k = 0; k < 4; ++k) { float xv[8]; unpack8(*(const LAS v4u*)(xs + (tq * 4 + k + j) * 512 + ch), xv);
#pragma unroll
                                for (int e = 0; e < 4; ++e) { acc[k][e] += w0[e] * xv[e]; acc[k][4 + e] += w1[e] * xv[4 + e]; } }
                        }
#pragma unroll
                        for (int k = 0; k < 4; ++k) { float s1 = 0.f;
#pragma unroll
                            for (int e = 0; e < 8; ++e) s1 += acc[k][e];
                            const float mean = g16_sum(s1) * (1.0f / 128.0f); float s2 = 0.f;
#pragma unroll
                            for (int e = 0; e < 8; ++e) { acc[k][e] -= mean; s2 += acc[k][e] * acc[k][e]; }
                            const float rstd = __builtin_amdgcn_rsqf(g16_sum(s2) * (1.0f / 128.0f) + LN_EPS); float o[8];
#pragma unroll
                            for (int e = 0; e < 4; ++e) { o[e] = siluf_(acc[k][e] * rstd * g0[e] + b0[e]); o[4 + e] = siluf_(acc[k][4 + e] * rstd * g1[e] + b1[e]); }
                            *(v4u*)(B1 + (size_t)(t0 + tq * 4 + k) * 512 + ch) = pack8(o); }
                    }
                    __syncthreads();
                }
                {
                    LAS bf16* vnT = (LAS bf16*)lds;
                    const float* lg = INP(I_SLNG) + l * 512, *lb = INP(I_SLNB) + l * 512;
                    bf16* B3 = BR + (size_t)3 * NTOK * 512;
                    const int nitems = (nrows2 / 128) * 4, r16 = lane & 15, quad = lane >> 4, w = X.wave;
                    for (int it = (vb + NB2 - NB2 / 4) % NB2; it < nitems; it += NB2) {
                        const int chunk = it >> 2, g = it & 3, r0 = chunk * 128;
                        unsigned raw[16];
#pragma unroll
                        for (int i = 0; i < 16; ++i) raw[i] = *(const unsigned*)(PSGU + (size_t)(r0 + w * 16 + i) * 1024 + 512 + g * 128 + 2 * lane);
                        const int c = g * 128 + 2 * lane; const float lg0 = lg[c], lg1 = lg[c + 1], lb0 = lb[c], lb1 = lb[c + 1];
                        __syncthreads();
                        { float sv[16];
#pragma unroll
                          for (int i = 0; i < 16; ++i) sv[i] = bflo(raw[i]) + bfhi(raw[i]);
                          const float ts = reduce16(sv, lane) * (1.0f / 128.0f); float mean[16];
#pragma unroll
                          for (int i = 0; i < 16; ++i) { mean[i] = __shfl(ts, 4 * i); const float v0 = bflo(raw[i]) - mean[i], v1 = bfhi(raw[i]) - mean[i]; sv[i] = v0 * v0 + v1 * v1; }
                          const float tv = reduce16(sv, lane) * (1.0f / 128.0f);
#pragma unroll
                          for (int i = 0; i < 16; ++i) { const float rstd = __builtin_amdgcn_rsqf(__shfl(tv, 4 * i) + LN_EPS); const float v0 = bflo(raw[i]) - mean[i], v1 = bfhi(raw[i]) - mean[i];
                            vnT[(2 * lane) * 136 + w * 16 + i] = (bf16)f2bf(v0 * rstd * lg0 + lb0); vnT[(2 * lane + 1) * 136 + w * 16 + i] = (bf16)f2bf(v1 * rstd * lg1 + lb1); } }
                        bf16x8 wf[4];
                        { const float* wsrc = INP(I_SWS) + ((size_t)(l * 4 + g) * 128 + 16 * w + r16) * 128 + quad * 8;
#pragma unroll
                          for (int ks = 0; ks < 4; ++ks) { const f32x4 x0 = *(const f32x4*)(wsrc + 32 * ks), x1 = *(const f32x4*)(wsrc + 32 * ks + 4);
                              v4u pk; pk.x = pk2(x0[0], x0[1]); pk.y = pk2(x0[2], x0[3]); pk.z = pk2(x1[0], x1[1]); pk.w = pk2(x1[2], x1[3]); wf[ks] = __builtin_bit_cast(bf16x8, pk); } }
                        const float bs = INP(I_SBS)[(l * 4 + g) * 128 + 16 * w + r16];
                        __syncthreads();
                        const size_t prow = (size_t)(r0 + 16 * w + r16);
#pragma unroll
                        for (int nt = 0; nt < 8; ++nt) { f32x4 acc = (f32x4){0.f, 0.f, 0.f, 0.f};
#pragma unroll
                            for (int ks = 0; ks < 4; ++ks) { const bf16x8 vf = *(const LAS bf16x8*)(vnT + (16 * nt + r16) * 136 + 32 * ks + quad * 8); acc = __builtin_amdgcn_mfma_f32_16x16x32_bf16(vf, wf[ks], acc, 0, 0, 0); }
                            const v2u uw = *(const v2u*)(PSGU + prow * 1024 + g * 128 + 16 * nt + quad * 4);
                            v2u o; o.x = pk2(bflo(uw.x) * (acc[0] + bs), bfhi(uw.x) * (acc[1] + bs)); o.y = pk2(bflo(uw.y) * (acc[2] + bs), bfhi(uw.y) * (acc[3] + bs));
                            *(v2u*)(B3 + prow * 512 + g * 128 + 16 * nt + quad * 4) = o; }
                    }
                    __syncthreads();
                }
            }
        } }
        SEAM(pb + 2);

        for (int rep_ = 0; rep_ <= (int)PH_REP(4); ++rep_) { if (rep_) GRID_BAR();
        if (PH_ON(4) && IN(pb + 3)) { PH_BEGIN(); const float* mv = modv + (size_t)l * 9 * 6144; (void)mv; unsigned* const moecnt = ctl + CW_MOE + l * 16 * 64; (void)moecnt;
            {
                const int r16 = lane & 15, quad = lane >> 4;
                bf16x8 m2[4][4];
#pragma unroll
                for (int jt = 0; jt < 4; ++jt)
#pragma unroll
                    for (int ks = 0; ks < 4; ++ks) { float o[8]; const int k2 = 16 * jt + r16;
#pragma unroll
                        for (int e = 0; e < 8; ++e) { const int t2 = 32 * (ks & 1) + 8 * quad + e; float sn, cs; fsincospi((float)((k2 * t2) & 63) * (1.0f / 32.0f), &sn, &cs); o[e] = ((ks >> 1) ? sn : cs) * 0.022097086912079608f; }
                        m2[jt][ks] = __builtin_bit_cast(bf16x8, pack8(o)); }
                bf16* B2 = BR + (size_t)2 * NTOK * 512;
                const int nq5 = 9216 - 4 * NGW;
                const bool bal = nq5 > 0 && nq5 < NGW;
                for (int it = bal ? gw - nq5 : gw; it < 8192; it += bal ? NGW - nq5 : NGW) {
                    if (it < 0) break;
                    const int b = it >> 10, k1 = (it >> 5) & 31, ct = it & 31;
                    const bf16* f1 = (b < 4 ? F1A + (size_t)(b * 512 + 16 * ct + r16) * 4096 : F1B + (size_t)((b - 4) * 512 + 16 * ct + r16) * 4096) + k1 * 128 + 8 * quad;
                    bf16x8 af[4];
#pragma unroll
                    for (int ks = 0; ks < 4; ++ks) af[ks] = *(const bf16x8*)(f1 + 32 * ks);
#pragma unroll
                    for (int jt = 0; jt < 4; ++jt) { f32x4 acc = (f32x4){0.f, 0.f, 0.f, 0.f};
#pragma unroll
                        for (int ks = 0; ks < 4; ++ks) acc = __builtin_amdgcn_mfma_f32_16x16x32_bf16(af[ks], m2[jt][ks], acc, 0, 0, 0);
                        v2u w; w.x = pk2(acc[0], acc[1]); w.y = pk2(acc[2], acc[3]);
                        *(v2u*)(B2 + (size_t)(b * 2048 + k1 + 32 * (16 * jt + r16)) * 512 + 16 * ct + 4 * quad) = w; }
                }
            }
            for (int qi = gw; qi < 9216; qi += NGW) {
                int lane_l = lane; asm volatile("" : "+v"(lane_l));
                const int r16 = lane_l & 15, quad = lane_l >> 4;
                LAS float* const Mt = (LAS float*)(lds + X.wave * 16384);
                LAS float* const gcl = (LAS float*)(lds + 132096 + X.wave * 1024);
                const int item = qi >> 2, q = qi & 3, cidx = item % 36, chain = item / 36, dir = chain & 1, hh = (chain >> 1) & 3, b = chain >> 3;
                const int row0 = cidx < 4 ? NLAT + b * CTXL + cidx * 64 : b * SEQ + (cidx - 4) * 64;
                const int rb = row0 + (dir ? 63 : 0); const long sg = dir ? -1 : 1;
                const float ga = GB[(size_t)(rb + sg * lane_l) * 16 + dir * 4 + hh], be = GB[(size_t)(rb + sg * lane_l) * 16 + 8 + dir * 4 + hh];
                float gc = ga;
#pragma unroll
                for (int o = 1; o < 64; o <<= 1) { const float tu = __shfl_up(gc, o); gc += (lane_l >= o) ? tu : 0.f; }
                const float gl = __shfl(gc, 63);
                gcl[lane_l] = gc; gcl[64 + lane_l] = be;
                const float scl = q >= 2 ? be * __expf(gc) : be;
                bf16x8 Kf[4][4];
                { const bf16* kp = QKV + (size_t)(rb + sg * r16) * 1536 + 512 + hh * 128 + quad * 8; const long ms = sg * 16 * 1536;
#pragma unroll
                  for (int mi = 0; mi < 4; ++mi)
#pragma unroll
                      for (int ks = 0; ks < 4; ++ks) Kf[mi][ks] = *(const bf16x8*)(kp + mi * ms + ks * 32); }
                LDS_WAIT();
                if (q == 0) {
                    bf16x8 Qf[4][4];
                    { const bf16* qp = QKV + (size_t)(rb + sg * r16) * 1536 + hh * 128 + quad * 8; const long ms = sg * 16 * 1536;
#pragma unroll
                      for (int mi = 0; mi < 4; ++mi)
#pragma unroll
                          for (int ks = 0; ks < 4; ++ks) Qf[mi][ks] = *(const bf16x8*)(qp + mi * ms + ks * 32); }
                    bf16* ait = AIT + (size_t)item * 4096 + (size_t)r16 * 8 + 4 * (quad & 1) + (quad >> 1) * 128;
#pragma unroll
                    for (int mi = 0; mi < 4; ++mi) { const float gci = gcl[16 * mi + r16];
#pragma unroll
                        for (int nj = 0; nj < 4; ++nj) {
                            v2u w; w.x = 0u; w.y = 0u;
                            if (nj <= mi) {
                                f32x4 c = (f32x4){0.f, 0.f, 0.f, 0.f};
#pragma unroll
                                for (int ks = 0; ks < 4; ++ks) c = __builtin_amdgcn_mfma_f32_16x16x32_bf16(Kf[nj][ks], Qf[mi][ks], c, 0, 0, 0);
                                const f32x4 gcj = *(const LAS f32x4*)(gcl + 16 * nj + quad * 4); float o4[4];
#pragma unroll
                                for (int r = 0; r < 4; ++r) { const bool incl = (nj < mi) || (quad * 4 + r <= r16); o4[r] = incl ? c[r] * __expf(gci - gcj[r]) : 0.f; }
                                w.x = pk2(o4[0], o4[1]); w.y = pk2(o4[2], o4[3]); }
                            *(v2u*)(ait + (mi * 2 + (nj >> 1)) * 512 + (nj & 1) * 256) = w; }
                    }
                }
                if (q == 1) { SIT[(size_t)item * 192 + lane_l] = __expf(gc); SIT[(size_t)item * 192 + 64 + lane_l] = __expf(gl - gc); if (lane_l == 0) SIT[(size_t)item * 192 + 128] = __expf(gl); }
                asm volatile("" ::: "memory");
                { LAS float* mw = Mt + r16 * 64 + quad * 4;
#pragma unroll
                  for (int mi = 0; mi < 4; ++mi) {
                    const f32x4 gci = *(const LAS f32x4*)(gcl + 16 * mi + quad * 4), bei = *(const LAS f32x4*)(gcl + 64 + 16 * mi + quad * 4);
#pragma unroll
                    for (int nj = 0; nj <= mi; ++nj) {
                        f32x4 c = (f32x4){0.f, 0.f, 0.f, 0.f};
#pragma unroll
                        for (int ks = 0; ks < 4; ++ks) c = __builtin_amdgcn_mfma_f32_16x16x32_bf16(Kf[mi][ks], Kf[nj][ks], c, 0, 0, 0);
                        const float gcj = gcl[16 * nj + r16]; f32x4 mv4;
#pragma unroll
                        for (int r = 0; r < 4; ++r) { const bool strict = (nj < mi) || (r16 < quad * 4 + r); mv4[r] = strict ? -(bei[r] * c[r] * __expf(gci[r] - gcj)) : 0.f; }
                        *(LAS f32x4*)(mw + (16 * nj) * 64 + 16 * mi) = mv4;
                    }
                  } }
                asm volatile("" ::: "memory");
                LDS_WAIT();
                float Xs[64];
                { const bf16* src = QKV + (size_t)rb * 1536 + (q < 2 ? 1024 + 64 * q : 512 + 64 * (q - 2)) + hh * 128 + lane_l; const long sstep = sg * 1536;
                  bf16 raw[64];
#pragma unroll
                  for (int sidx = 0; sidx < 64; ++sidx) { raw[sidx] = *src; src += sstep; }
                  asm volatile("" ::: "memory");
#pragma unroll
                  for (int sidx = 0; sidx < 64; ++sidx) { const float sc = __builtin_bit_cast(float, __builtin_amdgcn_readlane(__builtin_bit_cast(int, scl), sidx)); Xs[sidx] = bf1(raw[sidx]) * sc; } }
#pragma unroll
                for (int g4 = 0; g4 < 16; ++g4) {
                    f32x4 acc = (f32x4){Xs[4 * g4], Xs[4 * g4 + 1], Xs[4 * g4 + 2], Xs[4 * g4 + 3]};
#pragma unroll
                    for (int c0 = 0; c0 < 4 * g4; c0 += 16) {
                        f32x4 mb[16];
#pragma unroll
                        for (int e = 0; e < 16; ++e) if (c0 + e < 4 * g4) mb[e] = *(const LAS f32x4*)(Mt + (c0 + e) * 64 + 4 * g4);
                        LDS_WAIT();
#pragma unroll
                        for (int e = 0; e < 16; ++e) if (c0 + e < 4 * g4) acc += mb[e] * Xs[c0 + e];
                    }
                    const f32x4 m0 = *(const LAS f32x4*)(Mt + (4 * g4) * 64 + 4 * g4), m1 = *(const LAS f32x4*)(Mt + (4 * g4 + 1) * 64 + 4 * g4), m2 = *(const LAS f32x4*)(Mt + (4 * g4 + 2) * 64 + 4 * g4);
                    LDS_WAIT();
                    const float x0 = acc[0], x1 = acc[1] + m0[1] * x0, x2 = acc[2] + m0[2] * x0 + m1[2] * x1, x3 = acc[3] + m0[3] * x0 + m1[3] * x1 + m2[3] * x2;
                    Xs[4 * g4] = x0; Xs[4 * g4 + 1] = x1; Xs[4 * g4 + 2] = x2; Xs[4 * g4 + 3] = x3;
                }
                if (q < 2) {
                    bf16* u0 = UIT + (size_t)item * 8192 + ((size_t)((2 * q + (lane_l >> 5)) * 2 + ((lane_l >> 4) & 1)) * 256 + (lane_l & 15)) * 4;
#pragma unroll
                    for (int g = 0; g < 16; ++g) { v2u c0; c0.x = pk2(Xs[4 * g], Xs[4 * g + 1]); c0.y = pk2(Xs[4 * g + 2], Xs[4 * g + 3]);
                        *(v2u*)(u0 + ((g >> 2) * 64 + (g & 3) * 16) * 4) = c0; }
                } else {
                    { LAS bf16* Tt = (LAS bf16*)Mt;
                      LDS_WAIT(); asm volatile("" ::: "memory");
#pragma unroll
                      for (int sidx = 0; sidx < 64; ++sidx) Tt[sidx * 72 + lane_l] = (bf16)f2bf(Xs[sidx]);
                      LDS_WAIT(); asm volatile("" ::: "memory");
                      bf16* w0 = WIT + (size_t)item * 8192 + (size_t)lane_l * 8;
#pragma unroll
                      for (int mtt = 0; mtt < 4; ++mtt)
#pragma unroll
                          for (int ksl = 0; ksl < 2; ++ksl) { const v4u pc = *(const LAS v4u*)(Tt + (16 * mtt + r16) * 72 + 32 * ksl + 8 * quad);
                              *(v4u*)(w0 + (mtt * 4 + 2 * (q - 2) + ksl) * 512) = pc; }
                      LDS_WAIT(); }
                    asm volatile("" ::: "memory");
                    if (dir == 0) {
                        const bf16* src = QKV + (size_t)row0 * 1536 + 512 + hh * 128 + 64 * (q - 2) + lane_l;
                        bf16* k0 = KIT + ((size_t)((b * 4 + hh) * 36 + cidx)) * 8192 + ((size_t)(2 * (4 * (q - 2) + (lane_l >> 4))) * 64 + (lane_l & 15)) * 8;
                        unsigned kw[64];
#pragma unroll
                        for (int e = 0; e < 64; ++e) kw[e] = src[(size_t)e * 1536];
                        asm volatile("" ::: "memory");
#pragma unroll
                        for (int p = 0; p < 8; ++p) { v4u lo; lo.x = kw[8 * p] | (kw[8 * p + 1] << 16); lo.y = kw[8 * p + 2] | (kw[8 * p + 3] << 16); lo.z = kw[8 * p + 4] | (kw[8 * p + 5] << 16); lo.w = kw[8 * p + 6] | (kw[8 * p + 7] << 16);
                            *(v4u*)(k0 + ((p >> 2) * 64 + (p & 3) * 16) * 8) = lo; }
                    }
                }
                LDS_WAIT();
            }
        } }
        SEAM(pb + 3);

        for (int rep_ = 0; rep_ <= (int)PH_REP(5); ++rep_) { if (rep_) GRID_BAR();
        if (PH_ON(5) && IN(pb + 4)) { PH_BEGIN(); const float* mv = modv + (size_t)l * 9 * 6144; (void)mv; unsigned* const moecnt = ctl + CW_MOE + l * 16 * 64; (void)moecnt;
            LAS bf16* const STl = (LAS bf16*)lds;
            LAS bf16* const VNl = (LAS bf16*)(lds + 8704);
            LAS bf16* const VSl = (LAS bf16*)(lds + 13312);
            LAS bf16* const OTl = (LAS bf16*)(lds + 17920);
            const int w = X.wave, mt = w & 3, role = w >> 2, r16 = lane & 15, quad = lane >> 4;
            for (int blk = X.bid; blk < 256; blk += X.G) {
                const int item = (blk & 7) * 32 + (blk >> 3);
                const int chain = item >> 2, slice = item & 3, dir = chain & 1, hh = (chain >> 1) & 3, b = chain >> 3;
                bf16* const O = dir ? OB : OF;
                __syncthreads();
                for (int i = tid; i < 32 * 136 / 2; i += 512) ((LAS unsigned*)STl)[i] = 0u;
                __syncthreads();
                f32x4 Sacc[2]; Sacc[0] = (f32x4){0.f, 0.f, 0.f, 0.f}; Sacc[1] = (f32x4){0.f, 0.f, 0.f, 0.f};
#define GDN_LOAD(P, step_) do { const int cidx_ = dir ? ((step_) < 4 ? 3 - (step_) : 39 - (step_)) : (step_); const int item_ = chain * 36 + cidx_, kti_ = (chain >> 1) * 36 + cidx_; \
                    const int row0_ = cidx_ < 4 ? NLAT + b * CTXL + cidx_ * 64 : b * SEQ + (cidx_ - 4) * 64; \
                    const bf16* xp_ = role ? QKV + (size_t)(row0_ + (dir ? 63 - (16 * mt + r16) : 16 * mt + r16)) * 1536 + hh * 128 + quad * 8 : WIT + (size_t)item_ * 8192 + (mt * 256 + lane) * 8;     \
                    _Pragma("unroll") for (int ks = 0; ks < 4; ++ks) P##Xf[ks] = *(const bf16x8*)(xp_ + (role ? 32 : 512) * ks); \
                    { const bf16* kp_ = KIT + (size_t)kti_ * 8192 + (dir ? ((2 * w + 1) * 64 + (3 - quad) * 16 + r16) * 8 : (2 * w * 64 + quad * 16 + r16) * 8);     \
                      _Pragma("unroll") for (int ks = 0; ks < 2; ++ks) P##Kx[ks] = *(const v4u*)(kp_ + (dir ? -512 * ks : 512 * ks)); } \
                    const float* sp_ = SIT + (size_t)item_ * 192; P##sc4 = *(const f32x4*)(sp_ + (role ? 0 : 64) + 16 * mt + quad * 4); P##egl = sp_[128]; \
                      \
                    { const bf16* a0_ = role ? AIT + (size_t)item_ * 4096 + (mt * 128 + lane) * 8 : UIT + (size_t)item_ * 8192 + ((slice * 2 * 4 + mt) * 64 + lane) * 4; \
                      const bf16* a1_ = role ? a0_ + 512 : a0_ + 1024; \
                      P##Ax[0] = *(const v2u*)a0_; P##Ax[1] = *(const v2u*)(a0_ + 4); P##Ax[2] = *(const v2u*)a1_; P##Ax[3] = *(const v2u*)(a1_ + 4); } } while (0)
#define GDN_BAR() do { asm volatile("s_waitcnt lgkmcnt(0)" ::: "memory"); __builtin_amdgcn_s_barrier(); asm volatile("" ::: "memory"); } while (0)
#define GDN_STEP(P, step_) do { const int cidx = dir ? ((step_) < 4 ? 3 - (step_) : 39 - (step_)) : (step_); \
                    const int row0 = cidx < 4 ? NLAT + b * CTXL + cidx * 64 : b * SEQ + (cidx - 4) * 64; \
                      \
                    f32x4 x1[2]; x1[0] = (f32x4){0.f, 0.f, 0.f, 0.f}; x1[1] = (f32x4){0.f, 0.f, 0.f, 0.f}; \
                    { bf16x8 bfr[2][4]; \
                      _Pragma("unroll") for (int n_ = 0; n_ < 2; ++n_) _Pragma("unroll") for (int ks = 0; ks < 4; ++ks) bfr[n_][ks] = *(const LAS bf16x8*)(STl + (16 * n_ + r16) * 136 + 32 * ks + quad * 8); \
                      asm volatile("s_waitcnt lgkmcnt(0)" ::: "memory"); \
                      _Pragma("unroll") for (int ks = 0; ks < 4; ++ks) { x1[0] = __builtin_amdgcn_mfma_f32_16x16x32_bf16(P##Xf[ks], bfr[0][ks], x1[0], 0, 0, 0); x1[1] = __builtin_amdgcn_mfma_f32_16x16x32_bf16(P##Xf[ks], bfr[1][ks], x1[1], 0, 0, 0); } } \
                    if (role == 0) { \
                        _Pragma("unroll") for (int n_ = 0; n_ < 2; ++n_) { f32x4 vn; vn[0] = bflo(P##Ax[2 * n_].x) - x1[n_][0]; vn[1] = bfhi(P##Ax[2 * n_].x) - x1[n_][1]; vn[2] = bflo(P##Ax[2 * n_].y) - x1[n_][2]; vn[3] = bfhi(P##Ax[2 * n_].y) - x1[n_][3]; \
                            v2u p; p.x = pk2(vn[0], vn[1]); p.y = pk2(vn[2], vn[3]); *(LAS v2u*)(VNl + (16 * n_ + r16) * 72 + 16 * mt + quad * 4) = p; \
                            v2u q; q.x = pk2(vn[0] * P##sc4[0], vn[1] * P##sc4[1]); q.y = pk2(vn[2] * P##sc4[2], vn[3] * P##sc4[3]); *(LAS v2u*)(VSl + (16 * n_ + r16) * 72 + 16 * mt + quad * 4) = q; } } \
                    else { x1[0] = x1[0] * P##sc4; x1[1] = x1[1] * P##sc4; } \
                    bf16x8 kt_[2]; \
                    _Pragma("unroll") for (int ks = 0; ks < 2; ++ks) { const v4u kx_ = P##Kx[ks]; v4u kr_; \
                        kr_.x = dir ? ((kx_.w >> 16) | (kx_.w << 16)) : kx_.x; kr_.y = dir ? ((kx_.z >> 16) | (kx_.z << 16)) : kx_.y; kr_.z = dir ? ((kx_.y >> 16) | (kx_.y << 16)) : kx_.z; kr_.w = dir ? ((kx_.x >> 16) | (kx_.x << 16)) : kx_.w; \
                        kt_[ks] = __builtin_bit_cast(bf16x8, kr_); } \
                    GDN_BAR(); \
                      \
                    bf16x8 vsf[2][2]; \
                    _Pragma("unroll") for (int n2 = 0; n2 < 2; ++n2) { vsf[n2][0] = *(const LAS bf16x8*)(VSl + (16 * n2 + r16) * 72 + quad * 8); vsf[n2][1] = *(const LAS bf16x8*)(VSl + (16 * n2 + r16) * 72 + 32 + quad * 8); } \
                    if (role) { bf16x8 vb[2][2]; \
                        _Pragma("unroll") for (int n_ = 0; n_ < 2; ++n_) { vb[n_][0] = *(const LAS bf16x8*)(VNl + (16 * n_ + r16) * 72 + quad * 8); vb[n_][1] = *(const LAS bf16x8*)(VNl + (16 * n_ + r16) * 72 + 32 + quad * 8); } \
                        asm volatile("s_waitcnt lgkmcnt(0)" ::: "memory"); \
                        v4u af0_; af0_.x = P##Ax[0].x; af0_.y = P##Ax[0].y; af0_.z = P##Ax[1].x; af0_.w = P##Ax[1].y; v4u af1_; af1_.x = P##Ax[2].x; af1_.y = P##Ax[2].y; af1_.z = P##Ax[3].x; af1_.w = P##Ax[3].y; \
                        const bf16x8 Af0_ = __builtin_bit_cast(bf16x8, af0_), Af1_ = __builtin_bit_cast(bf16x8, af1_); \
                        _Pragma("unroll") for (int n_ = 0; n_ < 2; ++n_) { f32x4 oa = __builtin_amdgcn_mfma_f32_16x16x32_bf16(Af0_, vb[n_][0], x1[n_], 0, 0, 0); oa = __builtin_amdgcn_mfma_f32_16x16x32_bf16(Af1_, vb[n_][1], oa, 0, 0, 0); \
                            LAS bf16* ot_ = OTl + (16 * mt + quad * 4) * 36 + 16 * n_ + r16; \
                            _Pragma("unroll") for (int j = 0; j < 4; ++j) ot_[j * 36] = (bf16)f2bf(oa[j]); } } \
                    else { asm volatile("s_waitcnt lgkmcnt(0)" ::: "memory"); } \
                    _Pragma("unroll") for (int n2 = 0; n2 < 2; ++n2) { \
                        f32x4 sa = Sacc[n2] * P##egl; sa = __builtin_amdgcn_mfma_f32_16x16x32_bf16(kt_[0], vsf[n2][0], sa, 0, 0, 0); sa = __builtin_amdgcn_mfma_f32_16x16x32_bf16(kt_[1], vsf[n2][1], sa, 0, 0, 0); Sacc[n2] = sa; \
                        v2u p; p.x = pk2(sa[0], sa[1]); p.y = pk2(sa[2], sa[3]); *(LAS v2u*)(STl + (16 * n2 + r16) * 136 + 16 * w + quad * 4) = p; } \
                    GDN_BAR(); \
                      \
                    { const int tk_ = 8 * w + (lane >> 3), pc_ = lane & 7; const v2u ov_ = *(const LAS v2u*)(OTl + tk_ * 36 + 4 * pc_); \
                      *(v2u*)(O + (size_t)(row0 + (dir ? 63 - tk_ : tk_)) * 512 + hh * 128 + slice * 32 + 4 * pc_) = ov_; } } while (0)
#define GDN_DECL(P) bf16x8 P##Xf[4]; v4u P##Kx[2]; v2u P##Ax[4]; f32x4 P##sc4; float P##egl
                GDN_DECL(sa_); GDN_DECL(sb_);
                GDN_LOAD(sa_, 0);
                *(v2u*)(ws + WS_END + ((size_t)X.bid * 512 + tid) * 8) = (v2u){0u, 0u};
                for (int step = 0; step < 36; step += 2) {
                    GDN_LOAD(sb_, step + 1); GDN_STEP(sa_, step);
                    { const int s2 = step + 2 < 36 ? step + 2 : 35; GDN_LOAD(sa_, s2); } GDN_STEP(sb_, step + 1);
                }
#undef GDN_STEP
#undef GDN_BAR
#undef GDN_DECL
#undef GDN_LOAD
            }
        } }
        SEAM(pb + 4);

        for (int rep_ = 0; rep_ <= (int)PH_REP(6); ++rep_) { if (rep_) GRID_BAR();
        if (PH_ON(6) && IN(pb + 5)) { PH_BEGIN(); const float* mv = modv + (size_t)l * 9 * 6144; (void)mv; unsigned* const moecnt = ctl + CW_MOE + l * 16 * 64; (void)moecnt;
            const float* nw = INP(I_GNORM) + l * 128; const int ch = 8 * lane;
            const f32x4 nw0 = *(const f32x4*)(nw + (ch & 127)), nw1 = *(const f32x4*)(nw + (ch & 127) + 4);
            constexpr int ERT = 9;
            for (int rowb = gw; rowb < nrows2; rowb += ERT * NGW) {
                v4u lf[ERT], lb[ERT], lz[ERT];
#pragma unroll
                for (int k = 0; k < ERT; ++k) { const int row_ = rowb + k * NGW, row = row_ < nrows2 ? row_ : nrows2 - 1; lf[k] = *(const v4u*)(OF + (size_t)row * 512 + ch); lb[k] = *(const v4u*)(OB + (size_t)row * 512 + ch); lz[k] = *(const v4u*)(PZ + (size_t)row * 512 + ch); }
#pragma unroll
                for (int k = 0; k < ERT; ++k) { const int row_ = rowb + k * NGW, row = row_ < nrows2 ? row_ : nrows2 - 1; {
                    float of[8], ob[8], z[8], o[8]; unpack8(lf[k], of); unpack8(lb[k], ob); unpack8(lz[k], z); float ss = 0.f;
#pragma unroll
                    for (int e = 0; e < 8; ++e) { of[e] += ob[e]; ss += of[e] * of[e]; }
                    const float rs = __builtin_amdgcn_rsqf(g16_sum(ss) * (1.0f / 128.0f) + LN_EPS);
#pragma unroll
                    for (int e = 0; e < 4; ++e) { o[e] = of[e] * rs * nw0[e] * z[e]; o[4 + e] = of[4 + e] * rs * nw1[e] * z[4 + e]; }
                    if (row_ < nrows2) *(v4u*)(BR + (size_t)row * 512 + ch) = pack8(o); } }
            }
        } }
        SEAM(pb + 5);

        for (int rep_ = 0; rep_ <= (int)PH_REP(7); ++rep_) { if (rep_) GRID_BAR();
        if (PH_ON(7) && IN(pb + 6)) { PH_BEGIN(); const float* mv = modv + (size_t)l * 9 * 6144; (void)mv; unsigned* const moecnt = ctl + CW_MOE + l * 16 * 64; (void)moecnt;
            SchedBranch S{X.G, X.bid, npan2, (const char*)BR, (const char*)WBR};
            EpiBf16<0> E{GT, 4096, nullptr};
            pg8::gemm_phase<EpiBf16<0>, SchedBranch, true, true>(lds, Gemm{512, 512, 512}, S, E);
        } }
        SEAM(pb + 6);

        for (int rep_ = 0; rep_ <= (int)PH_REP(8); ++rep_) { if (rep_) GRID_BAR();
        if (PH_ON(8) && IN(pb + 7)) { PH_BEGIN(); const float* mv = modv + (size_t)l * 9 * 6144; (void)mv; unsigned* const moecnt = ctl + CW_MOE + l * 16 * 64; (void)moecnt;
            SchedGrid S{X.G, X.bid, npan2, 16, (const char*)XN, (const char*)(WIN + (size_t)5120 * 1024), (size_t)256 * 1024 * 2, (size_t)256 * 1024 * 2};
            EpiGateMerge E{GT, (bf16*)MERGED, binv + 5120};
            pg8::gemm_phase<EpiGateMerge, SchedGrid, true, true>(lds, Gemm{1024, 1024, 1024}, S, E);
        } }
        SEAM(pb + 7);

        for (int rep_ = 0; rep_ <= (int)PH_REP(9); ++rep_) { if (rep_) GRID_BAR();
        if (PH_ON(9) && IN(pb + 8)) { PH_BEGIN(); const float* mv = modv + (size_t)l * 9 * 6144; (void)mv; unsigned* const moecnt = ctl + CW_MOE + l * 16 * 64; (void)moecnt;
            SchedGrid S{X.G, X.bid, npan2, 4, (const char*)MERGED, (const char*)WOUT, (size_t)256 * 1024 * 2, (size_t)256 * 1024 * 2};
            EpiBf16<0> E{(bf16*)YB, 1024, INP(I_BOUT) + l * 1024};
            pg8::gemm_phase<EpiBf16<0>, SchedGrid, true, true>(lds, Gemm{1024, 1024, 1024}, S, E);
            __syncthreads();
            { LAS float* const wscr = (LAS float*)(lds + X.wave * 8448);
              const int first = npan2 * 4 > X.G ? npan2 * 4 - X.G : 0;
              if (X.bid >= first) { const int gwc = (X.bid - first) * NWAVES + X.wave, ngwc = (X.G - first) * NWAVES;
              for (int it = gwc; it < 12288; it += ngwc) {
                if (it < 8192) { const int e = it >> 9, rb = (it & 3) + 4 * ((it >> 3) & 7), kb = ((it >> 2) & 1) + 2 * ((it >> 6) & 7), row0 = rb * 32, j = row0 >> 8, w = row0 & 255;
                    const float* src = (w < 128 ? INP(I_EWG) : INP(I_EWU)) + ((size_t)(l * 16 + e) * 1024) * 512;
                    cvt_item(src, 512, 128 * j + (w & 127) + (lane & 31), kb * 64, WGU + ((size_t)e * 1024 + row0) * 1024, 1024, wscr, lane); }
                else { const int i2 = it - 8192; const int e = i2 >> 8, rb = (i2 & 3) + 4 * ((i2 >> 3) & 7), kb = ((i2 >> 2) & 1) + 2 * ((i2 >> 6) & 3);
                    cvt_item(INP(I_EWD) + ((size_t)(l * 16 + e) * 512) * 1024, 1024, rb * 32 + (lane & 31), kb * 64, WDN + ((size_t)e * 1024 + rb * 32) * 512, 512, wscr, lane); }
              } } }
        } }
        SEAM(pb + 8);

        for (int rep_ = 0; rep_ <= (int)PH_REP(10); ++rep_) { if (rep_) GRID_BAR();
        if (PH_ON(10) && IN(pb + 9)) { PH_BEGIN(); const float* mv = modv + (size_t)l * 9 * 6144; (void)mv; unsigned* const moecnt = ctl + CW_MOE + l * 16 * 64; (void)moecnt;
            LAS float* wr_ = (LAS float*)lds;
            volatile LAS unsigned* lcnt = (volatile LAS unsigned*)(lds + 100352);
            __syncthreads();
            if (tid < 32) lcnt[tid] = 0u;
            { f32x4 rq[10];
#pragma unroll
              for (int j = 0; j < 2; ++j) rq[j] = *(const f32x4*)(INP(I_RGW) + (size_t)l * 4096 + (size_t)(tid + 512 * j) * 4);
#pragma unroll
              for (int j = 0; j < 8; ++j) rq[2 + j] = *(const f32x4*)(INP(I_REW) + (size_t)l * 16384 + (size_t)(tid + 512 * (j & 1)) * 16 + 4 * (j >> 1));
#pragma unroll
              for (int j = 0; j < 2; ++j) { LAS float* p = wr_ + tid + 512 * j; p[0] = rq[j][0]; p[1024] = rq[j][1]; p[2048] = rq[j][2]; p[3072] = rq[j][3]; }
#pragma unroll
              for (int j = 0; j < 8; ++j) { LAS float* p = wr_ + (4 + 4 * (j >> 1)) * 1024 + tid + 512 * (j & 1); p[0] = rq[2 + j][0]; p[1024] = rq[2 + j][1]; p[2048] = rq[2 + j][2]; p[3072] = rq[2 + j][3]; } }
            __syncthreads();
            const float* g1 = INP(I_LN1G) + l * 1024, *b1 = INP(I_LN1B) + l * 1024;
            const float rgb_l = INP(I_RGB)[l * 4 + ((lane >> 4) & 3)], reb_l = INP(I_REB)[l * 16 + ((lane >> 2) & 15)];
            constexpr int RT = 2;
            for (int rowb = gw; rowb < nrows2; rowb += RT * NGW) {
                f32x4 v[RT][4];
#pragma unroll
                for (int q = 0; q < RT; ++q) { const int row_ = rowb + q * NGW, row = row_ < nrows2 ? row_ : nrows2 - 1; const bool live = row_ < nrows2;
                    float* hrow = row < NLAT ? hlat + (size_t)row * D : hctx + (size_t)(row - NLAT) * D;
                    const int mi = row < NLAT ? (row >> 11) : 8; const float* mrow = mv + mi * 6144;
                    v2u yw[4]; f32x4 hv[4], gt[4], g1v[4], b1v[4], scv[4], shv[4];
#pragma unroll
                    for (int j = 0; j < 4; ++j) { const int c = 4 * lane + 256 * j; yw[j] = *(const v2u*)((const bf16*)YB + (size_t)row * D + c); hv[j] = *(const f32x4*)(hrow + c); gt[j] = *(const f32x4*)(mrow + 2048 + c); }
#pragma unroll
                    for (int j = 0; j < 4; ++j) { const int c = 4 * lane + 256 * j; g1v[j] = *(const f32x4*)(g1 + c); b1v[j] = *(const f32x4*)(b1 + c); scv[j] = *(const f32x4*)(mrow + 4096 + c); shv[j] = *(const f32x4*)(mrow + 3072 + c); }
#pragma unroll
                    for (int j = 0; j < 4; ++j) { const f32x4 yv = (f32x4){bflo(yw[j].x), bfhi(yw[j].x), bflo(yw[j].y), bfhi(yw[j].y)}; v[q][j] = hv[j] * DN_ALPHA + gt[j] * yv; }
                    ln_rows(v[q]);
#pragma unroll
                    for (int j = 0; j < 4; ++j) { const int c = 4 * lane + 256 * j; v[q][j] = v[q][j] * g1v[j] + b1v[j]; if (live) *(f32x4*)(hrow + c) = v[q][j]; }
                    ln_rows(v[q]);
#pragma unroll
                    for (int j = 0; j < 4; ++j) { const int c = 4 * lane + 256 * j; v[q][j] = v[q][j] * (scv[j] + 1.0f) + shv[j];
                        v2u w; w.x = pk2(v[q][j][0], v[q][j][1]); w.y = pk2(v[q][j][2], v[q][j][3]); if (live) *(v2u*)(XN + (size_t)row * D + c) = w; }
                    asm volatile("" ::: "memory"); }
                static_assert(RT == 2, "the two rows of a trip ride in the two halves of packed f32 operations");
                float pg[RT][4], pe[RT][16];
                { f32x2 vp[4][4];
#pragma unroll
                  for (int j = 0; j < 4; ++j)
#pragma unroll
                      for (int e = 0; e < 4; ++e) vp[j][e] = (f32x2){v[0][j][e], v[1][j][e]};
#pragma unroll
                  for (int o = 0; o < 20; ++o) { f32x2 sr = (f32x2){0.f, 0.f};
#pragma unroll
                    for (int j = 0; j < 4; ++j) { const f32x4 w = *(const LAS f32x4*)(wr_ + o * 1024 + 4 * lane + 256 * j);
#pragma unroll
                        for (int e = 0; e < 4; ++e) sr += vp[j][e] * w[e]; }
                    if (o < 4) { pg[0][o] = sr[0]; pg[1][o] = sr[1]; } else { pe[0][o - 4] = sr[0]; pe[1][o - 4] = sr[1]; }
                    if ((o & 3) == 3) asm volatile("" ::: "memory"); } }
#pragma unroll
                for (int q = 0; q < RT; ++q) { const int row = rowb + q * NGW;
                float tg = reduce4(pg[q], lane), te = reduce16(pe[q], lane);
                tg += rgb_l; te += reb_l;
                float lg[20];
#pragma unroll
                for (int o = 0; o < 4; ++o) lg[o] = __shfl(tg, o * 16);
#pragma unroll
                for (int o = 0; o < 16; ++o) lg[4 + o] = __shfl(te, o * 4);
                int gs = 0; float gm = lg[0];
#pragma unroll
                for (int o = 1; o < 4; ++o) if (lg[o] > gm) { gm = lg[o]; gs = o; }
                float den = 0.f;
#pragma unroll
                for (int o = 0; o < 4; ++o) den += __expf(lg[o] - gm);
                const float gp = __builtin_amdgcn_rcpf(den);
                float el[4];
#pragma unroll
                for (int o = 0; o < 4; ++o) el[o] = gs == 0 ? lg[4 + o] : gs == 1 ? lg[8 + o] : gs == 2 ? lg[12 + o] : lg[16 + o];
                int i0 = 0; float v0 = el[0];
#pragma unroll
                for (int o = 1; o < 4; ++o) if (el[o] > v0) { v0 = el[o]; i0 = o; }
                int i1 = -1; float v1 = 0.f;
#pragma unroll
                for (int o = 0; o < 4; ++o) if (o != i0 && (i1 < 0 || el[o] > v1)) { v1 = el[o]; i1 = o; }
                const float ex = __expf(v1 - v0), rz = __builtin_amdgcn_rcpf(1.0f + ex), w0 = gp * rz, w1 = gp * ex * rz;
                const int e0 = gs * 4 + i0, e1 = gs * 4 + i1;
                if (lane == 0 && row < nrows2) {
                    const unsigned p0 = __hip_atomic_fetch_add((LAS unsigned*)lcnt + e0, 1u, __ATOMIC_RELAXED, __HIP_MEMORY_SCOPE_WORKGROUP);
                    const unsigned p1 = __hip_atomic_fetch_add((LAS unsigned*)lcnt + e1, 1u, __ATOMIC_RELAXED, __HIP_MEMORY_SCOPE_WORKGROUP);
                    float* rt = ROUTE + (size_t)row * 8;
                    rt[0] = __builtin_bit_cast(float, e0); rt[1] = __builtin_bit_cast(float, e1); rt[2] = w0; rt[3] = w1; rt[4] = __builtin_bit_cast(float, (int)p0); rt[5] = __builtin_bit_cast(float, (int)p1);
                }
                asm volatile("" ::: "memory"); }
            }
            __syncthreads();
            if (tid < 16) { const unsigned c = lcnt[tid]; lcnt[16 + tid] = c ? __hip_atomic_fetch_add(moecnt + 64 * tid, c, __ATOMIC_RELAXED, __HIP_MEMORY_SCOPE_AGENT) : 0u; }
            __syncthreads();
            for (int row = gw + lane * NGW; row < nrows2; row += 64 * NGW) {
                { float* rt = ROUTE + (size_t)row * 8; const int e0 = __builtin_bit_cast(int, rt[0]), e1 = __builtin_bit_cast(int, rt[1]);
                    const int q0 = __builtin_bit_cast(int, rt[4]) + (int)lcnt[16 + e0], q1 = __builtin_bit_cast(int, rt[5]) + (int)lcnt[16 + e1];
                    rt[4] = __builtin_bit_cast(float, q0); rt[5] = __builtin_bit_cast(float, q1);
                    ELIST[(size_t)e0 * NTOK + q0] = row; ELIST[(size_t)e1 * NTOK + q1] = row; }
            }
        } }
        SEAM(pb + 9);


        for (int rep_ = 0; rep_ <= (int)PH_REP(12); ++rep_) { if (rep_) GRID_BAR();
        if (PH_ON(12) && IN(pb + 11)) { PH_BEGIN(); const float* mv = modv + (size_t)l * 9 * 6144; (void)mv; unsigned* const moecnt = ctl + CW_MOE + l * 16 * 64; (void)moecnt;
            SchedMoeG S; S.G = X.G; S.c = X.bid; S.a0 = (const char*)XN; S.w0 = (const char*)WGU; S.wstep_e = (size_t)1024 * 1024 * 2; S.wstep_n = (size_t)256 * 1024 * 2; S.list = ELIST; S.init(moecnt, (LAS unsigned*)(lds + LDSCTL_OFF + 64));
            EpiMoe1 E{HID};
            pg8::gemm_phase<EpiMoe1, SchedMoeG, true, true>(lds, Gemm{1024, 1024, 1024}, S, E);
        } }
        SEAM(pb + 11);

        for (int rep_ = 0; rep_ <= (int)PH_REP(13); ++rep_) { if (rep_) GRID_BAR();
        if (PH_ON(13) && IN(pb + 12)) { PH_BEGIN(); const float* mv = modv + (size_t)l * 9 * 6144; (void)mv; unsigned* const moecnt = ctl + CW_MOE + l * 16 * 64; (void)moecnt;
            SchedMoe S; S.G = X.G; S.c = X.bid; S.a0 = (const char*)HID; S.w0 = (const char*)WDN; S.astep = (size_t)256 * 512 * 2; S.wstep_e = (size_t)1024 * 512 * 2; S.wstep_n = (size_t)256 * 512 * 2; S.init(moecnt);
            EpiBf16<0> E{MO, 1024, nullptr};
            pg8::gemm_phase<EpiBf16<0>, SchedMoe, true, true>(lds, Gemm{512, 512, 512}, S, E);
        } }
        SEAM(pb + 12);

        for (int rep_ = 0; rep_ <= (int)PH_REP(14); ++rep_) { if (rep_) GRID_BAR();
        if (PH_ON(14) && IN(pb + 13)) { PH_BEGIN(); const float* mv = modv + (size_t)l * 9 * 6144; (void)mv; unsigned* const moecnt = ctl + CW_MOE + l * 16 * 64; (void)moecnt;
            unsigned pre[16]; { unsigned s = 0;
#pragma unroll
                for (int e = 0; e < 16; ++e) { pre[e] = s; s += ((__hip_atomic_load(moecnt + 64 * e, __ATOMIC_RELAXED, __HIP_MEMORY_SCOPE_AGENT) + 255u) >> 8) << 8; } }
            const float* g2 = INP(I_LN2G) + l * 1024, *b2 = INP(I_LN2B) + l * 1024;
            for (int rowb = gw; rowb < nrows2; rowb += 3 * NGW) {
                int re0[3], re1[3], rp0[3], rp1[3]; float rw0[3], rw1[3];
#pragma unroll
                for (int k = 0; k < 3; ++k) { const int row_ = rowb + k * NGW, row = row_ < nrows2 ? row_ : nrows2 - 1; const float* rt = ROUTE + (size_t)row * 8;
                    re0[k] = __builtin_bit_cast(int, rt[0]); re1[k] = __builtin_bit_cast(int, rt[1]); rw0[k] = rt[2]; rw1[k] = rt[3]; rp0[k] = __builtin_bit_cast(int, rt[4]); rp1[k] = __builtin_bit_cast(int, rt[5]); }
                v2u ma[3][4], mb[3][4]; f32x4 hv[3][4];
#pragma unroll
                for (int k = 0; k < 3; ++k) { const int row_ = rowb + k * NGW, row = row_ < nrows2 ? row_ : nrows2 - 1; {
                    const int e0 = re0[k], e1 = re1[k]; unsigned ba0 = 0, ba1 = 0;
#pragma unroll
                    for (int q = 0; q < 16; ++q) { ba0 = (q == e0) ? pre[q] : ba0; ba1 = (q == e1) ? pre[q] : ba1; }
                    const bf16* m0 = MO + (size_t)(ba0 + (unsigned)rp0[k]) * D, *m1 = MO + (size_t)(ba1 + (unsigned)rp1[k]) * D;
                    const float* hrow = row < NLAT ? hlat + (size_t)row * D : hctx + (size_t)(row - NLAT) * D;
#pragma unroll
                    for (int j = 0; j < 4; ++j) { const int c = 4 * lane + 256 * j; ma[k][j] = *(const v2u*)(m0 + c); mb[k][j] = *(const v2u*)(m1 + c); hv[k][j] = *(const f32x4*)(hrow + c); } } }
#pragma unroll
                for (int k = 0; k < 3; ++k) { const int row_ = rowb + k * NGW, row = row_ < nrows2 ? row_ : nrows2 - 1; {
                    float* hrow = row < NLAT ? hlat + (size_t)row * D : hctx + (size_t)(row - NLAT) * D;
                    const int mi = row < NLAT ? (row >> 11) : 8; const float* mrow = mv + mi * 6144; const float w0 = rw0[k], w1 = rw1[k];
                    f32x4 v[4], gtv[4], g2v[4], b2v[4];
#pragma unroll
                    for (int j = 0; j < 4; ++j) { const int c = 4 * lane + 256 * j; gtv[j] = *(const f32x4*)(mrow + 5120 + c); g2v[j] = *(const f32x4*)(g2 + c); b2v[j] = *(const f32x4*)(b2 + c); }
#pragma unroll
                    for (int j = 0; j < 4; ++j) { const v2u a = ma[k][j], b = mb[k][j];
                        f32x4 mm; mm[0] = w0 * bflo(a.x) + w1 * bflo(b.x); mm[1] = w0 * bfhi(a.x) + w1 * bfhi(b.x); mm[2] = w0 * bflo(a.y) + w1 * bflo(b.y); mm[3] = w0 * bfhi(a.y) + w1 * bfhi(b.y);
                        v[j] = hv[k][j] * DN_ALPHA + gtv[j] * mm; }
                    ln_rows(v);
                    if (row_ < nrows2) {
#pragma unroll
                    for (int j = 0; j < 4; ++j) { const int c = 4 * lane + 256 * j; *(f32x4*)(hrow + c) = v[j] * g2v[j] + b2v[j]; } } } }
            }
        } }
        SEAM(pb + 13);
    }
#if TPROBE
    {
        GRID_BAR(); STAMP(NPHASES); GRID_BAR();
        unsigned* ts = (unsigned*)(args.ws + WS_CTL) + CW_TS; float T = 0.f;
        for (int l2 = 0; l2 < 2; ++l2) { const int p = (TPA) == 100 ? 0 : 1 + NPH_LAYER * l2 + (TPA);
            if ((TPA) != 100 || l2 == 0) T += (float)(__hip_atomic_load(ts + p + 1, __ATOMIC_RELAXED, __HIP_MEMORY_SCOPE_AGENT) - __hip_atomic_load(ts + p, __ATOMIC_RELAXED, __HIP_MEMORY_SCOPE_AGENT)) * 0.01f; }
        for (size_t i = (size_t)blockIdx.x * 512 + threadIdx.x; i < (size_t)NLAT * D; i += (size_t)gridDim.x * 512) { const int j = (int)(i >> 19);
            if (T >= (float)(TOFF) + 20.0f * (float)(j + 1)) args.out[i] += 0.2f; }
    }
#endif
#undef IN
#undef SEAM
}

extern "C" void kernel_launch(void* const* d_in, const int* in_sizes, int n_in, void* d_out, int out_size, void* d_ws, size_t ws_size, hipStream_t stream) {
    static int grid = 0;
    if (grid == 0) {
        if (n_in != 34 || out_size != NLAT * D || ws_size < WS_END + MiB) { fprintf(stderr, "kernel_launch: unexpected problem (n_in %d out %d ws %zu)\n", n_in, out_size, ws_size); grid = -1; return; }
        int dev = 0, cus = 0, per_cu = 0;
        if (hipGetDevice(&dev) != hipSuccess || hipDeviceGetAttribute(&cus, hipDeviceAttributeMultiprocessorCount, dev) != hipSuccess) { grid = -1; return; }
        if (hipFuncSetAttribute((const void*)fwd, hipFuncAttributeMaxDynamicSharedMemorySize, LDS_BYTES) != hipSuccess) { fprintf(stderr, "kernel_launch: hipFuncSetAttribute failed\n"); grid = -1; return; }
        if (hipOccupancyMaxActiveBlocksPerMultiprocessor(&per_cu, (const void*)fwd, NWAVES * 64, LDS_BYTES) != hipSuccess || per_cu < 1) { fprintf(stderr, "kernel_launch: occupancy query reports %d\n", per_cu); }
        (void)hipGetLastError();
        grid = cus;
    }
    if (grid < 0) return;
    if (hipMemsetAsync((char*)d_ws + WS_CTL, 0, CTL_ZERO_BYTES, stream) != hipSuccess) return;
    Args a{};
    for (int i = 0; i < 34; ++i) a.in[i] = (const float*)d_in[i];
    a.out = (float*)d_out; a.ws = (unsigned char*)d_ws;
#if MK_ONE_LAUNCH
    a.ph_lo = 0; a.ph_hi = NPHASES;
    hipLaunchKernelGGL(fwd, dim3(grid), dim3(NWAVES * 64), LDS_BYTES, stream, a);
#else
    for (int p = 0; p < NPHASES; ++p) { a.ph_lo = p; a.ph_hi = p + 1; hipLaunchKernelGGL(fwd, dim3(grid), dim3(NWAVES * 64), LDS_BYTES, stream, a); }
#endif
}
```

```cpp
#include <hip/hip_runtime.h>
#include <cstdio>
#include <cstdint>

#define GAS __attribute__((address_space(1)))
#define LAS __attribute__((address_space(3)))
typedef unsigned short bf16;
typedef unsigned v4u __attribute__((ext_vector_type(4)));
typedef unsigned v2u __attribute__((ext_vector_type(2)));
typedef float f32x4 __attribute__((ext_vector_type(4)));
typedef float f32x2 __attribute__((ext_vector_type(2)));
typedef short bf16x8 __attribute__((ext_vector_type(8)));

constexpr int D = 1024, NB = 8, SEQ = 2048, CTXL = 256, NLAT = NB * SEQ, NCTX = NB * CTXL, NTOK = NLAT + NCTX;
constexpr int OFF_Q = 0, OFF_K = 512, OFF_V = 1024, OFF_Z = 1536, OFF_A = 2048, OFF_B = 2056, OFF_CONF = 2064, OFF_FFT = 3088, OFF_SGU = 3600, OFF_GATE = 4624, N_IN = 8720;
constexpr int NWROWS = 9216;
constexpr float LN_EPS = 1e-6f;
constexpr float DN_ALPHA = 1.4142135623730951f;
constexpr int NWAVES = 8;
constexpr int NPH_LAYER = 14, NPHASES = 1 + 2 * NPH_LAYER;

#ifndef PHMASK
#define PHMASK 0xFFFFFFFFu
#endif
#define PH_ON(k) (((PHMASK) >> (k)) & 1u)
#ifndef REPMASK
#define REPMASK 0u
#endif
#define PH_REP(k) (((REPMASK) >> (k)) & 1u)
#ifndef TPA
#define TPA -1
#endif
#ifndef TPB
#define TPB -1
#endif
#ifndef TOFF
#define TOFF 0
#endif
#define TPROBE ((TPA) >= 0 || (TPB) >= 0)
#ifndef CPART
#define CPART 15
#endif
#ifndef MK_ONE_LAUNCH
#define MK_ONE_LAUNCH 1
#endif

constexpr size_t MiB = 1u << 20;
constexpr size_t WS_CTL = 0, CTL_ZERO_BYTES = 128 * 1024;
constexpr size_t WS_MODV = 1 * MiB;
constexpr size_t WS_BIN = 1 * MiB + 512 * 1024;
constexpr size_t WS_ROUTE = WS_BIN + 64 * 1024;
constexpr size_t WS_HCTX = 3 * MiB;
constexpr size_t WS_XN = 11 * MiB;
constexpr size_t WS_WIN = 47 * MiB;
constexpr size_t WS_WBR = 65 * MiB;
constexpr size_t WS_WOUT = 69 * MiB;
constexpr size_t WS_DFTL = 71 * MiB;
constexpr size_t WS_DFTC = 87 * MiB;
constexpr size_t WS_F1B = 71 * MiB;
constexpr size_t WS_R2 = 88 * MiB;
constexpr size_t WS_PQKV = WS_R2;
constexpr size_t WS_PCONF = WS_R2 + 54 * MiB;
constexpr size_t WS_PZ = WS_R2 + 72 * MiB;
constexpr size_t WS_PSGU = WS_R2 + 90 * MiB;
constexpr size_t WS_PFFT = WS_R2 + 126 * MiB;
constexpr size_t WS_PFFTC = WS_R2 + 158 * MiB;
constexpr size_t WS_AB = WS_R2 + 162 * MiB;
constexpr size_t WS_WIT = WS_R2;
constexpr size_t WS_UIT = WS_R2 + 36 * MiB;
constexpr size_t WS_AIT = WS_R2 + 90 * MiB;
constexpr size_t WS_KIT = WS_R2 + 108 * MiB;
constexpr size_t WS_SIT = WS_R2 + 126 * MiB;
constexpr size_t WS_OF = WS_R2 + 128 * MiB;
constexpr size_t WS_OB = WS_R2 + 146 * MiB;
constexpr size_t WS_G = WS_R2;
constexpr size_t WS_WGU = WS_R2;
constexpr size_t WS_WDN = WS_R2 + 32 * MiB;
constexpr size_t WS_XG = WS_R2 + 48 * MiB;
constexpr size_t WS_R3 = WS_R2 + 164 * MiB;
constexpr size_t WS_QKV = WS_R3;
constexpr size_t WS_GB = WS_R3 + 54 * MiB;
constexpr size_t WS_BR = WS_R3 + 72 * MiB;
constexpr size_t WS_F1A = WS_BR;
constexpr size_t WS_MERGED = WS_R3;
constexpr size_t WS_Y = WS_R3 + 72 * MiB;
constexpr size_t WS_HID = WS_R3;
constexpr size_t WS_MO = WS_R3 + 40 * MiB;
constexpr size_t WS_LIST = WS_R3 + 144 * MiB;
constexpr size_t WS_END = WS_LIST + 2 * MiB;
static_assert(WS_END <= 405 * MiB, "workspace map");
constexpr int CW_BAR = 4096;
constexpr int CW_MOE = 16384;

constexpr int RING_BYTES = 131072;
constexpr int LDSCTL_OFF = RING_BYTES, MISC_OFF = LDSCTL_OFF + 320;
constexpr int LDS_BYTES = 147456;

#define LDS_WAIT() asm volatile("s_waitcnt lgkmcnt(0)" ::: "memory")
#define VM_WAIT() asm volatile("s_waitcnt vmcnt(0)" ::: "memory")
typedef __bf16 bf16x2_t __attribute__((ext_vector_type(2)));
__device__ __forceinline__ unsigned pk2(float lo, float hi) { const f32x2 v = {lo, hi}; const bf16x2_t b = __builtin_convertvector(v, bf16x2_t); return __builtin_bit_cast(unsigned, b); }
__device__ __forceinline__ unsigned f2bf(float f) { return pk2(f, 0.0f) & 0xffffu; }
__device__ __forceinline__ float bflo(unsigned w) { return __builtin_bit_cast(float, w << 16); }
__device__ __forceinline__ float bfhi(unsigned w) { return __builtin_bit_cast(float, w & 0xffff0000u); }
__device__ __forceinline__ float bf1(bf16 b) { return __builtin_bit_cast(float, ((unsigned)b) << 16); }
__device__ __forceinline__ void unpack8(const v4u w, float (&o)[8]) { o[0] = bflo(w.x); o[1] = bfhi(w.x); o[2] = bflo(w.y); o[3] = bfhi(w.y); o[4] = bflo(w.z); o[5] = bfhi(w.z); o[6] = bflo(w.w); o[7] = bfhi(w.w); }
__device__ __forceinline__ v4u pack8(const float (&o)[8]) { v4u w; w.x = pk2(o[0], o[1]); w.y = pk2(o[2], o[3]); w.z = pk2(o[4], o[5]); w.w = pk2(o[6], o[7]); return w; }
__device__ __forceinline__ void fsincospi(float x, float* sn, float* cs) { *sn = __builtin_amdgcn_sinf(0.5f * x); *cs = __builtin_amdgcn_cosf(0.5f * x); }
__device__ __forceinline__ float sigmoidf_(float x) { return __builtin_amdgcn_rcpf(1.0f + __expf(-x)); }
__device__ __forceinline__ float siluf_(float x) { return x * __builtin_amdgcn_rcpf(1.0f + __expf(-x)); }
__device__ __forceinline__ float gelu_tanh(float x) { const float u = 0.7978845608028654f * (x + 0.044715f * x * x * x); return x * __builtin_amdgcn_rcpf(1.0f + __expf(-2.0f * u)); }
__device__ __forceinline__ float wave_sum(float v) {
#pragma unroll
    for (int o = 1; o < 64; o <<= 1) v += __shfl_xor(v, o);
    return v;
}
__device__ __forceinline__ float reduce16(const float (&v)[16], int lane) {
    const bool b5 = (lane & 32) != 0, b4 = (lane & 16) != 0, b3 = (lane & 8) != 0, b2 = (lane & 4) != 0;
    float a[8], b[4], c[2];
#pragma unroll
    for (int i = 0; i < 8; ++i) a[i] = (b5 ? v[i + 8] : v[i]) + __shfl_xor(b5 ? v[i] : v[i + 8], 32);
#pragma unroll
    for (int i = 0; i < 4; ++i) b[i] = (b4 ? a[i + 4] : a[i]) + __shfl_xor(b4 ? a[i] : a[i + 4], 16);
#pragma unroll
    for (int i = 0; i < 2; ++i) c[i] = (b3 ? b[i + 2] : b[i]) + __shfl_xor(b3 ? b[i] : b[i + 2], 8);
    float d = (b2 ? c[1] : c[0]) + __shfl_xor(b2 ? c[0] : c[1], 4);
    d += __shfl_xor(d, 2); d += __shfl_xor(d, 1);
    return d;
}
__device__ __forceinline__ float reduce4(const float (&v)[4], int lane) {
    const bool b5 = (lane & 32) != 0, b4 = (lane & 16) != 0; float a[2];
#pragma unroll
    for (int i = 0; i < 2; ++i) a[i] = (b5 ? v[i + 2] : v[i]) + __shfl_xor(b5 ? v[i] : v[i + 2], 32);
    float d = (b4 ? a[1] : a[0]) + __shfl_xor(b4 ? a[0] : a[1], 16);
    d += __shfl_xor(d, 8); d += __shfl_xor(d, 4); d += __shfl_xor(d, 2); d += __shfl_xor(d, 1);
    return d;
}
__device__ __forceinline__ float g16_sum(float v) {
#pragma unroll
    for (int o = 1; o < 16; o <<= 1) v += __shfl_xor(v, o);
    return v;
}

namespace pg8 {
constexpr int BM = 256, BK = 64, HALF = 128, HTB = HALF * BK * 2, STAGE_BYTES = 8 * HTB;
__host__ __device__ __forceinline__ int lds_byte(int r, int c) { const int st = (r >> 4) * 2 + (c >> 5), rr = r & 15, cc = c & 31, ob = rr * 64 + cc * 2; return st * 1024 + (ob ^ (((ob >> 9) & 1) << 5)); }
__host__ __device__ __forceinline__ void stage_rc(int b, int& R, int& C) { const int st = b / 1024, sb = b % 1024, swz = sb ^ (((sb >> 9) & 1) << 5); R = (st >> 1) * 16 + swz / 64; C = (st & 1) * 32 + (swz % 64) / 2; }
__host__ __device__ __forceinline__ int perm32(int rho) { const int n = rho >> 4, i = rho & 15; return 8 * (i >> 2) + 4 * n + (i & 3); }

struct Unit { int pm, pn, aux, ax2; const char* a; const char* b; };
struct Gemm { int K, lda, ldb; };

__device__ __forceinline__ void map_tile(int L, int nM, int nN, int& pm, int& pn) {
    const int nwg = nM * nN; int wgid = L; { const int q = nwg / 8, r = nwg % 8, xcd = wgid % 8, off = wgid / 8; wgid = (xcd < r ? xcd * (q + 1) : r * (q + 1) + (xcd - r) * q) + off; }
    const int nig = 8 * nN, gid = wgid / nig, fm = gid * 8, gsz = (nM - fm) < 8 ? (nM - fm) : 8;
    pm = fm + ((wgid % nig) % gsz); pn = (wgid % nig) / gsz;
}
__device__ __forceinline__ unsigned cvt_pk_bf16(float lo, float hi) { unsigned r; asm volatile("v_cvt_pk_bf16_f32 %0, %1, %2" : "=v"(r) : "v"(lo), "v"(hi)); return r; }

template <class Epi, class Sched, bool ALIGN_EPI, bool SP2>
__device__ __forceinline__ void gemm_phase(LAS unsigned char* lds, const Gemm g, const Sched& S, const Epi& E) {
    int tid_l = threadIdx.x; asm volatile("" : "+v"(tid_l));
    const int tid = tid_l, wid = __builtin_amdgcn_readfirstlane(tid >> 6), lane = tid & 63, wr = wid >> 2, wc = wid & 3, fr = lane & 15, fq = lane >> 4;
    const int K = g.K, nt = K / BK;
    unsigned voffA[2], voffB[2];
#pragma unroll
    for (int i = 0; i < 2; ++i) { int R, C; stage_rc(tid * 16 + i * 8192, R, C); const int Rb = Epi::PERM ? ((R & ~31) + perm32(R & 31)) : R;
        voffA[i] = (unsigned)(R * g.lda + C) * 2u; voffB[i] = (unsigned)(Rb * g.ldb + C) * 2u; }
    static_assert(!Sched::GATHER || SP2, "gathered A rows: only the SP2 loop");
    unsigned vA[2][2], vAn[2][2];
#define PG8_GCALC(dst, u_) do { _Pragma("unroll") for (int i_ = 0; i_ < 2; ++i_) { int R_, C_; stage_rc(tid * 16 + i_ * 8192, R_, C_); _Pragma("unroll") for (int h_ = 0; h_ < 2; ++h_) dst[h_][i_] = S.arow(u_, R_ + 128 * h_) + (unsigned)C_ * 2u; } } while (0)
#define PG8_STAGE_A(bufoff, base, h, nextsel) do { if constexpr (Sched::GATHER) { unsigned vs_[2]; vs_[0] = (nextsel) ? vAn[h][0] : vA[h][0]; vs_[1] = (nextsel) ? vAn[h][1] : vA[h][1]; PG8_STAGE(bufoff, base, vs_); } \
        else { PG8_STAGE(bufoff, (base) + (h) * hstepA, voffA); } } while (0)
    const size_t kstep = (size_t)(BK * 2);
    const size_t hstepA = (size_t)HALF * g.lda * 2, hstepB = (size_t)HALF * g.ldb * 2;
    const unsigned ldsw = (unsigned)wid * 1024u;
    const int aoff = lds_byte(wr * 64 + fr, fq * 8), boff = lds_byte(wc * 32 + fr, fq * 8);
#define PG8_SA(b, h) (((b) * 2 + (h)) * HTB)
#define PG8_SB(b, h) ((4 + (b) * 2 + (h)) * HTB)
#define PG8_STAGE(bufoff, gbase, voff) do { _Pragma("unroll") for (int _i = 0; _i < 2; ++_i) \
        __builtin_amdgcn_global_load_lds((const unsigned*)((const char*)(gbase) + (voff)[_i]), (LAS unsigned*)(lds + (bufoff) + ldsw + _i * 8192), 16, 0, 0); } while (0)
#define PG8_LDA(dst, b, h) do { _Pragma("unroll") for (int m = 0; m < 4; ++m) _Pragma("unroll") for (int k = 0; k < 2; ++k) dst[m][k] = *(const LAS bf16x8*)(lds + PG8_SA(b, h) + aoff + m * 2048 + k * 1024); } while (0)
#define PG8_LDB(dst, b, h) do { _Pragma("unroll") for (int n = 0; n < 2; ++n) _Pragma("unroll") for (int k = 0; k < 2; ++k) dst[n][k] = *(const LAS bf16x8*)(lds + PG8_SB(b, h) + boff + n * 2048 + k * 1024); } while (0)
#define PG8_MMA(ai, bj, At, Bt) do { __builtin_amdgcn_s_setprio(1); _Pragma("unroll") for (int m = 0; m < 4; ++m) _Pragma("unroll") for (int n = 0; n < 2; ++n) _Pragma("unroll") for (int k = 0; k < 2; ++k) \
        acc[ai][bj][m][n] = __builtin_amdgcn_mfma_f32_16x16x32_bf16(Bt[n][k], At[m][k], acc[ai][bj][m][n], 0, 0, 0); __builtin_amdgcn_s_setprio(0); } while (0)
#define PG8_WAIT_V(n) asm volatile("s_waitcnt vmcnt(" #n ")" ::: "memory")
#define PG8_WAIT_L(n) asm volatile("s_waitcnt lgkmcnt(" #n ")" ::: "memory")
#define PG8_BAR __builtin_amdgcn_s_barrier()
#define PG8_SCHED __builtin_amdgcn_sched_barrier(0)
    Unit cur, nxt; int ui = 0;
    if (!S.next(0, cur)) return;
    f32x4 acc[2][2][4][2];
#pragma unroll
    for (int a = 0; a < 2; ++a)
#pragma unroll
        for (int b = 0; b < 2; ++b)
#pragma unroll
            for (int m = 0; m < 4; ++m)
#pragma unroll
                for (int n = 0; n < 2; ++n) acc[a][b][m][n] = (f32x4){0.f, 0.f, 0.f, 0.f};
    bf16x8 At[4][2], B0[2][2], B1[2][2];
    const char* cA = cur.a; const char* cB = cur.b;
    if constexpr (SP2) {
        if constexpr (Sched::GATHER) { PG8_GCALC(vA, cur); }
        PG8_STAGE(PG8_SB(0, 0), cB, voffB); PG8_STAGE(PG8_SB(0, 1), cB + hstepB, voffB); PG8_STAGE_A(PG8_SA(0, 0), cA, 0, false); PG8_STAGE_A(PG8_SA(0, 1), cA, 1, false);
        if (wr == 1) PG8_BAR;
        PG8_WAIT_V(2); PG8_BAR;
        PG8_STAGE(PG8_SB(1, 0), cB + kstep, voffB); PG8_STAGE_A(PG8_SA(1, 0), cA + kstep, 0, false); PG8_STAGE(PG8_SB(1, 1), cB + hstepB + kstep, voffB);
        PG8_WAIT_V(6); PG8_BAR;
    } else {
        PG8_STAGE(PG8_SB(0, 0), cB, voffB); PG8_STAGE(PG8_SA(0, 0), cA, voffA); PG8_STAGE(PG8_SB(0, 1), cB + hstepB, voffB); PG8_STAGE(PG8_SA(0, 1), cA + hstepA, voffA);
        if (wr == 1) PG8_BAR;
        PG8_WAIT_V(4); PG8_BAR;
        PG8_STAGE(PG8_SB(1, 0), cB + kstep, voffB); PG8_STAGE(PG8_SA(1, 0), cA + kstep, voffA); PG8_STAGE(PG8_SB(1, 1), cB + hstepB + kstep, voffB);
        PG8_WAIT_V(6); PG8_BAR;
    }
    for (;;) {
        const bool has_next = S.next(ui + 1, nxt);
        const char* nA = has_next ? nxt.a : cA; const char* nB = has_next ? nxt.b : cB;
        if constexpr (Sched::GATHER) { if (has_next) { PG8_GCALC(vAn, nxt); } else {
#pragma unroll
            for (int h_ = 0; h_ < 2; ++h_)
#pragma unroll
                for (int i_ = 0; i_ < 2; ++i_) vAn[h_][i_] = vA[h_][i_]; } }
        for (int t = 0; t < nt; t += 2) {
            const bool last = (t == nt - 2);
            const char* a1 = cA + (size_t)(t + 1) * kstep;
            const char* a2 = last ? nA : cA + (size_t)(t + 2) * kstep; const char* b2 = last ? nB : cB + (size_t)(t + 2) * kstep;
            const char* a3 = a2 + kstep; const char* b3 = b2 + kstep;
            if constexpr (SP2) {
            PG8_LDB(B0, 0, 0); PG8_LDB(B1, 0, 1); PG8_SCHED; PG8_LDA(At, 0, 0); PG8_STAGE_A(PG8_SA(1, 1), a1, 1, false);
            PG8_WAIT_V(8); PG8_WAIT_L(0); PG8_BAR; PG8_MMA(0, 0, At, B0); PG8_MMA(0, 1, At, B1); PG8_BAR; PG8_SCHED;
            PG8_LDA(At, 0, 1); PG8_STAGE(PG8_SB(0, 0), b2, voffB); PG8_STAGE(PG8_SB(0, 1), b2 + hstepB, voffB); PG8_STAGE_A(PG8_SA(0, 0), a2, 0, last);
            PG8_WAIT_V(8); PG8_WAIT_L(0); PG8_BAR; PG8_MMA(1, 0, At, B0); PG8_MMA(1, 1, At, B1); PG8_BAR; PG8_SCHED;
            PG8_LDB(B0, 1, 0); PG8_LDB(B1, 1, 1); PG8_SCHED; PG8_LDA(At, 1, 0); PG8_STAGE_A(PG8_SA(0, 1), a2, 1, last);
            PG8_WAIT_V(8); PG8_WAIT_L(0); PG8_BAR; PG8_MMA(0, 0, At, B0); PG8_MMA(0, 1, At, B1); PG8_BAR; PG8_SCHED;
            PG8_LDA(At, 1, 1); PG8_STAGE(PG8_SB(1, 0), b3, voffB); PG8_STAGE(PG8_SB(1, 1), b3 + hstepB, voffB); PG8_STAGE_A(PG8_SA(1, 0), a3, 0, last);
            PG8_WAIT_V(8); PG8_WAIT_L(0); PG8_BAR; PG8_MMA(1, 0, At, B0); PG8_MMA(1, 1, At, B1); PG8_BAR; PG8_SCHED;
            } else {
            PG8_LDB(B0, 0, 0); PG8_SCHED; PG8_LDA(At, 0, 0); PG8_STAGE(PG8_SA(1, 1), a1 + hstepA, voffA);
            PG8_WAIT_L(8); PG8_BAR; PG8_WAIT_L(0); PG8_MMA(0, 0, At, B0); PG8_BAR; PG8_SCHED;
            PG8_LDB(B1, 0, 1); PG8_STAGE(PG8_SB(0, 0), b2, voffB);
            PG8_BAR; PG8_WAIT_L(0); PG8_MMA(0, 1, At, B1); PG8_BAR;
            PG8_LDA(At, 0, 1); PG8_STAGE(PG8_SA(0, 0), a2, voffA);
            PG8_BAR; PG8_WAIT_L(0); PG8_MMA(1, 0, At, B0); PG8_BAR; PG8_SCHED;
            PG8_STAGE(PG8_SB(0, 1), b2 + hstepB, voffB);
            PG8_WAIT_V(6); PG8_BAR; PG8_MMA(1, 1, At, B1); PG8_BAR;
            PG8_LDB(B0, 1, 0); PG8_SCHED; PG8_LDA(At, 1, 0); PG8_STAGE(PG8_SA(0, 1), a2 + hstepA, voffA);
            PG8_WAIT_L(8); PG8_BAR; PG8_WAIT_L(0); PG8_MMA(0, 0, At, B0); PG8_BAR; PG8_SCHED;
            PG8_LDB(B1, 1, 1); PG8_STAGE(PG8_SB(1, 0), b3, voffB);
            PG8_BAR; PG8_WAIT_L(0); PG8_MMA(0, 1, At, B1); PG8_BAR;
            PG8_LDA(At, 1, 1); PG8_STAGE(PG8_SA(1, 0), a3, voffA);
            PG8_BAR; PG8_WAIT_L(0); PG8_MMA(1, 0, At, B0); PG8_BAR; PG8_SCHED;
            PG8_STAGE(PG8_SB(1, 1), b3 + hstepB, voffB);
            PG8_WAIT_V(6); PG8_BAR; PG8_MMA(1, 1, At, B1); PG8_BAR;
            }
        }
        if constexpr (ALIGN_EPI) { if (wr == 0) PG8_BAR; }
        E(acc, cur, wr, wc, fr, fq);
        if (!has_next) break;
#pragma unroll
        for (int a = 0; a < 2; ++a)
#pragma unroll
            for (int b = 0; b < 2; ++b)
#pragma unroll
                for (int m = 0; m < 4; ++m)
#pragma unroll
                    for (int n = 0; n < 2; ++n) acc[a][b][m][n] = (f32x4){0.f, 0.f, 0.f, 0.f};
        cur = nxt; cA = nA; cB = nB; ++ui;
        if constexpr (Sched::GATHER) {
#pragma unroll
            for (int h_ = 0; h_ < 2; ++h_)
#pragma unroll
                for (int i_ = 0; i_ < 2; ++i_) vA[h_][i_] = vAn[h_][i_]; }
        if constexpr (ALIGN_EPI) { if (wr == 1) PG8_BAR; }
    }
    PG8_WAIT_V(0);
    if constexpr (!ALIGN_EPI) { if (wr == 0) PG8_BAR; }
    PG8_BAR;
#undef PG8_SA
#undef PG8_SB
#undef PG8_STAGE
#undef PG8_STAGE_A
#undef PG8_GCALC
#undef PG8_LDA
#undef PG8_LDB
#undef PG8_MMA
#undef PG8_WAIT_V
#undef PG8_WAIT_L
#undef PG8_BAR
#undef PG8_SCHED
}
}
using pg8::Unit;
using pg8::Gemm;
typedef f32x4 AccT[2][2][4][2];

#define XB_TMO      128
#define XB_XCNT(j)  (256  + 64 * (j))
#define XB_XSUB(j)  (1280 + 64 * (j))
#define XB_XGEN(j)  (2304 + 64 * (j))
#define XB_TOP      3328
#define XB_TOPGEN   3392
#define XCD_BAR_WORDS 3456
#define XB_SPIN_CAP (1u << 18)
__device__ __forceinline__ unsigned xb_ld(unsigned* p)              { return __hip_atomic_load(p, __ATOMIC_RELAXED, __HIP_MEMORY_SCOPE_AGENT); }
__device__ __forceinline__ unsigned xb_add(unsigned* p, unsigned v) { return __hip_atomic_fetch_add(p, v, __ATOMIC_RELAXED, __HIP_MEMORY_SCOPE_AGENT); }
__device__ __forceinline__ unsigned xb_xcc_id() { return (unsigned)__builtin_amdgcn_s_getreg((3 << 11) | 20) & 0xFu; }
#define XB_SPIN(cond, bar) do { unsigned _sp = 0; while (cond) { __builtin_amdgcn_s_sleep(1); \
    if ((++_sp & 255u) == 0u) { if (xb_ld(&(bar)[XB_TMO])) break; if (_sp > XB_SPIN_CAP) { atomicAdd(&(bar)[XB_TMO], 1u); break; } } } } while (0)
struct XcdBarrier { unsigned* bar; unsigned x; volatile LAS unsigned* st; };
__device__ __forceinline__ XcdBarrier xcd_barrier_post(unsigned* bar, volatile LAS unsigned* st) {
    XcdBarrier b; b.bar = bar; b.x = xb_xcc_id(); b.st = st;
    if (threadIdx.x == 0) (void)xb_add(&bar[XB_XCNT(b.x)], 1u);
    return b;
}
__device__ __forceinline__ void xcd_barrier_complete(unsigned* bar, unsigned x, unsigned& nloc, unsigned& nx) {
    const unsigned G = gridDim.x * gridDim.y * gridDim.z;
    unsigned sum, cnt, mine, sp = 0u;
    for (;;) {
        sum = 0u; cnt = 0u; mine = 0u;
#pragma unroll
        for (unsigned j = 0; j < 16; ++j) { const unsigned c = xb_ld(&bar[XB_XCNT(j)]); sum += c; cnt += (c > 0u) ? 1u : 0u; mine = (j == x) ? c : mine; }
        if (sum == G) break;
        __builtin_amdgcn_s_sleep(1);
        if ((++sp & 255u) == 0u) { if (xb_ld(&bar[XB_TMO])) break; if (sp > XB_SPIN_CAP) { atomicAdd(&bar[XB_TMO], 1u); break; } }
    }
    nloc = mine > 0u ? mine : 1u; nx = cnt > 0u ? cnt : 1u;
}
__device__ __forceinline__ void xcd_barrier(const XcdBarrier& b) {
    asm volatile("s_waitcnt vmcnt(0)" ::: "memory");
    __syncthreads();
    if (threadIdx.x == 0) {
        unsigned* bar = b.bar;
        __builtin_amdgcn_s_waitcnt(0);
        unsigned nloc = b.st[0], nx = b.st[1];
        if (nloc == 0u) { xcd_barrier_complete(bar, b.x, nloc, nx); b.st[0] = nloc; b.st[1] = nx; }
        const unsigned old = xb_add(&bar[XB_XSUB(b.x)], 1u);
        const unsigned gen = old / nloc;
        if (old + 1u == (gen + 1u) * nloc) {
            __builtin_amdgcn_fence(__ATOMIC_RELEASE, "agent");
            asm volatile("s_waitcnt vmcnt(0)" ::: "memory");
            const unsigned og = xb_add(&bar[XB_TOP], 1u);
            const unsigned tg = og / nx;
            if (og + 1u == (tg + 1u) * nx) xb_add(&bar[XB_TOPGEN], 1u);
            else XB_SPIN(xb_ld(&bar[XB_TOPGEN]) == tg, bar);
            __builtin_amdgcn_fence(__ATOMIC_ACQUIRE, "agent");
            xb_add(&bar[XB_XGEN(b.x)], 1u);
            asm volatile("s_waitcnt vmcnt(0)" ::: "memory");
        } else {
            XB_SPIN(xb_ld(&bar[XB_XGEN(b.x)]) == gen, bar);
            __builtin_amdgcn_fence(__ATOMIC_ACQUIRE, "agent");
            asm volatile("s_waitcnt vmcnt(0)" ::: "memory");
        }
    }
    __syncthreads();
}

struct Args { const float* in[34]; float* out; unsigned char* ws; int ph_lo, ph_hi; };
enum { I_X = 0, I_C, I_CTX, I_CCTX, I_WMOD, I_BMOD, I_WIN, I_BIN, I_GCONV, I_GALOG, I_GDT, I_GNORM, I_CDWW, I_CDWB, I_CLNG, I_CLNB, I_SLNG, I_SLNB, I_SWS, I_SBS,
       I_WBR, I_WOUT, I_BOUT, I_LN1G, I_LN1B, I_LN2G, I_LN2B, I_RGW, I_RGB, I_REW, I_REB, I_EWG, I_EWU, I_EWD };

__device__ __forceinline__ int xcd_chunk(int L, int U) { const int q = U >> 3, r = U & 7, x = L & 7, off = L >> 3; return (x < r ? x * (q + 1) : r * (q + 1) + (x - r) * q) + off; }
struct SchedInA {
    static constexpr bool GATHER = false;
    int G, c; const char* xn; const char* w;
    __device__ __forceinline__ bool next(int i, Unit& u) const {
        const int L = i * G + c; const size_t tstep = (size_t)256 * 1024 * 2;
        if (L < 1152) { int pm, pn; pg8::map_tile(L, 72, 16, pm, pn); u.pm = pm; u.pn = pn; u.aux = 0; u.a = xn + (size_t)pm * tstep; u.b = w + (size_t)pn * tstep; return true; }
        if (L < 1440) { const int q = xcd_chunk(L - 1152, 288), pm = 16 + (q & 3), pn = q >> 2;        u.pm = pm; u.pn = pn; u.aux = 1; u.a = w + (size_t)pm * tstep; u.b = xn + (size_t)pn * tstep; return true; }
        return false;
    }
};
struct SchedGrid {
    static constexpr bool GATHER = false;
    int G, c, nM, nN; const char* a0; const char* b0; size_t astep, bstep;
    __device__ __forceinline__ bool next(int i, Unit& u) const {
        const int L = i * G + c; if (L >= nM * nN) return false;
        int pm, pn; pg8::map_tile(L, nM, nN, pm, pn); u.pm = pm; u.pn = pn; u.aux = 0; u.a = a0 + (size_t)pm * astep; u.b = b0 + (size_t)pn * bstep; return true;
    }
};
struct SchedFftLat {
    static constexpr bool GATHER = false;
    int G, c; const char* dft; const char* pf;
    __device__ __forceinline__ bool next(int i, Unit& u) const {
        const int L = i * G + c; if (L >= 128) return false;
        const int b = L >> 4, kt = (L >> 1) & 7, pn = L & 1;
        u.pm = b * 8 + kt; u.pn = pn; u.aux = 0; u.a = dft + (size_t)kt * (256 * 4096 * 2); u.b = pf + (size_t)b * (512 * 4096 * 2) + (size_t)pn * (256 * 4096 * 2); return true;
    }
};
struct SchedFftCtx {
    static constexpr bool GATHER = false;
    int G, c; const char* dft; const char* pf;
    __device__ __forceinline__ bool next(int i, Unit& u) const {
        const int L = i * G + (G - 1 - c); if (L >= 16) return false;
        const int b = L >> 1, pn = L & 1;
        u.pm = 64 + b; u.pn = pn; u.aux = 0; u.a = dft; u.b = pf + (size_t)b * (512 * 512 * 2) + (size_t)pn * (256 * 512 * 2); return true;
    }
};
struct SchedBranch {
    static constexpr bool GATHER = false;
    int G, c, nM; const char* br; const char* wbr;
    __device__ __forceinline__ bool next(int j, Unit& u) const {
        const int L = j * G + c; if (L >= nM * 16) return false;
        int pm, pn; pg8::map_tile(L, nM, 16, pm, pn);
        u.pm = pm; u.pn = pn; u.aux = 0; u.a = br + (size_t)(pn >> 2) * ((size_t)NTOK * 512 * 2) + (size_t)pm * (256 * 512 * 2); u.b = wbr + (size_t)pn * (256 * 512 * 2); return true;
    }
};
struct SchedMoe {
    static constexpr bool GATHER = false;
    int G, c; unsigned pre[17]; const char* a0; const char* w0; size_t astep, wstep_e, wstep_n;
    __device__ __forceinline__ void init(const unsigned* cnt  ) {
        unsigned s = 0;
#pragma unroll
        for (int e = 0; e < 16; ++e) { pre[e] = s; s += ((unsigned)__builtin_amdgcn_readfirstlane((int)__hip_atomic_load(cnt + 64 * e, __ATOMIC_RELAXED, __HIP_MEMORY_SCOPE_AGENT)) + 255u) >> 8; }
        pre[16] = s;
    }
    __device__ __forceinline__ bool next(int i, Unit& u) const {
        const int L = i * G + c, U = (int)pre[16] * 4; if (L >= U) return false;
        const int W = xcd_chunk(L, U), jt = W >> 2, pn = W & 3; int e = 0;
#pragma unroll
        for (int k = 1; k < 16; ++k) e += ((unsigned)jt >= pre[k]) ? 1 : 0;
        u.pm = jt; u.pn = pn; u.aux = e; u.a = a0 + (size_t)jt * astep; u.b = w0 + (size_t)e * wstep_e + (size_t)pn * wstep_n; return true;
    }
};

struct SchedMoeG {
    static constexpr bool GATHER = true;
    int G, c; const LAS unsigned* pre; const char* a0; const char* w0; size_t wstep_e, wstep_n; const int* list; const unsigned* cnt;
    __device__ __forceinline__ void init(const unsigned* cnt_  , LAS unsigned* pre_) { cnt = cnt_; pre = pre_;
        if (threadIdx.x < 16) pre_[17 + threadIdx.x] = __hip_atomic_load(cnt_ + 64 * threadIdx.x, __ATOMIC_RELAXED, __HIP_MEMORY_SCOPE_AGENT);
        __syncthreads();
        if (threadIdx.x == 0) { unsigned s = 0;
            for (int e = 0; e < 16; ++e) { pre_[e] = s; s += (pre_[17 + e] + 255u) >> 8; }
            pre_[16] = s; }
        __syncthreads();
    }
    __device__ __forceinline__ bool next(int i, Unit& u) const {
        const int L = i * G + c, U = (int)pre[16] * 4; if (L >= U) return false;
        const int W = xcd_chunk(L, U), jt = W >> 2, pn = W & 3; int e = 0; unsigned pe = 0;
#pragma unroll
        for (int k = 1; k < 16; ++k) { const unsigned pk = pre[k]; const bool ge = (unsigned)jt >= pk; e += ge ? 1 : 0; pe = ge ? pk : pe; }
        e = __builtin_amdgcn_readfirstlane(e); pe = (unsigned)__builtin_amdgcn_readfirstlane((int)pe);
        u.pm = jt; u.pn = pn; u.aux = e; u.ax2 = (jt - (int)pe) * 256; u.a = a0; u.b = w0 + (size_t)e * wstep_e + (size_t)pn * wstep_n; return true;
    }
    __device__ __forceinline__ unsigned arow(const Unit& u, int r) const {
        const unsigned n = pre[17 + u.aux]; const unsigned pos = (unsigned)(u.ax2 + r);
        const int tok = pos < n ? list[(size_t)u.aux * NTOK + pos] : 0; return (unsigned)tok * 2048u;
    }
};

struct EpiInA {
    static constexpr bool PERM = true;
    bf16 *pqkv, *pz, *pconf, *psgu, *pfft, *pfftc; const float* bias;
    __device__ __forceinline__ void operator()(const AccT& acc, const Unit& u, int wr, int wc, int fr, int fq) const {
        if (u.aux == 0) {
            const int row0 = u.pm * 256 + wr * 64 + fr, cb = wc * 32 + 8 * fq, bcol0 = u.pn * 256 + cb;
            f32x4 bv[2][2];
#pragma unroll
            for (int bj = 0; bj < 2; ++bj)
#pragma unroll
                for (int n = 0; n < 2; ++n) bv[bj][n] = *(const f32x4*)(bias + bcol0 + bj * 128 + 4 * n);
            if (u.pn < 8) {
                const bool isz = u.pn >= 6;
#pragma unroll
                for (int ai = 0; ai < 2; ++ai)
#pragma unroll
                    for (int m = 0; m < 4; ++m) { const int row = row0 + ai * 128 + m * 16;
                        bf16* rowp = isz ? (pz + (size_t)row * 512 + (u.pn - 6) * 256 + cb) : (pqkv + (size_t)row * 1536 + u.pn * 256 + cb);
#pragma unroll
                        for (int bj = 0; bj < 2; ++bj) { f32x4 v0 = acc[ai][bj][m][0] + bv[bj][0], v1 = acc[ai][bj][m][1] + bv[bj][1];
                            if (isz) {
#pragma unroll
                                for (int j = 0; j < 4; ++j) { v0[j] = siluf_(v0[j]); v1[j] = siluf_(v1[j]); } }
                            v4u w; w.x = pk2(v0[0], v0[1]); w.y = pk2(v0[2], v0[3]); w.z = pk2(v1[0], v1[1]); w.w = pk2(v1[2], v1[3]);
                            *(v4u*)(rowp + bj * 128) = w; } }
            } else if (u.pn < 12) {
#pragma unroll
                for (int ai = 0; ai < 2; ++ai)
#pragma unroll
                    for (int m = 0; m < 4; ++m) { const int row = row0 + ai * 128 + m * 16;
                        const f32x4 a0 = acc[ai][0][m][0] + bv[0][0], a1 = acc[ai][0][m][1] + bv[0][1], g0 = acc[ai][1][m][0] + bv[1][0], g1 = acc[ai][1][m][1] + bv[1][1];
                        float o[8];
#pragma unroll
                        for (int j = 0; j < 4; ++j) { o[j] = a0[j] * sigmoidf_(g0[j]); o[4 + j] = a1[j] * sigmoidf_(g1[j]); }
                        *(v4u*)(pconf + (size_t)row * 512 + (u.pn - 8) * 128 + cb) = pack8(o); }
            } else {
#pragma unroll
                for (int ai = 0; ai < 2; ++ai)
#pragma unroll
                    for (int m = 0; m < 4; ++m) { const int row = row0 + ai * 128 + m * 16;
                        bf16* rowp = psgu + (size_t)row * 1024 + (u.pn - 12) * 256 + cb;
#pragma unroll
                        for (int bj = 0; bj < 2; ++bj) { f32x4 v0 = acc[ai][bj][m][0] + bv[bj][0], v1 = acc[ai][bj][m][1] + bv[bj][1];
#pragma unroll
                            for (int j = 0; j < 4; ++j) { v0[j] = gelu_tanh(v0[j]); v1[j] = gelu_tanh(v1[j]); }
                            v4u w; w.x = pk2(v0[0], v0[1]); w.y = pk2(v0[2], v0[3]); w.z = pk2(v1[0], v1[1]); w.w = pk2(v1[2], v1[3]);
                            *(v4u*)(rowp + bj * 128) = w; } }
            }
        } else {
            const int jrow0 = (u.pm - 16) * 256 + wr * 64 + fr, tok0 = u.pn * 256 + wc * 32 + 8 * fq;
#pragma unroll
            for (int ai = 0; ai < 2; ++ai)
#pragma unroll
                for (int m = 0; m < 4; ++m) { const int jrow = jrow0 + ai * 128 + m * 16; const float bb = bias[4096 + jrow]; const int cs = jrow >> 9, rr = jrow & 511;
#pragma unroll
                    for (int bj = 0; bj < 2; ++bj) { const int tok = tok0 + bj * 128; bf16* dst;
                        if (tok < NLAT) { const int b = tok >> 11, t = tok & 2047; dst = pfft + ((size_t)(b * 512 + rr)) * 4096 + cs * 2048 + t; }
                        else { const int tc = tok - NLAT, b = tc >> 8, t = tc & 255; dst = pfftc + ((size_t)(b * 512 + rr)) * 512 + cs * 256 + t; }
                        const f32x4 v0 = acc[ai][bj][m][0] + bb, v1 = acc[ai][bj][m][1] + bb;
                        v4u w; w.x = pk2(v0[0], v0[1]); w.y = pk2(v0[2], v0[3]); w.z = pk2(v1[0], v1[1]); w.w = pk2(v1[2], v1[3]);
                        *(v4u*)dst = w; } }
        }
    }
};
template <int ACT  > struct EpiBf16 {
    static constexpr bool PERM = true;
    bf16* O; int ldc; const float* bias;
    __device__ __forceinline__ void operator()(const AccT& acc, const Unit& u, int wr, int wc, int fr, int fq) const {
        const int row0 = u.pm * 256 + wr * 64 + fr, col0 = u.pn * 256 + wc * 32 + 8 * fq;
        f32x4 bv[2][2];
#pragma unroll
        for (int bj = 0; bj < 2; ++bj)
#pragma unroll
            for (int n = 0; n < 2; ++n) bv[bj][n] = bias ? *(const f32x4*)(bias + col0 + bj * 128 + 4 * n) : (f32x4){0.f, 0.f, 0.f, 0.f};
#pragma unroll
        for (int ai = 0; ai < 2; ++ai)
#pragma unroll
            for (int m = 0; m < 4; ++m) { bf16* rowp = O + (size_t)(row0 + ai * 128 + m * 16) * ldc + col0;
#pragma unroll
                for (int bj = 0; bj < 2; ++bj) { f32x4 v0 = acc[ai][bj][m][0] + bv[bj][0], v1 = acc[ai][bj][m][1] + bv[bj][1];
                    if (ACT == 1) {
#pragma unroll
                        for (int j = 0; j < 4; ++j) { v0[j] = sigmoidf_(v0[j]); v1[j] = sigmoidf_(v1[j]); } }
                    v4u w; w.x = pk2(v0[0], v0[1]); w.y = pk2(v0[2], v0[3]); w.z = pk2(v1[0], v1[1]); w.w = pk2(v1[2], v1[3]);
                    *(v4u*)(rowp + bj * 128) = w; } }
    }
};
struct EpiF32 {
    static constexpr bool PERM = false;
    float* C; int ldc; const float* bias;
    __device__ __forceinline__ void operator()(const AccT& acc, const Unit& u, int wr, int wc, int fr, int fq) const {
        const int row0 = u.pm * 256 + wr * 64 + fr, col0 = u.pn * 256 + wc * 32 + 4 * fq;
        f32x4 bv[2][2];
#pragma unroll
        for (int bj = 0; bj < 2; ++bj)
#pragma unroll
            for (int n = 0; n < 2; ++n) bv[bj][n] = *(const f32x4*)(bias + col0 + bj * 128 + n * 16);
#pragma unroll
        for (int ai = 0; ai < 2; ++ai)
#pragma unroll
            for (int m = 0; m < 4; ++m) { float* rowp = C + (size_t)(row0 + ai * 128 + m * 16) * ldc + col0;
#pragma unroll
                for (int bj = 0; bj < 2; ++bj)
#pragma unroll
                    for (int n = 0; n < 2; ++n) *(f32x4*)(rowp + bj * 128 + n * 16) = acc[ai][bj][m][n] + bv[bj][n]; }
    }
};
struct EpiGateMerge {
    static constexpr bool PERM = true;
    const bf16* P; bf16* mbf; const float* bias;
    __device__ __forceinline__ void operator()(const AccT& acc, const Unit& u, int wr, int wc, int fr, int fq) const {
        const int row0 = u.pm * 256 + wr * 64 + fr, cb = wc * 32 + 8 * fq, d0 = u.pn * 64 + wc * 16 + 4 * fq;
        f32x4 bv[2][2];
#pragma unroll
        for (int bj = 0; bj < 2; ++bj)
#pragma unroll
            for (int n = 0; n < 2; ++n) bv[bj][n] = *(const f32x4*)(bias + u.pn * 256 + cb + bj * 128 + 4 * n);
#pragma unroll
        for (int ai = 0; ai < 2; ++ai)
#pragma unroll
            for (int m = 0; m < 4; ++m) { const size_t row = (size_t)(row0 + ai * 128 + m * 16); const bf16* pr = P + row * 4096 + d0;
                f32x4 o = (f32x4){0.f, 0.f, 0.f, 0.f};
#pragma unroll
                for (int bj = 0; bj < 2; ++bj)
#pragma unroll
                    for (int n = 0; n < 2; ++n) { const v2u pw = *(const v2u*)(pr + (2 * bj + n) * 1024); const f32x4 g = acc[ai][bj][m][n] + bv[bj][n];
                        o[0] += sigmoidf_(g[0]) * bflo(pw.x); o[1] += sigmoidf_(g[1]) * bfhi(pw.x); o[2] += sigmoidf_(g[2]) * bflo(pw.y); o[3] += sigmoidf_(g[3]) * bfhi(pw.y); }
                v2u w; w.x = pk2(o[0], o[1]); w.y = pk2(o[2], o[3]); *(v2u*)(mbf + row * 1024 + d0) = w; }
    }
};
struct EpiMoe1 {
    static constexpr bool PERM = true;
    bf16* hid;
    __device__ __forceinline__ void operator()(const AccT& acc, const Unit& u, int wr, int wc, int fr, int fq) const {
        const int row0 = u.pm * 256 + wr * 64 + fr, cb = wc * 32 + 8 * fq;
#pragma unroll
        for (int ai = 0; ai < 2; ++ai)
#pragma unroll
            for (int m = 0; m < 4; ++m) { const int row = row0 + ai * 128 + m * 16;
                const f32x4 g0 = acc[ai][0][m][0], g1 = acc[ai][0][m][1], u0 = acc[ai][1][m][0], u1 = acc[ai][1][m][1];
                float o[8];
#pragma unroll
                for (int j = 0; j < 4; ++j) { o[j] = siluf_(g0[j]) * u0[j]; o[4 + j] = siluf_(g1[j]) * u1[j]; }
                *(v4u*)(hid + (size_t)row * 512 + u.pn * 128 + cb) = pack8(o); }
    }
};

struct Ctx {
    LAS unsigned char* lds; int tid, lane, wave, G, bid;
};

__device__ __forceinline__ int gate_srccol(int r) { const int q = r - 5120, t = q >> 8, c = q & 255, bj = c >> 7, wc = (c >> 5) & 3, fq = (c >> 3) & 3, n = (c >> 2) & 1, j = c & 3;
    return OFF_GATE + (2 * bj + n) * 1024 + 64 * t + 16 * wc + 4 * fq + j; }
__device__ __forceinline__ void cvt_tile(const Ctx& X, const float* src, int ld, int k0, bf16* dst, int Kp) {
    LAS float* tile = (LAS float*)X.lds;
#pragma unroll
    for (int i = 0; i < 8; ++i) { const int kk = (X.tid >> 6) + 8 * i, nn = X.tid & 63; tile[kk * 65 + nn] = src[(size_t)(k0 + kk) * ld + nn]; }
    __syncthreads();
    { const int n = X.tid >> 3, kc = X.tid & 7; float o[8];
#pragma unroll
      for (int j = 0; j < 8; ++j) o[j] = tile[(8 * kc + j) * 65 + n];
      *(v4u*)(dst + (size_t)n * Kp + k0 + 8 * kc) = pack8(o); }
    __syncthreads();
}

__device__ __forceinline__ void cvt_item(const float* src, int ld, int srccol, int k0, bf16* dst, int Kp, LAS float* scr, int lane) {
    float tv[32];
#pragma unroll
    for (int i = 0; i < 32; ++i) { const int kk = 2 * i + (lane >> 5); tv[i] = src[(size_t)(k0 + kk) * ld + srccol]; }
#pragma unroll
    for (int i = 0; i < 32; ++i) { const int kk = 2 * i + (lane >> 5); scr[kk * 33 + (lane & 31)] = tv[i]; }
    LDS_WAIT(); asm volatile("" ::: "memory");
    const int c = lane & 7;
#pragma unroll
    for (int j = 0; j < 4; ++j) { const int n = (lane >> 3) + 8 * j; const LAS float* sp = scr + (8 * c) * 33 + n; float o[8];
#pragma unroll
        for (int e = 0; e < 8; ++e) o[e] = sp[e * 33];
        *(v4u*)(dst + (size_t)n * Kp + k0 + 8 * c) = pack8(o); }
    LDS_WAIT(); asm volatile("" ::: "memory");
}

__device__ __forceinline__ void cvt_item4(const float* src, int ld, int col4, int k0, bf16* dst, int Kp, LAS float* scr, int lane) {
    f32x4 v[8]; const int kq = lane >> 3, n4 = 4 * (lane & 7);
#pragma unroll
    for (int i = 0; i < 8; ++i) v[i] = *(const f32x4*)(src + (size_t)(k0 + kq + 8 * i) * ld + col4);
#pragma unroll
    for (int i = 0; i < 8; ++i) { LAS float* p = scr + (kq + 8 * i) * 33 + n4; p[0] = v[i][0]; p[1] = v[i][1]; p[2] = v[i][2]; p[3] = v[i][3]; }
    LDS_WAIT(); asm volatile("" ::: "memory");
    const int c = lane & 7;
#pragma unroll
    for (int j = 0; j < 4; ++j) { const int n = (lane >> 3) + 8 * j; const LAS float* sp = scr + (8 * c) * 33 + n; float o[8];
#pragma unroll
        for (int e = 0; e < 8; ++e) o[e] = sp[e * 33];
        *(v4u*)(dst + (size_t)n * Kp + k0 + 8 * c) = pack8(o); }
    LDS_WAIT(); asm volatile("" ::: "memory");
}

__device__ __forceinline__ void ln_rows(f32x4 (&v)[4]) {
    float s = 0.f;
#pragma unroll
    for (int j = 0; j < 4; ++j) s += (v[j][0] + v[j][1]) + (v[j][2] + v[j][3]);
    const float mean = wave_sum(s) * (1.f / D); float s2 = 0.f;
#pragma unroll
    for (int j = 0; j < 4; ++j) { v[j] = v[j] - mean; s2 += (v[j][0] * v[j][0] + v[j][1] * v[j][1]) + (v[j][2] * v[j][2] + v[j][3] * v[j][3]); }
    const float rstd = __builtin_amdgcn_rsqf(wave_sum(s2) * (1.f / D) + LN_EPS);
#pragma unroll
    for (int j = 0; j < 4; ++j) v[j] = v[j] * rstd;
}

#define PH_BEGIN() \
    int tid_l = threadIdx.x; asm volatile("" : "+v"(tid_l)); const int tid = tid_l, lane = tid & 63; \
    Ctx X; X.lds = lds; X.tid = tid; X.lane = lane; X.wave = __builtin_amdgcn_readfirstlane(tid >> 6); X.G = gridDim.x; X.bid = blockIdx.x; \
    const int gw = X.bid * NWAVES + X.wave, NGW = X.G * NWAVES; (void)gw; (void)NGW; \
    const __attribute__((address_space(4))) char* kp = (const __attribute__((address_space(4))) char*)__builtin_amdgcn_kernarg_segment_ptr(); asm volatile("" : "+s"(kp)); \
    unsigned char* const ws = *(unsigned char* const __attribute__((address_space(4)))*)(kp + 280); \
    float* const hlat = *(float* const __attribute__((address_space(4)))*)(kp + 272); (void)hlat; \
    float* const hctx = (float*)(ws + WS_HCTX); (void)hctx; \
    float* const modv = (float*)(ws + WS_MODV); (void)modv; \
    float* const binv = (float*)(ws + WS_BIN); (void)binv; \
    bf16* const XN = (bf16*)(ws + WS_XN); (void)XN; \
    bf16* const WIN = (bf16*)(ws + WS_WIN); (void)WIN; \
    bf16* const WBR = (bf16*)(ws + WS_WBR); (void)WBR; \
    bf16* const WOUT = (bf16*)(ws + WS_WOUT); (void)WOUT; \
    bf16* const F1A = (bf16*)(ws + WS_F1A); (void)F1A; bf16* const F1B = (bf16*)(ws + WS_F1B); (void)F1B; \
    bf16* const DFTC = (bf16*)(ws + WS_DFTC); (void)DFTC; \
    bf16* const PQKV = (bf16*)(ws + WS_PQKV); (void)PQKV; \
    bf16* const PCONF = (bf16*)(ws + WS_PCONF); (void)PCONF; \
    bf16* const PZ = (bf16*)(ws + WS_PZ); (void)PZ; \
    bf16* const PSGU = (bf16*)(ws + WS_PSGU); (void)PSGU; \
    bf16* const PFFT = (bf16*)(ws + WS_PFFT); (void)PFFT; \
    bf16* const PFFTC = (bf16*)(ws + WS_PFFTC); (void)PFFTC; \
    float* const AB = (float*)(ws + WS_AB); (void)AB; \
    bf16* const OF = (bf16*)(ws + WS_OF); (void)OF; \
    bf16* const OB = (bf16*)(ws + WS_OB); (void)OB; \
    bf16* const WIT = (bf16*)(ws + WS_WIT); (void)WIT; \
    bf16* const UIT = (bf16*)(ws + WS_UIT); (void)UIT; \
    bf16* const AIT = (bf16*)(ws + WS_AIT); (void)AIT; \
    bf16* const KIT = (bf16*)(ws + WS_KIT); (void)KIT; \
    float* const SIT = (float*)(ws + WS_SIT); (void)SIT; \
    bf16* const GT = (bf16*)(ws + WS_G); (void)GT; \
    bf16* const WGU = (bf16*)(ws + WS_WGU); (void)WGU; \
    bf16* const WDN = (bf16*)(ws + WS_WDN); (void)WDN; \
    bf16* const XG = (bf16*)(ws + WS_XG); (void)XG; \
    bf16* const QKV = (bf16*)(ws + WS_QKV); (void)QKV; \
    float* const GB = (float*)(ws + WS_GB); (void)GB; \
    bf16* const BR = (bf16*)(ws + WS_BR); (void)BR; \
    float* const MERGED = (float*)(ws + WS_MERGED); (void)MERGED; \
    float* const YB = (float*)(ws + WS_Y); (void)YB; \
    bf16* const HID = (bf16*)(ws + WS_HID); (void)HID; \
    bf16* const MO = (bf16*)(ws + WS_MO); (void)MO; \
    float* const ROUTE = (float*)(ws + WS_ROUTE); (void)ROUTE; int* const ELIST = (int*)(ws + WS_LIST); (void)ELIST; \
    unsigned* const ctl = (unsigned*)(ws + WS_CTL); (void)ctl;
#define INP(i) (*(const float* const __attribute__((address_space(4)))*)(kp + 8 * (i)))
__global__ void __launch_bounds__(NWAVES * 64, 2) fwd(Args args) {
    extern __shared__ __attribute__((aligned(16))) unsigned char lds_raw[];
    LAS unsigned char* const lds = (LAS unsigned char*)lds_raw;
    volatile LAS unsigned* MISC = (volatile LAS unsigned*)(lds + MISC_OFF);
    for (int u = threadIdx.x; u < (LDS_BYTES - LDSCTL_OFF) / 4; u += NWAVES * 64) ((LAS unsigned*)(lds + LDSCTL_OFF))[u] = 0u;
    __syncthreads();
#if MK_ONE_LAUNCH
    XcdBarrier bar = xcd_barrier_post((unsigned*)(args.ws + WS_CTL) + CW_BAR, MISC + 8);
#define GRID_BAR() xcd_barrier(bar)
#else
#define GRID_BAR() do { } while (0)
#endif
    const int lo = args.ph_lo, hi = args.ph_hi;
#define IN(k) (lo <= (k) && (k) < hi)
#define CW_TS 20000
#if TPROBE
#define STAMP(k) do { if (blockIdx.x == 0 && threadIdx.x == 0) __hip_atomic_store((unsigned*)(args.ws + WS_CTL) + CW_TS + (k), (unsigned)__builtin_amdgcn_s_memrealtime(), __ATOMIC_RELAXED, __HIP_MEMORY_SCOPE_AGENT); } while (0)
#else
#define STAMP(k) do { } while (0)
#endif
#define SEAM(k) do { if (IN(k) && IN((k) + 1)) GRID_BAR(); STAMP((k) + 1); } while (0)
    STAMP(0);

    for (int rep0_ = 0; rep0_ <= (int)PH_REP(0); ++rep0_) { if (rep0_) GRID_BAR();
    if (PH_ON(0) && IN(0)) { PH_BEGIN();
        for (int idx = X.bid * 512 + tid; idx < 256 * 512 / 8; idx += X.G * 512) {
            const int k = idx >> 6, j0 = (idx & 63) * 8; float o[8];
#pragma unroll
            for (int e = 0; e < 8; ++e) { const int j = j0 + e, t = j & 255, a = (k * t) & 255; float s, c; fsincospi((float)a * (1.0f / 128.0f), &s, &c);
                o[e] = (j < 256 ? c : -s) * 0.0625f; }
            *(v4u*)(DFTC + (size_t)k * 512 + j0) = pack8(o);
        }
        {
            LAS float* sc = (LAS float*)lds;
            LAS float* red = (LAS float*)(lds + 36864);
            { float cv[18];
#pragma unroll
              for (int j = 0; j < 18; ++j) { const int r = j >> 1, k = tid + 512 * (j & 1); cv[j] = r < 8 ? INP(I_C)[r * 1024 + k] : INP(I_CCTX)[k]; }
#pragma unroll
              for (int j = 0; j < 18; ++j) sc[tid + 512 * j] = siluf_(cv[j]); }
            __syncthreads();
            for (int it = X.bid; it < 192; it += X.G) {
                const int l = it / 96, j = (it % 96) * 64 + lane; const float* W = INP(I_WMOD) + (size_t)l * 1024 * 6144 + j;
                float a[9];
#pragma unroll
                for (int r = 0; r < 9; ++r) a[r] = 0.f;
                const int kb = X.wave * 128;
                float wv[2][32];
#pragma unroll
                for (int i = 0; i < 32; ++i) wv[0][i] = W[(size_t)(kb + i) * 6144];
#pragma unroll
                for (int b = 0; b < 4; ++b) {
                    if (b < 3) {
#pragma unroll
                        for (int i = 0; i < 32; ++i) wv[(b + 1) & 1][i] = W[(size_t)(kb + 32 * (b + 1) + i) * 6144]; }
#pragma unroll
                    for (int i = 0; i < 32; i += 4) {
#pragma unroll
                        for (int r = 0; r < 9; ++r) { const f32x4 sv = *(const LAS f32x4*)(sc + r * 1024 + kb + 32 * b + i);
                            a[r] += (sv[0] * wv[b & 1][i] + sv[1] * wv[b & 1][i + 1]) + (sv[2] * wv[b & 1][i + 2] + sv[3] * wv[b & 1][i + 3]); } }
                }
#pragma unroll
                for (int r = 0; r < 9; ++r) red[(X.wave * 9 + r) * 64 + lane] = a[r];
                __syncthreads();
                for (int o = tid; o < 9 * 64; o += 512) { const int r = o >> 6, jj = o & 63; float s = 0.f;
#pragma unroll
                    for (int w = 0; w < 8; ++w) s += red[(w * 9 + r) * 64 + jj];
                    const int jc = (it % 96) * 64 + jj; modv[((size_t)l * 9 + r) * 6144 + jc] = s + INP(I_BMOD)[l * 6144 + jc]; }
                __syncthreads();
            }
        }
    } }
    SEAM(0);

    for (int l = 0; l < 2; ++l) {
        const int pb = 1 + NPH_LAYER * l;
        const int nrows2 = (l == 1) ? NLAT : NTOK;
        const int npan2 = nrows2 / 256;

        for (int rep_ = 0; rep_ <= (int)PH_REP(1); ++rep_) { if (rep_) GRID_BAR();
        if (PH_ON(1) && IN(pb + 0)) { PH_BEGIN(); const float* mv = modv + (size_t)l * 9 * 6144; (void)mv; unsigned* const moecnt = ctl + CW_MOE + l * 16 * 64; (void)moecnt;
            const float* win = INP(I_WIN) + (size_t)l * 1024 * N_IN;
            const float* bin = INP(I_BIN) + (size_t)l * N_IN;
#define FOLD_LOAD(it_) do { const int kb_ = (it_) >> 2, g_ = (it_) & 3; _Pragma("unroll") for (int j = 0; j < 4; ++j) { const int i = tid + 512 * j, kk = i >> 7, c = i & 127; wpre[j] = win[(size_t)(kb_ * 16 + kk) * N_IN + OFF_FFT + g_ * 128 + c]; } } while (0)
            float wpre[4]; FOLD_LOAD(X.bid < 256 ? X.bid : 255);
            LAS float* const wscr = (LAS float*)(lds + X.wave * 8448);
            for (int it = gw; it < 4096 + 1024 + 512 + 144; it += NGW) {
                if (it >= 5632) { const int r = (it - 5632) * 64 + lane;
                    if (r < 4096 || r >= 5120) { float v;
                        if (r < 2048) v = bin[r];
                        else if (r < 3072) { const int q = r - 2048, j = q >> 8, w = q & 255; v = bin[OFF_CONF + (w >= 128 ? 512 : 0) + 128 * j + (w & 127)]; }
                        else if (r < 4096) v = bin[OFF_SGU + (r - 3072)];
                        else v = bin[gate_srccol(r)];
                        binv[r] = v; }
                    continue; }
                const float* src; int ld, col, k0, Kp; bf16* dst; const int n4 = lane & 31;
                if (it < 4096) { const int rb_ = (it & 3) + 4 * ((it >> 3) & 63), rb = rb_ < 128 ? rb_ : rb_ + 32, row0 = rb * 32;
                    if (row0 < 2048) col = row0 + n4;
                    else if (row0 < 3072) { const int q = row0 - 2048, j = q >> 8, w = q & 255; col = OFF_CONF + (w >= 128 ? 512 : 0) + 128 * j + (w & 127) + n4; }
                    else if (row0 < 4096) col = OFF_SGU + (row0 - 3072) + n4;
                    else col = gate_srccol(row0 + n4);
                    src = win; ld = N_IN; k0 = (((it >> 2) & 1) + 2 * (it >> 9)) * 64; dst = WIN + (size_t)row0 * 1024; Kp = 1024; }
                else if (it < 5120) { const int q = it - 4096, i = q >> 8, nb = (q & 3) + 4 * ((q >> 3) & 7);
                    src = INP(I_WBR) + ((size_t)(l * 4 + i) * 512) * 1024; ld = 1024; col = nb * 32 + n4; k0 = (((q >> 2) & 1) + 2 * ((q >> 6) & 3)) * 64; dst = WBR + ((size_t)i * 1024 + nb * 32) * 512; Kp = 512; }
                else { const int q = it - 5120, nb = (q & 3) + 4 * ((q >> 3) & 7);
                    src = INP(I_WOUT) + (size_t)l * 1024 * 1024; ld = 1024; col = nb * 32 + n4; k0 = (((q >> 2) & 1) + 2 * (q >> 6)) * 64; dst = WOUT + (size_t)nb * 32 * 1024; Kp = 1024; }
                cvt_item(src, ld, col, k0, dst, Kp, wscr, lane);
            }
            LAS float* wab = (LAS float*)lds;
            f32x4 wq[8]; bool wq_have = false;
#pragma unroll
            for (int j = 0; j < 8; ++j) wq[j] = (f32x4){0.f, 0.f, 0.f, 0.f};
#define WAB_LOAD() do { _Pragma("unroll") for (int j = 0; j < 8; ++j) wq[j] = *(const f32x4*)(win + (size_t)(tid + 512 * (j & 1)) * N_IN + OFF_A + 4 * (j >> 1)); } while (0)
            for (int it = X.bid; it < 256; it += X.G) {
                const int kb = it >> 2, g = it & 3; LAS float* Wt = (LAS float*)(lds + 69632); LAS f32x2* cst = (LAS f32x2*)(lds + 69632 + 10240); LAS float* bl = (LAS float*)(cst + 128);
                if (it != X.bid) FOLD_LOAD(it);
#pragma unroll
                for (int j = 0; j < 4; ++j) { const int i = tid + 512 * j, kk = i >> 7, c = i & 127; Wt[c * 20 + kk] = wpre[j]; }
                if (tid < 128) { float sn, cn; fsincospi((float)tid * (1.0f / 64.0f), &sn, &cn); cst[tid] = (f32x2){cn * 0.08838834764831845f, sn * 0.08838834764831845f}; }
                else if (tid < 256 && kb == 0) bl[tid - 128] = bin[OFF_FFT + g * 128 + (tid - 128)];
                __syncthreads();
                if (!wq_have) { WAB_LOAD(); wq_have = true; }
                const int m = tid & 127, ks = tid >> 7; f32x2 acc[4];
#pragma unroll
                for (int kk = 0; kk < 4; ++kk) acc[kk] = (f32x2){0.f, 0.f};
                { int a = 0;
#pragma unroll 8
                for (int c = 0; c < 128; ++c) { const f32x2 t = cst[a]; const f32x4 w = *(const LAS f32x4*)(Wt + c * 20 + ks * 4);
#pragma unroll
                    for (int kk = 0; kk < 4; ++kk) acc[kk] += t * w[kk];
                    a = (a + m) & 127; } }
                bf16* dc = WIN + (size_t)(4096 + g * 128 + m) * 1024 + kb * 16 + ks * 4; bf16* dsn = dc + (size_t)512 * 1024;
                { v2u o; o.x = pk2(acc[0][0], acc[1][0]); o.y = pk2(acc[2][0], acc[3][0]); *(v2u*)dc = o; o.x = pk2(acc[0][1], acc[1][1]); o.y = pk2(acc[2][1], acc[3][1]); *(v2u*)dsn = o; }
                if (kb == 0 && tid < 256) {
                    const int cs = tid >> 7; float sb = 0.f; int a = 0;
#pragma unroll 8
                    for (int c = 0; c < 128; ++c) { const f32x2 t = cst[a]; sb += bl[c] * (cs ? t[1] : t[0]); a = (a + m) & 127; }
                    binv[4096 + cs * 512 + g * 128 + m] = sb; }
                if (it + X.G < 256) __syncthreads();
            }
            if (!wq_have) { __syncthreads(); WAB_LOAD(); }
#pragma unroll
            for (int j = 0; j < 8; ++j) { LAS float* p = wab + (4 * (j >> 1)) * 1024 + tid + 512 * (j & 1); p[0] = wq[j][0]; p[1024] = wq[j][1]; p[2048] = wq[j][2]; p[3072] = wq[j][3]; }
            __syncthreads();
#undef FOLD_LOAD
#undef WAB_LOAD
            f32x4 pe[4]; int pe_t = -1; const float binA = bin[OFF_A + (lane >> 2)];
#pragma unroll
            for (int j = 0; j < 4; ++j) pe[j] = (f32x4){0.f, 0.f, 0.f, 0.f};
            unsigned pre0[16]; { unsigned s_ = 0; const unsigned cm_ = (l == 1) ? __hip_atomic_load(ctl + CW_MOE + 64 * (lane & 15), __ATOMIC_RELAXED, __HIP_MEMORY_SCOPE_AGENT) : 0u;
#pragma unroll
                for (int e = 0; e < 16; ++e) { pre0[e] = s_; s_ += (((unsigned)__builtin_amdgcn_readlane((int)cm_, e) + 255u) >> 8) << 8; } }
#define M_ROUTE(row_, R_) do { const float* rt_ = ROUTE + (size_t)(row_) * 8; _Pragma("unroll") for (int i_ = 0; i_ < 6; ++i_) R_[i_] = rt_[i_]; } while (0)
#define M_LOAD(row_, R_, MA_, MB_, HV_, GT_) do { const int r_ = (row_); const int e0_ = __builtin_bit_cast(int, R_[0]), e1_ = __builtin_bit_cast(int, R_[1]), p0_ = __builtin_bit_cast(int, R_[4]), p1_ = __builtin_bit_cast(int, R_[5]); \
                unsigned ba0_ = 0, ba1_ = 0; _Pragma("unroll") for (int q_ = 0; q_ < 16; ++q_) { ba0_ = (q_ == e0_) ? pre0[q_] : ba0_; ba1_ = (q_ == e1_) ? pre0[q_] : ba1_; } \
                const bf16* m0_ = MO + (size_t)(ba0_ + (unsigned)p0_) * D, *m1_ = MO + (size_t)(ba1_ + (unsigned)p1_) * D; \
                const float* hr_ = r_ < NLAT ? hlat + (size_t)r_ * D : hctx + (size_t)(r_ - NLAT) * D; const int mi_ = r_ < NLAT ? (r_ >> 11) : 8; const float* gp_ = modv + (size_t)mi_ * 6144 + 5120; \
                _Pragma("unroll") for (int j = 0; j < 4; ++j) { const int c = 4 * lane + 256 * j; MA_[j] = *(const v2u*)(m0_ + c); MB_[j] = *(const v2u*)(m1_ + c); HV_[j] = *(const f32x4*)(hr_ + c); GT_[j] = *(const f32x4*)(gp_ + c); } } while (0)
#define M_FINISH(row_, live_, R_, MA_, MB_, HV_, GT_, V_) do { const int r_ = (row_); const float w0_ = R_[2], w1_ = R_[3]; float* hr_ = r_ < NLAT ? hlat + (size_t)r_ * D : hctx + (size_t)(r_ - NLAT) * D; \
                _Pragma("unroll") for (int j = 0; j < 4; ++j) { const v2u a = MA_[j], b = MB_[j]; \
                    f32x4 mm; mm[0] = w0_ * bflo(a.x) + w1_ * bflo(b.x); mm[1] = w0_ * bfhi(a.x) + w1_ * bfhi(b.x); mm[2] = w0_ * bflo(a.y) + w1_ * bflo(b.y); mm[3] = w0_ * bfhi(a.y) + w1_ * bfhi(b.y); \
                    V_[j] = HV_[j] * DN_ALPHA + GT_[j] * mm; } \
                ln_rows(V_); \
                _Pragma("unroll") for (int j = 0; j < 4; ++j) { V_[j] = V_[j] * g2v0[j] + b2v0[j]; if (live_) *(f32x4*)(hr_ + 4 * lane + 256 * j) = V_[j]; } } while (0)
            f32x4 g2v0[4], b2v0[4];
#pragma unroll
            for (int j = 0; j < 4; ++j) { g2v0[j] = *(const f32x4*)(INP(I_LN2G) + 4 * lane + 256 * j); b2v0[j] = *(const f32x4*)(INP(I_LN2B) + 4 * lane + 256 * j); }
            for (int rowb = gw; rowb < NTOK; rowb += 2 * NGW) {
                f32x4 va[4], vb2[4], scvB[4], shvB[4];
                float rtA[6], rtB[6]; v2u maA[4], mbA[4]; f32x4 hvA[4], gtA[4];
                const int rowA_ = rowb, rowB_ = rowb + NGW < NTOK ? rowb + NGW : NTOK - 1;
                if (l == 1) {
                    M_ROUTE(rowA_, rtA); M_ROUTE(rowB_, rtB);
                    M_LOAD(rowA_, rtA, maA, mbA, hvA, gtA); }
                else {
#pragma unroll
                    for (int i = 0; i < 6; ++i) { rtA[i] = 0.f; rtB[i] = 0.f; }
#pragma unroll
                    for (int j = 0; j < 4; ++j) { maA[j] = (v2u){0u, 0u}; mbA[j] = maA[j]; hvA[j] = (f32x4){0.f, 0.f, 0.f, 0.f}; gtA[j] = hvA[j]; } }
                {
                    const int rB_ = rowb + NGW < NTOK ? rowb + NGW : NTOK - 1; const int miB = rB_ < NLAT ? (rB_ >> 11) : 8; const float* shB = mv + miB * 6144, *scB = shB + 1024;
                    const float* srcB = (l == 0) ? (rB_ < NLAT ? INP(I_X) + (size_t)rB_ * D : INP(I_CTX) + (size_t)(rB_ - NLAT) * D) : (rB_ < NLAT ? (const float*)hlat + (size_t)rB_ * D : (const float*)hctx + (size_t)(rB_ - NLAT) * D);
#pragma unroll
                    for (int j = 0; j < 4; ++j) { vb2[j] = (l == 0) ? *(const f32x4*)(srcB + 4 * lane + 256 * j) : (f32x4){0.f, 0.f, 0.f, 0.f}; scvB[j] = *(const f32x4*)(scB + 4 * lane + 256 * j); shvB[j] = *(const f32x4*)(shB + 4 * lane + 256 * j); } }
                { const int row_ = rowb + 0, row = row_ < NTOK ? row_ : NTOK - 1; const bool LIVE_ = row_ < NTOK;
                float* hrow = row < NLAT ? hlat + (size_t)row * D : hctx + (size_t)(row - NLAT) * D;
                const int mi = row < NLAT ? (row >> 11) : 8; const float* shift = mv + mi * 6144, *scale = shift + 1024;

                if (l == 0) {
                    const float* src = row < NLAT ? INP(I_X) + (size_t)row * D : INP(I_CTX) + (size_t)(row - NLAT) * D;
#pragma unroll
                    for (int j = 0; j < 4; ++j) va[j] = *(const f32x4*)(src + 4 * lane + 256 * j);
                    if (row < NLAT) { const int t = row & 2047;
                        if (t != pe_t) { pe_t = t; const int prow = t >> 6, pcol = t & 63;
#pragma unroll 1
                            for (int j = 0; j < 4; ++j)
#pragma unroll
                                for (int e = 0; e < 4; ++e) { const int col = 4 * lane + 256 * j + e, part = col >> 9, within = col & 511, i = within & 255;
                                    const float omega = __builtin_amdgcn_exp2f((float)i * (-13.287712379549449f / 256.0f)); const float rev = (float)(part ? pcol : prow) * omega * 0.15915494309189535f;
                                    const float pv = (within >> 8) ? __builtin_amdgcn_cosf(rev) : __builtin_amdgcn_sinf(rev);
                                    if (j == 0) pe[0][e] = pv; else if (j == 1) pe[1][e] = pv; else if (j == 2) pe[2][e] = pv; else pe[3][e] = pv; } }
#pragma unroll
                        for (int j = 0; j < 4; ++j) va[j] += pe[j]; }
#pragma unroll
                    for (int j = 0; j < 4; ++j) if (LIVE_) *(f32x4*)(hrow + 4 * lane + 256 * j) = va[j];
                } else {
                    M_FINISH(row, LIVE_, rtA, maA, mbA, hvA, gtA, va);
                }
                f32x4 scv[4], shv[4];
#pragma unroll
                for (int j = 0; j < 4; ++j) { scv[j] = *(const f32x4*)(scale + 4 * lane + 256 * j); shv[j] = *(const f32x4*)(shift + 4 * lane + 256 * j); }
                ln_rows(va);
#pragma unroll
                for (int j = 0; j < 4; ++j) { const f32x4 sc = scv[j], sh = shv[j]; va[j] = va[j] * (sc + 1.0f) + sh;
                    v2u w; w.x = pk2(va[j][0], va[j][1]); w.y = pk2(va[j][2], va[j][3]); if (LIVE_) *(v2u*)(XN + (size_t)row * D + 4 * lane + 256 * j) = w; }
                }
                { const int row_ = rowb + NGW, row = row_ < NTOK ? row_ : NTOK - 1; const bool LIVE_ = row_ < NTOK;
                float* hrow = row < NLAT ? hlat + (size_t)row * D : hctx + (size_t)(row - NLAT) * D;
                const int mi = row < NLAT ? (row >> 11) : 8; const float* shift = mv + mi * 6144, *scale = shift + 1024;

                if (l == 0) {
                    const float* src = row < NLAT ? INP(I_X) + (size_t)row * D : INP(I_CTX) + (size_t)(row - NLAT) * D;
                    if (row < NLAT) { const int t = row & 2047;
                        if (t != pe_t) { pe_t = t; const int prow = t >> 6, pcol = t & 63;
#pragma unroll 1
                            for (int j = 0; j < 4; ++j)
#pragma unroll
                                for (int e = 0; e < 4; ++e) { const int col = 4 * lane + 256 * j + e, part = col >> 9, within = col & 511, i = within & 255;
                                    const float omega = __builtin_amdgcn_exp2f((float)i * (-13.287712379549449f / 256.0f)); const float rev = (float)(part ? pcol : prow) * omega * 0.15915494309189535f;
                                    const float pv = (within >> 8) ? __builtin_amdgcn_cosf(rev) : __builtin_amdgcn_sinf(rev);
                                    if (j == 0) pe[0][e] = pv; else if (j == 1) pe[1][e] = pv; else if (j == 2) pe[2][e] = pv; else pe[3][e] = pv; } }
#pragma unroll
                        for (int j = 0; j < 4; ++j) vb2[j] += pe[j]; }
#pragma unroll
                    for (int j = 0; j < 4; ++j) if (LIVE_) *(f32x4*)(hrow + 4 * lane + 256 * j) = vb2[j];
                } else {
                    { v2u maB[4], mbB[4]; f32x4 hvB[4], gtB[4]; M_LOAD(row, rtB, maB, mbB, hvB, gtB); M_FINISH(row, LIVE_, rtB, maB, mbB, hvB, gtB, vb2); }
                }
                f32x4 scv[4], shv[4];
#pragma unroll
                for (int j = 0; j < 4; ++j) { scv[j] = scvB[j]; shv[j] = shvB[j]; }
                ln_rows(vb2);
#pragma unroll
                for (int j = 0; j < 4; ++j) { const f32x4 sc = scv[j], sh = shv[j]; vb2[j] = vb2[j] * (sc + 1.0f) + sh;
                    v2u w; w.x = pk2(vb2[j][0], vb2[j][1]); w.y = pk2(vb2[j][2], vb2[j][3]); if (LIVE_) *(v2u*)(XN + (size_t)row * D + 4 * lane + 256 * j) = w; }
                }
                float pa[16], pb_[16];
                { f32x2 vp[4][4];
#pragma unroll
                  for (int j = 0; j < 4; ++j)
#pragma unroll
                      for (int e = 0; e < 4; ++e) vp[j][e] = (f32x2){va[j][e], vb2[j][e]};
#pragma unroll
                  for (int o = 0; o < 16; ++o) { f32x2 sr = (f32x2){0.f, 0.f};
#pragma unroll
                    for (int j = 0; j < 4; ++j) { const f32x4 w = *(const LAS f32x4*)(wab + o * 1024 + 4 * lane + 256 * j);
#pragma unroll
                        for (int e = 0; e < 4; ++e) sr += vp[j][e] * w[e]; }
                    pa[o] = sr[0]; pb_[o] = sr[1]; if ((o & 3) == 3) asm volatile("" ::: "memory"); } }
                const float t0_ = reduce16(pa, lane), t1_ = reduce16(pb_, lane);
                if ((lane & 3) == 0) { AB[(size_t)rowb * 16 + (lane >> 2)] = t0_ + binA; if (rowb + NGW < NTOK) AB[(size_t)(rowb + NGW) * 16 + (lane >> 2)] = t1_ + binA; }
            }
        } }
        SEAM(pb + 0);

        for (int rep_ = 0; rep_ <= (int)PH_REP(2); ++rep_) { if (rep_) GRID_BAR();
        if (PH_ON(2) && IN(pb + 1)) { PH_BEGIN(); const float* mv = modv + (size_t)l * 9 * 6144; (void)mv; unsigned* const moecnt = ctl + CW_MOE + l * 16 * 64; (void)moecnt;
            SchedInA S{X.G, X.bid, (const char*)XN, (const char*)WIN};
            EpiInA E{PQKV, PZ, PCONF, PSGU, PFFT, PFFTC, binv};
            pg8::gemm_phase<EpiInA, SchedInA, true, true>(lds, Gemm{1024, 1024, 1024}, S, E);
        } }
        SEAM(pb + 1);

        for (int rep_ = 0; rep_ <= (int)PH_REP(3); ++rep_) { if (rep_) GRID_BAR();
        if (PH_ON(3) && IN(pb + 2)) { PH_BEGIN(); const float* mv = modv + (size_t)l * 9 * 6144; (void)mv; unsigned* const moecnt = ctl + CW_MOE + l * 16 * 64; (void)moecnt;
            {
                const int vb = X.bid, NB2 = X.G, gw2 = gw, NGW2 = NGW;
                if (l == 0) { SchedFftCtx S{NB2, vb, (const char*)DFTC, (const char*)PFFTC}; EpiBf16<0> E{BR + (size_t)2 * NTOK * 512, 512, nullptr};
                  pg8::gemm_phase<EpiBf16<0>, SchedFftCtx, true, true>(lds, Gemm{512, 512, 512}, S, E); }
                __syncthreads();
                {
                    typedef short v4i16_t __attribute__((ext_vector_type(4)));
                    LAS unsigned char* tl = lds + X.wave * 8192;
                    const int r16 = lane & 15, quad = lane >> 4;
                    bf16x8 m1[4][2];
#pragma unroll
                    for (int mt = 0; mt < 4; ++mt)
#pragma unroll
                        for (int ks = 0; ks < 2; ++ks) { float o[8]; const int k1 = 16 * (mt & 1) + r16, ri = mt >> 1;
#pragma unroll
                            for (int e = 0; e < 8; ++e) { const int t1 = 8 * quad + e; float sn, cs; fsincospi((float)((k1 * t1) & 31) * (1.0f / 16.0f), &sn, &cs);
                                o[e] = ri == 0 ? (ks == 0 ? cs : -sn) : (ks == 0 ? -sn : -cs); }
                            m1[mt][ks] = __builtin_bit_cast(bf16x8, pack8(o)); }
                    float twc[2][4][4], tws[2][4][4];
#pragma unroll
                    for (int ml = 0; ml < 2; ++ml)
#pragma unroll
                        for (int c = 0; c < 4; ++c)
#pragma unroll
                            for (int r = 0; r < 4; ++r) { const int k1 = 16 * ml + r16, t2 = 16 * c + 4 * quad + r; fsincospi((float)(k1 * t2) * (1.0f / 1024.0f), &tws[ml][c][r], &twc[ml][c][r]); }
                    const unsigned tbase = (unsigned)(size_t)tl;
                    for (int it = gw2; it < NB * 512; it += NGW2) {
                        const int b = it >> 9, col = it & 511;
                        const bf16* src = PFFT + (size_t)it * 4096;
                        v4u ld[8];
#pragma unroll
                        for (int i = 0; i < 8; ++i) ld[i] = *(const v4u*)(src + (i * 64 + lane) * 8);
#pragma unroll
                        for (int i = 0; i < 8; ++i) *(LAS v4u*)(tl + (i * 64 + lane) * 16) = ld[i];
                        LDS_WAIT();
                        bf16* dst = (b < 4 ? F1A + (size_t)(b * 512 + col) * 4096 : F1B + (size_t)((b - 4) * 512 + col) * 4096);
#pragma unroll
                        for (int c = 0; c < 4; ++c) {
                            bf16x8 af[2];
#pragma unroll
                            for (int ks = 0; ks < 2; ++ks) { v4i16_t h[2];
#pragma unroll
                                for (int t = 0; t < 2; ++t) h[t] = __builtin_amdgcn_ds_read_tr16_b64_v4i16((LAS v4i16_t*)(tl + ks * 4096 + (8 * quad + 4 * t + (r16 >> 2)) * 128 + (16 * c + 4 * (lane & 3)) * 2));
                                bf16x8 f; f[0] = h[0][0]; f[1] = h[0][1]; f[2] = h[0][2]; f[3] = h[0][3]; f[4] = h[1][0]; f[5] = h[1][1]; f[6] = h[1][2]; f[7] = h[1][3]; af[ks] = f; }
                            f32x4 acc[4];
#pragma unroll
                            for (int mt = 0; mt < 4; ++mt) { acc[mt] = (f32x4){0.f, 0.f, 0.f, 0.f};
#pragma unroll
                                for (int ks = 0; ks < 2; ++ks) acc[mt] = __builtin_amdgcn_mfma_f32_16x16x32_bf16(af[ks], m1[mt][ks], acc[mt], 0, 0, 0); }
#pragma unroll
                            for (int ml = 0; ml < 2; ++ml) { const int k1 = 16 * ml + r16; float pr[4], pi[4];
#pragma unroll
                                for (int r = 0; r < 4; ++r) { const float ar = acc[ml][r], ai = acc[ml + 2][r]; pr[r] = ar * twc[ml][c][r] + ai * tws[ml][c][r]; pi[r] = ai * twc[ml][c][r] - ar * tws[ml][c][r]; }
                                v2u w0, w1; w0.x = pk2(pr[0], pr[1]); w0.y = pk2(pr[2], pr[3]); w1.x = pk2(pi[0], pi[1]); w1.y = pk2(pi[2], pi[3]);
                                *(v2u*)(dst + k1 * 128 + 16 * c + 4 * quad) = w0; *(v2u*)(dst + k1 * 128 + 64 + 16 * c + 4 * quad) = w1; }
                        }
                        LDS_WAIT();
                    }
                    (void)tbase;
                    __syncthreads();
                }
                {
                    LAS float* cwl = (LAS float*)lds;
                    const float* cw = INP(I_GCONV) + (size_t)l * 5 * 1536;
                    { f32x4 t4[4];
#pragma unroll
                      for (int j = 0; j < 4; ++j) { const int i = tid + 512 * j; t4[j] = *(const f32x4*)(cw + 4 * (i < 1920 ? i : 0)); }
#pragma unroll
                      for (int j = 0; j < 4; ++j) { const int i = tid + 512 * j; if (i < 1920) { const int jt = i / 384, rem = i - jt * 384;
                          *(LAS f32x4*)(cwl + jt * 1536 + (rem >> 7) * 512 + (rem & 1) * 256 + ((rem & 127) >> 1) * 4) = t4[j]; } } }
                    __syncthreads();
                    const float gdt_l = INP(I_GDT)[l * 8 + (lane & 7)], nega_l = -__expf(INP(I_GALOG)[l * 8 + (lane & 7)]);
                    for (int row = gw2; row < NTOK; row += NGW2) {
                        int t, T; if (row < NLAT) { t = row & 2047; T = 2048; } else { t = (row - NLAT) & 255; T = 256; }
                        v4u xr[3][5];
#pragma unroll
                        for (int seg = 0; seg < 3; ++seg)
#pragma unroll
                            for (int j = 0; j < 5; ++j) { const int tt = t + j - 2; xr[seg][j] = (tt >= 0 && tt < T) ? *(const v4u*)(PQKV + (size_t)(row + j - 2) * 1536 + seg * 512 + 8 * lane) : (v4u){0u, 0u, 0u, 0u}; }
                        float av = 0.f, bv = 0.f; if (lane < 8) { av = AB[(size_t)row * 16 + lane]; bv = AB[(size_t)row * 16 + 8 + lane]; }
#pragma unroll
                        for (int seg = 0; seg < 3; ++seg) { const int ch = seg * 512 + 8 * lane; float a[8];
#pragma unroll
                            for (int e = 0; e < 8; ++e) a[e] = 0.f;
#pragma unroll
                            for (int j = 0; j < 5; ++j) { float xv[8]; unpack8(xr[seg][j], xv);
                                const f32x4 w0 = *(const LAS f32x4*)(cwl + j * 1536 + seg * 512 + 4 * lane), w1 = *(const LAS f32x4*)(cwl + j * 1536 + seg * 512 + 256 + 4 * lane);
#pragma unroll
                                for (int e = 0; e < 4; ++e) { a[e] += w0[e] * xv[e]; a[4 + e] += w1[e] * xv[4 + e]; } }
                            float ss = 0.f;
#pragma unroll
                            for (int e = 0; e < 8; ++e) { a[e] = siluf_(a[e]); ss += a[e] * a[e]; }
                            if (seg < 2) { ss = g16_sum(ss); const float sc = __builtin_amdgcn_rsqf(ss + LN_EPS) * (seg == 0 ? 0.08838834764831845f : 1.0f);
#pragma unroll
                                for (int e = 0; e < 8; ++e) a[e] *= sc; }
                            *(v4u*)(QKV + (size_t)row * 1536 + ch) = pack8(a); }
                        if (lane < 8) { const float xs = av + gdt_l; const float sp = xs > 20.f ? xs : __logf(1.0f + __expf(xs));
                            GB[(size_t)row * 16 + lane] = nega_l * sp; GB[(size_t)row * 16 + 8 + lane] = __builtin_amdgcn_rcpf(1.0f + __expf(-bv)); }
                    }
                    __syncthreads();
                }
                {
                    LAS bf16* xs = (LAS bf16*)lds;
                    LAS float* wl = (LAS float*)(lds + 63488);
                    const float* dw = INP(I_CDWW) + (size_t)l * 31 * 512; const float* dwb = INP(I_CDWB) + l * 512, *lg = INP(I_CLNG) + l * 512, *lb = INP(I_CLNB) + l * 512;
                    bf16* B1 = BR + (size_t)1 * NTOK * 512;
                    { f32x4 t8[8];
#pragma unroll
                      for (int j = 0; j < 8; ++j) { const int i = tid + 512 * j; t8[j] = *(const f32x4*)(dw + 4 * (i < 3968 ? i : 0)); }
#pragma unroll
                      for (int j = 0; j < 8; ++j) { const int i = tid + 512 * j; if (i < 3968) *(LAS f32x4*)(wl + (i >> 7) * 512 + (i & 1) * 256 + ((i & 127) >> 1) * 4) = t8[j]; } }
                    const int ch = 8 * lane, tq = X.wave;
                    f32x4 bia0 = *(const f32x4*)(dwb + ch), bia1 = *(const f32x4*)(dwb + ch + 4);
                    const f32x4 g0 = *(const f32x4*)(lg + ch), g1 = *(const f32x4*)(lg + ch + 4), b0 = *(const f32x4*)(lb + ch), b1 = *(const f32x4*)(lb + ch + 4);
                    for (int tile = vb; tile < nrows2 / 32; tile += NB2) {
                        const int t0 = tile * 32; int rbase, T; if (t0 < NLAT) { rbase = t0 & ~2047; T = 2048; } else { rbase = NLAT + ((t0 - NLAT) & ~255); T = 256; }
                        __syncthreads();
                        { v4u tl8[8];
#pragma unroll
                          for (int j = 0; j < 8; ++j) { const int i = tid + 512 * j, r = i >> 6, c = i & 63, srow = t0 - 15 + r; const bool ok = i < 62 * 64 && srow >= rbase && srow < rbase + T;
                              tl8[j] = *(const v4u*)(PCONF + (size_t)(ok ? srow : t0) * 512 + 8 * c); if (!ok) tl8[j] = (v4u){0u, 0u, 0u, 0u}; }
#pragma unroll
                          for (int j = 0; j < 8; ++j) { const int i = tid + 512 * j, r = i >> 6, c = i & 63; if (i < 62 * 64) *(LAS v4u*)(xs + r * 512 + 8 * c) = tl8[j]; } }
                        __syncthreads();
                        float acc[4][8];
#pragma unroll
                        for (int k = 0; k < 4; ++k)
#pragma unroll
                            for (int e = 0; e < 4; ++e) { acc[k][e] = bia0[e]; acc[k][4 + e] = bia1[e]; }
                        float xw[4][8];
#pragma unroll
                        for (int k = 0; k < 4; ++k) unpack8(*(const LAS v4u*)(xs + (tq * 4 + k) * 512 + ch), xw[k]);
#define CONF_TAP(j_, i_, LOADNEXT_) do { const int jj_ = (j_); \
                            const f32x4 w0 = *(const LAS f32x4*)(wl + jj_ * 512 + 4 * lane), w1 = *(const LAS f32x4*)(wl + jj_ * 512 + 256 + 4 * lane); \
                            v4u nx_ = (v4u){0u, 0u, 0u, 0u}; if (LOADNEXT_) nx_ = *(const LAS v4u*)(xs + (tq * 4 + jj_ + 4) * 512 + ch); \
                            _Pragma("unroll") for (int k = 0; k < 4; ++k) _Pragma("unroll") for (int e = 0; e < 4; ++e) { acc[k][e] += w0[e] * xw[(k + (i_)) & 3][e]; acc[k][4 + e] += w1[e] * xw[(k + (i_)) & 3][4 + e]; } \
                            if (LOADNEXT_) unpack8(nx_, xw[(i_)]); } while (0)
#pragma unroll 1
                        for (int j0 = 0; j0 < 28; j0 += 4) { CONF_TAP(j0, 0, true); CONF_TAP(j0 + 1, 1, true); CONF_TAP(j0 + 2, 2, true); CONF_TAP(j0 + 3, 3, true); }
                        CONF_TAP(28, 0, true); CONF_TAP(29, 1, true); CONF_TAP(30, 2, false);
#undef CONF_TAP
#pragma unroll
                        for (int k = 0; k < 4; ++k) { float s1 = 0.f;
#pragma unroll
                            for (int e = 0; e < 8; ++e) s1 += acc[k][e];
                            const float mean = g16_sum(s1) * (1.0f / 128.0f); float s2 = 0.f;
#pragma unroll
                            for (int e = 0; e < 8; ++e) { acc[k][e] -= mean; s2 += acc[k][e] * acc[k][e]; }
                            const float rstd = __builtin_amdgcn_rsqf(g16_sum(s2) * (1.0f / 128.0f) + LN_EPS); float o[8];
#pragma unroll
                            for (int e = 0; e < 4; ++e) { o[e] = siluf_(acc[k][e] * rstd * g0[e] + b0[e]); o[4 + e] = siluf_(acc[k][4 + e] * rstd * g1[e] + b1[e]); }
                            *(v4u*)(B1 + (size_t)(t0 + tq * 4 + k) * 512 + ch) = pack8(o); }
                    }
                    __syncthreads();
                }
                {
                    LAS bf16* vnT = (LAS bf16*)lds;
                    const float* lg = INP(I_SLNG) + l * 512, *lb = INP(I_SLNB) + l * 512;
                    bf16* B3 = BR + (size_t)3 * NTOK * 512;
                    const int nitems = (nrows2 / 128) * 4, r16 = lane & 15, quad = lane >> 4, w = X.wave;
                    for (int it = (vb + NB2 - NB2 / 4) % NB2; it < nitems; it += NB2) {
                        const int chunk = it >> 2, g = it & 3, r0 = chunk * 128;
                        unsigned raw[16];
#pragma unroll
                        for (int i = 0; i < 16; ++i) raw[i] = *(const unsigned*)(PSGU + (size_t)(r0 + w * 16 + i) * 1024 + 512 + g * 128 + 2 * lane);
                        const int c = g * 128 + 2 * lane; const float lg0 = lg[c], lg1 = lg[c + 1], lb0 = lb[c], lb1 = lb[c + 1];
                        f32x4 wx[8]; v2u uwv[8]; const size_t prow = (size_t)(r0 + 16 * w + r16);
                        { const float* wsrc = INP(I_SWS) + ((size_t)(l * 4 + g) * 128 + 16 * w + r16) * 128 + quad * 8;
#pragma unroll
                          for (int ks = 0; ks < 4; ++ks) { wx[2 * ks] = *(const f32x4*)(wsrc + 32 * ks); wx[2 * ks + 1] = *(const f32x4*)(wsrc + 32 * ks + 4); } }
                        const float bs = INP(I_SBS)[(l * 4 + g) * 128 + 16 * w + r16];
#pragma unroll
                        for (int nt = 0; nt < 8; ++nt) uwv[nt] = *(const v2u*)(PSGU + prow * 1024 + g * 128 + 16 * nt + quad * 4);
                        __syncthreads();
                        { float sv[16];
#pragma unroll
                          for (int i = 0; i < 16; ++i) sv[i] = bflo(raw[i]) + bfhi(raw[i]);
                          const float ts = reduce16(sv, lane) * (1.0f / 128.0f); float mean[16];
#pragma unroll
                          for (int i = 0; i < 16; ++i) { mean[i] = __shfl(ts, 4 * i); const float v0 = bflo(raw[i]) - mean[i], v1 = bfhi(raw[i]) - mean[i]; sv[i] = v0 * v0 + v1 * v1; }
                          const float tv = reduce16(sv, lane) * (1.0f / 128.0f);
#pragma unroll
                          for (int i = 0; i < 16; ++i) { const float rstd = __builtin_amdgcn_rsqf(__shfl(tv, 4 * i) + LN_EPS); const float v0 = bflo(raw[i]) - mean[i], v1 = bfhi(raw[i]) - mean[i];
                            vnT[(2 * lane) * 136 + w * 16 + i] = (bf16)f2bf(v0 * rstd * lg0 + lb0); vnT[(2 * lane + 1) * 136 + w * 16 + i] = (bf16)f2bf(v1 * rstd * lg1 + lb1); } }
                        bf16x8 wf[4];
                        {
#pragma unroll
                          for (int ks = 0; ks < 4; ++ks) { const f32x4 x0 = wx[2 * ks], x1 = wx[2 * ks + 1];
                              v4u pk; pk.x = pk2(x0[0], x0[1]); pk.y = pk2(x0[2], x0[3]); pk.z = pk2(x1[0], x1[1]); pk.w = pk2(x1[2], x1[3]); wf[ks] = __builtin_bit_cast(bf16x8, pk); } }
                        __syncthreads();
#pragma unroll
                        for (int nt = 0; nt < 8; ++nt) { f32x4 acc = (f32x4){0.f, 0.f, 0.f, 0.f};
#pragma unroll
                            for (int ks = 0; ks < 4; ++ks) { const bf16x8 vf = *(const LAS bf16x8*)(vnT + (16 * nt + r16) * 136 + 32 * ks + quad * 8); acc = __builtin_amdgcn_mfma_f32_16x16x32_bf16(vf, wf[ks], acc, 0, 0, 0); }
                            const v2u uw = uwv[nt];
                            v2u o; o.x = pk2(bflo(uw.x) * (acc[0] + bs), bfhi(uw.x) * (acc[1] + bs)); o.y = pk2(bflo(uw.y) * (acc[2] + bs), bfhi(uw.y) * (acc[3] + bs));
                            *(v2u*)(B3 + prow * 512 + g * 128 + 16 * nt + quad * 4) = o; }
                    }
                    __syncthreads();
                }
            }
        } }
        SEAM(pb + 2);

        for (int rep_ = 0; rep_ <= (int)PH_REP(4); ++rep_) { if (rep_) GRID_BAR();
        if (PH_ON(4) && IN(pb + 3)) { PH_BEGIN(); const float* mv = modv + (size_t)l * 9 * 6144; (void)mv; unsigned* const moecnt = ctl + CW_MOE + l * 16 * 64; (void)moecnt;
            {
                const int r16 = lane & 15, quad = lane >> 4;
                bf16x8 m2[4][4];
#pragma unroll
                for (int jt = 0; jt < 4; ++jt)
#pragma unroll
                    for (int ks = 0; ks < 4; ++ks) { float o[8]; const int k2 = 16 * jt + r16;
#pragma unroll
                        for (int e = 0; e < 8; ++e) { const int t2 = 32 * (ks & 1) + 8 * quad + e; float sn, cs; fsincospi((float)((k2 * t2) & 63) * (1.0f / 32.0f), &sn, &cs); o[e] = ((ks >> 1) ? sn : cs) * 0.022097086912079608f; }
                        m2[jt][ks] = __builtin_bit_cast(bf16x8, pack8(o)); }
                bf16* B2 = BR + (size_t)2 * NTOK * 512;
                const int nq5 = 9216 - 4 * NGW;
                const bool bal = nq5 > 0 && nq5 < NGW;
                for (int it = bal ? gw - nq5 : gw; it < 8192; it += bal ? NGW - nq5 : NGW) {
                    if (it < 0) break;
                    const int b = it >> 10, k1 = (it >> 5) & 31, ct = it & 31;
                    const bf16* f1 = (b < 4 ? F1A + (size_t)(b * 512 + 16 * ct + r16) * 4096 : F1B + (size_t)((b - 4) * 512 + 16 * ct + r16) * 4096) + k1 * 128 + 8 * quad;
                    bf16x8 af[4];
#pragma unroll
                    for (int ks = 0; ks < 4; ++ks) af[ks] = *(const bf16x8*)(f1 + 32 * ks);
#pragma unroll
                    for (int jt = 0; jt < 4; ++jt) { f32x4 acc = (f32x4){0.f, 0.f, 0.f, 0.f};
#pragma unroll
                        for (int ks = 0; ks < 4; ++ks) acc = __builtin_amdgcn_mfma_f32_16x16x32_bf16(af[ks], m2[jt][ks], acc, 0, 0, 0);
                        v2u w; w.x = pk2(acc[0], acc[1]); w.y = pk2(acc[2], acc[3]);
                        *(v2u*)(B2 + (size_t)(b * 2048 + k1 + 32 * (16 * jt + r16)) * 512 + 16 * ct + 4 * quad) = w; }
                }
            }
            for (int qi = gw; qi < 9216; qi += NGW) {
                int lane_l = lane; asm volatile("" : "+v"(lane_l));
                const int r16 = lane_l & 15, quad = lane_l >> 4;
                LAS float* const Mt = (LAS float*)(lds + X.wave * 16384);
                LAS float* const gcl = (LAS float*)(lds + 132096 + X.wave * 1024);
                const int item = qi >> 2, q = qi & 3, cidx = item % 36, chain = item / 36, dir = chain & 1, hh = (chain >> 1) & 3, b = chain >> 3;
                const int row0 = cidx < 4 ? NLAT + b * CTXL + cidx * 64 : b * SEQ + (cidx - 4) * 64;
                const int rb = row0 + (dir ? 63 : 0); const long sg = dir ? -1 : 1;
                const float ga = GB[(size_t)(rb + sg * lane_l) * 16 + dir * 4 + hh], be = GB[(size_t)(rb + sg * lane_l) * 16 + 8 + dir * 4 + hh];
                float gc = ga;
#pragma unroll
                for (int o = 1; o < 64; o <<= 1) { const float tu = __shfl_up(gc, o); gc += (lane_l >= o) ? tu : 0.f; }
                const float gl = __shfl(gc, 63);
                gcl[lane_l] = gc; gcl[64 + lane_l] = be;
                const float scl = q >= 2 ? be * __expf(gc) : be;
                bf16x8 Kf[4][4];
                { const bf16* kp = QKV + (size_t)(rb + sg * r16) * 1536 + 512 + hh * 128 + quad * 8; const long ms = sg * 16 * 1536;
#pragma unroll
                  for (int mi = 0; mi < 4; ++mi)
#pragma unroll
                      for (int ks = 0; ks < 4; ++ks) Kf[mi][ks] = *(const bf16x8*)(kp + mi * ms + ks * 32); }
                LDS_WAIT();
                if (q == 0) {
                    bf16x8 Qf[4][4];
                    { const bf16* qp = QKV + (size_t)(rb + sg * r16) * 1536 + hh * 128 + quad * 8; const long ms = sg * 16 * 1536;
#pragma unroll
                      for (int mi = 0; mi < 4; ++mi)
#pragma unroll
                          for (int ks = 0; ks < 4; ++ks) Qf[mi][ks] = *(const bf16x8*)(qp + mi * ms + ks * 32); }
                    bf16* ait = AIT + (size_t)item * 4096 + (size_t)r16 * 8 + 4 * (quad & 1) + (quad >> 1) * 128;
#pragma unroll
                    for (int mi = 0; mi < 4; ++mi) { const float gci = gcl[16 * mi + r16];
#pragma unroll
                        for (int nj = 0; nj < 4; ++nj) {
                            v2u w; w.x = 0u; w.y = 0u;
                            if (nj <= mi) {
                                f32x4 c = (f32x4){0.f, 0.f, 0.f, 0.f};
#pragma unroll
                                for (int ks = 0; ks < 4; ++ks) c = __builtin_amdgcn_mfma_f32_16x16x32_bf16(Kf[nj][ks], Qf[mi][ks], c, 0, 0, 0);
                                const f32x4 gcj = *(const LAS f32x4*)(gcl + 16 * nj + quad * 4); float o4[4];
#pragma unroll
                                for (int r = 0; r < 4; ++r) { const bool incl = (nj < mi) || (quad * 4 + r <= r16); o4[r] = incl ? c[r] * __expf(gci - gcj[r]) : 0.f; }
                                w.x = pk2(o4[0], o4[1]); w.y = pk2(o4[2], o4[3]); }
                            *(v2u*)(ait + (mi * 2 + (nj >> 1)) * 512 + (nj & 1) * 256) = w; }
                    }
                }
                if (q == 1) { SIT[(size_t)item * 192 + lane_l] = __expf(gc); SIT[(size_t)item * 192 + 64 + lane_l] = __expf(gl - gc); if (lane_l == 0) SIT[(size_t)item * 192 + 128] = __expf(gl); }
                asm volatile("" ::: "memory");
                { LAS float* mw = Mt + r16 * 64 + quad * 4;
#pragma unroll
                  for (int mi = 0; mi < 4; ++mi) {
                    const f32x4 gci = *(const LAS f32x4*)(gcl + 16 * mi + quad * 4), bei = *(const LAS f32x4*)(gcl + 64 + 16 * mi + quad * 4);
#pragma unroll
                    for (int nj = 0; nj <= mi; ++nj) {
                        f32x4 c = (f32x4){0.f, 0.f, 0.f, 0.f};
#pragma unroll
                        for (int ks = 0; ks < 4; ++ks) c = __builtin_amdgcn_mfma_f32_16x16x32_bf16(Kf[mi][ks], Kf[nj][ks], c, 0, 0, 0);
                        const float gcj = gcl[16 * nj + r16]; f32x4 mv4;
#pragma unroll
                        for (int r = 0; r < 4; ++r) { const bool strict = (nj < mi) || (r16 < quad * 4 + r); mv4[r] = strict ? -(bei[r] * c[r] * __expf(gci[r] - gcj)) : 0.f; }
                        *(LAS f32x4*)(mw + (16 * nj) * 64 + 16 * mi) = mv4;
                    }
                  } }
                asm volatile("" ::: "memory");
                LDS_WAIT();
                float Xs[64];
                { const bf16* src = QKV + (size_t)rb * 1536 + (q < 2 ? 1024 + 64 * q : 512 + 64 * (q - 2)) + hh * 128 + lane_l; const long sstep = sg * 1536;
                  bf16 raw[64];
#pragma unroll
                  for (int sidx = 0; sidx < 64; ++sidx) { raw[sidx] = *src; src += sstep; }
                  asm volatile("" ::: "memory");
#pragma unroll
                  for (int sidx = 0; sidx < 64; ++sidx) { const float sc = __builtin_bit_cast(float, __builtin_amdgcn_readlane(__builtin_bit_cast(int, scl), sidx)); Xs[sidx] = bf1(raw[sidx]) * sc; } }
#pragma unroll
                for (int g4 = 0; g4 < 16; ++g4) {
                    f32x4 acc = (f32x4){Xs[4 * g4], Xs[4 * g4 + 1], Xs[4 * g4 + 2], Xs[4 * g4 + 3]};
#pragma unroll
                    for (int c0 = 0; c0 < 4 * g4; c0 += 16) {
                        f32x4 mb[16];
#pragma unroll
                        for (int e = 0; e < 16; ++e) if (c0 + e < 4 * g4) mb[e] = *(const LAS f32x4*)(Mt + (c0 + e) * 64 + 4 * g4);
                        LDS_WAIT();
#pragma unroll
                        for (int e = 0; e < 16; ++e) if (c0 + e < 4 * g4) acc += mb[e] * Xs[c0 + e];
                    }
                    const f32x4 m0 = *(const LAS f32x4*)(Mt + (4 * g4) * 64 + 4 * g4), m1 = *(const LAS f32x4*)(Mt + (4 * g4 + 1) * 64 + 4 * g4), m2 = *(const LAS f32x4*)(Mt + (4 * g4 + 2) * 64 + 4 * g4);
                    LDS_WAIT();
                    const float x0 = acc[0], x1 = acc[1] + m0[1] * x0, x2 = acc[2] + m0[2] * x0 + m1[2] * x1, x3 = acc[3] + m0[3] * x0 + m1[3] * x1 + m2[3] * x2;
                    Xs[4 * g4] = x0; Xs[4 * g4 + 1] = x1; Xs[4 * g4 + 2] = x2; Xs[4 * g4 + 3] = x3;
                }
                if (q < 2) {
                    bf16* u0 = UIT + (size_t)item * 8192 + ((size_t)((2 * q + (lane_l >> 5)) * 2 + ((lane_l >> 4) & 1)) * 256 + (lane_l & 15)) * 4;
#pragma unroll
                    for (int g = 0; g < 16; ++g) { v2u c0; c0.x = pk2(Xs[4 * g], Xs[4 * g + 1]); c0.y = pk2(Xs[4 * g + 2], Xs[4 * g + 3]);
                        *(v2u*)(u0 + ((g >> 2) * 64 + (g & 3) * 16) * 4) = c0; }
                } else {
                    { LAS bf16* Tt = (LAS bf16*)Mt;
                      LDS_WAIT(); asm volatile("" ::: "memory");
#pragma unroll
                      for (int sidx = 0; sidx < 64; ++sidx) Tt[sidx * 72 + lane_l] = (bf16)f2bf(Xs[sidx]);
                      LDS_WAIT(); asm volatile("" ::: "memory");
                      bf16* w0 = WIT + (size_t)item * 8192 + (size_t)lane_l * 8;
#pragma unroll
                      for (int mtt = 0; mtt < 4; ++mtt)
#pragma unroll
                          for (int ksl = 0; ksl < 2; ++ksl) { const v4u pc = *(const LAS v4u*)(Tt + (16 * mtt + r16) * 72 + 32 * ksl + 8 * quad);
                              *(v4u*)(w0 + (mtt * 4 + 2 * (q - 2) + ksl) * 512) = pc; }
                      LDS_WAIT(); }
                    asm volatile("" ::: "memory");
                    if (dir == 0) {
                        const bf16* src = QKV + (size_t)row0 * 1536 + 512 + hh * 128 + 64 * (q - 2) + lane_l;
                        bf16* k0 = KIT + ((size_t)((b * 4 + hh) * 36 + cidx)) * 8192 + ((size_t)(2 * (4 * (q - 2) + (lane_l >> 4))) * 64 + (lane_l & 15)) * 8;
                        unsigned kw[64];
#pragma unroll
                        for (int e = 0; e < 64; ++e) kw[e] = src[(size_t)e * 1536];
                        asm volatile("" ::: "memory");
#pragma unroll
                        for (int p = 0; p < 8; ++p) { v4u lo; lo.x = kw[8 * p] | (kw[8 * p + 1] << 16); lo.y = kw[8 * p + 2] | (kw[8 * p + 3] << 16); lo.z = kw[8 * p + 4] | (kw[8 * p + 5] << 16); lo.w = kw[8 * p + 6] | (kw[8 * p + 7] << 16);
                            *(v4u*)(k0 + ((p >> 2) * 64 + (p & 3) * 16) * 8) = lo; }
                    }
                }
                LDS_WAIT();
            }
        } }
        SEAM(pb + 3);

        for (int rep_ = 0; rep_ <= (int)PH_REP(5); ++rep_) { if (rep_) GRID_BAR();
        if (PH_ON(5) && IN(pb + 4)) { PH_BEGIN(); const float* mv = modv + (size_t)l * 9 * 6144; (void)mv; unsigned* const moecnt = ctl + CW_MOE + l * 16 * 64; (void)moecnt;
            LAS bf16* const STl = (LAS bf16*)lds;
            LAS bf16* const VNl = (LAS bf16*)(lds + 8704);
            LAS bf16* const VSl = (LAS bf16*)(lds + 13312);
            LAS bf16* const OTl = (LAS bf16*)(lds + 17920);
            const int w = X.wave, mt = w & 3, role = w >> 2, r16 = lane & 15, quad = lane >> 4;
            const int fS = ((r16 >> 2) ^ (r16 >> 3)) & 1;
            for (int blk = X.bid; blk < 256; blk += X.G) {
                const int item = (blk & 7) * 32 + (blk >> 3);
                const int chain = item >> 2, slice = item & 3, dir = chain & 1, hh = (chain >> 1) & 3, b = chain >> 3;
                bf16* const O = dir ? OB : OF;
                __syncthreads();
                for (int i = tid; i < 32 * 136 / 2; i += 512) ((LAS unsigned*)STl)[i] = 0u;
                __syncthreads();
                f32x4 Sacc[2]; Sacc[0] = (f32x4){0.f, 0.f, 0.f, 0.f}; Sacc[1] = (f32x4){0.f, 0.f, 0.f, 0.f};
#define GDN_LOAD(P, step_) do { const int cidx_ = dir ? ((step_) < 4 ? 3 - (step_) : 39 - (step_)) : (step_); const int item_ = chain * 36 + cidx_, kti_ = (chain >> 1) * 36 + cidx_; \
                    const int row0_ = cidx_ < 4 ? NLAT + b * CTXL + cidx_ * 64 : b * SEQ + (cidx_ - 4) * 64; \
                    const bf16* xp_ = role ? QKV + (size_t)(row0_ + (dir ? 63 - (16 * mt + r16) : 16 * mt + r16)) * 1536 + hh * 128 + quad * 8 : WIT + (size_t)item_ * 8192 + (mt * 256 + lane) * 8;     \
                    _Pragma("unroll") for (int ks = 0; ks < 4; ++ks) P##Xf[ks] = *(const bf16x8*)(xp_ + (role ? 32 : 512) * ks); \
                    { const bf16* kp_ = KIT + (size_t)kti_ * 8192 + (dir ? ((2 * w + 1) * 64 + (3 - quad) * 16 + r16) * 8 : (2 * w * 64 + quad * 16 + r16) * 8);     \
                      _Pragma("unroll") for (int ks = 0; ks < 2; ++ks) P##Kx[ks] = *(const v4u*)(kp_ + (dir ? -512 * ks : 512 * ks)); } \
                    const float* sp_ = SIT + (size_t)item_ * 192; P##sc4 = *(const f32x4*)(sp_ + (role ? 0 : 64) + 16 * mt + quad * 4); P##egl = sp_[128]; \
                      \
                    { const bf16* a0_ = role ? AIT + (size_t)item_ * 4096 + (mt * 128 + lane) * 8 : UIT + (size_t)item_ * 8192 + ((slice * 2 * 4 + mt) * 64 + lane) * 4; \
                      const bf16* a1_ = role ? a0_ + 512 : a0_ + 1024; \
                      P##Ax[0] = *(const v2u*)a0_; P##Ax[1] = *(const v2u*)(a0_ + 4); P##Ax[2] = *(const v2u*)a1_; P##Ax[3] = *(const v2u*)(a1_ + 4); } } while (0)
#define GDN_BAR() do { asm volatile("s_waitcnt lgkmcnt(0)" ::: "memory"); __builtin_amdgcn_s_barrier(); asm volatile("" ::: "memory"); } while (0)
#define GDN_STEP(P, step_) do { const int cidx = dir ? ((step_) < 4 ? 3 - (step_) : 39 - (step_)) : (step_); \
                    const int row0 = cidx < 4 ? NLAT + b * CTXL + cidx * 64 : b * SEQ + (cidx - 4) * 64; \
                      \
                    f32x4 x1[2]; x1[0] = (f32x4){0.f, 0.f, 0.f, 0.f}; x1[1] = (f32x4){0.f, 0.f, 0.f, 0.f}; \
                    { bf16x8 bfr[2][4]; \
                      _Pragma("unroll") for (int n_ = 0; n_ < 2; ++n_) _Pragma("unroll") for (int ks = 0; ks < 4; ++ks) bfr[n_][ks] = *(const LAS bf16x8*)(STl + (16 * n_ + r16) * 136 + ((4 * ks + quad) ^ fS) * 8); \
                      asm volatile("s_waitcnt lgkmcnt(0)" ::: "memory"); \
                      _Pragma("unroll") for (int ks = 0; ks < 4; ++ks) { x1[0] = __builtin_amdgcn_mfma_f32_16x16x32_bf16(P##Xf[ks], bfr[0][ks], x1[0], 0, 0, 0); x1[1] = __builtin_amdgcn_mfma_f32_16x16x32_bf16(P##Xf[ks], bfr[1][ks], x1[1], 0, 0, 0); } } \
                    if (role == 0) { \
                        _Pragma("unroll") for (int n_ = 0; n_ < 2; ++n_) { f32x4 vn; vn[0] = bflo(P##Ax[2 * n_].x) - x1[n_][0]; vn[1] = bfhi(P##Ax[2 * n_].x) - x1[n_][1]; vn[2] = bflo(P##Ax[2 * n_].y) - x1[n_][2]; vn[3] = bfhi(P##Ax[2 * n_].y) - x1[n_][3]; \
                            v2u p; p.x = pk2(vn[0], vn[1]); p.y = pk2(vn[2], vn[3]); *(LAS v2u*)(VNl + (16 * n_ + r16) * 72 + ((2 * mt + (quad >> 1)) ^ fS) * 8 + 4 * (quad & 1)) = p; \
                            v2u q; q.x = pk2(vn[0] * P##sc4[0], vn[1] * P##sc4[1]); q.y = pk2(vn[2] * P##sc4[2], vn[3] * P##sc4[3]); *(LAS v2u*)(VSl + (16 * n_ + r16) * 72 + ((2 * mt + (quad >> 1)) ^ fS) * 8 + 4 * (quad & 1)) = q; } } \
                    else { x1[0] = x1[0] * P##sc4; x1[1] = x1[1] * P##sc4; } \
                    bf16x8 kt_[2]; \
                    _Pragma("unroll") for (int ks = 0; ks < 2; ++ks) { const v4u kx_ = P##Kx[ks]; v4u kr_; \
                        kr_.x = dir ? ((kx_.w >> 16) | (kx_.w << 16)) : kx_.x; kr_.y = dir ? ((kx_.z >> 16) | (kx_.z << 16)) : kx_.y; kr_.z = dir ? ((kx_.y >> 16) | (kx_.y << 16)) : kx_.z; kr_.w = dir ? ((kx_.x >> 16) | (kx_.x << 16)) : kx_.w; \
                        kt_[ks] = __builtin_bit_cast(bf16x8, kr_); } \
                    GDN_BAR(); \
                      \
                    bf16x8 vsf[2][2]; \
                    _Pragma("unroll") for (int n2 = 0; n2 < 2; ++n2) { vsf[n2][0] = *(const LAS bf16x8*)(VSl + (16 * n2 + r16) * 72 + (quad ^ fS) * 8); vsf[n2][1] = *(const LAS bf16x8*)(VSl + (16 * n2 + r16) * 72 + 32 + (quad ^ fS) * 8); } \
                    if (role) { bf16x8 vb[2][2]; \
                        _Pragma("unroll") for (int n_ = 0; n_ < 2; ++n_) { vb[n_][0] = *(const LAS bf16x8*)(VNl + (16 * n_ + r16) * 72 + (quad ^ fS) * 8); vb[n_][1] = *(const LAS bf16x8*)(VNl + (16 * n_ + r16) * 72 + 32 + (quad ^ fS) * 8); } \
                        asm volatile("s_waitcnt lgkmcnt(0)" ::: "memory"); \
                        v4u af0_; af0_.x = P##Ax[0].x; af0_.y = P##Ax[0].y; af0_.z = P##Ax[1].x; af0_.w = P##Ax[1].y; v4u af1_; af1_.x = P##Ax[2].x; af1_.y = P##Ax[2].y; af1_.z = P##Ax[3].x; af1_.w = P##Ax[3].y; \
                        const bf16x8 Af0_ = __builtin_bit_cast(bf16x8, af0_), Af1_ = __builtin_bit_cast(bf16x8, af1_); \
                        _Pragma("unroll") for (int n_ = 0; n_ < 2; ++n_) { f32x4 oa = __builtin_amdgcn_mfma_f32_16x16x32_bf16(Af0_, vb[n_][0], x1[n_], 0, 0, 0); oa = __builtin_amdgcn_mfma_f32_16x16x32_bf16(Af1_, vb[n_][1], oa, 0, 0, 0); \
                            LAS bf16* ot_ = OTl + (16 * mt + quad * 4) * 36 + 16 * n_ + r16; \
                            _Pragma("unroll") for (int j = 0; j < 4; ++j) ot_[j * 36] = (bf16)f2bf(oa[j]); } } \
                    else { asm volatile("s_waitcnt lgkmcnt(0)" ::: "memory"); } \
                    _Pragma("unroll") for (int n2 = 0; n2 < 2; ++n2) { \
                        f32x4 sa = Sacc[n2] * P##egl; sa = __builtin_amdgcn_mfma_f32_16x16x32_bf16(kt_[0], vsf[n2][0], sa, 0, 0, 0); sa = __builtin_amdgcn_mfma_f32_16x16x32_bf16(kt_[1], vsf[n2][1], sa, 0, 0, 0); Sacc[n2] = sa; \
                        v2u p; p.x = pk2(sa[0], sa[1]); p.y = pk2(sa[2], sa[3]); *(LAS v2u*)(STl + (16 * n2 + r16) * 136 + ((2 * w + (quad >> 1)) ^ fS) * 8 + 4 * (quad & 1)) = p; } \
                    GDN_BAR(); \
                      \
                    { const int tk_ = 8 * w + (lane >> 3), pc_ = lane & 7; const v2u ov_ = *(const LAS v2u*)(OTl + tk_ * 36 + 4 * pc_); \
                      *(v2u*)(O + (size_t)(row0 + (dir ? 63 - tk_ : tk_)) * 512 + hh * 128 + slice * 32 + 4 * pc_) = ov_; } } while (0)
#define GDN_DECL(P) bf16x8 P##Xf[4]; v4u P##Kx[2]; v2u P##Ax[4]; f32x4 P##sc4; float P##egl
                GDN_DECL(sa_); GDN_DECL(sb_);
                GDN_LOAD(sa_, 0);
                *(v2u*)(ws + WS_END + ((size_t)X.bid * 512 + tid) * 8) = (v2u){0u, 0u};
                for (int step = 0; step < 36; step += 2) {
                    GDN_LOAD(sb_, step + 1); GDN_STEP(sa_, step);
                    { const int s2 = step + 2 < 36 ? step + 2 : 35; GDN_LOAD(sa_, s2); } GDN_STEP(sb_, step + 1);
                }
#undef GDN_STEP
#undef GDN_BAR
#undef GDN_DECL
#undef GDN_LOAD
            }
        } }
        SEAM(pb + 4);

        for (int rep_ = 0; rep_ <= (int)PH_REP(6); ++rep_) { if (rep_) GRID_BAR();
        if (PH_ON(6) && IN(pb + 5)) { PH_BEGIN(); const float* mv = modv + (size_t)l * 9 * 6144; (void)mv; unsigned* const moecnt = ctl + CW_MOE + l * 16 * 64; (void)moecnt;
            const float* nw = INP(I_GNORM) + l * 128; const int ch = 8 * lane;
            const f32x4 nw0 = *(const f32x4*)(nw + (ch & 127)), nw1 = *(const f32x4*)(nw + (ch & 127) + 4);
            constexpr int ERT = 9;
            for (int rowb = gw; rowb < nrows2; rowb += ERT * NGW) {
                v4u lf[ERT], lb[ERT], lz[ERT];
#pragma unroll
                for (int k = 0; k < ERT; ++k) { const int row_ = rowb + k * NGW, row = row_ < nrows2 ? row_ : nrows2 - 1; lf[k] = *(const v4u*)(OF + (size_t)row * 512 + ch); lb[k] = *(const v4u*)(OB + (size_t)row * 512 + ch); lz[k] = *(const v4u*)(PZ + (size_t)row * 512 + ch); }
#pragma unroll
                for (int k = 0; k < ERT; ++k) { const int row_ = rowb + k * NGW, row = row_ < nrows2 ? row_ : nrows2 - 1; {
                    float of[8], ob[8], z[8], o[8]; unpack8(lf[k], of); unpack8(lb[k], ob); unpack8(lz[k], z); float ss = 0.f;
#pragma unroll
                    for (int e = 0; e < 8; ++e) { of[e] += ob[e]; ss += of[e] * of[e]; }
                    const float rs = __builtin_amdgcn_rsqf(g16_sum(ss) * (1.0f / 128.0f) + LN_EPS);
#pragma unroll
                    for (int e = 0; e < 4; ++e) { o[e] = of[e] * rs * nw0[e] * z[e]; o[4 + e] = of[4 + e] * rs * nw1[e] * z[4 + e]; }
                    if (row_ < nrows2) *(v4u*)(BR + (size_t)row * 512 + ch) = pack8(o); } }
            }
        } }
        SEAM(pb + 5);

        for (int rep_ = 0; rep_ <= (int)PH_REP(7); ++rep_) { if (rep_) GRID_BAR();
        if (PH_ON(7) && IN(pb + 6)) { PH_BEGIN(); const float* mv = modv + (size_t)l * 9 * 6144; (void)mv; unsigned* const moecnt = ctl + CW_MOE + l * 16 * 64; (void)moecnt;
            SchedBranch S{X.G, X.bid, npan2, (const char*)BR, (const char*)WBR};
            EpiBf16<0> E{GT, 4096, nullptr};
            pg8::gemm_phase<EpiBf16<0>, SchedBranch, true, true>(lds, Gemm{512, 512, 512}, S, E);
        } }
        SEAM(pb + 6);

        for (int rep_ = 0; rep_ <= (int)PH_REP(8); ++rep_) { if (rep_) GRID_BAR();
        if (PH_ON(8) && IN(pb + 7)) { PH_BEGIN(); const float* mv = modv + (size_t)l * 9 * 6144; (void)mv; unsigned* const moecnt = ctl + CW_MOE + l * 16 * 64; (void)moecnt;
            SchedGrid S{X.G, X.bid, npan2, 16, (const char*)XN, (const char*)(WIN + (size_t)5120 * 1024), (size_t)256 * 1024 * 2, (size_t)256 * 1024 * 2};
            EpiGateMerge E{GT, (bf16*)MERGED, binv + 5120};
            pg8::gemm_phase<EpiGateMerge, SchedGrid, true, true>(lds, Gemm{1024, 1024, 1024}, S, E);
        } }
        SEAM(pb + 7);

        for (int rep_ = 0; rep_ <= (int)PH_REP(9); ++rep_) { if (rep_) GRID_BAR();
        if (PH_ON(9) && IN(pb + 8)) { PH_BEGIN(); const float* mv = modv + (size_t)l * 9 * 6144; (void)mv; unsigned* const moecnt = ctl + CW_MOE + l * 16 * 64; (void)moecnt;
            SchedGrid S{X.G, X.bid, npan2, 4, (const char*)MERGED, (const char*)WOUT, (size_t)256 * 1024 * 2, (size_t)256 * 1024 * 2};
            EpiBf16<0> E{(bf16*)YB, 1024, INP(I_BOUT) + l * 1024};
            pg8::gemm_phase<EpiBf16<0>, SchedGrid, true, true>(lds, Gemm{1024, 1024, 1024}, S, E);
            __syncthreads();
            { LAS float* const wscr = (LAS float*)(lds + X.wave * 8448);
              const int first = npan2 * 4 > X.G ? npan2 * 4 - X.G : 0;
              if (X.bid >= first) { const int gwc = (X.bid - first) * NWAVES + X.wave, ngwc = (X.G - first) * NWAVES;
              for (int it = gwc; it < 12288; it += ngwc) {
                if (it < 8192) { const int e = it >> 9, rb = (it & 3) + 4 * ((it >> 3) & 7), kb = ((it >> 2) & 1) + 2 * ((it >> 6) & 7), row0 = rb * 32, j = row0 >> 8, w = row0 & 255;
                    const float* src = (w < 128 ? INP(I_EWG) : INP(I_EWU)) + ((size_t)(l * 16 + e) * 1024) * 512;
                    cvt_item(src, 512, 128 * j + (w & 127) + (lane & 31), kb * 64, WGU + ((size_t)e * 1024 + row0) * 1024, 1024, wscr, lane); }
                else { const int i2 = it - 8192; const int e = i2 >> 8, rb = (i2 & 3) + 4 * ((i2 >> 3) & 7), kb = ((i2 >> 2) & 1) + 2 * ((i2 >> 6) & 3);
                    cvt_item(INP(I_EWD) + ((size_t)(l * 16 + e) * 512) * 1024, 1024, rb * 32 + (lane & 31), kb * 64, WDN + ((size_t)e * 1024 + rb * 32) * 512, 512, wscr, lane); }
              } } }
        } }
        SEAM(pb + 8);

        for (int rep_ = 0; rep_ <= (int)PH_REP(10); ++rep_) { if (rep_) GRID_BAR();
        if (PH_ON(10) && IN(pb + 9)) { PH_BEGIN(); const float* mv = modv + (size_t)l * 9 * 6144; (void)mv; unsigned* const moecnt = ctl + CW_MOE + l * 16 * 64; (void)moecnt;
            LAS float* wr_ = (LAS float*)lds;
            volatile LAS unsigned* lcnt = (volatile LAS unsigned*)(lds + 100352);
            __syncthreads();
            if (tid < 32) lcnt[tid] = 0u;
            { f32x4 rq[10];
#pragma unroll
              for (int j = 0; j < 2; ++j) rq[j] = *(const f32x4*)(INP(I_RGW) + (size_t)l * 4096 + (size_t)(tid + 512 * j) * 4);
#pragma unroll
              for (int j = 0; j < 8; ++j) rq[2 + j] = *(const f32x4*)(INP(I_REW) + (size_t)l * 16384 + (size_t)(tid + 512 * (j & 1)) * 16 + 4 * (j >> 1));
#pragma unroll
              for (int j = 0; j < 2; ++j) { LAS float* p = wr_ + tid + 512 * j; p[0] = rq[j][0]; p[1024] = rq[j][1]; p[2048] = rq[j][2]; p[3072] = rq[j][3]; }
#pragma unroll
              for (int j = 0; j < 8; ++j) { LAS float* p = wr_ + (4 + 4 * (j >> 1)) * 1024 + tid + 512 * (j & 1); p[0] = rq[2 + j][0]; p[1024] = rq[2 + j][1]; p[2048] = rq[2 + j][2]; p[3072] = rq[2 + j][3]; } }
            __syncthreads();
            const float* g1 = INP(I_LN1G) + l * 1024, *b1 = INP(I_LN1B) + l * 1024;
            const float rgb_l = INP(I_RGB)[l * 4 + ((lane >> 4) & 3)], reb_l = INP(I_REB)[l * 16 + ((lane >> 2) & 15)];
            constexpr int RT = 2;
            const int RPW = (nrows2 + NGW - 1) / NGW, r0w = gw * RPW, r1w = r0w + RPW < nrows2 ? r0w + RPW : nrows2;
            f32x4 g1v[4], b1v[4], gt[4], scv[4], shv[4]; int mic = -1;
#pragma unroll
            for (int j = 0; j < 4; ++j) { const int c = 4 * lane + 256 * j; g1v[j] = *(const f32x4*)(g1 + c); b1v[j] = *(const f32x4*)(b1 + c); gt[j] = (f32x4){0.f, 0.f, 0.f, 0.f}; scv[j] = gt[j]; shv[j] = gt[j]; }
            for (int rowb = r0w; rowb < r1w; rowb += RT) {
                f32x4 v[RT][4];
#pragma unroll
                for (int q = 0; q < RT; ++q) { const int row_ = rowb + q, row = row_ < r1w ? row_ : r1w - 1; const bool live = row_ < r1w;
                    float* hrow = row < NLAT ? hlat + (size_t)row * D : hctx + (size_t)(row - NLAT) * D;
                    const int mi = row < NLAT ? (row >> 11) : 8; const float* mrow = mv + mi * 6144;
                    v2u yw[4]; f32x4 hv[4];
#pragma unroll
                    for (int j = 0; j < 4; ++j) { const int c = 4 * lane + 256 * j; yw[j] = *(const v2u*)((const bf16*)YB + (size_t)row * D + c); hv[j] = *(const f32x4*)(hrow + c); }
                    if (mi != mic) { mic = mi;
#pragma unroll
                        for (int j = 0; j < 4; ++j) { const int c = 4 * lane + 256 * j; gt[j] = *(const f32x4*)(mrow + 2048 + c); scv[j] = *(const f32x4*)(mrow + 4096 + c); shv[j] = *(const f32x4*)(mrow + 3072 + c); } }
#pragma unroll
                    for (int j = 0; j < 4; ++j) { const f32x4 yv = (f32x4){bflo(yw[j].x), bfhi(yw[j].x), bflo(yw[j].y), bfhi(yw[j].y)}; v[q][j] = hv[j] * DN_ALPHA + gt[j] * yv; }
                    ln_rows(v[q]);
#pragma unroll
                    for (int j = 0; j < 4; ++j) { const int c = 4 * lane + 256 * j; v[q][j] = v[q][j] * g1v[j] + b1v[j]; if (live) *(f32x4*)(hrow + c) = v[q][j]; }
                    ln_rows(v[q]);
#pragma unroll
                    for (int j = 0; j < 4; ++j) { const int c = 4 * lane + 256 * j; v[q][j] = v[q][j] * (scv[j] + 1.0f) + shv[j];
                        v2u w; w.x = pk2(v[q][j][0], v[q][j][1]); w.y = pk2(v[q][j][2], v[q][j][3]); if (live) *(v2u*)(XN + (size_t)row * D + c) = w; }
                    asm volatile("" ::: "memory"); }
                static_assert(RT == 2, "the two rows of a trip ride in the two halves of packed f32 operations");
                float pg[RT][4], pe[RT][16];
                { f32x2 vp[4][4];
#pragma unroll
                  for (int j = 0; j < 4; ++j)
#pragma unroll
                      for (int e = 0; e < 4; ++e) vp[j][e] = (f32x2){v[0][j][e], v[1][j][e]};
#pragma unroll
                  for (int o = 0; o < 20; ++o) { f32x2 sr = (f32x2){0.f, 0.f};
#pragma unroll
                    for (int j = 0; j < 4; ++j) { const f32x4 w = *(const LAS f32x4*)(wr_ + o * 1024 + 4 * lane + 256 * j);
#pragma unroll
                        for (int e = 0; e < 4; ++e) sr += vp[j][e] * w[e]; }
                    if (o < 4) { pg[0][o] = sr[0]; pg[1][o] = sr[1]; } else { pe[0][o - 4] = sr[0]; pe[1][o - 4] = sr[1]; }
                    if ((o & 3) == 3) asm volatile("" ::: "memory"); } }
#pragma unroll
                for (int q = 0; q < RT; ++q) { const int row = rowb + q;
                float tg = reduce4(pg[q], lane), te = reduce16(pe[q], lane);
                tg += rgb_l; te += reb_l;
                float lg[20];
#pragma unroll
                for (int o = 0; o < 4; ++o) lg[o] = __shfl(tg, o * 16);
#pragma unroll
                for (int o = 0; o < 16; ++o) lg[4 + o] = __shfl(te, o * 4);
                int gs = 0; float gm = lg[0];
#pragma unroll
                for (int o = 1; o < 4; ++o) if (lg[o] > gm) { gm = lg[o]; gs = o; }
                float den = 0.f;
#pragma unroll
                for (int o = 0; o < 4; ++o) den += __expf(lg[o] - gm);
                const float gp = __builtin_amdgcn_rcpf(den);
                float el[4];
#pragma unroll
                for (int o = 0; o < 4; ++o) el[o] = gs == 0 ? lg[4 + o] : gs == 1 ? lg[8 + o] : gs == 2 ? lg[12 + o] : lg[16 + o];
                int i0 = 0; float v0 = el[0];
#pragma unroll
                for (int o = 1; o < 4; ++o) if (el[o] > v0) { v0 = el[o]; i0 = o; }
                int i1 = -1; float v1 = 0.f;
#pragma unroll
                for (int o = 0; o < 4; ++o) if (o != i0 && (i1 < 0 || el[o] > v1)) { v1 = el[o]; i1 = o; }
                const float ex = __expf(v1 - v0), rz = __builtin_amdgcn_rcpf(1.0f + ex), w0 = gp * rz, w1 = gp * ex * rz;
                const int e0 = gs * 4 + i0, e1 = gs * 4 + i1;
                if (lane == 0 && row < r1w) {
                    const unsigned p0 = __hip_atomic_fetch_add((LAS unsigned*)lcnt + e0, 1u, __ATOMIC_RELAXED, __HIP_MEMORY_SCOPE_WORKGROUP);
                    const unsigned p1 = __hip_atomic_fetch_add((LAS unsigned*)lcnt + e1, 1u, __ATOMIC_RELAXED, __HIP_MEMORY_SCOPE_WORKGROUP);
                    float* rt = ROUTE + (size_t)row * 8;
                    rt[0] = __builtin_bit_cast(float, e0); rt[1] = __builtin_bit_cast(float, e1); rt[2] = w0; rt[3] = w1; rt[4] = __builtin_bit_cast(float, (int)p0); rt[5] = __builtin_bit_cast(float, (int)p1);
                }
                asm volatile("" ::: "memory"); }
            }
            __syncthreads();
            if (tid < 16) { const unsigned c = lcnt[tid]; lcnt[16 + tid] = c ? __hip_atomic_fetch_add(moecnt + 64 * tid, c, __ATOMIC_RELAXED, __HIP_MEMORY_SCOPE_AGENT) : 0u; }
            __syncthreads();
            for (int row = r0w + lane; row < r1w; row += 64) {
                { float* rt = ROUTE + (size_t)row * 8; const int e0 = __builtin_bit_cast(int, rt[0]), e1 = __builtin_bit_cast(int, rt[1]);
                    const int q0 = __builtin_bit_cast(int, rt[4]) + (int)lcnt[16 + e0], q1 = __builtin_bit_cast(int, rt[5]) + (int)lcnt[16 + e1];
                    rt[4] = __builtin_bit_cast(float, q0); rt[5] = __builtin_bit_cast(float, q1);
                    ELIST[(size_t)e0 * NTOK + q0] = row; ELIST[(size_t)e1 * NTOK + q1] = row; }
            }
        } }
        SEAM(pb + 9);


        for (int rep_ = 0; rep_ <= (int)PH_REP(12); ++rep_) { if (rep_) GRID_BAR();
        if (PH_ON(12) && IN(pb + 11)) { PH_BEGIN(); const float* mv = modv + (size_t)l * 9 * 6144; (void)mv; unsigned* const moecnt = ctl + CW_MOE + l * 16 * 64; (void)moecnt;
            SchedMoeG S; S.G = X.G; S.c = X.bid; S.a0 = (const char*)XN; S.w0 = (const char*)WGU; S.wstep_e = (size_t)1024 * 1024 * 2; S.wstep_n = (size_t)256 * 1024 * 2; S.list = ELIST; S.init(moecnt, (LAS unsigned*)(lds + LDSCTL_OFF + 64));
            EpiMoe1 E{HID};
            pg8::gemm_phase<EpiMoe1, SchedMoeG, true, true>(lds, Gemm{1024, 1024, 1024}, S, E);
        } }
        SEAM(pb + 11);

        for (int rep_ = 0; rep_ <= (int)PH_REP(13); ++rep_) { if (rep_) GRID_BAR();
        if (PH_ON(13) && IN(pb + 12)) { PH_BEGIN(); const float* mv = modv + (size_t)l * 9 * 6144; (void)mv; unsigned* const moecnt = ctl + CW_MOE + l * 16 * 64; (void)moecnt;
            SchedMoe S; S.G = X.G; S.c = X.bid; S.a0 = (const char*)HID; S.w0 = (const char*)WDN; S.astep = (size_t)256 * 512 * 2; S.wstep_e = (size_t)1024 * 512 * 2; S.wstep_n = (size_t)256 * 512 * 2; S.init(moecnt);
            EpiBf16<0> E{MO, 1024, nullptr};
            pg8::gemm_phase<EpiBf16<0>, SchedMoe, true, true>(lds, Gemm{512, 512, 512}, S, E);
        } }
        SEAM(pb + 12);

        for (int rep_ = 0; rep_ <= (int)PH_REP(14); ++rep_) { if (rep_) GRID_BAR();
        if (PH_ON(14) && IN(pb + 13) && l != 0) {   PH_BEGIN(); const float* mv = modv + (size_t)l * 9 * 6144; (void)mv; unsigned* const moecnt = ctl + CW_MOE + l * 16 * 64; (void)moecnt;
            unsigned pre[16]; { unsigned s = 0;
                const unsigned cmine = __hip_atomic_load(moecnt + 64 * (lane & 15), __ATOMIC_RELAXED, __HIP_MEMORY_SCOPE_AGENT);
#pragma unroll
                for (int e = 0; e < 16; ++e) { pre[e] = s; s += (((unsigned)__builtin_amdgcn_readlane((int)cmine, e) + 255u) >> 8) << 8; } }
            const float* g2 = INP(I_LN2G) + l * 1024, *b2 = INP(I_LN2B) + l * 1024;
            const int RPW = (nrows2 + NGW - 1) / NGW, r0w = gw * RPW, r1w = r0w + RPW < nrows2 ? r0w + RPW : nrows2;
            f32x4 g2v[4], b2v[4], gtv[4]; int mic = -1;
#pragma unroll
            for (int j = 0; j < 4; ++j) { const int c = 4 * lane + 256 * j; g2v[j] = *(const f32x4*)(g2 + c); b2v[j] = *(const f32x4*)(b2 + c); gtv[j] = (f32x4){0.f, 0.f, 0.f, 0.f}; }
            for (int rowb = r0w; rowb < r1w; rowb += 3) {
                int re0[3], re1[3], rp0[3], rp1[3]; float rw0[3], rw1[3];
#pragma unroll
                for (int k = 0; k < 3; ++k) { const int row_ = rowb + k, row = row_ < r1w ? row_ : r1w - 1; const float* rt = ROUTE + (size_t)row * 8;
                    re0[k] = __builtin_bit_cast(int, rt[0]); re1[k] = __builtin_bit_cast(int, rt[1]); rw0[k] = rt[2]; rw1[k] = rt[3]; rp0[k] = __builtin_bit_cast(int, rt[4]); rp1[k] = __builtin_bit_cast(int, rt[5]); }
                v2u ma[3][4], mb[3][4]; f32x4 hv[3][4];
#pragma unroll
                for (int k = 0; k < 3; ++k) { const int row_ = rowb + k, row = row_ < r1w ? row_ : r1w - 1; {
                    const int e0 = re0[k], e1 = re1[k]; unsigned ba0 = 0, ba1 = 0;
#pragma unroll
                    for (int q = 0; q < 16; ++q) { ba0 = (q == e0) ? pre[q] : ba0; ba1 = (q == e1) ? pre[q] : ba1; }
                    const bf16* m0 = MO + (size_t)(ba0 + (unsigned)rp0[k]) * D, *m1 = MO + (size_t)(ba1 + (unsigned)rp1[k]) * D;
                    const float* hrow = row < NLAT ? hlat + (size_t)row * D : hctx + (size_t)(row - NLAT) * D;
#pragma unroll
                    for (int j = 0; j < 4; ++j) { const int c = 4 * lane + 256 * j; ma[k][j] = *(const v2u*)(m0 + c); mb[k][j] = *(const v2u*)(m1 + c); hv[k][j] = *(const f32x4*)(hrow + c); } } }
#pragma unroll
                for (int k = 0; k < 3; ++k) { const int row_ = rowb + k, row = row_ < r1w ? row_ : r1w - 1; {
                    float* hrow = row < NLAT ? hlat + (size_t)row * D : hctx + (size_t)(row - NLAT) * D;
                    const int mi = row < NLAT ? (row >> 11) : 8; const float* mrow = mv + mi * 6144; const float w0 = rw0[k], w1 = rw1[k];
                    f32x4 v[4];
                    if (mi != mic) { mic = mi;
#pragma unroll
                        for (int j = 0; j < 4; ++j) { const int c = 4 * lane + 256 * j; gtv[j] = *(const f32x4*)(mrow + 5120 + c); } }
#pragma unroll
                    for (int j = 0; j < 4; ++j) { const v2u a = ma[k][j], b = mb[k][j];
                        f32x4 mm; mm[0] = w0 * bflo(a.x) + w1 * bflo(b.x); mm[1] = w0 * bfhi(a.x) + w1 * bfhi(b.x); mm[2] = w0 * bflo(a.y) + w1 * bflo(b.y); mm[3] = w0 * bfhi(a.y) + w1 * bfhi(b.y);
                        v[j] = hv[k][j] * DN_ALPHA + gtv[j] * mm; }
                    ln_rows(v);
                    if (row_ < r1w) {
#pragma unroll
                    for (int j = 0; j < 4; ++j) { const int c = 4 * lane + 256 * j; *(f32x4*)(hrow + c) = v[j] * g2v[j] + b2v[j]; } } } }
            }
        } }
        if (l != 0) SEAM(pb + 13);
    }
#if TPROBE
    {
        GRID_BAR(); STAMP(NPHASES); GRID_BAR();
        unsigned* ts = (unsigned*)(args.ws + WS_CTL) + CW_TS; float T = 0.f;
        for (int l2 = 0; l2 < 2; ++l2) { const int p = (TPA) == 100 ? 0 : 1 + NPH_LAYER * l2 + (TPA);
            if ((TPA) != 100 || l2 == 0) T += (float)(__hip_atomic_load(ts + p + 1, __ATOMIC_RELAXED, __HIP_MEMORY_SCOPE_AGENT) - __hip_atomic_load(ts + p, __ATOMIC_RELAXED, __HIP_MEMORY_SCOPE_AGENT)) * 0.01f; }
        for (size_t i = (size_t)blockIdx.x * 512 + threadIdx.x; i < (size_t)NLAT * D; i += (size_t)gridDim.x * 512) { const int j = (int)(i >> 19);
            if (T >= (float)(TOFF) + 20.0f * (float)(j + 1)) args.out[i] += 0.2f; }
    }
#endif
#undef IN
#undef SEAM
}

extern "C" void kernel_launch(void* const* d_in, const int* in_sizes, int n_in, void* d_out, int out_size, void* d_ws, size_t ws_size, hipStream_t stream) {
    static int grid = 0;
    if (grid == 0) {
        if (n_in != 34 || out_size != NLAT * D || ws_size < WS_END + MiB) { fprintf(stderr, "kernel_launch: unexpected problem (n_in %d out %d ws %zu)\n", n_in, out_size, ws_size); grid = -1; return; }
        int dev = 0, cus = 0, per_cu = 0;
        if (hipGetDevice(&dev) != hipSuccess || hipDeviceGetAttribute(&cus, hipDeviceAttributeMultiprocessorCount, dev) != hipSuccess) { grid = -1; return; }
        if (hipFuncSetAttribute((const void*)fwd, hipFuncAttributeMaxDynamicSharedMemorySize, LDS_BYTES) != hipSuccess) { fprintf(stderr, "kernel_launch: hipFuncSetAttribute failed\n"); grid = -1; return; }
        if (hipOccupancyMaxActiveBlocksPerMultiprocessor(&per_cu, (const void*)fwd, NWAVES * 64, LDS_BYTES) != hipSuccess || per_cu < 1) { fprintf(stderr, "kernel_launch: occupancy query reports %d\n", per_cu); }
        (void)hipGetLastError();
        grid = cus;
    }
    if (grid < 0) return;
    if (hipMemsetAsync((char*)d_ws + WS_CTL, 0, CTL_ZERO_BYTES, stream) != hipSuccess) return;
    Args a{};
    for (int i = 0; i < 34; ++i) a.in[i] = (const float*)d_in[i];
    a.out = (float*)d_out; a.ws = (unsigned char*)d_ws;
#if MK_ONE_LAUNCH
    a.ph_lo = 0; a.ph_hi = NPHASES;
    hipLaunchKernelGGL(fwd, dim3(grid), dim3(NWAVES * 64), LDS_BYTES, stream, a);
#else
    for (int p = 0; p < NPHASES; ++p) { a.ph_lo = p; a.ph_hi = p + 1; hipLaunchKernelGGL(fwd, dim3(grid), dim3(NWAVES * 64), LDS_BYTES, stream, a); }
#endif
}
```
